# Optimizing an MI355X kernel written in HIP

```python
import math
import jax, jax.numpy as jnp
from jax import lax
import numpy as np

D_MODEL = 2048
BATCH = 2
SEQ = 4096
DEPTH = 1

EPS = 1e-6
GLA_HEADS = 8
GLA_DV = D_MODEL // 2 // GLA_HEADS
GLA_DK = GLA_DV // 2
GLA_GATE_RANK = 16
GLA_GATE_NORMALIZER = 16.0
GLA_CHUNK = 64
MOBA_HEADS = 8
MOBA_HEAD_DIM = D_MODEL // 2 // MOBA_HEADS
MOBA_BLOCK = 256
MOBA_TOPK = 3
MOBA_QCHUNK = 32
ROPE_THETA = 500000.0
ROPE_DIMS = MOBA_HEAD_DIM // 4
PEER_HEADS = 8
PEER_N_KEYS = 128
PEER_N_EXPERTS = PEER_N_KEYS * PEER_N_KEYS
PEER_QUERY_DIM = 256
PEER_TOPK = 16
PEER_TOKEN_CHUNK = 128
IN_SPLITS = (GLA_HEADS * GLA_DK, GLA_HEADS * GLA_DK, GLA_HEADS * GLA_DV, GLA_HEADS * GLA_DV, GLA_GATE_RANK,
             MOBA_HEADS * MOBA_HEAD_DIM, MOBA_HEADS * MOBA_HEAD_DIM, MOBA_HEADS * MOBA_HEAD_DIM)
IN_WIDTH = sum(IN_SPLITS)
MIX_WIDTH = GLA_HEADS * GLA_DV + MOBA_HEADS * MOBA_HEAD_DIM

kernel_name = "hybrid_gla_moba_peer_adaln"


def rms_norm(x, g):
    xf = x.astype(jnp.float32)
    y = xf * lax.rsqrt(jnp.mean(xf * xf, axis=-1, keepdims=True) + EPS)
    return (y * g.astype(jnp.float32)).astype(x.dtype)


def modulate(h, shift, scale):
    return h * (1.0 + scale[:, None, :]) + shift[:, None, :]


def partial_rotary(x, positions):
    half = ROPE_DIMS // 2
    inv_freq = jnp.power(jnp.float32(ROPE_THETA), -jnp.arange(half, dtype=jnp.float32) * (2.0 / ROPE_DIMS))
    ang = positions.astype(jnp.float32)[:, None, :, None] * inv_freq
    cos, sin = jnp.cos(ang), jnp.sin(ang)
    xr = x[..., :ROPE_DIMS].astype(jnp.float32)
    x1, x2 = xr[..., :half], xr[..., half:]
    rot = jnp.concatenate([x1 * cos - x2 * sin, x2 * cos + x1 * sin], axis=-1)
    return jnp.concatenate([rot.astype(x.dtype), x[..., ROPE_DIMS:]], axis=-1)


def gla_attention(q, k, v, log_a):
    B, H, S, DK = q.shape
    DV = v.shape[-1]
    L = GLA_CHUNK
    n = S // L
    f32 = jnp.float32
    rs = lambda t: t.astype(f32).reshape(B, H, n, L, t.shape[-1])
    q = rs(q) * (DK ** -0.5)
    k, v, log_a = rs(k), rs(v), rs(log_a)
    b = jnp.cumsum(log_a, axis=3)
    q_dec = q * jnp.exp(b)
    k_dec = k * jnp.exp(-b)
    causal = jnp.tril(jnp.ones((L, L), dtype=bool))
    attn = jnp.where(causal, jnp.einsum('bhnld,bhnmd->bhnlm', q_dec, k_dec), 0.0)
    o_intra = jnp.einsum('bhnlm,bhnmv->bhnlv', attn, v)
    b_last = b[:, :, :, -1:, :]
    chunk_update = jnp.einsum('bhnld,bhnlv->bhndv', k * jnp.exp(b_last - b), v)
    chunk_decay = jnp.exp(b_last[:, :, :, 0, :])

    def step(state, inp):
        dec, upd = inp
        return dec[..., None] * state + upd, state

    _, states = lax.scan(step, jnp.zeros((B, H, DK, DV), f32),
                         (jnp.moveaxis(chunk_decay, 2, 0), jnp.moveaxis(chunk_update, 2, 0)))
    states = jnp.moveaxis(states, 0, 2)
    o_inter = jnp.einsum('bhnld,bhndv->bhnlv', q_dec, states)
    return (o_intra + o_inter).reshape(B, H, S, DV)


def moba_attention(q, k, v):
    B, H, S, Dh = q.shape
    P = MOBA_BLOCK
    S_pad = -(-S // P) * P
    pad = S_pad - S
    if pad:
        padw = ((0, 0), (0, 0), (0, pad), (0, 0))
        q, k, v = jnp.pad(q, padw), jnp.pad(k, padw), jnp.pad(v, padw)
    nb = S_pad // P
    kb = k.reshape(B, H, nb, P, Dh)
    vb = v.reshape(B, H, nb, P, Dh)
    k_mean = jnp.mean(kb.astype(jnp.float32), axis=3)
    gate = jnp.einsum('bhsd,bhnd->bhsn', q.astype(jnp.float32), k_mean)
    q_block = jnp.arange(S_pad) // P
    past = jnp.arange(nb)[None, :] < q_block[:, None]
    gate = jnp.where(past, gate, -jnp.inf)
    n_sel = min(MOBA_TOPK, nb)
    _, sel = lax.top_k(gate, n_sel)
    sel_valid = sel < q_block[:, None]
    scale = Dh ** -0.5
    QC = MOBA_QCHUNK
    nq = S_pad // QC
    to_chunks = lambda t: jnp.moveaxis(t.reshape(B, H, nq, QC, t.shape[-1]), 2, 0)
    b_idx = jnp.arange(B)[:, None, None, None]
    h_idx = jnp.arange(H)[None, :, None, None]

    def chunk(args):
        ci, q_c, sel_c, valid_c = args
        blk = (ci * QC) // P
        k_sel = kb[b_idx, h_idx, sel_c]
        v_sel = vb[b_idx, h_idx, sel_c]
        k_own = lax.dynamic_index_in_dim(kb, blk, axis=2, keepdims=False)
        v_own = lax.dynamic_index_in_dim(vb, blk, axis=2, keepdims=False)
        s_sel = jnp.einsum('bhqd,bhqnpd->bhqnp', q_c, k_sel, preferred_element_type=jnp.float32) * scale
        s_sel = jnp.where(valid_c[..., None], s_sel, -jnp.inf).reshape(B, H, QC, n_sel * P)
        s_own = jnp.einsum('bhqd,bhpd->bhqp', q_c, k_own, preferred_element_type=jnp.float32) * scale
        q_pos = ci * QC + jnp.arange(QC)
        k_pos = blk * P + jnp.arange(P)
        s_own = jnp.where(k_pos[None, :] <= q_pos[:, None], s_own, -jnp.inf)
        p = jax.nn.softmax(jnp.concatenate([s_sel, s_own], axis=-1), axis=-1)
        p_sel = p[..., :n_sel * P].reshape(B, H, QC, n_sel, P).astype(v.dtype)
        p_own = p[..., n_sel * P:].astype(v.dtype)
        return (jnp.einsum('bhqnp,bhqnpd->bhqd', p_sel, v_sel)
                + jnp.einsum('bhqp,bhpd->bhqd', p_own, v_own))

    out = lax.map(chunk, (jnp.arange(nq), to_chunks(q), to_chunks(sel), to_chunks(sel_valid)))
    out = jnp.moveaxis(out, 0, 2).reshape(B, H, S_pad, Dh)
    return out[:, :, :S]


def peer_ffn(h, w_q, sub_keys, u, v):
    B, S, D = h.shape
    T = B * S
    K = PEER_TOPK
    hf = h.reshape(T, D)
    q = (hf @ w_q).reshape(T, PEER_HEADS, 2, PEER_QUERY_DIM // 2)
    s = jnp.einsum('thcd,hckd->thck', q, sub_keys, preferred_element_type=jnp.float32)
    s1, i1 = lax.top_k(s[:, :, 0], K)
    s2, i2 = lax.top_k(s[:, :, 1], K)
    cand_s = (s1[..., :, None] + s2[..., None, :]).reshape(T, PEER_HEADS, K * K)
    cand_i = (i1[..., :, None] * PEER_N_KEYS + i2[..., None, :]).reshape(T, PEER_HEADS, K * K)
    top_s, pos = lax.top_k(cand_s, K)
    expert = jnp.take_along_axis(cand_i, pos, axis=-1)
    gates = jax.nn.softmax(top_s, axis=-1)
    TC = PEER_TOKEN_CHUNK
    nc = T // TC

    def chunk(args):
        h_c, e_c, g_c = args
        act = jax.nn.gelu(jnp.einsum('td,thkd->thk', h_c, u[e_c], preferred_element_type=jnp.float32),
                          approximate=False)
        w = (g_c * act).astype(h.dtype)
        return jnp.einsum('thk,thkd->td', w, v[e_c])

    out = lax.map(chunk, (hf.reshape(nc, TC, D), expert.reshape(nc, TC, PEER_HEADS, K),
                          gates.reshape(nc, TC, PEER_HEADS, K)))
    return out.reshape(B, S, D)


def setup_inputs(seed: int = 0) -> dict:
    key = jax.random.key(seed)
    ks = jax.random.split(key, 16)
    D = D_MODEL
    nrm = lambda k, shape, s: jax.random.normal(k, shape, jnp.float32) * s
    return {
        "x": nrm(ks[0], (BATCH, SEQ, D), 1.0),
        "c": nrm(ks[1], (BATCH, D), 1.0),
        "positions": jnp.broadcast_to(jnp.arange(SEQ, dtype=jnp.int32)[None, :], (BATCH, SEQ)),
        "w_ada": nrm(ks[2], (D, 6 * D), 0.5 * D ** -0.5),
        "b_ada": nrm(ks[3], (6 * D,), 0.01),
        "norm1_g": 1.0 + nrm(ks[4], (D,), 0.02),
        "w_in": nrm(ks[5], (D, IN_WIDTH), D ** -0.5),
        "gla_w_a2": nrm(ks[6], (GLA_GATE_RANK, GLA_HEADS * GLA_DK), GLA_GATE_RANK ** -0.5),
        "gla_b_a": nrm(ks[7], (GLA_HEADS * GLA_DK,), 0.1),
        "gla_norm_g": 1.0 + nrm(ks[8], (GLA_DV,), 0.02),
        "moba_q_norm_g": 1.0 + nrm(ks[9], (MOBA_HEAD_DIM,), 0.02),
        "moba_k_norm_g": 1.0 + nrm(ks[10], (MOBA_HEAD_DIM,), 0.02),
        "w_out": nrm(ks[11], (MIX_WIDTH, D), MIX_WIDTH ** -0.5),
        "norm2_g": 1.0 + nrm(ks[12], (D,), 0.02),
        "peer_w_q": nrm(ks[13], (D, PEER_HEADS * PEER_QUERY_DIM), D ** -0.5),
        "peer_sub_keys": nrm(ks[14], (PEER_HEADS, 2, PEER_N_KEYS, PEER_QUERY_DIM // 2), (PEER_QUERY_DIM // 2) ** -0.5),
        "peer_u": nrm(jax.random.fold_in(ks[15], 0), (PEER_N_EXPERTS, D), D ** -0.5),
        "peer_v": nrm(jax.random.fold_in(ks[15], 1), (PEER_N_EXPERTS, D), 1.0),
    }


def reference(x, c, positions, w_ada, b_ada, norm1_g, w_in, gla_w_a2, gla_b_a, gla_norm_g,
              moba_q_norm_g, moba_k_norm_g, w_out, norm2_g, peer_w_q, peer_sub_keys, peer_u, peer_v):
    B, S, D = x.shape
    for _ in range(DEPTH):
        mod = jax.nn.silu(c) @ w_ada + b_ada
        shift1, scale1, gate1, shift2, scale2, gate2 = jnp.split(mod, 6, axis=-1)

        h = modulate(rms_norm(x, norm1_g), shift1, scale1)
        proj = h @ w_in
        offs = np.cumsum(IN_SPLITS)[:-1].tolist()
        gq, gk, gv, gg, ga, mq, mk, mv = jnp.split(proj, offs, axis=-1)

        heads = lambda t, nh: jnp.transpose(t.reshape(B, S, nh, -1), (0, 2, 1, 3))
        log_a = jax.nn.log_sigmoid((ga @ gla_w_a2 + gla_b_a).astype(jnp.float32)) / GLA_GATE_NORMALIZER
        o_gla = gla_attention(heads(gq, GLA_HEADS), heads(gk, GLA_HEADS), heads(gv, GLA_HEADS),
                              heads(log_a, GLA_HEADS)).astype(x.dtype)
        o_gla = rms_norm(jnp.transpose(o_gla, (0, 2, 1, 3)), gla_norm_g)
        o_gla = (o_gla * jax.nn.silu(gg.reshape(B, S, GLA_HEADS, GLA_DV))).reshape(B, S, GLA_HEADS * GLA_DV)

        qm = rms_norm(mq.reshape(B, S, MOBA_HEADS, MOBA_HEAD_DIM), moba_q_norm_g)
        km = rms_norm(mk.reshape(B, S, MOBA_HEADS, MOBA_HEAD_DIM), moba_k_norm_g)
        qm = partial_rotary(jnp.transpose(qm, (0, 2, 1, 3)), positions)
        km = partial_rotary(jnp.transpose(km, (0, 2, 1, 3)), positions)
        o_moba = moba_attention(qm, km, heads(mv, MOBA_HEADS))
        o_moba = jnp.transpose(o_moba, (0, 2, 1, 3)).reshape(B, S, MOBA_HEADS * MOBA_HEAD_DIM)

        mix = jnp.concatenate([o_gla, o_moba], axis=-1) @ w_out
        x = x + gate1[:, None, :] * mix

        h2 = modulate(rms_norm(x, norm2_g), shift2, scale2)
        x = x + gate2[:, None, :] * peer_ffn(h2, peer_w_q, peer_sub_keys, peer_u, peer_v)
    return x
```

```cpp
#include <hip/hip_runtime.h>
#include <hip/hip_bf16.h>
#include <cstdio>
#include <cstdint>
#include <cmath>
namespace pg8 {
#define PG8_LAS __attribute__((address_space(3)))
typedef unsigned short bf16_t;
typedef short bf16x8 __attribute__((ext_vector_type(8)));
typedef float f32x4 __attribute__((ext_vector_type(4)));
typedef unsigned u32x4 __attribute__((ext_vector_type(4)));
constexpr int BM = 256, BK = 64, HALF = 128, HTB = HALF * BK * 2  , STAGE_BYTES = 8 * HTB, NXCD = 8, WGM = 8;

__host__ __device__ __forceinline__ int lds_byte(int r, int c) { const int st = (r >> 4) * 2 + (c >> 5), rr = r & 15, cc = c & 31, ob = rr * 64 + cc * 2; return st * 1024 + (ob ^ (((ob >> 9) & 1) << 5)); }
__host__ __device__ __forceinline__ void stage_rc(int b, int& R, int& C) { const int st = b / 1024, sb = b % 1024, swz = sb ^ (((sb >> 9) & 1) << 5); R = (st >> 1) * 16 + swz / 64; C = (st & 1) * 32 + (swz % 64) / 2; }
__host__ __device__ __forceinline__ int perm32(int rho) { const int n = rho >> 4, i = rho & 15; return 8 * (i >> 2) + 4 * n + (i & 3); }

struct Unit { int pm, pn; };
struct Gemm { const bf16_t* A; const bf16_t* Bt; int M, N, K; };

struct StaticOrder {
    int nM, nN, nwg, G, c;
    __host__ __device__ void init(int M, int N, int G_, int c_) { nM = M / BM; nN = N / BM; nwg = nM * nN; G = G_; c = c_; }
    __host__ __device__ bool next(int i, Unit& u) const {
        const long L = (long)i * G + c; if (L >= nwg) return false;
        int wgid = (int)L; { const int q = nwg / NXCD, r = nwg % NXCD, xcd = wgid % NXCD, off = wgid / NXCD; wgid = (xcd < r ? xcd * (q + 1) : r * (q + 1) + (xcd - r) * q) + off; }
        const int nig = WGM * nN, gid = wgid / nig, fm = gid * WGM, gsz = (nM - fm) < WGM ? (nM - fm) : WGM;
        u.pm = fm + ((wgid % nig) % gsz); u.pn = (wgid % nig) / gsz; return true;
    }
    __device__ __forceinline__ void a_ready(const Unit&) const {}
    __device__ __forceinline__ void done(const Unit&) const {}
};

__device__ __forceinline__ unsigned cvt_pk_bf16(float lo, float hi) { unsigned r; asm volatile("v_cvt_pk_bf16_f32 %0, %1, %2" : "=v"(r) : "v"(lo), "v"(hi)); return r; }
typedef float f32x2 __attribute__((ext_vector_type(2)));
__device__ __forceinline__ f32x2 gelu_pk(f32x2 v) {
    const f32x2 av = __builtin_elementwise_abs(v), d = av * 0.2316418882f + 1.0f;
    f32x2 t; t.x = __builtin_amdgcn_rcpf(d.x); t.y = __builtin_amdgcn_rcpf(d.y);
    f32x2 q = t * 0.5307027145f + (-0.7265760135f); q = q * t + 0.7107068705f; q = q * t + (-0.142248368f); q = q * t + 0.127414796f; q = q * t;
    const f32x2 s = (v * v) * (-0.72134752044f);
    f32x2 e; e.x = __builtin_amdgcn_exp2f(s.x); e.y = __builtin_amdgcn_exp2f(s.y);
    const f32x2 m = v * (q * e), r = v - m;
    f32x2 o; o.x = v.x < 0.f ? m.x : r.x; o.y = v.y < 0.f ? m.y : r.y; return o;
}

template <int ACT  > struct EpiBf16 {
    static constexpr bool PERM = true, AFTER_DRAIN = false; static_assert(ACT == 0 || ACT == 1, "EpiBf16: ACT is 0 (none) or 1 (gelu_pk)");
    bf16_t* O; int ldc; const float* bias; int split_cols; size_t split_stride; float scale0;
    __device__ __forceinline__ void operator()(const f32x4 (&acc)[2][2][4][2], const Unit& u, int wr, int wc, int fr, int fq) const {
        const int row0 = u.pm * BM + wr * 64 + fr; int colt = u.pn * BM; bf16_t* base = O;
        float sc = 1.f; if (split_cols) { const int t = colt / split_cols; base += (size_t)t * split_stride; colt -= t * split_cols; if (t == 0) sc = scale0; }
        const int col0 = colt + wc * 32 + 8 * fq, bcol0 = u.pn * BM + wc * 32 + 8 * fq;
        f32x4 bv[2][2];
#pragma unroll
        for (int bj = 0; bj < 2; ++bj)
#pragma unroll
            for (int n = 0; n < 2; ++n) bv[bj][n] = bias ? *(const f32x4*)(bias + bcol0 + bj * HALF + 4 * n) : (f32x4){0.f, 0.f, 0.f, 0.f};
#pragma unroll
        for (int ai = 0; ai < 2; ++ai)
#pragma unroll
            for (int m = 0; m < 4; ++m) { bf16_t* rowp = base + (size_t)(row0 + ai * HALF + m * 16) * ldc + col0;
#pragma unroll
                for (int bj = 0; bj < 2; ++bj) { f32x4 v0 = acc[ai][bj][m][0] + bv[bj][0], v1 = acc[ai][bj][m][1] + bv[bj][1];
                    if (ACT == 1) { f32x2 a = gelu_pk((f32x2){v0[0], v0[1]}), b = gelu_pk((f32x2){v0[2], v0[3]}), c = gelu_pk((f32x2){v1[0], v1[1]}), d = gelu_pk((f32x2){v1[2], v1[3]});
                        v0 = (f32x4){a.x, a.y, b.x, b.y}; v1 = (f32x4){c.x, c.y, d.x, d.y}; }
                    v0 = v0 * sc; v1 = v1 * sc; u32x4 w; w.x = cvt_pk_bf16(v0[0], v0[1]); w.y = cvt_pk_bf16(v0[2], v0[3]); w.z = cvt_pk_bf16(v1[0], v1[1]); w.w = cvt_pk_bf16(v1[2], v1[3]);
                    *(u32x4*)(rowp + bj * HALF) = w; } }
    }
};
struct EpiF32 {
    static constexpr bool PERM = false, AFTER_DRAIN = false;
    float* C; int ldc; const float* bias;
    __device__ __forceinline__ void operator()(const f32x4 (&acc)[2][2][4][2], const Unit& u, int wr, int wc, int fr, int fq) const {
        const int row0 = u.pm * BM + wr * 64 + fr, col0 = u.pn * BM + wc * 32 + 4 * fq;
        f32x4 bv[2][2];
#pragma unroll
        for (int bj = 0; bj < 2; ++bj)
#pragma unroll
            for (int n = 0; n < 2; ++n) bv[bj][n] = bias ? *(const f32x4*)(bias + col0 + bj * HALF + n * 16) : (f32x4){0.f, 0.f, 0.f, 0.f};
#pragma unroll
        for (int ai = 0; ai < 2; ++ai)
#pragma unroll
            for (int m = 0; m < 4; ++m) { float* rowp = C + (size_t)(row0 + ai * HALF + m * 16) * ldc + col0;
#pragma unroll
                for (int bj = 0; bj < 2; ++bj)
#pragma unroll
                    for (int n = 0; n < 2; ++n) *(f32x4*)(rowp + bj * HALF + n * 16) = acc[ai][bj][m][n] + bv[bj][n]; }
    }
};
struct EpiResGate {
    static constexpr bool PERM = false, AFTER_DRAIN = false;
    const float* X; float* O; int ldc; const float* gate; int gate_stride, tiles_per_batch;
    __device__ __forceinline__ void operator()(const f32x4 (&acc)[2][2][4][2], const Unit& u, int wr, int wc, int fr, int fq) const {
        const int row0 = u.pm * BM + wr * 64 + fr, col0 = u.pn * BM + wc * 32 + 4 * fq;
        const float* gp = gate + (size_t)(u.pm / tiles_per_batch) * gate_stride;
        f32x4 gv[2][2];
#pragma unroll
        for (int bj = 0; bj < 2; ++bj)
#pragma unroll
            for (int n = 0; n < 2; ++n) gv[bj][n] = *(const f32x4*)(gp + col0 + bj * HALF + n * 16);
#pragma unroll
        for (int ai = 0; ai < 2; ++ai)
#pragma unroll
            for (int m = 0; m < 4; ++m) { const size_t off = (size_t)(row0 + ai * HALF + m * 16) * ldc + col0;
#pragma unroll
                for (int bj = 0; bj < 2; ++bj)
#pragma unroll
                    for (int n = 0; n < 2; ++n) { const f32x4 xv = *(const f32x4*)(X + off + bj * HALF + n * 16); *(f32x4*)(O + off + bj * HALF + n * 16) = xv + gv[bj][n] * acc[ai][bj][m][n]; } }
    }
};

template <class Epi, class Sched, bool ALIGN_EPI = false, bool SP2 = false>
__device__ __forceinline__ void gemm_phase(PG8_LAS unsigned char* lds, const Gemm g, const Sched& S, const Epi& E) {
    const int tid = threadIdx.x, wid = __builtin_amdgcn_readfirstlane(tid >> 6), lane = tid & 63, wr = wid >> 2, wc = wid & 3, fr = lane & 15, fq = lane >> 4;
    const int K = g.K, nt = K / BK;
    unsigned voffA[2], voffB[2];
#pragma unroll
    for (int i = 0; i < 2; ++i) { int R, C; stage_rc(tid * 16 + i * 8192, R, C); const int Rb = Epi::PERM ? ((R & ~31) + perm32(R & 31)) : R;
        voffA[i] = (unsigned)(R * K + C) * 2u; voffB[i] = (unsigned)(Rb * K + C) * 2u; }
    const size_t kstep = (size_t)(BK * 2);
    const size_t hstep = (size_t)HALF * K * 2;
    const size_t tstep = 2 * hstep;
    const unsigned ldsw = (unsigned)wid * 1024u;
    const int aoff = lds_byte(wr * 64 + fr, fq * 8), boff = lds_byte(wc * 32 + fr, fq * 8);
#define PG8_SA(b, h) (((b) * 2 + (h)) * HTB)
#define PG8_SB(b, h) ((4 + (b) * 2 + (h)) * HTB)
#define PG8_STAGE(bufoff, gbase, voff) do { _Pragma("unroll") for (int _i = 0; _i < 2; ++_i) \
        __builtin_amdgcn_global_load_lds((const unsigned*)((const char*)(gbase) + (voff)[_i]), (PG8_LAS unsigned*)(lds + (bufoff) + ldsw + _i * 8192), 16, 0, 0); } while (0)
#define PG8_LDA(dst, b, h) do { _Pragma("unroll") for (int m = 0; m < 4; ++m) _Pragma("unroll") for (int k = 0; k < 2; ++k) dst[m][k] = *(const PG8_LAS bf16x8*)(lds + PG8_SA(b, h) + aoff + m * 2048 + k * 1024); } while (0)
#define PG8_LDB(dst, b, h) do { _Pragma("unroll") for (int n = 0; n < 2; ++n) _Pragma("unroll") for (int k = 0; k < 2; ++k) dst[n][k] = *(const PG8_LAS bf16x8*)(lds + PG8_SB(b, h) + boff + n * 2048 + k * 1024); } while (0)
#define PG8_MMA(ai, bj, At, Bt) do { __builtin_amdgcn_s_setprio(1); _Pragma("unroll") for (int m = 0; m < 4; ++m) _Pragma("unroll") for (int n = 0; n < 2; ++n) _Pragma("unroll") for (int k = 0; k < 2; ++k) \
        acc[ai][bj][m][n] = __builtin_amdgcn_mfma_f32_16x16x32_bf16(Bt[n][k], At[m][k], acc[ai][bj][m][n], 0, 0, 0); __builtin_amdgcn_s_setprio(0); } while (0)
#define PG8_WAIT_V(n) asm volatile("s_waitcnt vmcnt(" #n ")" ::: "memory")
#define PG8_WAIT_L(n) asm volatile("s_waitcnt lgkmcnt(" #n ")" ::: "memory")
#define PG8_BAR __builtin_amdgcn_s_barrier()
#define PG8_SCHED __builtin_amdgcn_sched_barrier(0)
    Unit cur, nxt; int ui = 0;
    if (!S.next(0, cur)) return;
    f32x4 acc[2][2][4][2];
#pragma unroll
    for (int a = 0; a < 2; ++a)
#pragma unroll
        for (int b = 0; b < 2; ++b)
#pragma unroll
            for (int m = 0; m < 4; ++m)
#pragma unroll
                for (int n = 0; n < 2; ++n) acc[a][b][m][n] = (f32x4){0.f, 0.f, 0.f, 0.f};
    bf16x8 At[4][2], B0[2][2], B1[2][2];
    const char* cA = (const char*)g.A + (size_t)cur.pm * tstep; const char* cB = (const char*)g.Bt + (size_t)cur.pn * tstep;
    S.a_ready(cur);
    if constexpr (SP2) {
        PG8_STAGE(PG8_SB(0, 0), cB, voffB); PG8_STAGE(PG8_SB(0, 1), cB + hstep, voffB); PG8_STAGE(PG8_SA(0, 0), cA, voffA); PG8_STAGE(PG8_SA(0, 1), cA + hstep, voffA);
        if (wr == 1) PG8_BAR;
        PG8_WAIT_V(2); PG8_BAR;
        PG8_STAGE(PG8_SB(1, 0), cB + kstep, voffB); PG8_STAGE(PG8_SA(1, 0), cA + kstep, voffA); PG8_STAGE(PG8_SB(1, 1), cB + hstep + kstep, voffB);
        PG8_WAIT_V(6); PG8_BAR;
    } else {
        PG8_STAGE(PG8_SB(0, 0), cB, voffB); PG8_STAGE(PG8_SA(0, 0), cA, voffA); PG8_STAGE(PG8_SB(0, 1), cB + hstep, voffB); PG8_STAGE(PG8_SA(0, 1), cA + hstep, voffA);
        if (wr == 1) PG8_BAR;
        PG8_WAIT_V(4); PG8_BAR;
        PG8_STAGE(PG8_SB(1, 0), cB + kstep, voffB); PG8_STAGE(PG8_SA(1, 0), cA + kstep, voffA); PG8_STAGE(PG8_SB(1, 1), cB + hstep + kstep, voffB);
        PG8_WAIT_V(6); PG8_BAR;
    }
    for (;;) {
        const bool has_next = S.next(ui + 1, nxt);
        const char* nA = has_next ? (const char*)g.A + (size_t)nxt.pm * tstep : cA; const char* nB = has_next ? (const char*)g.Bt + (size_t)nxt.pn * tstep : cB;
        for (int t = 0; t < nt; t += 2) {
            const bool last = (t == nt - 2);
            const char* a1 = cA + (size_t)(t + 1) * kstep;
            const char* a2 = last ? nA : cA + (size_t)(t + 2) * kstep; const char* b2 = last ? nB : cB + (size_t)(t + 2) * kstep;
            const char* a3 = a2 + kstep; const char* b3 = b2 + kstep;
            if (last && has_next) S.a_ready(nxt);
            if constexpr (SP2) {
            PG8_LDB(B0, 0, 0); PG8_LDB(B1, 0, 1); PG8_SCHED; PG8_LDA(At, 0, 0); PG8_STAGE(PG8_SA(1, 1), a1 + hstep, voffA);
            PG8_WAIT_V(8); PG8_WAIT_L(0); PG8_BAR; PG8_MMA(0, 0, At, B0); PG8_MMA(0, 1, At, B1); PG8_BAR; PG8_SCHED;
            PG8_LDA(At, 0, 1); PG8_STAGE(PG8_SB(0, 0), b2, voffB); PG8_STAGE(PG8_SB(0, 1), b2 + hstep, voffB); PG8_STAGE(PG8_SA(0, 0), a2, voffA);
            PG8_WAIT_V(8); PG8_WAIT_L(0); PG8_BAR; PG8_MMA(1, 0, At, B0); PG8_MMA(1, 1, At, B1); PG8_BAR; PG8_SCHED;
            PG8_LDB(B0, 1, 0); PG8_LDB(B1, 1, 1); PG8_SCHED; PG8_LDA(At, 1, 0); PG8_STAGE(PG8_SA(0, 1), a2 + hstep, voffA);
            PG8_WAIT_V(8); PG8_WAIT_L(0); PG8_BAR; PG8_MMA(0, 0, At, B0); PG8_MMA(0, 1, At, B1); PG8_BAR; PG8_SCHED;
            PG8_LDA(At, 1, 1); PG8_STAGE(PG8_SB(1, 0), b3, voffB); PG8_STAGE(PG8_SB(1, 1), b3 + hstep, voffB); PG8_STAGE(PG8_SA(1, 0), a3, voffA);
            PG8_WAIT_V(8); PG8_WAIT_L(0); PG8_BAR; PG8_MMA(1, 0, At, B0); PG8_MMA(1, 1, At, B1); PG8_BAR; PG8_SCHED;
            } else {
            PG8_LDB(B0, 0, 0); PG8_SCHED; PG8_LDA(At, 0, 0); PG8_STAGE(PG8_SA(1, 1), a1 + hstep, voffA);
            PG8_WAIT_L(8); PG8_BAR; PG8_WAIT_L(0); PG8_MMA(0, 0, At, B0); PG8_BAR; PG8_SCHED;
            PG8_LDB(B1, 0, 1); PG8_STAGE(PG8_SB(0, 0), b2, voffB);
            PG8_BAR; PG8_WAIT_L(0); PG8_MMA(0, 1, At, B1); PG8_BAR;
            PG8_LDA(At, 0, 1); PG8_STAGE(PG8_SA(0, 0), a2, voffA);
            PG8_BAR; PG8_WAIT_L(0); PG8_MMA(1, 0, At, B0); PG8_BAR; PG8_SCHED;
            PG8_STAGE(PG8_SB(0, 1), b2 + hstep, voffB);
            PG8_WAIT_V(6); PG8_BAR; PG8_MMA(1, 1, At, B1); PG8_BAR;
            PG8_LDB(B0, 1, 0); PG8_SCHED; PG8_LDA(At, 1, 0); PG8_STAGE(PG8_SA(0, 1), a2 + hstep, voffA);
            PG8_WAIT_L(8); PG8_BAR; PG8_WAIT_L(0); PG8_MMA(0, 0, At, B0); PG8_BAR; PG8_SCHED;
            PG8_LDB(B1, 1, 1); PG8_STAGE(PG8_SB(1, 0), b3, voffB);
            PG8_BAR; PG8_WAIT_L(0); PG8_MMA(0, 1, At, B1); PG8_BAR;
            PG8_LDA(At, 1, 1); PG8_STAGE(PG8_SA(1, 0), a3, voffA);
            PG8_BAR; PG8_WAIT_L(0); PG8_MMA(1, 0, At, B0); PG8_BAR; PG8_SCHED;
            PG8_STAGE(PG8_SB(1, 1), b3 + hstep, voffB);
            PG8_WAIT_V(6); PG8_BAR; PG8_MMA(1, 1, At, B1); PG8_BAR;
            }
        }
        if constexpr (ALIGN_EPI) { if (wr == 0) PG8_BAR; }
        if constexpr (!Epi::AFTER_DRAIN) { E(acc, cur, wr, wc, fr, fq); S.done(cur); }
        if (!has_next) break;
#pragma unroll
        for (int a = 0; a < 2; ++a)
#pragma unroll
            for (int b = 0; b < 2; ++b)
#pragma unroll
                for (int m = 0; m < 4; ++m)
#pragma unroll
                    for (int n = 0; n < 2; ++n) acc[a][b][m][n] = (f32x4){0.f, 0.f, 0.f, 0.f};
        cur = nxt; cA = nA; cB = nB; ++ui;
        if constexpr (ALIGN_EPI) { if (wr == 1) PG8_BAR; }
    }
    PG8_WAIT_V(0);
    if constexpr (!ALIGN_EPI) { if (wr == 0) PG8_BAR; }
    PG8_BAR;
    if constexpr (Epi::AFTER_DRAIN) { E.fused(acc, cur, wr, wc, fr, fq, lds, wid, lane); S.done(cur); }
#undef PG8_SA
#undef PG8_SB
#undef PG8_STAGE
#undef PG8_LDA
#undef PG8_LDB
#undef PG8_MMA
#undef PG8_WAIT_V
#undef PG8_WAIT_L
#undef PG8_BAR
#undef PG8_SCHED
}
}

#ifndef PG8_SP2
#define PG8_SP2 true
#endif
#ifndef PG8_ALIGN
#define PG8_ALIGN true
#endif
constexpr int NWAVES = 8, NTHREADS = NWAVES * 64;
constexpr int BATCH = 2, SEQ = 4096, T = BATCH * SEQ, D = 2048;
constexpr int INW = 6160, NPROJ = 6144;
constexpr int GQ = 0, GK = 512, GV = 1024, GG = 2048, MQ = 3072, MK = 4096, MV = 5120;
constexpr int GA_SRC = 3072;
constexpr int NH = 8, NEXP = 16384, NMOD = 6 * D;
constexpr float EPS = 1e-6f;
#ifndef MK_N_LAUNCHES
#define MK_N_LAUNCHES 1
#endif
constexpr int N_PHASES = 12;

constexpr size_t MiB = 1u << 20;
constexpr size_t WS_CTL = 0, CTL_ZERO_BYTES = 1 * MiB;
constexpr size_t WS_WIN = 1 * MiB, WS_WGA = 25 * MiB, WS_WOUT = 26 * MiB, WS_WQ = 34 * MiB, WS_KEYS = 42 * MiB, WS_CS = 43 * MiB, WS_KMEAN = 44 * MiB, WS_DEC = 45 * MiB;
constexpr size_t WS_UB = 46 * MiB, WS_VB = 110 * MiB, WS_H = 174 * MiB, WS_CONCAT = 206 * MiB, WS_BCUM = 238 * MiB, WS_UT = 254 * MiB, WS_ST = 286 * MiB, WS_PROJ = 302 * MiB;
constexpr size_t WS_QP = WS_PROJ, WS_EXP = 366 * MiB, WS_GATE = 370 * MiB, WS_END = 398 * MiB;
constexpr int CW_BAR = 4096, CW_Q = 8192, CW_MOD = 16384;
static_assert((CW_MOD + 2 * BATCH * NMOD) * 4 <= (int)CTL_ZERO_BYTES, "CTL words inside the memset region");
constexpr size_t WS_MODF = 45 * MiB + 512 * 1024;

constexpr int RING_BYTES = 131072, MISC_OFF = RING_BYTES + 320, LDS_BYTES = 147456;

#define GAS __attribute__((address_space(1)))
#define LAS __attribute__((address_space(3)))
typedef unsigned short bf16;
typedef unsigned v4u __attribute__((ext_vector_type(4)));
typedef unsigned v2u __attribute__((ext_vector_type(2)));
typedef float f32x4 __attribute__((ext_vector_type(4)));
typedef float f32x2 __attribute__((ext_vector_type(2)));
typedef float f32x16 __attribute__((ext_vector_type(16)));
typedef short bf16x8 __attribute__((ext_vector_type(8)));
typedef short s16x4 __attribute__((ext_vector_type(4)));
typedef __bf16 bf16x2_t __attribute__((ext_vector_type(2)));
typedef GAS unsigned gu32;
#define LDS_WAIT() asm volatile("s_waitcnt lgkmcnt(0)" ::: "memory")
#define VM_WAIT() asm volatile("s_waitcnt vmcnt(0)" ::: "memory")
__device__ __forceinline__ unsigned pk2(float lo, float hi) { f32x2 v = {lo, hi}; bf16x2_t b = __builtin_convertvector(v, bf16x2_t); return __builtin_bit_cast(unsigned, b); }
__device__ __forceinline__ float bflo(unsigned u) { return __uint_as_float(u << 16); }
__device__ __forceinline__ float bfhi(unsigned u) { return __uint_as_float(u & 0xffff0000u); }
__device__ __forceinline__ float bf1(short s) { return __uint_as_float(((unsigned)(unsigned short)s) << 16); }
__device__ __forceinline__ bf16x8 pack8(float a0, float a1, float a2, float a3, float a4, float a5, float a6, float a7) { v4u w; w.x = pk2(a0, a1); w.y = pk2(a2, a3); w.z = pk2(a4, a5); w.w = pk2(a6, a7); return __builtin_bit_cast(bf16x8, w); }
__device__ __forceinline__ int crow(int r, int hi) { return (r & 3) + 8 * (r >> 2) + 4 * hi; }
__device__ __forceinline__ float wave_sum(float v) {
#pragma unroll
    for (int o = 1; o < 64; o <<= 1) v += __shfl_xor(v, o);
    return v;
}
typedef short v4i16_t __attribute__((ext_vector_type(4)));
__device__ __forceinline__ s16x4 vtr(const LAS unsigned char* p) { return __builtin_bit_cast(s16x4, __builtin_amdgcn_ds_read_tr16_b64_v4i16((LAS v4i16_t*)p)); }
__device__ __forceinline__ bf16x8 cat4(s16x4 lo, s16x4 hi) { return (bf16x8){lo[0], lo[1], lo[2], lo[3], hi[0], hi[1], hi[2], hi[3]}; }
#define MFMA32(a, b, c) __builtin_amdgcn_mfma_f32_32x32x16_bf16((a), (b), (c), 0, 0, 0)
#define XB_TMO      128
#define XB_XCNT(j)  (256  + 64 * (j))
#define XB_XSUB(j)  (1280 + 64 * (j))
#define XB_XGEN(j)  (2304 + 64 * (j))
#define XB_TOP      3328
#define XB_TOPGEN   3392
#define XCD_BAR_WORDS 3456
#define XB_SPIN_CAP (1u << 18)

__device__ __forceinline__ unsigned xb_ld(unsigned* p)              { return __hip_atomic_load(p, __ATOMIC_RELAXED, __HIP_MEMORY_SCOPE_AGENT); }
__device__ __forceinline__ unsigned xb_add(unsigned* p, unsigned v) { return __hip_atomic_fetch_add(p, v, __ATOMIC_RELAXED, __HIP_MEMORY_SCOPE_AGENT); }
__device__ __forceinline__ unsigned xb_xcc_id() { return (unsigned)__builtin_amdgcn_s_getreg((3 << 11) | 20) & 0xFu; }
#define XB_SPIN(cond, bar) do { unsigned _sp = 0; while (cond) { __builtin_amdgcn_s_sleep(1); \
    if ((++_sp & 255u) == 0u) { if (xb_ld(&(bar)[XB_TMO])) break; if (_sp > XB_SPIN_CAP) { atomicAdd(&(bar)[XB_TMO], 1u); break; } } } } while (0)

struct XcdBarrier {
    unsigned* bar; unsigned x;
    volatile LAS unsigned* st;
};

__device__ __forceinline__ XcdBarrier xcd_barrier_post(unsigned* bar, volatile LAS unsigned* st) {
    XcdBarrier b; b.bar = bar; b.x = xb_xcc_id(); b.st = st;
    if (threadIdx.x == 0) (void)xb_add(&bar[XB_XCNT(b.x)], 1u);
    return b;
}
__device__ __forceinline__ void xcd_barrier_complete(unsigned* bar, unsigned x, unsigned& nloc, unsigned& nx) {
    const unsigned G = gridDim.x * gridDim.y * gridDim.z;
    unsigned sum, cnt, mine, sp = 0u;
    for (;;) {
        sum = 0u; cnt = 0u; mine = 0u;
#pragma unroll
        for (unsigned j = 0; j < 16; ++j) { const unsigned c = xb_ld(&bar[XB_XCNT(j)]); sum += c; cnt += (c > 0u) ? 1u : 0u; mine = (j == x) ? c : mine; }
        if (sum == G) break;
        __builtin_amdgcn_s_sleep(1);
        if ((++sp & 255u) == 0u) { if (xb_ld(&bar[XB_TMO])) break; if (sp > XB_SPIN_CAP) { atomicAdd(&bar[XB_TMO], 1u); break; } }
    }
    nloc = mine > 0u ? mine : 1u; nx = cnt > 0u ? cnt : 1u;
}

__device__ __forceinline__ void xcd_barrier(const XcdBarrier& b) {
    asm volatile("s_waitcnt vmcnt(0)" ::: "memory");
    __syncthreads();
    if (threadIdx.x == 0) {
        unsigned* bar = b.bar;
        __builtin_amdgcn_s_waitcnt(0);
        unsigned nloc = b.st[0], nx = b.st[1];
        if (nloc == 0u) { xcd_barrier_complete(bar, b.x, nloc, nx); b.st[0] = nloc; b.st[1] = nx; }
        const unsigned old = xb_add(&bar[XB_XSUB(b.x)], 1u);
        const unsigned gen = old / nloc;
        if (old + 1u == (gen + 1u) * nloc) {
            __builtin_amdgcn_fence(__ATOMIC_RELEASE, "agent");
            asm volatile("s_waitcnt vmcnt(0)" ::: "memory");
            const unsigned og = xb_add(&bar[XB_TOP], 1u);
            const unsigned tg = og / nx;
            if (og + 1u == (tg + 1u) * nx) xb_add(&bar[XB_TOPGEN], 1u);
            else XB_SPIN(xb_ld(&bar[XB_TOPGEN]) == tg, bar);
            __builtin_amdgcn_fence(__ATOMIC_ACQUIRE, "agent");
            xb_add(&bar[XB_XGEN(b.x)], 1u);
            asm volatile("s_waitcnt vmcnt(0)" ::: "memory");
        } else {
            XB_SPIN(xb_ld(&bar[XB_XGEN(b.x)]) == gen, bar);
            __builtin_amdgcn_fence(__ATOMIC_ACQUIRE, "agent");
            asm volatile("s_waitcnt vmcnt(0)" ::: "memory");
        }
    }
    __syncthreads();
}

struct Ctx {
    LAS unsigned char* lds;
    int tid, lane, wave, vcu, G, gw, ngw;
    const float *x, *c; const int* pos; const float *w_ada, *b_ada, *g1, *w_in, *w_a2, *b_a, *gla_g, *qg, *kg, *w_out, *g2, *w_q, *keys, *pu, *pv;
    float* out;
    unsigned* ctl; long long* MODI; float* MOD;
    bf16 *WIN, *WGA, *WOUT, *WQ, *KEYSB, *UB, *VB, *H, *CONCAT, *PROJ, *ST;
    float *CS, *KMEAN, *DEC, *BCUM, *UT, *QP, *GATE; int* EXPI;
};

__device__ __forceinline__ void transpose_item(const float* W, int ldw, int K, bf16* WT, int dst_row0, int k0, int n0, LAS float* scr, int lane) {
#pragma unroll 8
    for (int i = 0; i < 32; ++i) { const int kk = 2 * i + (lane >> 5); scr[kk * 33 + (lane & 31)] = W[(size_t)(k0 + kk) * ldw + n0 + (lane & 31)]; }
    LDS_WAIT(); asm volatile("" ::: "memory");
    const int c = lane & 7;
#pragma unroll
    for (int j = 0; j < 4; ++j) { const int n = (lane >> 3) + 8 * j; const LAS float* s = scr + (8 * c) * 33 + n;
        v4u o; o.x = pk2(s[0 * 33], s[1 * 33]); o.y = pk2(s[2 * 33], s[3 * 33]); o.z = pk2(s[4 * 33], s[5 * 33]); o.w = pk2(s[6 * 33], s[7 * 33]);
        *(v4u*)(WT + (size_t)(dst_row0 + n) * K + k0 + 8 * c) = o; }
    LDS_WAIT(); asm volatile("" ::: "memory");
}
__device__ __forceinline__ void convert_item(const float* src, bf16* dst, size_t item, int lane) {
    const f32x4* s = (const f32x4*)(src + item * 8192) + 2 * lane; v4u* d = (v4u*)(dst + item * 8192) + lane;
#pragma unroll 4
    for (int it = 0; it < 16; ++it) { const f32x4 a = s[it * 128], b = s[it * 128 + 1]; v4u o; o.x = pk2(a.x, a.y); o.y = pk2(a.z, a.w); o.z = pk2(b.x, b.y); o.w = pk2(b.z, b.w); d[it * 64] = o; }
}
__device__ __forceinline__ void p0_phase(const Ctx& C) {
    const int lane = C.lane, gw = C.gw, ngw = C.ngw;
    LAS float* sc = (LAS float*)C.lds;
    for (int i = C.tid; i < BATCH * D; i += NTHREADS) { const float v = C.c[i]; sc[i] = v / (1.f + __expf(-v)); }
    __syncthreads();
    for (int it = gw; it < 192 * 8; it += ngw) {
        const int cc = it % 192, ks = it / 192, col = cc * 64 + lane;
        const float* w = C.w_ada + (size_t)(ks * 256) * NMOD + col; const LAS float* s0 = sc + ks * 256; const LAS float* s1 = sc + D + ks * 256;
        float a0 = 0.f, a1 = 0.f;
#pragma unroll 16
        for (int k = 0; k < 256; ++k) { const float wv = w[(size_t)k * NMOD]; a0 += s0[k] * wv; a1 += s1[k] * wv; }
        atomicAdd((unsigned long long*)(C.MODI + col), (unsigned long long)__double2ll_rn((double)a0 * 1099511627776.0)); atomicAdd((unsigned long long*)(C.MODI + NMOD + col), (unsigned long long)__double2ll_rn((double)a1 * 1099511627776.0));
    }
    __syncthreads();
    LAS float* scr = (LAS float*)(C.lds + C.wave * 16384);
    constexpr int I_IN = 32 * 192, I_SQ = 32 * 64;
    for (int it = gw; it < I_IN + 2 * I_SQ; it += ngw) {
        int r = it;
        if (r < I_IN) { const int kb = r / 192, nb = r % 192, n0 = 32 * nb; transpose_item(C.w_in, INW, D, C.WIN, n0, 64 * kb, n0 < 3072 ? n0 : n0 + 16, scr, lane); continue; } r -= I_IN;
        if (r < I_SQ) { transpose_item(C.w_out, D, D, C.WOUT, 32 * (r % 64), 64 * (r / 64), 32 * (r % 64), scr, lane); continue; } r -= I_SQ;
        transpose_item(C.w_q, D, D, C.WQ, 32 * (r % 64), 64 * (r / 64), 32 * (r % 64), scr, lane);
    }
    for (int it = gw; it < 32; it += ngw) { const int k = it * 64 + lane; const f32x4* s = (const f32x4*)(C.w_in + (size_t)k * INW + GA_SRC);
#pragma unroll
        for (int q = 0; q < 4; ++q) { const f32x4 v = s[q]; C.WGA[(4 * q + 0) * D + k] = (bf16)(pk2(v.x, 0.f) & 0xffff); C.WGA[(4 * q + 1) * D + k] = (bf16)(pk2(v.y, 0.f) & 0xffff);
            C.WGA[(4 * q + 2) * D + k] = (bf16)(pk2(v.z, 0.f) & 0xffff); C.WGA[(4 * q + 3) * D + k] = (bf16)(pk2(v.w, 0.f) & 0xffff); } }
    for (int it = gw; it < 4096 * 2 + 32; it += ngw) {
        if (it < 4096) convert_item(C.pu, C.UB, it, lane);
        else if (it < 8192) convert_item(C.pv, C.VB, it - 4096, lane);
        else convert_item(C.keys, C.KEYSB, it - 8192, lane);
    }
    for (int idx = C.vcu * NTHREADS + C.tid; idx < T * 16; idx += C.G * NTHREADS) {
        const int t = idx >> 4, f = idx & 15; const float inv = powf(500000.0f, -(float)f * 0.0625f); const float ang = (float)C.pos[t] * inv;
        C.CS[2 * idx] = cosf(ang); C.CS[2 * idx + 1] = sinf(ang);
    }
}

template <bool FIRST> __device__ __forceinline__ void norm_mod_phase(const Ctx& C, const float* X, const float* g, int shift_off, int scale_off, bf16* O) {
    if (FIRST) { for (int i = C.vcu * NTHREADS + C.tid; i < BATCH * NMOD; i += C.G * NTHREADS) C.MOD[i] = (float)((double)C.MODI[i] * (1.0 / 1099511627776.0)) + C.b_ada[i % NMOD]; }
    for (int m = C.gw; m < T; m += C.ngw) {
        const int b = m / SEQ; const f32x4* xr = (const f32x4*)(X + (size_t)m * D) + C.lane;
        f32x4 v[8]; float ss = 0.f;
#pragma unroll
        for (int j = 0; j < 8; ++j) { v[j] = xr[64 * j]; ss += (v[j].x * v[j].x + v[j].y * v[j].y) + (v[j].z * v[j].z + v[j].w * v[j].w); }
        const float rstd = rsqrtf(wave_sum(ss) * (1.f / D) + EPS);
        const f32x4* g4 = (const f32x4*)g + C.lane; v2u* o8 = (v2u*)(O + (size_t)m * D) + C.lane;
#pragma unroll
        for (int j = 0; j < 8; ++j) {
            f32x4 sh, sl;
            if (FIRST) { const long long* ph = C.MODI + b * NMOD + shift_off + 4 * (C.lane + 64 * j); const long long* pl = C.MODI + b * NMOD + scale_off + 4 * (C.lane + 64 * j);
                const f32x4 bh = ((const f32x4*)(C.b_ada + shift_off))[C.lane + 64 * j], bl = ((const f32x4*)(C.b_ada + scale_off))[C.lane + 64 * j];
                sh = (f32x4){(float)((double)ph[0] * (1.0 / 1099511627776.0)), (float)((double)ph[1] * (1.0 / 1099511627776.0)), (float)((double)ph[2] * (1.0 / 1099511627776.0)), (float)((double)ph[3] * (1.0 / 1099511627776.0))} + bh;
                sl = (f32x4){(float)((double)pl[0] * (1.0 / 1099511627776.0)), (float)((double)pl[1] * (1.0 / 1099511627776.0)), (float)((double)pl[2] * (1.0 / 1099511627776.0)), (float)((double)pl[3] * (1.0 / 1099511627776.0))} + bl; }
            else { sh = ((const f32x4*)(C.MOD + b * NMOD + shift_off))[C.lane + 64 * j]; sl = ((const f32x4*)(C.MOD + b * NMOD + scale_off))[C.lane + 64 * j]; }
            const f32x4 y = v[j] * rstd * g4[64 * j] * (1.f + sl) + sh; v2u w; w.x = pk2(y.x, y.y); w.y = pk2(y.z, y.w); o8[64 * j] = w; }
    }
}

__device__ __forceinline__ void gla_prep_item(const Ctx& C, int b, int n) {
    const int lane = C.lane, w = C.wave, fr = lane & 15, fq = lane >> 4, rt = w & 3, kh = w >> 2; const size_t t0 = (size_t)b * SEQ + 64 * n;
    const bf16* ap = C.H + (t0 + 16 * rt + fr) * D + kh * 1024 + 8 * fq; const bf16* bp = C.WGA + fr * D + kh * 1024 + 8 * fq;
    f32x4 acc = {0.f, 0.f, 0.f, 0.f};
#pragma unroll 8
    for (int s = 0; s < 32; ++s) acc = __builtin_amdgcn_mfma_f32_16x16x32_bf16(*(const bf16x8*)(ap + 32 * s), *(const bf16x8*)(bp + 32 * s), acc, 0, 0, 0);
    LAS float* gaP = (LAS float*)C.lds;
#pragma unroll
    for (int r = 0; r < 4; ++r) gaP[kh * 1024 + (16 * rt + 4 * fq + r) * 16 + fr] = acc[r];
    __syncthreads();
    const int t = C.tid; float wc[16];
#pragma unroll
    for (int r = 0; r < 16; ++r) wc[r] = C.w_a2[r * 512 + t];
    const float ba = C.b_a[t]; float cum = 0.f; float* bo = C.BCUM + t0 * 512 + t;
#pragma unroll 4
    for (int tok = 0; tok < 64; ++tok) {
        const LAS f32x4* g0 = (const LAS f32x4*)(gaP + tok * 16); const LAS f32x4* g1 = (const LAS f32x4*)(gaP + 1024 + tok * 16); float z = ba;
#pragma unroll
        for (int q = 0; q < 4; ++q) { const f32x4 gv = g0[q] + g1[q]; z += gv.x * wc[4 * q] + gv.y * wc[4 * q + 1] + gv.z * wc[4 * q + 2] + gv.w * wc[4 * q + 3]; }
        cum += (fminf(z, 0.f) - log1pf(__expf(-fabsf(z)))) * 0.0625f;
        bo[(size_t)tok * 512] = cum;
    }
    __syncthreads();
}
__device__ __forceinline__ void moba_prep_item(const Ctx& C, int b, int h, int blk) {
    const int lane = C.lane, w = C.wave, i = lane & 15, tg = lane >> 4; const size_t t0 = (size_t)b * SEQ + 256 * blk;
    float qg[8], kg[8], km[8];
#pragma unroll
    for (int j = 0; j < 8; ++j) { qg[j] = C.qg[8 * i + j]; kg[j] = C.kg[8 * i + j]; km[j] = 0.f; }
    for (int it = 0; it < 8; ++it) {
        const size_t tok = t0 + 32 * w + 4 * it + tg;
        float cs[16];
        if (i < 4) { const f32x4* cp = (const f32x4*)(C.CS + tok * 32 + (i & 1) * 16);
#pragma unroll
            for (int q = 0; q < 4; ++q) { const f32x4 v = cp[q]; cs[4 * q] = v.x; cs[4 * q + 1] = v.y; cs[4 * q + 2] = v.z; cs[4 * q + 3] = v.w; } }
        else {
#pragma unroll
            for (int q = 0; q < 16; ++q) cs[q] = 0.f; }
#pragma unroll
        for (int which = 0; which < 2; ++which) {
            bf16* p = C.PROJ + tok * NPROJ + (which ? MK : MQ) + h * 128 + 8 * i;
            const v4u raw = *(const v4u*)p; float xv[8];
            xv[0] = bflo(raw.x); xv[1] = bfhi(raw.x); xv[2] = bflo(raw.y); xv[3] = bfhi(raw.y); xv[4] = bflo(raw.z); xv[5] = bfhi(raw.z); xv[6] = bflo(raw.w); xv[7] = bfhi(raw.w);
            float ss = 0.f;
#pragma unroll
            for (int j = 0; j < 8; ++j) ss += xv[j] * xv[j];
            ss += __shfl_xor(ss, 1); ss += __shfl_xor(ss, 2); ss += __shfl_xor(ss, 4); ss += __shfl_xor(ss, 8);
            const float rstd = rsqrtf(ss * (1.f / 128.f) + EPS);
#pragma unroll
            for (int j = 0; j < 8; ++j) xv[j] = xv[j] * rstd * (which ? kg[j] : qg[j]);
#pragma unroll
            for (int j = 0; j < 8; ++j) { const float o = __shfl_xor(xv[j], 2); const float cv = cs[2 * j], sv = cs[2 * j + 1];
                if (i < 2) xv[j] = xv[j] * cv - o * sv; else if (i < 4) xv[j] = xv[j] * cv + o * sv; }
            v4u o; o.x = pk2(xv[0], xv[1]); o.y = pk2(xv[2], xv[3]); o.z = pk2(xv[4], xv[5]); o.w = pk2(xv[6], xv[7]);
            *(v4u*)p = o;
            if (which) {
#pragma unroll
                for (int j = 0; j < 8; ++j) km[j] += xv[j]; }
        }
    }
    LAS float* red = (LAS float*)C.lds;
#pragma unroll
    for (int j = 0; j < 8; ++j) { km[j] += __shfl_xor(km[j], 16); km[j] += __shfl_xor(km[j], 32); }
    if (lane < 16) {
#pragma unroll
        for (int j = 0; j < 8; ++j) red[w * 128 + 8 * i + j] = km[j]; }
    __syncthreads();
    if (C.tid < 128) { float s = 0.f;
#pragma unroll
        for (int ww = 0; ww < 8; ++ww) s += red[ww * 128 + C.tid];
        C.KMEAN[((size_t)(b * NH + h) * 16 + blk) * 128 + C.tid] = s * (1.f / 256.f); }
    __syncthreads();
}

constexpr int KP = 272, VP = 320;
constexpr int MB_K0 = 0, MB_V0 = 2 * 64 * KP, MB_END = MB_V0 + 2 * 64 * VP;
__device__ __forceinline__ void moba_unit(const Ctx& C, int b, int h, int qb) {
    const int tid = C.tid, lane = C.lane, w = C.wave, r = lane & 31, hh = lane >> 5;
    const size_t tb = (size_t)b * SEQ; const int q0 = qb * 256;
    const bf16* Qh = C.PROJ + MQ + h * 128; const bf16* Kh = C.PROJ + MK + h * 128; const bf16* Vh = C.PROJ + MV + h * 128;
    bf16x8 qf[8];
    { const bf16* qrow = Qh + (tb + q0 + 32 * w + r) * NPROJ + 8 * hh;
#pragma unroll
      for (int s = 0; s < 8; ++s) qf[s] = *(const bf16x8*)(qrow + 16 * s); }
    unsigned selmask = 0u;
    { float g0 = -INFINITY, g1 = -INFINITY, g2 = -INFINITY; int i0 = -1, i1 = -1, i2 = -1;
      const float* km = C.KMEAN + ((size_t)(b * NH + h) * 16) * 128 + 8 * hh;
      for (int j = 0; j < qb; ++j) {
          float acc = 0.f;
#pragma unroll
          for (int s = 0; s < 8; ++s) { const f32x4 k0 = *(const f32x4*)(km + j * 128 + 16 * s), k1 = *(const f32x4*)(km + j * 128 + 16 * s + 4);
              acc += bf1(qf[s][0]) * k0.x + bf1(qf[s][1]) * k0.y + bf1(qf[s][2]) * k0.z + bf1(qf[s][3]) * k0.w + bf1(qf[s][4]) * k1.x + bf1(qf[s][5]) * k1.y + bf1(qf[s][6]) * k1.z + bf1(qf[s][7]) * k1.w; }
          acc += __shfl_xor(acc, 32);
          if (acc > g0) { g2 = g1; i2 = i1; g1 = g0; i1 = i0; g0 = acc; i0 = j; }
          else if (acc > g1) { g2 = g1; i2 = i1; g1 = acc; i1 = j; }
          else if (acc > g2) { g2 = acc; i2 = j; }
      }
      if (i0 >= 0) selmask |= 1u << i0; if (i1 >= 0) selmask |= 1u << i1; if (i2 >= 0) selmask |= 1u << i2; }
    const int NT = 4 * (qb + 1);
    v4u kr[2], vr[2];
#define MB_LOAD(i) do { const int blk_ = (i) < 4 ? qb : ((i) - 4) >> 2; const size_t ks_ = tb + blk_ * 256 + 64 * ((i) & 3); _Pragma("unroll") for (int pp = 0; pp < 2; ++pp) { const int p_ = tid + 512 * pp; \
        kr[pp] = *(const v4u*)(Kh + (ks_ + (p_ >> 4)) * NPROJ + 8 * (p_ & 15)); vr[pp] = *(const v4u*)(Vh + (ks_ + (p_ >> 4)) * NPROJ + 8 * (p_ & 15)); } } while (0)
#define MB_STORE(buf) do { _Pragma("unroll") for (int pp = 0; pp < 2; ++pp) { const int p_ = tid + 512 * pp; \
        *(LAS v4u*)(C.lds + MB_K0 + (buf) * 64 * KP + (p_ >> 4) * KP + 16 * (p_ & 15)) = kr[pp]; *(LAS v4u*)(C.lds + MB_V0 + (buf) * 64 * VP + (p_ >> 4) * VP + 16 * (p_ & 15)) = vr[pp]; } } while (0)
    MB_LOAD(0); MB_STORE(0); __syncthreads();
    float m_run = -1e30f, l_run = 0.f; f32x16 o[4];
#pragma unroll
    for (int dt = 0; dt < 4; ++dt)
#pragma unroll
        for (int q = 0; q < 16; ++q) o[dt][q] = 0.f;
    const float c2 = 0.08838834764831845f * 1.4426950408889634f;
    for (int i = 0; i < NT; ++i) {
        if (i + 1 < NT) MB_LOAD(i + 1);
        const int buf = i & 1; const bool own = i < 4; const int tt = i & 3, blk = own ? qb : (i - 4) >> 2;
        const bool mine = own || ((selmask >> blk) & 1u);
        const bool need = own ? (64 * tt <= 32 * w + 31) : (__ballot(mine) != 0ull);
        if (need) {
            const LAS unsigned char* kb = C.lds + MB_K0 + buf * 64 * KP + r * KP + 16 * hh;
            f32x16 p0, p1;
#pragma unroll
            for (int q = 0; q < 16; ++q) { p0[q] = 0.f; p1[q] = 0.f; }
#pragma unroll
            for (int s = 0; s < 8; ++s) { const bf16x8 a0 = *(const LAS bf16x8*)(kb + 32 * s), a1 = *(const LAS bf16x8*)(kb + 32 * KP + 32 * s);
                p0 = MFMA32(a0, qf[s], p0); p1 = MFMA32(a1, qf[s], p1); }
            if (own) { const int qi = 32 * w + r;
#pragma unroll
                for (int q = 0; q < 16; ++q) { const int kk = 64 * tt + crow(q, hh); if (kk > qi) p0[q] = -INFINITY; if (kk + 32 > qi) p1[q] = -INFINITY; } }
            else if (!mine) {
#pragma unroll
                for (int q = 0; q < 16; ++q) { p0[q] = -INFINITY; p1[q] = -INFINITY; } }
            float mx = fmaxf(p0[0], p1[0]);
#pragma unroll
            for (int q = 1; q < 16; ++q) mx = fmaxf(mx, fmaxf(p0[q], p1[q]));
            mx = fmaxf(mx, __shfl_xor(mx, 32));
            const float m_new = fmaxf(m_run, mx * c2), alpha = __builtin_amdgcn_exp2f(m_run - m_new);
            m_run = m_new; float rs = 0.f;
#pragma unroll
            for (int q = 0; q < 16; ++q) { p0[q] = __builtin_amdgcn_exp2f(p0[q] * c2 - m_new); p1[q] = __builtin_amdgcn_exp2f(p1[q] * c2 - m_new); rs += p0[q] + p1[q]; }
            l_run = l_run * alpha + rs;
#pragma unroll
            for (int dt = 0; dt < 4; ++dt)
#pragma unroll
                for (int q = 0; q < 16; ++q) o[dt][q] *= alpha;
            bf16x8 pf[4];
            pf[0] = pack8(p0[0], p0[1], p0[2], p0[3], p0[4], p0[5], p0[6], p0[7]); pf[1] = pack8(p0[8], p0[9], p0[10], p0[11], p0[12], p0[13], p0[14], p0[15]);
            pf[2] = pack8(p1[0], p1[1], p1[2], p1[3], p1[4], p1[5], p1[6], p1[7]); pf[3] = pack8(p1[8], p1[9], p1[10], p1[11], p1[12], p1[13], p1[14], p1[15]);
            const LAS unsigned char* vb = C.lds + MB_V0 + buf * 64 * VP + (4 * hh + ((lane & 15) >> 2)) * VP + (16 * ((lane >> 4) & 1) + 4 * (lane & 3)) * 2;
#pragma unroll
            for (int kk = 0; kk < 4; ++kk)
#pragma unroll
                for (int dt = 0; dt < 4; ++dt) { const s16x4 lo = vtr(vb + (16 * kk) * VP + dt * 64), hi = vtr(vb + (16 * kk + 8) * VP + dt * 64); o[dt] = MFMA32(cat4(lo, hi), pf[kk], o[dt]); }
        }
        if (i + 1 < NT) MB_STORE((i + 1) & 1);
        __syncthreads();
    }
#undef MB_LOAD
#undef MB_STORE
    l_run += __shfl_xor(l_run, 32);
    const float inv = 1.f / l_run;
    bf16* op = C.CONCAT + (tb + q0 + 32 * w + r) * D + 1024 + h * 128 + 4 * hh;
#pragma unroll
    for (int dt = 0; dt < 4; ++dt)
#pragma unroll
        for (int k4 = 0; k4 < 4; ++k4) { v2u wv; wv.x = pk2(o[dt][4 * k4] * inv, o[dt][4 * k4 + 1] * inv); wv.y = pk2(o[dt][4 * k4 + 2] * inv, o[dt][4 * k4 + 3] * inv); *(v2u*)(op + 32 * dt + 8 * k4) = wv; }
}

constexpr int GKP = 192;
__device__ __forceinline__ void gla_v_to_lds(const Ctx& C, size_t t0, int h, int off) {
#pragma unroll
    for (int pp = 0; pp < 2; ++pp) { const int p = C.tid + 512 * pp; const v4u v = *(const v4u*)(C.PROJ + (t0 + (p >> 4)) * NPROJ + GV + h * 128 + 8 * (p & 15)); *(LAS v4u*)(C.lds + off + (p >> 4) * VP + 16 * (p & 15)) = v; }
}
__device__ __forceinline__ void gla_u_item(const Ctx& C, int b, int h, int n) {
    const int tid = C.tid, lane = C.lane, w = C.wave, r = lane & 31, hh = lane >> 5; const size_t t0 = (size_t)b * SEQ + 64 * n; const int bhn = (b * NH + h) * 64 + n;
    constexpr int KT = 0, VT = 64 * GKP;
    { const int tok = tid >> 3, ch = tid & 7;
      const v4u raw = *(const v4u*)(C.PROJ + (t0 + tok) * NPROJ + GK + h * 64 + 8 * ch);
      const f32x4* bp = (const f32x4*)(C.BCUM + (t0 + tok) * 512 + h * 64 + 8 * ch); const f32x4* bl = (const f32x4*)(C.BCUM + (t0 + 63) * 512 + h * 64 + 8 * ch);
      const f32x4 b0 = bp[0], b1 = bp[1], l0 = bl[0], l1 = bl[1];
      const bf16x8 kv = pack8(bflo(raw.x) * __expf(l0.x - b0.x), bfhi(raw.x) * __expf(l0.y - b0.y), bflo(raw.y) * __expf(l0.z - b0.z), bfhi(raw.y) * __expf(l0.w - b0.w),
                              bflo(raw.z) * __expf(l1.x - b1.x), bfhi(raw.z) * __expf(l1.y - b1.y), bflo(raw.w) * __expf(l1.z - b1.z), bfhi(raw.w) * __expf(l1.w - b1.w));
      *(LAS bf16x8*)(C.lds + KT + tok * GKP + 16 * ch) = kv;
      if (tok == 63) { f32x4* dp = (f32x4*)(C.DEC + (size_t)bhn * 64 + 8 * ch); dp[0] = (f32x4){__expf(l0.x), __expf(l0.y), __expf(l0.z), __expf(l0.w)}; dp[1] = (f32x4){__expf(l1.x), __expf(l1.y), __expf(l1.z), __expf(l1.w)}; } }
    gla_v_to_lds(C, t0, h, VT);
    __syncthreads();
    const int mt = w & 3, nt = w >> 2, q = (lane & 15) >> 2, cb = (16 * ((lane >> 4) & 1) + 4 * (lane & 3)) * 2;
    const LAS unsigned char* va = C.lds + VT + (4 * hh + q) * VP + cb + mt * 64; const LAS unsigned char* ka = C.lds + KT + (4 * hh + q) * GKP + cb + nt * 64;
    f32x16 acc;
#pragma unroll
    for (int i = 0; i < 16; ++i) acc[i] = 0.f;
#pragma unroll
    for (int s = 0; s < 4; ++s) acc = MFMA32(cat4(vtr(va + 16 * s * VP), vtr(va + (16 * s + 8) * VP)), cat4(vtr(ka + 16 * s * GKP), vtr(ka + (16 * s + 8) * GKP)), acc);
    float* up = C.UT + (size_t)bhn * 8192 + (32 * mt) * 64 + 32 * nt + r;
#pragma unroll
    for (int i = 0; i < 16; ++i) up[crow(i, hh) * 64] = acc[i];
    __syncthreads();
}
__device__ __forceinline__ void p4_phase(const Ctx& C) {
    volatile LAS int* qslot = (volatile LAS int*)(C.lds + MISC_OFF + 64);
    for (;;) {
        __syncthreads();
        if (C.tid == 0) *qslot = (int)atomicAdd(C.ctl + CW_Q, 1u);
        __syncthreads();
        const int id = *qslot;
        if (id >= 256 + 1024) break;
        if (id < 256) moba_unit(C, (id & 15) >> 3, id & 7, 15 - (id >> 4));
        else { const int g = id - 256; gla_u_item(C, g >> 9, (g >> 6) & 7, g & 63); }
    }
}

__device__ __forceinline__ void p5_phase(const Ctx& C) {
    for (int idx = C.vcu * NTHREADS + C.tid; idx < 16 * 8192; idx += C.G * NTHREADS) {
        const int bh = idx >> 13, rem = idx & 8191, dk = rem & 63; float s = 0.f;
        const float* up = C.UT + (size_t)bh * 64 * 8192 + rem; const float* dp = C.DEC + (size_t)bh * 64 * 64 + dk; bf16* sp = C.ST + (size_t)bh * 64 * 8192 + rem;
#pragma unroll 16
        for (int n = 0; n < 64; ++n) { sp[(size_t)n * 8192] = (bf16)(pk2(s, 0.f) & 0xffffu); s = dp[n * 64] * s + up[(size_t)n * 8192]; }
    }
}

__device__ __forceinline__ void gla_out_item(const Ctx& C, int b, int h, int n) {
    const int lane = C.lane, w = C.wave, r = lane & 31, hh = lane >> 5, dvt = w & 3, lt = w >> 2; const size_t t0 = (size_t)b * SEQ + 64 * n; const int bhn = (b * NH + h) * 64 + n;
    constexpr int VT = 0, RED = 64 * VP;
    gla_v_to_lds(C, t0, h, VT);
    bf16x8 qd[4];
    { const size_t tl = t0 + 32 * lt + r;
#pragma unroll
      for (int s = 0; s < 4; ++s) { const v4u raw = *(const v4u*)(C.PROJ + tl * NPROJ + GQ + h * 64 + 16 * s + 8 * hh); const f32x4* bp = (const f32x4*)(C.BCUM + tl * 512 + h * 64 + 16 * s + 8 * hh); const f32x4 b0 = bp[0], b1 = bp[1];
          qd[s] = pack8(bflo(raw.x) * 0.125f * __expf(b0.x), bfhi(raw.x) * 0.125f * __expf(b0.y), bflo(raw.y) * 0.125f * __expf(b0.z), bfhi(raw.y) * 0.125f * __expf(b0.w),
                        bflo(raw.z) * 0.125f * __expf(b1.x), bfhi(raw.z) * 0.125f * __expf(b1.y), bflo(raw.w) * 0.125f * __expf(b1.z), bfhi(raw.w) * 0.125f * __expf(b1.w)); } }
    __syncthreads();
    f32x16 o;
#pragma unroll
    for (int i = 0; i < 16; ++i) o[i] = 0.f;
    const LAS unsigned char* va = C.lds + VT + (4 * hh + ((lane & 15) >> 2)) * VP + (16 * ((lane >> 4) & 1) + 4 * (lane & 3)) * 2 + dvt * 64;
    for (int mt = 0; mt <= lt; ++mt) {
        const size_t tm = t0 + 32 * mt + r; f32x16 X;
#pragma unroll
        for (int i = 0; i < 16; ++i) X[i] = 0.f;
#pragma unroll
        for (int s = 0; s < 4; ++s) { const v4u raw = *(const v4u*)(C.PROJ + tm * NPROJ + GK + h * 64 + 16 * s + 8 * hh); const f32x4* bp = (const f32x4*)(C.BCUM + tm * 512 + h * 64 + 16 * s + 8 * hh); const f32x4 b0 = bp[0], b1 = bp[1];
            const bf16x8 kd = pack8(bflo(raw.x) * __expf(-b0.x), bfhi(raw.x) * __expf(-b0.y), bflo(raw.y) * __expf(-b0.z), bfhi(raw.y) * __expf(-b0.w),
                                    bflo(raw.z) * __expf(-b1.x), bfhi(raw.z) * __expf(-b1.y), bflo(raw.w) * __expf(-b1.z), bfhi(raw.w) * __expf(-b1.w));
            X = MFMA32(kd, qd[s], X); }
        if (mt == lt) {
#pragma unroll
            for (int i = 0; i < 16; ++i) if (crow(i, hh) > r) X[i] = 0.f; }
        const bf16x8 pf0 = pack8(X[0], X[1], X[2], X[3], X[4], X[5], X[6], X[7]), pf1 = pack8(X[8], X[9], X[10], X[11], X[12], X[13], X[14], X[15]);
        o = MFMA32(cat4(vtr(va + (32 * mt) * VP), vtr(va + (32 * mt + 8) * VP)), pf0, o);
        o = MFMA32(cat4(vtr(va + (32 * mt + 16) * VP), vtr(va + (32 * mt + 24) * VP)), pf1, o);
    }
    { const bf16* sp = C.ST + (size_t)bhn * 8192 + (32 * dvt + r) * 64 + 8 * hh;
#pragma unroll
      for (int s = 0; s < 4; ++s) o = MFMA32(*(const bf16x8*)(sp + 16 * s), qd[s], o); }
    float ss = 0.f;
#pragma unroll
    for (int i = 0; i < 16; ++i) ss += o[i] * o[i];
    ss += __shfl_xor(ss, 32);
    LAS float* red = (LAS float*)(C.lds + RED);
    if (hh == 0) red[dvt * 64 + 32 * lt + r] = ss;
    __syncthreads();
    const int l = 32 * lt + r; const float rstd = rsqrtf((red[l] + red[64 + l] + red[128 + l] + red[192 + l]) * (1.f / 128.f) + EPS);
    const size_t tl = t0 + l;
#pragma unroll
    for (int k4 = 0; k4 < 4; ++k4) { const int d0 = 32 * dvt + 8 * k4 + 4 * hh;
        const v2u graw = *(const v2u*)(C.PROJ + tl * NPROJ + GG + h * 128 + d0); const f32x4 gn = *(const f32x4*)(C.gla_g + d0);
        const float ga = bflo(graw.x), gb = bfhi(graw.x), gc = bflo(graw.y), gd = bfhi(graw.y);
        const float y0 = o[4 * k4] * rstd * gn.x * (ga / (1.f + __expf(-ga))), y1 = o[4 * k4 + 1] * rstd * gn.y * (gb / (1.f + __expf(-gb)));
        const float y2 = o[4 * k4 + 2] * rstd * gn.z * (gc / (1.f + __expf(-gc))), y3 = o[4 * k4 + 3] * rstd * gn.w * (gd / (1.f + __expf(-gd)));
        v2u wv; wv.x = pk2(y0, y1); wv.y = pk2(y2, y3); *(v2u*)(C.CONCAT + tl * D + h * 128 + d0) = wv; }
    __syncthreads();
}

#define INS16(L, xin) do { int x_ = (xin); _Pragma("unroll") for (int i_ = 0; i_ < 16; ++i_) { const int hi_ = max(L[i_], x_); x_ = min(L[i_], x_); L[i_] = hi_; } } while (0)
__device__ __forceinline__ int ord_key(float v) { int u = __float_as_int(v); return u ^ ((u >> 31) & 0x7fffffff); }
__device__ __forceinline__ float ord_val(int k, int mask) { int u = k & ~mask; return __int_as_float(u ^ ((u >> 31) & 0x7fffffff)); }
__device__ __forceinline__ void peer_topk_item(const Ctx& C, int tg, int hd) {
    const int lane = C.lane, r = lane & 31, hh = lane >> 5; const size_t tok = (size_t)tg * 32 + r;
    int La[16], Lb[16];
#pragma unroll
    for (int c = 0; c < 2; ++c) {
        int L[16];
#pragma unroll
        for (int i = 0; i < 16; ++i) L[i] = (int)0x80000000;
        bf16x8 qf[8];
        { const float* qp = C.QP + tok * D + hd * 256 + c * 128 + 8 * hh;
#pragma unroll
          for (int s = 0; s < 8; ++s) { const f32x4 a = *(const f32x4*)(qp + 16 * s), bq = *(const f32x4*)(qp + 16 * s + 4); qf[s] = pack8(a.x, a.y, a.z, a.w, bq.x, bq.y, bq.z, bq.w); } }
#pragma unroll 1
        for (int kt = 0; kt < 4; ++kt) {
            const bf16* kp = C.KEYSB + ((size_t)(hd * 2 + c) * 128 + 32 * kt + r) * 128 + 8 * hh; f32x16 X;
#pragma unroll
            for (int i = 0; i < 16; ++i) X[i] = 0.f;
#pragma unroll
            for (int s = 0; s < 8; ++s) X = MFMA32(*(const bf16x8*)(kp + 16 * s), qf[s], X);
#pragma unroll
            for (int i = 0; i < 16; ++i) INS16(L, (ord_key(X[i]) & ~127) | (32 * kt + crow(i, hh)));
        }
        int M[16];
#pragma unroll
        for (int i = 0; i < 16; ++i) M[i] = __shfl_xor(L[i], 32);
#pragma unroll
        for (int i = 0; i < 16; ++i) INS16(L, M[i]);
#pragma unroll
        for (int i = 0; i < 16; ++i) { if (c == 0) La[i] = L[i]; else Lb[i] = L[i]; }
    }
    float sa[16], sb[16]; int Lc[16];
#pragma unroll
    for (int i = 0; i < 16; ++i) { sa[i] = ord_val(La[i], 127); sb[i] = ord_val(Lb[i], 127); Lc[i] = (int)0x80000000; }
#pragma unroll
    for (int i = 0; i < 16; ++i)
#pragma unroll
        for (int j = 0; j < 16; ++j) if ((i + 1) * (j + 1) <= 16) INS16(Lc, (ord_key(sa[i] + sb[j]) & ~255) | (i * 16 + j));
    float e[16], sum = 0.f; int ex[16]; const float mx = ord_val(Lc[0], 255);
#pragma unroll
    for (int i = 0; i < 16; ++i) {
        e[i] = __expf(ord_val(Lc[i], 255) - mx); sum += e[i];
        const int ii = (Lc[i] >> 4) & 15, jj = Lc[i] & 15; int i1 = 0, i2 = 0;
#pragma unroll
        for (int q = 0; q < 16; ++q) { i1 = (ii == q) ? (La[q] & 127) : i1; i2 = (jj == q) ? (Lb[q] & 127) : i2; }
        ex[i] = i1 * 128 + i2;
    }
    const float inv = 1.f / sum;
    if (hh == 0) {
        v4u* ep = (v4u*)(C.EXPI + tok * 128 + hd * 16); f32x4* gp = (f32x4*)(C.GATE + tok * 128 + hd * 16);
#pragma unroll
        for (int q = 0; q < 4; ++q) { ep[q] = (v4u){(unsigned)ex[4 * q], (unsigned)ex[4 * q + 1], (unsigned)ex[4 * q + 2], (unsigned)ex[4 * q + 3]}; gp[q] = (f32x4){e[4 * q] * inv, e[4 * q + 1] * inv, e[4 * q + 2] * inv, e[4 * q + 3] * inv}; }
    }
}

__device__ __forceinline__ float dot8(v4u a, v4u b, float acc) {
    acc += bflo(a.x) * bflo(b.x); acc += bfhi(a.x) * bfhi(b.x); acc += bflo(a.y) * bflo(b.y); acc += bfhi(a.y) * bfhi(b.y);
    acc += bflo(a.z) * bflo(b.z); acc += bfhi(a.z) * bfhi(b.z); acc += bflo(a.w) * bflo(b.w); acc += bfhi(a.w) * bfhi(b.w); return acc;
}
__device__ __forceinline__ void peer_token(const Ctx& C, int t) {
    const int lane = C.lane; const int b = t / SEQ;
    v4u hq[4];
    { const v4u* hp = (const v4u*)(C.H + (size_t)t * D) + lane;
#pragma unroll
      for (int j = 0; j < 4; ++j) hq[j] = hp[64 * j]; }
    const int e_lo = C.EXPI[(size_t)t * 128 + lane], e_hi = C.EXPI[(size_t)t * 128 + 64 + lane];
    const float g_lo = C.GATE[(size_t)t * 128 + lane], g_hi = C.GATE[(size_t)t * 128 + 64 + lane];
    float a_lo = 0.f, a_hi = 0.f;
    for (int k0 = 0; k0 < 128; k0 += 4) {
        v4u u[4][4];
#pragma unroll
        for (int kk = 0; kk < 4; ++kk) { const int k = k0 + kk; const int e = __builtin_amdgcn_readlane(k < 64 ? e_lo : e_hi, k & 63); const v4u* up = (const v4u*)(C.UB + (size_t)e * D) + lane;
#pragma unroll
            for (int j = 0; j < 4; ++j) u[kk][j] = up[64 * j]; }
#pragma unroll
        for (int kk = 0; kk < 4; ++kk) { const int k = k0 + kk; float acc = 0.f;
#pragma unroll
            for (int j = 0; j < 4; ++j) acc = dot8(hq[j], u[kk][j], acc);
            acc = wave_sum(acc);
            if (lane == (k & 63)) { if (k < 64) a_lo = acc; else a_hi = acc; } }
    }
    const float w_lo = g_lo * 0.5f * a_lo * (1.f + erff(a_lo * 0.70710678118654752f)), w_hi = g_hi * 0.5f * a_hi * (1.f + erff(a_hi * 0.70710678118654752f));
    float acc[32];
#pragma unroll
    for (int i = 0; i < 32; ++i) acc[i] = 0.f;
    for (int k0 = 0; k0 < 128; k0 += 4) {
        v4u v[4][4]; float wk[4];
#pragma unroll
        for (int kk = 0; kk < 4; ++kk) { const int k = k0 + kk; const int e = __builtin_amdgcn_readlane(k < 64 ? e_lo : e_hi, k & 63); wk[kk] = __uint_as_float(__builtin_amdgcn_readlane(__float_as_uint(k < 64 ? w_lo : w_hi), k & 63));
            const v4u* vp = (const v4u*)(C.VB + (size_t)e * D) + lane;
#pragma unroll
            for (int j = 0; j < 4; ++j) v[kk][j] = vp[64 * j]; }
#pragma unroll
        for (int kk = 0; kk < 4; ++kk)
#pragma unroll
            for (int j = 0; j < 4; ++j) { const v4u q = v[kk][j]; const float ww = wk[kk];
                acc[8 * j + 0] += ww * bflo(q.x); acc[8 * j + 1] += ww * bfhi(q.x); acc[8 * j + 2] += ww * bflo(q.y); acc[8 * j + 3] += ww * bfhi(q.y);
                acc[8 * j + 4] += ww * bflo(q.z); acc[8 * j + 5] += ww * bfhi(q.z); acc[8 * j + 6] += ww * bflo(q.w); acc[8 * j + 7] += ww * bfhi(q.w); }
    }
#pragma unroll
    for (int j = 0; j < 4; ++j) { const int d0 = 512 * j + 8 * lane; float* op = C.out + (size_t)t * D + d0;
        const f32x4* gm = (const f32x4*)(C.MOD + b * NMOD + 5 * D + d0);
#pragma unroll
        for (int q = 0; q < 2; ++q) { const f32x4 x1 = ((const f32x4*)op)[q]; const f32x4 g = gm[q]; const f32x4 a = {acc[8 * j + 4 * q], acc[8 * j + 4 * q + 1], acc[8 * j + 4 * q + 2], acc[8 * j + 4 * q + 3]}; ((f32x4*)op)[q] = x1 + g * a; } }
}

struct Args { const void* in[18]; float* out; unsigned char* ws; int ph_lo, ph_hi; };
__global__ void __launch_bounds__(NTHREADS, 2) fwd_kernel(Args args) {
    extern __shared__ __attribute__((aligned(16))) unsigned char lds[];
    Ctx C;
    C.lds = (LAS unsigned char*)lds; C.tid = threadIdx.x; C.lane = C.tid & 63; C.wave = __builtin_amdgcn_readfirstlane(C.tid >> 6);
    C.G = gridDim.x; { const int bx = blockIdx.x; C.vcu = (C.G % 8 == 0) ? (bx % 8) * (C.G / 8) + bx / 8 : bx; }
    C.gw = C.vcu * NWAVES + C.wave; C.ngw = C.G * NWAVES;
    C.x = (const float*)args.in[0]; C.c = (const float*)args.in[1]; C.pos = (const int*)args.in[2]; C.w_ada = (const float*)args.in[3]; C.b_ada = (const float*)args.in[4]; C.g1 = (const float*)args.in[5];
    C.w_in = (const float*)args.in[6]; C.w_a2 = (const float*)args.in[7]; C.b_a = (const float*)args.in[8]; C.gla_g = (const float*)args.in[9]; C.qg = (const float*)args.in[10]; C.kg = (const float*)args.in[11];
    C.w_out = (const float*)args.in[12]; C.g2 = (const float*)args.in[13]; C.w_q = (const float*)args.in[14]; C.keys = (const float*)args.in[15]; C.pu = (const float*)args.in[16]; C.pv = (const float*)args.in[17];
    C.out = args.out; unsigned char* ws = args.ws;
    C.ctl = (unsigned*)(ws + WS_CTL); C.MODI = (long long*)(C.ctl + CW_MOD); C.MOD = (float*)(ws + WS_MODF);
    C.WIN = (bf16*)(ws + WS_WIN); C.WGA = (bf16*)(ws + WS_WGA); C.WOUT = (bf16*)(ws + WS_WOUT); C.WQ = (bf16*)(ws + WS_WQ); C.KEYSB = (bf16*)(ws + WS_KEYS); C.UB = (bf16*)(ws + WS_UB); C.VB = (bf16*)(ws + WS_VB);
    C.H = (bf16*)(ws + WS_H); C.CONCAT = (bf16*)(ws + WS_CONCAT); C.PROJ = (bf16*)(ws + WS_PROJ); C.ST = (bf16*)(ws + WS_ST);
    C.CS = (float*)(ws + WS_CS); C.KMEAN = (float*)(ws + WS_KMEAN); C.DEC = (float*)(ws + WS_DEC); C.BCUM = (float*)(ws + WS_BCUM); C.UT = (float*)(ws + WS_UT); C.QP = (float*)(ws + WS_QP); C.GATE = (float*)(ws + WS_GATE); C.EXPI = (int*)(ws + WS_EXP);
    for (int u = C.tid; u < (LDS_BYTES - RING_BYTES) / 4; u += NTHREADS) ((LAS unsigned*)(C.lds + RING_BYTES))[u] = 0u;
    __syncthreads();
    const int lo = args.ph_lo, hi = args.ph_hi;
    XcdBarrier bar; bar.bar = C.ctl + CW_BAR; bar.x = 0; bar.st = nullptr;
    if (hi - lo > 1) bar = xcd_barrier_post(C.ctl + CW_BAR, (volatile LAS unsigned*)(C.lds + MISC_OFF) + 8);
#ifndef SKIPMASK
#define SKIPMASK 0
#endif
#define IN(k) (!((SKIPMASK >> (k)) & 1) && lo <= (k) && (k) < hi)
#define SEAM(k) do { if (IN(k) && IN((k) + 1)) xcd_barrier(bar); } while (0)
    if (IN(0)) { p0_phase(C); } SEAM(0);
    if (IN(1)) { norm_mod_phase<true>(C, C.x, C.g1, 0, D, C.H); } SEAM(1);
    if (IN(2)) { pg8::Gemm g{C.H, C.WIN, T, NPROJ, D}; pg8::StaticOrder S; S.init(T, NPROJ, C.G, (int)blockIdx.x); pg8::EpiBf16<0> E{C.PROJ, NPROJ, nullptr, 0, 0, 1.f};
                 pg8::gemm_phase<pg8::EpiBf16<0>, pg8::StaticOrder, PG8_ALIGN, PG8_SP2>(C.lds, g, S, E); } SEAM(2);
    if (IN(3)) { for (int it = C.vcu; it < 128 + 256; it += C.G) { if (it < 256) moba_prep_item(C, it >> 7, (it >> 4) & 7, it & 15); else gla_prep_item(C, (it - 256) >> 6, (it - 256) & 63); } } SEAM(3);
    if (IN(4)) { p4_phase(C); } SEAM(4);
    if (IN(5)) { p5_phase(C); } SEAM(5);
    if (IN(6)) { for (int it = C.vcu; it < 1024; it += C.G) gla_out_item(C, it >> 9, (it >> 6) & 7, it & 63); } SEAM(6);
    if (IN(7)) { pg8::Gemm g{C.CONCAT, C.WOUT, T, D, D}; pg8::StaticOrder S; S.init(T, D, C.G, (int)blockIdx.x); pg8::EpiResGate E{C.x, C.out, D, C.MOD + 2 * D, NMOD, SEQ / 256};
                 pg8::gemm_phase<pg8::EpiResGate, pg8::StaticOrder, PG8_ALIGN, PG8_SP2>(C.lds, g, S, E); } SEAM(7);
    if (IN(8)) { norm_mod_phase<false>(C, C.out, C.g2, 3 * D, 4 * D, C.H); } SEAM(8);
    if (IN(9)) { pg8::Gemm g{C.H, C.WQ, T, D, D}; pg8::StaticOrder S; S.init(T, D, C.G, (int)blockIdx.x); pg8::EpiF32 E{C.QP, D, nullptr};
                 pg8::gemm_phase<pg8::EpiF32, pg8::StaticOrder, PG8_ALIGN, PG8_SP2>(C.lds, g, S, E); } SEAM(9);
    if (IN(10)) { for (int it = C.gw; it < 256 * 8; it += C.ngw) peer_topk_item(C, it >> 3, it & 7); } SEAM(10);
    if (IN(11)) { for (int t = C.gw; t < T; t += C.ngw) peer_token(C, t); }
#undef IN
#undef SEAM
}

extern "C" void kernel_launch(void* const* d_in, const int* in_sizes, int n_in, void* d_out, int out_size, void* d_ws, size_t ws_size, hipStream_t stream) {
    static int grid = 0;
    if (grid == 0) {
        if (n_in != 18 || in_sizes[0] != T * D || out_size != T * D || ws_size < WS_END) { fprintf(stderr, "kernel_launch: shape/workspace mismatch (n_in %d, in0 %d, out %d, ws %zu, need %zu); nothing launched\n", n_in, n_in > 0 ? in_sizes[0] : -1, out_size, ws_size, (size_t)WS_END); grid = -1; return; }
        int dev = 0, cus = 0, per_cu = 0;
        if (hipGetDevice(&dev) != hipSuccess || hipDeviceGetAttribute(&cus, hipDeviceAttributeMultiprocessorCount, dev) != hipSuccess) { fprintf(stderr, "kernel_launch: device query failed\n"); grid = -1; return; }
        if (hipFuncSetAttribute((const void*)fwd_kernel, hipFuncAttributeMaxDynamicSharedMemorySize, LDS_BYTES) != hipSuccess) { fprintf(stderr, "kernel_launch: hipFuncSetAttribute failed\n"); grid = -1; return; }
        if (hipOccupancyMaxActiveBlocksPerMultiprocessor(&per_cu, (const void*)fwd_kernel, NTHREADS, LDS_BYTES) != hipSuccess || per_cu < 1) { fprintf(stderr, "kernel_launch: occupancy query reports %d workgroups per CU\n", per_cu); (void)hipGetLastError(); grid = -1; return; }
        grid = cus;
    }
    if (grid < 0) return;
    if (hipMemsetAsync((char*)d_ws + WS_CTL, 0, CTL_ZERO_BYTES, stream) != hipSuccess) { fprintf(stderr, "kernel_launch: memset failed\n"); return; }
    Args a{};
    for (int i = 0; i < 18; ++i) a.in[i] = d_in[i];
    a.out = (float*)d_out; a.ws = (unsigned char*)d_ws;
#if MK_N_LAUNCHES == 1
    a.ph_lo = 0; a.ph_hi = N_PHASES;
    void* kargs[] = {&a};
    hipError_t le = hipLaunchCooperativeKernel((const void*)fwd_kernel, dim3(grid), dim3(NTHREADS), kargs, LDS_BYTES, stream);
    if (le != hipSuccess) fprintf(stderr, "kernel_launch: cooperative launch failed: %s (grid %d)\n", hipGetErrorName(le), grid);
#else
    for (int p = 0; p < N_PHASES; ++p) { a.ph_lo = p; a.ph_hi = p + 1; hipLaunchKernelGGL(fwd_kernel, dim3(grid), dim3(NTHREADS), LDS_BYTES, stream, a); }
#endif
}
```

```cpp
#include <hip/hip_runtime.h>
#include <hip/hip_bf16.h>
#include <cstdio>
#include <cstdint>
#include <cmath>
namespace pg8 {
#define PG8_LAS __attribute__((address_space(3)))
typedef unsigned short bf16_t;
typedef short bf16x8 __attribute__((ext_vector_type(8)));
typedef float f32x4 __attribute__((ext_vector_type(4)));
typedef unsigned u32x4 __attribute__((ext_vector_type(4)));
constexpr int BM = 256, BK = 64, HALF = 128, HTB = HALF * BK * 2  , STAGE_BYTES = 8 * HTB, NXCD = 8, WGM = 8;

__host__ __device__ __forceinline__ int lds_byte(int r, int c) { const int st = (r >> 4) * 2 + (c >> 5), rr = r & 15, cc = c & 31, ob = rr * 64 + cc * 2; return st * 1024 + (ob ^ (((ob >> 9) & 1) << 5)); }
__host__ __device__ __forceinline__ void stage_rc(int b, int& R, int& C) { const int st = b / 1024, sb = b % 1024, swz = sb ^ (((sb >> 9) & 1) << 5); R = (st >> 1) * 16 + swz / 64; C = (st & 1) * 32 + (swz % 64) / 2; }
__host__ __device__ __forceinline__ int perm32(int rho) { const int n = rho >> 4, i = rho & 15; return 8 * (i >> 2) + 4 * n + (i & 3); }

struct Unit { int pm, pn; };
struct Gemm { const bf16_t* A; const bf16_t* Bt; int M, N, K; };

struct StaticOrder {
    int nM, nN, nwg, G, c;
    __host__ __device__ void init(int M, int N, int G_, int c_) { nM = M / BM; nN = N / BM; nwg = nM * nN; G = G_; c = c_; }
    __host__ __device__ bool next(int i, Unit& u) const {
        const long L = (long)i * G + c; if (L >= nwg) return false;
        int wgid = (int)L; { const int q = nwg / NXCD, r = nwg % NXCD, xcd = wgid % NXCD, off = wgid / NXCD; wgid = (xcd < r ? xcd * (q + 1) : r * (q + 1) + (xcd - r) * q) + off; }
        const int nig = WGM * nN, gid = wgid / nig, fm = gid * WGM, gsz = (nM - fm) < WGM ? (nM - fm) : WGM;
        u.pm = fm + ((wgid % nig) % gsz); u.pn = (wgid % nig) / gsz; return true;
    }
    __device__ __forceinline__ void a_ready(const Unit&) const {}
    __device__ __forceinline__ void done(const Unit&) const {}
};

__device__ __forceinline__ unsigned cvt_pk_bf16(float lo, float hi) { unsigned r; asm volatile("v_cvt_pk_bf16_f32 %0, %1, %2" : "=v"(r) : "v"(lo), "v"(hi)); return r; }
typedef float f32x2 __attribute__((ext_vector_type(2)));
__device__ __forceinline__ f32x2 gelu_pk(f32x2 v) {
    const f32x2 av = __builtin_elementwise_abs(v), d = av * 0.2316418882f + 1.0f;
    f32x2 t; t.x = __builtin_amdgcn_rcpf(d.x); t.y = __builtin_amdgcn_rcpf(d.y);
    f32x2 q = t * 0.5307027145f + (-0.7265760135f); q = q * t + 0.7107068705f; q = q * t + (-0.142248368f); q = q * t + 0.127414796f; q = q * t;
    const f32x2 s = (v * v) * (-0.72134752044f);
    f32x2 e; e.x = __builtin_amdgcn_exp2f(s.x); e.y = __builtin_amdgcn_exp2f(s.y);
    const f32x2 m = v * (q * e), r = v - m;
    f32x2 o; o.x = v.x < 0.f ? m.x : r.x; o.y = v.y < 0.f ? m.y : r.y; return o;
}

template <int ACT  > struct EpiBf16 {
    static constexpr bool PERM = true, AFTER_DRAIN = false; static_assert(ACT == 0 || ACT == 1, "EpiBf16: ACT is 0 (none) or 1 (gelu_pk)");
    bf16_t* O; int ldc; const float* bias; int split_cols; size_t split_stride; float scale0;
    __device__ __forceinline__ void operator()(const f32x4 (&acc)[2][2][4][2], const Unit& u, int wr, int wc, int fr, int fq) const {
        const int row0 = u.pm * BM + wr * 64 + fr; int colt = u.pn * BM; bf16_t* base = O;
        float sc = 1.f; if (split_cols) { const int t = colt / split_cols; base += (size_t)t * split_stride; colt -= t * split_cols; if (t == 0) sc = scale0; }
        const int col0 = colt + wc * 32 + 8 * fq, bcol0 = u.pn * BM + wc * 32 + 8 * fq;
        f32x4 bv[2][2];
#pragma unroll
        for (int bj = 0; bj < 2; ++bj)
#pragma unroll
            for (int n = 0; n < 2; ++n) bv[bj][n] = bias ? *(const f32x4*)(bias + bcol0 + bj * HALF + 4 * n) : (f32x4){0.f, 0.f, 0.f, 0.f};
#pragma unroll
        for (int ai = 0; ai < 2; ++ai)
#pragma unroll
            for (int m = 0; m < 4; ++m) { bf16_t* rowp = base + (size_t)(row0 + ai * HALF + m * 16) * ldc + col0;
#pragma unroll
                for (int bj = 0; bj < 2; ++bj) { f32x4 v0 = acc[ai][bj][m][0] + bv[bj][0], v1 = acc[ai][bj][m][1] + bv[bj][1];
                    if (ACT == 1) { f32x2 a = gelu_pk((f32x2){v0[0], v0[1]}), b = gelu_pk((f32x2){v0[2], v0[3]}), c = gelu_pk((f32x2){v1[0], v1[1]}), d = gelu_pk((f32x2){v1[2], v1[3]});
                        v0 = (f32x4){a.x, a.y, b.x, b.y}; v1 = (f32x4){c.x, c.y, d.x, d.y}; }
                    v0 = v0 * sc; v1 = v1 * sc; u32x4 w; w.x = cvt_pk_bf16(v0[0], v0[1]); w.y = cvt_pk_bf16(v0[2], v0[3]); w.z = cvt_pk_bf16(v1[0], v1[1]); w.w = cvt_pk_bf16(v1[2], v1[3]);
                    *(u32x4*)(rowp + bj * HALF) = w; } }
    }
};
struct EpiF32 {
    static constexpr bool PERM = false, AFTER_DRAIN = false;
    float* C; int ldc; const float* bias;
    __device__ __forceinline__ void operator()(const f32x4 (&acc)[2][2][4][2], const Unit& u, int wr, int wc, int fr, int fq) const {
        const int row0 = u.pm * BM + wr * 64 + fr, col0 = u.pn * BM + wc * 32 + 4 * fq;
        f32x4 bv[2][2];
#pragma unroll
        for (int bj = 0; bj < 2; ++bj)
#pragma unroll
            for (int n = 0; n < 2; ++n) bv[bj][n] = bias ? *(const f32x4*)(bias + col0 + bj * HALF + n * 16) : (f32x4){0.f, 0.f, 0.f, 0.f};
#pragma unroll
        for (int ai = 0; ai < 2; ++ai)
#pragma unroll
            for (int m = 0; m < 4; ++m) { float* rowp = C + (size_t)(row0 + ai * HALF + m * 16) * ldc + col0;
#pragma unroll
                for (int bj = 0; bj < 2; ++bj)
#pragma unroll
                    for (int n = 0; n < 2; ++n) *(f32x4*)(rowp + bj * HALF + n * 16) = acc[ai][bj][m][n] + bv[bj][n]; }
    }
};
struct EpiResGate {
    static constexpr bool PERM = false, AFTER_DRAIN = false;
    const float* X; float* O; int ldc; const float* gate; int gate_stride, tiles_per_batch;
    __device__ __forceinline__ void operator()(const f32x4 (&acc)[2][2][4][2], const Unit& u, int wr, int wc, int fr, int fq) const {
        const int row0 = u.pm * BM + wr * 64 + fr, col0 = u.pn * BM + wc * 32 + 4 * fq;
        const float* gp = gate + (size_t)(u.pm / tiles_per_batch) * gate_stride;
        f32x4 gv[2][2];
#pragma unroll
        for (int bj = 0; bj < 2; ++bj)
#pragma unroll
            for (int n = 0; n < 2; ++n) gv[bj][n] = *(const f32x4*)(gp + col0 + bj * HALF + n * 16);
#pragma unroll
        for (int ai = 0; ai < 2; ++ai)
#pragma unroll
            for (int m = 0; m < 4; ++m) { const size_t off = (size_t)(row0 + ai * HALF + m * 16) * ldc + col0;
#pragma unroll
                for (int bj = 0; bj < 2; ++bj)
#pragma unroll
                    for (int n = 0; n < 2; ++n) { const f32x4 xv = *(const f32x4*)(X + off + bj * HALF + n * 16); *(f32x4*)(O + off + bj * HALF + n * 16) = xv + gv[bj][n] * acc[ai][bj][m][n]; } }
    }
};

template <class Epi, class Sched, bool ALIGN_EPI = false, bool SP2 = false>
__device__ __forceinline__ void gemm_phase(PG8_LAS unsigned char* lds, const Gemm g, const Sched& S, const Epi& E) {
    const int tid = threadIdx.x, wid = __builtin_amdgcn_readfirstlane(tid >> 6), lane = tid & 63, wr = wid >> 2, wc = wid & 3, fr = lane & 15, fq = lane >> 4;
    const int K = g.K, nt = K / BK;
    unsigned voffA[2], voffB[2];
#pragma unroll
    for (int i = 0; i < 2; ++i) { int R, C; stage_rc(tid * 16 + i * 8192, R, C); const int Rb = Epi::PERM ? ((R & ~31) + perm32(R & 31)) : R;
        voffA[i] = (unsigned)(R * K + C) * 2u; voffB[i] = (unsigned)(Rb * K + C) * 2u; }
    const size_t kstep = (size_t)(BK * 2);
    const size_t hstep = (size_t)HALF * K * 2;
    const size_t tstep = 2 * hstep;
    const unsigned ldsw = (unsigned)wid * 1024u;
    const int aoff = lds_byte(wr * 64 + fr, fq * 8), boff = lds_byte(wc * 32 + fr, fq * 8);
#define PG8_SA(b, h) (((b) * 2 + (h)) * HTB)
#define PG8_SB(b, h) ((4 + (b) * 2 + (h)) * HTB)
#define PG8_STAGE(bufoff, gbase, voff) do { _Pragma("unroll") for (int _i = 0; _i < 2; ++_i) \
        __builtin_amdgcn_global_load_lds((const unsigned*)((const char*)(gbase) + (voff)[_i]), (PG8_LAS unsigned*)(lds + (bufoff) + ldsw + _i * 8192), 16, 0, 0); } while (0)
#define PG8_LDA(dst, b, h) do { _Pragma("unroll") for (int m = 0; m < 4; ++m) _Pragma("unroll") for (int k = 0; k < 2; ++k) dst[m][k] = *(const PG8_LAS bf16x8*)(lds + PG8_SA(b, h) + aoff + m * 2048 + k * 1024); } while (0)
#define PG8_LDB(dst, b, h) do { _Pragma("unroll") for (int n = 0; n < 2; ++n) _Pragma("unroll") for (int k = 0; k < 2; ++k) dst[n][k] = *(const PG8_LAS bf16x8*)(lds + PG8_SB(b, h) + boff + n * 2048 + k * 1024); } while (0)
#define PG8_MMA(ai, bj, At, Bt) do { __builtin_amdgcn_s_setprio(1); _Pragma("unroll") for (int m = 0; m < 4; ++m) _Pragma("unroll") for (int n = 0; n < 2; ++n) _Pragma("unroll") for (int k = 0; k < 2; ++k) \
        acc[ai][bj][m][n] = __builtin_amdgcn_mfma_f32_16x16x32_bf16(Bt[n][k], At[m][k], acc[ai][bj][m][n], 0, 0, 0); __builtin_amdgcn_s_setprio(0); } while (0)
#define PG8_WAIT_V(n) asm volatile("s_waitcnt vmcnt(" #n ")" ::: "memory")
#define PG8_WAIT_L(n) asm volatile("s_waitcnt lgkmcnt(" #n ")" ::: "memory")
#define PG8_BAR __builtin_amdgcn_s_barrier()
#define PG8_SCHED __builtin_amdgcn_sched_barrier(0)
    Unit cur, nxt; int ui = 0;
    if (!S.next(0, cur)) return;
    f32x4 acc[2][2][4][2];
#pragma unroll
    for (int a = 0; a < 2; ++a)
#pragma unroll
        for (int b = 0; b < 2; ++b)
#pragma unroll
            for (int m = 0; m < 4; ++m)
#pragma unroll
                for (int n = 0; n < 2; ++n) acc[a][b][m][n] = (f32x4){0.f, 0.f, 0.f, 0.f};
    bf16x8 At[4][2], B0[2][2], B1[2][2];
    const char* cA = (const char*)g.A + (size_t)cur.pm * tstep; const char* cB = (const char*)g.Bt + (size_t)cur.pn * tstep;
    S.a_ready(cur);
    if constexpr (SP2) {
        PG8_STAGE(PG8_SB(0, 0), cB, voffB); PG8_STAGE(PG8_SB(0, 1), cB + hstep, voffB); PG8_STAGE(PG8_SA(0, 0), cA, voffA); PG8_STAGE(PG8_SA(0, 1), cA + hstep, voffA);
        if (wr == 1) PG8_BAR;
        PG8_WAIT_V(2); PG8_BAR;
        PG8_STAGE(PG8_SB(1, 0), cB + kstep, voffB); PG8_STAGE(PG8_SA(1, 0), cA + kstep, voffA); PG8_STAGE(PG8_SB(1, 1), cB + hstep + kstep, voffB);
        PG8_WAIT_V(6); PG8_BAR;
    } else {
        PG8_STAGE(PG8_SB(0, 0), cB, voffB); PG8_STAGE(PG8_SA(0, 0), cA, voffA); PG8_STAGE(PG8_SB(0, 1), cB + hstep, voffB); PG8_STAGE(PG8_SA(0, 1), cA + hstep, voffA);
        if (wr == 1) PG8_BAR;
        PG8_WAIT_V(4); PG8_BAR;
        PG8_STAGE(PG8_SB(1, 0), cB + kstep, voffB); PG8_STAGE(PG8_SA(1, 0), cA + kstep, voffA); PG8_STAGE(PG8_SB(1, 1), cB + hstep + kstep, voffB);
        PG8_WAIT_V(6); PG8_BAR;
    }
    for (;;) {
        const bool has_next = S.next(ui + 1, nxt);
        const char* nA = has_next ? (const char*)g.A + (size_t)nxt.pm * tstep : cA; const char* nB = has_next ? (const char*)g.Bt + (size_t)nxt.pn * tstep : cB;
        for (int t = 0; t < nt; t += 2) {
            const bool last = (t == nt - 2);
            const char* a1 = cA + (size_t)(t + 1) * kstep;
            const char* a2 = last ? nA : cA + (size_t)(t + 2) * kstep; const char* b2 = last ? nB : cB + (size_t)(t + 2) * kstep;
            const char* a3 = a2 + kstep; const char* b3 = b2 + kstep;
            if (last && has_next) S.a_ready(nxt);
            if constexpr (SP2) {
            PG8_LDB(B0, 0, 0); PG8_LDB(B1, 0, 1); PG8_SCHED; PG8_LDA(At, 0, 0); PG8_STAGE(PG8_SA(1, 1), a1 + hstep, voffA);
            PG8_WAIT_V(8); PG8_WAIT_L(0); PG8_BAR; PG8_MMA(0, 0, At, B0); PG8_MMA(0, 1, At, B1); PG8_BAR; PG8_SCHED;
            PG8_LDA(At, 0, 1); PG8_STAGE(PG8_SB(0, 0), b2, voffB); PG8_STAGE(PG8_SB(0, 1), b2 + hstep, voffB); PG8_STAGE(PG8_SA(0, 0), a2, voffA);
            PG8_WAIT_V(8); PG8_WAIT_L(0); PG8_BAR; PG8_MMA(1, 0, At, B0); PG8_MMA(1, 1, At, B1); PG8_BAR; PG8_SCHED;
            PG8_LDB(B0, 1, 0); PG8_LDB(B1, 1, 1); PG8_SCHED; PG8_LDA(At, 1, 0); PG8_STAGE(PG8_SA(0, 1), a2 + hstep, voffA);
            PG8_WAIT_V(8); PG8_WAIT_L(0); PG8_BAR; PG8_MMA(0, 0, At, B0); PG8_MMA(0, 1, At, B1); PG8_BAR; PG8_SCHED;
            PG8_LDA(At, 1, 1); PG8_STAGE(PG8_SB(1, 0), b3, voffB); PG8_STAGE(PG8_SB(1, 1), b3 + hstep, voffB); PG8_STAGE(PG8_SA(1, 0), a3, voffA);
            PG8_WAIT_V(8); PG8_WAIT_L(0); PG8_BAR; PG8_MMA(1, 0, At, B0); PG8_MMA(1, 1, At, B1); PG8_BAR; PG8_SCHED;
            } else {
            PG8_LDB(B0, 0, 0); PG8_SCHED; PG8_LDA(At, 0, 0); PG8_STAGE(PG8_SA(1, 1), a1 + hstep, voffA);
            PG8_WAIT_L(8); PG8_BAR; PG8_WAIT_L(0); PG8_MMA(0, 0, At, B0); PG8_BAR; PG8_SCHED;
            PG8_LDB(B1, 0, 1); PG8_STAGE(PG8_SB(0, 0), b2, voffB);
            PG8_BAR; PG8_WAIT_L(0); PG8_MMA(0, 1, At, B1); PG8_BAR;
            PG8_LDA(At, 0, 1); PG8_STAGE(PG8_SA(0, 0), a2, voffA);
            PG8_BAR; PG8_WAIT_L(0); PG8_MMA(1, 0, At, B0); PG8_BAR; PG8_SCHED;
            PG8_STAGE(PG8_SB(0, 1), b2 + hstep, voffB);
            PG8_WAIT_V(6); PG8_BAR; PG8_MMA(1, 1, At, B1); PG8_BAR;
            PG8_LDB(B0, 1, 0); PG8_SCHED; PG8_LDA(At, 1, 0); PG8_STAGE(PG8_SA(0, 1), a2 + hstep, voffA);
            PG8_WAIT_L(8); PG8_BAR; PG8_WAIT_L(0); PG8_MMA(0, 0, At, B0); PG8_BAR; PG8_SCHED;
            PG8_LDB(B1, 1, 1); PG8_STAGE(PG8_SB(1, 0), b3, voffB);
            PG8_BAR; PG8_WAIT_L(0); PG8_MMA(0, 1, At, B1); PG8_BAR;
            PG8_LDA(At, 1, 1); PG8_STAGE(PG8_SA(1, 0), a3, voffA);
            PG8_BAR; PG8_WAIT_L(0); PG8_MMA(1, 0, At, B0); PG8_BAR; PG8_SCHED;
            PG8_STAGE(PG8_SB(1, 1), b3 + hstep, voffB);
            PG8_WAIT_V(6); PG8_BAR; PG8_MMA(1, 1, At, B1); PG8_BAR;
            }
        }
        if constexpr (ALIGN_EPI) { if (wr == 0) PG8_BAR; }
        if constexpr (!Epi::AFTER_DRAIN) { E(acc, cur, wr, wc, fr, fq); S.done(cur); }
        if (!has_next) break;
#pragma unroll
        for (int a = 0; a < 2; ++a)
#pragma unroll
            for (int b = 0; b < 2; ++b)
#pragma unroll
                for (int m = 0; m < 4; ++m)
#pragma unroll
                    for (int n = 0; n < 2; ++n) acc[a][b][m][n] = (f32x4){0.f, 0.f, 0.f, 0.f};
        cur = nxt; cA = nA; cB = nB; ++ui;
        if constexpr (ALIGN_EPI) { if (wr == 1) PG8_BAR; }
    }
    PG8_WAIT_V(0);
    if constexpr (!ALIGN_EPI) { if (wr == 0) PG8_BAR; }
    PG8_BAR;
    if constexpr (Epi::AFTER_DRAIN) { E.fused(acc, cur, wr, wc, fr, fq, lds, wid, lane); S.done(cur); }
#undef PG8_SA
#undef PG8_SB
#undef PG8_STAGE
#undef PG8_LDA
#undef PG8_LDB
#undef PG8_MMA
#undef PG8_WAIT_V
#undef PG8_WAIT_L
#undef PG8_BAR
#undef PG8_SCHED
}
}

#ifndef PG8_SP2
#define PG8_SP2 true
#endif
#ifndef PG8_ALIGN
#define PG8_ALIGN true
#endif
constexpr int NWAVES = 8, NTHREADS = NWAVES * 64;
constexpr int BATCH = 2, SEQ = 4096, T = BATCH * SEQ, D = 2048;
constexpr int INW = 6160, NPROJ = 6144;
constexpr int GQ = 0, GK = 512, GV = 1024, GG = 2048, MQ = 3072, MK = 4096, MV = 5120;
constexpr int GA_SRC = 3072;
constexpr int NH = 8, NEXP = 16384, NMOD = 6 * D;
constexpr float EPS = 1e-6f;
#ifndef MK_N_LAUNCHES
#define MK_N_LAUNCHES 1
#endif
constexpr int N_PHASES = 13;
constexpr int NSL = 8, SLW = 256, PCH = 64, NCHUNK = (BATCH * SEQ) / PCH;

constexpr size_t MiB = 1u << 20;
constexpr size_t WS_CTL = 0, CTL_ZERO_BYTES = 1 * MiB;
constexpr size_t WS_WIN = 1 * MiB, WS_WGA = 25 * MiB, WS_WOUT = 26 * MiB, WS_WQ = 34 * MiB, WS_KEYS = 42 * MiB, WS_CS = 43 * MiB, WS_KMEAN = 44 * MiB, WS_DEC = 45 * MiB;
constexpr size_t WS_UB = 46 * MiB, WS_VB = 110 * MiB, WS_H = 174 * MiB, WS_CONCAT = 206 * MiB, WS_BCUM = 238 * MiB, WS_UT = 254 * MiB, WS_ST = 286 * MiB, WS_PROJ = 302 * MiB;
constexpr size_t WS_QP = WS_PROJ, WS_EXP = 366 * MiB, WS_GATE = 370 * MiB, WS_GU = 374 * MiB, WS_ACT = 378 * MiB, WS_HQ = 382 * MiB, WS_END = 398 * MiB;
constexpr size_t WS_US = WS_UB + 40 * MiB, WS_VS = WS_VB + 40 * MiB, WS_HS = WS_VB + 41 * MiB;
constexpr int CW_BAR = 4096, CW_Q = 8192, CW_QA = 9216, CW_QB = 10240, CW_MOD = 16384;
static_assert((CW_MOD + 2 * BATCH * NMOD) * 4 <= (int)CTL_ZERO_BYTES, "CTL words inside the memset region");
constexpr size_t WS_MODF = 45 * MiB + 512 * 1024;

constexpr int RING_BYTES = 131072, MISC_OFF = RING_BYTES + 320, LDS_BYTES = 147456;

#define GAS __attribute__((address_space(1)))
#define LAS __attribute__((address_space(3)))
typedef unsigned short bf16;
typedef unsigned v4u __attribute__((ext_vector_type(4)));
typedef unsigned v2u __attribute__((ext_vector_type(2)));
typedef float f32x4 __attribute__((ext_vector_type(4)));
typedef float f32x2 __attribute__((ext_vector_type(2)));
typedef float f32x16 __attribute__((ext_vector_type(16)));
typedef short bf16x8 __attribute__((ext_vector_type(8)));
typedef short s16x4 __attribute__((ext_vector_type(4)));
typedef __bf16 bf16x2_t __attribute__((ext_vector_type(2)));
typedef GAS unsigned gu32;
#define LDS_WAIT() asm volatile("s_waitcnt lgkmcnt(0)" ::: "memory")
#define VM_WAIT() asm volatile("s_waitcnt vmcnt(0)" ::: "memory")
__device__ __forceinline__ unsigned pk2(float lo, float hi) { f32x2 v = {lo, hi}; bf16x2_t b = __builtin_convertvector(v, bf16x2_t); return __builtin_bit_cast(unsigned, b); }
__device__ __forceinline__ float bflo(unsigned u) { return __uint_as_float(u << 16); }
__device__ __forceinline__ float bfhi(unsigned u) { return __uint_as_float(u & 0xffff0000u); }
__device__ __forceinline__ float bf1(short s) { return __uint_as_float(((unsigned)(unsigned short)s) << 16); }
__device__ __forceinline__ bf16x8 pack8(float a0, float a1, float a2, float a3, float a4, float a5, float a6, float a7) { v4u w; w.x = pk2(a0, a1); w.y = pk2(a2, a3); w.z = pk2(a4, a5); w.w = pk2(a6, a7); return __builtin_bit_cast(bf16x8, w); }
__device__ __forceinline__ int crow(int r, int hi) { return (r & 3) + 8 * (r >> 2) + 4 * hi; }
__device__ __forceinline__ float wave_sum(float v) {
#pragma unroll
    for (int o = 1; o < 64; o <<= 1) v += __shfl_xor(v, o);
    return v;
}
typedef short v4i16_t __attribute__((ext_vector_type(4)));
__device__ __forceinline__ s16x4 vtr(const LAS unsigned char* p) { return __builtin_bit_cast(s16x4, __builtin_amdgcn_ds_read_tr16_b64_v4i16((LAS v4i16_t*)p)); }
__device__ __forceinline__ bf16x8 cat4(s16x4 lo, s16x4 hi) { return (bf16x8){lo[0], lo[1], lo[2], lo[3], hi[0], hi[1], hi[2], hi[3]}; }
#define MFMA32(a, b, c) __builtin_amdgcn_mfma_f32_32x32x16_bf16((a), (b), (c), 0, 0, 0)
#define XB_TMO      128
#define XB_XCNT(j)  (256  + 64 * (j))
#define XB_XSUB(j)  (1280 + 64 * (j))
#define XB_XGEN(j)  (2304 + 64 * (j))
#define XB_TOP      3328
#define XB_TOPGEN   3392
#define XCD_BAR_WORDS 3456
#define XB_SPIN_CAP (1u << 18)

__device__ __forceinline__ unsigned xb_ld(unsigned* p)              { return __hip_atomic_load(p, __ATOMIC_RELAXED, __HIP_MEMORY_SCOPE_AGENT); }
__device__ __forceinline__ unsigned xb_add(unsigned* p, unsigned v) { return __hip_atomic_fetch_add(p, v, __ATOMIC_RELAXED, __HIP_MEMORY_SCOPE_AGENT); }
__device__ __forceinline__ unsigned xb_xcc_id() { return (unsigned)__builtin_amdgcn_s_getreg((3 << 11) | 20) & 0xFu; }
#define XB_SPIN(cond, bar) do { unsigned _sp = 0; while (cond) { __builtin_amdgcn_s_sleep(1); \
    if ((++_sp & 255u) == 0u) { if (xb_ld(&(bar)[XB_TMO])) break; if (_sp > XB_SPIN_CAP) { atomicAdd(&(bar)[XB_TMO], 1u); break; } } } } while (0)

struct XcdBarrier {
    unsigned* bar; unsigned x;
    volatile LAS unsigned* st;
};

__device__ __forceinline__ XcdBarrier xcd_barrier_post(unsigned* bar, volatile LAS unsigned* st) {
    XcdBarrier b; b.bar = bar; b.x = xb_xcc_id(); b.st = st;
    if (threadIdx.x == 0) (void)xb_add(&bar[XB_XCNT(b.x)], 1u);
    return b;
}
__device__ __forceinline__ void xcd_barrier_complete(unsigned* bar, unsigned x, unsigned& nloc, unsigned& nx) {
    const unsigned G = gridDim.x * gridDim.y * gridDim.z;
    unsigned sum, cnt, mine, sp = 0u;
    for (;;) {
        sum = 0u; cnt = 0u; mine = 0u;
#pragma unroll
        for (unsigned j = 0; j < 16; ++j) { const unsigned c = xb_ld(&bar[XB_XCNT(j)]); sum += c; cnt += (c > 0u) ? 1u : 0u; mine = (j == x) ? c : mine; }
        if (sum == G) break;
        __builtin_amdgcn_s_sleep(1);
        if ((++sp & 255u) == 0u) { if (xb_ld(&bar[XB_TMO])) break; if (sp > XB_SPIN_CAP) { atomicAdd(&bar[XB_TMO], 1u); break; } }
    }
    nloc = mine > 0u ? mine : 1u; nx = cnt > 0u ? cnt : 1u;
}

__device__ __forceinline__ void xcd_barrier(const XcdBarrier& b) {
    asm volatile("s_waitcnt vmcnt(0)" ::: "memory");
    __syncthreads();
    if (threadIdx.x == 0) {
        unsigned* bar = b.bar;
        __builtin_amdgcn_s_waitcnt(0);
        unsigned nloc = b.st[0], nx = b.st[1];
        if (nloc == 0u) { xcd_barrier_complete(bar, b.x, nloc, nx); b.st[0] = nloc; b.st[1] = nx; }
        const unsigned old = xb_add(&bar[XB_XSUB(b.x)], 1u);
        const unsigned gen = old / nloc;
        if (old + 1u == (gen + 1u) * nloc) {
            __builtin_amdgcn_fence(__ATOMIC_RELEASE, "agent");
            asm volatile("s_waitcnt vmcnt(0)" ::: "memory");
            const unsigned og = xb_add(&bar[XB_TOP], 1u);
            const unsigned tg = og / nx;
            if (og + 1u == (tg + 1u) * nx) xb_add(&bar[XB_TOPGEN], 1u);
            else XB_SPIN(xb_ld(&bar[XB_TOPGEN]) == tg, bar);
            __builtin_amdgcn_fence(__ATOMIC_ACQUIRE, "agent");
            xb_add(&bar[XB_XGEN(b.x)], 1u);
            asm volatile("s_waitcnt vmcnt(0)" ::: "memory");
        } else {
            XB_SPIN(xb_ld(&bar[XB_XGEN(b.x)]) == gen, bar);
            __builtin_amdgcn_fence(__ATOMIC_ACQUIRE, "agent");
            asm volatile("s_waitcnt vmcnt(0)" ::: "memory");
        }
    }
    __syncthreads();
}

struct Ctx {
    LAS unsigned char* lds;
    int tid, lane, wave, vcu, G, gw, ngw;
    const float *x, *c; const int* pos; const float *w_ada, *b_ada, *g1, *w_in, *w_a2, *b_a, *gla_g, *qg, *kg, *w_out, *g2, *w_q, *keys, *pu, *pv;
    float* out;
    unsigned* ctl; long long* MODI; float* MOD;
    bf16 *WIN, *WGA, *WOUT, *WQ, *KEYSB, *H, *CONCAT, *PROJ, *ST;
    unsigned char *UQ, *VQ, *HQ;
    float *CS, *KMEAN, *DEC, *BCUM, *UT, *QP, *GATE, *GU, *US, *VS, *HS; int *EXPI, *ACT;
};

__device__ __forceinline__ void transpose_item(const float* W, int ldw, int K, bf16* WT, int dst_row0, int k0, int n0, LAS float* scr, int lane) {
#pragma unroll 8
    for (int i = 0; i < 32; ++i) { const int kk = 2 * i + (lane >> 5); scr[kk * 33 + (lane & 31)] = W[(size_t)(k0 + kk) * ldw + n0 + (lane & 31)]; }
    LDS_WAIT(); asm volatile("" ::: "memory");
    const int c = lane & 7;
#pragma unroll
    for (int j = 0; j < 4; ++j) { const int n = (lane >> 3) + 8 * j; const LAS float* s = scr + (8 * c) * 33 + n;
        v4u o; o.x = pk2(s[0 * 33], s[1 * 33]); o.y = pk2(s[2 * 33], s[3 * 33]); o.z = pk2(s[4 * 33], s[5 * 33]); o.w = pk2(s[6 * 33], s[7 * 33]);
        *(v4u*)(WT + (size_t)(dst_row0 + n) * K + k0 + 8 * c) = o; }
    LDS_WAIT(); asm volatile("" ::: "memory");
}
__device__ __forceinline__ void convert_item(const float* src, bf16* dst, size_t item, int lane) {
    const f32x4* s = (const f32x4*)(src + item * 8192) + 2 * lane; v4u* d = (v4u*)(dst + item * 8192) + lane;
#pragma unroll 4
    for (int it = 0; it < 16; ++it) { const f32x4 a = s[it * 128], b = s[it * 128 + 1]; v4u o; o.x = pk2(a.x, a.y); o.y = pk2(a.z, a.w); o.z = pk2(b.x, b.y); o.w = pk2(b.z, b.w); d[it * 64] = o; }
}
__device__ __forceinline__ float wave_max(float v) {
#pragma unroll
    for (int o = 1; o < 64; o <<= 1) v = fmaxf(v, __shfl_xor(v, o));
    return v;
}
__device__ __forceinline__ void quant_store(const f32x4 (&v)[8], unsigned char* dst, float* scales, int row, size_t nrows, int lane, int bias) {
    float am = 0.f;
#pragma unroll
    for (int j = 0; j < 8; ++j) am = fmaxf(am, fmaxf(fmaxf(fabsf(v[j].x), fabsf(v[j].y)), fmaxf(fabsf(v[j].z), fabsf(v[j].w))));
    am = wave_max(am);
    const float inv = am > 0.f ? 127.f / am : 0.f;
    if (lane == 0) scales[row] = am > 0.f ? am / 127.f : 1.f;
#pragma unroll
    for (int j = 0; j < 8; ++j) { const int q0 = (int)rintf(v[j].x * inv) + bias, q1 = (int)rintf(v[j].y * inv) + bias, q2 = (int)rintf(v[j].z * inv) + bias, q3 = (int)rintf(v[j].w * inv) + bias;
        *(unsigned*)(dst + ((size_t)j * nrows + row) * 256 + 4 * lane) = (unsigned)(q0 & 0xff) | ((unsigned)(q1 & 0xff) << 8) | ((unsigned)(q2 & 0xff) << 16) | ((unsigned)(q3 & 0xff) << 24); }
}
__device__ __forceinline__ void quant_row(const float* src, unsigned char* dst, float* scales, int row, size_t nrows, int lane, int bias) {
    const f32x4* s = (const f32x4*)src + lane; f32x4 v[8];
#pragma unroll
    for (int j = 0; j < 8; ++j) v[j] = s[64 * j];
    quant_store(v, dst, scales, row, nrows, lane, bias);
}
__device__ __forceinline__ void p0_phase(const Ctx& C) {
    const int lane = C.lane, gw = C.gw, ngw = C.ngw;
    LAS float* sc = (LAS float*)C.lds;
    for (int i = C.tid; i < BATCH * D; i += NTHREADS) { const float v = C.c[i]; sc[i] = v / (1.f + __expf(-v)); }
    __syncthreads();
    for (int it = gw; it < 192 * 8; it += ngw) {
        const int cc = it % 192, ks = it / 192, col = cc * 64 + lane;
        const float* w = C.w_ada + (size_t)(ks * 256) * NMOD + col; const LAS float* s0 = sc + ks * 256; const LAS float* s1 = sc + D + ks * 256;
        float a0 = 0.f, a1 = 0.f;
#pragma unroll 16
        for (int k = 0; k < 256; ++k) { const float wv = w[(size_t)k * NMOD]; a0 += s0[k] * wv; a1 += s1[k] * wv; }
        atomicAdd((unsigned long long*)(C.MODI + col), (unsigned long long)__double2ll_rn((double)a0 * 1099511627776.0)); atomicAdd((unsigned long long*)(C.MODI + NMOD + col), (unsigned long long)__double2ll_rn((double)a1 * 1099511627776.0));
    }
    __syncthreads();
    LAS float* scr = (LAS float*)(C.lds + C.wave * 16384);
    constexpr int I_IN = 32 * 192, I_SQ = 32 * 64;
    for (int it = gw; it < I_IN + 2 * I_SQ; it += ngw) {
        int r = it;
        if (r < I_IN) { const int kb = r / 192, nb = r % 192, n0 = 32 * nb; transpose_item(C.w_in, INW, D, C.WIN, n0, 64 * kb, n0 < 3072 ? n0 : n0 + 16, scr, lane); continue; } r -= I_IN;
        if (r < I_SQ) { transpose_item(C.w_out, D, D, C.WOUT, 32 * (r % 64), 64 * (r / 64), 32 * (r % 64), scr, lane); continue; } r -= I_SQ;
        transpose_item(C.w_q, D, D, C.WQ, 32 * (r % 64), 64 * (r / 64), 32 * (r % 64), scr, lane);
    }
    for (int it = gw; it < 32; it += ngw) { const int k = it * 64 + lane; const f32x4* s = (const f32x4*)(C.w_in + (size_t)k * INW + GA_SRC);
#pragma unroll
        for (int q = 0; q < 4; ++q) { const f32x4 v = s[q]; C.WGA[(4 * q + 0) * D + k] = (bf16)(pk2(v.x, 0.f) & 0xffff); C.WGA[(4 * q + 1) * D + k] = (bf16)(pk2(v.y, 0.f) & 0xffff);
            C.WGA[(4 * q + 2) * D + k] = (bf16)(pk2(v.z, 0.f) & 0xffff); C.WGA[(4 * q + 3) * D + k] = (bf16)(pk2(v.w, 0.f) & 0xffff); } }
    for (int it = gw; it < 2 * NEXP; it += ngw) {
        if (it < NEXP) quant_row(C.pu + (size_t)it * D, C.UQ, C.US, it, NEXP, lane, 0);
        else quant_row(C.pv + (size_t)(it - NEXP) * D, C.VQ, C.VS, it - NEXP, NEXP, lane, 128);
    }
    for (int it = gw; it < 32; it += ngw) convert_item(C.keys, C.KEYSB, it, lane);
    for (int idx = C.vcu * NTHREADS + C.tid; idx < T * 16; idx += C.G * NTHREADS) {
        const int t = idx >> 4, f = idx & 15; const float inv = powf(500000.0f, -(float)f * 0.0625f); const float ang = (float)C.pos[t] * inv;
        C.CS[2 * idx] = cosf(ang); C.CS[2 * idx + 1] = sinf(ang);
    }
}

template <bool FIRST> __device__ __forceinline__ void norm_mod_phase(const Ctx& C, const float* X, const float* g, int shift_off, int scale_off, bf16* O) {
    if (FIRST) { for (int i = C.vcu * NTHREADS + C.tid; i < BATCH * NMOD; i += C.G * NTHREADS) C.MOD[i] = (float)((double)C.MODI[i] * (1.0 / 1099511627776.0)) + C.b_ada[i % NMOD]; }
    for (int m = C.gw; m < T; m += C.ngw) {
        const int b = m / SEQ; const f32x4* xr = (const f32x4*)(X + (size_t)m * D) + C.lane;
        f32x4 v[8]; float ss = 0.f;
#pragma unroll
        for (int j = 0; j < 8; ++j) { v[j] = xr[64 * j]; ss += (v[j].x * v[j].x + v[j].y * v[j].y) + (v[j].z * v[j].z + v[j].w * v[j].w); }
        const float rstd = rsqrtf(wave_sum(ss) * (1.f / D) + EPS);
        const f32x4* g4 = (const f32x4*)g + C.lane; v2u* o8 = (v2u*)(O + (size_t)m * D) + C.lane;
#pragma unroll
        for (int j = 0; j < 8; ++j) {
            f32x4 sh, sl;
            if (FIRST) { const long long* ph = C.MODI + b * NMOD + shift_off + 4 * (C.lane + 64 * j); const long long* pl = C.MODI + b * NMOD + scale_off + 4 * (C.lane + 64 * j);
                const f32x4 bh = ((const f32x4*)(C.b_ada + shift_off))[C.lane + 64 * j], bl = ((const f32x4*)(C.b_ada + scale_off))[C.lane + 64 * j];
                sh = (f32x4){(float)((double)ph[0] * (1.0 / 1099511627776.0)), (float)((double)ph[1] * (1.0 / 1099511627776.0)), (float)((double)ph[2] * (1.0 / 1099511627776.0)), (float)((double)ph[3] * (1.0 / 1099511627776.0))} + bh;
                sl = (f32x4){(float)((double)pl[0] * (1.0 / 1099511627776.0)), (float)((double)pl[1] * (1.0 / 1099511627776.0)), (float)((double)pl[2] * (1.0 / 1099511627776.0)), (float)((double)pl[3] * (1.0 / 1099511627776.0))} + bl; }
            else { sh = ((const f32x4*)(C.MOD + b * NMOD + shift_off))[C.lane + 64 * j]; sl = ((const f32x4*)(C.MOD + b * NMOD + scale_off))[C.lane + 64 * j]; }
            const f32x4 y = v[j] * rstd * g4[64 * j] * (1.f + sl) + sh; v2u w; w.x = pk2(y.x, y.y); w.y = pk2(y.z, y.w); o8[64 * j] = w; v[j] = y; }
        if (!FIRST) quant_store(v, C.HQ, C.HS, m, T, C.lane, 0);
    }
}

__device__ __forceinline__ void gla_prep_item(const Ctx& C, int b, int n) {
    const int lane = C.lane, w = C.wave, fr = lane & 15, fq = lane >> 4, rt = w & 3, kh = w >> 2; const size_t t0 = (size_t)b * SEQ + 64 * n;
    const bf16* ap = C.H + (t0 + 16 * rt + fr) * D + kh * 1024 + 8 * fq; const bf16* bp = C.WGA + fr * D + kh * 1024 + 8 * fq;
    f32x4 acc = {0.f, 0.f, 0.f, 0.f};
#pragma unroll 8
    for (int s = 0; s < 32; ++s) acc = __builtin_amdgcn_mfma_f32_16x16x32_bf16(*(const bf16x8*)(ap + 32 * s), *(const bf16x8*)(bp + 32 * s), acc, 0, 0, 0);
    LAS float* gaP = (LAS float*)C.lds;
#pragma unroll
    for (int r = 0; r < 4; ++r) gaP[kh * 1024 + (16 * rt + 4 * fq + r) * 16 + fr] = acc[r];
    __syncthreads();
    const int t = C.tid; float wc[16];
#pragma unroll
    for (int r = 0; r < 16; ++r) wc[r] = C.w_a2[r * 512 + t];
    const float ba = C.b_a[t]; float cum = 0.f; float* bo = C.BCUM + t0 * 512 + t;
#pragma unroll 4
    for (int tok = 0; tok < 64; ++tok) {
        const LAS f32x4* g0 = (const LAS f32x4*)(gaP + tok * 16); const LAS f32x4* g1 = (const LAS f32x4*)(gaP + 1024 + tok * 16); float z = ba;
#pragma unroll
        for (int q = 0; q < 4; ++q) { const f32x4 gv = g0[q] + g1[q]; z += gv.x * wc[4 * q] + gv.y * wc[4 * q + 1] + gv.z * wc[4 * q + 2] + gv.w * wc[4 * q + 3]; }
        cum += (fminf(z, 0.f) - log1pf(__expf(-fabsf(z)))) * 0.0625f;
        bo[(size_t)tok * 512] = cum;
    }
    __syncthreads();
}
__device__ __forceinline__ void moba_prep_item(const Ctx& C, int b, int h, int blk) {
    const int lane = C.lane, w = C.wave, i = lane & 15, tg = lane >> 4; const size_t t0 = (size_t)b * SEQ + 256 * blk;
    float qg[8], kg[8], km[8];
#pragma unroll
    for (int j = 0; j < 8; ++j) { qg[j] = C.qg[8 * i + j]; kg[j] = C.kg[8 * i + j]; km[j] = 0.f; }
    for (int it = 0; it < 8; ++it) {
        const size_t tok = t0 + 32 * w + 4 * it + tg;
        float cs[16];
        if (i < 4) { const f32x4* cp = (const f32x4*)(C.CS + tok * 32 + (i & 1) * 16);
#pragma unroll
            for (int q = 0; q < 4; ++q) { const f32x4 v = cp[q]; cs[4 * q] = v.x; cs[4 * q + 1] = v.y; cs[4 * q + 2] = v.z; cs[4 * q + 3] = v.w; } }
        else {
#pragma unroll
            for (int q = 0; q < 16; ++q) cs[q] = 0.f; }
#pragma unroll
        for (int which = 0; which < 2; ++which) {
            bf16* p = C.PROJ + tok * NPROJ + (which ? MK : MQ) + h * 128 + 8 * i;
            const v4u raw = *(const v4u*)p; float xv[8];
            xv[0] = bflo(raw.x); xv[1] = bfhi(raw.x); xv[2] = bflo(raw.y); xv[3] = bfhi(raw.y); xv[4] = bflo(raw.z); xv[5] = bfhi(raw.z); xv[6] = bflo(raw.w); xv[7] = bfhi(raw.w);
            float ss = 0.f;
#pragma unroll
            for (int j = 0; j < 8; ++j) ss += xv[j] * xv[j];
            ss += __shfl_xor(ss, 1); ss += __shfl_xor(ss, 2); ss += __shfl_xor(ss, 4); ss += __shfl_xor(ss, 8);
            const float rstd = rsqrtf(ss * (1.f / 128.f) + EPS);
#pragma unroll
            for (int j = 0; j < 8; ++j) xv[j] = xv[j] * rstd * (which ? kg[j] : qg[j]);
#pragma unroll
            for (int j = 0; j < 8; ++j) { const float o = __shfl_xor(xv[j], 2); const float cv = cs[2 * j], sv = cs[2 * j + 1];
                if (i < 2) xv[j] = xv[j] * cv - o * sv; else if (i < 4) xv[j] = xv[j] * cv + o * sv; }
            v4u o; o.x = pk2(xv[0], xv[1]); o.y = pk2(xv[2], xv[3]); o.z = pk2(xv[4], xv[5]); o.w = pk2(xv[6], xv[7]);
            *(v4u*)p = o;
            if (which) {
#pragma unroll
                for (int j = 0; j < 8; ++j) km[j] += xv[j]; }
        }
    }
    LAS float* red = (LAS float*)C.lds;
#pragma unroll
    for (int j = 0; j < 8; ++j) { km[j] += __shfl_xor(km[j], 16); km[j] += __shfl_xor(km[j], 32); }
    if (lane < 16) {
#pragma unroll
        for (int j = 0; j < 8; ++j) red[w * 128 + 8 * i + j] = km[j]; }
    __syncthreads();
    if (C.tid < 128) { float s = 0.f;
#pragma unroll
        for (int ww = 0; ww < 8; ++ww) s += red[ww * 128 + C.tid];
        C.KMEAN[((size_t)(b * NH + h) * 16 + blk) * 128 + C.tid] = s * (1.f / 256.f); }
    __syncthreads();
}

constexpr int KP = 272, VP = 320;
constexpr int MB_K0 = 0, MB_V0 = 2 * 64 * KP, MB_END = MB_V0 + 2 * 64 * VP;
__device__ __forceinline__ void moba_unit(const Ctx& C, int b, int h, int qb) {
    const int tid = C.tid, lane = C.lane, w = C.wave, r = lane & 31, hh = lane >> 5;
    const size_t tb = (size_t)b * SEQ; const int q0 = qb * 256;
    const bf16* Qh = C.PROJ + MQ + h * 128; const bf16* Kh = C.PROJ + MK + h * 128; const bf16* Vh = C.PROJ + MV + h * 128;
    bf16x8 qf[8];
    { const bf16* qrow = Qh + (tb + q0 + 32 * w + r) * NPROJ + 8 * hh;
#pragma unroll
      for (int s = 0; s < 8; ++s) qf[s] = *(const bf16x8*)(qrow + 16 * s); }
    unsigned selmask = 0u;
    { float g0 = -INFINITY, g1 = -INFINITY, g2 = -INFINITY; int i0 = -1, i1 = -1, i2 = -1;
      const float* km = C.KMEAN + ((size_t)(b * NH + h) * 16) * 128 + 8 * hh;
      for (int j = 0; j < qb; ++j) {
          float acc = 0.f;
#pragma unroll
          for (int s = 0; s < 8; ++s) { const f32x4 k0 = *(const f32x4*)(km + j * 128 + 16 * s), k1 = *(const f32x4*)(km + j * 128 + 16 * s + 4);
              acc += bf1(qf[s][0]) * k0.x + bf1(qf[s][1]) * k0.y + bf1(qf[s][2]) * k0.z + bf1(qf[s][3]) * k0.w + bf1(qf[s][4]) * k1.x + bf1(qf[s][5]) * k1.y + bf1(qf[s][6]) * k1.z + bf1(qf[s][7]) * k1.w; }
          acc += __shfl_xor(acc, 32);
          if (acc > g0) { g2 = g1; i2 = i1; g1 = g0; i1 = i0; g0 = acc; i0 = j; }
          else if (acc > g1) { g2 = g1; i2 = i1; g1 = acc; i1 = j; }
          else if (acc > g2) { g2 = acc; i2 = j; }
      }
      if (i0 >= 0) selmask |= 1u << i0; if (i1 >= 0) selmask |= 1u << i1; if (i2 >= 0) selmask |= 1u << i2; }
    const int NT = 4 * (qb + 1);
    v4u kr[2], vr[2];
#define MB_LOAD(i) do { const int blk_ = (i) < 4 ? qb : ((i) - 4) >> 2; const size_t ks_ = tb + blk_ * 256 + 64 * ((i) & 3); _Pragma("unroll") for (int pp = 0; pp < 2; ++pp) { const int p_ = tid + 512 * pp; \
        kr[pp] = *(const v4u*)(Kh + (ks_ + (p_ >> 4)) * NPROJ + 8 * (p_ & 15)); vr[pp] = *(const v4u*)(Vh + (ks_ + (p_ >> 4)) * NPROJ + 8 * (p_ & 15)); } } while (0)
#define MB_STORE(buf) do { _Pragma("unroll") for (int pp = 0; pp < 2; ++pp) { const int p_ = tid + 512 * pp; \
        *(LAS v4u*)(C.lds + MB_K0 + (buf) * 64 * KP + (p_ >> 4) * KP + 16 * (p_ & 15)) = kr[pp]; *(LAS v4u*)(C.lds + MB_V0 + (buf) * 64 * VP + (p_ >> 4) * VP + 16 * (p_ & 15)) = vr[pp]; } } while (0)
    MB_LOAD(0); MB_STORE(0); __syncthreads();
    float m_run = -1e30f, l_run = 0.f; f32x16 o[4];
#pragma unroll
    for (int dt = 0; dt < 4; ++dt)
#pragma unroll
        for (int q = 0; q < 16; ++q) o[dt][q] = 0.f;
    const float c2 = 0.08838834764831845f * 1.4426950408889634f;
    for (int i = 0; i < NT; ++i) {
        if (i + 1 < NT) MB_LOAD(i + 1);
        const int buf = i & 1; const bool own = i < 4; const int tt = i & 3, blk = own ? qb : (i - 4) >> 2;
        const bool mine = own || ((selmask >> blk) & 1u);
        const bool need = own ? (64 * tt <= 32 * w + 31) : (__ballot(mine) != 0ull);
        if (need) {
            const LAS unsigned char* kb = C.lds + MB_K0 + buf * 64 * KP + r * KP + 16 * hh;
            f32x16 p0, p1;
#pragma unroll
            for (int q = 0; q < 16; ++q) { p0[q] = 0.f; p1[q] = 0.f; }
#pragma unroll
            for (int s = 0; s < 8; ++s) { const bf16x8 a0 = *(const LAS bf16x8*)(kb + 32 * s), a1 = *(const LAS bf16x8*)(kb + 32 * KP + 32 * s);
                p0 = MFMA32(a0, qf[s], p0); p1 = MFMA32(a1, qf[s], p1); }
            if (own) { const int qi = 32 * w + r;
#pragma unroll
                for (int q = 0; q < 16; ++q) { const int kk = 64 * tt + crow(q, hh); if (kk > qi) p0[q] = -INFINITY; if (kk + 32 > qi) p1[q] = -INFINITY; } }
            else if (!mine) {
#pragma unroll
                for (int q = 0; q < 16; ++q) { p0[q] = -INFINITY; p1[q] = -INFINITY; } }
            float mx = fmaxf(p0[0], p1[0]);
#pragma unroll
            for (int q = 1; q < 16; ++q) mx = fmaxf(mx, fmaxf(p0[q], p1[q]));
            mx = fmaxf(mx, __shfl_xor(mx, 32));
            const float m_new = fmaxf(m_run, mx * c2), alpha = __builtin_amdgcn_exp2f(m_run - m_new);
            m_run = m_new; float rs = 0.f;
#pragma unroll
            for (int q = 0; q < 16; ++q) { p0[q] = __builtin_amdgcn_exp2f(p0[q] * c2 - m_new); p1[q] = __builtin_amdgcn_exp2f(p1[q] * c2 - m_new); rs += p0[q] + p1[q]; }
            l_run = l_run * alpha + rs;
#pragma unroll
            for (int dt = 0; dt < 4; ++dt)
#pragma unroll
                for (int q = 0; q < 16; ++q) o[dt][q] *= alpha;
            bf16x8 pf[4];
            pf[0] = pack8(p0[0], p0[1], p0[2], p0[3], p0[4], p0[5], p0[6], p0[7]); pf[1] = pack8(p0[8], p0[9], p0[10], p0[11], p0[12], p0[13], p0[14], p0[15]);
            pf[2] = pack8(p1[0], p1[1], p1[2], p1[3], p1[4], p1[5], p1[6], p1[7]); pf[3] = pack8(p1[8], p1[9], p1[10], p1[11], p1[12], p1[13], p1[14], p1[15]);
            const LAS unsigned char* vb = C.lds + MB_V0 + buf * 64 * VP + (4 * hh + ((lane & 15) >> 2)) * VP + (16 * ((lane >> 4) & 1) + 4 * (lane & 3)) * 2;
#pragma unroll
            for (int kk = 0; kk < 4; ++kk)
#pragma unroll
                for (int dt = 0; dt < 4; ++dt) { const s16x4 lo = vtr(vb + (16 * kk) * VP + dt * 64), hi = vtr(vb + (16 * kk + 8) * VP + dt * 64); o[dt] = MFMA32(cat4(lo, hi), pf[kk], o[dt]); }
        }
        if (i + 1 < NT) MB_STORE((i + 1) & 1);
        __syncthreads();
    }
#undef MB_LOAD
#undef MB_STORE
    l_run += __shfl_xor(l_run, 32);
    const float inv = 1.f / l_run;
    bf16* op = C.CONCAT + (tb + q0 + 32 * w + r) * D + 1024 + h * 128 + 4 * hh;
#pragma unroll
    for (int dt = 0; dt < 4; ++dt)
#pragma unroll
        for (int k4 = 0; k4 < 4; ++k4) { v2u wv; wv.x = pk2(o[dt][4 * k4] * inv, o[dt][4 * k4 + 1] * inv); wv.y = pk2(o[dt][4 * k4 + 2] * inv, o[dt][4 * k4 + 3] * inv); *(v2u*)(op + 32 * dt + 8 * k4) = wv; }
}

constexpr int GKP = 192;
__device__ __forceinline__ void gla_v_to_lds(const Ctx& C, size_t t0, int h, int off) {
#pragma unroll
    for (int pp = 0; pp < 2; ++pp) { const int p = C.tid + 512 * pp; const v4u v = *(const v4u*)(C.PROJ + (t0 + (p >> 4)) * NPROJ + GV + h * 128 + 8 * (p & 15)); *(LAS v4u*)(C.lds + off + (p >> 4) * VP + 16 * (p & 15)) = v; }
}
__device__ __forceinline__ void gla_u_item(const Ctx& C, int b, int h, int n) {
    const int tid = C.tid, lane = C.lane, w = C.wave, r = lane & 31, hh = lane >> 5; const size_t t0 = (size_t)b * SEQ + 64 * n; const int bhn = (b * NH + h) * 64 + n;
    constexpr int KT = 0, VT = 64 * GKP;
    { const int tok = tid >> 3, ch = tid & 7;
      const v4u raw = *(const v4u*)(C.PROJ + (t0 + tok) * NPROJ + GK + h * 64 + 8 * ch);
      const f32x4* bp = (const f32x4*)(C.BCUM + (t0 + tok) * 512 + h * 64 + 8 * ch); const f32x4* bl = (const f32x4*)(C.BCUM + (t0 + 63) * 512 + h * 64 + 8 * ch);
      const f32x4 b0 = bp[0], b1 = bp[1], l0 = bl[0], l1 = bl[1];
      const bf16x8 kv = pack8(bflo(raw.x) * __expf(l0.x - b0.x), bfhi(raw.x) * __expf(l0.y - b0.y), bflo(raw.y) * __expf(l0.z - b0.z), bfhi(raw.y) * __expf(l0.w - b0.w),
                              bflo(raw.z) * __expf(l1.x - b1.x), bfhi(raw.z) * __expf(l1.y - b1.y), bflo(raw.w) * __expf(l1.z - b1.z), bfhi(raw.w) * __expf(l1.w - b1.w));
      *(LAS bf16x8*)(C.lds + KT + tok * GKP + 16 * ch) = kv;
      if (tok == 63) { f32x4* dp = (f32x4*)(C.DEC + (size_t)bhn * 64 + 8 * ch); dp[0] = (f32x4){__expf(l0.x), __expf(l0.y), __expf(l0.z), __expf(l0.w)}; dp[1] = (f32x4){__expf(l1.x), __expf(l1.y), __expf(l1.z), __expf(l1.w)}; } }
    gla_v_to_lds(C, t0, h, VT);
    __syncthreads();
    const int mt = w & 3, nt = w >> 2, q = (lane & 15) >> 2, cb = (16 * ((lane >> 4) & 1) + 4 * (lane & 3)) * 2;
    const LAS unsigned char* va = C.lds + VT + (4 * hh + q) * VP + cb + mt * 64; const LAS unsigned char* ka = C.lds + KT + (4 * hh + q) * GKP + cb + nt * 64;
    f32x16 acc;
#pragma unroll
    for (int i = 0; i < 16; ++i) acc[i] = 0.f;
#pragma unroll
    for (int s = 0; s < 4; ++s) acc = MFMA32(cat4(vtr(va + 16 * s * VP), vtr(va + (16 * s + 8) * VP)), cat4(vtr(ka + 16 * s * GKP), vtr(ka + (16 * s + 8) * GKP)), acc);
    float* up = C.UT + (size_t)bhn * 8192 + (32 * mt) * 64 + 32 * nt + r;
#pragma unroll
    for (int i = 0; i < 16; ++i) up[crow(i, hh) * 64] = acc[i];
    __syncthreads();
}
__device__ __forceinline__ void p4_phase(const Ctx& C, int rep) {
    volatile LAS int* qslot = (volatile LAS int*)(C.lds + MISC_OFF + 64);
    for (;;) {
        __syncthreads();
        if (C.tid == 0) *qslot = (int)atomicAdd(C.ctl + CW_Q + 64 * rep, 1u);
        __syncthreads();
        const int id = *qslot;
        if (id >= 256 + 1024) break;
        if (id < 256) moba_unit(C, (id & 15) >> 3, id & 7, 15 - (id >> 4));
        else { const int g = id - 256; gla_u_item(C, g >> 9, (g >> 6) & 7, g & 63); }
    }
}

__device__ __forceinline__ void p5_phase(const Ctx& C) {
    for (int idx = C.vcu * NTHREADS + C.tid; idx < 16 * 8192; idx += C.G * NTHREADS) {
        const int bh = idx >> 13, rem = idx & 8191, dk = rem & 63; float s = 0.f;
        const float* up = C.UT + (size_t)bh * 64 * 8192 + rem; const float* dp = C.DEC + (size_t)bh * 64 * 64 + dk; bf16* sp = C.ST + (size_t)bh * 64 * 8192 + rem;
#pragma unroll 16
        for (int n = 0; n < 64; ++n) { sp[(size_t)n * 8192] = (bf16)(pk2(s, 0.f) & 0xffffu); s = dp[n * 64] * s + up[(size_t)n * 8192]; }
    }
}

__device__ __forceinline__ void gla_out_item(const Ctx& C, int b, int h, int n) {
    const int lane = C.lane, w = C.wave, r = lane & 31, hh = lane >> 5, dvt = w & 3, lt = w >> 2; const size_t t0 = (size_t)b * SEQ + 64 * n; const int bhn = (b * NH + h) * 64 + n;
    constexpr int VT = 0, RED = 64 * VP;
    gla_v_to_lds(C, t0, h, VT);
    bf16x8 qd[4];
    { const size_t tl = t0 + 32 * lt + r;
#pragma unroll
      for (int s = 0; s < 4; ++s) { const v4u raw = *(const v4u*)(C.PROJ + tl * NPROJ + GQ + h * 64 + 16 * s + 8 * hh); const f32x4* bp = (const f32x4*)(C.BCUM + tl * 512 + h * 64 + 16 * s + 8 * hh); const f32x4 b0 = bp[0], b1 = bp[1];
          qd[s] = pack8(bflo(raw.x) * 0.125f * __expf(b0.x), bfhi(raw.x) * 0.125f * __expf(b0.y), bflo(raw.y) * 0.125f * __expf(b0.z), bfhi(raw.y) * 0.125f * __expf(b0.w),
                        bflo(raw.z) * 0.125f * __expf(b1.x), bfhi(raw.z) * 0.125f * __expf(b1.y), bflo(raw.w) * 0.125f * __expf(b1.z), bfhi(raw.w) * 0.125f * __expf(b1.w)); } }
    __syncthreads();
    f32x16 o;
#pragma unroll
    for (int i = 0; i < 16; ++i) o[i] = 0.f;
    const LAS unsigned char* va = C.lds + VT + (4 * hh + ((lane & 15) >> 2)) * VP + (16 * ((lane >> 4) & 1) + 4 * (lane & 3)) * 2 + dvt * 64;
    for (int mt = 0; mt <= lt; ++mt) {
        const size_t tm = t0 + 32 * mt + r; f32x16 X;
#pragma unroll
        for (int i = 0; i < 16; ++i) X[i] = 0.f;
#pragma unroll
        for (int s = 0; s < 4; ++s) { const v4u raw = *(const v4u*)(C.PROJ + tm * NPROJ + GK + h * 64 + 16 * s + 8 * hh); const f32x4* bp = (const f32x4*)(C.BCUM + tm * 512 + h * 64 + 16 * s + 8 * hh); const f32x4 b0 = bp[0], b1 = bp[1];
            const bf16x8 kd = pack8(bflo(raw.x) * __expf(-b0.x), bfhi(raw.x) * __expf(-b0.y), bflo(raw.y) * __expf(-b0.z), bfhi(raw.y) * __expf(-b0.w),
                                    bflo(raw.z) * __expf(-b1.x), bfhi(raw.z) * __expf(-b1.y), bflo(raw.w) * __expf(-b1.z), bfhi(raw.w) * __expf(-b1.w));
            X = MFMA32(kd, qd[s], X); }
        if (mt == lt) {
#pragma unroll
            for (int i = 0; i < 16; ++i) if (crow(i, hh) > r) X[i] = 0.f; }
        const bf16x8 pf0 = pack8(X[0], X[1], X[2], X[3], X[4], X[5], X[6], X[7]), pf1 = pack8(X[8], X[9], X[10], X[11], X[12], X[13], X[14], X[15]);
        o = MFMA32(cat4(vtr(va + (32 * mt) * VP), vtr(va + (32 * mt + 8) * VP)), pf0, o);
        o = MFMA32(cat4(vtr(va + (32 * mt + 16) * VP), vtr(va + (32 * mt + 24) * VP)), pf1, o);
    }
    { const bf16* sp = C.ST + (size_t)bhn * 8192 + (32 * dvt + r) * 64 + 8 * hh;
#pragma unroll
      for (int s = 0; s < 4; ++s) o = MFMA32(*(const bf16x8*)(sp + 16 * s), qd[s], o); }
    float ss = 0.f;
#pragma unroll
    for (int i = 0; i < 16; ++i) ss += o[i] * o[i];
    ss += __shfl_xor(ss, 32);
    LAS float* red = (LAS float*)(C.lds + RED);
    if (hh == 0) red[dvt * 64 + 32 * lt + r] = ss;
    __syncthreads();
    const int l = 32 * lt + r; const float rstd = rsqrtf((red[l] + red[64 + l] + red[128 + l] + red[192 + l]) * (1.f / 128.f) + EPS);
    const size_t tl = t0 + l;
#pragma unroll
    for (int k4 = 0; k4 < 4; ++k4) { const int d0 = 32 * dvt + 8 * k4 + 4 * hh;
        const v2u graw = *(const v2u*)(C.PROJ + tl * NPROJ + GG + h * 128 + d0); const f32x4 gn = *(const f32x4*)(C.gla_g + d0);
        const float ga = bflo(graw.x), gb = bfhi(graw.x), gc = bflo(graw.y), gd = bfhi(graw.y);
        const float y0 = o[4 * k4] * rstd * gn.x * (ga / (1.f + __expf(-ga))), y1 = o[4 * k4 + 1] * rstd * gn.y * (gb / (1.f + __expf(-gb)));
        const float y2 = o[4 * k4 + 2] * rstd * gn.z * (gc / (1.f + __expf(-gc))), y3 = o[4 * k4 + 3] * rstd * gn.w * (gd / (1.f + __expf(-gd)));
        v2u wv; wv.x = pk2(y0, y1); wv.y = pk2(y2, y3); *(v2u*)(C.CONCAT + tl * D + h * 128 + d0) = wv; }
    __syncthreads();
}

#define INS16(L, xin) do { int x_ = (xin); _Pragma("unroll") for (int i_ = 0; i_ < 16; ++i_) { const int hi_ = max(L[i_], x_); x_ = min(L[i_], x_); L[i_] = hi_; } } while (0)
__device__ __forceinline__ int ord_key(float v) { int u = __float_as_int(v); return u ^ ((u >> 31) & 0x7fffffff); }
__device__ __forceinline__ float ord_val(int k, int mask) { int u = k & ~mask; return __int_as_float(u ^ ((u >> 31) & 0x7fffffff)); }
__device__ __forceinline__ void peer_topk_item(const Ctx& C, int tg, int hd) {
    const int lane = C.lane, r = lane & 31, hh = lane >> 5; const size_t tok = (size_t)tg * 32 + r;
    int La[16], Lb[16];
#pragma unroll
    for (int c = 0; c < 2; ++c) {
        int L[16];
#pragma unroll
        for (int i = 0; i < 16; ++i) L[i] = (int)0x80000000;
        bf16x8 qf[8];
        { const float* qp = C.QP + tok * D + hd * 256 + c * 128 + 8 * hh;
#pragma unroll
          for (int s = 0; s < 8; ++s) { const f32x4 a = *(const f32x4*)(qp + 16 * s), bq = *(const f32x4*)(qp + 16 * s + 4); qf[s] = pack8(a.x, a.y, a.z, a.w, bq.x, bq.y, bq.z, bq.w); } }
#pragma unroll 1
        for (int kt = 0; kt < 4; ++kt) {
            const bf16* kp = C.KEYSB + ((size_t)(hd * 2 + c) * 128 + 32 * kt + r) * 128 + 8 * hh; f32x16 X;
#pragma unroll
            for (int i = 0; i < 16; ++i) X[i] = 0.f;
#pragma unroll
            for (int s = 0; s < 8; ++s) X = MFMA32(*(const bf16x8*)(kp + 16 * s), qf[s], X);
#pragma unroll
            for (int i = 0; i < 16; ++i) INS16(L, (ord_key(X[i]) & ~127) | (32 * kt + crow(i, hh)));
        }
        int M[16];
#pragma unroll
        for (int i = 0; i < 16; ++i) M[i] = __shfl_xor(L[i], 32);
#pragma unroll
        for (int i = 0; i < 16; ++i) INS16(L, M[i]);
#pragma unroll
        for (int i = 0; i < 16; ++i) { if (c == 0) La[i] = L[i]; else Lb[i] = L[i]; }
    }
    float sa[16], sb[16]; int Lc[16];
#pragma unroll
    for (int i = 0; i < 16; ++i) { sa[i] = ord_val(La[i], 127); sb[i] = ord_val(Lb[i], 127); Lc[i] = (int)0x80000000; }
#pragma unroll
    for (int i = 0; i < 16; ++i)
#pragma unroll
        for (int j = 0; j < 16; ++j) if ((i + 1) * (j + 1) <= 16) INS16(Lc, (ord_key(sa[i] + sb[j]) & ~255) | (i * 16 + j));
    float e[16], sum = 0.f; int ex[16]; const float mx = ord_val(Lc[0], 255);
#pragma unroll
    for (int i = 0; i < 16; ++i) {
        e[i] = __expf(ord_val(Lc[i], 255) - mx); sum += e[i];
        const int ii = (Lc[i] >> 4) & 15, jj = Lc[i] & 15; int i1 = 0, i2 = 0;
#pragma unroll
        for (int q = 0; q < 16; ++q) { i1 = (ii == q) ? (La[q] & 127) : i1; i2 = (jj == q) ? (Lb[q] & 127) : i2; }
        ex[i] = i1 * 128 + i2;
    }
    const float inv = 1.f / sum;
    if (hh == 0) {
        v4u* ep = (v4u*)(C.EXPI + tok * 128 + hd * 16); f32x4* gp = (f32x4*)(C.GATE + tok * 128 + hd * 16); f32x4* up = (f32x4*)(C.GU + tok * 128 + hd * 16); v4u* ap = (v4u*)(C.ACT + tok * 128 + hd * 16);
        const float hs = C.HS[tok];
#pragma unroll
        for (int q = 0; q < 4; ++q) { ep[q] = (v4u){(unsigned)ex[4 * q], (unsigned)ex[4 * q + 1], (unsigned)ex[4 * q + 2], (unsigned)ex[4 * q + 3]};
            gp[q] = (f32x4){e[4 * q] * inv * C.VS[ex[4 * q]], e[4 * q + 1] * inv * C.VS[ex[4 * q + 1]], e[4 * q + 2] * inv * C.VS[ex[4 * q + 2]], e[4 * q + 3] * inv * C.VS[ex[4 * q + 3]]};
            up[q] = (f32x4){hs * C.US[ex[4 * q]], hs * C.US[ex[4 * q + 1]], hs * C.US[ex[4 * q + 2]], hs * C.US[ex[4 * q + 3]]};
            ap[q] = (v4u){0u, 0u, 0u, 0u}; }
    }
}

__device__ __forceinline__ int peer_dequeue(const Ctx& C, unsigned* cnt, int xcc) {
    volatile LAS int* slot = (volatile LAS int*)(C.lds + MISC_OFF + 64);
    __syncthreads();
    if (C.tid == 0) { int res = -1;
        for (int s = 0; s < NSL; ++s) { const int sl = (xcc + s) & (NSL - 1);
            if (__hip_atomic_load(cnt + 64 * sl, __ATOMIC_RELAXED, __HIP_MEMORY_SCOPE_AGENT) >= (unsigned)NCHUNK) continue;
            const unsigned id = atomicAdd(cnt + 64 * sl, 1u); if (id < (unsigned)NCHUNK) { res = sl * NCHUNK + (int)id; break; } }
        *slot = res; }
    __syncthreads();
    return *slot;
}
#define ROWSUM16(d) do { d += __builtin_amdgcn_update_dpp(0, d, 0x121, 0xf, 0xf, false); d += __builtin_amdgcn_update_dpp(0, d, 0x122, 0xf, 0xf, false); \
                         d += __builtin_amdgcn_update_dpp(0, d, 0x124, 0xf, 0xf, false); d += __builtin_amdgcn_update_dpp(0, d, 0x128, 0xf, 0xf, false); } while (0)
__device__ __forceinline__ void peer_a_token(const Ctx& C, int t, int x) {
    const int lane = C.lane, i = lane & 15;
    const v4u hq = *(const v4u*)(C.HQ + ((size_t)x * T + t) * SLW + 16 * i);
    const int e_lo = C.EXPI[(size_t)t * 128 + lane], e_hi = C.EXPI[(size_t)t * 128 + 64 + lane];
    const unsigned char* tab = C.UQ + (size_t)x * NEXP * SLW + 16 * i;
    int r_lo = 0, r_hi = 0;
#define PA_STEP(src, dstv, j) do { const int e_ = __builtin_amdgcn_ds_swizzle(src, ((j) << 5) | 0x10); const v4u u_ = *(const v4u*)(tab + (size_t)e_ * SLW); \
        int d_ = __builtin_amdgcn_sdot4((int)hq.x, (int)u_.x, 0, false); d_ = __builtin_amdgcn_sdot4((int)hq.y, (int)u_.y, d_, false); d_ = __builtin_amdgcn_sdot4((int)hq.z, (int)u_.z, d_, false); d_ = __builtin_amdgcn_sdot4((int)hq.w, (int)u_.w, d_, false); \
        ROWSUM16(d_); dstv = (i == (j)) ? d_ : dstv; } while (0)
    PA_STEP(e_lo, r_lo, 0); PA_STEP(e_lo, r_lo, 1); PA_STEP(e_lo, r_lo, 2); PA_STEP(e_lo, r_lo, 3); PA_STEP(e_lo, r_lo, 4); PA_STEP(e_lo, r_lo, 5); PA_STEP(e_lo, r_lo, 6); PA_STEP(e_lo, r_lo, 7);
    PA_STEP(e_lo, r_lo, 8); PA_STEP(e_lo, r_lo, 9); PA_STEP(e_lo, r_lo, 10); PA_STEP(e_lo, r_lo, 11); PA_STEP(e_lo, r_lo, 12); PA_STEP(e_lo, r_lo, 13); PA_STEP(e_lo, r_lo, 14); PA_STEP(e_lo, r_lo, 15);
    PA_STEP(e_hi, r_hi, 0); PA_STEP(e_hi, r_hi, 1); PA_STEP(e_hi, r_hi, 2); PA_STEP(e_hi, r_hi, 3); PA_STEP(e_hi, r_hi, 4); PA_STEP(e_hi, r_hi, 5); PA_STEP(e_hi, r_hi, 6); PA_STEP(e_hi, r_hi, 7);
    PA_STEP(e_hi, r_hi, 8); PA_STEP(e_hi, r_hi, 9); PA_STEP(e_hi, r_hi, 10); PA_STEP(e_hi, r_hi, 11); PA_STEP(e_hi, r_hi, 12); PA_STEP(e_hi, r_hi, 13); PA_STEP(e_hi, r_hi, 14); PA_STEP(e_hi, r_hi, 15);
#undef PA_STEP
    atomicAdd(C.ACT + (size_t)t * 128 + lane, r_lo); atomicAdd(C.ACT + (size_t)t * 128 + 64 + lane, r_hi);
}
__device__ __forceinline__ float sum_swap16(float v) { auto r = __builtin_amdgcn_permlane16_swap(__float_as_uint(v), __float_as_uint(v), false, false); return __uint_as_float(r[0]) + __uint_as_float(r[1]); }
__device__ __forceinline__ float sum_swap32(float v) { auto r = __builtin_amdgcn_permlane32_swap(__float_as_uint(v), __float_as_uint(v), false, false); return __uint_as_float(r[0]) + __uint_as_float(r[1]); }
__device__ __forceinline__ void peer_b_token(const Ctx& C, int t, int x, float* dst) {
    const int lane = C.lane, i = lane & 15, g = lane >> 4, b = t / SEQ;
    const int e_lo = C.EXPI[(size_t)t * 128 + lane], e_hi = C.EXPI[(size_t)t * 128 + 64 + lane];
    const float a_lo = (float)C.ACT[(size_t)t * 128 + lane] * C.GU[(size_t)t * 128 + lane], a_hi = (float)C.ACT[(size_t)t * 128 + 64 + lane] * C.GU[(size_t)t * 128 + 64 + lane];
    const float w_lo = C.GATE[(size_t)t * 128 + lane] * 0.5f * a_lo * (1.f + erff(a_lo * 0.70710678118654752f)), w_hi = C.GATE[(size_t)t * 128 + 64 + lane] * 0.5f * a_hi * (1.f + erff(a_hi * 0.70710678118654752f));
    const unsigned char* tab = C.VQ + (size_t)x * NEXP * SLW + 16 * i;
    float acc[16], sw = 0.f;
#pragma unroll
    for (int q = 0; q < 16; ++q) acc[q] = 0.f;
#define PB_BYTES(word, base, w_) do { acc[(base)] += (w_) * (float)((word) & 0xffu); acc[(base) + 1] += (w_) * (float)(((word) >> 8) & 0xffu); acc[(base) + 2] += (w_) * (float)(((word) >> 16) & 0xffu); acc[(base) + 3] += (w_) * (float)((word) >> 24); } while (0)
#define PB_STEP(esrc, wsrc, j) do { const int e_ = __builtin_amdgcn_ds_swizzle(esrc, ((j) << 5) | 0x10); const float w_ = __int_as_float(__builtin_amdgcn_ds_swizzle(__float_as_int(wsrc), ((j) << 5) | 0x10)); \
        const v4u v_ = *(const v4u*)(tab + (size_t)e_ * SLW); sw += w_; PB_BYTES(v_.x, 0, w_); PB_BYTES(v_.y, 4, w_); PB_BYTES(v_.z, 8, w_); PB_BYTES(v_.w, 12, w_); } while (0)
    PB_STEP(e_lo, w_lo, 0); PB_STEP(e_lo, w_lo, 1); PB_STEP(e_lo, w_lo, 2); PB_STEP(e_lo, w_lo, 3); PB_STEP(e_lo, w_lo, 4); PB_STEP(e_lo, w_lo, 5); PB_STEP(e_lo, w_lo, 6); PB_STEP(e_lo, w_lo, 7);
    PB_STEP(e_lo, w_lo, 8); PB_STEP(e_lo, w_lo, 9); PB_STEP(e_lo, w_lo, 10); PB_STEP(e_lo, w_lo, 11); PB_STEP(e_lo, w_lo, 12); PB_STEP(e_lo, w_lo, 13); PB_STEP(e_lo, w_lo, 14); PB_STEP(e_lo, w_lo, 15);
    PB_STEP(e_hi, w_hi, 0); PB_STEP(e_hi, w_hi, 1); PB_STEP(e_hi, w_hi, 2); PB_STEP(e_hi, w_hi, 3); PB_STEP(e_hi, w_hi, 4); PB_STEP(e_hi, w_hi, 5); PB_STEP(e_hi, w_hi, 6); PB_STEP(e_hi, w_hi, 7);
    PB_STEP(e_hi, w_hi, 8); PB_STEP(e_hi, w_hi, 9); PB_STEP(e_hi, w_hi, 10); PB_STEP(e_hi, w_hi, 11); PB_STEP(e_hi, w_hi, 12); PB_STEP(e_hi, w_hi, 13); PB_STEP(e_hi, w_hi, 14); PB_STEP(e_hi, w_hi, 15);
#undef PB_STEP
#undef PB_BYTES
    sw = sum_swap32(sum_swap16(sw));
#pragma unroll
    for (int q = 0; q < 16; ++q) acc[q] = sum_swap32(sum_swap16(acc[q]));
    f32x4 o;
#pragma unroll
    for (int q = 0; q < 4; ++q) o[q] = (g == 0 ? acc[q] : g == 1 ? acc[4 + q] : g == 2 ? acc[8 + q] : acc[12 + q]) - 128.f * sw;
    const int d0 = x * SLW + 16 * i + 4 * g; const size_t off = (size_t)t * D + d0;
    const f32x4 x1 = *(const f32x4*)(C.out + off), gm = *(const f32x4*)(C.MOD + b * NMOD + 5 * D + d0);
    *(f32x4*)(dst + off) = x1 + gm * o;
}
template <int STAGE> __device__ __forceinline__ void peer_expert_phase(const Ctx& C, float* dst, int rep) {
    const int xcc = (int)(xb_xcc_id() & (NSL - 1)); unsigned* cnt = C.ctl + (STAGE == 0 ? CW_QA : CW_QB) + 64 * NSL * rep;
    for (;;) {
        const int id = peer_dequeue(C, cnt, xcc); if (id < 0) break;
        const int x = id / NCHUNK, t0 = (id % NCHUNK) * PCH + C.wave * (PCH / NWAVES);
        for (int tt = 0; tt < PCH / NWAVES; ++tt) { if (STAGE == 0) peer_a_token(C, t0 + tt, x); else peer_b_token(C, t0 + tt, x, dst); }
    }
}

struct Args { const void* in[18]; float* out; unsigned char* ws; int ph_lo, ph_hi; };
__global__ void __launch_bounds__(NTHREADS, 2) fwd_kernel(Args args) {
    extern __shared__ __attribute__((aligned(16))) unsigned char lds[];
    Ctx C;
    C.lds = (LAS unsigned char*)lds; C.tid = threadIdx.x; C.lane = C.tid & 63; C.wave = __builtin_amdgcn_readfirstlane(C.tid >> 6);
    C.G = gridDim.x; { const int bx = blockIdx.x; C.vcu = (C.G % 8 == 0) ? (bx % 8) * (C.G / 8) + bx / 8 : bx; }
    C.gw = C.vcu * NWAVES + C.wave; C.ngw = C.G * NWAVES;
    C.x = (const float*)args.in[0]; C.c = (const float*)args.in[1]; C.pos = (const int*)args.in[2]; C.w_ada = (const float*)args.in[3]; C.b_ada = (const float*)args.in[4]; C.g1 = (const float*)args.in[5];
    C.w_in = (const float*)args.in[6]; C.w_a2 = (const float*)args.in[7]; C.b_a = (const float*)args.in[8]; C.gla_g = (const float*)args.in[9]; C.qg = (const float*)args.in[10]; C.kg = (const float*)args.in[11];
    C.w_out = (const float*)args.in[12]; C.g2 = (const float*)args.in[13]; C.w_q = (const float*)args.in[14]; C.keys = (const float*)args.in[15]; C.pu = (const float*)args.in[16]; C.pv = (const float*)args.in[17];
    C.out = args.out; unsigned char* ws = args.ws;
    C.ctl = (unsigned*)(ws + WS_CTL); C.MODI = (long long*)(C.ctl + CW_MOD); C.MOD = (float*)(ws + WS_MODF);
    C.WIN = (bf16*)(ws + WS_WIN); C.WGA = (bf16*)(ws + WS_WGA); C.WOUT = (bf16*)(ws + WS_WOUT); C.WQ = (bf16*)(ws + WS_WQ); C.KEYSB = (bf16*)(ws + WS_KEYS); C.UQ = ws + WS_UB; C.VQ = ws + WS_VB; C.HQ = ws + WS_HQ; C.US = (float*)(ws + WS_US); C.VS = (float*)(ws + WS_VS); C.HS = (float*)(ws + WS_HS); C.GU = (float*)(ws + WS_GU); C.ACT = (int*)(ws + WS_ACT);
    C.H = (bf16*)(ws + WS_H); C.CONCAT = (bf16*)(ws + WS_CONCAT); C.PROJ = (bf16*)(ws + WS_PROJ); C.ST = (bf16*)(ws + WS_ST);
    C.CS = (float*)(ws + WS_CS); C.KMEAN = (float*)(ws + WS_KMEAN); C.DEC = (float*)(ws + WS_DEC); C.BCUM = (float*)(ws + WS_BCUM); C.UT = (float*)(ws + WS_UT); C.QP = (float*)(ws + WS_QP); C.GATE = (float*)(ws + WS_GATE); C.EXPI = (int*)(ws + WS_EXP);
    for (int u = C.tid; u < (LDS_BYTES - RING_BYTES) / 4; u += NTHREADS) ((LAS unsigned*)(C.lds + RING_BYTES))[u] = 0u;
    __syncthreads();
    const int lo = args.ph_lo, hi = args.ph_hi;
    XcdBarrier bar; bar.bar = C.ctl + CW_BAR; bar.x = 0; bar.st = nullptr;
    if (hi - lo > 1) bar = xcd_barrier_post(C.ctl + CW_BAR, (volatile LAS unsigned*)(C.lds + MISC_OFF) + 8);
#ifndef SKIPMASK
#define SKIPMASK 0
#endif
#ifndef REPEATMASK
#define REPEATMASK 0
#endif
#define IN(k) (!((SKIPMASK >> (k)) & 1) && lo <= (k) && (k) < hi)
#define REP(k) for (int rep_ = ((REPEATMASK >> (k)) & 1); rep_ >= 0; --rep_)
#define SEAM(k) do { if (IN(k) && IN((k) + 1)) xcd_barrier(bar); } while (0)
    if (IN(0)) REP(0) { p0_phase(C); } SEAM(0);
    if (IN(1)) REP(1) { norm_mod_phase<true>(C, C.x, C.g1, 0, D, C.H); } SEAM(1);
    if (IN(2)) REP(2) { pg8::Gemm g{C.H, C.WIN, T, NPROJ, D}; pg8::StaticOrder S; S.init(T, NPROJ, C.G, (int)blockIdx.x); pg8::EpiBf16<0> E{C.PROJ, NPROJ, nullptr, 0, 0, 1.f};
                 pg8::gemm_phase<pg8::EpiBf16<0>, pg8::StaticOrder, PG8_ALIGN, PG8_SP2>(C.lds, g, S, E); } SEAM(2);
    if (IN(3)) REP(3) { for (int it = C.vcu; it < 128 + 256; it += C.G) { if (it < 256) moba_prep_item(C, it >> 7, (it >> 4) & 7, it & 15); else gla_prep_item(C, (it - 256) >> 6, (it - 256) & 63); } } SEAM(3);
    if (IN(4)) REP(4) { p4_phase(C, rep_); } SEAM(4);
    if (IN(5)) REP(5) { p5_phase(C); } SEAM(5);
    if (IN(6)) REP(6) { for (int it = C.vcu; it < 1024; it += C.G) gla_out_item(C, it >> 9, (it >> 6) & 7, it & 63); } SEAM(6);
    if (IN(7)) REP(7) { pg8::Gemm g{C.CONCAT, C.WOUT, T, D, D}; pg8::StaticOrder S; S.init(T, D, C.G, (int)blockIdx.x); pg8::EpiResGate E{C.x, C.out, D, C.MOD + 2 * D, NMOD, SEQ / 256};
                 pg8::gemm_phase<pg8::EpiResGate, pg8::StaticOrder, PG8_ALIGN, PG8_SP2>(C.lds, g, S, E); } SEAM(7);
    if (IN(8)) REP(8) { norm_mod_phase<false>(C, C.out, C.g2, 3 * D, 4 * D, C.H); } SEAM(8);
    if (IN(9)) REP(9) { pg8::Gemm g{C.H, C.WQ, T, D, D}; pg8::StaticOrder S; S.init(T, D, C.G, (int)blockIdx.x); pg8::EpiF32 E{C.QP, D, nullptr};
                 pg8::gemm_phase<pg8::EpiF32, pg8::StaticOrder, PG8_ALIGN, PG8_SP2>(C.lds, g, S, E); } SEAM(9);
    if (IN(10)) REP(10) { for (int it = C.gw; it < 256 * 8; it += C.ngw) peer_topk_item(C, it >> 3, it & 7); } SEAM(10);
    if (IN(11)) { peer_expert_phase<0>(C, nullptr, 0); } SEAM(11);
    if (IN(12)) REP(12) { peer_expert_phase<1>(C, rep_ ? C.QP : C.out, rep_); }
#undef IN
#undef SEAM
}

extern "C" void kernel_launch(void* const* d_in, const int* in_sizes, int n_in, void* d_out, int out_size, void* d_ws, size_t ws_size, hipStream_t stream) {
    static int grid = 0;
    if (grid == 0) {
        if (n_in != 18 || in_sizes[0] != T * D || out_size != T * D || ws_size < WS_END) { fprintf(stderr, "kernel_launch: shape/workspace mismatch (n_in %d, in0 %d, out %d, ws %zu, need %zu); nothing launched\n", n_in, n_in > 0 ? in_sizes[0] : -1, out_size, ws_size, (size_t)WS_END); grid = -1; return; }
        int dev = 0, cus = 0, per_cu = 0;
        if (hipGetDevice(&dev) != hipSuccess || hipDeviceGetAttribute(&cus, hipDeviceAttributeMultiprocessorCount, dev) != hipSuccess) { fprintf(stderr, "kernel_launch: device query failed\n"); grid = -1; return; }
        if (hipFuncSetAttribute((const void*)fwd_kernel, hipFuncAttributeMaxDynamicSharedMemorySize, LDS_BYTES) != hipSuccess) { fprintf(stderr, "kernel_launch: hipFuncSetAttribute failed\n"); grid = -1; return; }
        if (hipOccupancyMaxActiveBlocksPerMultiprocessor(&per_cu, (const void*)fwd_kernel, NTHREADS, LDS_BYTES) != hipSuccess || per_cu < 1) { fprintf(stderr, "kernel_launch: occupancy query reports %d workgroups per CU\n", per_cu); (void)hipGetLastError(); grid = -1; return; }
        grid = cus;
    }
    if (grid < 0) return;
    if (hipMemsetAsync((char*)d_ws + WS_CTL, 0, CTL_ZERO_BYTES, stream) != hipSuccess) { fprintf(stderr, "kernel_launch: memset failed\n"); return; }
    Args a{};
    for (int i = 0; i < 18; ++i) a.in[i] = d_in[i];
    a.out = (float*)d_out; a.ws = (unsigned char*)d_ws;
#if MK_N_LAUNCHES == 1
    a.ph_lo = 0; a.ph_hi = N_PHASES;
    void* kargs[] = {&a};
    hipError_t le = hipLaunchCooperativeKernel((const void*)fwd_kernel, dim3(grid), dim3(NTHREADS), kargs, LDS_BYTES, stream);
    if (le != hipSuccess) fprintf(stderr, "kernel_launch: cooperative launch failed: %s (grid %d)\n", hipGetErrorName(le), grid);
#else
    for (int p = 0; p < N_PHASES; ++p) { a.ph_lo = p; a.ph_hi = p + 1; hipLaunchKernelGGL(fwd_kernel, dim3(grid), dim3(NTHREADS), LDS_BYTES, stream, a); }
#endif
}
```

```cpp
#define REPEATMASK 0
#include <hip/hip_runtime.h>
#include <hip/hip_bf16.h>
#include <cstdio>
#include <cstdint>
#include <cmath>
namespace pg8 {
#define PG8_LAS __attribute__((address_space(3)))
typedef unsigned short bf16_t;
typedef short bf16x8 __attribute__((ext_vector_type(8)));
typedef float f32x4 __attribute__((ext_vector_type(4)));
typedef unsigned u32x4 __attribute__((ext_vector_type(4)));
constexpr int BM = 256, BK = 64, HALF = 128, HTB = HALF * BK * 2  , STAGE_BYTES = 8 * HTB, NXCD = 8, WGM = 8;

__host__ __device__ __forceinline__ int lds_byte(int r, int c) { const int st = (r >> 4) * 2 + (c >> 5), rr = r & 15, cc = c & 31, ob = rr * 64 + cc * 2; return st * 1024 + (ob ^ (((ob >> 9) & 1) << 5)); }
__host__ __device__ __forceinline__ void stage_rc(int b, int& R, int& C) { const int st = b / 1024, sb = b % 1024, swz = sb ^ (((sb >> 9) & 1) << 5); R = (st >> 1) * 16 + swz / 64; C = (st & 1) * 32 + (swz % 64) / 2; }
__host__ __device__ __forceinline__ int perm32(int rho) { const int n = rho >> 4, i = rho & 15; return 8 * (i >> 2) + 4 * n + (i & 3); }

struct Unit { int pm, pn; };
struct Gemm { const bf16_t* A; const bf16_t* Bt; int M, N, K; };

struct StaticOrder {
    int nM, nN, nwg, G, c;
    __host__ __device__ void init(int M, int N, int G_, int c_) { nM = M / BM; nN = N / BM; nwg = nM * nN; G = G_; c = c_; }
    __host__ __device__ bool next(int i, Unit& u) const {
        const long L = (long)i * G + c; if (L >= nwg) return false;
        int wgid = (int)L; { const int q = nwg / NXCD, r = nwg % NXCD, xcd = wgid % NXCD, off = wgid / NXCD; wgid = (xcd < r ? xcd * (q + 1) : r * (q + 1) + (xcd - r) * q) + off; }
        const int nig = WGM * nN, gid = wgid / nig, fm = gid * WGM, gsz = (nM - fm) < WGM ? (nM - fm) : WGM;
        u.pm = fm + ((wgid % nig) % gsz); u.pn = (wgid % nig) / gsz; return true;
    }
    __device__ __forceinline__ void a_ready(const Unit&) const {}
    __device__ __forceinline__ void done(const Unit&) const {}
};

__device__ __forceinline__ unsigned cvt_pk_bf16(float lo, float hi) { unsigned r; asm volatile("v_cvt_pk_bf16_f32 %0, %1, %2" : "=v"(r) : "v"(lo), "v"(hi)); return r; }
typedef float f32x2 __attribute__((ext_vector_type(2)));
__device__ __forceinline__ f32x2 gelu_pk(f32x2 v) {
    const f32x2 av = __builtin_elementwise_abs(v), d = av * 0.2316418882f + 1.0f;
    f32x2 t; t.x = __builtin_amdgcn_rcpf(d.x); t.y = __builtin_amdgcn_rcpf(d.y);
    f32x2 q = t * 0.5307027145f + (-0.7265760135f); q = q * t + 0.7107068705f; q = q * t + (-0.142248368f); q = q * t + 0.127414796f; q = q * t;
    const f32x2 s = (v * v) * (-0.72134752044f);
    f32x2 e; e.x = __builtin_amdgcn_exp2f(s.x); e.y = __builtin_amdgcn_exp2f(s.y);
    const f32x2 m = v * (q * e), r = v - m;
    f32x2 o; o.x = v.x < 0.f ? m.x : r.x; o.y = v.y < 0.f ? m.y : r.y; return o;
}

template <int ACT  > struct EpiBf16 {
    static constexpr bool PERM = true, AFTER_DRAIN = false; static_assert(ACT == 0 || ACT == 1, "EpiBf16: ACT is 0 (none) or 1 (gelu_pk)");
    bf16_t* O; int ldc; const float* bias; int split_cols; size_t split_stride; float scale0;
    __device__ __forceinline__ void operator()(const f32x4 (&acc)[2][2][4][2], const Unit& u, int wr, int wc, int fr, int fq) const {
        const int row0 = u.pm * BM + wr * 64 + fr; int colt = u.pn * BM; bf16_t* base = O;
        float sc = 1.f; if (split_cols) { const int t = colt / split_cols; base += (size_t)t * split_stride; colt -= t * split_cols; if (t == 0) sc = scale0; }
        const int col0 = colt + wc * 32 + 8 * fq, bcol0 = u.pn * BM + wc * 32 + 8 * fq;
        f32x4 bv[2][2];
#pragma unroll
        for (int bj = 0; bj < 2; ++bj)
#pragma unroll
            for (int n = 0; n < 2; ++n) bv[bj][n] = bias ? *(const f32x4*)(bias + bcol0 + bj * HALF + 4 * n) : (f32x4){0.f, 0.f, 0.f, 0.f};
#pragma unroll
        for (int ai = 0; ai < 2; ++ai)
#pragma unroll
            for (int m = 0; m < 4; ++m) { bf16_t* rowp = base + (size_t)(row0 + ai * HALF + m * 16) * ldc + col0;
#pragma unroll
                for (int bj = 0; bj < 2; ++bj) { f32x4 v0 = acc[ai][bj][m][0] + bv[bj][0], v1 = acc[ai][bj][m][1] + bv[bj][1];
                    if (ACT == 1) { f32x2 a = gelu_pk((f32x2){v0[0], v0[1]}), b = gelu_pk((f32x2){v0[2], v0[3]}), c = gelu_pk((f32x2){v1[0], v1[1]}), d = gelu_pk((f32x2){v1[2], v1[3]});
                        v0 = (f32x4){a.x, a.y, b.x, b.y}; v1 = (f32x4){c.x, c.y, d.x, d.y}; }
                    v0 = v0 * sc; v1 = v1 * sc; u32x4 w; w.x = cvt_pk_bf16(v0[0], v0[1]); w.y = cvt_pk_bf16(v0[2], v0[3]); w.z = cvt_pk_bf16(v1[0], v1[1]); w.w = cvt_pk_bf16(v1[2], v1[3]);
                    *(u32x4*)(rowp + bj * HALF) = w; } }
    }
};
struct EpiF32 {
    static constexpr bool PERM = false, AFTER_DRAIN = false;
    float* C; int ldc; const float* bias;
    __device__ __forceinline__ void operator()(const f32x4 (&acc)[2][2][4][2], const Unit& u, int wr, int wc, int fr, int fq) const {
        const int row0 = u.pm * BM + wr * 64 + fr, col0 = u.pn * BM + wc * 32 + 4 * fq;
        f32x4 bv[2][2];
#pragma unroll
        for (int bj = 0; bj < 2; ++bj)
#pragma unroll
            for (int n = 0; n < 2; ++n) bv[bj][n] = bias ? *(const f32x4*)(bias + col0 + bj * HALF + n * 16) : (f32x4){0.f, 0.f, 0.f, 0.f};
#pragma unroll
        for (int ai = 0; ai < 2; ++ai)
#pragma unroll
            for (int m = 0; m < 4; ++m) { float* rowp = C + (size_t)(row0 + ai * HALF + m * 16) * ldc + col0;
#pragma unroll
                for (int bj = 0; bj < 2; ++bj)
#pragma unroll
                    for (int n = 0; n < 2; ++n) *(f32x4*)(rowp + bj * HALF + n * 16) = acc[ai][bj][m][n] + bv[bj][n]; }
    }
};
struct EpiResGate {
    static constexpr bool PERM = false, AFTER_DRAIN = false;
    const float* X; float* O; int ldc; const float* gate; int gate_stride, tiles_per_batch;
    __device__ __forceinline__ void operator()(const f32x4 (&acc)[2][2][4][2], const Unit& u, int wr, int wc, int fr, int fq) const {
        const int row0 = u.pm * BM + wr * 64 + fr, col0 = u.pn * BM + wc * 32 + 4 * fq;
        const float* gp = gate + (size_t)(u.pm / tiles_per_batch) * gate_stride;
        f32x4 gv[2][2];
#pragma unroll
        for (int bj = 0; bj < 2; ++bj)
#pragma unroll
            for (int n = 0; n < 2; ++n) gv[bj][n] = *(const f32x4*)(gp + col0 + bj * HALF + n * 16);
#pragma unroll
        for (int ai = 0; ai < 2; ++ai)
#pragma unroll
            for (int m = 0; m < 4; ++m) { const size_t off = (size_t)(row0 + ai * HALF + m * 16) * ldc + col0;
#pragma unroll
                for (int bj = 0; bj < 2; ++bj)
#pragma unroll
                    for (int n = 0; n < 2; ++n) { const f32x4 xv = *(const f32x4*)(X + off + bj * HALF + n * 16); *(f32x4*)(O + off + bj * HALF + n * 16) = xv + gv[bj][n] * acc[ai][bj][m][n]; } }
    }
};

template <class Epi, class Sched, bool ALIGN_EPI = false, bool SP2 = false>
__device__ __forceinline__ void gemm_phase(PG8_LAS unsigned char* lds, const Gemm g, const Sched& S, const Epi& E) {
    const int tid = threadIdx.x, wid = __builtin_amdgcn_readfirstlane(tid >> 6), lane = tid & 63, wr = wid >> 2, wc = wid & 3, fr = lane & 15, fq = lane >> 4;
    const int K = g.K, nt = K / BK;
    unsigned voffA[2], voffB[2];
#pragma unroll
    for (int i = 0; i < 2; ++i) { int R, C; stage_rc(tid * 16 + i * 8192, R, C); const int Rb = Epi::PERM ? ((R & ~31) + perm32(R & 31)) : R;
        voffA[i] = (unsigned)(R * K + C) * 2u; voffB[i] = (unsigned)(Rb * K + C) * 2u; }
    const size_t kstep = (size_t)(BK * 2);
    const size_t hstep = (size_t)HALF * K * 2;
    const size_t tstep = 2 * hstep;
    const unsigned ldsw = (unsigned)wid * 1024u;
    const int aoff = lds_byte(wr * 64 + fr, fq * 8), boff = lds_byte(wc * 32 + fr, fq * 8);
#define PG8_SA(b, h) (((b) * 2 + (h)) * HTB)
#define PG8_SB(b, h) ((4 + (b) * 2 + (h)) * HTB)
#define PG8_STAGE(bufoff, gbase, voff) do { _Pragma("unroll") for (int _i = 0; _i < 2; ++_i) \
        __builtin_amdgcn_global_load_lds((const unsigned*)((const char*)(gbase) + (voff)[_i]), (PG8_LAS unsigned*)(lds + (bufoff) + ldsw + _i * 8192), 16, 0, 0); } while (0)
#define PG8_LDA(dst, b, h) do { _Pragma("unroll") for (int m = 0; m < 4; ++m) _Pragma("unroll") for (int k = 0; k < 2; ++k) dst[m][k] = *(const PG8_LAS bf16x8*)(lds + PG8_SA(b, h) + aoff + m * 2048 + k * 1024); } while (0)
#define PG8_LDB(dst, b, h) do { _Pragma("unroll") for (int n = 0; n < 2; ++n) _Pragma("unroll") for (int k = 0; k < 2; ++k) dst[n][k] = *(const PG8_LAS bf16x8*)(lds + PG8_SB(b, h) + boff + n * 2048 + k * 1024); } while (0)
#define PG8_MMA(ai, bj, At, Bt) do { __builtin_amdgcn_s_setprio(1); _Pragma("unroll") for (int m = 0; m < 4; ++m) _Pragma("unroll") for (int n = 0; n < 2; ++n) _Pragma("unroll") for (int k = 0; k < 2; ++k) \
        acc[ai][bj][m][n] = __builtin_amdgcn_mfma_f32_16x16x32_bf16(Bt[n][k], At[m][k], acc[ai][bj][m][n], 0, 0, 0); __builtin_amdgcn_s_setprio(0); } while (0)
#define PG8_WAIT_V(n) asm volatile("s_waitcnt vmcnt(" #n ")" ::: "memory")
#define PG8_WAIT_L(n) asm volatile("s_waitcnt lgkmcnt(" #n ")" ::: "memory")
#define PG8_BAR __builtin_amdgcn_s_barrier()
#define PG8_SCHED __builtin_amdgcn_sched_barrier(0)
    Unit cur, nxt; int ui = 0;
    if (!S.next(0, cur)) return;
    f32x4 acc[2][2][4][2];
#pragma unroll
    for (int a = 0; a < 2; ++a)
#pragma unroll
        for (int b = 0; b < 2; ++b)
#pragma unroll
            for (int m = 0; m < 4; ++m)
#pragma unroll
                for (int n = 0; n < 2; ++n) acc[a][b][m][n] = (f32x4){0.f, 0.f, 0.f, 0.f};
    bf16x8 At[4][2], B0[2][2], B1[2][2];
    const char* cA = (const char*)g.A + (size_t)cur.pm * tstep; const char* cB = (const char*)g.Bt + (size_t)cur.pn * tstep;
    S.a_ready(cur);
    if constexpr (SP2) {
        PG8_STAGE(PG8_SB(0, 0), cB, voffB); PG8_STAGE(PG8_SB(0, 1), cB + hstep, voffB); PG8_STAGE(PG8_SA(0, 0), cA, voffA); PG8_STAGE(PG8_SA(0, 1), cA + hstep, voffA);
        if (wr == 1) PG8_BAR;
        PG8_WAIT_V(2); PG8_BAR;
        PG8_STAGE(PG8_SB(1, 0), cB + kstep, voffB); PG8_STAGE(PG8_SA(1, 0), cA + kstep, voffA); PG8_STAGE(PG8_SB(1, 1), cB + hstep + kstep, voffB);
        PG8_WAIT_V(6); PG8_BAR;
    } else {
        PG8_STAGE(PG8_SB(0, 0), cB, voffB); PG8_STAGE(PG8_SA(0, 0), cA, voffA); PG8_STAGE(PG8_SB(0, 1), cB + hstep, voffB); PG8_STAGE(PG8_SA(0, 1), cA + hstep, voffA);
        if (wr == 1) PG8_BAR;
        PG8_WAIT_V(4); PG8_BAR;
        PG8_STAGE(PG8_SB(1, 0), cB + kstep, voffB); PG8_STAGE(PG8_SA(1, 0), cA + kstep, voffA); PG8_STAGE(PG8_SB(1, 1), cB + hstep + kstep, voffB);
        PG8_WAIT_V(6); PG8_BAR;
    }
    for (;;) {
        const bool has_next = S.next(ui + 1, nxt);
        const char* nA = has_next ? (const char*)g.A + (size_t)nxt.pm * tstep : cA; const char* nB = has_next ? (const char*)g.Bt + (size_t)nxt.pn * tstep : cB;
        for (int t = 0; t < nt; t += 2) {
            const bool last = (t == nt - 2);
            const char* a1 = cA + (size_t)(t + 1) * kstep;
            const char* a2 = last ? nA : cA + (size_t)(t + 2) * kstep; const char* b2 = last ? nB : cB + (size_t)(t + 2) * kstep;
            const char* a3 = a2 + kstep; const char* b3 = b2 + kstep;
            if (last && has_next) S.a_ready(nxt);
            if constexpr (SP2) {
            PG8_LDB(B0, 0, 0); PG8_LDB(B1, 0, 1); PG8_SCHED; PG8_LDA(At, 0, 0); PG8_STAGE(PG8_SA(1, 1), a1 + hstep, voffA);
            PG8_WAIT_V(8); PG8_WAIT_L(0); PG8_BAR; PG8_MMA(0, 0, At, B0); PG8_MMA(0, 1, At, B1); PG8_BAR; PG8_SCHED;
            PG8_LDA(At, 0, 1); PG8_STAGE(PG8_SB(0, 0), b2, voffB); PG8_STAGE(PG8_SB(0, 1), b2 + hstep, voffB); PG8_STAGE(PG8_SA(0, 0), a2, voffA);
            PG8_WAIT_V(8); PG8_WAIT_L(0); PG8_BAR; PG8_MMA(1, 0, At, B0); PG8_MMA(1, 1, At, B1); PG8_BAR; PG8_SCHED;
            PG8_LDB(B0, 1, 0); PG8_LDB(B1, 1, 1); PG8_SCHED; PG8_LDA(At, 1, 0); PG8_STAGE(PG8_SA(0, 1), a2 + hstep, voffA);
            PG8_WAIT_V(8); PG8_WAIT_L(0); PG8_BAR; PG8_MMA(0, 0, At, B0); PG8_MMA(0, 1, At, B1); PG8_BAR; PG8_SCHED;
            PG8_LDA(At, 1, 1); PG8_STAGE(PG8_SB(1, 0), b3, voffB); PG8_STAGE(PG8_SB(1, 1), b3 + hstep, voffB); PG8_STAGE(PG8_SA(1, 0), a3, voffA);
            PG8_WAIT_V(8); PG8_WAIT_L(0); PG8_BAR; PG8_MMA(1, 0, At, B0); PG8_MMA(1, 1, At, B1); PG8_BAR; PG8_SCHED;
            } else {
            PG8_LDB(B0, 0, 0); PG8_SCHED; PG8_LDA(At, 0, 0); PG8_STAGE(PG8_SA(1, 1), a1 + hstep, voffA);
            PG8_WAIT_L(8); PG8_BAR; PG8_WAIT_L(0); PG8_MMA(0, 0, At, B0); PG8_BAR; PG8_SCHED;
            PG8_LDB(B1, 0, 1); PG8_STAGE(PG8_SB(0, 0), b2, voffB);
            PG8_BAR; PG8_WAIT_L(0); PG8_MMA(0, 1, At, B1); PG8_BAR;
            PG8_LDA(At, 0, 1); PG8_STAGE(PG8_SA(0, 0), a2, voffA);
            PG8_BAR; PG8_WAIT_L(0); PG8_MMA(1, 0, At, B0); PG8_BAR; PG8_SCHED;
            PG8_STAGE(PG8_SB(0, 1), b2 + hstep, voffB);
            PG8_WAIT_V(6); PG8_BAR; PG8_MMA(1, 1, At, B1); PG8_BAR;
            PG8_LDB(B0, 1, 0); PG8_SCHED; PG8_LDA(At, 1, 0); PG8_STAGE(PG8_SA(0, 1), a2 + hstep, voffA);
            PG8_WAIT_L(8); PG8_BAR; PG8_WAIT_L(0); PG8_MMA(0, 0, At, B0); PG8_BAR; PG8_SCHED;
            PG8_LDB(B1, 1, 1); PG8_STAGE(PG8_SB(1, 0), b3, voffB);
            PG8_BAR; PG8_WAIT_L(0); PG8_MMA(0, 1, At, B1); PG8_BAR;
            PG8_LDA(At, 1, 1); PG8_STAGE(PG8_SA(1, 0), a3, voffA);
            PG8_BAR; PG8_WAIT_L(0); PG8_MMA(1, 0, At, B0); PG8_BAR; PG8_SCHED;
            PG8_STAGE(PG8_SB(1, 1), b3 + hstep, voffB);
            PG8_WAIT_V(6); PG8_BAR; PG8_MMA(1, 1, At, B1); PG8_BAR;
            }
        }
        if constexpr (ALIGN_EPI) { if (wr == 0) PG8_BAR; }
        if constexpr (!Epi::AFTER_DRAIN) { E(acc, cur, wr, wc, fr, fq); S.done(cur); }
        if (!has_next) break;
#pragma unroll
        for (int a = 0; a < 2; ++a)
#pragma unroll
            for (int b = 0; b < 2; ++b)
#pragma unroll
                for (int m = 0; m < 4; ++m)
#pragma unroll
                    for (int n = 0; n < 2; ++n) acc[a][b][m][n] = (f32x4){0.f, 0.f, 0.f, 0.f};
        cur = nxt; cA = nA; cB = nB; ++ui;
        if constexpr (ALIGN_EPI) { if (wr == 1) PG8_BAR; }
    }
    PG8_WAIT_V(0);
    if constexpr (!ALIGN_EPI) { if (wr == 0) PG8_BAR; }
    PG8_BAR;
    if constexpr (Epi::AFTER_DRAIN) { E.fused(acc, cur, wr, wc, fr, fq, lds, wid, lane); S.done(cur); }
#undef PG8_SA
#undef PG8_SB
#undef PG8_STAGE
#undef PG8_LDA
#undef PG8_LDB
#undef PG8_MMA
#undef PG8_WAIT_V
#undef PG8_WAIT_L
#undef PG8_BAR
#undef PG8_SCHED
}
}

#ifndef PG8_SP2
#define PG8_SP2 true
#endif
#ifndef PG8_ALIGN
#define PG8_ALIGN true
#endif
constexpr int NWAVES = 8, NTHREADS = NWAVES * 64;
constexpr int BATCH = 2, SEQ = 4096, T = BATCH * SEQ, D = 2048;
constexpr int INW = 6160, NPROJ = 6144;
constexpr int GQ = 0, GK = 512, GV = 1024, GG = 2048, MQ = 3072, MK = 4096, MV = 5120;
constexpr int GA_SRC = 3072;
constexpr int NH = 8, NEXP = 16384, NMOD = 6 * D;
constexpr float EPS = 1e-6f;
#ifndef MK_N_LAUNCHES
#define MK_N_LAUNCHES 1
#endif
constexpr int N_PHASES = 13;
constexpr int NSL = 8, SLW = 256, PCH = 64, NCHUNK = (BATCH * SEQ) / PCH;

constexpr size_t MiB = 1u << 20;
constexpr size_t WS_CTL = 0, CTL_ZERO_BYTES = 1 * MiB;
constexpr size_t WS_WIN = 1 * MiB, WS_WGA = 25 * MiB, WS_WOUT = 26 * MiB, WS_WQ = 34 * MiB, WS_KEYS = 42 * MiB, WS_CS = 43 * MiB, WS_KMEAN = 44 * MiB, WS_DEC = 45 * MiB;
constexpr size_t WS_UB = 46 * MiB, WS_VB = 110 * MiB, WS_H = 174 * MiB, WS_CONCAT = 206 * MiB, WS_BCUM = 238 * MiB, WS_UT = 254 * MiB, WS_ST = 286 * MiB, WS_PROJ = 302 * MiB;
constexpr size_t WS_QP = WS_PROJ, WS_EXP = 366 * MiB, WS_GATE = 370 * MiB, WS_GU = 374 * MiB, WS_ACT = 378 * MiB, WS_HQ = 382 * MiB, WS_END = 398 * MiB;
constexpr size_t WS_US = WS_UB + 40 * MiB, WS_VS = WS_VB + 40 * MiB, WS_HS = WS_VB + 41 * MiB;
constexpr int CW_BAR = 4096, CW_Q = 8192, CW_QA = 9216, CW_QB = 10240, CW_MOD = 16384;
static_assert((CW_MOD + 2 * BATCH * NMOD) * 4 <= (int)CTL_ZERO_BYTES, "CTL words inside the memset region");
constexpr size_t WS_MODF = 45 * MiB + 512 * 1024;

constexpr int RING_BYTES = 131072, MISC_OFF = RING_BYTES + 320, LDS_BYTES = 147456;

#define GAS __attribute__((address_space(1)))
#define LAS __attribute__((address_space(3)))
typedef unsigned short bf16;
typedef unsigned v4u __attribute__((ext_vector_type(4)));
typedef unsigned v2u __attribute__((ext_vector_type(2)));
typedef float f32x4 __attribute__((ext_vector_type(4)));
typedef float f32x2 __attribute__((ext_vector_type(2)));
typedef float f32x16 __attribute__((ext_vector_type(16)));
typedef short bf16x8 __attribute__((ext_vector_type(8)));
typedef short s16x4 __attribute__((ext_vector_type(4)));
typedef __bf16 bf16x2_t __attribute__((ext_vector_type(2)));
typedef GAS unsigned gu32;
#define LDS_WAIT() asm volatile("s_waitcnt lgkmcnt(0)" ::: "memory")
#define VM_WAIT() asm volatile("s_waitcnt vmcnt(0)" ::: "memory")
__device__ __forceinline__ unsigned pk2(float lo, float hi) { f32x2 v = {lo, hi}; bf16x2_t b = __builtin_convertvector(v, bf16x2_t); return __builtin_bit_cast(unsigned, b); }
__device__ __forceinline__ float bflo(unsigned u) { return __uint_as_float(u << 16); }
__device__ __forceinline__ float bfhi(unsigned u) { return __uint_as_float(u & 0xffff0000u); }
__device__ __forceinline__ float bf1(short s) { return __uint_as_float(((unsigned)(unsigned short)s) << 16); }
__device__ __forceinline__ bf16x8 pack8(float a0, float a1, float a2, float a3, float a4, float a5, float a6, float a7) { v4u w; w.x = pk2(a0, a1); w.y = pk2(a2, a3); w.z = pk2(a4, a5); w.w = pk2(a6, a7); return __builtin_bit_cast(bf16x8, w); }
__device__ __forceinline__ int crow(int r, int hi) { return (r & 3) + 8 * (r >> 2) + 4 * hi; }
__device__ __forceinline__ float wave_sum(float v) {
#pragma unroll
    for (int o = 1; o < 64; o <<= 1) v += __shfl_xor(v, o);
    return v;
}
typedef short v4i16_t __attribute__((ext_vector_type(4)));
__device__ __forceinline__ s16x4 vtr(const LAS unsigned char* p) { return __builtin_bit_cast(s16x4, __builtin_amdgcn_ds_read_tr16_b64_v4i16((LAS v4i16_t*)p)); }
__device__ __forceinline__ bf16x8 cat4(s16x4 lo, s16x4 hi) { return (bf16x8){lo[0], lo[1], lo[2], lo[3], hi[0], hi[1], hi[2], hi[3]}; }
#define MFMA32(a, b, c) __builtin_amdgcn_mfma_f32_32x32x16_bf16((a), (b), (c), 0, 0, 0)
#define XB_TMO      128
#define XB_XCNT(j)  (256  + 64 * (j))
#define XB_XSUB(j)  (1280 + 64 * (j))
#define XB_XGEN(j)  (2304 + 64 * (j))
#define XB_TOP      3328
#define XB_TOPGEN   3392
#define XCD_BAR_WORDS 3456
#define XB_SPIN_CAP (1u << 18)

__device__ __forceinline__ unsigned xb_ld(unsigned* p)              { return __hip_atomic_load(p, __ATOMIC_RELAXED, __HIP_MEMORY_SCOPE_AGENT); }
__device__ __forceinline__ unsigned xb_add(unsigned* p, unsigned v) { return __hip_atomic_fetch_add(p, v, __ATOMIC_RELAXED, __HIP_MEMORY_SCOPE_AGENT); }
__device__ __forceinline__ unsigned xb_xcc_id() { return (unsigned)__builtin_amdgcn_s_getreg((3 << 11) | 20) & 0xFu; }
#define XB_SPIN(cond, bar) do { unsigned _sp = 0; while (cond) { __builtin_amdgcn_s_sleep(1); \
    if ((++_sp & 255u) == 0u) { if (xb_ld(&(bar)[XB_TMO])) break; if (_sp > XB_SPIN_CAP) { atomicAdd(&(bar)[XB_TMO], 1u); break; } } } } while (0)

struct XcdBarrier {
    unsigned* bar; unsigned x;
    volatile LAS unsigned* st;
};

__device__ __forceinline__ XcdBarrier xcd_barrier_post(unsigned* bar, volatile LAS unsigned* st) {
    XcdBarrier b; b.bar = bar; b.x = xb_xcc_id(); b.st = st;
    if (threadIdx.x == 0) (void)xb_add(&bar[XB_XCNT(b.x)], 1u);
    return b;
}
__device__ __forceinline__ void xcd_barrier_complete(unsigned* bar, unsigned x, unsigned& nloc, unsigned& nx) {
    const unsigned G = gridDim.x * gridDim.y * gridDim.z;
    unsigned sum, cnt, mine, sp = 0u;
    for (;;) {
        sum = 0u; cnt = 0u; mine = 0u;
#pragma unroll
        for (unsigned j = 0; j < 16; ++j) { const unsigned c = xb_ld(&bar[XB_XCNT(j)]); sum += c; cnt += (c > 0u) ? 1u : 0u; mine = (j == x) ? c : mine; }
        if (sum == G) break;
        __builtin_amdgcn_s_sleep(1);
        if ((++sp & 255u) == 0u) { if (xb_ld(&bar[XB_TMO])) break; if (sp > XB_SPIN_CAP) { atomicAdd(&bar[XB_TMO], 1u); break; } }
    }
    nloc = mine > 0u ? mine : 1u; nx = cnt > 0u ? cnt : 1u;
}

__device__ __forceinline__ void xcd_barrier(const XcdBarrier& b) {
    asm volatile("s_waitcnt vmcnt(0)" ::: "memory");
    __syncthreads();
    if (threadIdx.x == 0) {
        unsigned* bar = b.bar;
        __builtin_amdgcn_s_waitcnt(0);
        unsigned nloc = b.st[0], nx = b.st[1];
        if (nloc == 0u) { xcd_barrier_complete(bar, b.x, nloc, nx); b.st[0] = nloc; b.st[1] = nx; }
        const unsigned old = xb_add(&bar[XB_XSUB(b.x)], 1u);
        const unsigned gen = old / nloc;
        if (old + 1u == (gen + 1u) * nloc) {
            __builtin_amdgcn_fence(__ATOMIC_RELEASE, "agent");
            asm volatile("s_waitcnt vmcnt(0)" ::: "memory");
            const unsigned og = xb_add(&bar[XB_TOP], 1u);
            const unsigned tg = og / nx;
            if (og + 1u == (tg + 1u) * nx) xb_add(&bar[XB_TOPGEN], 1u);
            else XB_SPIN(xb_ld(&bar[XB_TOPGEN]) == tg, bar);
            __builtin_amdgcn_fence(__ATOMIC_ACQUIRE, "agent");
            xb_add(&bar[XB_XGEN(b.x)], 1u);
            asm volatile("s_waitcnt vmcnt(0)" ::: "memory");
        } else {
            XB_SPIN(xb_ld(&bar[XB_XGEN(b.x)]) == gen, bar);
            __builtin_amdgcn_fence(__ATOMIC_ACQUIRE, "agent");
            asm volatile("s_waitcnt vmcnt(0)" ::: "memory");
        }
    }
    __syncthreads();
}

struct Ctx {
    LAS unsigned char* lds;
    int tid, lane, wave, vcu, G, gw, ngw;
    const float *x, *c; const int* pos; const float *w_ada, *b_ada, *g1, *w_in, *w_a2, *b_a, *gla_g, *qg, *kg, *w_out, *g2, *w_q, *keys, *pu, *pv;
    float* out;
    unsigned* ctl; long long* MODI; float* MOD;
    bf16 *WIN, *WGA, *WOUT, *WQ, *KEYSB, *H, *CONCAT, *PROJ, *ST;
    unsigned char *UQ, *VQ, *HQ;
    float *CS, *KMEAN, *DEC, *BCUM, *UT, *QP, *GATE, *GU, *US, *VS, *HS; int *EXPI, *ACT;
};

__device__ __forceinline__ void transpose_item(const float* W, int ldw, int K, bf16* WT, int dst_row0, int k0, int n0, LAS float* scr, int lane) {
#pragma unroll 8
    for (int i = 0; i < 32; ++i) { const int kk = 2 * i + (lane >> 5); scr[kk * 33 + (lane & 31)] = W[(size_t)(k0 + kk) * ldw + n0 + (lane & 31)]; }
    LDS_WAIT(); asm volatile("" ::: "memory");
    const int c = lane & 7;
#pragma unroll
    for (int j = 0; j < 4; ++j) { const int n = (lane >> 3) + 8 * j; const LAS float* s = scr + (8 * c) * 33 + n;
        v4u o; o.x = pk2(s[0 * 33], s[1 * 33]); o.y = pk2(s[2 * 33], s[3 * 33]); o.z = pk2(s[4 * 33], s[5 * 33]); o.w = pk2(s[6 * 33], s[7 * 33]);
        *(v4u*)(WT + (size_t)(dst_row0 + n) * K + k0 + 8 * c) = o; }
    LDS_WAIT(); asm volatile("" ::: "memory");
}
__device__ __forceinline__ void convert_item(const float* src, bf16* dst, size_t item, int lane) {
    const f32x4* s = (const f32x4*)(src + item * 8192) + 2 * lane; v4u* d = (v4u*)(dst + item * 8192) + lane;
#pragma unroll 4
    for (int it = 0; it < 16; ++it) { const f32x4 a = s[it * 128], b = s[it * 128 + 1]; v4u o; o.x = pk2(a.x, a.y); o.y = pk2(a.z, a.w); o.z = pk2(b.x, b.y); o.w = pk2(b.z, b.w); d[it * 64] = o; }
}
__device__ __forceinline__ float wave_max(float v) {
#pragma unroll
    for (int o = 1; o < 64; o <<= 1) v = fmaxf(v, __shfl_xor(v, o));
    return v;
}
__device__ __forceinline__ void quant_store(const f32x4 (&v)[8], unsigned char* dst, float* scales, int row, size_t nrows, int lane, int bias) {
    float am = 0.f;
#pragma unroll
    for (int j = 0; j < 8; ++j) am = fmaxf(am, fmaxf(fmaxf(fabsf(v[j].x), fabsf(v[j].y)), fmaxf(fabsf(v[j].z), fabsf(v[j].w))));
    am = wave_max(am);
    const float inv = am > 0.f ? 127.f / am : 0.f;
    if (lane == 0) scales[row] = am > 0.f ? am / 127.f : 1.f;
#pragma unroll
    for (int j = 0; j < 8; ++j) { const int q0 = (int)rintf(v[j].x * inv) + bias, q1 = (int)rintf(v[j].y * inv) + bias, q2 = (int)rintf(v[j].z * inv) + bias, q3 = (int)rintf(v[j].w * inv) + bias;
        *(unsigned*)(dst + ((size_t)j * nrows + row) * 256 + 4 * lane) = (unsigned)(q0 & 0xff) | ((unsigned)(q1 & 0xff) << 8) | ((unsigned)(q2 & 0xff) << 16) | ((unsigned)(q3 & 0xff) << 24); }
}
__device__ __forceinline__ void quant_row(const float* src, unsigned char* dst, float* scales, int row, size_t nrows, int lane, int bias) {
    const f32x4* s = (const f32x4*)src + lane; f32x4 v[8];
#pragma unroll
    for (int j = 0; j < 8; ++j) v[j] = s[64 * j];
    quant_store(v, dst, scales, row, nrows, lane, bias);
}
__device__ __forceinline__ void p0_phase(const Ctx& C, int rep) {
    const int lane = C.lane, gw = C.gw, ngw = C.ngw;
    LAS float* sc = (LAS float*)C.lds;
    for (int i = C.tid; i < BATCH * D; i += NTHREADS) { const float v = C.c[i]; sc[i] = v / (1.f + __expf(-v)); }
    __syncthreads();
    for (int it = gw; it < 192 * 8; it += ngw) {
        const int cc = it % 192, ks = it / 192, col = cc * 64 + lane;
        const float* w = C.w_ada + (size_t)(ks * 256) * NMOD + col; const LAS float* s0 = sc + ks * 256; const LAS float* s1 = sc + D + ks * 256;
        float a0 = 0.f, a1 = 0.f;
#pragma unroll 16
        for (int k = 0; k < 256; ++k) { const float wv = w[(size_t)k * NMOD]; a0 += s0[k] * wv; a1 += s1[k] * wv; }
        long long* mi = C.MODI + rep * 2 * NMOD; atomicAdd((unsigned long long*)(mi + col), (unsigned long long)__double2ll_rn((double)a0 * 1099511627776.0)); atomicAdd((unsigned long long*)(mi + NMOD + col), (unsigned long long)__double2ll_rn((double)a1 * 1099511627776.0));
    }
    __syncthreads();
    LAS float* scr = (LAS float*)(C.lds + C.wave * 16384);
    constexpr int I_IN = 32 * 192, I_SQ = 32 * 64;
    for (int it = gw; it < I_IN + 2 * I_SQ; it += ngw) {
        int r = it;
        if (r < I_IN) { const int kb = r / 192, nb = r % 192, n0 = 32 * nb; transpose_item(C.w_in, INW, D, C.WIN, n0, 64 * kb, n0 < 3072 ? n0 : n0 + 16, scr, lane); continue; } r -= I_IN;
        if (r < I_SQ) { transpose_item(C.w_out, D, D, C.WOUT, 32 * (r % 64), 64 * (r / 64), 32 * (r % 64), scr, lane); continue; } r -= I_SQ;
        transpose_item(C.w_q, D, D, C.WQ, 32 * (r % 64), 64 * (r / 64), 32 * (r % 64), scr, lane);
    }
    for (int it = gw; it < 32; it += ngw) { const int k = it * 64 + lane; const f32x4* s = (const f32x4*)(C.w_in + (size_t)k * INW + GA_SRC);
#pragma unroll
        for (int q = 0; q < 4; ++q) { const f32x4 v = s[q]; C.WGA[(4 * q + 0) * D + k] = (bf16)(pk2(v.x, 0.f) & 0xffff); C.WGA[(4 * q + 1) * D + k] = (bf16)(pk2(v.y, 0.f) & 0xffff);
            C.WGA[(4 * q + 2) * D + k] = (bf16)(pk2(v.z, 0.f) & 0xffff); C.WGA[(4 * q + 3) * D + k] = (bf16)(pk2(v.w, 0.f) & 0xffff); } }
    for (int it = gw; it < 2 * NEXP; it += ngw) {
        if (it < NEXP) quant_row(C.pu + (size_t)it * D, C.UQ, C.US, it, NEXP, lane, 0);
        else quant_row(C.pv + (size_t)(it - NEXP) * D, C.VQ, C.VS, it - NEXP, NEXP, lane, 0);
    }
    for (int it = gw; it < 32; it += ngw) convert_item(C.keys, C.KEYSB, it, lane);
    for (int idx = C.vcu * NTHREADS + C.tid; idx < T * 16; idx += C.G * NTHREADS) {
        const int t = idx >> 4, f = idx & 15; const float inv = powf(500000.0f, -(float)f * 0.0625f); const float ang = (float)C.pos[t] * inv;
        C.CS[2 * idx] = cosf(ang); C.CS[2 * idx + 1] = sinf(ang);
    }
}

template <bool FIRST> __device__ __forceinline__ void norm_mod_phase(const Ctx& C, const float* X, const float* g, int shift_off, int scale_off, bf16* O) {
    if (FIRST) { for (int i = C.vcu * NTHREADS + C.tid; i < BATCH * NMOD; i += C.G * NTHREADS) C.MOD[i] = (float)((double)C.MODI[i] * (1.0 / 1099511627776.0)) + C.b_ada[i % NMOD]; }
    for (int m = C.gw; m < T; m += C.ngw) {
        const int b = m / SEQ; const f32x4* xr = (const f32x4*)(X + (size_t)m * D) + C.lane;
        f32x4 v[8]; float ss = 0.f;
#pragma unroll
        for (int j = 0; j < 8; ++j) { v[j] = xr[64 * j]; ss += (v[j].x * v[j].x + v[j].y * v[j].y) + (v[j].z * v[j].z + v[j].w * v[j].w); }
        const float rstd = rsqrtf(wave_sum(ss) * (1.f / D) + EPS);
        const f32x4* g4 = (const f32x4*)g + C.lane; v2u* o8 = (v2u*)(O + (size_t)m * D) + C.lane;
#pragma unroll
        for (int j = 0; j < 8; ++j) {
            f32x4 sh, sl;
            if (FIRST) { const long long* ph = C.MODI + b * NMOD + shift_off + 4 * (C.lane + 64 * j); const long long* pl = C.MODI + b * NMOD + scale_off + 4 * (C.lane + 64 * j);
                const f32x4 bh = ((const f32x4*)(C.b_ada + shift_off))[C.lane + 64 * j], bl = ((const f32x4*)(C.b_ada + scale_off))[C.lane + 64 * j];
                sh = (f32x4){(float)((double)ph[0] * (1.0 / 1099511627776.0)), (float)((double)ph[1] * (1.0 / 1099511627776.0)), (float)((double)ph[2] * (1.0 / 1099511627776.0)), (float)((double)ph[3] * (1.0 / 1099511627776.0))} + bh;
                sl = (f32x4){(float)((double)pl[0] * (1.0 / 1099511627776.0)), (float)((double)pl[1] * (1.0 / 1099511627776.0)), (float)((double)pl[2] * (1.0 / 1099511627776.0)), (float)((double)pl[3] * (1.0 / 1099511627776.0))} + bl; }
            else { sh = ((const f32x4*)(C.MOD + b * NMOD + shift_off))[C.lane + 64 * j]; sl = ((const f32x4*)(C.MOD + b * NMOD + scale_off))[C.lane + 64 * j]; }
            const f32x4 y = v[j] * rstd * g4[64 * j] * (1.f + sl) + sh; v2u w; w.x = pk2(y.x, y.y); w.y = pk2(y.z, y.w); o8[64 * j] = w; v[j] = y; }
        if (!FIRST) quant_store(v, C.HQ, C.HS, m, T, C.lane, 0);
    }
}

__device__ __forceinline__ void gla_prep_item(const Ctx& C, int b, int n) {
    const int lane = C.lane, w = C.wave, fr = lane & 15, fq = lane >> 4, rt = w & 3, kh = w >> 2; const size_t t0 = (size_t)b * SEQ + 64 * n;
    const bf16* ap = C.H + (t0 + 16 * rt + fr) * D + kh * 1024 + 8 * fq; const bf16* bp = C.WGA + fr * D + kh * 1024 + 8 * fq;
    f32x4 acc = {0.f, 0.f, 0.f, 0.f};
#pragma unroll 8
    for (int s = 0; s < 32; ++s) acc = __builtin_amdgcn_mfma_f32_16x16x32_bf16(*(const bf16x8*)(ap + 32 * s), *(const bf16x8*)(bp + 32 * s), acc, 0, 0, 0);
    LAS float* gaP = (LAS float*)C.lds;
#pragma unroll
    for (int r = 0; r < 4; ++r) gaP[kh * 1024 + (16 * rt + 4 * fq + r) * 16 + fr] = acc[r];
    __syncthreads();
    const int t = C.tid; float wc[16];
#pragma unroll
    for (int r = 0; r < 16; ++r) wc[r] = C.w_a2[r * 512 + t];
    const float ba = C.b_a[t]; float cum = 0.f; float* bo = C.BCUM + t0 * 512 + t;
#pragma unroll 4
    for (int tok = 0; tok < 64; ++tok) {
        const LAS f32x4* g0 = (const LAS f32x4*)(gaP + tok * 16); const LAS f32x4* g1 = (const LAS f32x4*)(gaP + 1024 + tok * 16); float z = ba;
#pragma unroll
        for (int q = 0; q < 4; ++q) { const f32x4 gv = g0[q] + g1[q]; z += gv.x * wc[4 * q] + gv.y * wc[4 * q + 1] + gv.z * wc[4 * q + 2] + gv.w * wc[4 * q + 3]; }
        cum += (fminf(z, 0.f) - log1pf(__expf(-fabsf(z)))) * 0.0625f;
        bo[(size_t)tok * 512] = cum;
    }
    __syncthreads();
}
__device__ __forceinline__ void moba_prep_item(const Ctx& C, int b, int h, int blk) {
    const int lane = C.lane, w = C.wave, i = lane & 15, tg = lane >> 4; const size_t t0 = (size_t)b * SEQ + 256 * blk;
    float qg[8], kg[8], km[8];
#pragma unroll
    for (int j = 0; j < 8; ++j) { qg[j] = C.qg[8 * i + j]; kg[j] = C.kg[8 * i + j]; km[j] = 0.f; }
    for (int it = 0; it < 8; ++it) {
        const size_t tok = t0 + 32 * w + 4 * it + tg;
        float cs[16];
        if (i < 4) { const f32x4* cp = (const f32x4*)(C.CS + tok * 32 + (i & 1) * 16);
#pragma unroll
            for (int q = 0; q < 4; ++q) { const f32x4 v = cp[q]; cs[4 * q] = v.x; cs[4 * q + 1] = v.y; cs[4 * q + 2] = v.z; cs[4 * q + 3] = v.w; } }
        else {
#pragma unroll
            for (int q = 0; q < 16; ++q) cs[q] = 0.f; }
#pragma unroll
        for (int which = 0; which < 2; ++which) {
            bf16* p = C.PROJ + tok * NPROJ + (which ? MK : MQ) + h * 128 + 8 * i;
            const v4u raw = *(const v4u*)p; float xv[8];
            xv[0] = bflo(raw.x); xv[1] = bfhi(raw.x); xv[2] = bflo(raw.y); xv[3] = bfhi(raw.y); xv[4] = bflo(raw.z); xv[5] = bfhi(raw.z); xv[6] = bflo(raw.w); xv[7] = bfhi(raw.w);
            float ss = 0.f;
#pragma unroll
            for (int j = 0; j < 8; ++j) ss += xv[j] * xv[j];
            ss += __shfl_xor(ss, 1); ss += __shfl_xor(ss, 2); ss += __shfl_xor(ss, 4); ss += __shfl_xor(ss, 8);
            const float rstd = rsqrtf(ss * (1.f / 128.f) + EPS);
#pragma unroll
            for (int j = 0; j < 8; ++j) xv[j] = xv[j] * rstd * (which ? kg[j] : qg[j]);
#pragma unroll
            for (int j = 0; j < 8; ++j) { const float o = __shfl_xor(xv[j], 2); const float cv = cs[2 * j], sv = cs[2 * j + 1];
                if (i < 2) xv[j] = xv[j] * cv - o * sv; else if (i < 4) xv[j] = xv[j] * cv + o * sv; }
            v4u o; o.x = pk2(xv[0], xv[1]); o.y = pk2(xv[2], xv[3]); o.z = pk2(xv[4], xv[5]); o.w = pk2(xv[6], xv[7]);
            *(v4u*)p = o;
            if (which) {
#pragma unroll
                for (int j = 0; j < 8; ++j) km[j] += xv[j]; }
        }
    }
    LAS float* red = (LAS float*)C.lds;
#pragma unroll
    for (int j = 0; j < 8; ++j) { km[j] += __shfl_xor(km[j], 16); km[j] += __shfl_xor(km[j], 32); }
    if (lane < 16) {
#pragma unroll
        for (int j = 0; j < 8; ++j) red[w * 128 + 8 * i + j] = km[j]; }
    __syncthreads();
    if (C.tid < 128) { float s = 0.f;
#pragma unroll
        for (int ww = 0; ww < 8; ++ww) s += red[ww * 128 + C.tid];
        C.KMEAN[((size_t)(b * NH + h) * 16 + blk) * 128 + C.tid] = s * (1.f / 256.f); }
    __syncthreads();
}

constexpr int KP = 272, VP = 320;
constexpr int MB_K0 = 0, MB_V0 = 2 * 64 * KP, MB_END = MB_V0 + 2 * 64 * VP;
__device__ __forceinline__ void moba_unit(const Ctx& C, int b, int h, int qb, int half) {
    const int tid = C.tid, lane = C.lane, w = C.wave, r = lane & 31, hh = lane >> 5, grp = w >> 2, wq = w & 3;
    const size_t tb = (size_t)b * SEQ; const int q0 = qb * 256 + 128 * half;
    const bf16* Qh = C.PROJ + MQ + h * 128; const bf16* Kh = C.PROJ + MK + h * 128; const bf16* Vh = C.PROJ + MV + h * 128;
    bf16x8 qf[8];
    { const bf16* qrow = Qh + (tb + q0 + 32 * wq + r) * NPROJ + 8 * hh;
#pragma unroll
      for (int s = 0; s < 8; ++s) qf[s] = *(const bf16x8*)(qrow + 16 * s); }
    unsigned selmask = 0u;
    { float g0 = -INFINITY, g1 = -INFINITY, g2 = -INFINITY; int i0 = -1, i1 = -1, i2 = -1;
      const float* km = C.KMEAN + ((size_t)(b * NH + h) * 16) * 128 + 8 * hh;
      for (int j = 0; j < qb; ++j) {
          float acc = 0.f;
#pragma unroll
          for (int s = 0; s < 8; ++s) { const f32x4 k0 = *(const f32x4*)(km + j * 128 + 16 * s), k1 = *(const f32x4*)(km + j * 128 + 16 * s + 4);
              acc += bf1(qf[s][0]) * k0.x + bf1(qf[s][1]) * k0.y + bf1(qf[s][2]) * k0.z + bf1(qf[s][3]) * k0.w + bf1(qf[s][4]) * k1.x + bf1(qf[s][5]) * k1.y + bf1(qf[s][6]) * k1.z + bf1(qf[s][7]) * k1.w; }
          acc += __shfl_xor(acc, 32);
          if (acc > g0) { g2 = g1; i2 = i1; g1 = g0; i1 = i0; g0 = acc; i0 = j; }
          else if (acc > g1) { g2 = g1; i2 = i1; g1 = acc; i1 = j; }
          else if (acc > g2) { g2 = acc; i2 = j; }
      }
      if (i0 >= 0) selmask |= 1u << i0; if (i1 >= 0) selmask |= 1u << i1; if (i2 >= 0) selmask |= 1u << i2; }
    LAS unsigned char* qs = C.lds + MB_END + wq * 32 * KP + r * KP + 16 * hh;
    if (grp == 0) {
#pragma unroll
        for (int s = 0; s < 8; ++s) *(LAS bf16x8*)(qs + 32 * s) = qf[s]; }
    const int nown = 2 * half + 2, NT = nown + 4 * qb, NS = (NT + 1) >> 1;
    v4u kr[4], vr[4];
#define MB_KEY0(i) ((i) < nown ? qb * 256 + 64 * (i) : (((i) - nown) >> 2) * 256 + 64 * (((i) - nown) & 3))
    const unsigned voff0 = (unsigned)(((tid >> 4) * NPROJ + 8 * (tid & 15)) * 2), voff1 = voff0 + (unsigned)(32 * NPROJ * 2);
#define MB_LOAD(s) do { _Pragma("unroll") for (int tl = 0; tl < 2; ++tl) { int i_ = 2 * (s) + tl; if (i_ >= NT) i_ = NT - 1; const size_t ks_ = (size_t)__builtin_amdgcn_readfirstlane((int)(MB_KEY0(i_))) * (NPROJ * 2); \
        const char* kp_ = (const char*)(Kh + tb * NPROJ) + ks_; const char* vp_ = (const char*)(Vh + tb * NPROJ) + ks_; \
        kr[2 * tl] = *(const v4u*)(kp_ + voff0); kr[2 * tl + 1] = *(const v4u*)(kp_ + voff1); vr[2 * tl] = *(const v4u*)(vp_ + voff0); vr[2 * tl + 1] = *(const v4u*)(vp_ + voff1); } } while (0)
#define MB_STORE() do { _Pragma("unroll") for (int tl = 0; tl < 2; ++tl) _Pragma("unroll") for (int pp = 0; pp < 2; ++pp) { const int p_ = tid + 512 * pp; \
        *(LAS v4u*)(C.lds + MB_K0 + tl * 64 * KP + (p_ >> 4) * KP + 16 * (p_ & 15)) = kr[2 * tl + pp]; *(LAS v4u*)(C.lds + MB_V0 + tl * 64 * VP + (p_ >> 4) * VP + 16 * (p_ & 15)) = vr[2 * tl + pp]; } } while (0)
    MB_LOAD(0); MB_STORE(); __syncthreads();
    float m_run = -1e30f, l_run = 0.f; f32x16 o[4];
#pragma unroll
    for (int dt = 0; dt < 4; ++dt)
#pragma unroll
        for (int q = 0; q < 16; ++q) o[dt][q] = 0.f;
    const float c2 = 0.08838834764831845f * 1.4426950408889634f;
    for (int s = 0; s < NS; ++s) {
        const int i = 2 * s + grp; const bool own = i < nown; const int tt = i, blk = own ? qb : (i - nown) >> 2;
        const bool mine = own || ((selmask >> blk) & 1u);
        const bool need = i < NT && (own ? (64 * tt <= 128 * half + 32 * wq + 31) : (__ballot(mine) != 0ull));
        bf16x8 pf[4];
        if (need) {
            const LAS unsigned char* kb = C.lds + MB_K0 + grp * 64 * KP + r * KP + 16 * hh;
            f32x16 p0, p1;
#pragma unroll
            for (int q = 0; q < 16; ++q) { p0[q] = 0.f; p1[q] = 0.f; }
#pragma unroll
            for (int ss = 0; ss < 8; ++ss) { const bf16x8 a0 = *(const LAS bf16x8*)(kb + 32 * ss), a1 = *(const LAS bf16x8*)(kb + 32 * KP + 32 * ss);
                const bf16x8 qv = *(const LAS bf16x8*)(qs + 32 * ss); p0 = MFMA32(a0, qv, p0); p1 = MFMA32(a1, qv, p1); }
            if (own) { const int qi = 128 * half + 32 * wq + r;
#pragma unroll
                for (int q = 0; q < 16; ++q) { const int kk = 64 * tt + crow(q, hh); if (kk > qi) p0[q] = -INFINITY; if (kk + 32 > qi) p1[q] = -INFINITY; } }
            else if (!mine) {
#pragma unroll
                for (int q = 0; q < 16; ++q) { p0[q] = -INFINITY; p1[q] = -INFINITY; } }
            float mx = fmaxf(p0[0], p1[0]);
#pragma unroll
            for (int q = 1; q < 16; ++q) mx = fmaxf(mx, fmaxf(p0[q], p1[q]));
            mx = fmaxf(mx, __shfl_xor(mx, 32));
            const float m_new = fmaxf(m_run, mx * c2), alpha = __builtin_amdgcn_exp2f(m_run - m_new);
            m_run = m_new; float rs = 0.f;
#pragma unroll
            for (int q = 0; q < 16; ++q) { p0[q] = __builtin_amdgcn_exp2f(p0[q] * c2 - m_new); p1[q] = __builtin_amdgcn_exp2f(p1[q] * c2 - m_new); rs += p0[q] + p1[q]; }
            l_run = l_run * alpha + rs;
            if (__ballot(alpha != 1.f) != 0ull) {
#pragma unroll
                for (int dt = 0; dt < 4; ++dt)
#pragma unroll
                    for (int q = 0; q < 16; ++q) o[dt][q] *= alpha; }
            pf[0] = pack8(p0[0], p0[1], p0[2], p0[3], p0[4], p0[5], p0[6], p0[7]); pf[1] = pack8(p0[8], p0[9], p0[10], p0[11], p0[12], p0[13], p0[14], p0[15]);
            pf[2] = pack8(p1[0], p1[1], p1[2], p1[3], p1[4], p1[5], p1[6], p1[7]); pf[3] = pack8(p1[8], p1[9], p1[10], p1[11], p1[12], p1[13], p1[14], p1[15]);
        }
        if (s + 1 < NS) MB_LOAD(s + 1);
        if (need) {
            const LAS unsigned char* vb = C.lds + MB_V0 + grp * 64 * VP + (4 * hh + ((lane & 15) >> 2)) * VP + (16 * ((lane >> 4) & 1) + 4 * (lane & 3)) * 2;
#pragma unroll
            for (int kk = 0; kk < 4; ++kk)
#pragma unroll
                for (int dt = 0; dt < 4; ++dt) { const s16x4 lo = vtr(vb + (16 * kk) * VP + dt * 64), hi = vtr(vb + (16 * kk + 8) * VP + dt * 64); o[dt] = MFMA32(cat4(lo, hi), pf[kk], o[dt]); }
        }
        __syncthreads();
        if (s + 1 < NS) { MB_STORE(); __syncthreads(); }
    }
#undef MB_LOAD
#undef MB_STORE
#undef MB_KEY0
    LAS float* mo = (LAS float*)C.lds + wq * (66 * 64);
    if (grp == 1) {
#pragma unroll
        for (int dt = 0; dt < 4; ++dt)
#pragma unroll
            for (int q = 0; q < 16; ++q) mo[(16 * dt + q) * 64 + lane] = o[dt][q];
        mo[64 * 64 + lane] = m_run; mo[65 * 64 + lane] = l_run; }
    __syncthreads();
    if (grp == 0) {
        const float m1 = mo[64 * 64 + lane], l1 = mo[65 * 64 + lane], m = fmaxf(m_run, m1), a0 = __builtin_amdgcn_exp2f(m_run - m), a1 = __builtin_amdgcn_exp2f(m1 - m);
        float l = l_run * a0 + l1 * a1; l += __shfl_xor(l, 32);
        const float inv = 1.f / l, s0 = a0 * inv, s1 = a1 * inv;
        bf16* op = C.CONCAT + (tb + q0 + 32 * wq + r) * D + 1024 + h * 128 + 4 * hh;
#pragma unroll
        for (int dt = 0; dt < 4; ++dt)
#pragma unroll
            for (int k4 = 0; k4 < 4; ++k4) { float y[4];
#pragma unroll
                for (int q = 0; q < 4; ++q) y[q] = o[dt][4 * k4 + q] * s0 + mo[(16 * dt + 4 * k4 + q) * 64 + lane] * s1;
                v2u wv; wv.x = pk2(y[0], y[1]); wv.y = pk2(y[2], y[3]); *(v2u*)(op + 32 * dt + 8 * k4) = wv; }
    }
    __syncthreads();
}

constexpr int GKP = 192;
__device__ __forceinline__ void gla_v_to_lds(const Ctx& C, size_t t0, int h, int off) {
#pragma unroll
    for (int pp = 0; pp < 2; ++pp) { const int p = C.tid + 512 * pp; const v4u v = *(const v4u*)(C.PROJ + (t0 + (p >> 4)) * NPROJ + GV + h * 128 + 8 * (p & 15)); *(LAS v4u*)(C.lds + off + (p >> 4) * VP + 16 * (p & 15)) = v; }
}
__device__ __forceinline__ void gla_u_item(const Ctx& C, int b, int h, int n) {
    const int tid = C.tid, lane = C.lane, w = C.wave, r = lane & 31, hh = lane >> 5; const size_t t0 = (size_t)b * SEQ + 64 * n; const int bhn = (b * NH + h) * 64 + n;
    constexpr int KT = 0, VT = 64 * GKP;
    { const int tok = tid >> 3, ch = tid & 7;
      const v4u raw = *(const v4u*)(C.PROJ + (t0 + tok) * NPROJ + GK + h * 64 + 8 * ch);
      const f32x4* bp = (const f32x4*)(C.BCUM + (t0 + tok) * 512 + h * 64 + 8 * ch); const f32x4* bl = (const f32x4*)(C.BCUM + (t0 + 63) * 512 + h * 64 + 8 * ch);
      const f32x4 b0 = bp[0], b1 = bp[1], l0 = bl[0], l1 = bl[1];
      const bf16x8 kv = pack8(bflo(raw.x) * __expf(l0.x - b0.x), bfhi(raw.x) * __expf(l0.y - b0.y), bflo(raw.y) * __expf(l0.z - b0.z), bfhi(raw.y) * __expf(l0.w - b0.w),
                              bflo(raw.z) * __expf(l1.x - b1.x), bfhi(raw.z) * __expf(l1.y - b1.y), bflo(raw.w) * __expf(l1.z - b1.z), bfhi(raw.w) * __expf(l1.w - b1.w));
      *(LAS bf16x8*)(C.lds + KT + tok * GKP + 16 * ch) = kv;
      if (tok == 63) { f32x4* dp = (f32x4*)(C.DEC + (size_t)bhn * 64 + 8 * ch); dp[0] = (f32x4){__expf(l0.x), __expf(l0.y), __expf(l0.z), __expf(l0.w)}; dp[1] = (f32x4){__expf(l1.x), __expf(l1.y), __expf(l1.z), __expf(l1.w)}; } }
    gla_v_to_lds(C, t0, h, VT);
    __syncthreads();
    const int mt = w & 3, nt = w >> 2, q = (lane & 15) >> 2, cb = (16 * ((lane >> 4) & 1) + 4 * (lane & 3)) * 2;
    const LAS unsigned char* va = C.lds + VT + (4 * hh + q) * VP + cb + mt * 64; const LAS unsigned char* ka = C.lds + KT + (4 * hh + q) * GKP + cb + nt * 64;
    f32x16 acc;
#pragma unroll
    for (int i = 0; i < 16; ++i) acc[i] = 0.f;
#pragma unroll
    for (int s = 0; s < 4; ++s) acc = MFMA32(cat4(vtr(va + 16 * s * VP), vtr(va + (16 * s + 8) * VP)), cat4(vtr(ka + 16 * s * GKP), vtr(ka + (16 * s + 8) * GKP)), acc);
    float* up = C.UT + (size_t)bhn * 8192 + (32 * mt) * 64 + 32 * nt + r;
#pragma unroll
    for (int i = 0; i < 16; ++i) up[crow(i, hh) * 64] = acc[i];
    __syncthreads();
}
__device__ __forceinline__ void p4_phase(const Ctx& C, int rep) {
    volatile LAS int* qslot = (volatile LAS int*)(C.lds + MISC_OFF + 64);
    for (;;) {
        __syncthreads();
        if (C.tid == 0) *qslot = (int)atomicAdd(C.ctl + CW_Q + 64 * rep, 1u);
        __syncthreads();
        const int id = *qslot;
        if (id >= 512 + 1024) break;
        if (id < 512) moba_unit(C, (id & 15) >> 3, id & 7, 15 - (id >> 5), 1 - ((id >> 4) & 1));
        else { const int g = id - 512; gla_u_item(C, g >> 9, (g >> 6) & 7, g & 63); }
    }
}

__device__ __forceinline__ void p5_phase(const Ctx& C) {
    for (int idx = C.vcu * NTHREADS + C.tid; idx < 16 * 8192; idx += C.G * NTHREADS) {
        const int bh = idx >> 13, rem = idx & 8191, dk = rem & 63; float s = 0.f;
        const float* up = C.UT + (size_t)bh * 64 * 8192 + rem; const float* dp = C.DEC + (size_t)bh * 64 * 64 + dk; bf16* sp = C.ST + (size_t)bh * 64 * 8192 + rem;
#pragma unroll 16
        for (int n = 0; n < 64; ++n) { sp[(size_t)n * 8192] = (bf16)(pk2(s, 0.f) & 0xffffu); s = dp[n * 64] * s + up[(size_t)n * 8192]; }
    }
}

__device__ __forceinline__ void gla_out_item(const Ctx& C, int b, int h, int n) {
    const int lane = C.lane, w = C.wave, r = lane & 31, hh = lane >> 5, dvt = w & 3, lt = w >> 2; const size_t t0 = (size_t)b * SEQ + 64 * n; const int bhn = (b * NH + h) * 64 + n;
    constexpr int VT = 0, RED = 64 * VP;
    gla_v_to_lds(C, t0, h, VT);
    bf16x8 qd[4];
    { const size_t tl = t0 + 32 * lt + r;
#pragma unroll
      for (int s = 0; s < 4; ++s) { const v4u raw = *(const v4u*)(C.PROJ + tl * NPROJ + GQ + h * 64 + 16 * s + 8 * hh); const f32x4* bp = (const f32x4*)(C.BCUM + tl * 512 + h * 64 + 16 * s + 8 * hh); const f32x4 b0 = bp[0], b1 = bp[1];
          qd[s] = pack8(bflo(raw.x) * 0.125f * __expf(b0.x), bfhi(raw.x) * 0.125f * __expf(b0.y), bflo(raw.y) * 0.125f * __expf(b0.z), bfhi(raw.y) * 0.125f * __expf(b0.w),
                        bflo(raw.z) * 0.125f * __expf(b1.x), bfhi(raw.z) * 0.125f * __expf(b1.y), bflo(raw.w) * 0.125f * __expf(b1.z), bfhi(raw.w) * 0.125f * __expf(b1.w)); } }
    __syncthreads();
    f32x16 o;
#pragma unroll
    for (int i = 0; i < 16; ++i) o[i] = 0.f;
    const LAS unsigned char* va = C.lds + VT + (4 * hh + ((lane & 15) >> 2)) * VP + (16 * ((lane >> 4) & 1) + 4 * (lane & 3)) * 2 + dvt * 64;
    for (int mt = 0; mt <= lt; ++mt) {
        const size_t tm = t0 + 32 * mt + r; f32x16 X;
#pragma unroll
        for (int i = 0; i < 16; ++i) X[i] = 0.f;
#pragma unroll
        for (int s = 0; s < 4; ++s) { const v4u raw = *(const v4u*)(C.PROJ + tm * NPROJ + GK + h * 64 + 16 * s + 8 * hh); const f32x4* bp = (const f32x4*)(C.BCUM + tm * 512 + h * 64 + 16 * s + 8 * hh); const f32x4 b0 = bp[0], b1 = bp[1];
            const bf16x8 kd = pack8(bflo(raw.x) * __expf(-b0.x), bfhi(raw.x) * __expf(-b0.y), bflo(raw.y) * __expf(-b0.z), bfhi(raw.y) * __expf(-b0.w),
                                    bflo(raw.z) * __expf(-b1.x), bfhi(raw.z) * __expf(-b1.y), bflo(raw.w) * __expf(-b1.z), bfhi(raw.w) * __expf(-b1.w));
            X = MFMA32(kd, qd[s], X); }
        if (mt == lt) {
#pragma unroll
            for (int i = 0; i < 16; ++i) if (crow(i, hh) > r) X[i] = 0.f; }
        const bf16x8 pf0 = pack8(X[0], X[1], X[2], X[3], X[4], X[5], X[6], X[7]), pf1 = pack8(X[8], X[9], X[10], X[11], X[12], X[13], X[14], X[15]);
        o = MFMA32(cat4(vtr(va + (32 * mt) * VP), vtr(va + (32 * mt + 8) * VP)), pf0, o);
        o = MFMA32(cat4(vtr(va + (32 * mt + 16) * VP), vtr(va + (32 * mt + 24) * VP)), pf1, o);
    }
    { const bf16* sp = C.ST + (size_t)bhn * 8192 + (32 * dvt + r) * 64 + 8 * hh;
#pragma unroll
      for (int s = 0; s < 4; ++s) o = MFMA32(*(const bf16x8*)(sp + 16 * s), qd[s], o); }
    float ss = 0.f;
#pragma unroll
    for (int i = 0; i < 16; ++i) ss += o[i] * o[i];
    ss += __shfl_xor(ss, 32);
    LAS float* red = (LAS float*)(C.lds + RED);
    if (hh == 0) red[dvt * 64 + 32 * lt + r] = ss;
    __syncthreads();
    const int l = 32 * lt + r; const float rstd = rsqrtf((red[l] + red[64 + l] + red[128 + l] + red[192 + l]) * (1.f / 128.f) + EPS);
    const size_t tl = t0 + l;
#pragma unroll
    for (int k4 = 0; k4 < 4; ++k4) { const int d0 = 32 * dvt + 8 * k4 + 4 * hh;
        const v2u graw = *(const v2u*)(C.PROJ + tl * NPROJ + GG + h * 128 + d0); const f32x4 gn = *(const f32x4*)(C.gla_g + d0);
        const float ga = bflo(graw.x), gb = bfhi(graw.x), gc = bflo(graw.y), gd = bfhi(graw.y);
        const float y0 = o[4 * k4] * rstd * gn.x * (ga / (1.f + __expf(-ga))), y1 = o[4 * k4 + 1] * rstd * gn.y * (gb / (1.f + __expf(-gb)));
        const float y2 = o[4 * k4 + 2] * rstd * gn.z * (gc / (1.f + __expf(-gc))), y3 = o[4 * k4 + 3] * rstd * gn.w * (gd / (1.f + __expf(-gd)));
        v2u wv; wv.x = pk2(y0, y1); wv.y = pk2(y2, y3); *(v2u*)(C.CONCAT + tl * D + h * 128 + d0) = wv; }
    __syncthreads();
}

#define INS16(L, xin) do { int x_ = (xin); _Pragma("unroll") for (int i_ = 0; i_ < 16; ++i_) { const int hi_ = max(L[i_], x_); x_ = min(L[i_], x_); L[i_] = hi_; } } while (0)
__device__ __forceinline__ int ord_key(float v) { int u = __float_as_int(v); return u ^ ((u >> 31) & 0x7fffffff); }
__device__ __forceinline__ float ord_val(int k, int mask) { int u = k & ~mask; return __int_as_float(u ^ ((u >> 31) & 0x7fffffff)); }
__device__ __forceinline__ void peer_topk_item(const Ctx& C, int tg, int hd) {
    const int lane = C.lane, r = lane & 31, hh = lane >> 5; const size_t tok = (size_t)tg * 32 + r;
    int La[16], Lb[16];
#pragma unroll
    for (int c = 0; c < 2; ++c) {
        int L[16];
#pragma unroll
        for (int i = 0; i < 16; ++i) L[i] = (int)0x80000000;
        bf16x8 qf[8];
        { const float* qp = C.QP + tok * D + hd * 256 + c * 128 + 8 * hh;
#pragma unroll
          for (int s = 0; s < 8; ++s) { const f32x4 a = *(const f32x4*)(qp + 16 * s), bq = *(const f32x4*)(qp + 16 * s + 4); qf[s] = pack8(a.x, a.y, a.z, a.w, bq.x, bq.y, bq.z, bq.w); } }
#pragma unroll 1
        for (int kt = 0; kt < 4; ++kt) {
            const bf16* kp = C.KEYSB + ((size_t)(hd * 2 + c) * 128 + 32 * kt + r) * 128 + 8 * hh; f32x16 X;
#pragma unroll
            for (int i = 0; i < 16; ++i) X[i] = 0.f;
#pragma unroll
            for (int s = 0; s < 8; ++s) X = MFMA32(*(const bf16x8*)(kp + 16 * s), qf[s], X);
#pragma unroll
            for (int i = 0; i < 16; ++i) INS16(L, (ord_key(X[i]) & ~127) | (32 * kt + crow(i, hh)));
        }
        int M[16];
#pragma unroll
        for (int i = 0; i < 16; ++i) M[i] = __shfl_xor(L[i], 32);
#pragma unroll
        for (int i = 0; i < 16; ++i) INS16(L, M[i]);
#pragma unroll
        for (int i = 0; i < 16; ++i) { if (c == 0) La[i] = L[i]; else Lb[i] = L[i]; }
    }
    float sa[16], sb[16]; int Lc[16];
#pragma unroll
    for (int i = 0; i < 16; ++i) { sa[i] = ord_val(La[i], 127); sb[i] = ord_val(Lb[i], 127); Lc[i] = (int)0x80000000; }
#pragma unroll
    for (int i = 0; i < 16; ++i)
#pragma unroll
        for (int j = 0; j < 16; ++j) if ((i + 1) * (j + 1) <= 16) INS16(Lc, (ord_key(sa[i] + sb[j]) & ~255) | (i * 16 + j));
    float e[16], sum = 0.f; int ex[16]; const float mx = ord_val(Lc[0], 255);
#pragma unroll
    for (int i = 0; i < 16; ++i) {
        e[i] = __expf(ord_val(Lc[i], 255) - mx); sum += e[i];
        const int ii = (Lc[i] >> 4) & 15, jj = Lc[i] & 15; int i1 = 0, i2 = 0;
#pragma unroll
        for (int q = 0; q < 16; ++q) { i1 = (ii == q) ? (La[q] & 127) : i1; i2 = (jj == q) ? (Lb[q] & 127) : i2; }
        ex[i] = i1 * 128 + i2;
    }
    const float inv = 1.f / sum;
    if (hh == 0) {
        v4u* ep = (v4u*)(C.EXPI + tok * 128 + hd * 16); f32x4* gp = (f32x4*)(C.GATE + tok * 128 + hd * 16); f32x4* up = (f32x4*)(C.GU + tok * 128 + hd * 16); v4u* ap = (v4u*)(C.ACT + tok * 128 + hd * 16);
        const float hs = C.HS[tok];
#pragma unroll
        for (int q = 0; q < 4; ++q) { ep[q] = (v4u){(unsigned)ex[4 * q], (unsigned)ex[4 * q + 1], (unsigned)ex[4 * q + 2], (unsigned)ex[4 * q + 3]};
            gp[q] = (f32x4){e[4 * q] * inv * C.VS[ex[4 * q]], e[4 * q + 1] * inv * C.VS[ex[4 * q + 1]], e[4 * q + 2] * inv * C.VS[ex[4 * q + 2]], e[4 * q + 3] * inv * C.VS[ex[4 * q + 3]]};
            up[q] = (f32x4){hs * C.US[ex[4 * q]], hs * C.US[ex[4 * q + 1]], hs * C.US[ex[4 * q + 2]], hs * C.US[ex[4 * q + 3]]};
            ap[q] = (v4u){0u, 0u, 0u, 0u}; }
    }
}

__device__ __forceinline__ int peer_dequeue(const Ctx& C, unsigned* cnt, int xcc) {
    volatile LAS int* slot = (volatile LAS int*)(C.lds + MISC_OFF + 64);
    __syncthreads();
    if (C.tid == 0) { int res = -1;
        for (int s = 0; s < NSL; ++s) { const int sl = (xcc + s) & (NSL - 1);
            if (__hip_atomic_load(cnt + 64 * sl, __ATOMIC_RELAXED, __HIP_MEMORY_SCOPE_AGENT) >= (unsigned)NCHUNK) continue;
            const unsigned id = atomicAdd(cnt + 64 * sl, 1u); if (id < (unsigned)NCHUNK) { res = sl * NCHUNK + (int)id; break; } }
        *slot = res; }
    __syncthreads();
    return *slot;
}
#define ROWSUM16(d) do { d += __builtin_amdgcn_update_dpp(0, d, 0x121, 0xf, 0xf, false); d += __builtin_amdgcn_update_dpp(0, d, 0x122, 0xf, 0xf, false); \
                         d += __builtin_amdgcn_update_dpp(0, d, 0x124, 0xf, 0xf, false); d += __builtin_amdgcn_update_dpp(0, d, 0x128, 0xf, 0xf, false); } while (0)
#define PA_ISSUE1(buf, esrc, j_) buf[j_] = *(const v4u*)(tab + (size_t)__builtin_amdgcn_ds_swizzle(esrc, ((j_) << 5) | 0x10) * SLW)
#define PA_ISSUE(buf, esrc) do { PA_ISSUE1(buf, esrc, 0); PA_ISSUE1(buf, esrc, 1); PA_ISSUE1(buf, esrc, 2); PA_ISSUE1(buf, esrc, 3); PA_ISSUE1(buf, esrc, 4); PA_ISSUE1(buf, esrc, 5); PA_ISSUE1(buf, esrc, 6); PA_ISSUE1(buf, esrc, 7); \
        PA_ISSUE1(buf, esrc, 8); PA_ISSUE1(buf, esrc, 9); PA_ISSUE1(buf, esrc, 10); PA_ISSUE1(buf, esrc, 11); PA_ISSUE1(buf, esrc, 12); PA_ISSUE1(buf, esrc, 13); PA_ISSUE1(buf, esrc, 14); PA_ISSUE1(buf, esrc, 15); } while (0)
#define PA_COMPUTE(buf, hq_, dstv) do { _Pragma("unroll") for (int j_ = 0; j_ < 16; ++j_) { const v4u u_ = buf[j_]; \
        int d_ = __builtin_amdgcn_sdot4((int)hq_.x, (int)u_.x, 0, false); d_ = __builtin_amdgcn_sdot4((int)hq_.y, (int)u_.y, d_, false); d_ = __builtin_amdgcn_sdot4((int)hq_.z, (int)u_.z, d_, false); d_ = __builtin_amdgcn_sdot4((int)hq_.w, (int)u_.w, d_, false); \
        ROWSUM16(d_); dstv = (i == j_) ? d_ : dstv; } } while (0)
__device__ __forceinline__ void peer_a_chunk(const Ctx& C, int t0, int x) {
    const int lane = C.lane, i = lane & 15;
    v4u hq[8]; int el[8], eh[8];
#pragma unroll
    for (int tt = 0; tt < 8; ++tt) { hq[tt] = __builtin_nontemporal_load((const v4u*)(C.HQ + ((size_t)x * T + t0 + tt) * SLW + 16 * i)); el[tt] = __builtin_nontemporal_load(C.EXPI + (size_t)(t0 + tt) * 128 + lane); eh[tt] = __builtin_nontemporal_load(C.EXPI + (size_t)(t0 + tt) * 128 + 64 + lane); }
    const unsigned char* tab = C.UQ + (size_t)x * NEXP * SLW + 16 * i;
    v4u bA[16], bB[16];
    PA_ISSUE(bA, el[0]);
#pragma unroll
    for (int tt = 0; tt < 8; ++tt) {
        PA_ISSUE(bB, eh[tt]);
        int r_lo = 0, r_hi = 0;
        PA_COMPUTE(bA, hq[tt], r_lo);
        if (tt + 1 < 8) PA_ISSUE(bA, el[tt + 1]);
        PA_COMPUTE(bB, hq[tt], r_hi);
        atomicAdd(C.ACT + (size_t)(t0 + tt) * 128 + lane, r_lo); atomicAdd(C.ACT + (size_t)(t0 + tt) * 128 + 64 + lane, r_hi);
    }
}
#undef PA_ISSUE
#undef PA_ISSUE1
#undef PA_COMPUTE
#define PB_ISSUE(buf, esrc) do { _Pragma("unroll") for (int j_ = 0; j_ < 64; ++j_) buf[j_] = *(const unsigned*)(tab + (size_t)__builtin_amdgcn_readlane(esrc, j_) * SLW); } while (0)
#define PB_COMPUTE(buf, psrc) do { _Pragma("unroll") for (int j_ = 0; j_ < 16; ++j_) { const int wp_ = __builtin_amdgcn_readlane((int)psrc, 4 * j_); \
        const unsigned t0_ = __builtin_amdgcn_perm(buf[4 * j_ + 1], buf[4 * j_], 0x05010400u), t1_ = __builtin_amdgcn_perm(buf[4 * j_ + 1], buf[4 * j_], 0x07030602u); \
        const unsigned t2_ = __builtin_amdgcn_perm(buf[4 * j_ + 3], buf[4 * j_ + 2], 0x05010400u), t3_ = __builtin_amdgcn_perm(buf[4 * j_ + 3], buf[4 * j_ + 2], 0x07030602u); \
        c0 = __builtin_amdgcn_sdot4((int)__builtin_amdgcn_perm(t2_, t0_, 0x05040100u), wp_, c0, false); c1 = __builtin_amdgcn_sdot4((int)__builtin_amdgcn_perm(t2_, t0_, 0x07060302u), wp_, c1, false); \
        c2 = __builtin_amdgcn_sdot4((int)__builtin_amdgcn_perm(t3_, t1_, 0x05040100u), wp_, c2, false); c3 = __builtin_amdgcn_sdot4((int)__builtin_amdgcn_perm(t3_, t1_, 0x07060302u), wp_, c3, false); } } while (0)
__device__ __forceinline__ void peer_b_chunk(const Ctx& C, int t0, int x, float* dst) {
    const int lane = C.lane, b = t0 / SEQ;
    int el[8], eh[8]; unsigned pl[8], ph[8]; float ws[8];
#pragma unroll
    for (int tt = 0; tt < 8; ++tt) { const size_t o = (size_t)(t0 + tt) * 128 + lane;
        el[tt] = __builtin_nontemporal_load(C.EXPI + o); eh[tt] = __builtin_nontemporal_load(C.EXPI + o + 64);
        const float a_lo = (float)__builtin_nontemporal_load(C.ACT + o) * __builtin_nontemporal_load(C.GU + o), a_hi = (float)__builtin_nontemporal_load(C.ACT + o + 64) * __builtin_nontemporal_load(C.GU + o + 64);
        const float w_lo = __builtin_nontemporal_load(C.GATE + o) * 0.5f * a_lo * (1.f + erff(a_lo * 0.70710678118654752f)), w_hi = __builtin_nontemporal_load(C.GATE + o + 64) * 0.5f * a_hi * (1.f + erff(a_hi * 0.70710678118654752f));
        const float wm = wave_max(fmaxf(fabsf(w_lo), fabsf(w_hi))), winv = wm > 0.f ? 127.f / wm : 0.f; ws[tt] = wm * (1.f / 127.f);
        unsigned p_lo = (unsigned)((int)rintf(w_lo * winv) & 0xff), p_hi = (unsigned)((int)rintf(w_hi * winv) & 0xff);
        p_lo |= (unsigned)__builtin_amdgcn_update_dpp(0, (int)p_lo, 0xB1, 0xf, 0xf, false) << 8; p_lo |= (unsigned)__builtin_amdgcn_update_dpp(0, (int)p_lo, 0x4E, 0xf, 0xf, false) << 16;
        p_hi |= (unsigned)__builtin_amdgcn_update_dpp(0, (int)p_hi, 0xB1, 0xf, 0xf, false) << 8; p_hi |= (unsigned)__builtin_amdgcn_update_dpp(0, (int)p_hi, 0x4E, 0xf, 0xf, false) << 16;
        pl[tt] = p_lo; ph[tt] = p_hi; }
    const unsigned char* tab = C.VQ + (size_t)x * NEXP * SLW + 4 * lane;
    const int d0 = x * SLW + 4 * lane; const f32x4 gm = *(const f32x4*)(C.MOD + b * NMOD + 5 * D + d0);
    unsigned bA[64], bB[64];
    PB_ISSUE(bA, el[0]);
#pragma unroll
    for (int tt = 0; tt < 8; ++tt) {
        PB_ISSUE(bB, eh[tt]);
        const size_t off = (size_t)(t0 + tt) * D + d0; const f32x4 x1 = __builtin_nontemporal_load((const f32x4*)(C.out + off));
        int c0 = 0, c1 = 0, c2 = 0, c3 = 0;
        PB_COMPUTE(bA, pl[tt]);
        if (tt + 1 < 8) PB_ISSUE(bA, el[tt + 1]);
        PB_COMPUTE(bB, ph[tt]);
        const f32x4 o = {(float)c0 * ws[tt], (float)c1 * ws[tt], (float)c2 * ws[tt], (float)c3 * ws[tt]};
        __builtin_nontemporal_store(x1 + gm * o, (f32x4*)(dst + off));
    }
}
#undef PB_ISSUE
#undef PB_COMPUTE
template <int STAGE> __device__ __forceinline__ void peer_expert_phase(const Ctx& C, float* dst, int rep) {
    const int xcc = (int)(xb_xcc_id() & (NSL - 1)); unsigned* cnt = C.ctl + (STAGE == 0 ? CW_QA : CW_QB) + 64 * NSL * rep;
    for (;;) {
        const int id = peer_dequeue(C, cnt, xcc); if (id < 0) break;
        const int x = id / NCHUNK, t0 = (id % NCHUNK) * PCH + C.wave * (PCH / NWAVES);
        if (STAGE == 0) peer_a_chunk(C, t0, x); else peer_b_chunk(C, t0, x, dst);
    }
}

struct Args { const void* in[18]; float* out; unsigned char* ws; int ph_lo, ph_hi; };
__global__ void __launch_bounds__(NTHREADS, 2) fwd_kernel(Args args) {
    extern __shared__ __attribute__((aligned(16))) unsigned char lds[];
    Ctx C;
    C.lds = (LAS unsigned char*)lds; C.tid = threadIdx.x; C.lane = C.tid & 63; C.wave = __builtin_amdgcn_readfirstlane(C.tid >> 6);
    C.G = gridDim.x; { const int bx = blockIdx.x; C.vcu = (C.G % 8 == 0) ? (bx % 8) * (C.G / 8) + bx / 8 : bx; }
    C.gw = C.vcu * NWAVES + C.wave; C.ngw = C.G * NWAVES;
    C.x = (const float*)args.in[0]; C.c = (const float*)args.in[1]; C.pos = (const int*)args.in[2]; C.w_ada = (const float*)args.in[3]; C.b_ada = (const float*)args.in[4]; C.g1 = (const float*)args.in[5];
    C.w_in = (const float*)args.in[6]; C.w_a2 = (const float*)args.in[7]; C.b_a = (const float*)args.in[8]; C.gla_g = (const float*)args.in[9]; C.qg = (const float*)args.in[10]; C.kg = (const float*)args.in[11];
    C.w_out = (const float*)args.in[12]; C.g2 = (const float*)args.in[13]; C.w_q = (const float*)args.in[14]; C.keys = (const float*)args.in[15]; C.pu = (const float*)args.in[16]; C.pv = (const float*)args.in[17];
    C.out = args.out; unsigned char* ws = args.ws;
    C.ctl = (unsigned*)(ws + WS_CTL); C.MODI = (long long*)(C.ctl + CW_MOD); C.MOD = (float*)(ws + WS_MODF);
    C.WIN = (bf16*)(ws + WS_WIN); C.WGA = (bf16*)(ws + WS_WGA); C.WOUT = (bf16*)(ws + WS_WOUT); C.WQ = (bf16*)(ws + WS_WQ); C.KEYSB = (bf16*)(ws + WS_KEYS); C.UQ = ws + WS_UB; C.VQ = ws + WS_VB; C.HQ = ws + WS_HQ; C.US = (float*)(ws + WS_US); C.VS = (float*)(ws + WS_VS); C.HS = (float*)(ws + WS_HS); C.GU = (float*)(ws + WS_GU); C.ACT = (int*)(ws + WS_ACT);
    C.H = (bf16*)(ws + WS_H); C.CONCAT = (bf16*)(ws + WS_CONCAT); C.PROJ = (bf16*)(ws + WS_PROJ); C.ST = (bf16*)(ws + WS_ST);
    C.CS = (float*)(ws + WS_CS); C.KMEAN = (float*)(ws + WS_KMEAN); C.DEC = (float*)(ws + WS_DEC); C.BCUM = (float*)(ws + WS_BCUM); C.UT = (float*)(ws + WS_UT); C.QP = (float*)(ws + WS_QP); C.GATE = (float*)(ws + WS_GATE); C.EXPI = (int*)(ws + WS_EXP);
    for (int u = C.tid; u < (LDS_BYTES - RING_BYTES) / 4; u += NTHREADS) ((LAS unsigned*)(C.lds + RING_BYTES))[u] = 0u;
    __syncthreads();
    const int lo = args.ph_lo, hi = args.ph_hi;
    XcdBarrier bar; bar.bar = C.ctl + CW_BAR; bar.x = 0; bar.st = nullptr;
    if (hi - lo > 1) bar = xcd_barrier_post(C.ctl + CW_BAR, (volatile LAS unsigned*)(C.lds + MISC_OFF) + 8);
#ifndef SKIPMASK
#define SKIPMASK 0
#endif
#ifndef REPEATMASK
#define REPEATMASK 0
#endif
#define IN(k) (!((SKIPMASK >> (k)) & 1) && lo <= (k) && (k) < hi)
#define REP(k, ...) do { if ((REPEATMASK >> (k)) & 1) { const int rep_ = 1; (void)rep_; __VA_ARGS__; xcd_barrier(bar); } { const int rep_ = 0; (void)rep_; __VA_ARGS__; } } while (0)
#define SEAM(k) do { if (IN(k) && IN((k) + 1)) xcd_barrier(bar); } while (0)
    if (IN(0)) REP(0, p0_phase(C, rep_)); SEAM(0);
    if (IN(1)) REP(1, norm_mod_phase<true>(C, C.x, C.g1, 0, D, C.H)); SEAM(1);
    if (IN(2)) REP(2, pg8::Gemm g{C.H, C.WIN, T, NPROJ, D}; pg8::StaticOrder S; S.init(T, NPROJ, C.G, (int)blockIdx.x); pg8::EpiBf16<0> E{C.PROJ, NPROJ, nullptr, 0, 0, 1.f};
                 pg8::gemm_phase<pg8::EpiBf16<0>, pg8::StaticOrder, PG8_ALIGN, PG8_SP2>(C.lds, g, S, E)); SEAM(2);
    if (IN(3)) REP(3, for (int it = C.vcu; it < 128 + 256; it += C.G) { if (it < 256) moba_prep_item(C, it >> 7, (it >> 4) & 7, it & 15); else gla_prep_item(C, (it - 256) >> 6, (it - 256) & 63); }); SEAM(3);
    if (IN(4)) REP(4, p4_phase(C, rep_)); SEAM(4);
    if (IN(5)) REP(5, p5_phase(C)); SEAM(5);
    if (IN(6)) REP(6, for (int it = C.vcu; it < 1024; it += C.G) gla_out_item(C, it >> 9, (it >> 6) & 7, it & 63)); SEAM(6);
    if (IN(7)) REP(7, pg8::Gemm g{C.CONCAT, C.WOUT, T, D, D}; pg8::StaticOrder S; S.init(T, D, C.G, (int)blockIdx.x); pg8::EpiResGate E{C.x, C.out, D, C.MOD + 2 * D, NMOD, SEQ / 256};
                 pg8::gemm_phase<pg8::EpiResGate, pg8::StaticOrder, PG8_ALIGN, PG8_SP2>(C.lds, g, S, E)); SEAM(7);
    if (IN(8)) REP(8, norm_mod_phase<false>(C, C.out, C.g2, 3 * D, 4 * D, C.H)); SEAM(8);
    if (IN(9)) REP(9, pg8::Gemm g{C.H, C.WQ, T, D, D}; pg8::StaticOrder S; S.init(T, D, C.G, (int)blockIdx.x); pg8::EpiF32 E{C.QP, D, nullptr};
                 pg8::gemm_phase<pg8::EpiF32, pg8::StaticOrder, PG8_ALIGN, PG8_SP2>(C.lds, g, S, E)); SEAM(9);
    if (IN(10)) REP(10, for (int it = C.gw; it < 256 * 8; it += C.ngw) peer_topk_item(C, it >> 3, it & 7)); SEAM(10);
    if (IN(11)) { peer_expert_phase<0>(C, nullptr, 0); } SEAM(11);
    if (IN(12)) REP(12, peer_expert_phase<1>(C, rep_ ? C.QP : C.out, rep_));
#undef IN
#undef SEAM
}

extern "C" void kernel_launch(void* const* d_in, const int* in_sizes, int n_in, void* d_out, int out_size, void* d_ws, size_t ws_size, hipStream_t stream) {
    static int grid = 0;
    if (grid == 0) {
        if (n_in != 18 || in_sizes[0] != T * D || out_size != T * D || ws_size < WS_END) { fprintf(stderr, "kernel_launch: shape/workspace mismatch (n_in %d, in0 %d, out %d, ws %zu, need %zu); nothing launched\n", n_in, n_in > 0 ? in_sizes[0] : -1, out_size, ws_size, (size_t)WS_END); grid = -1; return; }
        int dev = 0, cus = 0, per_cu = 0;
        if (hipGetDevice(&dev) != hipSuccess || hipDeviceGetAttribute(&cus, hipDeviceAttributeMultiprocessorCount, dev) != hipSuccess) { fprintf(stderr, "kernel_launch: device query failed\n"); grid = -1; return; }
        if (hipFuncSetAttribute((const void*)fwd_kernel, hipFuncAttributeMaxDynamicSharedMemorySize, LDS_BYTES) != hipSuccess) { fprintf(stderr, "kernel_launch: hipFuncSetAttribute failed\n"); grid = -1; return; }
        if (hipOccupancyMaxActiveBlocksPerMultiprocessor(&per_cu, (const void*)fwd_kernel, NTHREADS, LDS_BYTES) != hipSuccess || per_cu < 1) { fprintf(stderr, "kernel_launch: occupancy query reports %d workgroups per CU\n", per_cu); (void)hipGetLastError(); grid = -1; return; }
        grid = cus;
    }
    if (grid < 0) return;
    if (hipMemsetAsync((char*)d_ws + WS_CTL, 0, CTL_ZERO_BYTES, stream) != hipSuccess) { fprintf(stderr, "kernel_launch: memset failed\n"); return; }
    Args a{};
    for (int i = 0; i < 18; ++i) a.in[i] = d_in[i];
    a.out = (float*)d_out; a.ws = (unsigned char*)d_ws;
#if MK_N_LAUNCHES == 1
    a.ph_lo = 0; a.ph_hi = N_PHASES;
    void* kargs[] = {&a};
    hipError_t le = hipLaunchCooperativeKernel((const void*)fwd_kernel, dim3(grid), dim3(NTHREADS), kargs, LDS_BYTES, stream);
    if (le != hipSuccess) fprintf(stderr, "kernel_launch: cooperative launch failed: %s (grid %d)\n", hipGetErrorName(le), grid);
#else
    for (int p = 0; p < N_PHASES; ++p) { a.ph_lo = p; a.ph_hi = p + 1; hipLaunchKernelGGL(fwd_kernel, dim3(grid), dim3(NTHREADS), LDS_BYTES, stream, a); }
#endif
}
```

```cpp
#define REPEATMASK 0
#include <hip/hip_runtime.h>
#include <hip/hip_bf16.h>
#include <cstdio>
#include <cstdint>
#include <cmath>
namespace pg8 {
#define PG8_LAS __attribute__((address_space(3)))
typedef unsigned short bf16_t;
typedef short bf16x8 __attribute__((ext_vector_type(8)));
typedef float f32x4 __attribute__((ext_vector_type(4)));
typedef unsigned u32x4 __attribute__((ext_vector_type(4)));
constexpr int BM = 256, BK = 64, HALF = 128, HTB = HALF * BK * 2  , STAGE_BYTES = 8 * HTB, NXCD = 8, WGM = 8;

__host__ __device__ __forceinline__ int lds_byte(int r, int c) { const int st = (r >> 4) * 2 + (c >> 5), rr = r & 15, cc = c & 31, ob = rr * 64 + cc * 2; return st * 1024 + (ob ^ (((ob >> 9) & 1) << 5)); }
__host__ __device__ __forceinline__ void stage_rc(int b, int& R, int& C) { const int st = b / 1024, sb = b % 1024, swz = sb ^ (((sb >> 9) & 1) << 5); R = (st >> 1) * 16 + swz / 64; C = (st & 1) * 32 + (swz % 64) / 2; }
__host__ __device__ __forceinline__ int perm32(int rho) { const int n = rho >> 4, i = rho & 15; return 8 * (i >> 2) + 4 * n + (i & 3); }

struct Unit { int pm, pn; };
struct Gemm { const bf16_t* A; const bf16_t* Bt; int M, N, K; };

struct StaticOrder {
    int nM, nN, nwg, G, c;
    __host__ __device__ void init(int M, int N, int G_, int c_) { nM = M / BM; nN = N / BM; nwg = nM * nN; G = G_; c = c_; }
    __host__ __device__ bool next(int i, Unit& u) const {
        const long L = (long)i * G + c; if (L >= nwg) return false;
        int wgid = (int)L; { const int q = nwg / NXCD, r = nwg % NXCD, xcd = wgid % NXCD, off = wgid / NXCD; wgid = (xcd < r ? xcd * (q + 1) : r * (q + 1) + (xcd - r) * q) + off; }
        const int nig = WGM * nN, gid = wgid / nig, fm = gid * WGM, gsz = (nM - fm) < WGM ? (nM - fm) : WGM;
        u.pm = fm + ((wgid % nig) % gsz); u.pn = (wgid % nig) / gsz; return true;
    }
    __device__ __forceinline__ void a_ready(const Unit&) const {}
    __device__ __forceinline__ void done(const Unit&) const {}
};

__device__ __forceinline__ unsigned cvt_pk_bf16(float lo, float hi) { unsigned r; asm volatile("v_cvt_pk_bf16_f32 %0, %1, %2" : "=v"(r) : "v"(lo), "v"(hi)); return r; }
typedef float f32x2 __attribute__((ext_vector_type(2)));
__device__ __forceinline__ f32x2 gelu_pk(f32x2 v) {
    const f32x2 av = __builtin_elementwise_abs(v), d = av * 0.2316418882f + 1.0f;
    f32x2 t; t.x = __builtin_amdgcn_rcpf(d.x); t.y = __builtin_amdgcn_rcpf(d.y);
    f32x2 q = t * 0.5307027145f + (-0.7265760135f); q = q * t + 0.7107068705f; q = q * t + (-0.142248368f); q = q * t + 0.127414796f; q = q * t;
    const f32x2 s = (v * v) * (-0.72134752044f);
    f32x2 e; e.x = __builtin_amdgcn_exp2f(s.x); e.y = __builtin_amdgcn_exp2f(s.y);
    const f32x2 m = v * (q * e), r = v - m;
    f32x2 o; o.x = v.x < 0.f ? m.x : r.x; o.y = v.y < 0.f ? m.y : r.y; return o;
}

template <int ACT  > struct EpiBf16 {
    static constexpr bool PERM = true, AFTER_DRAIN = false; static_assert(ACT == 0 || ACT == 1, "EpiBf16: ACT is 0 (none) or 1 (gelu_pk)");
    bf16_t* O; int ldc; const float* bias; int split_cols; size_t split_stride; float scale0;
    __device__ __forceinline__ void operator()(const f32x4 (&acc)[2][2][4][2], const Unit& u, int wr, int wc, int fr, int fq) const {
        const int row0 = u.pm * BM + wr * 64 + fr; int colt = u.pn * BM; bf16_t* base = O;
        float sc = 1.f; if (split_cols) { const int t = colt / split_cols; base += (size_t)t * split_stride; colt -= t * split_cols; if (t == 0) sc = scale0; }
        const int col0 = colt + wc * 32 + 8 * fq, bcol0 = u.pn * BM + wc * 32 + 8 * fq;
        f32x4 bv[2][2];
#pragma unroll
        for (int bj = 0; bj < 2; ++bj)
#pragma unroll
            for (int n = 0; n < 2; ++n) bv[bj][n] = bias ? *(const f32x4*)(bias + bcol0 + bj * HALF + 4 * n) : (f32x4){0.f, 0.f, 0.f, 0.f};
#pragma unroll
        for (int ai = 0; ai < 2; ++ai)
#pragma unroll
            for (int m = 0; m < 4; ++m) { bf16_t* rowp = base + (size_t)(row0 + ai * HALF + m * 16) * ldc + col0;
#pragma unroll
                for (int bj = 0; bj < 2; ++bj) { f32x4 v0 = acc[ai][bj][m][0] + bv[bj][0], v1 = acc[ai][bj][m][1] + bv[bj][1];
                    if (ACT == 1) { f32x2 a = gelu_pk((f32x2){v0[0], v0[1]}), b = gelu_pk((f32x2){v0[2], v0[3]}), c = gelu_pk((f32x2){v1[0], v1[1]}), d = gelu_pk((f32x2){v1[2], v1[3]});
                        v0 = (f32x4){a.x, a.y, b.x, b.y}; v1 = (f32x4){c.x, c.y, d.x, d.y}; }
                    v0 = v0 * sc; v1 = v1 * sc; u32x4 w; w.x = cvt_pk_bf16(v0[0], v0[1]); w.y = cvt_pk_bf16(v0[2], v0[3]); w.z = cvt_pk_bf16(v1[0], v1[1]); w.w = cvt_pk_bf16(v1[2], v1[3]);
                    *(u32x4*)(rowp + bj * HALF) = w; } }
    }
};
struct EpiF32 {
    static constexpr bool PERM = false, AFTER_DRAIN = false;
    float* C; int ldc; const float* bias;
    __device__ __forceinline__ void operator()(const f32x4 (&acc)[2][2][4][2], const Unit& u, int wr, int wc, int fr, int fq) const {
        const int row0 = u.pm * BM + wr * 64 + fr, col0 = u.pn * BM + wc * 32 + 4 * fq;
        f32x4 bv[2][2];
#pragma unroll
        for (int bj = 0; bj < 2; ++bj)
#pragma unroll
            for (int n = 0; n < 2; ++n) bv[bj][n] = bias ? *(const f32x4*)(bias + col0 + bj * HALF + n * 16) : (f32x4){0.f, 0.f, 0.f, 0.f};
#pragma unroll
        for (int ai = 0; ai < 2; ++ai)
#pragma unroll
            for (int m = 0; m < 4; ++m) { float* rowp = C + (size_t)(row0 + ai * HALF + m * 16) * ldc + col0;
#pragma unroll
                for (int bj = 0; bj < 2; ++bj)
#pragma unroll
                    for (int n = 0; n < 2; ++n) *(f32x4*)(rowp + bj * HALF + n * 16) = acc[ai][bj][m][n] + bv[bj][n]; }
    }
};
struct EpiResGate {
    static constexpr bool PERM = false, AFTER_DRAIN = false;
    const float* X; float* O; int ldc; const float* gate; int gate_stride, tiles_per_batch;
    __device__ __forceinline__ void operator()(const f32x4 (&acc)[2][2][4][2], const Unit& u, int wr, int wc, int fr, int fq) const {
        const int row0 = u.pm * BM + wr * 64 + fr, col0 = u.pn * BM + wc * 32 + 4 * fq;
        const float* gp = gate + (size_t)(u.pm / tiles_per_batch) * gate_stride;
        f32x4 gv[2][2];
#pragma unroll
        for (int bj = 0; bj < 2; ++bj)
#pragma unroll
            for (int n = 0; n < 2; ++n) gv[bj][n] = *(const f32x4*)(gp + col0 + bj * HALF + n * 16);
#pragma unroll
        for (int ai = 0; ai < 2; ++ai)
#pragma unroll
            for (int m = 0; m < 4; ++m) { const size_t off = (size_t)(row0 + ai * HALF + m * 16) * ldc + col0;
#pragma unroll
                for (int bj = 0; bj < 2; ++bj)
#pragma unroll
                    for (int n = 0; n < 2; ++n) { const f32x4 xv = *(const f32x4*)(X + off + bj * HALF + n * 16); *(f32x4*)(O + off + bj * HALF + n * 16) = xv + gv[bj][n] * acc[ai][bj][m][n]; } }
    }
};

template <class Epi, class Sched, bool ALIGN_EPI = false, bool SP2 = false>
__device__ __forceinline__ void gemm_phase(PG8_LAS unsigned char* lds, const Gemm g, const Sched& S, const Epi& E) {
    const int tid = threadIdx.x, wid = __builtin_amdgcn_readfirstlane(tid >> 6), lane = tid & 63, wr = wid >> 2, wc = wid & 3, fr = lane & 15, fq = lane >> 4;
    const int K = g.K, nt = K / BK;
    unsigned voffA[2], voffB[2];
#pragma unroll
    for (int i = 0; i < 2; ++i) { int R, C; stage_rc(tid * 16 + i * 8192, R, C); const int Rb = Epi::PERM ? ((R & ~31) + perm32(R & 31)) : R;
        voffA[i] = (unsigned)(R * K + C) * 2u; voffB[i] = (unsigned)(Rb * K + C) * 2u; }
    const size_t kstep = (size_t)(BK * 2);
    const size_t hstep = (size_t)HALF * K * 2;
    const size_t tstep = 2 * hstep;
    const unsigned ldsw = (unsigned)wid * 1024u;
    const int aoff = lds_byte(wr * 64 + fr, fq * 8), boff = lds_byte(wc * 32 + fr, fq * 8);
#define PG8_SA(b, h) (((b) * 2 + (h)) * HTB)
#define PG8_SB(b, h) ((4 + (b) * 2 + (h)) * HTB)
#define PG8_STAGE(bufoff, gbase, voff) do { _Pragma("unroll") for (int _i = 0; _i < 2; ++_i) \
        __builtin_amdgcn_global_load_lds((const unsigned*)((const char*)(gbase) + (voff)[_i]), (PG8_LAS unsigned*)(lds + (bufoff) + ldsw + _i * 8192), 16, 0, 0); } while (0)
#define PG8_LDA(dst, b, h) do { _Pragma("unroll") for (int m = 0; m < 4; ++m) _Pragma("unroll") for (int k = 0; k < 2; ++k) dst[m][k] = *(const PG8_LAS bf16x8*)(lds + PG8_SA(b, h) + aoff + m * 2048 + k * 1024); } while (0)
#define PG8_LDB(dst, b, h) do { _Pragma("unroll") for (int n = 0; n < 2; ++n) _Pragma("unroll") for (int k = 0; k < 2; ++k) dst[n][k] = *(const PG8_LAS bf16x8*)(lds + PG8_SB(b, h) + boff + n * 2048 + k * 1024); } while (0)
#define PG8_MMA(ai, bj, At, Bt) do { __builtin_amdgcn_s_setprio(1); _Pragma("unroll") for (int m = 0; m < 4; ++m) _Pragma("unroll") for (int n = 0; n < 2; ++n) _Pragma("unroll") for (int k = 0; k < 2; ++k) \
        acc[ai][bj][m][n] = __builtin_amdgcn_mfma_f32_16x16x32_bf16(Bt[n][k], At[m][k], acc[ai][bj][m][n], 0, 0, 0); __builtin_amdgcn_s_setprio(0); } while (0)
#define PG8_WAIT_V(n) asm volatile("s_waitcnt vmcnt(" #n ")" ::: "memory")
#define PG8_WAIT_L(n) asm volatile("s_waitcnt lgkmcnt(" #n ")" ::: "memory")
#define PG8_BAR __builtin_amdgcn_s_barrier()
#define PG8_SCHED __builtin_amdgcn_sched_barrier(0)
    Unit cur, nxt; int ui = 0;
    if (!S.next(0, cur)) return;
    f32x4 acc[2][2][4][2];
#pragma unroll
    for (int a = 0; a < 2; ++a)
#pragma unroll
        for (int b = 0; b < 2; ++b)
#pragma unroll
            for (int m = 0; m < 4; ++m)
#pragma unroll
                for (int n = 0; n < 2; ++n) acc[a][b][m][n] = (f32x4){0.f, 0.f, 0.f, 0.f};
    bf16x8 At[4][2], B0[2][2], B1[2][2];
    const char* cA = (const char*)g.A + (size_t)cur.pm * tstep; const char* cB = (const char*)g.Bt + (size_t)cur.pn * tstep;
    S.a_ready(cur);
    if constexpr (SP2) {
        PG8_STAGE(PG8_SB(0, 0), cB, voffB); PG8_STAGE(PG8_SB(0, 1), cB + hstep, voffB); PG8_STAGE(PG8_SA(0, 0), cA, voffA); PG8_STAGE(PG8_SA(0, 1), cA + hstep, voffA);
        if (wr == 1) PG8_BAR;
        PG8_WAIT_V(2); PG8_BAR;
        PG8_STAGE(PG8_SB(1, 0), cB + kstep, voffB); PG8_STAGE(PG8_SA(1, 0), cA + kstep, voffA); PG8_STAGE(PG8_SB(1, 1), cB + hstep + kstep, voffB);
        PG8_WAIT_V(6); PG8_BAR;
    } else {
        PG8_STAGE(PG8_SB(0, 0), cB, voffB); PG8_STAGE(PG8_SA(0, 0), cA, voffA); PG8_STAGE(PG8_SB(0, 1), cB + hstep, voffB); PG8_STAGE(PG8_SA(0, 1), cA + hstep, voffA);
        if (wr == 1) PG8_BAR;
        PG8_WAIT_V(4); PG8_BAR;
        PG8_STAGE(PG8_SB(1, 0), cB + kstep, voffB); PG8_STAGE(PG8_SA(1, 0), cA + kstep, voffA); PG8_STAGE(PG8_SB(1, 1), cB + hstep + kstep, voffB);
        PG8_WAIT_V(6); PG8_BAR;
    }
    for (;;) {
        const bool has_next = S.next(ui + 1, nxt);
        const char* nA = has_next ? (const char*)g.A + (size_t)nxt.pm * tstep : cA; const char* nB = has_next ? (const char*)g.Bt + (size_t)nxt.pn * tstep : cB;
        for (int t = 0; t < nt; t += 2) {
            const bool last = (t == nt - 2);
            const char* a1 = cA + (size_t)(t + 1) * kstep;
            const char* a2 = last ? nA : cA + (size_t)(t + 2) * kstep; const char* b2 = last ? nB : cB + (size_t)(t + 2) * kstep;
            const char* a3 = a2 + kstep; const char* b3 = b2 + kstep;
            if (last && has_next) S.a_ready(nxt);
            if constexpr (SP2) {
            PG8_LDB(B0, 0, 0); PG8_LDB(B1, 0, 1); PG8_SCHED; PG8_LDA(At, 0, 0); PG8_STAGE(PG8_SA(1, 1), a1 + hstep, voffA);
            PG8_WAIT_V(8); PG8_WAIT_L(0); PG8_BAR; PG8_MMA(0, 0, At, B0); PG8_MMA(0, 1, At, B1); PG8_BAR; PG8_SCHED;
            PG8_LDA(At, 0, 1); PG8_STAGE(PG8_SB(0, 0), b2, voffB); PG8_STAGE(PG8_SB(0, 1), b2 + hstep, voffB); PG8_STAGE(PG8_SA(0, 0), a2, voffA);
            PG8_WAIT_V(8); PG8_WAIT_L(0); PG8_BAR; PG8_MMA(1, 0, At, B0); PG8_MMA(1, 1, At, B1); PG8_BAR; PG8_SCHED;
            PG8_LDB(B0, 1, 0); PG8_LDB(B1, 1, 1); PG8_SCHED; PG8_LDA(At, 1, 0); PG8_STAGE(PG8_SA(0, 1), a2 + hstep, voffA);
            PG8_WAIT_V(8); PG8_WAIT_L(0); PG8_BAR; PG8_MMA(0, 0, At, B0); PG8_MMA(0, 1, At, B1); PG8_BAR; PG8_SCHED;
            PG8_LDA(At, 1, 1); PG8_STAGE(PG8_SB(1, 0), b3, voffB); PG8_STAGE(PG8_SB(1, 1), b3 + hstep, voffB); PG8_STAGE(PG8_SA(1, 0), a3, voffA);
            PG8_WAIT_V(8); PG8_WAIT_L(0); PG8_BAR; PG8_MMA(1, 0, At, B0); PG8_MMA(1, 1, At, B1); PG8_BAR; PG8_SCHED;
            } else {
            PG8_LDB(B0, 0, 0); PG8_SCHED; PG8_LDA(At, 0, 0); PG8_STAGE(PG8_SA(1, 1), a1 + hstep, voffA);
            PG8_WAIT_L(8); PG8_BAR; PG8_WAIT_L(0); PG8_MMA(0, 0, At, B0); PG8_BAR; PG8_SCHED;
            PG8_LDB(B1, 0, 1); PG8_STAGE(PG8_SB(0, 0), b2, voffB);
            PG8_BAR; PG8_WAIT_L(0); PG8_MMA(0, 1, At, B1); PG8_BAR;
            PG8_LDA(At, 0, 1); PG8_STAGE(PG8_SA(0, 0), a2, voffA);
            PG8_BAR; PG8_WAIT_L(0); PG8_MMA(1, 0, At, B0); PG8_BAR; PG8_SCHED;
            PG8_STAGE(PG8_SB(0, 1), b2 + hstep, voffB);
            PG8_WAIT_V(6); PG8_BAR; PG8_MMA(1, 1, At, B1); PG8_BAR;
            PG8_LDB(B0, 1, 0); PG8_SCHED; PG8_LDA(At, 1, 0); PG8_STAGE(PG8_SA(0, 1), a2 + hstep, voffA);
            PG8_WAIT_L(8); PG8_BAR; PG8_WAIT_L(0); PG8_MMA(0, 0, At, B0); PG8_BAR; PG8_SCHED;
            PG8_LDB(B1, 1, 1); PG8_STAGE(PG8_SB(1, 0), b3, voffB);
            PG8_BAR; PG8_WAIT_L(0); PG8_MMA(0, 1, At, B1); PG8_BAR;
            PG8_LDA(At, 1, 1); PG8_STAGE(PG8_SA(1, 0), a3, voffA);
            PG8_BAR; PG8_WAIT_L(0); PG8_MMA(1, 0, At, B0); PG8_BAR; PG8_SCHED;
            PG8_STAGE(PG8_SB(1, 1), b3 + hstep, voffB);
            PG8_WAIT_V(6); PG8_BAR; PG8_MMA(1, 1, At, B1); PG8_BAR;
            }
        }
        if constexpr (ALIGN_EPI) { if (wr == 0) PG8_BAR; }
        if constexpr (!Epi::AFTER_DRAIN) { E(acc, cur, wr, wc, fr, fq); S.done(cur); }
        if (!has_next) break;
#pragma unroll
        for (int a = 0; a < 2; ++a)
#pragma unroll
            for (int b = 0; b < 2; ++b)
#pragma unroll
                for (int m = 0; m < 4; ++m)
#pragma unroll
                    for (int n = 0; n < 2; ++n) acc[a][b][m][n] = (f32x4){0.f, 0.f, 0.f, 0.f};
        cur = nxt; cA = nA; cB = nB; ++ui;
        if constexpr (ALIGN_EPI) { if (wr == 1) PG8_BAR; }
    }
    PG8_WAIT_V(0);
    if constexpr (!ALIGN_EPI) { if (wr == 0) PG8_BAR; }
    PG8_BAR;
    if constexpr (Epi::AFTER_DRAIN) { E.fused(acc, cur, wr, wc, fr, fq, lds, wid, lane); S.done(cur); }
#undef PG8_SA
#undef PG8_SB
#undef PG8_STAGE
#undef PG8_LDA
#undef PG8_LDB
#undef PG8_MMA
#undef PG8_WAIT_V
#undef PG8_WAIT_L
#undef PG8_BAR
#undef PG8_SCHED
}
}

#ifndef PG8_SP2
#define PG8_SP2 true
#endif
#ifndef PG8_ALIGN
#define PG8_ALIGN true
#endif
constexpr int NWAVES = 8, NTHREADS = NWAVES * 64;
constexpr int BATCH = 2, SEQ = 4096, T = BATCH * SEQ, D = 2048;
constexpr int INW = 6160, NPROJ = 6144;
constexpr int GQ = 0, GK = 512, GV = 1024, GG = 2048, MQ = 3072, MK = 4096, MV = 5120;
constexpr int GA_SRC = 3072;
constexpr int NH = 8, NEXP = 16384, NMOD = 6 * D;
constexpr float EPS = 1e-6f;
#ifndef MK_N_LAUNCHES
#define MK_N_LAUNCHES 1
#endif
constexpr int N_PHASES = 13;
constexpr int NSL = 8, SLW = 256, PCH = 64, NCHUNK = (BATCH * SEQ) / PCH;

constexpr size_t MiB = 1u << 20;
constexpr size_t WS_CTL = 0, CTL_ZERO_BYTES = 1 * MiB;
constexpr size_t WS_WIN = 1 * MiB, WS_WGA = 25 * MiB, WS_WOUT = 26 * MiB, WS_WQ = 34 * MiB, WS_KEYS = 42 * MiB, WS_CS = 43 * MiB, WS_KMEAN = 44 * MiB, WS_DEC = 45 * MiB;
constexpr size_t WS_UB = 46 * MiB, WS_VB = 110 * MiB, WS_H = 174 * MiB, WS_CONCAT = 206 * MiB, WS_BCUM = 238 * MiB, WS_UT = 254 * MiB, WS_ST = 286 * MiB, WS_PROJ = 302 * MiB;
constexpr size_t WS_QP = WS_PROJ, WS_EXP = 366 * MiB, WS_GATE = 370 * MiB, WS_GU = 374 * MiB, WS_ACT = 378 * MiB, WS_HQ = 382 * MiB, WS_END = 398 * MiB;
constexpr size_t WS_US = WS_UB + 40 * MiB, WS_VS = WS_VB + 40 * MiB, WS_HS = WS_VB + 41 * MiB;
constexpr int CW_BAR = 4096, CW_Q = 8192, CW_QA = 12288, CW_QB = 13312, CW_MOD = 16384;
static_assert((CW_MOD + 2 * BATCH * NMOD) * 4 <= (int)CTL_ZERO_BYTES, "CTL words inside the memset region");
constexpr size_t WS_MODF = 45 * MiB + 512 * 1024;

constexpr int RING_BYTES = 131072, MISC_OFF = RING_BYTES + 320, LDS_BYTES = 147456;

#define GAS __attribute__((address_space(1)))
#define LAS __attribute__((address_space(3)))
typedef unsigned short bf16;
typedef unsigned v4u __attribute__((ext_vector_type(4)));
typedef unsigned v2u __attribute__((ext_vector_type(2)));
typedef float f32x4 __attribute__((ext_vector_type(4)));
typedef float f32x2 __attribute__((ext_vector_type(2)));
typedef float f32x16 __attribute__((ext_vector_type(16)));
typedef short bf16x8 __attribute__((ext_vector_type(8)));
typedef short s16x4 __attribute__((ext_vector_type(4)));
typedef __bf16 bf16x2_t __attribute__((ext_vector_type(2)));
typedef GAS unsigned gu32;
#define LDS_WAIT() asm volatile("s_waitcnt lgkmcnt(0)" ::: "memory")
#define VM_WAIT() asm volatile("s_waitcnt vmcnt(0)" ::: "memory")
__device__ __forceinline__ unsigned pk2(float lo, float hi) { f32x2 v = {lo, hi}; bf16x2_t b = __builtin_convertvector(v, bf16x2_t); return __builtin_bit_cast(unsigned, b); }
__device__ __forceinline__ float bflo(unsigned u) { return __uint_as_float(u << 16); }
__device__ __forceinline__ float bfhi(unsigned u) { return __uint_as_float(u & 0xffff0000u); }
__device__ __forceinline__ float bf1(short s) { return __uint_as_float(((unsigned)(unsigned short)s) << 16); }
__device__ __forceinline__ bf16x8 pack8(float a0, float a1, float a2, float a3, float a4, float a5, float a6, float a7) { v4u w; w.x = pk2(a0, a1); w.y = pk2(a2, a3); w.z = pk2(a4, a5); w.w = pk2(a6, a7); return __builtin_bit_cast(bf16x8, w); }
__device__ __forceinline__ int crow(int r, int hi) { return (r & 3) + 8 * (r >> 2) + 4 * hi; }
__device__ __forceinline__ float wave_sum(float v) {
#pragma unroll
    for (int o = 1; o < 64; o <<= 1) v += __shfl_xor(v, o);
    return v;
}
typedef short v4i16_t __attribute__((ext_vector_type(4)));
__device__ __forceinline__ s16x4 vtr(const LAS unsigned char* p) { return __builtin_bit_cast(s16x4, __builtin_amdgcn_ds_read_tr16_b64_v4i16((LAS v4i16_t*)p)); }
__device__ __forceinline__ bf16x8 cat4(s16x4 lo, s16x4 hi) { return (bf16x8){lo[0], lo[1], lo[2], lo[3], hi[0], hi[1], hi[2], hi[3]}; }
#define MFMA32(a, b, c) __builtin_amdgcn_mfma_f32_32x32x16_bf16((a), (b), (c), 0, 0, 0)
#define XB_TMO      128
#define XB_XCNT(j)  (256  + 64 * (j))
#define XB_XSUB(j)  (1280 + 64 * (j))
#define XB_XGEN(j)  (2304 + 64 * (j))
#define XB_TOP      3328
#define XB_TOPGEN   3392
#define XCD_BAR_WORDS 3456
#define XB_SPIN_CAP (1u << 18)

__device__ __forceinline__ unsigned xb_ld(unsigned* p)              { return __hip_atomic_load(p, __ATOMIC_RELAXED, __HIP_MEMORY_SCOPE_AGENT); }
__device__ __forceinline__ unsigned xb_add(unsigned* p, unsigned v) { return __hip_atomic_fetch_add(p, v, __ATOMIC_RELAXED, __HIP_MEMORY_SCOPE_AGENT); }
__device__ __forceinline__ unsigned xb_xcc_id() { return (unsigned)__builtin_amdgcn_s_getreg((3 << 11) | 20) & 0xFu; }
#define XB_SPIN(cond, bar) do { unsigned _sp = 0; while (cond) { __builtin_amdgcn_s_sleep(1); \
    if ((++_sp & 255u) == 0u) { if (xb_ld(&(bar)[XB_TMO])) break; if (_sp > XB_SPIN_CAP) { atomicAdd(&(bar)[XB_TMO], 1u); break; } } } } while (0)

struct XcdBarrier {
    unsigned* bar; unsigned x;
    volatile LAS unsigned* st;
};

__device__ __forceinline__ XcdBarrier xcd_barrier_post(unsigned* bar, volatile LAS unsigned* st) {
    XcdBarrier b; b.bar = bar; b.x = xb_xcc_id(); b.st = st;
    if (threadIdx.x == 0) (void)xb_add(&bar[XB_XCNT(b.x)], 1u);
    return b;
}
__device__ __forceinline__ void xcd_barrier_complete(unsigned* bar, unsigned x, unsigned& nloc, unsigned& nx) {
    const unsigned G = gridDim.x * gridDim.y * gridDim.z;
    unsigned sum, cnt, mine, sp = 0u;
    for (;;) {
        sum = 0u; cnt = 0u; mine = 0u;
#pragma unroll
        for (unsigned j = 0; j < 16; ++j) { const unsigned c = xb_ld(&bar[XB_XCNT(j)]); sum += c; cnt += (c > 0u) ? 1u : 0u; mine = (j == x) ? c : mine; }
        if (sum == G) break;
        __builtin_amdgcn_s_sleep(1);
        if ((++sp & 255u) == 0u) { if (xb_ld(&bar[XB_TMO])) break; if (sp > XB_SPIN_CAP) { atomicAdd(&bar[XB_TMO], 1u); break; } }
    }
    nloc = mine > 0u ? mine : 1u; nx = cnt > 0u ? cnt : 1u;
}

__device__ __forceinline__ void xcd_barrier(const XcdBarrier& b) {
    asm volatile("s_waitcnt vmcnt(0)" ::: "memory");
    __syncthreads();
    if (threadIdx.x == 0) {
        unsigned* bar = b.bar;
        __builtin_amdgcn_s_waitcnt(0);
        unsigned nloc = b.st[0], nx = b.st[1];
        if (nloc == 0u) { xcd_barrier_complete(bar, b.x, nloc, nx); b.st[0] = nloc; b.st[1] = nx; }
        const unsigned old = xb_add(&bar[XB_XSUB(b.x)], 1u);
        const unsigned gen = old / nloc;
        if (old + 1u == (gen + 1u) * nloc) {
            __builtin_amdgcn_fence(__ATOMIC_RELEASE, "agent");
            asm volatile("s_waitcnt vmcnt(0)" ::: "memory");
            const unsigned og = xb_add(&bar[XB_TOP], 1u);
            const unsigned tg = og / nx;
            if (og + 1u == (tg + 1u) * nx) xb_add(&bar[XB_TOPGEN], 1u);
            else XB_SPIN(xb_ld(&bar[XB_TOPGEN]) == tg, bar);
            __builtin_amdgcn_fence(__ATOMIC_ACQUIRE, "agent");
            xb_add(&bar[XB_XGEN(b.x)], 1u);
            asm volatile("s_waitcnt vmcnt(0)" ::: "memory");
        } else {
            XB_SPIN(xb_ld(&bar[XB_XGEN(b.x)]) == gen, bar);
            __builtin_amdgcn_fence(__ATOMIC_ACQUIRE, "agent");
            asm volatile("s_waitcnt vmcnt(0)" ::: "memory");
        }
    }
    __syncthreads();
}

struct Ctx {
    LAS unsigned char* lds;
    int tid, lane, wave, vcu, G, gw, ngw;
    const float *x, *c; const int* pos; const float *w_ada, *b_ada, *g1, *w_in, *w_a2, *b_a, *gla_g, *qg, *kg, *w_out, *g2, *w_q, *keys, *pu, *pv;
    float* out;
    unsigned* ctl; long long* MODI; float* MOD;
    bf16 *WIN, *WGA, *WOUT, *WQ, *KEYSB, *H, *CONCAT, *PROJ, *ST;
    unsigned char *UQ, *VQ, *HQ;
    float *CS, *KMEAN, *DEC, *BCUM, *UT, *QP, *GATE, *GU, *US, *VS, *HS; int *EXPI, *ACT;
};

__device__ __forceinline__ void transpose_item(const float* W, int ldw, int K, bf16* WT, int dst_row0, int k0, int n0, LAS float* scr, int lane) {
#pragma unroll 8
    for (int i = 0; i < 32; ++i) { const int kk = 2 * i + (lane >> 5); scr[kk * 33 + (lane & 31)] = W[(size_t)(k0 + kk) * ldw + n0 + (lane & 31)]; }
    LDS_WAIT(); asm volatile("" ::: "memory");
    const int c = lane & 7;
#pragma unroll
    for (int j = 0; j < 4; ++j) { const int n = (lane >> 3) + 8 * j; const LAS float* s = scr + (8 * c) * 33 + n;
        v4u o; o.x = pk2(s[0 * 33], s[1 * 33]); o.y = pk2(s[2 * 33], s[3 * 33]); o.z = pk2(s[4 * 33], s[5 * 33]); o.w = pk2(s[6 * 33], s[7 * 33]);
        *(v4u*)(WT + (size_t)(dst_row0 + n) * K + k0 + 8 * c) = o; }
    LDS_WAIT(); asm volatile("" ::: "memory");
}
__device__ __forceinline__ void convert_item(const float* src, bf16* dst, size_t item, int lane) {
    const f32x4* s = (const f32x4*)(src + item * 8192) + 2 * lane; v4u* d = (v4u*)(dst + item * 8192) + lane;
#pragma unroll 4
    for (int it = 0; it < 16; ++it) { const f32x4 a = s[it * 128], b = s[it * 128 + 1]; v4u o; o.x = pk2(a.x, a.y); o.y = pk2(a.z, a.w); o.z = pk2(b.x, b.y); o.w = pk2(b.z, b.w); d[it * 64] = o; }
}
__device__ __forceinline__ float wave_max(float v) {
#pragma unroll
    for (int o = 1; o < 64; o <<= 1) v = fmaxf(v, __shfl_xor(v, o));
    return v;
}
__device__ __forceinline__ void quant_store(const f32x4 (&v)[8], unsigned char* dst, float* scales, int row, size_t nrows, int lane, int bias) {
    float am = 0.f;
#pragma unroll
    for (int j = 0; j < 8; ++j) am = fmaxf(am, fmaxf(fmaxf(fabsf(v[j].x), fabsf(v[j].y)), fmaxf(fabsf(v[j].z), fabsf(v[j].w))));
    am = wave_max(am);
    const float inv = am > 0.f ? 127.f / am : 0.f;
    if (lane == 0) scales[row] = am > 0.f ? am / 127.f : 1.f;
#pragma unroll
    for (int j = 0; j < 8; ++j) { const int q0 = (int)rintf(v[j].x * inv) + bias, q1 = (int)rintf(v[j].y * inv) + bias, q2 = (int)rintf(v[j].z * inv) + bias, q3 = (int)rintf(v[j].w * inv) + bias;
        *(unsigned*)(dst + ((size_t)j * nrows + row) * 256 + 4 * lane) = (unsigned)(q0 & 0xff) | ((unsigned)(q1 & 0xff) << 8) | ((unsigned)(q2 & 0xff) << 16) | ((unsigned)(q3 & 0xff) << 24); }
}
__device__ __forceinline__ void quant_row(const float* src, unsigned char* dst, float* scales, int row, size_t nrows, int lane, int bias) {
    const f32x4* s = (const f32x4*)src + lane; f32x4 v[8];
#pragma unroll
    for (int j = 0; j < 8; ++j) v[j] = s[64 * j];
    quant_store(v, dst, scales, row, nrows, lane, bias);
}
__device__ __forceinline__ void p0_phase(const Ctx& C, int rep) {
    const int lane = C.lane, gw = C.gw, ngw = C.ngw;
    LAS float* sc = (LAS float*)C.lds;
    for (int i = C.tid; i < BATCH * D; i += NTHREADS) { const float v = C.c[i]; sc[i] = v / (1.f + __expf(-v)); }
    __syncthreads();
    for (int it = gw; it < 192 * 8; it += ngw) {
        const int cc = it % 192, ks = it / 192, col = cc * 64 + lane;
        const float* w = C.w_ada + (size_t)(ks * 256) * NMOD + col; const LAS float* s0 = sc + ks * 256; const LAS float* s1 = sc + D + ks * 256;
        float a0 = 0.f, a1 = 0.f;
#pragma unroll 16
        for (int k = 0; k < 256; ++k) { const float wv = w[(size_t)k * NMOD]; a0 += s0[k] * wv; a1 += s1[k] * wv; }
        long long* mi = C.MODI + rep * 2 * NMOD; atomicAdd((unsigned long long*)(mi + col), (unsigned long long)__double2ll_rn((double)a0 * 1099511627776.0)); atomicAdd((unsigned long long*)(mi + NMOD + col), (unsigned long long)__double2ll_rn((double)a1 * 1099511627776.0));
    }
    __syncthreads();
    LAS float* scr = (LAS float*)(C.lds + C.wave * 16384);
    constexpr int I_IN = 32 * 192, I_SQ = 32 * 64;
    for (int it = gw; it < I_IN + 2 * I_SQ; it += ngw) {
        int r = it;
        if (r < I_IN) { const int kb = r / 192, nb = r % 192, n0 = 32 * nb; transpose_item(C.w_in, INW, D, C.WIN, n0, 64 * kb, n0 < 3072 ? n0 : n0 + 16, scr, lane); continue; } r -= I_IN;
        if (r < I_SQ) { transpose_item(C.w_out, D, D, C.WOUT, 32 * (r % 64), 64 * (r / 64), 32 * (r % 64), scr, lane); continue; } r -= I_SQ;
        transpose_item(C.w_q, D, D, C.WQ, 32 * (r % 64), 64 * (r / 64), 32 * (r % 64), scr, lane);
    }
    for (int it = gw; it < 32; it += ngw) { const int k = it * 64 + lane; const f32x4* s = (const f32x4*)(C.w_in + (size_t)k * INW + GA_SRC);
#pragma unroll
        for (int q = 0; q < 4; ++q) { const f32x4 v = s[q]; C.WGA[(4 * q + 0) * D + k] = (bf16)(pk2(v.x, 0.f) & 0xffff); C.WGA[(4 * q + 1) * D + k] = (bf16)(pk2(v.y, 0.f) & 0xffff);
            C.WGA[(4 * q + 2) * D + k] = (bf16)(pk2(v.z, 0.f) & 0xffff); C.WGA[(4 * q + 3) * D + k] = (bf16)(pk2(v.w, 0.f) & 0xffff); } }
    for (int it = gw; it < 2 * NEXP; it += ngw) {
        if (it < NEXP) quant_row(C.pu + (size_t)it * D, C.UQ, C.US, it, NEXP, lane, 0);
        else quant_row(C.pv + (size_t)(it - NEXP) * D, C.VQ, C.VS, it - NEXP, NEXP, lane, 0);
    }
    for (int it = gw; it < 32; it += ngw) convert_item(C.keys, C.KEYSB, it, lane);
    for (int idx = C.vcu * NTHREADS + C.tid; idx < T * 16; idx += C.G * NTHREADS) {
        const int t = idx >> 4, f = idx & 15; const float inv = powf(500000.0f, -(float)f * 0.0625f); const float ang = (float)C.pos[t] * inv;
        C.CS[2 * idx] = cosf(ang); C.CS[2 * idx + 1] = sinf(ang);
    }
}

template <bool FIRST> __device__ __forceinline__ void norm_mod_phase(const Ctx& C, const float* X, const float* g, int shift_off, int scale_off, bf16* O) {
    if (FIRST) { for (int i = C.vcu * NTHREADS + C.tid; i < BATCH * NMOD; i += C.G * NTHREADS) C.MOD[i] = (float)((double)C.MODI[i] * (1.0 / 1099511627776.0)) + C.b_ada[i % NMOD]; }
    for (int m = C.gw; m < T; m += C.ngw) {
        const int b = m / SEQ; const f32x4* xr = (const f32x4*)(X + (size_t)m * D) + C.lane;
        f32x4 v[8]; float ss = 0.f;
#pragma unroll
        for (int j = 0; j < 8; ++j) { v[j] = xr[64 * j]; ss += (v[j].x * v[j].x + v[j].y * v[j].y) + (v[j].z * v[j].z + v[j].w * v[j].w); }
        const float rstd = rsqrtf(wave_sum(ss) * (1.f / D) + EPS);
        const f32x4* g4 = (const f32x4*)g + C.lane; v2u* o8 = (v2u*)(O + (size_t)m * D) + C.lane;
#pragma unroll
        for (int j = 0; j < 8; ++j) {
            f32x4 sh, sl;
            if (FIRST) { const long long* ph = C.MODI + b * NMOD + shift_off + 4 * (C.lane + 64 * j); const long long* pl = C.MODI + b * NMOD + scale_off + 4 * (C.lane + 64 * j);
                const f32x4 bh = ((const f32x4*)(C.b_ada + shift_off))[C.lane + 64 * j], bl = ((const f32x4*)(C.b_ada + scale_off))[C.lane + 64 * j];
                sh = (f32x4){(float)((double)ph[0] * (1.0 / 1099511627776.0)), (float)((double)ph[1] * (1.0 / 1099511627776.0)), (float)((double)ph[2] * (1.0 / 1099511627776.0)), (float)((double)ph[3] * (1.0 / 1099511627776.0))} + bh;
                sl = (f32x4){(float)((double)pl[0] * (1.0 / 1099511627776.0)), (float)((double)pl[1] * (1.0 / 1099511627776.0)), (float)((double)pl[2] * (1.0 / 1099511627776.0)), (float)((double)pl[3] * (1.0 / 1099511627776.0))} + bl; }
            else { sh = ((const f32x4*)(C.MOD + b * NMOD + shift_off))[C.lane + 64 * j]; sl = ((const f32x4*)(C.MOD + b * NMOD + scale_off))[C.lane + 64 * j]; }
            const f32x4 y = v[j] * rstd * g4[64 * j] * (1.f + sl) + sh; v2u w; w.x = pk2(y.x, y.y); w.y = pk2(y.z, y.w); o8[64 * j] = w; v[j] = y; }
        if (!FIRST) quant_store(v, C.HQ, C.HS, m, T, C.lane, 0);
    }
}

__device__ __forceinline__ void gla_prep_item(const Ctx& C, int b, int n, int ch) {
    const int lane = C.lane, w = C.wave, fr = lane & 15, fq = lane >> 4, rt = w & 3, kh = w >> 2; const size_t t0 = (size_t)b * SEQ + 64 * n;
    const bf16* ap = C.H + (t0 + 16 * rt + fr) * D + kh * 1024 + 8 * fq; const bf16* bp = C.WGA + fr * D + kh * 1024 + 8 * fq;
    f32x4 acc = {0.f, 0.f, 0.f, 0.f};
#pragma unroll 16
    for (int s = 0; s < 32; ++s) acc = __builtin_amdgcn_mfma_f32_16x16x32_bf16(*(const bf16x8*)(ap + 32 * s), *(const bf16x8*)(bp + 32 * s), acc, 0, 0, 0);
    LAS float* gaP = (LAS float*)C.lds;
#pragma unroll
    for (int r = 0; r < 4; ++r) gaP[kh * 1024 + (16 * rt + 4 * fq + r) * 16 + fr] = acc[r];
    __syncthreads();
    const int c = C.tid & 255, th = C.tid >> 8, col = ch * 256 + c; float wc[16];
#pragma unroll
    for (int r = 0; r < 16; ++r) wc[r] = C.w_a2[r * 512 + col];
    const float ba = C.b_a[col]; float cum = 0.f, la[32];
#pragma unroll
    for (int k = 0; k < 32; ++k) { const int tok = 32 * th + k;
        const LAS f32x4* g0 = (const LAS f32x4*)(gaP + tok * 16); const LAS f32x4* g1 = (const LAS f32x4*)(gaP + 1024 + tok * 16); float z = ba;
#pragma unroll
        for (int q = 0; q < 4; ++q) { const f32x4 gv = g0[q] + g1[q]; z += gv.x * wc[4 * q] + gv.y * wc[4 * q + 1] + gv.z * wc[4 * q + 2] + gv.w * wc[4 * q + 3]; }
        cum += (fminf(z, 0.f) - __logf(1.f + __expf(-fabsf(z)))) * 0.0625f; la[k] = cum; }
    if (th == 0) gaP[2048 + c] = cum;
    __syncthreads();
    const float base = th ? gaP[2048 + c] : 0.f; float* bo = C.BCUM + (t0 + 32 * th) * 512 + col;
#pragma unroll
    for (int k = 0; k < 32; ++k) bo[(size_t)k * 512] = la[k] + base;
    __syncthreads();
}
__device__ __forceinline__ void moba_prep_item(const Ctx& C, int b, int h, int blk, int rep) {
    const int lane = C.lane, w = C.wave, i = lane & 15, tg = lane >> 4; const size_t t0 = (size_t)b * SEQ + 256 * blk;
    float qg[8], kg[8], km[8];
#pragma unroll
    for (int j = 0; j < 8; ++j) { qg[j] = C.qg[8 * i + j]; kg[j] = C.kg[8 * i + j]; km[j] = 0.f; }
    v4u rawq[8], rawk[8];
#pragma unroll
    for (int it = 0; it < 8; ++it) { const size_t tok = t0 + 32 * w + 4 * it + tg; rawq[it] = *(const v4u*)(C.PROJ + tok * NPROJ + MQ + h * 128 + 8 * i); rawk[it] = *(const v4u*)(C.PROJ + tok * NPROJ + MK + h * 128 + 8 * i); }
#pragma unroll
    for (int it = 0; it < 8; ++it) {
        const size_t tok = t0 + 32 * w + 4 * it + tg;
        float cs[16];
        if (i < 4) { const f32x4* cp = (const f32x4*)(C.CS + tok * 32 + (i & 1) * 16);
#pragma unroll
            for (int q = 0; q < 4; ++q) { const f32x4 v = cp[q]; cs[4 * q] = v.x; cs[4 * q + 1] = v.y; cs[4 * q + 2] = v.z; cs[4 * q + 3] = v.w; } }
        else {
#pragma unroll
            for (int q = 0; q < 16; ++q) cs[q] = 0.f; }
#pragma unroll
        for (int which = 0; which < 2; ++which) {
            bf16* p = C.PROJ + tok * NPROJ + (which ? MK : MQ) + h * 128 + 8 * i;
            const v4u raw = which ? rawk[it] : rawq[it]; float xv[8];
            xv[0] = bflo(raw.x); xv[1] = bfhi(raw.x); xv[2] = bflo(raw.y); xv[3] = bfhi(raw.y); xv[4] = bflo(raw.z); xv[5] = bfhi(raw.z); xv[6] = bflo(raw.w); xv[7] = bfhi(raw.w);
            float ss = 0.f;
#pragma unroll
            for (int j = 0; j < 8; ++j) ss += xv[j] * xv[j];
            ss += __shfl_xor(ss, 1); ss += __shfl_xor(ss, 2); ss += __shfl_xor(ss, 4); ss += __shfl_xor(ss, 8);
            const float rstd = rsqrtf(ss * (1.f / 128.f) + EPS);
#pragma unroll
            for (int j = 0; j < 8; ++j) xv[j] = xv[j] * rstd * (which ? kg[j] : qg[j]);
#pragma unroll
            for (int j = 0; j < 8; ++j) { const float o = __shfl_xor(xv[j], 2); const float cv = cs[2 * j], sv = cs[2 * j + 1];
                if (i < 2) xv[j] = xv[j] * cv - o * sv; else if (i < 4) xv[j] = xv[j] * cv + o * sv; }
            v4u o; o.x = pk2(xv[0], xv[1]); o.y = pk2(xv[2], xv[3]); o.z = pk2(xv[4], xv[5]); o.w = pk2(xv[6], xv[7]);
            if (rep) *(v4u*)(C.CONCAT + tok * D + which * 1024 + h * 128 + 8 * i) = o; else *(v4u*)p = o;
            if (which) {
#pragma unroll
                for (int j = 0; j < 8; ++j) km[j] += xv[j]; }
        }
    }
    LAS float* red = (LAS float*)C.lds;
#pragma unroll
    for (int j = 0; j < 8; ++j) { km[j] += __shfl_xor(km[j], 16); km[j] += __shfl_xor(km[j], 32); }
    if (lane < 16) {
#pragma unroll
        for (int j = 0; j < 8; ++j) red[w * 128 + 8 * i + j] = km[j]; }
    __syncthreads();
    if (C.tid < 128) { float s = 0.f;
#pragma unroll
        for (int ww = 0; ww < 8; ++ww) s += red[ww * 128 + C.tid];
        C.KMEAN[((size_t)(b * NH + h) * 16 + blk) * 128 + C.tid] = s * (1.f / 256.f); }
    __syncthreads();
}

constexpr int KP = 272, VP = 320;
constexpr int MB_BUF = 65536, MB_KT = 16384, MB_V0 = 32768;
__device__ __forceinline__ void moba_unit(const Ctx& C, int b, int h, int qb, int half) {
    const int lane = C.lane, w = C.wave, r = lane & 31, hh = lane >> 5, grp = w >> 2, wq = w & 3;
    const size_t tb = (size_t)b * SEQ; const int q0 = qb * 256 + 128 * half;
    const bf16* Qh = C.PROJ + MQ + h * 128; const bf16* Kh = C.PROJ + MK + h * 128; const bf16* Vh = C.PROJ + MV + h * 128;
    bf16x8 qf[8];
    { const bf16* qrow = Qh + (tb + q0 + 32 * wq + r) * NPROJ + 8 * hh;
#pragma unroll
      for (int s = 0; s < 8; ++s) qf[s] = *(const bf16x8*)(qrow + 16 * s); }
    unsigned selmask = 0u;
    { float g0 = -INFINITY, g1 = -INFINITY, g2 = -INFINITY; int i0 = -1, i1 = -1, i2 = -1;
      const float* km = C.KMEAN + ((size_t)(b * NH + h) * 16) * 128 + 8 * hh;
      for (int j = 0; j < qb; ++j) {
          float acc = 0.f;
#pragma unroll
          for (int s = 0; s < 8; ++s) { const f32x4 k0 = *(const f32x4*)(km + j * 128 + 16 * s), k1 = *(const f32x4*)(km + j * 128 + 16 * s + 4);
              acc += bf1(qf[s][0]) * k0.x + bf1(qf[s][1]) * k0.y + bf1(qf[s][2]) * k0.z + bf1(qf[s][3]) * k0.w + bf1(qf[s][4]) * k1.x + bf1(qf[s][5]) * k1.y + bf1(qf[s][6]) * k1.z + bf1(qf[s][7]) * k1.w; }
          acc += __shfl_xor(acc, 32);
          if (acc > g0) { g2 = g1; i2 = i1; g1 = g0; i1 = i0; g0 = acc; i0 = j; }
          else if (acc > g1) { g2 = g1; i2 = i1; g1 = acc; i1 = j; }
          else if (acc > g2) { g2 = acc; i2 = j; }
      }
      if (i0 >= 0) selmask |= 1u << i0; if (i1 >= 0) selmask |= 1u << i1; if (i2 >= 0) selmask |= 1u << i2; }
    asm volatile("s_waitcnt vmcnt(0)" ::: "memory");
    const int nown = 2 * half + 2, NT = nown + 4 * qb, NS = (NT + 1) >> 1;
    unsigned kso[2], vso[2];
#pragma unroll
    for (int j = 0; j < 2; ++j) { const int row = 8 * w + 4 * j + (lane >> 4), cp = lane & 15; kso[j] = (unsigned)(row * (NPROJ * 2) + 16 * (cp ^ (row & 15))); vso[j] = (unsigned)(row * (NPROJ * 2) + 16 * (cp ^ ((row & 3) << 2))); }
#define MB_KEY0(i) ((i) < nown ? qb * 256 + 64 * (i) : (((i) - nown) >> 2) * 256 + 64 * (((i) - nown) & 3))
#define MB_DMA(s, buf) do { _Pragma("unroll") for (int tl = 0; tl < 2; ++tl) { int i_ = 2 * (s) + tl; if (i_ >= NT) i_ = NT - 1; const size_t ks_ = (size_t)__builtin_amdgcn_readfirstlane((int)(MB_KEY0(i_))) * (NPROJ * 2); \
        const char* kp_ = (const char*)(Kh + tb * NPROJ) + ks_; const char* vp_ = (const char*)(Vh + tb * NPROJ) + ks_; _Pragma("unroll") for (int j = 0; j < 2; ++j) { \
            __builtin_amdgcn_global_load_lds((const unsigned*)(kp_ + kso[j]), (LAS unsigned*)(C.lds + (buf) * MB_BUF + tl * MB_KT + (2 * w + j) * 1024), 16, 0, 0); \
            __builtin_amdgcn_global_load_lds((const unsigned*)(vp_ + vso[j]), (LAS unsigned*)(C.lds + (buf) * MB_BUF + MB_V0 + tl * MB_KT + (2 * w + j) * 1024), 16, 0, 0); } } } while (0)
    MB_DMA(0, 0); __syncthreads();
    float m_run = -1e30f, l_run = 0.f; f32x16 o[4];
#pragma unroll
    for (int dt = 0; dt < 4; ++dt)
#pragma unroll
        for (int q = 0; q < 16; ++q) o[dt][q] = 0.f;
    const float c2 = 0.08838834764831845f * 1.4426950408889634f;
    const int xr = r & 15, vq = (lane & 15) >> 2;
    const int kfo = grp * MB_KT + r * 256, vfo = MB_V0 + grp * MB_KT + (4 * hh + vq) * 256 + 32 * ((lane >> 4) & 1) + 8 * (lane & 3);
    for (int s = 0; s < NS; ++s) {
        const int buf = s & 1;
        if (s + 1 < NS) MB_DMA(s + 1, buf ^ 1);
        const int i = 2 * s + grp; const bool own = i < nown; const int tt = i, blk = own ? qb : (i - nown) >> 2;
        const bool mine = own || ((selmask >> blk) & 1u);
        const bool need = i < NT && (own ? (64 * tt <= 128 * half + 32 * wq + 31) : (__ballot(mine) != 0ull));
        if (need) {
            const LAS unsigned char* kb = C.lds + buf * MB_BUF + kfo;
            bf16x8 ka[4], kc[4];
#define MB_KLOAD(dst, s2) do { _Pragma("unroll") for (int u_ = 0; u_ < 2; ++u_) { const int co_ = ((2 * (2 * (s2) + u_) + hh) ^ xr) << 4; dst[2 * u_] = *(const LAS bf16x8*)(kb + co_); dst[2 * u_ + 1] = *(const LAS bf16x8*)(kb + 32 * 256 + co_); } } while (0)
#define MB_QK(src, s2) do { _Pragma("unroll") for (int u_ = 0; u_ < 2; ++u_) { p0 = MFMA32(src[2 * u_], qf[2 * (s2) + u_], p0); p1 = MFMA32(src[2 * u_ + 1], qf[2 * (s2) + u_], p1); } } while (0)
            MB_KLOAD(ka, 0); MB_KLOAD(kc, 1); __builtin_amdgcn_sched_barrier(0);
            f32x16 p0 = {0.f, 0.f, 0.f, 0.f, 0.f, 0.f, 0.f, 0.f, 0.f, 0.f, 0.f, 0.f, 0.f, 0.f, 0.f, 0.f}, p1 = p0;
            MB_QK(ka, 0); MB_KLOAD(ka, 2); __builtin_amdgcn_sched_barrier(0);
            MB_QK(kc, 1); MB_KLOAD(kc, 3); __builtin_amdgcn_sched_barrier(0);
            MB_QK(ka, 2); MB_QK(kc, 3);
#undef MB_KLOAD
#undef MB_QK
            const LAS unsigned char* vb = C.lds + buf * MB_BUF + vfo;
            s16x4 va[8], vc[8];
#define MB_VLOAD(dst, dt) do { const LAS unsigned char* vd_ = vb + 64 * ((dt) ^ vq); _Pragma("unroll") for (int kk = 0; kk < 4; ++kk) { dst[2 * kk] = vtr(vd_ + (16 * kk) * 256); dst[2 * kk + 1] = vtr(vd_ + (16 * kk + 8) * 256); } } while (0)
#define MB_PV(src, dt) do { _Pragma("unroll") for (int kk = 0; kk < 4; ++kk) o[dt] = MFMA32(cat4(src[2 * kk], src[2 * kk + 1]), pf[kk], o[dt]); } while (0)
            MB_VLOAD(va, 0);
            __builtin_amdgcn_sched_barrier(0);
            if (own) { const int qi = 128 * half + 32 * wq + r;
#pragma unroll
                for (int q = 0; q < 16; ++q) { const int kk = 64 * tt + crow(q, hh); if (kk > qi) p0[q] = -INFINITY; if (kk + 32 > qi) p1[q] = -INFINITY; } }
            else if (!mine) {
#pragma unroll
                for (int q = 0; q < 16; ++q) { p0[q] = -INFINITY; p1[q] = -INFINITY; } }
            float mx = fmaxf(p0[0], p1[0]);
#pragma unroll
            for (int q = 1; q < 16; ++q) mx = fmaxf(mx, fmaxf(p0[q], p1[q]));
            { auto rr = __builtin_amdgcn_permlane32_swap(__float_as_uint(mx), __float_as_uint(mx), false, false); mx = fmaxf(__uint_as_float(rr[0]), __uint_as_float(rr[1])); }
            const float m_new = fmaxf(m_run, mx * c2), alpha = __builtin_amdgcn_exp2f(m_run - m_new);
            m_run = m_new; float rs = 0.f;
#pragma unroll
            for (int q = 0; q < 16; ++q) { p0[q] = __builtin_amdgcn_exp2f(p0[q] * c2 - m_new); p1[q] = __builtin_amdgcn_exp2f(p1[q] * c2 - m_new); rs += p0[q] + p1[q]; }
            l_run = l_run * alpha + rs;
            if (__ballot(alpha != 1.f) != 0ull) {
#pragma unroll
                for (int dt = 0; dt < 4; ++dt)
#pragma unroll
                    for (int q = 0; q < 16; ++q) o[dt][q] *= alpha; }
            bf16x8 pf[4];
            pf[0] = pack8(p0[0], p0[1], p0[2], p0[3], p0[4], p0[5], p0[6], p0[7]); pf[1] = pack8(p0[8], p0[9], p0[10], p0[11], p0[12], p0[13], p0[14], p0[15]);
            pf[2] = pack8(p1[0], p1[1], p1[2], p1[3], p1[4], p1[5], p1[6], p1[7]); pf[3] = pack8(p1[8], p1[9], p1[10], p1[11], p1[12], p1[13], p1[14], p1[15]);
            MB_VLOAD(vc, 1); __builtin_amdgcn_sched_barrier(0); MB_PV(va, 0); __builtin_amdgcn_sched_barrier(0);
            MB_VLOAD(va, 2); __builtin_amdgcn_sched_barrier(0); MB_PV(vc, 1); __builtin_amdgcn_sched_barrier(0);
            MB_VLOAD(vc, 3); __builtin_amdgcn_sched_barrier(0); MB_PV(va, 2); __builtin_amdgcn_sched_barrier(0);
            MB_PV(vc, 3);
#undef MB_VLOAD
#undef MB_PV
        }
        __syncthreads();
    }
#undef MB_DMA
#undef MB_KEY0
    LAS float* mo = (LAS float*)C.lds + wq * (66 * 64);
    if (grp == 1) {
#pragma unroll
        for (int dt = 0; dt < 4; ++dt)
#pragma unroll
            for (int q = 0; q < 16; ++q) mo[(16 * dt + q) * 64 + lane] = o[dt][q];
        mo[64 * 64 + lane] = m_run; mo[65 * 64 + lane] = l_run; }
    __syncthreads();
    if (grp == 0) {
        const float m1 = mo[64 * 64 + lane], l1 = mo[65 * 64 + lane], m = fmaxf(m_run, m1), a0 = __builtin_amdgcn_exp2f(m_run - m), a1 = __builtin_amdgcn_exp2f(m1 - m);
        float l = l_run * a0 + l1 * a1; l += __shfl_xor(l, 32);
        const float inv = 1.f / l, s0 = a0 * inv, s1 = a1 * inv;
        bf16* op = C.CONCAT + (tb + q0 + 32 * wq + r) * D + 1024 + h * 128 + 4 * hh;
#pragma unroll
        for (int dt = 0; dt < 4; ++dt)
#pragma unroll
            for (int k4 = 0; k4 < 4; ++k4) { float y[4];
#pragma unroll
                for (int q = 0; q < 4; ++q) y[q] = o[dt][4 * k4 + q] * s0 + mo[(16 * dt + 4 * k4 + q) * 64 + lane] * s1;
                v2u wv; wv.x = pk2(y[0], y[1]); wv.y = pk2(y[2], y[3]); *(v2u*)(op + 32 * dt + 8 * k4) = wv; }
    }
    __syncthreads();
}

constexpr int GKP = 192;
__device__ __forceinline__ void gla_v_to_lds(const Ctx& C, size_t t0, int h, int off) {
#pragma unroll
    for (int pp = 0; pp < 2; ++pp) { const int p = C.tid + 512 * pp; const v4u v = *(const v4u*)(C.PROJ + (t0 + (p >> 4)) * NPROJ + GV + h * 128 + 8 * (p & 15)); *(LAS v4u*)(C.lds + off + (p >> 4) * VP + 16 * (p & 15)) = v; }
}
__device__ __forceinline__ void gla_u_item(const Ctx& C, int b, int h, int n) {
    const int tid = C.tid, lane = C.lane, w = C.wave, r = lane & 31, hh = lane >> 5; const size_t t0 = (size_t)b * SEQ + 64 * n; const int bhn = (b * NH + h) * 64 + n;
    constexpr int KT = 0, VT = 64 * GKP;
    { const int tok = tid >> 3, ch = tid & 7;
      const v4u raw = *(const v4u*)(C.PROJ + (t0 + tok) * NPROJ + GK + h * 64 + 8 * ch);
      const f32x4* bp = (const f32x4*)(C.BCUM + (t0 + tok) * 512 + h * 64 + 8 * ch); const f32x4* bl = (const f32x4*)(C.BCUM + (t0 + 63) * 512 + h * 64 + 8 * ch);
      const f32x4 b0 = bp[0], b1 = bp[1], l0 = bl[0], l1 = bl[1];
      const bf16x8 kv = pack8(bflo(raw.x) * __expf(l0.x - b0.x), bfhi(raw.x) * __expf(l0.y - b0.y), bflo(raw.y) * __expf(l0.z - b0.z), bfhi(raw.y) * __expf(l0.w - b0.w),
                              bflo(raw.z) * __expf(l1.x - b1.x), bfhi(raw.z) * __expf(l1.y - b1.y), bflo(raw.w) * __expf(l1.z - b1.z), bfhi(raw.w) * __expf(l1.w - b1.w));
      *(LAS bf16x8*)(C.lds + KT + tok * GKP + 16 * ch) = kv;
      if (tok == 63) { f32x4* dp = (f32x4*)(C.DEC + (size_t)bhn * 64 + 8 * ch); dp[0] = (f32x4){__expf(l0.x), __expf(l0.y), __expf(l0.z), __expf(l0.w)}; dp[1] = (f32x4){__expf(l1.x), __expf(l1.y), __expf(l1.z), __expf(l1.w)}; } }
    gla_v_to_lds(C, t0, h, VT);
    __syncthreads();
    const int mt = w & 3, nt = w >> 2, q = (lane & 15) >> 2, cb = (16 * ((lane >> 4) & 1) + 4 * (lane & 3)) * 2;
    const LAS unsigned char* va = C.lds + VT + (4 * hh + q) * VP + cb + mt * 64; const LAS unsigned char* ka = C.lds + KT + (4 * hh + q) * GKP + cb + nt * 64;
    f32x16 acc;
#pragma unroll
    for (int i = 0; i < 16; ++i) acc[i] = 0.f;
#pragma unroll
    for (int s = 0; s < 4; ++s) acc = MFMA32(cat4(vtr(va + 16 * s * VP), vtr(va + (16 * s + 8) * VP)), cat4(vtr(ka + 16 * s * GKP), vtr(ka + (16 * s + 8) * GKP)), acc);
    float* up = C.UT + (size_t)bhn * 8192 + (32 * mt) * 64 + 32 * nt + r;
#pragma unroll
    for (int i = 0; i < 16; ++i) up[crow(i, hh) * 64] = acc[i];
    __syncthreads();
}
__device__ __forceinline__ void p4_phase(const Ctx& C, int rep) {
    volatile LAS int* qslot = (volatile LAS int*)(C.lds + MISC_OFF + 64);
    const int xcc = (int)(xb_xcc_id() & 7u); unsigned* cnt = C.ctl + CW_Q + 64 * 16 * rep;
    for (;;) {
        __syncthreads();
        if (C.tid == 0) { int res = -1;
            for (int s = 0; s < 8 && res < 0; ++s) { const int q = (xcc + s) & 7;
                if (__hip_atomic_load(cnt + 64 * q, __ATOMIC_RELAXED, __HIP_MEMORY_SCOPE_AGENT) >= 64u) continue;
                const unsigned id = atomicAdd(cnt + 64 * q, 1u); if (id < 64u) res = q * 64 + (int)id; }
            if (res < 0) { const unsigned id = atomicAdd(cnt + 64 * 8, 1u); res = id < 1024u ? 512 + (int)id : -1; }
            *qslot = res; }
        __syncthreads();
        const int id = *qslot;
        if (id < 0) break;
        if (id < 512) { const int q = id >> 6, li = id & 63, bh = 2 * q + (li & 1), rank = li >> 1; moba_unit(C, bh >> 3, bh & 7, 15 - (rank >> 1), 1 - (rank & 1)); }
        else { const int g = id - 512; gla_u_item(C, g >> 9, (g >> 6) & 7, g & 63); }
    }
}

__device__ __forceinline__ void p5_phase(const Ctx& C) {
    for (int idx = C.vcu * NTHREADS + C.tid; idx < 16 * 8192; idx += C.G * NTHREADS) {
        const int bh = idx >> 13, rem = idx & 8191, dk = rem & 63; float s = 0.f;
        const float* up = C.UT + (size_t)bh * 64 * 8192 + rem; const float* dp = C.DEC + (size_t)bh * 64 * 64 + dk; bf16* sp = C.ST + (size_t)bh * 64 * 8192 + rem;
#pragma unroll 16
        for (int n = 0; n < 64; ++n) { sp[(size_t)n * 8192] = (bf16)(pk2(s, 0.f) & 0xffffu); s = dp[n * 64] * s + up[(size_t)n * 8192]; }
    }
}

__device__ __forceinline__ void gla_out_item(const Ctx& C, int b, int h, int n) {
    const int lane = C.lane, w = C.wave, r = lane & 31, hh = lane >> 5, dvt = w & 3, lt = w >> 2; const size_t t0 = (size_t)b * SEQ + 64 * n; const int bhn = (b * NH + h) * 64 + n;
    constexpr int VT = 0, RED = 64 * VP;
    gla_v_to_lds(C, t0, h, VT);
    bf16x8 qd[4];
    { const size_t tl = t0 + 32 * lt + r;
#pragma unroll
      for (int s = 0; s < 4; ++s) { const v4u raw = *(const v4u*)(C.PROJ + tl * NPROJ + GQ + h * 64 + 16 * s + 8 * hh); const f32x4* bp = (const f32x4*)(C.BCUM + tl * 512 + h * 64 + 16 * s + 8 * hh); const f32x4 b0 = bp[0], b1 = bp[1];
          qd[s] = pack8(bflo(raw.x) * 0.125f * __expf(b0.x), bfhi(raw.x) * 0.125f * __expf(b0.y), bflo(raw.y) * 0.125f * __expf(b0.z), bfhi(raw.y) * 0.125f * __expf(b0.w),
                        bflo(raw.z) * 0.125f * __expf(b1.x), bfhi(raw.z) * 0.125f * __expf(b1.y), bflo(raw.w) * 0.125f * __expf(b1.z), bfhi(raw.w) * 0.125f * __expf(b1.w)); } }
    __syncthreads();
    f32x16 o;
#pragma unroll
    for (int i = 0; i < 16; ++i) o[i] = 0.f;
    const LAS unsigned char* va = C.lds + VT + (4 * hh + ((lane & 15) >> 2)) * VP + (16 * ((lane >> 4) & 1) + 4 * (lane & 3)) * 2 + dvt * 64;
    for (int mt = 0; mt <= lt; ++mt) {
        const size_t tm = t0 + 32 * mt + r; f32x16 X;
#pragma unroll
        for (int i = 0; i < 16; ++i) X[i] = 0.f;
#pragma unroll
        for (int s = 0; s < 4; ++s) { const v4u raw = *(const v4u*)(C.PROJ + tm * NPROJ + GK + h * 64 + 16 * s + 8 * hh); const f32x4* bp = (const f32x4*)(C.BCUM + tm * 512 + h * 64 + 16 * s + 8 * hh); const f32x4 b0 = bp[0], b1 = bp[1];
            const bf16x8 kd = pack8(bflo(raw.x) * __expf(-b0.x), bfhi(raw.x) * __expf(-b0.y), bflo(raw.y) * __expf(-b0.z), bfhi(raw.y) * __expf(-b0.w),
                                    bflo(raw.z) * __expf(-b1.x), bfhi(raw.z) * __expf(-b1.y), bflo(raw.w) * __expf(-b1.z), bfhi(raw.w) * __expf(-b1.w));
            X = MFMA32(kd, qd[s], X); }
        if (mt == lt) {
#pragma unroll
            for (int i = 0; i < 16; ++i) if (crow(i, hh) > r) X[i] = 0.f; }
        const bf16x8 pf0 = pack8(X[0], X[1], X[2], X[3], X[4], X[5], X[6], X[7]), pf1 = pack8(X[8], X[9], X[10], X[11], X[12], X[13], X[14], X[15]);
        o = MFMA32(cat4(vtr(va + (32 * mt) * VP), vtr(va + (32 * mt + 8) * VP)), pf0, o);
        o = MFMA32(cat4(vtr(va + (32 * mt + 16) * VP), vtr(va + (32 * mt + 24) * VP)), pf1, o);
    }
    { const bf16* sp = C.ST + (size_t)bhn * 8192 + (32 * dvt + r) * 64 + 8 * hh;
#pragma unroll
      for (int s = 0; s < 4; ++s) o = MFMA32(*(const bf16x8*)(sp + 16 * s), qd[s], o); }
    float ss = 0.f;
#pragma unroll
    for (int i = 0; i < 16; ++i) ss += o[i] * o[i];
    ss += __shfl_xor(ss, 32);
    LAS float* red = (LAS float*)(C.lds + RED);
    if (hh == 0) red[dvt * 64 + 32 * lt + r] = ss;
    __syncthreads();
    const int l = 32 * lt + r; const float rstd = rsqrtf((red[l] + red[64 + l] + red[128 + l] + red[192 + l]) * (1.f / 128.f) + EPS);
    const size_t tl = t0 + l;
#pragma unroll
    for (int k4 = 0; k4 < 4; ++k4) { const int d0 = 32 * dvt + 8 * k4 + 4 * hh;
        const v2u graw = *(const v2u*)(C.PROJ + tl * NPROJ + GG + h * 128 + d0); const f32x4 gn = *(const f32x4*)(C.gla_g + d0);
        const float ga = bflo(graw.x), gb = bfhi(graw.x), gc = bflo(graw.y), gd = bfhi(graw.y);
        const float y0 = o[4 * k4] * rstd * gn.x * (ga / (1.f + __expf(-ga))), y1 = o[4 * k4 + 1] * rstd * gn.y * (gb / (1.f + __expf(-gb)));
        const float y2 = o[4 * k4 + 2] * rstd * gn.z * (gc / (1.f + __expf(-gc))), y3 = o[4 * k4 + 3] * rstd * gn.w * (gd / (1.f + __expf(-gd)));
        v2u wv; wv.x = pk2(y0, y1); wv.y = pk2(y2, y3); *(v2u*)(C.CONCAT + tl * D + h * 128 + d0) = wv; }
    __syncthreads();
}

#define INS16(L, xin) do { int x_ = (xin); _Pragma("unroll") for (int i_ = 0; i_ < 16; ++i_) { const int hi_ = max(L[i_], x_); x_ = min(L[i_], x_); L[i_] = hi_; } } while (0)
#define CE_DESC(a, b) do { const int hi_ = max(a, b), lo_ = min(a, b); a = hi_; b = lo_; } while (0)
#define BITONIC_MERGE16(L) do { _Pragma("unroll") for (int j_ = 8; j_ > 0; j_ >>= 1) _Pragma("unroll") for (int i_ = 0; i_ < 16; ++i_) if ((i_ & j_) == 0) CE_DESC(L[i_], L[i_ | j_]); } while (0)
#define SORT16(L) do { _Pragma("unroll") for (int k_ = 2; k_ <= 16; k_ <<= 1) _Pragma("unroll") for (int j_ = k_ >> 1; j_ > 0; j_ >>= 1) _Pragma("unroll") for (int i_ = 0; i_ < 16; ++i_) { const int l_ = i_ ^ j_; \
        if (l_ > i_) { if ((i_ & k_) == 0) CE_DESC(L[i_], L[l_]); else CE_DESC(L[l_], L[i_]); } } } while (0)
#define MERGE16(L, M) do { _Pragma("unroll") for (int i_ = 0; i_ < 16; ++i_) L[i_] = max(L[i_], M[15 - i_]); BITONIC_MERGE16(L); } while (0)
__device__ __forceinline__ int ord_key(float v) { int u = __float_as_int(v); return u ^ ((u >> 31) & 0x7fffffff); }
__device__ __forceinline__ float ord_val(int k, int mask) { int u = k & ~mask; return __int_as_float(u ^ ((u >> 31) & 0x7fffffff)); }
__device__ __forceinline__ void peer_topk_item(const Ctx& C, int tg, int hd) {
    const int lane = C.lane, r = lane & 31, hh = lane >> 5; const size_t tok = (size_t)tg * 32 + r;
    int La[16], Lb[16];
#pragma unroll
    for (int c = 0; c < 2; ++c) {
        int L[16];
#pragma unroll
        for (int i = 0; i < 16; ++i) L[i] = (int)0x80000000;
        bf16x8 qf[8];
        { const float* qp = C.QP + tok * D + hd * 256 + c * 128 + 8 * hh;
#pragma unroll
          for (int s = 0; s < 8; ++s) { const f32x4 a = *(const f32x4*)(qp + 16 * s), bq = *(const f32x4*)(qp + 16 * s + 4); qf[s] = pack8(a.x, a.y, a.z, a.w, bq.x, bq.y, bq.z, bq.w); } }
        int G[16];
#pragma unroll 1
        for (int kt = 0; kt < 4; ++kt) {
            const bf16* kp = C.KEYSB + ((size_t)(hd * 2 + c) * 128 + 32 * kt + r) * 128 + 8 * hh; f32x16 X;
#pragma unroll
            for (int i = 0; i < 16; ++i) X[i] = 0.f;
#pragma unroll
            for (int s = 0; s < 8; ++s) X = MFMA32(*(const bf16x8*)(kp + 16 * s), qf[s], X);
#pragma unroll
            for (int i = 0; i < 16; ++i) G[i] = (ord_key(X[i]) & ~127) | (32 * kt + crow(i, hh));
            SORT16(G); MERGE16(L, G);
        }
        int M[16];
#pragma unroll
        for (int i = 0; i < 16; ++i) M[i] = __shfl_xor(L[i], 32);
        MERGE16(L, M);
#pragma unroll
        for (int i = 0; i < 16; ++i) { if (c == 0) La[i] = L[i]; else Lb[i] = L[i]; }
    }
    float sa[16], sb[16]; int Lc[16];
#pragma unroll
    for (int i = 0; i < 16; ++i) { sa[i] = ord_val(La[i], 127); sb[i] = ord_val(Lb[i], 127); Lc[i] = (int)0x80000000; }
#pragma unroll
    for (int i = 0; i < 16; ++i)
#pragma unroll
        for (int j = 0; j < 16; ++j) if ((i + 1) * (j + 1) <= 16) INS16(Lc, (ord_key(sa[i] + sb[j]) & ~255) | (i * 16 + j));
    float e[16], sum = 0.f; int ex[16]; const float mx = ord_val(Lc[0], 255);
#pragma unroll
    for (int i = 0; i < 16; ++i) {
        e[i] = __expf(ord_val(Lc[i], 255) - mx); sum += e[i];
        const int ii = (Lc[i] >> 4) & 15, jj = Lc[i] & 15; int i1 = 0, i2 = 0;
#pragma unroll
        for (int q = 0; q < 16; ++q) { i1 = (ii == q) ? (La[q] & 127) : i1; i2 = (jj == q) ? (Lb[q] & 127) : i2; }
        ex[i] = i1 * 128 + i2;
    }
    const float inv = 1.f / sum;
    if (hh == 0) {
        v4u* ep = (v4u*)(C.EXPI + tok * 128 + hd * 16); f32x4* gp = (f32x4*)(C.GATE + tok * 128 + hd * 16); f32x4* up = (f32x4*)(C.GU + tok * 128 + hd * 16); v4u* ap = (v4u*)(C.ACT + tok * 128 + hd * 16);
        const float hs = C.HS[tok];
#pragma unroll
        for (int q = 0; q < 4; ++q) { ep[q] = (v4u){(unsigned)ex[4 * q], (unsigned)ex[4 * q + 1], (unsigned)ex[4 * q + 2], (unsigned)ex[4 * q + 3]};
            gp[q] = (f32x4){e[4 * q] * inv * C.VS[ex[4 * q]], e[4 * q + 1] * inv * C.VS[ex[4 * q + 1]], e[4 * q + 2] * inv * C.VS[ex[4 * q + 2]], e[4 * q + 3] * inv * C.VS[ex[4 * q + 3]]};
            up[q] = (f32x4){hs * C.US[ex[4 * q]], hs * C.US[ex[4 * q + 1]], hs * C.US[ex[4 * q + 2]], hs * C.US[ex[4 * q + 3]]};
            ap[q] = (v4u){0u, 0u, 0u, 0u}; }
    }
}

__device__ __forceinline__ int peer_dequeue(const Ctx& C, unsigned* cnt, int xcc) {
    volatile LAS int* slot = (volatile LAS int*)(C.lds + MISC_OFF + 64);
    __syncthreads();
    if (C.tid == 0) { int res = -1;
        for (int s = 0; s < NSL; ++s) { const int sl = (xcc + s) & (NSL - 1);
            if (__hip_atomic_load(cnt + 64 * sl, __ATOMIC_RELAXED, __HIP_MEMORY_SCOPE_AGENT) >= (unsigned)NCHUNK) continue;
            const unsigned id = atomicAdd(cnt + 64 * sl, 1u); if (id < (unsigned)NCHUNK) { res = sl * NCHUNK + (int)id; break; } }
        *slot = res; }
    __syncthreads();
    return *slot;
}
#define ROWSUM16(d) do { d += __builtin_amdgcn_update_dpp(0, d, 0x121, 0xf, 0xf, false); d += __builtin_amdgcn_update_dpp(0, d, 0x122, 0xf, 0xf, false); \
                         d += __builtin_amdgcn_update_dpp(0, d, 0x124, 0xf, 0xf, false); d += __builtin_amdgcn_update_dpp(0, d, 0x128, 0xf, 0xf, false); } while (0)
#define PA_ISSUE1(buf, esrc, j_) buf[j_] = *(const v4u*)(tab + (size_t)__builtin_amdgcn_ds_swizzle(esrc, ((j_) << 5) | 0x10) * SLW)
#define PA_ISSUE(buf, esrc) do { PA_ISSUE1(buf, esrc, 0); PA_ISSUE1(buf, esrc, 1); PA_ISSUE1(buf, esrc, 2); PA_ISSUE1(buf, esrc, 3); PA_ISSUE1(buf, esrc, 4); PA_ISSUE1(buf, esrc, 5); PA_ISSUE1(buf, esrc, 6); PA_ISSUE1(buf, esrc, 7); \
        PA_ISSUE1(buf, esrc, 8); PA_ISSUE1(buf, esrc, 9); PA_ISSUE1(buf, esrc, 10); PA_ISSUE1(buf, esrc, 11); PA_ISSUE1(buf, esrc, 12); PA_ISSUE1(buf, esrc, 13); PA_ISSUE1(buf, esrc, 14); PA_ISSUE1(buf, esrc, 15); } while (0)
#define PA_COMPUTE(buf, hq_, dstv) do { _Pragma("unroll") for (int j_ = 0; j_ < 16; ++j_) { const v4u u_ = buf[j_]; \
        int d_ = __builtin_amdgcn_sdot4((int)hq_.x, (int)u_.x, 0, false); d_ = __builtin_amdgcn_sdot4((int)hq_.y, (int)u_.y, d_, false); d_ = __builtin_amdgcn_sdot4((int)hq_.z, (int)u_.z, d_, false); d_ = __builtin_amdgcn_sdot4((int)hq_.w, (int)u_.w, d_, false); \
        ROWSUM16(d_); dstv = (i == j_) ? d_ : dstv; } } while (0)
__device__ __forceinline__ void peer_a_chunk(const Ctx& C, int t0, int x) {
    const int lane = C.lane, i = lane & 15;
    v4u hq[8]; int el[8], eh[8];
#pragma unroll
    for (int tt = 0; tt < 8; ++tt) { hq[tt] = __builtin_nontemporal_load((const v4u*)(C.HQ + ((size_t)x * T + t0 + tt) * SLW + 16 * i)); el[tt] = __builtin_nontemporal_load(C.EXPI + (size_t)(t0 + tt) * 128 + lane); eh[tt] = __builtin_nontemporal_load(C.EXPI + (size_t)(t0 + tt) * 128 + 64 + lane); }
    const unsigned char* tab = C.UQ + (size_t)x * NEXP * SLW + 16 * i;
    v4u bA[16], bB[16];
    PA_ISSUE(bA, el[0]);
#pragma unroll
    for (int tt = 0; tt < 8; ++tt) {
        PA_ISSUE(bB, eh[tt]);
        int r_lo = 0, r_hi = 0;
        PA_COMPUTE(bA, hq[tt], r_lo);
        if (tt + 1 < 8) PA_ISSUE(bA, el[tt + 1]);
        PA_COMPUTE(bB, hq[tt], r_hi);
        atomicAdd(C.ACT + (size_t)(t0 + tt) * 128 + lane, r_lo); atomicAdd(C.ACT + (size_t)(t0 + tt) * 128 + 64 + lane, r_hi);
    }
}
#undef PA_ISSUE
#undef PA_ISSUE1
#undef PA_COMPUTE
#define PB_ISSUE(buf, esrc) do { _Pragma("unroll") for (int j_ = 0; j_ < 64; ++j_) buf[j_] = *(const unsigned*)(tab + (size_t)__builtin_amdgcn_readlane(esrc, j_) * SLW); } while (0)
#define PB_COMPUTE(buf, psrc) do { _Pragma("unroll") for (int j_ = 0; j_ < 16; ++j_) { const int wp_ = __builtin_amdgcn_readlane((int)psrc, 4 * j_); \
        const unsigned t0_ = __builtin_amdgcn_perm(buf[4 * j_ + 1], buf[4 * j_], 0x05010400u), t1_ = __builtin_amdgcn_perm(buf[4 * j_ + 1], buf[4 * j_], 0x07030602u); \
        const unsigned t2_ = __builtin_amdgcn_perm(buf[4 * j_ + 3], buf[4 * j_ + 2], 0x05010400u), t3_ = __builtin_amdgcn_perm(buf[4 * j_ + 3], buf[4 * j_ + 2], 0x07030602u); \
        c0 = __builtin_amdgcn_sdot4((int)__builtin_amdgcn_perm(t2_, t0_, 0x05040100u), wp_, c0, false); c1 = __builtin_amdgcn_sdot4((int)__builtin_amdgcn_perm(t2_, t0_, 0x07060302u), wp_, c1, false); \
        c2 = __builtin_amdgcn_sdot4((int)__builtin_amdgcn_perm(t3_, t1_, 0x05040100u), wp_, c2, false); c3 = __builtin_amdgcn_sdot4((int)__builtin_amdgcn_perm(t3_, t1_, 0x07060302u), wp_, c3, false); } } while (0)
__device__ __forceinline__ void peer_b_chunk(const Ctx& C, int t0, int x, float* dst) {
    const int lane = C.lane, b = t0 / SEQ;
    int el[8], eh[8]; unsigned pl[8], ph[8]; float ws[8];
#pragma unroll
    for (int tt = 0; tt < 8; ++tt) { const size_t o = (size_t)(t0 + tt) * 128 + lane;
        el[tt] = __builtin_nontemporal_load(C.EXPI + o); eh[tt] = __builtin_nontemporal_load(C.EXPI + o + 64);
        const float a_lo = (float)__builtin_nontemporal_load(C.ACT + o) * __builtin_nontemporal_load(C.GU + o), a_hi = (float)__builtin_nontemporal_load(C.ACT + o + 64) * __builtin_nontemporal_load(C.GU + o + 64);
        const float w_lo = __builtin_nontemporal_load(C.GATE + o) * 0.5f * a_lo * (1.f + erff(a_lo * 0.70710678118654752f)), w_hi = __builtin_nontemporal_load(C.GATE + o + 64) * 0.5f * a_hi * (1.f + erff(a_hi * 0.70710678118654752f));
        const float wm = wave_max(fmaxf(fabsf(w_lo), fabsf(w_hi))), winv = wm > 0.f ? 127.f / wm : 0.f; ws[tt] = wm * (1.f / 127.f);
        unsigned p_lo = (unsigned)((int)rintf(w_lo * winv) & 0xff), p_hi = (unsigned)((int)rintf(w_hi * winv) & 0xff);
        p_lo |= (unsigned)__builtin_amdgcn_update_dpp(0, (int)p_lo, 0xB1, 0xf, 0xf, false) << 8; p_lo |= (unsigned)__builtin_amdgcn_update_dpp(0, (int)p_lo, 0x4E, 0xf, 0xf, false) << 16;
        p_hi |= (unsigned)__builtin_amdgcn_update_dpp(0, (int)p_hi, 0xB1, 0xf, 0xf, false) << 8; p_hi |= (unsigned)__builtin_amdgcn_update_dpp(0, (int)p_hi, 0x4E, 0xf, 0xf, false) << 16;
        pl[tt] = p_lo; ph[tt] = p_hi; }
    const unsigned char* tab = C.VQ + (size_t)x * NEXP * SLW + 4 * lane;
    const int d0 = x * SLW + 4 * lane; const f32x4 gm = *(const f32x4*)(C.MOD + b * NMOD + 5 * D + d0);
    unsigned bA[64], bB[64];
    PB_ISSUE(bA, el[0]);
#pragma unroll
    for (int tt = 0; tt < 8; ++tt) {
        PB_ISSUE(bB, eh[tt]);
        const size_t off = (size_t)(t0 + tt) * D + d0; const f32x4 x1 = __builtin_nontemporal_load((const f32x4*)(C.out + off));
        int c0 = 0, c1 = 0, c2 = 0, c3 = 0;
        PB_COMPUTE(bA, pl[tt]);
        if (tt + 1 < 8) PB_ISSUE(bA, el[tt + 1]);
        PB_COMPUTE(bB, ph[tt]);
        const f32x4 o = {(float)c0 * ws[tt], (float)c1 * ws[tt], (float)c2 * ws[tt], (float)c3 * ws[tt]};
        __builtin_nontemporal_store(x1 + gm * o, (f32x4*)(dst + off));
    }
}
#undef PB_ISSUE
#undef PB_COMPUTE
template <int STAGE> __device__ __forceinline__ void peer_expert_phase(const Ctx& C, float* dst, int rep) {
    const int xcc = (int)(xb_xcc_id() & (NSL - 1)); unsigned* cnt = C.ctl + (STAGE == 0 ? CW_QA : CW_QB) + 64 * NSL * rep;
    for (;;) {
        const int id = peer_dequeue(C, cnt, xcc); if (id < 0) break;
        const int x = id / NCHUNK, t0 = (id % NCHUNK) * PCH + C.wave * (PCH / NWAVES);
        if (STAGE == 0) peer_a_chunk(C, t0, x); else peer_b_chunk(C, t0, x, dst);
    }
}

struct Args { const void* in[18]; float* out; unsigned char* ws; int ph_lo, ph_hi; };
__global__ void __launch_bounds__(NTHREADS, 2) fwd_kernel(Args args) {
    extern __shared__ __attribute__((aligned(16))) unsigned char lds[];
    Ctx C;
    C.lds = (LAS unsigned char*)lds; C.tid = threadIdx.x; C.lane = C.tid & 63; C.wave = __builtin_amdgcn_readfirstlane(C.tid >> 6);
    C.G = gridDim.x; { const int bx = blockIdx.x; C.vcu = (C.G % 8 == 0) ? (bx % 8) * (C.G / 8) + bx / 8 : bx; }
    C.gw = C.vcu * NWAVES + C.wave; C.ngw = C.G * NWAVES;
    C.x = (const float*)args.in[0]; C.c = (const float*)args.in[1]; C.pos = (const int*)args.in[2]; C.w_ada = (const float*)args.in[3]; C.b_ada = (const float*)args.in[4]; C.g1 = (const float*)args.in[5];
    C.w_in = (const float*)args.in[6]; C.w_a2 = (const float*)args.in[7]; C.b_a = (const float*)args.in[8]; C.gla_g = (const float*)args.in[9]; C.qg = (const float*)args.in[10]; C.kg = (const float*)args.in[11];
    C.w_out = (const float*)args.in[12]; C.g2 = (const float*)args.in[13]; C.w_q = (const float*)args.in[14]; C.keys = (const float*)args.in[15]; C.pu = (const float*)args.in[16]; C.pv = (const float*)args.in[17];
    C.out = args.out; unsigned char* ws = args.ws;
    C.ctl = (unsigned*)(ws + WS_CTL); C.MODI = (long long*)(C.ctl + CW_MOD); C.MOD = (float*)(ws + WS_MODF);
    C.WIN = (bf16*)(ws + WS_WIN); C.WGA = (bf16*)(ws + WS_WGA); C.WOUT = (bf16*)(ws + WS_WOUT); C.WQ = (bf16*)(ws + WS_WQ); C.KEYSB = (bf16*)(ws + WS_KEYS); C.UQ = ws + WS_UB; C.VQ = ws + WS_VB; C.HQ = ws + WS_HQ; C.US = (float*)(ws + WS_US); C.VS = (float*)(ws + WS_VS); C.HS = (float*)(ws + WS_HS); C.GU = (float*)(ws + WS_GU); C.ACT = (int*)(ws + WS_ACT);
    C.H = (bf16*)(ws + WS_H); C.CONCAT = (bf16*)(ws + WS_CONCAT); C.PROJ = (bf16*)(ws + WS_PROJ); C.ST = (bf16*)(ws + WS_ST);
    C.CS = (float*)(ws + WS_CS); C.KMEAN = (float*)(ws + WS_KMEAN); C.DEC = (float*)(ws + WS_DEC); C.BCUM = (float*)(ws + WS_BCUM); C.UT = (float*)(ws + WS_UT); C.QP = (float*)(ws + WS_QP); C.GATE = (float*)(ws + WS_GATE); C.EXPI = (int*)(ws + WS_EXP);
    for (int u = C.tid; u < (LDS_BYTES - RING_BYTES) / 4; u += NTHREADS) ((LAS unsigned*)(C.lds + RING_BYTES))[u] = 0u;
    __syncthreads();
    const int lo = args.ph_lo, hi = args.ph_hi;
    XcdBarrier bar; bar.bar = C.ctl + CW_BAR; bar.x = 0; bar.st = nullptr;
    if (hi - lo > 1) bar = xcd_barrier_post(C.ctl + CW_BAR, (volatile LAS unsigned*)(C.lds + MISC_OFF) + 8);
#ifndef SKIPMASK
#define SKIPMASK 0
#endif
#ifndef REPEATMASK
#define REPEATMASK 0
#endif
#define IN(k) (!((SKIPMASK >> (k)) & 1) && lo <= (k) && (k) < hi)
#define REP(k, ...) do { if ((REPEATMASK >> (k)) & 1) { const int rep_ = 1; (void)rep_; __VA_ARGS__; xcd_barrier(bar); } { const int rep_ = 0; (void)rep_; __VA_ARGS__; } } while (0)
#define SEAM(k) do { if (IN(k) && IN((k) + 1)) xcd_barrier(bar); { int t_ = C.tid; asm volatile("" : "+v"(t_)); C.tid = t_; C.lane = t_ & 63; } } while (0)
    if (IN(0)) REP(0, p0_phase(C, rep_)); SEAM(0);
    if (IN(1)) REP(1, norm_mod_phase<true>(C, C.x, C.g1, 0, D, C.H)); SEAM(1);
    if (IN(2)) REP(2, pg8::Gemm g{C.H, C.WIN, T, NPROJ, D}; pg8::StaticOrder S; S.init(T, NPROJ, C.G, (int)blockIdx.x); pg8::EpiBf16<0> E{C.PROJ, NPROJ, nullptr, 0, 0, 1.f};
                 pg8::gemm_phase<pg8::EpiBf16<0>, pg8::StaticOrder, PG8_ALIGN, PG8_SP2>(C.lds, g, S, E)); SEAM(2);
    if (IN(3)) REP(3, for (int it = C.vcu; it < 256 + 256; it += C.G) { if (it < 256) moba_prep_item(C, it >> 7, (it >> 4) & 7, it & 15, rep_); else gla_prep_item(C, (it - 256) >> 7, ((it - 256) >> 1) & 63, it & 1); }); SEAM(3);
    if (IN(4)) REP(4, p4_phase(C, rep_)); SEAM(4);
    if (IN(5)) REP(5, p5_phase(C)); SEAM(5);
    if (IN(6)) REP(6, for (int it = C.vcu; it < 1024; it += C.G) gla_out_item(C, it >> 9, (it >> 6) & 7, it & 63)); SEAM(6);
    if (IN(7)) REP(7, pg8::Gemm g{C.CONCAT, C.WOUT, T, D, D}; pg8::StaticOrder S; S.init(T, D, C.G, (int)blockIdx.x); pg8::EpiResGate E{C.x, C.out, D, C.MOD + 2 * D, NMOD, SEQ / 256};
                 pg8::gemm_phase<pg8::EpiResGate, pg8::StaticOrder, PG8_ALIGN, PG8_SP2>(C.lds, g, S, E)); SEAM(7);
    if (IN(8)) REP(8, norm_mod_phase<false>(C, C.out, C.g2, 3 * D, 4 * D, C.H)); SEAM(8);
    if (IN(9)) REP(9, pg8::Gemm g{C.H, C.WQ, T, D, D}; pg8::StaticOrder S; S.init(T, D, C.G, (int)blockIdx.x); pg8::EpiF32 E{C.QP, D, nullptr};
                 pg8::gemm_phase<pg8::EpiF32, pg8::StaticOrder, PG8_ALIGN, PG8_SP2>(C.lds, g, S, E)); SEAM(9);
    if (IN(10)) REP(10, for (int it = C.gw; it < 256 * 8; it += C.ngw) peer_topk_item(C, it >> 3, it & 7)); SEAM(10);
    if (IN(11)) { peer_expert_phase<0>(C, nullptr, 0); } SEAM(11);
    if (IN(12)) REP(12, peer_expert_phase<1>(C, rep_ ? C.QP : C.out, rep_));
#undef IN
#undef SEAM
}

extern "C" void kernel_launch(void* const* d_in, const int* in_sizes, int n_in, void* d_out, int out_size, void* d_ws, size_t ws_size, hipStream_t stream) {
    static int grid = 0;
    if (grid == 0) {
        if (n_in != 18 || in_sizes[0] != T * D || out_size != T * D || ws_size < WS_END) { fprintf(stderr, "kernel_launch: shape/workspace mismatch (n_in %d, in0 %d, out %d, ws %zu, need %zu); nothing launched\n", n_in, n_in > 0 ? in_sizes[0] : -1, out_size, ws_size, (size_t)WS_END); grid = -1; return; }
        int dev = 0, cus = 0, per_cu = 0;
        if (hipGetDevice(&dev) != hipSuccess || hipDeviceGetAttribute(&cus, hipDeviceAttributeMultiprocessorCount, dev) != hipSuccess) { fprintf(stderr, "kernel_launch: device query failed\n"); grid = -1; return; }
        if (hipFuncSetAttribute((const void*)fwd_kernel, hipFuncAttributeMaxDynamicSharedMemorySize, LDS_BYTES) != hipSuccess) { fprintf(stderr, "kernel_launch: hipFuncSetAttribute failed\n"); grid = -1; return; }
        if (hipOccupancyMaxActiveBlocksPerMultiprocessor(&per_cu, (const void*)fwd_kernel, NTHREADS, LDS_BYTES) != hipSuccess || per_cu < 1) { fprintf(stderr, "kernel_launch: occupancy query reports %d workgroups per CU\n", per_cu); (void)hipGetLastError(); grid = -1; return; }
        grid = cus;
    }
    if (grid < 0) return;
    if (hipMemsetAsync((char*)d_ws + WS_CTL, 0, CTL_ZERO_BYTES, stream) != hipSuccess) { fprintf(stderr, "kernel_launch: memset failed\n"); return; }
    Args a{};
    for (int i = 0; i < 18; ++i) a.in[i] = d_in[i];
    a.out = (float*)d_out; a.ws = (unsigned char*)d_ws;
#if MK_N_LAUNCHES == 1
    a.ph_lo = 0; a.ph_hi = N_PHASES;
    void* kargs[] = {&a};
    hipError_t le = hipLaunchCooperativeKernel((const void*)fwd_kernel, dim3(grid), dim3(NTHREADS), kargs, LDS_BYTES, stream);
    if (le != hipSuccess) fprintf(stderr, "kernel_launch: cooperative launch failed: %s (grid %d)\n", hipGetErrorName(le), grid);
#else
    for (int p = 0; p < N_PHASES; ++p) { a.ph_lo = p; a.ph_hi = p + 1; hipLaunchKernelGGL(fwd_kernel, dim3(grid), dim3(NTHREADS), LDS_BYTES, stream, a); }
#endif
}
```

```cpp
#define REPEATMASK 0
#include <hip/hip_runtime.h>
#include <hip/hip_bf16.h>
#include <cstdio>
#include <cstdint>
#include <cmath>
namespace pg8 {
#define PG8_LAS __attribute__((address_space(3)))
typedef unsigned short bf16_t;
typedef short bf16x8 __attribute__((ext_vector_type(8)));
typedef float f32x4 __attribute__((ext_vector_type(4)));
typedef unsigned u32x4 __attribute__((ext_vector_type(4)));
constexpr int BM = 256, BK = 64, HALF = 128, HTB = HALF * BK * 2  , STAGE_BYTES = 8 * HTB, NXCD = 8, WGM = 8;

__host__ __device__ __forceinline__ int lds_byte(int r, int c) { const int st = (r >> 4) * 2 + (c >> 5), rr = r & 15, cc = c & 31, ob = rr * 64 + cc * 2; return st * 1024 + (ob ^ (((ob >> 9) & 1) << 5)); }
__host__ __device__ __forceinline__ void stage_rc(int b, int& R, int& C) { const int st = b / 1024, sb = b % 1024, swz = sb ^ (((sb >> 9) & 1) << 5); R = (st >> 1) * 16 + swz / 64; C = (st & 1) * 32 + (swz % 64) / 2; }
__host__ __device__ __forceinline__ int perm32(int rho) { const int n = rho >> 4, i = rho & 15; return 8 * (i >> 2) + 4 * n + (i & 3); }

struct Unit { int pm, pn; };
struct Gemm { const bf16_t* A; const bf16_t* Bt; int M, N, K; };

struct StaticOrder {
    int nM, nN, nwg, G, c;
    __host__ __device__ void init(int M, int N, int G_, int c_) { nM = M / BM; nN = N / BM; nwg = nM * nN; G = G_; c = c_; }
    __host__ __device__ bool next(int i, Unit& u) const {
        const long L = (long)i * G + c; if (L >= nwg) return false;
        int wgid = (int)L; { const int q = nwg / NXCD, r = nwg % NXCD, xcd = wgid % NXCD, off = wgid / NXCD; wgid = (xcd < r ? xcd * (q + 1) : r * (q + 1) + (xcd - r) * q) + off; }
        const int nig = WGM * nN, gid = wgid / nig, fm = gid * WGM, gsz = (nM - fm) < WGM ? (nM - fm) : WGM;
        u.pm = fm + ((wgid % nig) % gsz); u.pn = (wgid % nig) / gsz; return true;
    }
    __device__ __forceinline__ void a_ready(const Unit&) const {}
    __device__ __forceinline__ void done(const Unit&) const {}
};

__device__ __forceinline__ unsigned cvt_pk_bf16(float lo, float hi) { unsigned r; asm volatile("v_cvt_pk_bf16_f32 %0, %1, %2" : "=v"(r) : "v"(lo), "v"(hi)); return r; }
typedef float f32x2 __attribute__((ext_vector_type(2)));
__device__ __forceinline__ f32x2 gelu_pk(f32x2 v) {
    const f32x2 av = __builtin_elementwise_abs(v), d = av * 0.2316418882f + 1.0f;
    f32x2 t; t.x = __builtin_amdgcn_rcpf(d.x); t.y = __builtin_amdgcn_rcpf(d.y);
    f32x2 q = t * 0.5307027145f + (-0.7265760135f); q = q * t + 0.7107068705f; q = q * t + (-0.142248368f); q = q * t + 0.127414796f; q = q * t;
    const f32x2 s = (v * v) * (-0.72134752044f);
    f32x2 e; e.x = __builtin_amdgcn_exp2f(s.x); e.y = __builtin_amdgcn_exp2f(s.y);
    const f32x2 m = v * (q * e), r = v - m;
    f32x2 o; o.x = v.x < 0.f ? m.x : r.x; o.y = v.y < 0.f ? m.y : r.y; return o;
}

template <int ACT  > struct EpiBf16 {
    static constexpr bool PERM = true, AFTER_DRAIN = false; static_assert(ACT == 0 || ACT == 1, "EpiBf16: ACT is 0 (none) or 1 (gelu_pk)");
    bf16_t* O; int ldc; const float* bias; int split_cols; size_t split_stride; float scale0;
    __device__ __forceinline__ void operator()(const f32x4 (&acc)[2][2][4][2], const Unit& u, int wr, int wc, int fr, int fq) const {
        const int row0 = u.pm * BM + wr * 64 + fr; int colt = u.pn * BM; bf16_t* base = O;
        float sc = 1.f; if (split_cols) { const int t = colt / split_cols; base += (size_t)t * split_stride; colt -= t * split_cols; if (t == 0) sc = scale0; }
        const int col0 = colt + wc * 32 + 8 * fq, bcol0 = u.pn * BM + wc * 32 + 8 * fq;
        f32x4 bv[2][2];
#pragma unroll
        for (int bj = 0; bj < 2; ++bj)
#pragma unroll
            for (int n = 0; n < 2; ++n) bv[bj][n] = bias ? *(const f32x4*)(bias + bcol0 + bj * HALF + 4 * n) : (f32x4){0.f, 0.f, 0.f, 0.f};
#pragma unroll
        for (int ai = 0; ai < 2; ++ai)
#pragma unroll
            for (int m = 0; m < 4; ++m) { bf16_t* rowp = base + (size_t)(row0 + ai * HALF + m * 16) * ldc + col0;
#pragma unroll
                for (int bj = 0; bj < 2; ++bj) { f32x4 v0 = acc[ai][bj][m][0] + bv[bj][0], v1 = acc[ai][bj][m][1] + bv[bj][1];
                    if (ACT == 1) { f32x2 a = gelu_pk((f32x2){v0[0], v0[1]}), b = gelu_pk((f32x2){v0[2], v0[3]}), c = gelu_pk((f32x2){v1[0], v1[1]}), d = gelu_pk((f32x2){v1[2], v1[3]});
                        v0 = (f32x4){a.x, a.y, b.x, b.y}; v1 = (f32x4){c.x, c.y, d.x, d.y}; }
                    v0 = v0 * sc; v1 = v1 * sc; u32x4 w; w.x = cvt_pk_bf16(v0[0], v0[1]); w.y = cvt_pk_bf16(v0[2], v0[3]); w.z = cvt_pk_bf16(v1[0], v1[1]); w.w = cvt_pk_bf16(v1[2], v1[3]);
                    *(u32x4*)(rowp + bj * HALF) = w; } }
    }
};
struct EpiF32 {
    static constexpr bool PERM = false, AFTER_DRAIN = false;
    float* C; int ldc; const float* bias;
    __device__ __forceinline__ void operator()(const f32x4 (&acc)[2][2][4][2], const Unit& u, int wr, int wc, int fr, int fq) const {
        const int row0 = u.pm * BM + wr * 64 + fr, col0 = u.pn * BM + wc * 32 + 4 * fq;
        f32x4 bv[2][2];
#pragma unroll
        for (int bj = 0; bj < 2; ++bj)
#pragma unroll
            for (int n = 0; n < 2; ++n) bv[bj][n] = bias ? *(const f32x4*)(bias + col0 + bj * HALF + n * 16) : (f32x4){0.f, 0.f, 0.f, 0.f};
#pragma unroll
        for (int ai = 0; ai < 2; ++ai)
#pragma unroll
            for (int m = 0; m < 4; ++m) { float* rowp = C + (size_t)(row0 + ai * HALF + m * 16) * ldc + col0;
#pragma unroll
                for (int bj = 0; bj < 2; ++bj)
#pragma unroll
                    for (int n = 0; n < 2; ++n) *(f32x4*)(rowp + bj * HALF + n * 16) = acc[ai][bj][m][n] + bv[bj][n]; }
    }
};
struct EpiResGate {
    static constexpr bool PERM = false, AFTER_DRAIN = false;
    const float* X; float* O; int ldc; const float* gate; int gate_stride, tiles_per_batch;
    __device__ __forceinline__ void operator()(const f32x4 (&acc)[2][2][4][2], const Unit& u, int wr, int wc, int fr, int fq) const {
        const int row0 = u.pm * BM + wr * 64 + fr, col0 = u.pn * BM + wc * 32 + 4 * fq;
        const float* gp = gate + (size_t)(u.pm / tiles_per_batch) * gate_stride;
        f32x4 gv[2][2];
#pragma unroll
        for (int bj = 0; bj < 2; ++bj)
#pragma unroll
            for (int n = 0; n < 2; ++n) gv[bj][n] = *(const f32x4*)(gp + col0 + bj * HALF + n * 16);
        f32x4 xv[2][2][2];
#define ERG_LOAD(idx, slot) do { const size_t off_ = (size_t)(row0 + ((idx) >> 2) * HALF + ((idx) & 3) * 16) * ldc + col0; _Pragma("unroll") for (int bj = 0; bj < 2; ++bj) _Pragma("unroll") for (int n = 0; n < 2; ++n) xv[slot][bj][n] = *(const f32x4*)(X + off_ + bj * HALF + n * 16); } while (0)
        ERG_LOAD(0, 0); ERG_LOAD(1, 1);
#pragma unroll
        for (int idx = 0; idx < 8; ++idx) { const int ai = idx >> 2, m = idx & 3; const size_t off = (size_t)(row0 + ai * HALF + m * 16) * ldc + col0;
#pragma unroll
            for (int bj = 0; bj < 2; ++bj)
#pragma unroll
                for (int n = 0; n < 2; ++n) *(f32x4*)(O + off + bj * HALF + n * 16) = xv[idx & 1][bj][n] + gv[bj][n] * acc[ai][bj][m][n];
            if (idx + 2 < 8) ERG_LOAD(idx + 2, idx & 1); }
#undef ERG_LOAD
    }
};

template <class Epi, class Sched, bool ALIGN_EPI = false, bool SP2 = false>
__device__ __forceinline__ void gemm_phase(PG8_LAS unsigned char* lds, const Gemm g, const Sched& S, const Epi& E) {
    const int tid = threadIdx.x, wid = __builtin_amdgcn_readfirstlane(tid >> 6), lane = tid & 63, wr = wid >> 2, wc = wid & 3, fr = lane & 15, fq = lane >> 4;
    const int K = g.K, nt = K / BK;
    unsigned voffA[2], voffB[2];
#pragma unroll
    for (int i = 0; i < 2; ++i) { int R, C; stage_rc(tid * 16 + i * 8192, R, C); const int Rb = Epi::PERM ? ((R & ~31) + perm32(R & 31)) : R;
        voffA[i] = (unsigned)(R * K + C) * 2u; voffB[i] = (unsigned)(Rb * K + C) * 2u; }
    const size_t kstep = (size_t)(BK * 2);
    const size_t hstep = (size_t)HALF * K * 2;
    const size_t tstep = 2 * hstep;
    const unsigned ldsw = (unsigned)wid * 1024u;
    const int aoff = lds_byte(wr * 64 + fr, fq * 8), boff = lds_byte(wc * 32 + fr, fq * 8);
#define PG8_SA(b, h) (((b) * 2 + (h)) * HTB)
#define PG8_SB(b, h) ((4 + (b) * 2 + (h)) * HTB)
#define PG8_STAGE(bufoff, gbase, voff) do { _Pragma("unroll") for (int _i = 0; _i < 2; ++_i) \
        __builtin_amdgcn_global_load_lds((const unsigned*)((const char*)(gbase) + (voff)[_i]), (PG8_LAS unsigned*)(lds + (bufoff) + ldsw + _i * 8192), 16, 0, 0); } while (0)
#define PG8_LDA(dst, b, h) do { _Pragma("unroll") for (int m = 0; m < 4; ++m) _Pragma("unroll") for (int k = 0; k < 2; ++k) dst[m][k] = *(const PG8_LAS bf16x8*)(lds + PG8_SA(b, h) + aoff + m * 2048 + k * 1024); } while (0)
#define PG8_LDB(dst, b, h) do { _Pragma("unroll") for (int n = 0; n < 2; ++n) _Pragma("unroll") for (int k = 0; k < 2; ++k) dst[n][k] = *(const PG8_LAS bf16x8*)(lds + PG8_SB(b, h) + boff + n * 2048 + k * 1024); } while (0)
#define PG8_MMA(ai, bj, At, Bt) do { __builtin_amdgcn_s_setprio(1); _Pragma("unroll") for (int m = 0; m < 4; ++m) _Pragma("unroll") for (int n = 0; n < 2; ++n) _Pragma("unroll") for (int k = 0; k < 2; ++k) \
        acc[ai][bj][m][n] = __builtin_amdgcn_mfma_f32_16x16x32_bf16(Bt[n][k], At[m][k], acc[ai][bj][m][n], 0, 0, 0); __builtin_amdgcn_s_setprio(0); } while (0)
#define PG8_WAIT_V(n) asm volatile("s_waitcnt vmcnt(" #n ")" ::: "memory")
#define PG8_WAIT_L(n) asm volatile("s_waitcnt lgkmcnt(" #n ")" ::: "memory")
#define PG8_BAR __builtin_amdgcn_s_barrier()
#define PG8_SCHED __builtin_amdgcn_sched_barrier(0)
    Unit cur, nxt; int ui = 0;
    if (!S.next(0, cur)) return;
    f32x4 acc[2][2][4][2];
#pragma unroll
    for (int a = 0; a < 2; ++a)
#pragma unroll
        for (int b = 0; b < 2; ++b)
#pragma unroll
            for (int m = 0; m < 4; ++m)
#pragma unroll
                for (int n = 0; n < 2; ++n) acc[a][b][m][n] = (f32x4){0.f, 0.f, 0.f, 0.f};
    bf16x8 At[4][2], B0[2][2], B1[2][2];
    const char* cA = (const char*)g.A + (size_t)cur.pm * tstep; const char* cB = (const char*)g.Bt + (size_t)cur.pn * tstep;
    S.a_ready(cur);
    if constexpr (SP2) {
        PG8_STAGE(PG8_SB(0, 0), cB, voffB); PG8_STAGE(PG8_SB(0, 1), cB + hstep, voffB); PG8_STAGE(PG8_SA(0, 0), cA, voffA); PG8_STAGE(PG8_SA(0, 1), cA + hstep, voffA);
        if (wr == 1) PG8_BAR;
        PG8_WAIT_V(2); PG8_BAR;
        PG8_STAGE(PG8_SB(1, 0), cB + kstep, voffB); PG8_STAGE(PG8_SA(1, 0), cA + kstep, voffA); PG8_STAGE(PG8_SB(1, 1), cB + hstep + kstep, voffB);
        PG8_WAIT_V(6); PG8_BAR;
    } else {
        PG8_STAGE(PG8_SB(0, 0), cB, voffB); PG8_STAGE(PG8_SA(0, 0), cA, voffA); PG8_STAGE(PG8_SB(0, 1), cB + hstep, voffB); PG8_STAGE(PG8_SA(0, 1), cA + hstep, voffA);
        if (wr == 1) PG8_BAR;
        PG8_WAIT_V(4); PG8_BAR;
        PG8_STAGE(PG8_SB(1, 0), cB + kstep, voffB); PG8_STAGE(PG8_SA(1, 0), cA + kstep, voffA); PG8_STAGE(PG8_SB(1, 1), cB + hstep + kstep, voffB);
        PG8_WAIT_V(6); PG8_BAR;
    }
    for (;;) {
        const bool has_next = S.next(ui + 1, nxt);
        const char* nA = has_next ? (const char*)g.A + (size_t)nxt.pm * tstep : cA; const char* nB = has_next ? (const char*)g.Bt + (size_t)nxt.pn * tstep : cB;
        for (int t = 0; t < nt; t += 2) {
            const bool last = (t == nt - 2);
            const char* a1 = cA + (size_t)(t + 1) * kstep;
            const char* a2 = last ? nA : cA + (size_t)(t + 2) * kstep; const char* b2 = last ? nB : cB + (size_t)(t + 2) * kstep;
            const char* a3 = a2 + kstep; const char* b3 = b2 + kstep;
            if (last && has_next) S.a_ready(nxt);
            if constexpr (SP2) {
            PG8_LDB(B0, 0, 0); PG8_LDB(B1, 0, 1); PG8_SCHED; PG8_LDA(At, 0, 0); PG8_STAGE(PG8_SA(1, 1), a1 + hstep, voffA);
            PG8_WAIT_V(8); PG8_WAIT_L(0); PG8_BAR; PG8_MMA(0, 0, At, B0); PG8_MMA(0, 1, At, B1); PG8_BAR; PG8_SCHED;
            PG8_LDA(At, 0, 1); PG8_STAGE(PG8_SB(0, 0), b2, voffB); PG8_STAGE(PG8_SB(0, 1), b2 + hstep, voffB); PG8_STAGE(PG8_SA(0, 0), a2, voffA);
            PG8_WAIT_V(8); PG8_WAIT_L(0); PG8_BAR; PG8_MMA(1, 0, At, B0); PG8_MMA(1, 1, At, B1); PG8_BAR; PG8_SCHED;
            PG8_LDB(B0, 1, 0); PG8_LDB(B1, 1, 1); PG8_SCHED; PG8_LDA(At, 1, 0); PG8_STAGE(PG8_SA(0, 1), a2 + hstep, voffA);
            PG8_WAIT_V(8); PG8_WAIT_L(0); PG8_BAR; PG8_MMA(0, 0, At, B0); PG8_MMA(0, 1, At, B1); PG8_BAR; PG8_SCHED;
            PG8_LDA(At, 1, 1); PG8_STAGE(PG8_SB(1, 0), b3, voffB); PG8_STAGE(PG8_SB(1, 1), b3 + hstep, voffB); PG8_STAGE(PG8_SA(1, 0), a3, voffA);
            PG8_WAIT_V(8); PG8_WAIT_L(0); PG8_BAR; PG8_MMA(1, 0, At, B0); PG8_MMA(1, 1, At, B1); PG8_BAR; PG8_SCHED;
            } else {
            PG8_LDB(B0, 0, 0); PG8_SCHED; PG8_LDA(At, 0, 0); PG8_STAGE(PG8_SA(1, 1), a1 + hstep, voffA);
            PG8_WAIT_L(8); PG8_BAR; PG8_WAIT_L(0); PG8_MMA(0, 0, At, B0); PG8_BAR; PG8_SCHED;
            PG8_LDB(B1, 0, 1); PG8_STAGE(PG8_SB(0, 0), b2, voffB);
            PG8_BAR; PG8_WAIT_L(0); PG8_MMA(0, 1, At, B1); PG8_BAR;
            PG8_LDA(At, 0, 1); PG8_STAGE(PG8_SA(0, 0), a2, voffA);
            PG8_BAR; PG8_WAIT_L(0); PG8_MMA(1, 0, At, B0); PG8_BAR; PG8_SCHED;
            PG8_STAGE(PG8_SB(0, 1), b2 + hstep, voffB);
            PG8_WAIT_V(6); PG8_BAR; PG8_MMA(1, 1, At, B1); PG8_BAR;
            PG8_LDB(B0, 1, 0); PG8_SCHED; PG8_LDA(At, 1, 0); PG8_STAGE(PG8_SA(0, 1), a2 + hstep, voffA);
            PG8_WAIT_L(8); PG8_BAR; PG8_WAIT_L(0); PG8_MMA(0, 0, At, B0); PG8_BAR; PG8_SCHED;
            PG8_LDB(B1, 1, 1); PG8_STAGE(PG8_SB(1, 0), b3, voffB);
            PG8_BAR; PG8_WAIT_L(0); PG8_MMA(0, 1, At, B1); PG8_BAR;
            PG8_LDA(At, 1, 1); PG8_STAGE(PG8_SA(1, 0), a3, voffA);
            PG8_BAR; PG8_WAIT_L(0); PG8_MMA(1, 0, At, B0); PG8_BAR; PG8_SCHED;
            PG8_STAGE(PG8_SB(1, 1), b3 + hstep, voffB);
            PG8_WAIT_V(6); PG8_BAR; PG8_MMA(1, 1, At, B1); PG8_BAR;
            }
        }
        if constexpr (ALIGN_EPI) { if (wr == 0) PG8_BAR; }
        if constexpr (!Epi::AFTER_DRAIN) { E(acc, cur, wr, wc, fr, fq); S.done(cur); }
        if (!has_next) break;
#pragma unroll
        for (int a = 0; a < 2; ++a)
#pragma unroll
            for (int b = 0; b < 2; ++b)
#pragma unroll
                for (int m = 0; m < 4; ++m)
#pragma unroll
                    for (int n = 0; n < 2; ++n) acc[a][b][m][n] = (f32x4){0.f, 0.f, 0.f, 0.f};
        cur = nxt; cA = nA; cB = nB; ++ui;
        if constexpr (ALIGN_EPI) { if (wr == 1) PG8_BAR; }
    }
    PG8_WAIT_V(0);
    if constexpr (!ALIGN_EPI) { if (wr == 0) PG8_BAR; }
    PG8_BAR;
    if constexpr (Epi::AFTER_DRAIN) { E.fused(acc, cur, wr, wc, fr, fq, lds, wid, lane); S.done(cur); }
#undef PG8_SA
#undef PG8_SB
#undef PG8_STAGE
#undef PG8_LDA
#undef PG8_LDB
#undef PG8_MMA
#undef PG8_WAIT_V
#undef PG8_WAIT_L
#undef PG8_BAR
#undef PG8_SCHED
}
}

#ifndef PG8_SP2
#define PG8_SP2 true
#endif
#ifndef PG8_ALIGN
#define PG8_ALIGN true
#endif
constexpr int NWAVES = 8, NTHREADS = NWAVES * 64;
constexpr int BATCH = 2, SEQ = 4096, T = BATCH * SEQ, D = 2048;
constexpr int INW = 6160, NPROJ = 6144;
constexpr int GQ = 0, GK = 512, GV = 1024, GG = 2048, MQ = 3072, MK = 4096, MV = 5120;
constexpr int GA_SRC = 3072;
constexpr int NH = 8, NEXP = 16384, NMOD = 6 * D;
constexpr float EPS = 1e-6f;
#ifndef MK_N_LAUNCHES
#define MK_N_LAUNCHES 1
#endif
constexpr int N_PHASES = 13;
constexpr int NSL = 8, SLW = 256, PCH = 64, NCHUNK = (BATCH * SEQ) / PCH;

constexpr size_t MiB = 1u << 20;
constexpr size_t WS_CTL = 0, CTL_ZERO_BYTES = 1 * MiB;
constexpr size_t WS_WIN = 1 * MiB, WS_WGA = 25 * MiB, WS_WOUT = 26 * MiB, WS_WQ = 34 * MiB, WS_KEYS = 42 * MiB, WS_CS = 43 * MiB, WS_KMEAN = 44 * MiB, WS_DEC = 45 * MiB;
constexpr size_t WS_UB = 46 * MiB, WS_VB = 110 * MiB, WS_H = 174 * MiB, WS_CONCAT = 206 * MiB, WS_BCUM = 238 * MiB, WS_UT = 254 * MiB, WS_ST = 286 * MiB, WS_PROJ = 302 * MiB;
constexpr size_t WS_QP = WS_PROJ, WS_EXP = 366 * MiB, WS_GATE = 370 * MiB, WS_GU = 374 * MiB, WS_ACT = 378 * MiB, WS_HQ = 382 * MiB, WS_END = 398 * MiB;
constexpr size_t WS_US = WS_UB + 40 * MiB, WS_VS = WS_VB + 40 * MiB, WS_HS = WS_VB + 41 * MiB;
constexpr int CW_BAR = 4096, CW_Q = 8192, CW_QA = 12288, CW_QB = 13312, CW_MOD = 16384;
static_assert((CW_MOD + 2 * BATCH * NMOD) * 4 <= (int)CTL_ZERO_BYTES, "CTL words inside the memset region");
constexpr size_t WS_MODF = 45 * MiB + 512 * 1024;

constexpr int RING_BYTES = 131072, MISC_OFF = RING_BYTES + 320, LDS_BYTES = 147456;

#define GAS __attribute__((address_space(1)))
#define LAS __attribute__((address_space(3)))
typedef unsigned short bf16;
typedef unsigned v4u __attribute__((ext_vector_type(4)));
typedef unsigned v2u __attribute__((ext_vector_type(2)));
typedef float f32x4 __attribute__((ext_vector_type(4)));
typedef float f32x2 __attribute__((ext_vector_type(2)));
typedef float f32x16 __attribute__((ext_vector_type(16)));
typedef short bf16x8 __attribute__((ext_vector_type(8)));
typedef short s16x4 __attribute__((ext_vector_type(4)));
typedef __bf16 bf16x2_t __attribute__((ext_vector_type(2)));
typedef GAS unsigned gu32;
#define LDS_WAIT() asm volatile("s_waitcnt lgkmcnt(0)" ::: "memory")
#define VM_WAIT() asm volatile("s_waitcnt vmcnt(0)" ::: "memory")
__device__ __forceinline__ unsigned pk2(float lo, float hi) { f32x2 v = {lo, hi}; bf16x2_t b = __builtin_convertvector(v, bf16x2_t); return __builtin_bit_cast(unsigned, b); }
__device__ __forceinline__ float bflo(unsigned u) { return __uint_as_float(u << 16); }
__device__ __forceinline__ float bfhi(unsigned u) { return __uint_as_float(u & 0xffff0000u); }
__device__ __forceinline__ float bf1(short s) { return __uint_as_float(((unsigned)(unsigned short)s) << 16); }
__device__ __forceinline__ bf16x8 pack8(float a0, float a1, float a2, float a3, float a4, float a5, float a6, float a7) { v4u w; w.x = pk2(a0, a1); w.y = pk2(a2, a3); w.z = pk2(a4, a5); w.w = pk2(a6, a7); return __builtin_bit_cast(bf16x8, w); }
__device__ __forceinline__ int crow(int r, int hi) { return (r & 3) + 8 * (r >> 2) + 4 * hi; }
__device__ __forceinline__ float wave_sum(float v) {
#pragma unroll
    for (int o = 1; o < 64; o <<= 1) v += __shfl_xor(v, o);
    return v;
}
typedef short v4i16_t __attribute__((ext_vector_type(4)));
__device__ __forceinline__ s16x4 vtr(const LAS unsigned char* p) { return __builtin_bit_cast(s16x4, __builtin_amdgcn_ds_read_tr16_b64_v4i16((LAS v4i16_t*)p)); }
__device__ __forceinline__ bf16x8 cat4(s16x4 lo, s16x4 hi) { return (bf16x8){lo[0], lo[1], lo[2], lo[3], hi[0], hi[1], hi[2], hi[3]}; }
#define MFMA32(a, b, c) __builtin_amdgcn_mfma_f32_32x32x16_bf16((a), (b), (c), 0, 0, 0)
#define XB_TMO      128
#define XB_XCNT(j)  (256  + 64 * (j))
#define XB_XSUB(j)  (1280 + 64 * (j))
#define XB_XGEN(j)  (2304 + 64 * (j))
#define XB_TOP      3328
#define XB_TOPGEN   3392
#define XCD_BAR_WORDS 3456
#define XB_SPIN_CAP (1u << 18)

__device__ __forceinline__ unsigned xb_ld(unsigned* p)              { return __hip_atomic_load(p, __ATOMIC_RELAXED, __HIP_MEMORY_SCOPE_AGENT); }
__device__ __forceinline__ unsigned xb_add(unsigned* p, unsigned v) { return __hip_atomic_fetch_add(p, v, __ATOMIC_RELAXED, __HIP_MEMORY_SCOPE_AGENT); }
__device__ __forceinline__ unsigned xb_xcc_id() { return (unsigned)__builtin_amdgcn_s_getreg((3 << 11) | 20) & 0xFu; }
#define XB_SPIN(cond, bar) do { unsigned _sp = 0; while (cond) { __builtin_amdgcn_s_sleep(1); \
    if ((++_sp & 255u) == 0u) { if (xb_ld(&(bar)[XB_TMO])) break; if (_sp > XB_SPIN_CAP) { atomicAdd(&(bar)[XB_TMO], 1u); break; } } } } while (0)

struct XcdBarrier {
    unsigned* bar; unsigned x;
    volatile LAS unsigned* st;
};

__device__ __forceinline__ XcdBarrier xcd_barrier_post(unsigned* bar, volatile LAS unsigned* st) {
    XcdBarrier b; b.bar = bar; b.x = xb_xcc_id(); b.st = st;
    if (threadIdx.x == 0) (void)xb_add(&bar[XB_XCNT(b.x)], 1u);
    return b;
}
__device__ __forceinline__ void xcd_barrier_complete(unsigned* bar, unsigned x, unsigned& nloc, unsigned& nx) {
    const unsigned G = gridDim.x * gridDim.y * gridDim.z;
    unsigned sum, cnt, mine, sp = 0u;
    for (;;) {
        sum = 0u; cnt = 0u; mine = 0u;
#pragma unroll
        for (unsigned j = 0; j < 16; ++j) { const unsigned c = xb_ld(&bar[XB_XCNT(j)]); sum += c; cnt += (c > 0u) ? 1u : 0u; mine = (j == x) ? c : mine; }
        if (sum == G) break;
        __builtin_amdgcn_s_sleep(1);
        if ((++sp & 255u) == 0u) { if (xb_ld(&bar[XB_TMO])) break; if (sp > XB_SPIN_CAP) { atomicAdd(&bar[XB_TMO], 1u); break; } }
    }
    nloc = mine > 0u ? mine : 1u; nx = cnt > 0u ? cnt : 1u;
}

__device__ __forceinline__ void xcd_barrier(const XcdBarrier& b) {
    asm volatile("s_waitcnt vmcnt(0)" ::: "memory");
    __syncthreads();
    if (threadIdx.x == 0) {
        unsigned* bar = b.bar;
        __builtin_amdgcn_s_waitcnt(0);
        unsigned nloc = b.st[0], nx = b.st[1];
        if (nloc == 0u) { xcd_barrier_complete(bar, b.x, nloc, nx); b.st[0] = nloc; b.st[1] = nx; }
        const unsigned old = xb_add(&bar[XB_XSUB(b.x)], 1u);
        const unsigned gen = old / nloc;
        if (old + 1u == (gen + 1u) * nloc) {
            __builtin_amdgcn_fence(__ATOMIC_RELEASE, "agent");
            asm volatile("s_waitcnt vmcnt(0)" ::: "memory");
            const unsigned og = xb_add(&bar[XB_TOP], 1u);
            const unsigned tg = og / nx;
            if (og + 1u == (tg + 1u) * nx) xb_add(&bar[XB_TOPGEN], 1u);
            else XB_SPIN(xb_ld(&bar[XB_TOPGEN]) == tg, bar);
            __builtin_amdgcn_fence(__ATOMIC_ACQUIRE, "agent");
            xb_add(&bar[XB_XGEN(b.x)], 1u);
            asm volatile("s_waitcnt vmcnt(0)" ::: "memory");
        } else {
            XB_SPIN(xb_ld(&bar[XB_XGEN(b.x)]) == gen, bar);
            __builtin_amdgcn_fence(__ATOMIC_ACQUIRE, "agent");
            asm volatile("s_waitcnt vmcnt(0)" ::: "memory");
        }
    }
    __syncthreads();
}

struct Ctx {
    LAS unsigned char* lds;
    int tid, lane, wave, vcu, G, gw, ngw;
    const float *x, *c; const int* pos; const float *w_ada, *b_ada, *g1, *w_in, *w_a2, *b_a, *gla_g, *qg, *kg, *w_out, *g2, *w_q, *keys, *pu, *pv;
    float* out;
    unsigned* ctl; long long* MODI; float* MOD;
    bf16 *WIN, *WGA, *WOUT, *WQ, *KEYSB, *H, *CONCAT, *PROJ, *ST;
    unsigned char *UQ, *VQ, *HQ;
    float *CS, *KMEAN, *DEC, *BCUM, *UT, *QP, *GATE, *GU, *US, *VS, *HS; int *EXPI, *ACT;
};

__device__ __forceinline__ void transpose_item(const float* W, int ldw, int K, bf16* WT, int dst_row0, int k0, int n0, LAS float* scr, int lane) {
#pragma unroll 8
    for (int i = 0; i < 32; ++i) { const int kk = 2 * i + (lane >> 5); scr[kk * 33 + (lane & 31)] = W[(size_t)(k0 + kk) * ldw + n0 + (lane & 31)]; }
    LDS_WAIT(); asm volatile("" ::: "memory");
    const int c = lane & 7;
#pragma unroll
    for (int j = 0; j < 4; ++j) { const int n = (lane >> 3) + 8 * j; const LAS float* s = scr + (8 * c) * 33 + n;
        v4u o; o.x = pk2(s[0 * 33], s[1 * 33]); o.y = pk2(s[2 * 33], s[3 * 33]); o.z = pk2(s[4 * 33], s[5 * 33]); o.w = pk2(s[6 * 33], s[7 * 33]);
        *(v4u*)(WT + (size_t)(dst_row0 + n) * K + k0 + 8 * c) = o; }
    LDS_WAIT(); asm volatile("" ::: "memory");
}
__device__ __forceinline__ void convert_item(const float* src, bf16* dst, size_t item, int lane) {
    const f32x4* s = (const f32x4*)(src + item * 8192) + 2 * lane; v4u* d = (v4u*)(dst + item * 8192) + lane;
#pragma unroll 4
    for (int it = 0; it < 16; ++it) { const f32x4 a = s[it * 128], b = s[it * 128 + 1]; v4u o; o.x = pk2(a.x, a.y); o.y = pk2(a.z, a.w); o.z = pk2(b.x, b.y); o.w = pk2(b.z, b.w); d[it * 64] = o; }
}
__device__ __forceinline__ float wave_max(float v) {
#pragma unroll
    for (int o = 1; o < 64; o <<= 1) v = fmaxf(v, __shfl_xor(v, o));
    return v;
}
__device__ __forceinline__ void quant_store(const f32x4 (&v)[8], unsigned char* dst, float* scales, int row, size_t nrows, int lane, int bias) {
    float am = 0.f;
#pragma unroll
    for (int j = 0; j < 8; ++j) am = fmaxf(am, fmaxf(fmaxf(fabsf(v[j].x), fabsf(v[j].y)), fmaxf(fabsf(v[j].z), fabsf(v[j].w))));
    am = wave_max(am);
    const float inv = am > 0.f ? 127.f / am : 0.f;
    if (lane == 0) scales[row] = am > 0.f ? am / 127.f : 1.f;
#pragma unroll
    for (int j = 0; j < 8; ++j) { const int q0 = (int)rintf(v[j].x * inv) + bias, q1 = (int)rintf(v[j].y * inv) + bias, q2 = (int)rintf(v[j].z * inv) + bias, q3 = (int)rintf(v[j].w * inv) + bias;
        *(unsigned*)(dst + ((size_t)j * nrows + row) * 256 + 4 * lane) = (unsigned)(q0 & 0xff) | ((unsigned)(q1 & 0xff) << 8) | ((unsigned)(q2 & 0xff) << 16) | ((unsigned)(q3 & 0xff) << 24); }
}
__device__ __forceinline__ void quant_row(const float* src, unsigned char* dst, float* scales, int row, size_t nrows, int lane, int bias) {
    const f32x4* s = (const f32x4*)src + lane; f32x4 v[8];
#pragma unroll
    for (int j = 0; j < 8; ++j) v[j] = s[64 * j];
    quant_store(v, dst, scales, row, nrows, lane, bias);
}
__device__ __forceinline__ void p0_phase(const Ctx& C, int rep) {
    const int lane = C.lane, gw = C.gw, ngw = C.ngw;
    LAS float* sc = (LAS float*)C.lds;
    LAS float* part = sc + BATCH * D;
    for (int i = C.tid; i < BATCH * D; i += NTHREADS) { const float v = C.c[i]; sc[i] = v / (1.f + __expf(-v)); }
    __syncthreads();
    for (int it = C.vcu; it < 192; it += C.G) {
        const int cq = lane & 15, rg = lane >> 4, col = it * 64 + 4 * cq, r0 = 256 * C.wave + rg;
        const f32x4* w = (const f32x4*)(C.w_ada + (size_t)r0 * NMOD + col); const LAS float* s0 = sc + r0; const LAS float* s1 = sc + D + r0;
        f32x4 a0 = {0.f, 0.f, 0.f, 0.f}, a1 = a0;
#pragma unroll 16
        for (int k = 0; k < 64; ++k) { const f32x4 wv = w[(size_t)k * NMOD]; a0 += s0[4 * k] * wv; a1 += s1[4 * k] * wv; }
#pragma unroll
        for (int q = 0; q < 4; ++q) { a0[q] += __shfl_xor(a0[q], 16); a0[q] += __shfl_xor(a0[q], 32); a1[q] += __shfl_xor(a1[q], 16); a1[q] += __shfl_xor(a1[q], 32); }
        if (rg == 0) { *(LAS f32x4*)(part + (C.wave * 2 + 0) * 64 + 4 * cq) = a0; *(LAS f32x4*)(part + (C.wave * 2 + 1) * 64 + 4 * cq) = a1; }
        __syncthreads();
        if (C.tid < 128) { const int bb = C.tid >> 6, cl = C.tid & 63; float s = 0.f;
#pragma unroll
            for (int ww = 0; ww < 8; ++ww) s += part[(ww * 2 + bb) * 64 + cl];
            C.MOD[bb * NMOD + it * 64 + cl] = s + C.b_ada[it * 64 + cl]; }
        __syncthreads();
    }
    LAS float* scr = (LAS float*)(C.lds + C.wave * 16384);
    constexpr int I_IN = 32 * 192, I_SQ = 32 * 64;
    for (int it = gw; it < I_IN + 2 * I_SQ; it += ngw) {
        int r = it;
        if (r < I_IN) { const int kb = r / 192, nb = r % 192, n0 = 32 * nb; transpose_item(C.w_in, INW, D, C.WIN, n0, 64 * kb, n0 < 3072 ? n0 : n0 + 16, scr, lane); continue; } r -= I_IN;
        if (r < I_SQ) { transpose_item(C.w_out, D, D, C.WOUT, 32 * (r % 64), 64 * (r / 64), 32 * (r % 64), scr, lane); continue; } r -= I_SQ;
        transpose_item(C.w_q, D, D, C.WQ, 32 * (r % 64), 64 * (r / 64), 32 * (r % 64), scr, lane);
    }
    for (int it = gw; it < 32; it += ngw) { const int k = it * 64 + lane; const f32x4* s = (const f32x4*)(C.w_in + (size_t)k * INW + GA_SRC);
#pragma unroll
        for (int q = 0; q < 4; ++q) { const f32x4 v = s[q]; C.WGA[(4 * q + 0) * D + k] = (bf16)(pk2(v.x, 0.f) & 0xffff); C.WGA[(4 * q + 1) * D + k] = (bf16)(pk2(v.y, 0.f) & 0xffff);
            C.WGA[(4 * q + 2) * D + k] = (bf16)(pk2(v.z, 0.f) & 0xffff); C.WGA[(4 * q + 3) * D + k] = (bf16)(pk2(v.w, 0.f) & 0xffff); } }
    for (int it = gw; it < NEXP; it += ngw) {
        const f32x4* su = (const f32x4*)(C.pu + (size_t)it * D) + lane; const f32x4* sv = (const f32x4*)(C.pv + (size_t)it * D) + lane; f32x4 vu[8], vv[8];
#pragma unroll
        for (int j = 0; j < 8; ++j) { vu[j] = su[64 * j]; vv[j] = sv[64 * j]; }
        quant_store(vu, C.UQ, C.US, it, NEXP, lane, 0); quant_store(vv, C.VQ, C.VS, it, NEXP, lane, 0);
    }
    for (int it = gw; it < 32; it += ngw) convert_item(C.keys, C.KEYSB, it, lane);
    for (int idx = C.vcu * NTHREADS + C.tid; idx < T * 16; idx += C.G * NTHREADS) {
        const int t = idx >> 4, f = idx & 15; const float inv = powf(500000.0f, -(float)f * 0.0625f); const float ang = (float)C.pos[t] * inv;
        C.CS[2 * idx] = cosf(ang); C.CS[2 * idx + 1] = sinf(ang);
    }
}

__device__ __forceinline__ float modi_to_f32(long long v) { return (float)(int)(v >> 32) * 0.00390625f + (float)(unsigned)v * 9.094947017729282e-13f; }
template <bool FIRST> __device__ __forceinline__ void norm_mod_phase(const Ctx& C, const float* X, const float* g, int shift_off, int scale_off, bf16* O) {
    LAS float* lg = (LAS float*)C.lds; LAS float* lsh = lg + D; LAS float* lsc = lsh + BATCH * D;
    for (int i = C.tid; i < D; i += NTHREADS) lg[i] = g[i];
    for (int i = C.tid; i < BATCH * D; i += NTHREADS) { const int b = i / D, j = i % D;
        lsh[i] = C.MOD[b * NMOD + shift_off + j]; lsc[i] = 1.f + C.MOD[b * NMOD + scale_off + j]; }
    __syncthreads();
    for (int m = C.gw; m < T; m += C.ngw) {
        const int b = m / SEQ; const f32x4* xr = (const f32x4*)(X + (size_t)m * D) + C.lane;
        f32x4 v[8]; float ss = 0.f;
#pragma unroll
        for (int j = 0; j < 8; ++j) { v[j] = xr[64 * j]; ss += (v[j].x * v[j].x + v[j].y * v[j].y) + (v[j].z * v[j].z + v[j].w * v[j].w); }
        const float rstd = rsqrtf(wave_sum(ss) * (1.f / D) + EPS);
        const LAS f32x4* g4 = (const LAS f32x4*)lg + C.lane; const LAS f32x4* sh4 = (const LAS f32x4*)(lsh + b * D) + C.lane; const LAS f32x4* sc4 = (const LAS f32x4*)(lsc + b * D) + C.lane;
        v2u* o8 = (v2u*)(O + (size_t)m * D) + C.lane;
#pragma unroll
        for (int j = 0; j < 8; ++j) { const f32x4 y = v[j] * rstd * g4[64 * j] * sc4[64 * j] + sh4[64 * j]; v2u w; w.x = pk2(y.x, y.y); w.y = pk2(y.z, y.w); o8[64 * j] = w; v[j] = y; }
        if (!FIRST) quant_store(v, C.HQ, C.HS, m, T, C.lane, 0);
    }
    __syncthreads();
}

__device__ __forceinline__ void gla_prep_item(const Ctx& C, int b, int n, int ch) {
    const int lane = C.lane, w = C.wave, fr = lane & 15, fq = lane >> 4, rt = w & 3, kh = w >> 2; const size_t t0 = (size_t)b * SEQ + 64 * n;
    const bf16* ap = C.H + (t0 + 16 * rt + fr) * D + kh * 1024 + 8 * fq; const bf16* bp = C.WGA + fr * D + kh * 1024 + 8 * fq;
    f32x4 acc = {0.f, 0.f, 0.f, 0.f};
#pragma unroll 16
    for (int s = 0; s < 32; ++s) acc = __builtin_amdgcn_mfma_f32_16x16x32_bf16(*(const bf16x8*)(ap + 32 * s), *(const bf16x8*)(bp + 32 * s), acc, 0, 0, 0);
    LAS float* gaP = (LAS float*)C.lds;
#pragma unroll
    for (int r = 0; r < 4; ++r) gaP[kh * 1024 + (16 * rt + 4 * fq + r) * 16 + fr] = acc[r];
    __syncthreads();
    const int c = C.tid & 255, th = C.tid >> 8, col = ch * 256 + c; float wc[16];
#pragma unroll
    for (int r = 0; r < 16; ++r) wc[r] = C.w_a2[r * 512 + col];
    const float ba = C.b_a[col]; float cum = 0.f, la[32];
#pragma unroll
    for (int k = 0; k < 32; ++k) { const int tok = 32 * th + k;
        const LAS f32x4* g0 = (const LAS f32x4*)(gaP + tok * 16); const LAS f32x4* g1 = (const LAS f32x4*)(gaP + 1024 + tok * 16); float z = ba;
#pragma unroll
        for (int q = 0; q < 4; ++q) { const f32x4 gv = g0[q] + g1[q]; z += gv.x * wc[4 * q] + gv.y * wc[4 * q + 1] + gv.z * wc[4 * q + 2] + gv.w * wc[4 * q + 3]; }
        cum += (fminf(z, 0.f) - __logf(1.f + __expf(-fabsf(z)))) * 0.0625f; la[k] = cum; }
    if (th == 0) gaP[2048 + c] = cum;
    __syncthreads();
    const float base = th ? gaP[2048 + c] : 0.f; float* bo = C.BCUM + (t0 + 32 * th) * 512 + col;
#pragma unroll
    for (int k = 0; k < 32; ++k) bo[(size_t)k * 512] = la[k] + base;
    __syncthreads();
}
__device__ __forceinline__ void moba_prep_item(const Ctx& C, int b, int h, int blk, int rep) {
    const int lane = C.lane, w = C.wave, i = lane & 15, tg = lane >> 4; const size_t t0 = (size_t)b * SEQ + 256 * blk;
    float qg[8], kg[8], km[8];
#pragma unroll
    for (int j = 0; j < 8; ++j) { qg[j] = C.qg[8 * i + j]; kg[j] = C.kg[8 * i + j]; km[j] = 0.f; }
    v4u rawq[8], rawk[8];
#pragma unroll
    for (int it = 0; it < 8; ++it) { const size_t tok = t0 + 32 * w + 4 * it + tg; rawq[it] = *(const v4u*)(C.PROJ + tok * NPROJ + MQ + h * 128 + 8 * i); rawk[it] = *(const v4u*)(C.PROJ + tok * NPROJ + MK + h * 128 + 8 * i); }
#pragma unroll
    for (int it = 0; it < 8; ++it) {
        const size_t tok = t0 + 32 * w + 4 * it + tg;
        float cs[16];
        if (i < 4) { const f32x4* cp = (const f32x4*)(C.CS + tok * 32 + (i & 1) * 16);
#pragma unroll
            for (int q = 0; q < 4; ++q) { const f32x4 v = cp[q]; cs[4 * q] = v.x; cs[4 * q + 1] = v.y; cs[4 * q + 2] = v.z; cs[4 * q + 3] = v.w; } }
        else {
#pragma unroll
            for (int q = 0; q < 16; ++q) cs[q] = 0.f; }
#pragma unroll
        for (int which = 0; which < 2; ++which) {
            bf16* p = C.PROJ + tok * NPROJ + (which ? MK : MQ) + h * 128 + 8 * i;
            const v4u raw = which ? rawk[it] : rawq[it]; float xv[8];
            xv[0] = bflo(raw.x); xv[1] = bfhi(raw.x); xv[2] = bflo(raw.y); xv[3] = bfhi(raw.y); xv[4] = bflo(raw.z); xv[5] = bfhi(raw.z); xv[6] = bflo(raw.w); xv[7] = bfhi(raw.w);
            float ss = 0.f;
#pragma unroll
            for (int j = 0; j < 8; ++j) ss += xv[j] * xv[j];
            ss += __shfl_xor(ss, 1); ss += __shfl_xor(ss, 2); ss += __shfl_xor(ss, 4); ss += __shfl_xor(ss, 8);
            const float rstd = rsqrtf(ss * (1.f / 128.f) + EPS);
#pragma unroll
            for (int j = 0; j < 8; ++j) xv[j] = xv[j] * rstd * (which ? kg[j] : qg[j]);
#pragma unroll
            for (int j = 0; j < 8; ++j) { const float o = __shfl_xor(xv[j], 2); const float cv = cs[2 * j], sv = cs[2 * j + 1];
                if (i < 2) xv[j] = xv[j] * cv - o * sv; else if (i < 4) xv[j] = xv[j] * cv + o * sv; }
            v4u o; o.x = pk2(xv[0], xv[1]); o.y = pk2(xv[2], xv[3]); o.z = pk2(xv[4], xv[5]); o.w = pk2(xv[6], xv[7]);
            if (rep) *(v4u*)(C.CONCAT + tok * D + which * 1024 + h * 128 + 8 * i) = o; else *(v4u*)p = o;
            if (which) {
#pragma unroll
                for (int j = 0; j < 8; ++j) km[j] += xv[j]; }
        }
    }
    LAS float* red = (LAS float*)C.lds;
#pragma unroll
    for (int j = 0; j < 8; ++j) { km[j] += __shfl_xor(km[j], 16); km[j] += __shfl_xor(km[j], 32); }
    if (lane < 16) {
#pragma unroll
        for (int j = 0; j < 8; ++j) red[w * 128 + 8 * i + j] = km[j]; }
    __syncthreads();
    if (C.tid < 128) { float s = 0.f;
#pragma unroll
        for (int ww = 0; ww < 8; ++ww) s += red[ww * 128 + C.tid];
        C.KMEAN[((size_t)(b * NH + h) * 16 + blk) * 128 + C.tid] = s * (1.f / 256.f); }
    __syncthreads();
}

constexpr int KP = 272, VP = 320;
constexpr int MB_BUF = 65536, MB_KT = 16384, MB_V0 = 32768;
__device__ __forceinline__ void moba_unit(const Ctx& C, int b, int h, int qb, int half) {
    const int lane = C.lane, w = C.wave, r = lane & 31, hh = lane >> 5, grp = w >> 2, wq = w & 3;
    const size_t tb = (size_t)b * SEQ; const int q0 = qb * 256 + 128 * half;
    const bf16* Qh = C.PROJ + MQ + h * 128; const bf16* Kh = C.PROJ + MK + h * 128; const bf16* Vh = C.PROJ + MV + h * 128;
    bf16x8 qf[8];
    { const bf16* qrow = Qh + (tb + q0 + 32 * wq + r) * NPROJ + 8 * hh;
#pragma unroll
      for (int s = 0; s < 8; ++s) qf[s] = *(const bf16x8*)(qrow + 16 * s); }
    unsigned selmask = 0u;
    { float g0 = -INFINITY, g1 = -INFINITY, g2 = -INFINITY; int i0 = -1, i1 = -1, i2 = -1;
      const float* km = C.KMEAN + ((size_t)(b * NH + h) * 16) * 128 + 8 * hh;
      for (int j = 0; j < qb; ++j) {
          float acc = 0.f;
#pragma unroll
          for (int s = 0; s < 8; ++s) { const f32x4 k0 = *(const f32x4*)(km + j * 128 + 16 * s), k1 = *(const f32x4*)(km + j * 128 + 16 * s + 4);
              acc += bf1(qf[s][0]) * k0.x + bf1(qf[s][1]) * k0.y + bf1(qf[s][2]) * k0.z + bf1(qf[s][3]) * k0.w + bf1(qf[s][4]) * k1.x + bf1(qf[s][5]) * k1.y + bf1(qf[s][6]) * k1.z + bf1(qf[s][7]) * k1.w; }
          acc += __shfl_xor(acc, 32);
          if (acc > g0) { g2 = g1; i2 = i1; g1 = g0; i1 = i0; g0 = acc; i0 = j; }
          else if (acc > g1) { g2 = g1; i2 = i1; g1 = acc; i1 = j; }
          else if (acc > g2) { g2 = acc; i2 = j; }
      }
      if (i0 >= 0) selmask |= 1u << i0; if (i1 >= 0) selmask |= 1u << i1; if (i2 >= 0) selmask |= 1u << i2; }
    asm volatile("s_waitcnt vmcnt(0)" ::: "memory");
    const int nown = 2 * half + 2, NT = nown + 4 * qb, NS = (NT + 1) >> 1;
    unsigned kso[2], vso[2];
#pragma unroll
    for (int j = 0; j < 2; ++j) { const int row = 8 * w + 4 * j + (lane >> 4), cp = lane & 15; kso[j] = (unsigned)(row * (NPROJ * 2) + 16 * (cp ^ (row & 15))); vso[j] = (unsigned)(row * (NPROJ * 2) + 16 * (cp ^ ((row & 3) << 2))); }
#define MB_KEY0(i) ((i) < nown ? qb * 256 + 64 * (i) : (((i) - nown) >> 2) * 256 + 64 * (((i) - nown) & 3))
#define MB_DMA(s, buf) do { _Pragma("unroll") for (int tl = 0; tl < 2; ++tl) { int i_ = 2 * (s) + tl; if (i_ >= NT) i_ = NT - 1; const size_t ks_ = (size_t)__builtin_amdgcn_readfirstlane((int)(MB_KEY0(i_))) * (NPROJ * 2); \
        const char* kp_ = (const char*)(Kh + tb * NPROJ) + ks_; const char* vp_ = (const char*)(Vh + tb * NPROJ) + ks_; _Pragma("unroll") for (int j = 0; j < 2; ++j) { \
            __builtin_amdgcn_global_load_lds((const unsigned*)(kp_ + kso[j]), (LAS unsigned*)(C.lds + (buf) * MB_BUF + tl * MB_KT + (2 * w + j) * 1024), 16, 0, 0); \
            __builtin_amdgcn_global_load_lds((const unsigned*)(vp_ + vso[j]), (LAS unsigned*)(C.lds + (buf) * MB_BUF + MB_V0 + tl * MB_KT + (2 * w + j) * 1024), 16, 0, 0); } } } while (0)
    MB_DMA(0, 0); __syncthreads();
    float m_run = -1e30f, l_run = 0.f; f32x16 o[4];
#pragma unroll
    for (int dt = 0; dt < 4; ++dt)
#pragma unroll
        for (int q = 0; q < 16; ++q) o[dt][q] = 0.f;
    const float c2 = 0.08838834764831845f * 1.4426950408889634f;
    const int xr = r & 15, vq = (lane & 15) >> 2;
    const int kfo = grp * MB_KT + r * 256, vfo = MB_V0 + grp * MB_KT + (4 * hh + vq) * 256 + 32 * ((lane >> 4) & 1) + 8 * (lane & 3);
    for (int s = 0; s < NS; ++s) {
        const int buf = s & 1;
        if (s + 1 < NS) MB_DMA(s + 1, buf ^ 1);
        const int i = 2 * s + grp; const bool own = i < nown; const int tt = i, blk = own ? qb : (i - nown) >> 2;
        const bool mine = own || ((selmask >> blk) & 1u);
        const bool need = i < NT && (own ? (64 * tt <= 128 * half + 32 * wq + 31) : (__ballot(mine) != 0ull));
        if (need) {
            const LAS unsigned char* kb = C.lds + buf * MB_BUF + kfo;
            bf16x8 ka[4], kc[4];
#define MB_KLOAD(dst, s2) do { _Pragma("unroll") for (int u_ = 0; u_ < 2; ++u_) { const int co_ = ((2 * (2 * (s2) + u_) + hh) ^ xr) << 4; dst[2 * u_] = *(const LAS bf16x8*)(kb + co_); dst[2 * u_ + 1] = *(const LAS bf16x8*)(kb + 32 * 256 + co_); } } while (0)
#define MB_QK(src, s2) do { _Pragma("unroll") for (int u_ = 0; u_ < 2; ++u_) { p0 = MFMA32(src[2 * u_], qf[2 * (s2) + u_], p0); p1 = MFMA32(src[2 * u_ + 1], qf[2 * (s2) + u_], p1); } } while (0)
            MB_KLOAD(ka, 0); MB_KLOAD(kc, 1); __builtin_amdgcn_sched_barrier(0);
            f32x16 p0 = {0.f, 0.f, 0.f, 0.f, 0.f, 0.f, 0.f, 0.f, 0.f, 0.f, 0.f, 0.f, 0.f, 0.f, 0.f, 0.f}, p1 = p0;
            MB_QK(ka, 0); MB_KLOAD(ka, 2); __builtin_amdgcn_sched_barrier(0);
            MB_QK(kc, 1); MB_KLOAD(kc, 3); __builtin_amdgcn_sched_barrier(0);
            MB_QK(ka, 2); MB_QK(kc, 3);
#undef MB_KLOAD
#undef MB_QK
            const LAS unsigned char* vb = C.lds + buf * MB_BUF + vfo;
            s16x4 va[8], vc[8];
#define MB_VLOAD(dst, dt) do { const LAS unsigned char* vd_ = vb + 64 * ((dt) ^ vq); _Pragma("unroll") for (int kk = 0; kk < 4; ++kk) { dst[2 * kk] = vtr(vd_ + (16 * kk) * 256); dst[2 * kk + 1] = vtr(vd_ + (16 * kk + 8) * 256); } } while (0)
#define MB_PV(src, dt) do { _Pragma("unroll") for (int kk = 0; kk < 4; ++kk) o[dt] = MFMA32(cat4(src[2 * kk], src[2 * kk + 1]), pf[kk], o[dt]); } while (0)
            MB_VLOAD(va, 0);
            __builtin_amdgcn_sched_barrier(0);
            if (own) { const int qi = 128 * half + 32 * wq + r;
#pragma unroll
                for (int q = 0; q < 16; ++q) { const int kk = 64 * tt + crow(q, hh); if (kk > qi) p0[q] = -INFINITY; if (kk + 32 > qi) p1[q] = -INFINITY; } }
            else if (!mine) {
#pragma unroll
                for (int q = 0; q < 16; ++q) { p0[q] = -INFINITY; p1[q] = -INFINITY; } }
            float mx = fmaxf(p0[0], p1[0]);
#pragma unroll
            for (int q = 1; q < 16; ++q) mx = fmaxf(mx, fmaxf(p0[q], p1[q]));
            { auto rr = __builtin_amdgcn_permlane32_swap(__float_as_uint(mx), __float_as_uint(mx), false, false); mx = fmaxf(__uint_as_float(rr[0]), __uint_as_float(rr[1])); }
            const float m_new = fmaxf(m_run, mx * c2), alpha = __builtin_amdgcn_exp2f(m_run - m_new);
            m_run = m_new; float rs = 0.f;
#pragma unroll
            for (int q = 0; q < 16; ++q) { p0[q] = __builtin_amdgcn_exp2f(p0[q] * c2 - m_new); p1[q] = __builtin_amdgcn_exp2f(p1[q] * c2 - m_new); rs += p0[q] + p1[q]; }
            l_run = l_run * alpha + rs;
            if (__ballot(alpha != 1.f) != 0ull) {
#pragma unroll
                for (int dt = 0; dt < 4; ++dt)
#pragma unroll
                    for (int q = 0; q < 16; ++q) o[dt][q] *= alpha; }
            bf16x8 pf[4];
            pf[0] = pack8(p0[0], p0[1], p0[2], p0[3], p0[4], p0[5], p0[6], p0[7]); pf[1] = pack8(p0[8], p0[9], p0[10], p0[11], p0[12], p0[13], p0[14], p0[15]);
            pf[2] = pack8(p1[0], p1[1], p1[2], p1[3], p1[4], p1[5], p1[6], p1[7]); pf[3] = pack8(p1[8], p1[9], p1[10], p1[11], p1[12], p1[13], p1[14], p1[15]);
            MB_VLOAD(vc, 1); __builtin_amdgcn_sched_barrier(0); MB_PV(va, 0); __builtin_amdgcn_sched_barrier(0);
            MB_VLOAD(va, 2); __builtin_amdgcn_sched_barrier(0); MB_PV(vc, 1); __builtin_amdgcn_sched_barrier(0);
            MB_VLOAD(vc, 3); __builtin_amdgcn_sched_barrier(0); MB_PV(va, 2); __builtin_amdgcn_sched_barrier(0);
            MB_PV(vc, 3);
#undef MB_VLOAD
#undef MB_PV
        }
        __syncthreads();
    }
#undef MB_DMA
#undef MB_KEY0
    LAS float* mo = (LAS float*)C.lds + wq * (66 * 64);
    if (grp == 1) {
#pragma unroll
        for (int dt = 0; dt < 4; ++dt)
#pragma unroll
            for (int q = 0; q < 16; ++q) mo[(16 * dt + q) * 64 + lane] = o[dt][q];
        mo[64 * 64 + lane] = m_run; mo[65 * 64 + lane] = l_run; }
    __syncthreads();
    if (grp == 0) {
        const float m1 = mo[64 * 64 + lane], l1 = mo[65 * 64 + lane], m = fmaxf(m_run, m1), a0 = __builtin_amdgcn_exp2f(m_run - m), a1 = __builtin_amdgcn_exp2f(m1 - m);
        float l = l_run * a0 + l1 * a1; l += __shfl_xor(l, 32);
        const float inv = 1.f / l, s0 = a0 * inv, s1 = a1 * inv;
        bf16* op = C.CONCAT + (tb + q0 + 32 * wq + r) * D + 1024 + h * 128 + 4 * hh;
#pragma unroll
        for (int dt = 0; dt < 4; ++dt)
#pragma unroll
            for (int k4 = 0; k4 < 4; ++k4) { float y[4];
#pragma unroll
                for (int q = 0; q < 4; ++q) y[q] = o[dt][4 * k4 + q] * s0 + mo[(16 * dt + 4 * k4 + q) * 64 + lane] * s1;
                v2u wv; wv.x = pk2(y[0], y[1]); wv.y = pk2(y[2], y[3]); *(v2u*)(op + 32 * dt + 8 * k4) = wv; }
    }
    __syncthreads();
}

constexpr int GKP = 192;
__device__ __forceinline__ void gla_v_to_lds(const Ctx& C, size_t t0, int h, int off) {
#pragma unroll
    for (int pp = 0; pp < 2; ++pp) { const int p = C.tid + 512 * pp; const v4u v = *(const v4u*)(C.PROJ + (t0 + (p >> 4)) * NPROJ + GV + h * 128 + 8 * (p & 15)); *(LAS v4u*)(C.lds + off + (p >> 4) * VP + 16 * (p & 15)) = v; }
}
__device__ __forceinline__ void gla_u_item(const Ctx& C, int b, int h, int n) {
    const int tid = C.tid, lane = C.lane, w = C.wave, r = lane & 31, hh = lane >> 5; const size_t t0 = (size_t)b * SEQ + 64 * n; const int bhn = (b * NH + h) * 64 + n;
    constexpr int KT = 0, VT = 64 * GKP;
    { const int tok = tid >> 3, ch = tid & 7;
      const v4u raw = *(const v4u*)(C.PROJ + (t0 + tok) * NPROJ + GK + h * 64 + 8 * ch);
      const f32x4* bp = (const f32x4*)(C.BCUM + (t0 + tok) * 512 + h * 64 + 8 * ch); const f32x4* bl = (const f32x4*)(C.BCUM + (t0 + 63) * 512 + h * 64 + 8 * ch);
      const f32x4 b0 = bp[0], b1 = bp[1], l0 = bl[0], l1 = bl[1];
      const bf16x8 kv = pack8(bflo(raw.x) * __expf(l0.x - b0.x), bfhi(raw.x) * __expf(l0.y - b0.y), bflo(raw.y) * __expf(l0.z - b0.z), bfhi(raw.y) * __expf(l0.w - b0.w),
                              bflo(raw.z) * __expf(l1.x - b1.x), bfhi(raw.z) * __expf(l1.y - b1.y), bflo(raw.w) * __expf(l1.z - b1.z), bfhi(raw.w) * __expf(l1.w - b1.w));
      *(LAS bf16x8*)(C.lds + KT + tok * GKP + 16 * ch) = kv;
      if (tok == 63) { f32x4* dp = (f32x4*)(C.DEC + (size_t)bhn * 64 + 8 * ch); dp[0] = (f32x4){__expf(l0.x), __expf(l0.y), __expf(l0.z), __expf(l0.w)}; dp[1] = (f32x4){__expf(l1.x), __expf(l1.y), __expf(l1.z), __expf(l1.w)}; } }
    gla_v_to_lds(C, t0, h, VT);
    __syncthreads();
    const int mt = w & 3, nt = w >> 2, q = (lane & 15) >> 2, cb = (16 * ((lane >> 4) & 1) + 4 * (lane & 3)) * 2;
    const LAS unsigned char* va = C.lds + VT + (4 * hh + q) * VP + cb + mt * 64; const LAS unsigned char* ka = C.lds + KT + (4 * hh + q) * GKP + cb + nt * 64;
    f32x16 acc;
#pragma unroll
    for (int i = 0; i < 16; ++i) acc[i] = 0.f;
#pragma unroll
    for (int s = 0; s < 4; ++s) acc = MFMA32(cat4(vtr(va + 16 * s * VP), vtr(va + (16 * s + 8) * VP)), cat4(vtr(ka + 16 * s * GKP), vtr(ka + (16 * s + 8) * GKP)), acc);
    float* up = C.UT + (size_t)bhn * 8192 + (32 * mt) * 64 + 32 * nt + r;
#pragma unroll
    for (int i = 0; i < 16; ++i) up[crow(i, hh) * 64] = acc[i];
    __syncthreads();
}
__device__ __forceinline__ void p4_phase(const Ctx& C, int rep) {
    volatile LAS int* qslot = (volatile LAS int*)(C.lds + MISC_OFF + 64);
    const int xcc = (int)(xb_xcc_id() & 7u); unsigned* cnt = C.ctl + CW_Q + 64 * 16 * rep;
    for (;;) {
        __syncthreads();
        if (C.tid == 0) { int res = -1;
            for (int s = 0; s < 8 && res < 0; ++s) { const int q = (xcc + s) & 7;
                if (__hip_atomic_load(cnt + 64 * q, __ATOMIC_RELAXED, __HIP_MEMORY_SCOPE_AGENT) >= 64u) continue;
                const unsigned id = atomicAdd(cnt + 64 * q, 1u); if (id < 64u) res = q * 64 + (int)id; }
            if (res < 0) { const unsigned id = atomicAdd(cnt + 64 * 8, 1u); res = id < 1024u ? 512 + (int)id : -1; }
            *qslot = res; }
        __syncthreads();
        const int id = *qslot;
        if (id < 0) break;
        if (id < 512) { const int q = id >> 6, li = id & 63, bh = 2 * q + (li & 1), rank = li >> 1; moba_unit(C, bh >> 3, bh & 7, 15 - (rank >> 1), 1 - (rank & 1)); }
        else { const int g = id - 512; gla_u_item(C, g >> 9, (g >> 6) & 7, g & 63); }
    }
}

__device__ __forceinline__ void p5_phase(const Ctx& C) {
    for (int idx = C.vcu * NTHREADS + C.tid; idx < 16 * 8192; idx += C.G * NTHREADS) {
        const int bh = idx >> 13, rem = idx & 8191, dk = rem & 63; float s = 0.f;
        const float* up = C.UT + (size_t)bh * 64 * 8192 + rem; const float* dp = C.DEC + (size_t)bh * 64 * 64 + dk; bf16* sp = C.ST + (size_t)bh * 64 * 8192 + rem;
#pragma unroll 16
        for (int n = 0; n < 64; ++n) { sp[(size_t)n * 8192] = (bf16)(pk2(s, 0.f) & 0xffffu); s = dp[n * 64] * s + up[(size_t)n * 8192]; }
    }
}

__device__ __forceinline__ void gla_out_item(const Ctx& C, int b, int h, int n) {
    const int lane = C.lane, w = C.wave, r = lane & 31, hh = lane >> 5, dvt = w & 3, lt = w >> 2; const size_t t0 = (size_t)b * SEQ + 64 * n; const int bhn = (b * NH + h) * 64 + n;
    constexpr int VT = 0, RED = 64 * VP;
    const size_t tl = t0 + 32 * lt + r;
    v4u vraw[2], qraw[4], kraw[2][4]; f32x4 bq[4][2], bk[4][2];
#pragma unroll
    for (int pp = 0; pp < 2; ++pp) { const int p = C.tid + 512 * pp; vraw[pp] = *(const v4u*)(C.PROJ + (t0 + (p >> 4)) * NPROJ + GV + h * 128 + 8 * (p & 15)); }
#pragma unroll
    for (int s = 0; s < 4; ++s) { qraw[s] = *(const v4u*)(C.PROJ + tl * NPROJ + GQ + h * 64 + 16 * s + 8 * hh); const f32x4* bp = (const f32x4*)(C.BCUM + tl * 512 + h * 64 + 16 * s + 8 * hh); bq[s][0] = bp[0]; bq[s][1] = bp[1];
        kraw[1][s] = *(const v4u*)(C.PROJ + tl * NPROJ + GK + h * 64 + 16 * s + 8 * hh); }
    if (lt == 1) { const size_t tm = t0 + r;
#pragma unroll
        for (int s = 0; s < 4; ++s) { kraw[0][s] = *(const v4u*)(C.PROJ + tm * NPROJ + GK + h * 64 + 16 * s + 8 * hh); const f32x4* bp = (const f32x4*)(C.BCUM + tm * 512 + h * 64 + 16 * s + 8 * hh); bk[s][0] = bp[0]; bk[s][1] = bp[1]; } }
    else {
#pragma unroll
        for (int s = 0; s < 4; ++s) { kraw[0][s] = kraw[1][s]; bk[s][0] = bq[s][0]; bk[s][1] = bq[s][1]; } }
#pragma unroll
    for (int pp = 0; pp < 2; ++pp) { const int p = C.tid + 512 * pp; *(LAS v4u*)(C.lds + VT + (p >> 4) * VP + 16 * (p & 15)) = vraw[pp]; }
    bf16x8 qd[4];
#pragma unroll
    for (int s = 0; s < 4; ++s) { const v4u raw = qraw[s]; const f32x4 b0 = bq[s][0], b1 = bq[s][1];
        qd[s] = pack8(bflo(raw.x) * 0.125f * __expf(b0.x), bfhi(raw.x) * 0.125f * __expf(b0.y), bflo(raw.y) * 0.125f * __expf(b0.z), bfhi(raw.y) * 0.125f * __expf(b0.w),
                      bflo(raw.z) * 0.125f * __expf(b1.x), bfhi(raw.z) * 0.125f * __expf(b1.y), bflo(raw.w) * 0.125f * __expf(b1.z), bfhi(raw.w) * 0.125f * __expf(b1.w)); }
    bf16x8 sfr[4]; v2u graw[4]; f32x4 gn[4];
    { const bf16* sp = C.ST + (size_t)bhn * 8192 + (32 * dvt + r) * 64 + 8 * hh;
#pragma unroll
      for (int s = 0; s < 4; ++s) sfr[s] = *(const bf16x8*)(sp + 16 * s);
#pragma unroll
      for (int k4 = 0; k4 < 4; ++k4) { const int d0 = 32 * dvt + 8 * k4 + 4 * hh; graw[k4] = *(const v2u*)(C.PROJ + tl * NPROJ + GG + h * 128 + d0); gn[k4] = *(const f32x4*)(C.gla_g + d0); } }
    __syncthreads();
    f32x16 o;
#pragma unroll
    for (int i = 0; i < 16; ++i) o[i] = 0.f;
    const LAS unsigned char* va = C.lds + VT + (4 * hh + ((lane & 15) >> 2)) * VP + (16 * ((lane >> 4) & 1) + 4 * (lane & 3)) * 2 + dvt * 64;
#pragma unroll
    for (int mt = 0; mt < 2; ++mt) {
        if (mt > lt) break;
        const bool diag = (mt == lt); f32x16 X;
#pragma unroll
        for (int i = 0; i < 16; ++i) X[i] = 0.f;
#pragma unroll
        for (int s = 0; s < 4; ++s) { const v4u raw = diag ? kraw[1][s] : kraw[0][s]; const f32x4 b0 = diag ? bq[s][0] : bk[s][0], b1 = diag ? bq[s][1] : bk[s][1];
            const bf16x8 kd = pack8(bflo(raw.x) * __expf(-b0.x), bfhi(raw.x) * __expf(-b0.y), bflo(raw.y) * __expf(-b0.z), bfhi(raw.y) * __expf(-b0.w),
                                    bflo(raw.z) * __expf(-b1.x), bfhi(raw.z) * __expf(-b1.y), bflo(raw.w) * __expf(-b1.z), bfhi(raw.w) * __expf(-b1.w));
            X = MFMA32(kd, qd[s], X); }
        if (diag) {
#pragma unroll
            for (int i = 0; i < 16; ++i) if (crow(i, hh) > r) X[i] = 0.f; }
        const bf16x8 pf0 = pack8(X[0], X[1], X[2], X[3], X[4], X[5], X[6], X[7]), pf1 = pack8(X[8], X[9], X[10], X[11], X[12], X[13], X[14], X[15]);
        o = MFMA32(cat4(vtr(va + (32 * mt) * VP), vtr(va + (32 * mt + 8) * VP)), pf0, o);
        o = MFMA32(cat4(vtr(va + (32 * mt + 16) * VP), vtr(va + (32 * mt + 24) * VP)), pf1, o);
    }
#pragma unroll
    for (int s = 0; s < 4; ++s) o = MFMA32(sfr[s], qd[s], o);
    float ss = 0.f;
#pragma unroll
    for (int i = 0; i < 16; ++i) ss += o[i] * o[i];
    ss += __shfl_xor(ss, 32);
    LAS float* red = (LAS float*)(C.lds + RED);
    if (hh == 0) red[dvt * 64 + 32 * lt + r] = ss;
    __syncthreads();
    const int l = 32 * lt + r; const float rstd = rsqrtf((red[l] + red[64 + l] + red[128 + l] + red[192 + l]) * (1.f / 128.f) + EPS);
#pragma unroll
    for (int k4 = 0; k4 < 4; ++k4) { const int d0 = 32 * dvt + 8 * k4 + 4 * hh;
        const float ga = bflo(graw[k4].x), gb = bfhi(graw[k4].x), gc = bflo(graw[k4].y), gd = bfhi(graw[k4].y); const f32x4 gnv = gn[k4];
        const float y0 = o[4 * k4] * rstd * gnv.x * (ga / (1.f + __expf(-ga))), y1 = o[4 * k4 + 1] * rstd * gnv.y * (gb / (1.f + __expf(-gb)));
        const float y2 = o[4 * k4 + 2] * rstd * gnv.z * (gc / (1.f + __expf(-gc))), y3 = o[4 * k4 + 3] * rstd * gnv.w * (gd / (1.f + __expf(-gd)));
        v2u wv; wv.x = pk2(y0, y1); wv.y = pk2(y2, y3); *(v2u*)(C.CONCAT + tl * D + h * 128 + d0) = wv; }
    __syncthreads();
}

#define INS16(L, xin) do { int x_ = (xin); _Pragma("unroll") for (int i_ = 0; i_ < 16; ++i_) { const int hi_ = max(L[i_], x_); x_ = min(L[i_], x_); L[i_] = hi_; } } while (0)
#define CE_DESC(a, b) do { const int hi_ = max(a, b), lo_ = min(a, b); a = hi_; b = lo_; } while (0)
#define BITONIC_MERGE16(L) do { _Pragma("unroll") for (int j_ = 8; j_ > 0; j_ >>= 1) _Pragma("unroll") for (int i_ = 0; i_ < 16; ++i_) if ((i_ & j_) == 0) CE_DESC(L[i_], L[i_ | j_]); } while (0)
#define SORT16(L) do { _Pragma("unroll") for (int k_ = 2; k_ <= 16; k_ <<= 1) _Pragma("unroll") for (int j_ = k_ >> 1; j_ > 0; j_ >>= 1) _Pragma("unroll") for (int i_ = 0; i_ < 16; ++i_) { const int l_ = i_ ^ j_; \
        if (l_ > i_) { if ((i_ & k_) == 0) CE_DESC(L[i_], L[l_]); else CE_DESC(L[l_], L[i_]); } } } while (0)
#define MERGE16(L, M) do { _Pragma("unroll") for (int i_ = 0; i_ < 16; ++i_) L[i_] = max(L[i_], M[15 - i_]); BITONIC_MERGE16(L); } while (0)
__device__ __forceinline__ int ord_key(float v) { int u = __float_as_int(v); return u ^ ((u >> 31) & 0x7fffffff); }
__device__ __forceinline__ float ord_val(int k, int mask) { int u = k & ~mask; return __int_as_float(u ^ ((u >> 31) & 0x7fffffff)); }
__device__ __forceinline__ void peer_topk_item(const Ctx& C, int tg, int hd) {
    const int lane = C.lane, r = lane & 31, hh = lane >> 5; const size_t tok = (size_t)tg * 32 + r;
    int La[16], Lb[16];
#pragma unroll
    for (int c = 0; c < 2; ++c) {
        int L[16];
#pragma unroll
        for (int i = 0; i < 16; ++i) L[i] = (int)0x80000000;
        bf16x8 qf[8];
        { const bf16* qp = (const bf16*)C.QP + tok * D + hd * 256 + c * 128 + 8 * hh;
#pragma unroll
          for (int s = 0; s < 8; ++s) qf[s] = *(const bf16x8*)(qp + 16 * s); }
        int G[16];
        bf16x8 kfA[8], kfB[8];
#define PT_KLOAD(dst, kt) do { const bf16* kp_ = C.KEYSB + ((size_t)(hd * 2 + c) * 128 + 32 * (kt) + r) * 128 + 8 * hh; _Pragma("unroll") for (int s = 0; s < 8; ++s) dst[s] = *(const bf16x8*)(kp_ + 16 * s); } while (0)
#define PT_TILE(src, kt) do { f32x16 X; _Pragma("unroll") for (int i = 0; i < 16; ++i) X[i] = 0.f; _Pragma("unroll") for (int s = 0; s < 8; ++s) X = MFMA32(src[s], qf[s], X); \
            _Pragma("unroll") for (int i = 0; i < 16; ++i) G[i] = (ord_key(X[i]) & ~127) | (32 * (kt) + crow(i, hh)); SORT16(G); MERGE16(L, G); } while (0)
        PT_KLOAD(kfA, 0);
#pragma unroll 1
        for (int k2 = 0; k2 < 2; ++k2) {
            PT_KLOAD(kfB, 2 * k2 + 1);
            PT_TILE(kfA, 2 * k2);
            if (k2 == 0) PT_KLOAD(kfA, 2);
            PT_TILE(kfB, 2 * k2 + 1);
        }
#undef PT_KLOAD
#undef PT_TILE
        int M[16];
#pragma unroll
        for (int i = 0; i < 16; ++i) M[i] = __shfl_xor(L[i], 32);
        MERGE16(L, M);
#pragma unroll
        for (int i = 0; i < 16; ++i) { if (c == 0) La[i] = L[i]; else Lb[i] = L[i]; }
    }
    float sa[16], sb[16]; int Lc[16];
#pragma unroll
    for (int i = 0; i < 16; ++i) { sa[i] = ord_val(La[i], 127); sb[i] = ord_val(Lb[i], 127); Lc[i] = (int)0x80000000; }
#pragma unroll
    for (int i = 0; i < 16; ++i)
#pragma unroll
        for (int j = 0; j < 16; ++j) if ((i + 1) * (j + 1) <= 16) INS16(Lc, (ord_key(sa[i] + sb[j]) & ~255) | (i * 16 + j));
    float e[16], sum = 0.f; int ex[16]; const float mx = ord_val(Lc[0], 255);
#pragma unroll
    for (int i = 0; i < 16; ++i) {
        e[i] = __expf(ord_val(Lc[i], 255) - mx); sum += e[i];
        const int ii = (Lc[i] >> 4) & 15, jj = Lc[i] & 15; int i1 = 0, i2 = 0;
#pragma unroll
        for (int q = 0; q < 16; ++q) { i1 = (ii == q) ? (La[q] & 127) : i1; i2 = (jj == q) ? (Lb[q] & 127) : i2; }
        ex[i] = i1 * 128 + i2;
    }
    const float inv = 1.f / sum;
    if (hh == 0) {
        v4u* ep = (v4u*)(C.EXPI + tok * 128 + hd * 16); f32x4* gp = (f32x4*)(C.GATE + tok * 128 + hd * 16); f32x4* up = (f32x4*)(C.GU + tok * 128 + hd * 16); v4u* ap = (v4u*)(C.ACT + tok * 128 + hd * 16);
        const float hs = C.HS[tok];
#pragma unroll
        for (int q = 0; q < 4; ++q) { ep[q] = (v4u){(unsigned)ex[4 * q], (unsigned)ex[4 * q + 1], (unsigned)ex[4 * q + 2], (unsigned)ex[4 * q + 3]};
            gp[q] = (f32x4){e[4 * q] * inv * C.VS[ex[4 * q]], e[4 * q + 1] * inv * C.VS[ex[4 * q + 1]], e[4 * q + 2] * inv * C.VS[ex[4 * q + 2]], e[4 * q + 3] * inv * C.VS[ex[4 * q + 3]]};
            up[q] = (f32x4){hs * C.US[ex[4 * q]], hs * C.US[ex[4 * q + 1]], hs * C.US[ex[4 * q + 2]], hs * C.US[ex[4 * q + 3]]};
            ap[q] = (v4u){0u, 0u, 0u, 0u}; }
    }
}

__device__ __forceinline__ int peer_dequeue(const Ctx& C, unsigned* cnt, int xcc) {
    volatile LAS int* slot = (volatile LAS int*)(C.lds + MISC_OFF + 64);
    __syncthreads();
    if (C.tid == 0) { int res = -1;
        for (int s = 0; s < NSL; ++s) { const int sl = (xcc + s) & (NSL - 1);
            if (__hip_atomic_load(cnt + 64 * sl, __ATOMIC_RELAXED, __HIP_MEMORY_SCOPE_AGENT) >= (unsigned)NCHUNK) continue;
            const unsigned id = atomicAdd(cnt + 64 * sl, 1u); if (id < (unsigned)NCHUNK) { res = sl * NCHUNK + (int)id; break; } }
        *slot = res; }
    __syncthreads();
    return *slot;
}
#define ROWSUM16(d) do { d += __builtin_amdgcn_update_dpp(0, d, 0x121, 0xf, 0xf, false); d += __builtin_amdgcn_update_dpp(0, d, 0x122, 0xf, 0xf, false); \
                         d += __builtin_amdgcn_update_dpp(0, d, 0x124, 0xf, 0xf, false); d += __builtin_amdgcn_update_dpp(0, d, 0x128, 0xf, 0xf, false); } while (0)
#define PA_ISSUE1(buf, esrc, j_) buf[j_] = *(const v4u*)(tab + (size_t)__builtin_amdgcn_ds_swizzle(esrc, ((j_) << 5) | 0x10) * SLW)
#define PA_ISSUE(buf, esrc) do { PA_ISSUE1(buf, esrc, 0); PA_ISSUE1(buf, esrc, 1); PA_ISSUE1(buf, esrc, 2); PA_ISSUE1(buf, esrc, 3); PA_ISSUE1(buf, esrc, 4); PA_ISSUE1(buf, esrc, 5); PA_ISSUE1(buf, esrc, 6); PA_ISSUE1(buf, esrc, 7); \
        PA_ISSUE1(buf, esrc, 8); PA_ISSUE1(buf, esrc, 9); PA_ISSUE1(buf, esrc, 10); PA_ISSUE1(buf, esrc, 11); PA_ISSUE1(buf, esrc, 12); PA_ISSUE1(buf, esrc, 13); PA_ISSUE1(buf, esrc, 14); PA_ISSUE1(buf, esrc, 15); } while (0)
#define PA_COMPUTE(buf, hq_, dstv) do { _Pragma("unroll") for (int j_ = 0; j_ < 16; ++j_) { const v4u u_ = buf[j_]; \
        int d_ = __builtin_amdgcn_sdot4((int)hq_.x, (int)u_.x, 0, false); d_ = __builtin_amdgcn_sdot4((int)hq_.y, (int)u_.y, d_, false); d_ = __builtin_amdgcn_sdot4((int)hq_.z, (int)u_.z, d_, false); d_ = __builtin_amdgcn_sdot4((int)hq_.w, (int)u_.w, d_, false); \
        ROWSUM16(d_); dstv = (i == j_) ? d_ : dstv; } } while (0)
__device__ __forceinline__ void peer_a_chunk(const Ctx& C, int t0, int x, int* act) {
    const int lane = C.lane, i = lane & 15;
    v4u hq[8]; int el[8], eh[8];
#pragma unroll
    for (int tt = 0; tt < 8; ++tt) { hq[tt] = __builtin_nontemporal_load((const v4u*)(C.HQ + ((size_t)x * T + t0 + tt) * SLW + 16 * i)); el[tt] = __builtin_nontemporal_load(C.EXPI + (size_t)(t0 + tt) * 128 + lane); eh[tt] = __builtin_nontemporal_load(C.EXPI + (size_t)(t0 + tt) * 128 + 64 + lane); }
    const unsigned char* tab = C.UQ + (size_t)x * NEXP * SLW + 16 * i;
    v4u bA[16], bB[16];
    PA_ISSUE(bA, el[0]);
#pragma unroll
    for (int tt = 0; tt < 8; ++tt) {
        PA_ISSUE(bB, eh[tt]);
        int r_lo = 0, r_hi = 0;
        PA_COMPUTE(bA, hq[tt], r_lo);
        if (tt + 1 < 8) PA_ISSUE(bA, el[tt + 1]);
        PA_COMPUTE(bB, hq[tt], r_hi);
        atomicAdd(act + (size_t)(t0 + tt) * 128 + lane, r_lo); atomicAdd(act + (size_t)(t0 + tt) * 128 + 64 + lane, r_hi);
    }
}
#undef PA_ISSUE
#undef PA_ISSUE1
#undef PA_COMPUTE
#define PB_ISSUE(buf, esrc) do { _Pragma("unroll") for (int j_ = 0; j_ < 16; ++j_) { const int e_ = __builtin_amdgcn_ds_bpermute(4 * (16 * (j_ >> 2) + 4 * g + (j_ & 3)), esrc); buf[j_] = *(const v4u*)(tab + (size_t)e_ * SLW); } } while (0)
#define PB_TR4(r0_, r1_, r2_, r3_, wp_, base) do { const unsigned t0_ = __builtin_amdgcn_perm(r1_, r0_, 0x05010400u), t1_ = __builtin_amdgcn_perm(r1_, r0_, 0x07030602u), t2_ = __builtin_amdgcn_perm(r3_, r2_, 0x05010400u), t3_ = __builtin_amdgcn_perm(r3_, r2_, 0x07030602u); \
        c[(base)] = __builtin_amdgcn_sdot4((int)__builtin_amdgcn_perm(t2_, t0_, 0x05040100u), wp_, c[(base)], false); c[(base) + 1] = __builtin_amdgcn_sdot4((int)__builtin_amdgcn_perm(t2_, t0_, 0x07060302u), wp_, c[(base) + 1], false); \
        c[(base) + 2] = __builtin_amdgcn_sdot4((int)__builtin_amdgcn_perm(t3_, t1_, 0x05040100u), wp_, c[(base) + 2], false); c[(base) + 3] = __builtin_amdgcn_sdot4((int)__builtin_amdgcn_perm(t3_, t1_, 0x07060302u), wp_, c[(base) + 3], false); } while (0)
#define PB_COMPUTE(buf, psrc) do { _Pragma("unroll") for (int jb_ = 0; jb_ < 4; ++jb_) { const int wp_ = __builtin_amdgcn_ds_bpermute(4 * (16 * jb_ + 4 * g), (int)psrc); \
        PB_TR4(buf[4 * jb_].x, buf[4 * jb_ + 1].x, buf[4 * jb_ + 2].x, buf[4 * jb_ + 3].x, wp_, 0); PB_TR4(buf[4 * jb_].y, buf[4 * jb_ + 1].y, buf[4 * jb_ + 2].y, buf[4 * jb_ + 3].y, wp_, 4); \
        PB_TR4(buf[4 * jb_].z, buf[4 * jb_ + 1].z, buf[4 * jb_ + 2].z, buf[4 * jb_ + 3].z, wp_, 8); PB_TR4(buf[4 * jb_].w, buf[4 * jb_ + 1].w, buf[4 * jb_ + 2].w, buf[4 * jb_ + 3].w, wp_, 12); } } while (0)
__device__ __forceinline__ int isum_swap16(int v) { auto r = __builtin_amdgcn_permlane16_swap((unsigned)v, (unsigned)v, false, false); return (int)r[0] + (int)r[1]; }
__device__ __forceinline__ int isum_swap32(int v) { auto r = __builtin_amdgcn_permlane32_swap((unsigned)v, (unsigned)v, false, false); return (int)r[0] + (int)r[1]; }
__device__ __forceinline__ void peer_b_chunk(const Ctx& C, int t0, int x, float* dst) {
    const int lane = C.lane, i = lane & 15, g = lane >> 4, b = t0 / SEQ;
    int el[8], eh[8]; unsigned pl[8], ph[8]; float ws[8];
#pragma unroll
    for (int tt = 0; tt < 8; ++tt) { const size_t o = (size_t)(t0 + tt) * 128 + lane;
        el[tt] = __builtin_nontemporal_load(C.EXPI + o); eh[tt] = __builtin_nontemporal_load(C.EXPI + o + 64);
        const float a_lo = (float)__builtin_nontemporal_load(C.ACT + o) * __builtin_nontemporal_load(C.GU + o), a_hi = (float)__builtin_nontemporal_load(C.ACT + o + 64) * __builtin_nontemporal_load(C.GU + o + 64);
        const float w_lo = __builtin_nontemporal_load(C.GATE + o) * 0.5f * a_lo * (1.f + erff(a_lo * 0.70710678118654752f)), w_hi = __builtin_nontemporal_load(C.GATE + o + 64) * 0.5f * a_hi * (1.f + erff(a_hi * 0.70710678118654752f));
        const float wm = wave_max(fmaxf(fabsf(w_lo), fabsf(w_hi))), winv = wm > 0.f ? 127.f / wm : 0.f; ws[tt] = wm * (1.f / 127.f);
        unsigned p_lo = (unsigned)((int)rintf(w_lo * winv) & 0xff), p_hi = (unsigned)((int)rintf(w_hi * winv) & 0xff);
        p_lo |= (unsigned)__builtin_amdgcn_update_dpp(0, (int)p_lo, 0xB1, 0xf, 0xf, false) << 8; p_lo |= (unsigned)__builtin_amdgcn_update_dpp(0, (int)p_lo, 0x4E, 0xf, 0xf, false) << 16;
        p_hi |= (unsigned)__builtin_amdgcn_update_dpp(0, (int)p_hi, 0xB1, 0xf, 0xf, false) << 8; p_hi |= (unsigned)__builtin_amdgcn_update_dpp(0, (int)p_hi, 0x4E, 0xf, 0xf, false) << 16;
        pl[tt] = p_lo; ph[tt] = p_hi; }
    const unsigned char* tab = C.VQ + (size_t)x * NEXP * SLW + 16 * i;
    const int d0 = x * SLW + 16 * i + 4 * g; const f32x4 gm = *(const f32x4*)(C.MOD + b * NMOD + 5 * D + d0);
    v4u bA[16], bB[16];
    PB_ISSUE(bA, el[0]);
#pragma unroll
    for (int tt = 0; tt < 8; ++tt) {
        PB_ISSUE(bB, eh[tt]);
        const size_t off = (size_t)(t0 + tt) * D + d0; const f32x4 x1 = __builtin_nontemporal_load((const f32x4*)(C.out + off));
        int c[16];
#pragma unroll
        for (int q = 0; q < 16; ++q) c[q] = 0;
        PB_COMPUTE(bA, pl[tt]);
        if (tt + 1 < 8) PB_ISSUE(bA, el[tt + 1]);
        PB_COMPUTE(bB, ph[tt]);
#pragma unroll
        for (int q = 0; q < 16; ++q) c[q] = isum_swap32(isum_swap16(c[q]));
        f32x4 o;
#pragma unroll
        for (int q = 0; q < 4; ++q) o[q] = (float)(g == 0 ? c[q] : g == 1 ? c[4 + q] : g == 2 ? c[8 + q] : c[12 + q]) * ws[tt];
        __builtin_nontemporal_store(x1 + gm * o, (f32x4*)(dst + off));
    }
}
#undef PB_ISSUE
#undef PB_COMPUTE
#undef PB_TR4
template <int STAGE> __device__ __forceinline__ void peer_expert_phase(const Ctx& C, float* dst, int rep) {
    const int xcc = (int)(xb_xcc_id() & (NSL - 1)); unsigned* cnt = C.ctl + (STAGE == 0 ? CW_QA : CW_QB) + 64 * NSL * rep;
    for (;;) {
        const int id = peer_dequeue(C, cnt, xcc); if (id < 0) break;
        const int x = id / NCHUNK, t0 = (id % NCHUNK) * PCH + C.wave * (PCH / NWAVES);
        if (STAGE == 0) peer_a_chunk(C, t0, x, rep ? (int*)C.QP : C.ACT); else peer_b_chunk(C, t0, x, dst);
    }
}

struct Args { const void* in[18]; float* out; unsigned char* ws; int ph_lo, ph_hi; };
__global__ void __launch_bounds__(NTHREADS, 2) fwd_kernel(Args args) {
    extern __shared__ __attribute__((aligned(16))) unsigned char lds[];
    Ctx C;
    C.lds = (LAS unsigned char*)lds; C.tid = threadIdx.x; C.lane = C.tid & 63; C.wave = __builtin_amdgcn_readfirstlane(C.tid >> 6);
    C.G = gridDim.x; { const int bx = blockIdx.x; C.vcu = (C.G % 8 == 0) ? (bx % 8) * (C.G / 8) + bx / 8 : bx; }
    C.gw = C.vcu * NWAVES + C.wave; C.ngw = C.G * NWAVES;
    C.x = (const float*)args.in[0]; C.c = (const float*)args.in[1]; C.pos = (const int*)args.in[2]; C.w_ada = (const float*)args.in[3]; C.b_ada = (const float*)args.in[4]; C.g1 = (const float*)args.in[5];
    C.w_in = (const float*)args.in[6]; C.w_a2 = (const float*)args.in[7]; C.b_a = (const float*)args.in[8]; C.gla_g = (const float*)args.in[9]; C.qg = (const float*)args.in[10]; C.kg = (const float*)args.in[11];
    C.w_out = (const float*)args.in[12]; C.g2 = (const float*)args.in[13]; C.w_q = (const float*)args.in[14]; C.keys = (const float*)args.in[15]; C.pu = (const float*)args.in[16]; C.pv = (const float*)args.in[17];
    C.out = args.out; unsigned char* ws = args.ws;
    C.ctl = (unsigned*)(ws + WS_CTL); C.MODI = (long long*)(C.ctl + CW_MOD); C.MOD = (float*)(ws + WS_MODF);
    C.WIN = (bf16*)(ws + WS_WIN); C.WGA = (bf16*)(ws + WS_WGA); C.WOUT = (bf16*)(ws + WS_WOUT); C.WQ = (bf16*)(ws + WS_WQ); C.KEYSB = (bf16*)(ws + WS_KEYS); C.UQ = ws + WS_UB; C.VQ = ws + WS_VB; C.HQ = ws + WS_HQ; C.US = (float*)(ws + WS_US); C.VS = (float*)(ws + WS_VS); C.HS = (float*)(ws + WS_HS); C.GU = (float*)(ws + WS_GU); C.ACT = (int*)(ws + WS_ACT);
    C.H = (bf16*)(ws + WS_H); C.CONCAT = (bf16*)(ws + WS_CONCAT); C.PROJ = (bf16*)(ws + WS_PROJ); C.ST = (bf16*)(ws + WS_ST);
    C.CS = (float*)(ws + WS_CS); C.KMEAN = (float*)(ws + WS_KMEAN); C.DEC = (float*)(ws + WS_DEC); C.BCUM = (float*)(ws + WS_BCUM); C.UT = (float*)(ws + WS_UT); C.QP = (float*)(ws + WS_QP); C.GATE = (float*)(ws + WS_GATE); C.EXPI = (int*)(ws + WS_EXP);
    for (int u = C.tid; u < (LDS_BYTES - RING_BYTES) / 4; u += NTHREADS) ((LAS unsigned*)(C.lds + RING_BYTES))[u] = 0u;
    __syncthreads();
    const int lo = args.ph_lo, hi = args.ph_hi;
    XcdBarrier bar; bar.bar = C.ctl + CW_BAR; bar.x = 0; bar.st = nullptr;
    if (hi - lo > 1) bar = xcd_barrier_post(C.ctl + CW_BAR, (volatile LAS unsigned*)(C.lds + MISC_OFF) + 8);
#ifndef SKIPMASK
#define SKIPMASK 0
#endif
#ifndef REPEATMASK
#define REPEATMASK 0
#endif
#define IN(k) (!((SKIPMASK >> (k)) & 1) && lo <= (k) && (k) < hi)
#define REP(k, ...) do { if ((REPEATMASK >> (k)) & 1) { const int rep_ = 1; (void)rep_; __VA_ARGS__; xcd_barrier(bar); } { const int rep_ = 0; (void)rep_; __VA_ARGS__; } } while (0)
#define SEAM(k) do { if (IN(k) && IN((k) + 1)) xcd_barrier(bar); { int t_ = C.tid; asm volatile("" : "+v"(t_)); C.tid = t_; C.lane = t_ & 63; } } while (0)
    if (IN(0)) REP(0, p0_phase(C, rep_)); SEAM(0);
    if (IN(1)) REP(1, norm_mod_phase<true>(C, C.x, C.g1, 0, D, C.H)); SEAM(1);
    if (IN(2)) REP(2, pg8::Gemm g{C.H, C.WIN, T, NPROJ, D}; pg8::StaticOrder S; S.init(T, NPROJ, C.G, (int)blockIdx.x); pg8::EpiBf16<0> E{C.PROJ, NPROJ, nullptr, 0, 0, 1.f};
                 pg8::gemm_phase<pg8::EpiBf16<0>, pg8::StaticOrder, PG8_ALIGN, PG8_SP2>(C.lds, g, S, E)); SEAM(2);
    if (IN(3)) REP(3, for (int it = C.vcu; it < 256 + 256; it += C.G) { if (it < 256) moba_prep_item(C, it >> 7, (it >> 4) & 7, it & 15, rep_); else gla_prep_item(C, (it - 256) >> 7, ((it - 256) >> 1) & 63, it & 1); }); SEAM(3);
    if (IN(4)) REP(4, p4_phase(C, rep_)); SEAM(4);
    if (IN(5)) REP(5, p5_phase(C)); SEAM(5);
    if (IN(6)) REP(6, for (int it = C.vcu; it < 1024; it += C.G) gla_out_item(C, it >> 9, (it >> 6) & 7, it & 63)); SEAM(6);
    if (IN(7)) REP(7, pg8::Gemm g{C.CONCAT, C.WOUT, T, D, D}; pg8::StaticOrder S; S.init(T, D, C.G, (int)blockIdx.x); pg8::EpiResGate E{C.x, C.out, D, C.MOD + 2 * D, NMOD, SEQ / 256};
                 pg8::gemm_phase<pg8::EpiResGate, pg8::StaticOrder, PG8_ALIGN, PG8_SP2>(C.lds, g, S, E)); SEAM(7);
    if (IN(8)) REP(8, norm_mod_phase<false>(C, C.out, C.g2, 3 * D, 4 * D, C.H)); SEAM(8);
    if (IN(9)) REP(9, pg8::Gemm g{C.H, C.WQ, T, D, D}; pg8::StaticOrder S; S.init(T, D, C.G, (int)blockIdx.x); pg8::EpiBf16<0> E{(bf16*)C.QP, D, nullptr, 0, 0, 1.f};
                 pg8::gemm_phase<pg8::EpiBf16<0>, pg8::StaticOrder, PG8_ALIGN, PG8_SP2>(C.lds, g, S, E)); SEAM(9);
    if (IN(10)) REP(10, for (int it = C.gw; it < 256 * 8; it += C.ngw) peer_topk_item(C, it >> 3, it & 7)); SEAM(10);
    if (IN(11)) REP(11, peer_expert_phase<0>(C, nullptr, rep_)); SEAM(11);
    if (IN(12)) REP(12, peer_expert_phase<1>(C, rep_ ? C.QP : C.out, rep_));
#undef IN
#undef SEAM
}

extern "C" void kernel_launch(void* const* d_in, const int* in_sizes, int n_in, void* d_out, int out_size, void* d_ws, size_t ws_size, hipStream_t stream) {
    static int grid = 0;
    if (grid == 0) {
        if (n_in != 18 || in_sizes[0] != T * D || out_size != T * D || ws_size < WS_END) { fprintf(stderr, "kernel_launch: shape/workspace mismatch (n_in %d, in0 %d, out %d, ws %zu, need %zu); nothing launched\n", n_in, n_in > 0 ? in_sizes[0] : -1, out_size, ws_size, (size_t)WS_END); grid = -1; return; }
        int dev = 0, cus = 0, per_cu = 0;
        if (hipGetDevice(&dev) != hipSuccess || hipDeviceGetAttribute(&cus, hipDeviceAttributeMultiprocessorCount, dev) != hipSuccess) { fprintf(stderr, "kernel_launch: device query failed\n"); grid = -1; return; }
        if (hipFuncSetAttribute((const void*)fwd_kernel, hipFuncAttributeMaxDynamicSharedMemorySize, LDS_BYTES) != hipSuccess) { fprintf(stderr, "kernel_launch: hipFuncSetAttribute failed\n"); grid = -1; return; }
        if (hipOccupancyMaxActiveBlocksPerMultiprocessor(&per_cu, (const void*)fwd_kernel, NTHREADS, LDS_BYTES) != hipSuccess || per_cu < 1) { fprintf(stderr, "kernel_launch: occupancy query reports %d workgroups per CU\n", per_cu); (void)hipGetLastError(); grid = -1; return; }
        grid = cus;
    }
    if (grid < 0) return;
    if (hipMemsetAsync((char*)d_ws + WS_CTL, 0, CTL_ZERO_BYTES, stream) != hipSuccess) { fprintf(stderr, "kernel_launch: memset failed\n"); return; }
    Args a{};
    for (int i = 0; i < 18; ++i) a.in[i] = d_in[i];
    a.out = (float*)d_out; a.ws = (unsigned char*)d_ws;
#if MK_N_LAUNCHES == 1
    a.ph_lo = 0; a.ph_hi = N_PHASES;
    void* kargs[] = {&a};
    hipError_t le = hipLaunchCooperativeKernel((const void*)fwd_kernel, dim3(grid), dim3(NTHREADS), kargs, LDS_BYTES, stream);
    if (le != hipSuccess) fprintf(stderr, "kernel_launch: cooperative launch failed: %s (grid %d)\n", hipGetErrorName(le), grid);
#else
    for (int p = 0; p < N_PHASES; ++p) { a.ph_lo = p; a.ph_hi = p + 1; hipLaunchKernelGGL(fwd_kernel, dim3(grid), dim3(NTHREADS), LDS_BYTES, stream, a); }
#endif
}
```

```cpp
#include <hip/hip_runtime.h>
#include <hip/hip_bf16.h>
#include <cstdio>
#include <cstdint>
#include <cmath>
namespace pg8 {
#define PG8_LAS __attribute__((address_space(3)))
typedef unsigned short bf16_t;
typedef short bf16x8 __attribute__((ext_vector_type(8)));
typedef float f32x4 __attribute__((ext_vector_type(4)));
typedef unsigned u32x4 __attribute__((ext_vector_type(4)));
constexpr int BM = 256, BK = 64, HALF = 128, HTB = HALF * BK * 2  , STAGE_BYTES = 8 * HTB, NXCD = 8, WGM = 8;

__host__ __device__ __forceinline__ int lds_byte(int r, int c) { const int st = (r >> 4) * 2 + (c >> 5), rr = r & 15, cc = c & 31, ob = rr * 64 + cc * 2; return st * 1024 + (ob ^ (((ob >> 9) & 1) << 5)); }
__host__ __device__ __forceinline__ void stage_rc(int b, int& R, int& C) { const int st = b / 1024, sb = b % 1024, swz = sb ^ (((sb >> 9) & 1) << 5); R = (st >> 1) * 16 + swz / 64; C = (st & 1) * 32 + (swz % 64) / 2; }
__host__ __device__ __forceinline__ int perm32(int rho) { const int n = rho >> 4, i = rho & 15; return 8 * (i >> 2) + 4 * n + (i & 3); }

struct Unit { int pm, pn; };
struct Gemm { const bf16_t* A; const bf16_t* Bt; int M, N, K; };

struct StaticOrder {
    int nM, nN, nwg, G, c;
    __host__ __device__ void init(int M, int N, int G_, int c_) { nM = M / BM; nN = N / BM; nwg = nM * nN; G = G_; c = c_; }
    __host__ __device__ bool next(int i, Unit& u) const {
        const long L = (long)i * G + c; if (L >= nwg) return false;
        int wgid = (int)L; { const int q = nwg / NXCD, r = nwg % NXCD, xcd = wgid % NXCD, off = wgid / NXCD; wgid = (xcd < r ? xcd * (q + 1) : r * (q + 1) + (xcd - r) * q) + off; }
        const int nig = WGM * nN, gid = wgid / nig, fm = gid * WGM, gsz = (nM - fm) < WGM ? (nM - fm) : WGM;
        u.pm = fm + ((wgid % nig) % gsz); u.pn = (wgid % nig) / gsz; return true;
    }
    __device__ __forceinline__ void a_ready(const Unit&) const {}
    __device__ __forceinline__ void done(const Unit&) const {}
};

__device__ __forceinline__ unsigned cvt_pk_bf16(float lo, float hi) { unsigned r; asm volatile("v_cvt_pk_bf16_f32 %0, %1, %2" : "=v"(r) : "v"(lo), "v"(hi)); return r; }
typedef float f32x2 __attribute__((ext_vector_type(2)));
__device__ __forceinline__ f32x2 gelu_pk(f32x2 v) {
    const f32x2 av = __builtin_elementwise_abs(v), d = av * 0.2316418882f + 1.0f;
    f32x2 t; t.x = __builtin_amdgcn_rcpf(d.x); t.y = __builtin_amdgcn_rcpf(d.y);
    f32x2 q = t * 0.5307027145f + (-0.7265760135f); q = q * t + 0.7107068705f; q = q * t + (-0.142248368f); q = q * t + 0.127414796f; q = q * t;
    const f32x2 s = (v * v) * (-0.72134752044f);
    f32x2 e; e.x = __builtin_amdgcn_exp2f(s.x); e.y = __builtin_amdgcn_exp2f(s.y);
    const f32x2 m = v * (q * e), r = v - m;
    f32x2 o; o.x = v.x < 0.f ? m.x : r.x; o.y = v.y < 0.f ? m.y : r.y; return o;
}

template <int ACT  > struct EpiBf16 {
    static constexpr bool PERM = true, AFTER_DRAIN = false; static_assert(ACT == 0 || ACT == 1, "EpiBf16: ACT is 0 (none) or 1 (gelu_pk)");
    bf16_t* O; int ldc; const float* bias; int split_cols; size_t split_stride; float scale0;
    __device__ __forceinline__ void operator()(const f32x4 (&acc)[2][2][4][2], const Unit& u, int wr, int wc, int fr, int fq) const {
        const int row0 = u.pm * BM + wr * 64 + fr; int colt = u.pn * BM; bf16_t* base = O;
        float sc = 1.f; if (split_cols) { const int t = colt / split_cols; base += (size_t)t * split_stride; colt -= t * split_cols; if (t == 0) sc = scale0; }
        const int col0 = colt + wc * 32 + 8 * fq, bcol0 = u.pn * BM + wc * 32 + 8 * fq;
        f32x4 bv[2][2];
#pragma unroll
        for (int bj = 0; bj < 2; ++bj)
#pragma unroll
            for (int n = 0; n < 2; ++n) bv[bj][n] = bias ? *(const f32x4*)(bias + bcol0 + bj * HALF + 4 * n) : (f32x4){0.f, 0.f, 0.f, 0.f};
#pragma unroll
        for (int ai = 0; ai < 2; ++ai)
#pragma unroll
            for (int m = 0; m < 4; ++m) { bf16_t* rowp = base + (size_t)(row0 + ai * HALF + m * 16) * ldc + col0;
#pragma unroll
                for (int bj = 0; bj < 2; ++bj) { f32x4 v0 = acc[ai][bj][m][0] + bv[bj][0], v1 = acc[ai][bj][m][1] + bv[bj][1];
                    if (ACT == 1) { f32x2 a = gelu_pk((f32x2){v0[0], v0[1]}), b = gelu_pk((f32x2){v0[2], v0[3]}), c = gelu_pk((f32x2){v1[0], v1[1]}), d = gelu_pk((f32x2){v1[2], v1[3]});
                        v0 = (f32x4){a.x, a.y, b.x, b.y}; v1 = (f32x4){c.x, c.y, d.x, d.y}; }
                    v0 = v0 * sc; v1 = v1 * sc; u32x4 w; w.x = cvt_pk_bf16(v0[0], v0[1]); w.y = cvt_pk_bf16(v0[2], v0[3]); w.z = cvt_pk_bf16(v1[0], v1[1]); w.w = cvt_pk_bf16(v1[2], v1[3]);
                    *(u32x4*)(rowp + bj * HALF) = w; } }
    }
};
struct EpiF32 {
    static constexpr bool PERM = false, AFTER_DRAIN = false;
    float* C; int ldc; const float* bias;
    __device__ __forceinline__ void operator()(const f32x4 (&acc)[2][2][4][2], const Unit& u, int wr, int wc, int fr, int fq) const {
        const int row0 = u.pm * BM + wr * 64 + fr, col0 = u.pn * BM + wc * 32 + 4 * fq;
        f32x4 bv[2][2];
#pragma unroll
        for (int bj = 0; bj < 2; ++bj)
#pragma unroll
            for (int n = 0; n < 2; ++n) bv[bj][n] = bias ? *(const f32x4*)(bias + col0 + bj * HALF + n * 16) : (f32x4){0.f, 0.f, 0.f, 0.f};
#pragma unroll
        for (int ai = 0; ai < 2; ++ai)
#pragma unroll
            for (int m = 0; m < 4; ++m) { float* rowp = C + (size_t)(row0 + ai * HALF + m * 16) * ldc + col0;
#pragma unroll
                for (int bj = 0; bj < 2; ++bj)
#pragma unroll
                    for (int n = 0; n < 2; ++n) *(f32x4*)(rowp + bj * HALF + n * 16) = acc[ai][bj][m][n] + bv[bj][n]; }
    }
};
struct EpiResGate {
    static constexpr bool PERM = false, AFTER_DRAIN = false;
    const float* X; float* O; int ldc; const float* gate; int gate_stride, tiles_per_batch;
    __device__ __forceinline__ void operator()(const f32x4 (&acc)[2][2][4][2], const Unit& u, int wr, int wc, int fr, int fq) const {
        const int row0 = u.pm * BM + wr * 64 + fr, col0 = u.pn * BM + wc * 32 + 4 * fq;
        const float* gp = gate + (size_t)(u.pm / tiles_per_batch) * gate_stride;
        f32x4 gv[2][2];
#pragma unroll
        for (int bj = 0; bj < 2; ++bj)
#pragma unroll
            for (int n = 0; n < 2; ++n) gv[bj][n] = *(const f32x4*)(gp + col0 + bj * HALF + n * 16);
        f32x4 xv[2][2][2];
#define ERG_LOAD(idx, slot) do { const size_t off_ = (size_t)(row0 + ((idx) >> 2) * HALF + ((idx) & 3) * 16) * ldc + col0; _Pragma("unroll") for (int bj = 0; bj < 2; ++bj) _Pragma("unroll") for (int n = 0; n < 2; ++n) xv[slot][bj][n] = *(const f32x4*)(X + off_ + bj * HALF + n * 16); } while (0)
        ERG_LOAD(0, 0); ERG_LOAD(1, 1);
#pragma unroll
        for (int idx = 0; idx < 8; ++idx) { const int ai = idx >> 2, m = idx & 3; const size_t off = (size_t)(row0 + ai * HALF + m * 16) * ldc + col0;
#pragma unroll
            for (int bj = 0; bj < 2; ++bj)
#pragma unroll
                for (int n = 0; n < 2; ++n) *(f32x4*)(O + off + bj * HALF + n * 16) = xv[idx & 1][bj][n] + gv[bj][n] * acc[ai][bj][m][n];
            if (idx + 2 < 8) ERG_LOAD(idx + 2, idx & 1); }
#undef ERG_LOAD
    }
};

template <class Epi, class Sched, bool ALIGN_EPI = false, bool SP2 = false>
__device__ __forceinline__ void gemm_phase(PG8_LAS unsigned char* lds, const Gemm g, const Sched& S, const Epi& E) {
    const int tid = threadIdx.x, wid = __builtin_amdgcn_readfirstlane(tid >> 6), lane = tid & 63, wr = wid >> 2, wc = wid & 3, fr = lane & 15, fq = lane >> 4;
    const int K = g.K, nt = K / BK;
    unsigned voffA[2], voffB[2];
#pragma unroll
    for (int i = 0; i < 2; ++i) { int R, C; stage_rc(tid * 16 + i * 8192, R, C); const int Rb = Epi::PERM ? ((R & ~31) + perm32(R & 31)) : R;
        voffA[i] = (unsigned)(R * K + C) * 2u; voffB[i] = (unsigned)(Rb * K + C) * 2u; }
    const size_t kstep = (size_t)(BK * 2);
    const size_t hstep = (size_t)HALF * K * 2;
    const size_t tstep = 2 * hstep;
    const unsigned ldsw = (unsigned)wid * 1024u;
    const int aoff = lds_byte(wr * 64 + fr, fq * 8), boff = lds_byte(wc * 32 + fr, fq * 8);
#define PG8_SA(b, h) (((b) * 2 + (h)) * HTB)
#define PG8_SB(b, h) ((4 + (b) * 2 + (h)) * HTB)
#define PG8_STAGE(bufoff, gbase, voff) do { _Pragma("unroll") for (int _i = 0; _i < 2; ++_i) \
        __builtin_amdgcn_global_load_lds((const unsigned*)((const char*)(gbase) + (voff)[_i]), (PG8_LAS unsigned*)(lds + (bufoff) + ldsw + _i * 8192), 16, 0, 0); } while (0)
#define PG8_LDA(dst, b, h) do { _Pragma("unroll") for (int m = 0; m < 4; ++m) _Pragma("unroll") for (int k = 0; k < 2; ++k) dst[m][k] = *(const PG8_LAS bf16x8*)(lds + PG8_SA(b, h) + aoff + m * 2048 + k * 1024); } while (0)
#define PG8_LDB(dst, b, h) do { _Pragma("unroll") for (int n = 0; n < 2; ++n) _Pragma("unroll") for (int k = 0; k < 2; ++k) dst[n][k] = *(const PG8_LAS bf16x8*)(lds + PG8_SB(b, h) + boff + n * 2048 + k * 1024); } while (0)
#define PG8_MMA(ai, bj, At, Bt) do { __builtin_amdgcn_s_setprio(1); _Pragma("unroll") for (int m = 0; m < 4; ++m) _Pragma("unroll") for (int n = 0; n < 2; ++n) _Pragma("unroll") for (int k = 0; k < 2; ++k) \
        acc[ai][bj][m][n] = __builtin_amdgcn_mfma_f32_16x16x32_bf16(Bt[n][k], At[m][k], acc[ai][bj][m][n], 0, 0, 0); __builtin_amdgcn_s_setprio(0); } while (0)
#define PG8_WAIT_V(n) asm volatile("s_waitcnt vmcnt(" #n ")" ::: "memory")
#define PG8_WAIT_L(n) asm volatile("s_waitcnt lgkmcnt(" #n ")" ::: "memory")
#define PG8_BAR __builtin_amdgcn_s_barrier()
#define PG8_SCHED __builtin_amdgcn_sched_barrier(0)
    Unit cur, nxt; int ui = 0;
    if (!S.next(0, cur)) return;
    f32x4 acc[2][2][4][2];
#pragma unroll
    for (int a = 0; a < 2; ++a)
#pragma unroll
        for (int b = 0; b < 2; ++b)
#pragma unroll
            for (int m = 0; m < 4; ++m)
#pragma unroll
                for (int n = 0; n < 2; ++n) acc[a][b][m][n] = (f32x4){0.f, 0.f, 0.f, 0.f};
    bf16x8 At[4][2], B0[2][2], B1[2][2];
    const char* cA = (const char*)g.A + (size_t)cur.pm * tstep; const char* cB = (const char*)g.Bt + (size_t)cur.pn * tstep;
    S.a_ready(cur);
    if constexpr (SP2) {
        PG8_STAGE(PG8_SB(0, 0), cB, voffB); PG8_STAGE(PG8_SB(0, 1), cB + hstep, voffB); PG8_STAGE(PG8_SA(0, 0), cA, voffA); PG8_STAGE(PG8_SA(0, 1), cA + hstep, voffA);
        if (wr == 1) PG8_BAR;
        PG8_WAIT_V(2); PG8_BAR;
        PG8_STAGE(PG8_SB(1, 0), cB + kstep, voffB); PG8_STAGE(PG8_SA(1, 0), cA + kstep, voffA); PG8_STAGE(PG8_SB(1, 1), cB + hstep + kstep, voffB);
        PG8_WAIT_V(6); PG8_BAR;
    } else {
        PG8_STAGE(PG8_SB(0, 0), cB, voffB); PG8_STAGE(PG8_SA(0, 0), cA, voffA); PG8_STAGE(PG8_SB(0, 1), cB + hstep, voffB); PG8_STAGE(PG8_SA(0, 1), cA + hstep, voffA);
        if (wr == 1) PG8_BAR;
        PG8_WAIT_V(4); PG8_BAR;
        PG8_STAGE(PG8_SB(1, 0), cB + kstep, voffB); PG8_STAGE(PG8_SA(1, 0), cA + kstep, voffA); PG8_STAGE(PG8_SB(1, 1), cB + hstep + kstep, voffB);
        PG8_WAIT_V(6); PG8_BAR;
    }
    for (;;) {
        const bool has_next = S.next(ui + 1, nxt);
        const char* nA = has_next ? (const char*)g.A + (size_t)nxt.pm * tstep : cA; const char* nB = has_next ? (const char*)g.Bt + (size_t)nxt.pn * tstep : cB;
        for (int t = 0; t < nt; t += 2) {
            const bool last = (t == nt - 2);
            const char* a1 = cA + (size_t)(t + 1) * kstep;
            const char* a2 = last ? nA : cA + (size_t)(t + 2) * kstep; const char* b2 = last ? nB : cB + (size_t)(t + 2) * kstep;
            const char* a3 = a2 + kstep; const char* b3 = b2 + kstep;
            if (last && has_next) S.a_ready(nxt);
            if constexpr (SP2) {
            PG8_LDB(B0, 0, 0); PG8_LDB(B1, 0, 1); PG8_SCHED; PG8_LDA(At, 0, 0); PG8_STAGE(PG8_SA(1, 1), a1 + hstep, voffA);
            PG8_WAIT_V(8); PG8_WAIT_L(0); PG8_BAR; PG8_MMA(0, 0, At, B0); PG8_MMA(0, 1, At, B1); PG8_BAR; PG8_SCHED;
            PG8_LDA(At, 0, 1); PG8_STAGE(PG8_SB(0, 0), b2, voffB); PG8_STAGE(PG8_SB(0, 1), b2 + hstep, voffB); PG8_STAGE(PG8_SA(0, 0), a2, voffA);
            PG8_WAIT_V(8); PG8_WAIT_L(0); PG8_BAR; PG8_MMA(1, 0, At, B0); PG8_MMA(1, 1, At, B1); PG8_BAR; PG8_SCHED;
            PG8_LDB(B0, 1, 0); PG8_LDB(B1, 1, 1); PG8_SCHED; PG8_LDA(At, 1, 0); PG8_STAGE(PG8_SA(0, 1), a2 + hstep, voffA);
            PG8_WAIT_V(8); PG8_WAIT_L(0); PG8_BAR; PG8_MMA(0, 0, At, B0); PG8_MMA(0, 1, At, B1); PG8_BAR; PG8_SCHED;
            PG8_LDA(At, 1, 1); PG8_STAGE(PG8_SB(1, 0), b3, voffB); PG8_STAGE(PG8_SB(1, 1), b3 + hstep, voffB); PG8_STAGE(PG8_SA(1, 0), a3, voffA);
            PG8_WAIT_V(8); PG8_WAIT_L(0); PG8_BAR; PG8_MMA(1, 0, At, B0); PG8_MMA(1, 1, At, B1); PG8_BAR; PG8_SCHED;
            } else {
            PG8_LDB(B0, 0, 0); PG8_SCHED; PG8_LDA(At, 0, 0); PG8_STAGE(PG8_SA(1, 1), a1 + hstep, voffA);
            PG8_WAIT_L(8); PG8_BAR; PG8_WAIT_L(0); PG8_MMA(0, 0, At, B0); PG8_BAR; PG8_SCHED;
            PG8_LDB(B1, 0, 1); PG8_STAGE(PG8_SB(0, 0), b2, voffB);
            PG8_BAR; PG8_WAIT_L(0); PG8_MMA(0, 1, At, B1); PG8_BAR;
            PG8_LDA(At, 0, 1); PG8_STAGE(PG8_SA(0, 0), a2, voffA);
            PG8_BAR; PG8_WAIT_L(0); PG8_MMA(1, 0, At, B0); PG8_BAR; PG8_SCHED;
            PG8_STAGE(PG8_SB(0, 1), b2 + hstep, voffB);
            PG8_WAIT_V(6); PG8_BAR; PG8_MMA(1, 1, At, B1); PG8_BAR;
            PG8_LDB(B0, 1, 0); PG8_SCHED; PG8_LDA(At, 1, 0); PG8_STAGE(PG8_SA(0, 1), a2 + hstep, voffA);
            PG8_WAIT_L(8); PG8_BAR; PG8_WAIT_L(0); PG8_MMA(0, 0, At, B0); PG8_BAR; PG8_SCHED;
            PG8_LDB(B1, 1, 1); PG8_STAGE(PG8_SB(1, 0), b3, voffB);
            PG8_BAR; PG8_WAIT_L(0); PG8_MMA(0, 1, At, B1); PG8_BAR;
            PG8_LDA(At, 1, 1); PG8_STAGE(PG8_SA(1, 0), a3, voffA);
            PG8_BAR; PG8_WAIT_L(0); PG8_MMA(1, 0, At, B0); PG8_BAR; PG8_SCHED;
            PG8_STAGE(PG8_SB(1, 1), b3 + hstep, voffB);
            PG8_WAIT_V(6); PG8_BAR; PG8_MMA(1, 1, At, B1); PG8_BAR;
            }
        }
        if constexpr (ALIGN_EPI) { if (wr == 0) PG8_BAR; }
        if constexpr (!Epi::AFTER_DRAIN) { E(acc, cur, wr, wc, fr, fq); S.done(cur); }
        if (!has_next) break;
#pragma unroll
        for (int a = 0; a < 2; ++a)
#pragma unroll
            for (int b = 0; b < 2; ++b)
#pragma unroll
                for (int m = 0; m < 4; ++m)
#pragma unroll
                    for (int n = 0; n < 2; ++n) acc[a][b][m][n] = (f32x4){0.f, 0.f, 0.f, 0.f};
        cur = nxt; cA = nA; cB = nB; ++ui;
        if constexpr (ALIGN_EPI) { if (wr == 1) PG8_BAR; }
    }
    PG8_WAIT_V(0);
    if constexpr (!ALIGN_EPI) { if (wr == 0) PG8_BAR; }
    PG8_BAR;
    if constexpr (Epi::AFTER_DRAIN) { E.fused(acc, cur, wr, wc, fr, fq, lds, wid, lane); S.done(cur); }
#undef PG8_SA
#undef PG8_SB
#undef PG8_STAGE
#undef PG8_LDA
#undef PG8_LDB
#undef PG8_MMA
#undef PG8_WAIT_V
#undef PG8_WAIT_L
#undef PG8_BAR
#undef PG8_SCHED
}
}

#ifndef PG8_SP2
#define PG8_SP2 true
#endif
#ifndef PG8_ALIGN
#define PG8_ALIGN true
#endif
constexpr int NWAVES = 8, NTHREADS = NWAVES * 64;
constexpr int BATCH = 2, SEQ = 4096, T = BATCH * SEQ, D = 2048;
constexpr int INW = 6160, NPROJ = 6144;
constexpr int GQ = 0, GK = 512, GV = 1024, GG = 2048, MQ = 3072, MK = 4096, MV = 5120;
constexpr int GA_SRC = 3072;
constexpr int NH = 8, NEXP = 16384, NMOD = 6 * D;
constexpr float EPS = 1e-6f;
#ifndef MK_N_LAUNCHES
#define MK_N_LAUNCHES 1
#endif
constexpr int N_PHASES = 13;
constexpr int NSL = 8, SLW = 256, PCH = 64, NCHUNK = (BATCH * SEQ) / PCH;

constexpr size_t MiB = 1u << 20;
constexpr size_t WS_CTL = 0, CTL_ZERO_BYTES = 1 * MiB;
constexpr size_t WS_WIN = 1 * MiB, WS_WGA = 25 * MiB, WS_WOUT = 26 * MiB, WS_WQ = 34 * MiB, WS_KEYS = 42 * MiB, WS_CS = 43 * MiB, WS_KMEAN = 44 * MiB, WS_DEC = 45 * MiB;
constexpr size_t WS_UB = 46 * MiB, WS_VB = 110 * MiB, WS_H = 174 * MiB, WS_CONCAT = 206 * MiB, WS_BCUM = 238 * MiB, WS_UT = 254 * MiB, WS_ST = 286 * MiB, WS_PROJ = 302 * MiB;
constexpr size_t WS_QP = WS_PROJ, WS_EXP = 366 * MiB, WS_GATE = 370 * MiB, WS_GU = 374 * MiB, WS_ACT = 378 * MiB, WS_HQ = 382 * MiB, WS_QDEC = 398 * MiB, WS_KDEC = 406 * MiB, WS_KUPD = 414 * MiB, WS_END = 422 * MiB;
constexpr size_t WS_US = WS_UB + 40 * MiB, WS_VS = WS_VB + 40 * MiB, WS_HS = WS_VB + 41 * MiB;
constexpr int CW_BAR = 4096, CW_Q = 8192, CW_QA = 12288, CW_QB = 13312, CW_MOD = 16384;
static_assert((CW_MOD + 2 * BATCH * NMOD) * 4 <= (int)CTL_ZERO_BYTES, "CTL words inside the memset region");
constexpr size_t WS_MODF = 45 * MiB + 512 * 1024;

constexpr int RING_BYTES = 131072, MISC_OFF = RING_BYTES + 320, LDS_BYTES = 147456;

#define GAS __attribute__((address_space(1)))
#define LAS __attribute__((address_space(3)))
typedef unsigned short bf16;
typedef unsigned v4u __attribute__((ext_vector_type(4)));
typedef unsigned v2u __attribute__((ext_vector_type(2)));
typedef float f32x4 __attribute__((ext_vector_type(4)));
typedef float f32x2 __attribute__((ext_vector_type(2)));
typedef float f32x16 __attribute__((ext_vector_type(16)));
typedef short bf16x8 __attribute__((ext_vector_type(8)));
typedef short s16x4 __attribute__((ext_vector_type(4)));
typedef __bf16 bf16x2_t __attribute__((ext_vector_type(2)));
typedef GAS unsigned gu32;
#define LDS_WAIT() asm volatile("s_waitcnt lgkmcnt(0)" ::: "memory")
#define VM_WAIT() asm volatile("s_waitcnt vmcnt(0)" ::: "memory")
__device__ __forceinline__ unsigned pk2(float lo, float hi) { f32x2 v = {lo, hi}; bf16x2_t b = __builtin_convertvector(v, bf16x2_t); return __builtin_bit_cast(unsigned, b); }
__device__ __forceinline__ float bflo(unsigned u) { return __uint_as_float(u << 16); }
__device__ __forceinline__ float bfhi(unsigned u) { return __uint_as_float(u & 0xffff0000u); }
__device__ __forceinline__ float bf1(short s) { return __uint_as_float(((unsigned)(unsigned short)s) << 16); }
__device__ __forceinline__ bf16x8 pack8(float a0, float a1, float a2, float a3, float a4, float a5, float a6, float a7) { v4u w; w.x = pk2(a0, a1); w.y = pk2(a2, a3); w.z = pk2(a4, a5); w.w = pk2(a6, a7); return __builtin_bit_cast(bf16x8, w); }
__device__ __forceinline__ int crow(int r, int hi) { return (r & 3) + 8 * (r >> 2) + 4 * hi; }
__device__ __forceinline__ float wave_sum(float v) {
#pragma unroll
    for (int o = 1; o < 64; o <<= 1) v += __shfl_xor(v, o);
    return v;
}
typedef short v4i16_t __attribute__((ext_vector_type(4)));
__device__ __forceinline__ s16x4 vtr(const LAS unsigned char* p) { return __builtin_bit_cast(s16x4, __builtin_amdgcn_ds_read_tr16_b64_v4i16((LAS v4i16_t*)p)); }
__device__ __forceinline__ bf16x8 cat4(s16x4 lo, s16x4 hi) { return (bf16x8){lo[0], lo[1], lo[2], lo[3], hi[0], hi[1], hi[2], hi[3]}; }
#define MFMA32(a, b, c) __builtin_amdgcn_mfma_f32_32x32x16_bf16((a), (b), (c), 0, 0, 0)
#define XB_TMO      128
#define XB_XCNT(j)  (256  + 64 * (j))
#define XB_XSUB(j)  (1280 + 64 * (j))
#define XB_XGEN(j)  (2304 + 64 * (j))
#define XB_TOP      3328
#define XB_TOPGEN   3392
#define XCD_BAR_WORDS 3456
#define XB_SPIN_CAP (1u << 18)

__device__ __forceinline__ unsigned xb_ld(unsigned* p)              { return __hip_atomic_load(p, __ATOMIC_RELAXED, __HIP_MEMORY_SCOPE_AGENT); }
__device__ __forceinline__ unsigned xb_add(unsigned* p, unsigned v) { return __hip_atomic_fetch_add(p, v, __ATOMIC_RELAXED, __HIP_MEMORY_SCOPE_AGENT); }
__device__ __forceinline__ unsigned xb_xcc_id() { return (unsigned)__builtin_amdgcn_s_getreg((3 << 11) | 20) & 0xFu; }
#define XB_SPIN(cond, bar) do { unsigned _sp = 0; while (cond) { __builtin_amdgcn_s_sleep(1); \
    if ((++_sp & 255u) == 0u) { if (xb_ld(&(bar)[XB_TMO])) break; if (_sp > XB_SPIN_CAP) { atomicAdd(&(bar)[XB_TMO], 1u); break; } } } } while (0)

struct XcdBarrier {
    unsigned* bar; unsigned x;
    volatile LAS unsigned* st;
};

__device__ __forceinline__ XcdBarrier xcd_barrier_post(unsigned* bar, volatile LAS unsigned* st) {
    XcdBarrier b; b.bar = bar; b.x = xb_xcc_id(); b.st = st;
    if (threadIdx.x == 0) (void)xb_add(&bar[XB_XCNT(b.x)], 1u);
    return b;
}
__device__ __forceinline__ void xcd_barrier_complete(unsigned* bar, unsigned x, unsigned& nloc, unsigned& nx) {
    const unsigned G = gridDim.x * gridDim.y * gridDim.z;
    unsigned sum, cnt, mine, sp = 0u;
    for (;;) {
        sum = 0u; cnt = 0u; mine = 0u;
#pragma unroll
        for (unsigned j = 0; j < 16; ++j) { const unsigned c = xb_ld(&bar[XB_XCNT(j)]); sum += c; cnt += (c > 0u) ? 1u : 0u; mine = (j == x) ? c : mine; }
        if (sum == G) break;
        __builtin_amdgcn_s_sleep(1);
        if ((++sp & 255u) == 0u) { if (xb_ld(&bar[XB_TMO])) break; if (sp > XB_SPIN_CAP) { atomicAdd(&bar[XB_TMO], 1u); break; } }
    }
    nloc = mine > 0u ? mine : 1u; nx = cnt > 0u ? cnt : 1u;
}

__device__ __forceinline__ void xcd_barrier(const XcdBarrier& b) {
    asm volatile("s_waitcnt vmcnt(0)" ::: "memory");
    __syncthreads();
    if (threadIdx.x == 0) {
        unsigned* bar = b.bar;
        __builtin_amdgcn_s_waitcnt(0);
        unsigned nloc = b.st[0], nx = b.st[1];
        if (nloc == 0u) { xcd_barrier_complete(bar, b.x, nloc, nx); b.st[0] = nloc; b.st[1] = nx; }
        const unsigned old = xb_add(&bar[XB_XSUB(b.x)], 1u);
        const unsigned gen = old / nloc;
        if (old + 1u == (gen + 1u) * nloc) {
            __builtin_amdgcn_fence(__ATOMIC_RELEASE, "agent");
            asm volatile("s_waitcnt vmcnt(0)" ::: "memory");
            const unsigned og = xb_add(&bar[XB_TOP], 1u);
            const unsigned tg = og / nx;
            if (og + 1u == (tg + 1u) * nx) xb_add(&bar[XB_TOPGEN], 1u);
            else XB_SPIN(xb_ld(&bar[XB_TOPGEN]) == tg, bar);
            __builtin_amdgcn_fence(__ATOMIC_ACQUIRE, "agent");
            xb_add(&bar[XB_XGEN(b.x)], 1u);
            asm volatile("s_waitcnt vmcnt(0)" ::: "memory");
        } else {
            XB_SPIN(xb_ld(&bar[XB_XGEN(b.x)]) == gen, bar);
            __builtin_amdgcn_fence(__ATOMIC_ACQUIRE, "agent");
            asm volatile("s_waitcnt vmcnt(0)" ::: "memory");
        }
    }
    __syncthreads();
}

struct Ctx {
    LAS unsigned char* lds;
    int tid, lane, wave, vcu, G, gw, ngw;
    const float *x, *c; const int* pos; const float *w_ada, *b_ada, *g1, *w_in, *w_a2, *b_a, *gla_g, *qg, *kg, *w_out, *g2, *w_q, *keys, *pu, *pv;
    float* out;
    unsigned* ctl; long long* MODI; float* MOD;
    bf16 *WIN, *WGA, *WOUT, *WQ, *KEYSB, *H, *CONCAT, *PROJ, *ST, *QDEC, *KDEC, *KUPD;
    unsigned char *UQ, *VQ, *HQ;
    float *CS, *KMEAN, *DEC, *BCUM, *UT, *QP, *GATE, *GU, *US, *VS, *HS; int *EXPI, *ACT;
};

__device__ __forceinline__ void transpose_item(const float* W, int ldw, int K, bf16* WT, int dst_row0, int k0, int n0, LAS float* scr, int lane) {
#pragma unroll 8
    for (int i = 0; i < 32; ++i) { const int kk = 2 * i + (lane >> 5); scr[kk * 33 + (lane & 31)] = W[(size_t)(k0 + kk) * ldw + n0 + (lane & 31)]; }
    LDS_WAIT(); asm volatile("" ::: "memory");
    const int c = lane & 7;
#pragma unroll
    for (int j = 0; j < 4; ++j) { const int n = (lane >> 3) + 8 * j; const LAS float* s = scr + (8 * c) * 33 + n;
        v4u o; o.x = pk2(s[0 * 33], s[1 * 33]); o.y = pk2(s[2 * 33], s[3 * 33]); o.z = pk2(s[4 * 33], s[5 * 33]); o.w = pk2(s[6 * 33], s[7 * 33]);
        *(v4u*)(WT + (size_t)(dst_row0 + n) * K + k0 + 8 * c) = o; }
    LDS_WAIT(); asm volatile("" ::: "memory");
}
__device__ __forceinline__ void convert_item(const float* src, bf16* dst, size_t item, int lane) {
    const f32x4* s = (const f32x4*)(src + item * 8192) + 2 * lane; v4u* d = (v4u*)(dst + item * 8192) + lane;
#pragma unroll 4
    for (int it = 0; it < 16; ++it) { const f32x4 a = s[it * 128], b = s[it * 128 + 1]; v4u o; o.x = pk2(a.x, a.y); o.y = pk2(a.z, a.w); o.z = pk2(b.x, b.y); o.w = pk2(b.z, b.w); d[it * 64] = o; }
}
__device__ __forceinline__ float wave_max(float v) {
#pragma unroll
    for (int o = 1; o < 64; o <<= 1) v = fmaxf(v, __shfl_xor(v, o));
    return v;
}
__device__ __forceinline__ void quant_store(const f32x4 (&v)[8], unsigned char* dst, float* scales, int row, size_t nrows, int lane, int bias) {
    float am = 0.f;
#pragma unroll
    for (int j = 0; j < 8; ++j) am = fmaxf(am, fmaxf(fmaxf(fabsf(v[j].x), fabsf(v[j].y)), fmaxf(fabsf(v[j].z), fabsf(v[j].w))));
    am = wave_max(am);
    const float inv = am > 0.f ? 127.f / am : 0.f;
    if (lane == 0) scales[row] = am > 0.f ? am / 127.f : 1.f;
#pragma unroll
    for (int j = 0; j < 8; ++j) { const int q0 = (int)rintf(v[j].x * inv) + bias, q1 = (int)rintf(v[j].y * inv) + bias, q2 = (int)rintf(v[j].z * inv) + bias, q3 = (int)rintf(v[j].w * inv) + bias;
        *(unsigned*)(dst + ((size_t)j * nrows + row) * 256 + 4 * lane) = (unsigned)(q0 & 0xff) | ((unsigned)(q1 & 0xff) << 8) | ((unsigned)(q2 & 0xff) << 16) | ((unsigned)(q3 & 0xff) << 24); }
}
__device__ __forceinline__ void quant_row(const float* src, unsigned char* dst, float* scales, int row, size_t nrows, int lane, int bias) {
    const f32x4* s = (const f32x4*)src + lane; f32x4 v[8];
#pragma unroll
    for (int j = 0; j < 8; ++j) v[j] = s[64 * j];
    quant_store(v, dst, scales, row, nrows, lane, bias);
}
__device__ __forceinline__ void p0_phase(const Ctx& C, int rep) {
    const int lane = C.lane, gw = C.gw, ngw = C.ngw;
    LAS float* sc = (LAS float*)C.lds;
    LAS float* part = sc + BATCH * D;
    for (int i = C.tid; i < BATCH * D; i += NTHREADS) { const float v = C.c[i]; sc[i] = v / (1.f + __expf(-v)); }
    __syncthreads();
    for (int it = C.vcu; it < 192; it += C.G) {
        const int cq = lane & 15, rg = lane >> 4, col = it * 64 + 4 * cq, r0 = 256 * C.wave + rg;
        const f32x4* w = (const f32x4*)(C.w_ada + (size_t)r0 * NMOD + col); const LAS float* s0 = sc + r0; const LAS float* s1 = sc + D + r0;
        f32x4 a0 = {0.f, 0.f, 0.f, 0.f}, a1 = a0;
#pragma unroll 16
        for (int k = 0; k < 64; ++k) { const f32x4 wv = w[(size_t)k * NMOD]; a0 += s0[4 * k] * wv; a1 += s1[4 * k] * wv; }
#pragma unroll
        for (int q = 0; q < 4; ++q) { a0[q] += __shfl_xor(a0[q], 16); a0[q] += __shfl_xor(a0[q], 32); a1[q] += __shfl_xor(a1[q], 16); a1[q] += __shfl_xor(a1[q], 32); }
        if (rg == 0) { *(LAS f32x4*)(part + (C.wave * 2 + 0) * 64 + 4 * cq) = a0; *(LAS f32x4*)(part + (C.wave * 2 + 1) * 64 + 4 * cq) = a1; }
        __syncthreads();
        if (C.tid < 128) { const int bb = C.tid >> 6, cl = C.tid & 63; float s = 0.f;
#pragma unroll
            for (int ww = 0; ww < 8; ++ww) s += part[(ww * 2 + bb) * 64 + cl];
            C.MOD[bb * NMOD + it * 64 + cl] = s + C.b_ada[it * 64 + cl]; }
        __syncthreads();
    }
    LAS float* scr = (LAS float*)(C.lds + C.wave * 16384);
    constexpr int I_IN = 32 * 192, I_SQ = 32 * 64;
    for (int it = gw; it < I_IN + 2 * I_SQ; it += ngw) {
        int r = it;
        if (r < I_IN) { const int kb = r / 192, nb = r % 192, n0 = 32 * nb; transpose_item(C.w_in, INW, D, C.WIN, n0, 64 * kb, n0 < 3072 ? n0 : n0 + 16, scr, lane); continue; } r -= I_IN;
        if (r < I_SQ) { transpose_item(C.w_out, D, D, C.WOUT, 32 * (r % 64), 64 * (r / 64), 32 * (r % 64), scr, lane); continue; } r -= I_SQ;
        transpose_item(C.w_q, D, D, C.WQ, 32 * (r % 64), 64 * (r / 64), 32 * (r % 64), scr, lane);
    }
    for (int it = gw; it < 32; it += ngw) { const int k = it * 64 + lane; const f32x4* s = (const f32x4*)(C.w_in + (size_t)k * INW + GA_SRC);
#pragma unroll
        for (int q = 0; q < 4; ++q) { const f32x4 v = s[q]; C.WGA[(4 * q + 0) * D + k] = (bf16)(pk2(v.x, 0.f) & 0xffff); C.WGA[(4 * q + 1) * D + k] = (bf16)(pk2(v.y, 0.f) & 0xffff);
            C.WGA[(4 * q + 2) * D + k] = (bf16)(pk2(v.z, 0.f) & 0xffff); C.WGA[(4 * q + 3) * D + k] = (bf16)(pk2(v.w, 0.f) & 0xffff); } }
    for (int it = gw; it < NEXP; it += ngw) {
        const f32x4* su = (const f32x4*)(C.pu + (size_t)it * D) + lane; const f32x4* sv = (const f32x4*)(C.pv + (size_t)it * D) + lane; f32x4 vu[8], vv[8];
#pragma unroll
        for (int j = 0; j < 8; ++j) { vu[j] = su[64 * j]; vv[j] = sv[64 * j]; }
        quant_store(vu, C.UQ, C.US, it, NEXP, lane, 0); quant_store(vv, C.VQ, C.VS, it, NEXP, lane, 0);
    }
    for (int it = gw; it < 32; it += ngw) convert_item(C.keys, C.KEYSB, it, lane);
    for (int idx = C.vcu * NTHREADS + C.tid; idx < T * 16; idx += C.G * NTHREADS) {
        const int t = idx >> 4, f = idx & 15; const float inv = powf(500000.0f, -(float)f * 0.0625f); const float ang = (float)C.pos[t] * inv;
        C.CS[2 * idx] = cosf(ang); C.CS[2 * idx + 1] = sinf(ang);
    }
}

__device__ __forceinline__ float modi_to_f32(long long v) { return (float)(int)(v >> 32) * 0.00390625f + (float)(unsigned)v * 9.094947017729282e-13f; }
template <bool FIRST> __device__ __forceinline__ void norm_mod_phase(const Ctx& C, const float* X, const float* g, int shift_off, int scale_off, bf16* O) {
    LAS float* lg = (LAS float*)C.lds; LAS float* lsh = lg + D; LAS float* lsc = lsh + BATCH * D;
    for (int i = C.tid; i < D; i += NTHREADS) lg[i] = g[i];
    for (int i = C.tid; i < BATCH * D; i += NTHREADS) { const int b = i / D, j = i % D;
        lsh[i] = C.MOD[b * NMOD + shift_off + j]; lsc[i] = 1.f + C.MOD[b * NMOD + scale_off + j]; }
    __syncthreads();
    for (int m = C.gw; m < T; m += C.ngw) {
        const int b = m / SEQ; const f32x4* xr = (const f32x4*)(X + (size_t)m * D) + C.lane;
        f32x4 v[8]; float ss = 0.f;
#pragma unroll
        for (int j = 0; j < 8; ++j) { v[j] = xr[64 * j]; ss += (v[j].x * v[j].x + v[j].y * v[j].y) + (v[j].z * v[j].z + v[j].w * v[j].w); }
        const float rstd = rsqrtf(wave_sum(ss) * (1.f / D) + EPS);
        const LAS f32x4* g4 = (const LAS f32x4*)lg + C.lane; const LAS f32x4* sh4 = (const LAS f32x4*)(lsh + b * D) + C.lane; const LAS f32x4* sc4 = (const LAS f32x4*)(lsc + b * D) + C.lane;
        v2u* o8 = (v2u*)(O + (size_t)m * D) + C.lane;
#pragma unroll
        for (int j = 0; j < 8; ++j) { const f32x4 y = v[j] * rstd * g4[64 * j] * sc4[64 * j] + sh4[64 * j]; v2u w; w.x = pk2(y.x, y.y); w.y = pk2(y.z, y.w); o8[64 * j] = w; v[j] = y; }
        if (!FIRST) quant_store(v, C.HQ, C.HS, m, T, C.lane, 0);
    }
    __syncthreads();
}

__device__ __forceinline__ void gla_prep_item(const Ctx& C, int b, int n, int ch) {
    const int lane = C.lane, w = C.wave, fr = lane & 15, fq = lane >> 4, rt = w & 3, kh = w >> 2; const size_t t0 = (size_t)b * SEQ + 64 * n;
    const bf16* ap = C.H + (t0 + 16 * rt + fr) * D + kh * 1024 + 8 * fq; const bf16* bp = C.WGA + fr * D + kh * 1024 + 8 * fq;
    f32x4 acc = {0.f, 0.f, 0.f, 0.f};
#pragma unroll 16
    for (int s = 0; s < 32; ++s) acc = __builtin_amdgcn_mfma_f32_16x16x32_bf16(*(const bf16x8*)(ap + 32 * s), *(const bf16x8*)(bp + 32 * s), acc, 0, 0, 0);
    LAS float* gaP = (LAS float*)C.lds;
#pragma unroll
    for (int r = 0; r < 4; ++r) gaP[kh * 1024 + (16 * rt + 4 * fq + r) * 16 + fr] = acc[r];
    __syncthreads();
    const int c = C.tid & 255, th = C.tid >> 8, col = ch * 256 + c; float wc[16];
#pragma unroll
    for (int r = 0; r < 16; ++r) wc[r] = C.w_a2[r * 512 + col];
    const float ba = C.b_a[col]; float cum = 0.f, la[32];
#pragma unroll
    for (int k = 0; k < 32; ++k) { const int tok = 32 * th + k;
        const LAS f32x4* g0 = (const LAS f32x4*)(gaP + tok * 16); const LAS f32x4* g1 = (const LAS f32x4*)(gaP + 1024 + tok * 16); float z = ba;
#pragma unroll
        for (int q = 0; q < 4; ++q) { const f32x4 gv = g0[q] + g1[q]; z += gv.x * wc[4 * q] + gv.y * wc[4 * q + 1] + gv.z * wc[4 * q + 2] + gv.w * wc[4 * q + 3]; }
        cum += (fminf(z, 0.f) - __logf(1.f + __expf(-fabsf(z)))) * 0.0625f; la[k] = cum; }
    if (th == 0) gaP[2048 + c] = cum;
    __syncthreads();
    const float base = th ? gaP[2048 + c] : 0.f;
    if (th == 1) gaP[2048 + 256 + c] = cum + base;
    __syncthreads();
    const float blast = gaP[2048 + 256 + c];
    if (th == 1) C.DEC[((size_t)(b * NH + (col >> 6)) * 64 + n) * 64 + (col & 63)] = __expf(blast);
    const bf16* qp = C.PROJ + (t0 + 32 * th) * NPROJ + GQ + col; const bf16* kp = C.PROJ + (t0 + 32 * th) * NPROJ + GK + col;
    bf16* qo = C.QDEC + (t0 + 32 * th) * 512 + col; bf16* ko = C.KDEC + (t0 + 32 * th) * 512 + col; bf16* uo = C.KUPD + (t0 + 32 * th) * 512 + col;
    unsigned short qr[32], kr[32];
#pragma unroll
    for (int k = 0; k < 32; ++k) { qr[k] = qp[(size_t)k * NPROJ]; kr[k] = kp[(size_t)k * NPROJ]; }
#pragma unroll
    for (int k = 0; k < 32; ++k) { const float bb = la[k] + base, qv = __uint_as_float((unsigned)qr[k] << 16), kv = __uint_as_float((unsigned)kr[k] << 16);
        qo[(size_t)k * 512] = (bf16)(pk2(qv * 0.125f * __expf(bb), 0.f) & 0xffffu); ko[(size_t)k * 512] = (bf16)(pk2(kv * __expf(-bb), 0.f) & 0xffffu); uo[(size_t)k * 512] = (bf16)(pk2(kv * __expf(blast - bb), 0.f) & 0xffffu); }
    __syncthreads();
}
__device__ __forceinline__ void moba_prep_item(const Ctx& C, int b, int h, int blk, int rep) {
    const int lane = C.lane, w = C.wave, i = lane & 15, tg = lane >> 4; const size_t t0 = (size_t)b * SEQ + 256 * blk;
    float qg[8], kg[8], km[8];
#pragma unroll
    for (int j = 0; j < 8; ++j) { qg[j] = C.qg[8 * i + j]; kg[j] = C.kg[8 * i + j]; km[j] = 0.f; }
    v4u rawq[8], rawk[8];
#pragma unroll
    for (int it = 0; it < 8; ++it) { const size_t tok = t0 + 32 * w + 4 * it + tg; rawq[it] = *(const v4u*)(C.PROJ + tok * NPROJ + MQ + h * 128 + 8 * i); rawk[it] = *(const v4u*)(C.PROJ + tok * NPROJ + MK + h * 128 + 8 * i); }
#pragma unroll
    for (int it = 0; it < 8; ++it) {
        const size_t tok = t0 + 32 * w + 4 * it + tg;
        float cs[16];
        if (i < 4) { const f32x4* cp = (const f32x4*)(C.CS + tok * 32 + (i & 1) * 16);
#pragma unroll
            for (int q = 0; q < 4; ++q) { const f32x4 v = cp[q]; cs[4 * q] = v.x; cs[4 * q + 1] = v.y; cs[4 * q + 2] = v.z; cs[4 * q + 3] = v.w; } }
        else {
#pragma unroll
            for (int q = 0; q < 16; ++q) cs[q] = 0.f; }
#pragma unroll
        for (int which = 0; which < 2; ++which) {
            bf16* p = C.PROJ + tok * NPROJ + (which ? MK : MQ) + h * 128 + 8 * i;
            const v4u raw = which ? rawk[it] : rawq[it]; float xv[8];
            xv[0] = bflo(raw.x); xv[1] = bfhi(raw.x); xv[2] = bflo(raw.y); xv[3] = bfhi(raw.y); xv[4] = bflo(raw.z); xv[5] = bfhi(raw.z); xv[6] = bflo(raw.w); xv[7] = bfhi(raw.w);
            float ss = 0.f;
#pragma unroll
            for (int j = 0; j < 8; ++j) ss += xv[j] * xv[j];
            ss += __shfl_xor(ss, 1); ss += __shfl_xor(ss, 2); ss += __shfl_xor(ss, 4); ss += __shfl_xor(ss, 8);
            const float rstd = rsqrtf(ss * (1.f / 128.f) + EPS);
#pragma unroll
            for (int j = 0; j < 8; ++j) xv[j] = xv[j] * rstd * (which ? kg[j] : qg[j]);
#pragma unroll
            for (int j = 0; j < 8; ++j) { const float o = __shfl_xor(xv[j], 2); const float cv = cs[2 * j], sv = cs[2 * j + 1];
                if (i < 2) xv[j] = xv[j] * cv - o * sv; else if (i < 4) xv[j] = xv[j] * cv + o * sv; }
            v4u o; o.x = pk2(xv[0], xv[1]); o.y = pk2(xv[2], xv[3]); o.z = pk2(xv[4], xv[5]); o.w = pk2(xv[6], xv[7]);
            if (rep) *(v4u*)(C.CONCAT + tok * D + which * 1024 + h * 128 + 8 * i) = o; else *(v4u*)p = o;
            if (which) {
#pragma unroll
                for (int j = 0; j < 8; ++j) km[j] += xv[j]; }
        }
    }
    LAS float* red = (LAS float*)C.lds;
#pragma unroll
    for (int j = 0; j < 8; ++j) { km[j] += __shfl_xor(km[j], 16); km[j] += __shfl_xor(km[j], 32); }
    if (lane < 16) {
#pragma unroll
        for (int j = 0; j < 8; ++j) red[w * 128 + 8 * i + j] = km[j]; }
    __syncthreads();
    if (C.tid < 128) { float s = 0.f;
#pragma unroll
        for (int ww = 0; ww < 8; ++ww) s += red[ww * 128 + C.tid];
        C.KMEAN[((size_t)(b * NH + h) * 16 + blk) * 128 + C.tid] = s * (1.f / 256.f); }
    __syncthreads();
}

constexpr int KP = 272, VP = 320;
constexpr int MB_BUF = 65536, MB_KT = 16384, MB_V0 = 32768;
__device__ __forceinline__ void moba_unit(const Ctx& C, int b, int h, int qb, int half) {
    const int lane = C.lane, w = C.wave, r = lane & 31, hh = lane >> 5, grp = w >> 2, wq = w & 3;
    const size_t tb = (size_t)b * SEQ; const int q0 = qb * 256 + 128 * half;
    const bf16* Qh = C.PROJ + MQ + h * 128; const bf16* Kh = C.PROJ + MK + h * 128; const bf16* Vh = C.PROJ + MV + h * 128;
    bf16x8 qf[8];
    { const bf16* qrow = Qh + (tb + q0 + 32 * wq + r) * NPROJ + 8 * hh;
#pragma unroll
      for (int s = 0; s < 8; ++s) qf[s] = *(const bf16x8*)(qrow + 16 * s); }
    unsigned selmask = 0u;
    { float g0 = -INFINITY, g1 = -INFINITY, g2 = -INFINITY; int i0 = -1, i1 = -1, i2 = -1;
      const float* km = C.KMEAN + ((size_t)(b * NH + h) * 16) * 128 + 8 * hh;
      for (int j = 0; j < qb; ++j) {
          float acc = 0.f;
#pragma unroll
          for (int s = 0; s < 8; ++s) { const f32x4 k0 = *(const f32x4*)(km + j * 128 + 16 * s), k1 = *(const f32x4*)(km + j * 128 + 16 * s + 4);
              acc += bf1(qf[s][0]) * k0.x + bf1(qf[s][1]) * k0.y + bf1(qf[s][2]) * k0.z + bf1(qf[s][3]) * k0.w + bf1(qf[s][4]) * k1.x + bf1(qf[s][5]) * k1.y + bf1(qf[s][6]) * k1.z + bf1(qf[s][7]) * k1.w; }
          acc += __shfl_xor(acc, 32);
          if (acc > g0) { g2 = g1; i2 = i1; g1 = g0; i1 = i0; g0 = acc; i0 = j; }
          else if (acc > g1) { g2 = g1; i2 = i1; g1 = acc; i1 = j; }
          else if (acc > g2) { g2 = acc; i2 = j; }
      }
      if (i0 >= 0) selmask |= 1u << i0; if (i1 >= 0) selmask |= 1u << i1; if (i2 >= 0) selmask |= 1u << i2; }
    asm volatile("s_waitcnt vmcnt(0)" ::: "memory");
    const int nown = 2 * half + 2, NT = nown + 4 * qb, NS = (NT + 1) >> 1;
    unsigned kso[2], vso[2];
#pragma unroll
    for (int j = 0; j < 2; ++j) { const int row = 8 * w + 4 * j + (lane >> 4), cp = lane & 15; kso[j] = (unsigned)(row * (NPROJ * 2) + 16 * (cp ^ (row & 15))); vso[j] = (unsigned)(row * (NPROJ * 2) + 16 * (cp ^ ((row & 3) << 2))); }
#define MB_KEY0(i) ((i) < nown ? qb * 256 + 64 * (i) : (((i) - nown) >> 2) * 256 + 64 * (((i) - nown) & 3))
#define MB_DMA(s, buf) do { _Pragma("unroll") for (int tl = 0; tl < 2; ++tl) { int i_ = 2 * (s) + tl; if (i_ >= NT) i_ = NT - 1; const size_t ks_ = (size_t)__builtin_amdgcn_readfirstlane((int)(MB_KEY0(i_))) * (NPROJ * 2); \
        const char* kp_ = (const char*)(Kh + tb * NPROJ) + ks_; const char* vp_ = (const char*)(Vh + tb * NPROJ) + ks_; _Pragma("unroll") for (int j = 0; j < 2; ++j) { \
            __builtin_amdgcn_global_load_lds((const unsigned*)(kp_ + kso[j]), (LAS unsigned*)(C.lds + (buf) * MB_BUF + tl * MB_KT + (2 * w + j) * 1024), 16, 0, 0); \
            __builtin_amdgcn_global_load_lds((const unsigned*)(vp_ + vso[j]), (LAS unsigned*)(C.lds + (buf) * MB_BUF + MB_V0 + tl * MB_KT + (2 * w + j) * 1024), 16, 0, 0); } } } while (0)
    MB_DMA(0, 0); __syncthreads();
    float m_run = -1e30f, l_run = 0.f; f32x16 o[4];
#pragma unroll
    for (int dt = 0; dt < 4; ++dt)
#pragma unroll
        for (int q = 0; q < 16; ++q) o[dt][q] = 0.f;
    const float c2 = 0.08838834764831845f * 1.4426950408889634f;
    const int xr = r & 15, vq = (lane & 15) >> 2;
    const int kfo = grp * MB_KT + r * 256, vfo = MB_V0 + grp * MB_KT + (4 * hh + vq) * 256 + 32 * ((lane >> 4) & 1) + 8 * (lane & 3);
    for (int s = 0; s < NS; ++s) {
        const int buf = s & 1;
        if (s + 1 < NS) MB_DMA(s + 1, buf ^ 1);
        const int i = 2 * s + grp; const bool own = i < nown; const int tt = i, blk = own ? qb : (i - nown) >> 2;
        const bool mine = own || ((selmask >> blk) & 1u);
        const bool need = i < NT && (own ? (64 * tt <= 128 * half + 32 * wq + 31) : (__ballot(mine) != 0ull));
        if (need) {
            const LAS unsigned char* kb = C.lds + buf * MB_BUF + kfo;
            bf16x8 ka[4], kc[4];
#define MB_KLOAD(dst, s2) do { _Pragma("unroll") for (int u_ = 0; u_ < 2; ++u_) { const int co_ = ((2 * (2 * (s2) + u_) + hh) ^ xr) << 4; dst[2 * u_] = *(const LAS bf16x8*)(kb + co_); dst[2 * u_ + 1] = *(const LAS bf16x8*)(kb + 32 * 256 + co_); } } while (0)
#define MB_QK(src, s2) do { _Pragma("unroll") for (int u_ = 0; u_ < 2; ++u_) { p0 = MFMA32(src[2 * u_], qf[2 * (s2) + u_], p0); p1 = MFMA32(src[2 * u_ + 1], qf[2 * (s2) + u_], p1); } } while (0)
            MB_KLOAD(ka, 0); MB_KLOAD(kc, 1); __builtin_amdgcn_sched_barrier(0);
            f32x16 p0 = {0.f, 0.f, 0.f, 0.f, 0.f, 0.f, 0.f, 0.f, 0.f, 0.f, 0.f, 0.f, 0.f, 0.f, 0.f, 0.f}, p1 = p0;
            MB_QK(ka, 0); MB_KLOAD(ka, 2); __builtin_amdgcn_sched_barrier(0);
            MB_QK(kc, 1); MB_KLOAD(kc, 3); __builtin_amdgcn_sched_barrier(0);
            MB_QK(ka, 2); MB_QK(kc, 3);
#undef MB_KLOAD
#undef MB_QK
            const LAS unsigned char* vb = C.lds + buf * MB_BUF + vfo;
            s16x4 va[8], vc[8];
#define MB_VLOAD(dst, dt) do { const LAS unsigned char* vd_ = vb + 64 * ((dt) ^ vq); _Pragma("unroll") for (int kk = 0; kk < 4; ++kk) { dst[2 * kk] = vtr(vd_ + (16 * kk) * 256); dst[2 * kk + 1] = vtr(vd_ + (16 * kk + 8) * 256); } } while (0)
#define MB_PV(src, dt) do { _Pragma("unroll") for (int kk = 0; kk < 4; ++kk) o[dt] = MFMA32(cat4(src[2 * kk], src[2 * kk + 1]), pf[kk], o[dt]); } while (0)
            MB_VLOAD(va, 0);
            __builtin_amdgcn_sched_barrier(0);
            if (own) { const int qi = 128 * half + 32 * wq + r;
#pragma unroll
                for (int q = 0; q < 16; ++q) { const int kk = 64 * tt + crow(q, hh); if (kk > qi) p0[q] = -INFINITY; if (kk + 32 > qi) p1[q] = -INFINITY; } }
            else if (!mine) {
#pragma unroll
                for (int q = 0; q < 16; ++q) { p0[q] = -INFINITY; p1[q] = -INFINITY; } }
            float mx = fmaxf(p0[0], p1[0]);
#pragma unroll
            for (int q = 1; q < 16; ++q) mx = fmaxf(mx, fmaxf(p0[q], p1[q]));
            { auto rr = __builtin_amdgcn_permlane32_swap(__float_as_uint(mx), __float_as_uint(mx), false, false); mx = fmaxf(__uint_as_float(rr[0]), __uint_as_float(rr[1])); }
            const float m_new = fmaxf(m_run, mx * c2), alpha = __builtin_amdgcn_exp2f(m_run - m_new);
            m_run = m_new; float rs = 0.f;
#pragma unroll
            for (int q = 0; q < 16; ++q) { p0[q] = __builtin_amdgcn_exp2f(p0[q] * c2 - m_new); p1[q] = __builtin_amdgcn_exp2f(p1[q] * c2 - m_new); rs += p0[q] + p1[q]; }
            l_run = l_run * alpha + rs;
            if (__ballot(alpha != 1.f) != 0ull) {
#pragma unroll
                for (int dt = 0; dt < 4; ++dt)
#pragma unroll
                    for (int q = 0; q < 16; ++q) o[dt][q] *= alpha; }
            bf16x8 pf[4];
            pf[0] = pack8(p0[0], p0[1], p0[2], p0[3], p0[4], p0[5], p0[6], p0[7]); pf[1] = pack8(p0[8], p0[9], p0[10], p0[11], p0[12], p0[13], p0[14], p0[15]);
            pf[2] = pack8(p1[0], p1[1], p1[2], p1[3], p1[4], p1[5], p1[6], p1[7]); pf[3] = pack8(p1[8], p1[9], p1[10], p1[11], p1[12], p1[13], p1[14], p1[15]);
            MB_VLOAD(vc, 1); __builtin_amdgcn_sched_barrier(0); MB_PV(va, 0); __builtin_amdgcn_sched_barrier(0);
            MB_VLOAD(va, 2); __builtin_amdgcn_sched_barrier(0); MB_PV(vc, 1); __builtin_amdgcn_sched_barrier(0);
            MB_VLOAD(vc, 3); __builtin_amdgcn_sched_barrier(0); MB_PV(va, 2); __builtin_amdgcn_sched_barrier(0);
            MB_PV(vc, 3);
#undef MB_VLOAD
#undef MB_PV
        }
        __syncthreads();
    }
#undef MB_DMA
#undef MB_KEY0
    LAS float* mo = (LAS float*)C.lds + wq * (66 * 64);
    if (grp == 1) {
#pragma unroll
        for (int dt = 0; dt < 4; ++dt)
#pragma unroll
            for (int q = 0; q < 16; ++q) mo[(16 * dt + q) * 64 + lane] = o[dt][q];
        mo[64 * 64 + lane] = m_run; mo[65 * 64 + lane] = l_run; }
    __syncthreads();
    if (grp == 0) {
        const float m1 = mo[64 * 64 + lane], l1 = mo[65 * 64 + lane], m = fmaxf(m_run, m1), a0 = __builtin_amdgcn_exp2f(m_run - m), a1 = __builtin_amdgcn_exp2f(m1 - m);
        float l = l_run * a0 + l1 * a1; l += __shfl_xor(l, 32);
        const float inv = 1.f / l, s0 = a0 * inv, s1 = a1 * inv;
        bf16* op = C.CONCAT + (tb + q0 + 32 * wq + r) * D + 1024 + h * 128 + 4 * hh;
#pragma unroll
        for (int dt = 0; dt < 4; ++dt)
#pragma unroll
            for (int k4 = 0; k4 < 4; ++k4) { float y[4];
#pragma unroll
                for (int q = 0; q < 4; ++q) y[q] = o[dt][4 * k4 + q] * s0 + mo[(16 * dt + 4 * k4 + q) * 64 + lane] * s1;
                v2u wv; wv.x = pk2(y[0], y[1]); wv.y = pk2(y[2], y[3]); *(v2u*)(op + 32 * dt + 8 * k4) = wv; }
    }
    __syncthreads();
}

constexpr int GKP = 192;
__device__ __forceinline__ void gla_v_to_lds(const Ctx& C, size_t t0, int h, int off) {
#pragma unroll
    for (int pp = 0; pp < 2; ++pp) { const int p = C.tid + 512 * pp; const v4u v = *(const v4u*)(C.PROJ + (t0 + (p >> 4)) * NPROJ + GV + h * 128 + 8 * (p & 15)); *(LAS v4u*)(C.lds + off + (p >> 4) * VP + 16 * (p & 15)) = v; }
}
__device__ __forceinline__ void gla_u_item(const Ctx& C, int b, int h, int n) {
    const int tid = C.tid, lane = C.lane, w = C.wave, r = lane & 31, hh = lane >> 5; const size_t t0 = (size_t)b * SEQ + 64 * n; const int bhn = (b * NH + h) * 64 + n;
    constexpr int KT = 0, VT = 64 * GKP;
    { const int tok = tid >> 3, ch = tid & 7; *(LAS v4u*)(C.lds + KT + tok * GKP + 16 * ch) = *(const v4u*)(C.KUPD + (t0 + tok) * 512 + h * 64 + 8 * ch); }
    gla_v_to_lds(C, t0, h, VT);
    __syncthreads();
    const int mt = w & 3, nt = w >> 2, q = (lane & 15) >> 2, cb = (16 * ((lane >> 4) & 1) + 4 * (lane & 3)) * 2;
    const LAS unsigned char* va = C.lds + VT + (4 * hh + q) * VP + cb + mt * 64; const LAS unsigned char* ka = C.lds + KT + (4 * hh + q) * GKP + cb + nt * 64;
    f32x16 acc;
#pragma unroll
    for (int i = 0; i < 16; ++i) acc[i] = 0.f;
#pragma unroll
    for (int s = 0; s < 4; ++s) acc = MFMA32(cat4(vtr(va + 16 * s * VP), vtr(va + (16 * s + 8) * VP)), cat4(vtr(ka + 16 * s * GKP), vtr(ka + (16 * s + 8) * GKP)), acc);
    float* up = C.UT + (size_t)bhn * 8192 + (32 * mt) * 64 + 32 * nt + r;
#pragma unroll
    for (int i = 0; i < 16; ++i) up[crow(i, hh) * 64] = acc[i];
    __syncthreads();
}
__device__ __forceinline__ void p4_phase(const Ctx& C, int rep) {
    volatile LAS int* qslot = (volatile LAS int*)(C.lds + MISC_OFF + 64);
    const int xcc = (int)(xb_xcc_id() & 7u); unsigned* cnt = C.ctl + CW_Q + 64 * 16 * rep;
    for (;;) {
        __syncthreads();
        if (C.tid == 0) { int res = -1;
            for (int s = 0; s < 8 && res < 0; ++s) { const int q = (xcc + s) & 7;
                if (__hip_atomic_load(cnt + 64 * q, __ATOMIC_RELAXED, __HIP_MEMORY_SCOPE_AGENT) >= 64u) continue;
                const unsigned id = atomicAdd(cnt + 64 * q, 1u); if (id < 64u) res = q * 64 + (int)id; }
            if (res < 0) { const unsigned id = atomicAdd(cnt + 64 * 8, 1u); res = id < 1024u ? 512 + (int)id : -1; }
            *qslot = res; }
        __syncthreads();
        const int id = *qslot;
        if (id < 0) break;
        if (id < 512) { const int q = id >> 6, li = id & 63, bh = 2 * q + (li & 1), rank = li >> 1; moba_unit(C, bh >> 3, bh & 7, 15 - (rank >> 1), 1 - (rank & 1)); }
        else { const int g = id - 512; gla_u_item(C, g >> 9, (g >> 6) & 7, g & 63); }
    }
}

__device__ __forceinline__ void p5_phase(const Ctx& C) {
    for (int idx = C.vcu * NTHREADS + C.tid; idx < 16 * 8192; idx += C.G * NTHREADS) {
        const int bh = idx >> 13, rem = idx & 8191, dk = rem & 63; float s = 0.f;
        const float* up = C.UT + (size_t)bh * 64 * 8192 + rem; const float* dp = C.DEC + (size_t)bh * 64 * 64 + dk; bf16* sp = C.ST + (size_t)bh * 64 * 8192 + rem;
#pragma unroll 16
        for (int n = 0; n < 64; ++n) { sp[(size_t)n * 8192] = (bf16)(pk2(s, 0.f) & 0xffffu); s = dp[n * 64] * s + up[(size_t)n * 8192]; }
    }
}

__device__ __forceinline__ void gla_out_item(const Ctx& C, int b, int h, int n) {
    const int lane = C.lane, w = C.wave, r = lane & 31, hh = lane >> 5, dvt = w & 3, lt = w >> 2; const size_t t0 = (size_t)b * SEQ + 64 * n; const int bhn = (b * NH + h) * 64 + n;
    constexpr int VT = 0, RED = 64 * VP;
    const size_t tl = t0 + 32 * lt + r;
    v4u vraw[2]; bf16x8 qd[4], kd[2][4];
#pragma unroll
    for (int pp = 0; pp < 2; ++pp) { const int p = C.tid + 512 * pp; vraw[pp] = *(const v4u*)(C.PROJ + (t0 + (p >> 4)) * NPROJ + GV + h * 128 + 8 * (p & 15)); }
#pragma unroll
    for (int s = 0; s < 4; ++s) { qd[s] = *(const bf16x8*)(C.QDEC + tl * 512 + h * 64 + 16 * s + 8 * hh); kd[1][s] = *(const bf16x8*)(C.KDEC + tl * 512 + h * 64 + 16 * s + 8 * hh);
        kd[0][s] = *(const bf16x8*)(C.KDEC + (t0 + r) * 512 + h * 64 + 16 * s + 8 * hh); }
#pragma unroll
    for (int pp = 0; pp < 2; ++pp) { const int p = C.tid + 512 * pp; *(LAS v4u*)(C.lds + VT + (p >> 4) * VP + 16 * (p & 15)) = vraw[pp]; }
    bf16x8 sfr[4]; v2u graw[4]; f32x4 gn[4];
    { const bf16* sp = C.ST + (size_t)bhn * 8192 + (32 * dvt + r) * 64 + 8 * hh;
#pragma unroll
      for (int s = 0; s < 4; ++s) sfr[s] = *(const bf16x8*)(sp + 16 * s);
#pragma unroll
      for (int k4 = 0; k4 < 4; ++k4) { const int d0 = 32 * dvt + 8 * k4 + 4 * hh; graw[k4] = *(const v2u*)(C.PROJ + tl * NPROJ + GG + h * 128 + d0); gn[k4] = *(const f32x4*)(C.gla_g + d0); } }
    __syncthreads();
    f32x16 o;
#pragma unroll
    for (int i = 0; i < 16; ++i) o[i] = 0.f;
    const LAS unsigned char* va = C.lds + VT + (4 * hh + ((lane & 15) >> 2)) * VP + (16 * ((lane >> 4) & 1) + 4 * (lane & 3)) * 2 + dvt * 64;
#pragma unroll
    for (int mt = 0; mt < 2; ++mt) {
        if (mt > lt) break;
        const bool diag = (mt == lt); f32x16 X;
#pragma unroll
        for (int i = 0; i < 16; ++i) X[i] = 0.f;
#pragma unroll
        for (int s = 0; s < 4; ++s) X = MFMA32(diag ? kd[1][s] : kd[0][s], qd[s], X);
        if (diag) {
#pragma unroll
            for (int i = 0; i < 16; ++i) if (crow(i, hh) > r) X[i] = 0.f; }
        const bf16x8 pf0 = pack8(X[0], X[1], X[2], X[3], X[4], X[5], X[6], X[7]), pf1 = pack8(X[8], X[9], X[10], X[11], X[12], X[13], X[14], X[15]);
        o = MFMA32(cat4(vtr(va + (32 * mt) * VP), vtr(va + (32 * mt + 8) * VP)), pf0, o);
        o = MFMA32(cat4(vtr(va + (32 * mt + 16) * VP), vtr(va + (32 * mt + 24) * VP)), pf1, o);
    }
#pragma unroll
    for (int s = 0; s < 4; ++s) o = MFMA32(sfr[s], qd[s], o);
    float ss = 0.f;
#pragma unroll
    for (int i = 0; i < 16; ++i) ss += o[i] * o[i];
    ss += __shfl_xor(ss, 32);
    LAS float* red = (LAS float*)(C.lds + RED);
    if (hh == 0) red[dvt * 64 + 32 * lt + r] = ss;
    __syncthreads();
    const int l = 32 * lt + r; const float rstd = rsqrtf((red[l] + red[64 + l] + red[128 + l] + red[192 + l]) * (1.f / 128.f) + EPS);
#pragma unroll
    for (int k4 = 0; k4 < 4; ++k4) { const int d0 = 32 * dvt + 8 * k4 + 4 * hh;
        const float ga = bflo(graw[k4].x), gb = bfhi(graw[k4].x), gc = bflo(graw[k4].y), gd = bfhi(graw[k4].y); const f32x4 gnv = gn[k4];
        const float y0 = o[4 * k4] * rstd * gnv.x * (ga / (1.f + __expf(-ga))), y1 = o[4 * k4 + 1] * rstd * gnv.y * (gb / (1.f + __expf(-gb)));
        const float y2 = o[4 * k4 + 2] * rstd * gnv.z * (gc / (1.f + __expf(-gc))), y3 = o[4 * k4 + 3] * rstd * gnv.w * (gd / (1.f + __expf(-gd)));
        v2u wv; wv.x = pk2(y0, y1); wv.y = pk2(y2, y3); *(v2u*)(C.CONCAT + tl * D + h * 128 + d0) = wv; }
    __syncthreads();
}

#define INS16(L, xin) do { int x_ = (xin); _Pragma("unroll") for (int i_ = 0; i_ < 16; ++i_) { const int hi_ = max(L[i_], x_); x_ = min(L[i_], x_); L[i_] = hi_; } } while (0)
#define CE_DESC(a, b) do { const int hi_ = max(a, b), lo_ = min(a, b); a = hi_; b = lo_; } while (0)
#define BITONIC_MERGE16(L) do { _Pragma("unroll") for (int j_ = 8; j_ > 0; j_ >>= 1) _Pragma("unroll") for (int i_ = 0; i_ < 16; ++i_) if ((i_ & j_) == 0) CE_DESC(L[i_], L[i_ | j_]); } while (0)
#define SORT16(L) do { _Pragma("unroll") for (int k_ = 2; k_ <= 16; k_ <<= 1) _Pragma("unroll") for (int j_ = k_ >> 1; j_ > 0; j_ >>= 1) _Pragma("unroll") for (int i_ = 0; i_ < 16; ++i_) { const int l_ = i_ ^ j_; \
        if (l_ > i_) { if ((i_ & k_) == 0) CE_DESC(L[i_], L[l_]); else CE_DESC(L[l_], L[i_]); } } } while (0)
#define MERGE16(L, M) do { _Pragma("unroll") for (int i_ = 0; i_ < 16; ++i_) L[i_] = max(L[i_], M[15 - i_]); BITONIC_MERGE16(L); } while (0)
__device__ __forceinline__ int ord_key(float v) { int u = __float_as_int(v); return u ^ ((u >> 31) & 0x7fffffff); }
__device__ __forceinline__ float ord_val(int k, int mask) { int u = k & ~mask; return __int_as_float(u ^ ((u >> 31) & 0x7fffffff)); }
__device__ __forceinline__ void peer_topk_item(const Ctx& C, int tg, int hd) {
    const int lane = C.lane, r = lane & 31, hh = lane >> 5; const size_t tok = (size_t)tg * 32 + r;
    int La[16], Lb[16];
#pragma unroll
    for (int c = 0; c < 2; ++c) {
        int L[16];
#pragma unroll
        for (int i = 0; i < 16; ++i) L[i] = (int)0x80000000;
        bf16x8 qf[8];
        { const bf16* qp = (const bf16*)C.QP + tok * D + hd * 256 + c * 128 + 8 * hh;
#pragma unroll
          for (int s = 0; s < 8; ++s) qf[s] = *(const bf16x8*)(qp + 16 * s); }
        int G[16];
        bf16x8 kfA[8], kfB[8];
#define PT_KLOAD(dst, kt) do { const bf16* kp_ = C.KEYSB + ((size_t)(hd * 2 + c) * 128 + 32 * (kt) + r) * 128 + 8 * hh; _Pragma("unroll") for (int s = 0; s < 8; ++s) dst[s] = *(const bf16x8*)(kp_ + 16 * s); } while (0)
#define PT_TILE(src, kt) do { f32x16 X; _Pragma("unroll") for (int i = 0; i < 16; ++i) X[i] = 0.f; _Pragma("unroll") for (int s = 0; s < 8; ++s) X = MFMA32(src[s], qf[s], X); \
            _Pragma("unroll") for (int i = 0; i < 16; ++i) G[i] = (ord_key(X[i]) & ~127) | (32 * (kt) + crow(i, hh)); SORT16(G); MERGE16(L, G); } while (0)
        PT_KLOAD(kfA, 0);
#pragma unroll 1
        for (int k2 = 0; k2 < 2; ++k2) {
            PT_KLOAD(kfB, 2 * k2 + 1);
            PT_TILE(kfA, 2 * k2);
            if (k2 == 0) PT_KLOAD(kfA, 2);
            PT_TILE(kfB, 2 * k2 + 1);
        }
#undef PT_KLOAD
#undef PT_TILE
        int M[16];
#pragma unroll
        for (int i = 0; i < 16; ++i) M[i] = __shfl_xor(L[i], 32);
        MERGE16(L, M);
#pragma unroll
        for (int i = 0; i < 16; ++i) { if (c == 0) La[i] = L[i]; else Lb[i] = L[i]; }
    }
    float sa[16], sb[16]; int Lc[16];
#pragma unroll
    for (int i = 0; i < 16; ++i) { sa[i] = ord_val(La[i], 127); sb[i] = ord_val(Lb[i], 127); Lc[i] = (int)0x80000000; }
#pragma unroll
    for (int i = 0; i < 16; ++i)
#pragma unroll
        for (int j = 0; j < 16; ++j) if ((i + 1) * (j + 1) <= 16) INS16(Lc, (ord_key(sa[i] + sb[j]) & ~255) | (i * 16 + j));
    float e[16], sum = 0.f; int ex[16]; const float mx = ord_val(Lc[0], 255);
#pragma unroll
    for (int i = 0; i < 16; ++i) {
        e[i] = __expf(ord_val(Lc[i], 255) - mx); sum += e[i];
        const int ii = (Lc[i] >> 4) & 15, jj = Lc[i] & 15; int i1 = 0, i2 = 0;
#pragma unroll
        for (int q = 0; q < 16; ++q) { i1 = (ii == q) ? (La[q] & 127) : i1; i2 = (jj == q) ? (Lb[q] & 127) : i2; }
        ex[i] = i1 * 128 + i2;
    }
    const float inv = 1.f / sum;
    if (hh == 0) {
        v4u* ep = (v4u*)(C.EXPI + tok * 128 + hd * 16); f32x4* gp = (f32x4*)(C.GATE + tok * 128 + hd * 16); f32x4* up = (f32x4*)(C.GU + tok * 128 + hd * 16); v4u* ap = (v4u*)(C.ACT + tok * 128 + hd * 16);
        const float hs = C.HS[tok];
#pragma unroll
        for (int q = 0; q < 4; ++q) { ep[q] = (v4u){(unsigned)ex[4 * q], (unsigned)ex[4 * q + 1], (unsigned)ex[4 * q + 2], (unsigned)ex[4 * q + 3]};
            gp[q] = (f32x4){e[4 * q] * inv * C.VS[ex[4 * q]], e[4 * q + 1] * inv * C.VS[ex[4 * q + 1]], e[4 * q + 2] * inv * C.VS[ex[4 * q + 2]], e[4 * q + 3] * inv * C.VS[ex[4 * q + 3]]};
            up[q] = (f32x4){hs * C.US[ex[4 * q]], hs * C.US[ex[4 * q + 1]], hs * C.US[ex[4 * q + 2]], hs * C.US[ex[4 * q + 3]]};
            ap[q] = (v4u){0u, 0u, 0u, 0u}; }
    }
}

__device__ __forceinline__ int peer_dequeue(const Ctx& C, unsigned* cnt, int xcc) {
    volatile LAS int* slot = (volatile LAS int*)(C.lds + MISC_OFF + 64);
    __syncthreads();
    if (C.tid == 0) { int res = -1;
        for (int s = 0; s < NSL; ++s) { const int sl = (xcc + s) & (NSL - 1);
            if (__hip_atomic_load(cnt + 64 * sl, __ATOMIC_RELAXED, __HIP_MEMORY_SCOPE_AGENT) >= (unsigned)NCHUNK) continue;
            const unsigned id = atomicAdd(cnt + 64 * sl, 1u); if (id < (unsigned)NCHUNK) { res = sl * NCHUNK + (int)id; break; } }
        *slot = res; }
    __syncthreads();
    return *slot;
}
#define ROWSUM16(d) do { d += __builtin_amdgcn_update_dpp(0, d, 0x121, 0xf, 0xf, false); d += __builtin_amdgcn_update_dpp(0, d, 0x122, 0xf, 0xf, false); \
                         d += __builtin_amdgcn_update_dpp(0, d, 0x124, 0xf, 0xf, false); d += __builtin_amdgcn_update_dpp(0, d, 0x128, 0xf, 0xf, false); } while (0)
#define PA_ISSUE1(buf, esrc, j_) buf[j_] = *(const v4u*)(tab + (size_t)__builtin_amdgcn_ds_swizzle(esrc, ((j_) << 5) | 0x10) * SLW)
#define PA_ISSUE(buf, esrc) do { PA_ISSUE1(buf, esrc, 0); PA_ISSUE1(buf, esrc, 1); PA_ISSUE1(buf, esrc, 2); PA_ISSUE1(buf, esrc, 3); PA_ISSUE1(buf, esrc, 4); PA_ISSUE1(buf, esrc, 5); PA_ISSUE1(buf, esrc, 6); PA_ISSUE1(buf, esrc, 7); \
        PA_ISSUE1(buf, esrc, 8); PA_ISSUE1(buf, esrc, 9); PA_ISSUE1(buf, esrc, 10); PA_ISSUE1(buf, esrc, 11); PA_ISSUE1(buf, esrc, 12); PA_ISSUE1(buf, esrc, 13); PA_ISSUE1(buf, esrc, 14); PA_ISSUE1(buf, esrc, 15); } while (0)
#define PA_COMPUTE(buf, hq_, dstv) do { _Pragma("unroll") for (int j_ = 0; j_ < 16; ++j_) { const v4u u_ = buf[j_]; \
        int d_ = __builtin_amdgcn_sdot4((int)hq_.x, (int)u_.x, 0, false); d_ = __builtin_amdgcn_sdot4((int)hq_.y, (int)u_.y, d_, false); d_ = __builtin_amdgcn_sdot4((int)hq_.z, (int)u_.z, d_, false); d_ = __builtin_amdgcn_sdot4((int)hq_.w, (int)u_.w, d_, false); \
        ROWSUM16(d_); dstv = (i == j_) ? d_ : dstv; } } while (0)
__device__ __forceinline__ void peer_a_chunk(const Ctx& C, int t0, int x, int* act) {
    const int lane = C.lane, i = lane & 15;
    v4u hq[8]; int el[8], eh[8];
#pragma unroll
    for (int tt = 0; tt < 8; ++tt) { hq[tt] = __builtin_nontemporal_load((const v4u*)(C.HQ + ((size_t)x * T + t0 + tt) * SLW + 16 * i)); el[tt] = __builtin_nontemporal_load(C.EXPI + (size_t)(t0 + tt) * 128 + lane); eh[tt] = __builtin_nontemporal_load(C.EXPI + (size_t)(t0 + tt) * 128 + 64 + lane); }
    const unsigned char* tab = C.UQ + (size_t)x * NEXP * SLW + 16 * i;
    v4u bA[16], bB[16];
    PA_ISSUE(bA, el[0]);
#pragma unroll
    for (int tt = 0; tt < 8; ++tt) {
        PA_ISSUE(bB, eh[tt]);
        int r_lo = 0, r_hi = 0;
        PA_COMPUTE(bA, hq[tt], r_lo);
        if (tt + 1 < 8) PA_ISSUE(bA, el[tt + 1]);
        PA_COMPUTE(bB, hq[tt], r_hi);
        atomicAdd(act + (size_t)(t0 + tt) * 128 + lane, r_lo); atomicAdd(act + (size_t)(t0 + tt) * 128 + 64 + lane, r_hi);
    }
}
#undef PA_ISSUE
#undef PA_ISSUE1
#undef PA_COMPUTE
#define PB_ISSUE(buf, esrc) do { _Pragma("unroll") for (int j_ = 0; j_ < 16; ++j_) { const int e_ = __builtin_amdgcn_ds_bpermute(4 * (16 * (j_ >> 2) + 4 * g + (j_ & 3)), esrc); buf[j_] = *(const v4u*)(tab + (size_t)e_ * SLW); } } while (0)
#define PB_TR4(r0_, r1_, r2_, r3_, wp_, base) do { const unsigned t0_ = __builtin_amdgcn_perm(r1_, r0_, 0x05010400u), t1_ = __builtin_amdgcn_perm(r1_, r0_, 0x07030602u), t2_ = __builtin_amdgcn_perm(r3_, r2_, 0x05010400u), t3_ = __builtin_amdgcn_perm(r3_, r2_, 0x07030602u); \
        c[(base)] = __builtin_amdgcn_sdot4((int)__builtin_amdgcn_perm(t2_, t0_, 0x05040100u), wp_, c[(base)], false); c[(base) + 1] = __builtin_amdgcn_sdot4((int)__builtin_amdgcn_perm(t2_, t0_, 0x07060302u), wp_, c[(base) + 1], false); \
        c[(base) + 2] = __builtin_amdgcn_sdot4((int)__builtin_amdgcn_perm(t3_, t1_, 0x05040100u), wp_, c[(base) + 2], false); c[(base) + 3] = __builtin_amdgcn_sdot4((int)__builtin_amdgcn_perm(t3_, t1_, 0x07060302u), wp_, c[(base) + 3], false); } while (0)
#define PB_COMPUTE(buf, psrc) do { _Pragma("unroll") for (int jb_ = 0; jb_ < 4; ++jb_) { const int wp_ = __builtin_amdgcn_ds_bpermute(4 * (16 * jb_ + 4 * g), (int)psrc); \
        PB_TR4(buf[4 * jb_].x, buf[4 * jb_ + 1].x, buf[4 * jb_ + 2].x, buf[4 * jb_ + 3].x, wp_, 0); PB_TR4(buf[4 * jb_].y, buf[4 * jb_ + 1].y, buf[4 * jb_ + 2].y, buf[4 * jb_ + 3].y, wp_, 4); \
        PB_TR4(buf[4 * jb_].z, buf[4 * jb_ + 1].z, buf[4 * jb_ + 2].z, buf[4 * jb_ + 3].z, wp_, 8); PB_TR4(buf[4 * jb_].w, buf[4 * jb_ + 1].w, buf[4 * jb_ + 2].w, buf[4 * jb_ + 3].w, wp_, 12); } } while (0)
__device__ __forceinline__ int isum_swap16(int v) { auto r = __builtin_amdgcn_permlane16_swap((unsigned)v, (unsigned)v, false, false); return (int)r[0] + (int)r[1]; }
__device__ __forceinline__ int isum_swap32(int v) { auto r = __builtin_amdgcn_permlane32_swap((unsigned)v, (unsigned)v, false, false); return (int)r[0] + (int)r[1]; }
__device__ __forceinline__ void peer_b_chunk(const Ctx& C, int t0, int x, float* dst) {
    const int lane = C.lane, i = lane & 15, g = lane >> 4, b = t0 / SEQ;
    int el[8], eh[8]; unsigned pl[8], ph[8]; float ws[8];
#pragma unroll
    for (int tt = 0; tt < 8; ++tt) { const size_t o = (size_t)(t0 + tt) * 128 + lane;
        el[tt] = __builtin_nontemporal_load(C.EXPI + o); eh[tt] = __builtin_nontemporal_load(C.EXPI + o + 64);
        const float a_lo = (float)__builtin_nontemporal_load(C.ACT + o) * __builtin_nontemporal_load(C.GU + o), a_hi = (float)__builtin_nontemporal_load(C.ACT + o + 64) * __builtin_nontemporal_load(C.GU + o + 64);
        const float w_lo = __builtin_nontemporal_load(C.GATE + o) * 0.5f * a_lo * (1.f + erff(a_lo * 0.70710678118654752f)), w_hi = __builtin_nontemporal_load(C.GATE + o + 64) * 0.5f * a_hi * (1.f + erff(a_hi * 0.70710678118654752f));
        const float wm = wave_max(fmaxf(fabsf(w_lo), fabsf(w_hi))), winv = wm > 0.f ? 127.f / wm : 0.f; ws[tt] = wm * (1.f / 127.f);
        unsigned p_lo = (unsigned)((int)rintf(w_lo * winv) & 0xff), p_hi = (unsigned)((int)rintf(w_hi * winv) & 0xff);
        p_lo |= (unsigned)__builtin_amdgcn_update_dpp(0, (int)p_lo, 0xB1, 0xf, 0xf, false) << 8; p_lo |= (unsigned)__builtin_amdgcn_update_dpp(0, (int)p_lo, 0x4E, 0xf, 0xf, false) << 16;
        p_hi |= (unsigned)__builtin_amdgcn_update_dpp(0, (int)p_hi, 0xB1, 0xf, 0xf, false) << 8; p_hi |= (unsigned)__builtin_amdgcn_update_dpp(0, (int)p_hi, 0x4E, 0xf, 0xf, false) << 16;
        pl[tt] = p_lo; ph[tt] = p_hi; }
    const unsigned char* tab = C.VQ + (size_t)x * NEXP * SLW + 16 * i;
    const int d0 = x * SLW + 16 * i + 4 * g; const f32x4 gm = *(const f32x4*)(C.MOD + b * NMOD + 5 * D + d0);
    v4u bA[16], bB[16];
    PB_ISSUE(bA, el[0]);
#pragma unroll
    for (int tt = 0; tt < 8; ++tt) {
        PB_ISSUE(bB, eh[tt]);
        const size_t off = (size_t)(t0 + tt) * D + d0; const f32x4 x1 = __builtin_nontemporal_load((const f32x4*)(C.out + off));
        int c[16];
#pragma unroll
        for (int q = 0; q < 16; ++q) c[q] = 0;
        PB_COMPUTE(bA, pl[tt]);
        if (tt + 1 < 8) PB_ISSUE(bA, el[tt + 1]);
        PB_COMPUTE(bB, ph[tt]);
#pragma unroll
        for (int q = 0; q < 16; ++q) c[q] = isum_swap32(isum_swap16(c[q]));
        f32x4 o;
#pragma unroll
        for (int q = 0; q < 4; ++q) o[q] = (float)(g == 0 ? c[q] : g == 1 ? c[4 + q] : g == 2 ? c[8 + q] : c[12 + q]) * ws[tt];
        __builtin_nontemporal_store(x1 + gm * o, (f32x4*)(dst + off));
    }
}
#undef PB_ISSUE
#undef PB_COMPUTE
#undef PB_TR4
template <int STAGE> __device__ __forceinline__ void peer_expert_phase(const Ctx& C, float* dst, int rep) {
    const int xcc = (int)(xb_xcc_id() & (NSL - 1)); unsigned* cnt = C.ctl + (STAGE == 0 ? CW_QA : CW_QB) + 64 * NSL * rep;
    for (;;) {
        const int id = peer_dequeue(C, cnt, xcc); if (id < 0) break;
        const int x = id / NCHUNK, t0 = (id % NCHUNK) * PCH + C.wave * (PCH / NWAVES);
        if (STAGE == 0) peer_a_chunk(C, t0, x, rep ? (int*)C.QP : C.ACT); else peer_b_chunk(C, t0, x, dst);
    }
}

struct Args { const void* in[18]; float* out; unsigned char* ws; int ph_lo, ph_hi; };
__global__ void __launch_bounds__(NTHREADS, 2) fwd_kernel(Args args) {
    extern __shared__ __attribute__((aligned(16))) unsigned char lds[];
    Ctx C;
    C.lds = (LAS unsigned char*)lds; C.tid = threadIdx.x; C.lane = C.tid & 63; C.wave = __builtin_amdgcn_readfirstlane(C.tid >> 6);
    C.G = gridDim.x; { const int bx = blockIdx.x; C.vcu = (C.G % 8 == 0) ? (bx % 8) * (C.G / 8) + bx / 8 : bx; }
    C.gw = C.vcu * NWAVES + C.wave; C.ngw = C.G * NWAVES;
    C.x = (const float*)args.in[0]; C.c = (const float*)args.in[1]; C.pos = (const int*)args.in[2]; C.w_ada = (const float*)args.in[3]; C.b_ada = (const float*)args.in[4]; C.g1 = (const float*)args.in[5];
    C.w_in = (const float*)args.in[6]; C.w_a2 = (const float*)args.in[7]; C.b_a = (const float*)args.in[8]; C.gla_g = (const float*)args.in[9]; C.qg = (const float*)args.in[10]; C.kg = (const float*)args.in[11];
    C.w_out = (const float*)args.in[12]; C.g2 = (const float*)args.in[13]; C.w_q = (const float*)args.in[14]; C.keys = (const float*)args.in[15]; C.pu = (const float*)args.in[16]; C.pv = (const float*)args.in[17];
    C.out = args.out; unsigned char* ws = args.ws;
    C.ctl = (unsigned*)(ws + WS_CTL); C.MODI = (long long*)(C.ctl + CW_MOD); C.MOD = (float*)(ws + WS_MODF);
    C.WIN = (bf16*)(ws + WS_WIN); C.WGA = (bf16*)(ws + WS_WGA); C.WOUT = (bf16*)(ws + WS_WOUT); C.WQ = (bf16*)(ws + WS_WQ); C.KEYSB = (bf16*)(ws + WS_KEYS); C.UQ = ws + WS_UB; C.VQ = ws + WS_VB; C.HQ = ws + WS_HQ; C.US = (float*)(ws + WS_US); C.VS = (float*)(ws + WS_VS); C.HS = (float*)(ws + WS_HS); C.GU = (float*)(ws + WS_GU); C.ACT = (int*)(ws + WS_ACT);
    C.QDEC = (bf16*)(ws + WS_QDEC); C.KDEC = (bf16*)(ws + WS_KDEC); C.KUPD = (bf16*)(ws + WS_KUPD); C.H = (bf16*)(ws + WS_H); C.CONCAT = (bf16*)(ws + WS_CONCAT); C.PROJ = (bf16*)(ws + WS_PROJ); C.ST = (bf16*)(ws + WS_ST);
    C.CS = (float*)(ws + WS_CS); C.KMEAN = (float*)(ws + WS_KMEAN); C.DEC = (float*)(ws + WS_DEC); C.BCUM = (float*)(ws + WS_BCUM); C.UT = (float*)(ws + WS_UT); C.QP = (float*)(ws + WS_QP); C.GATE = (float*)(ws + WS_GATE); C.EXPI = (int*)(ws + WS_EXP);
    for (int u = C.tid; u < (LDS_BYTES - RING_BYTES) / 4; u += NTHREADS) ((LAS unsigned*)(C.lds + RING_BYTES))[u] = 0u;
    __syncthreads();
    const int lo = args.ph_lo, hi = args.ph_hi;
    XcdBarrier bar; bar.bar = C.ctl + CW_BAR; bar.x = 0; bar.st = nullptr;
    if (hi - lo > 1) bar = xcd_barrier_post(C.ctl + CW_BAR, (volatile LAS unsigned*)(C.lds + MISC_OFF) + 8);
#ifndef SKIPMASK
#define SKIPMASK 0
#endif
#ifndef REPEATMASK
#define REPEATMASK 0
#endif
#define IN(k) (!((SKIPMASK >> (k)) & 1) && lo <= (k) && (k) < hi)
#define REP(k, ...) do { if ((REPEATMASK >> (k)) & 1) { const int rep_ = 1; (void)rep_; __VA_ARGS__; xcd_barrier(bar); } { const int rep_ = 0; (void)rep_; __VA_ARGS__; } } while (0)
#define SEAM(k) do { if (IN(k) && IN((k) + 1)) xcd_barrier(bar); { int t_ = C.tid; asm volatile("" : "+v"(t_)); C.tid = t_; C.lane = t_ & 63; } } while (0)
    if (IN(0)) REP(0, p0_phase(C, rep_)); SEAM(0);
    if (IN(1)) REP(1, norm_mod_phase<true>(C, C.x, C.g1, 0, D, C.H)); SEAM(1);
    if (IN(2)) REP(2, pg8::Gemm g{C.H, C.WIN, T, NPROJ, D}; pg8::StaticOrder S; S.init(T, NPROJ, C.G, (int)blockIdx.x); pg8::EpiBf16<0> E{C.PROJ, NPROJ, nullptr, 0, 0, 1.f};
                 pg8::gemm_phase<pg8::EpiBf16<0>, pg8::StaticOrder, PG8_ALIGN, PG8_SP2>(C.lds, g, S, E)); SEAM(2);
    if (IN(3)) REP(3, for (int it = C.vcu; it < 256 + 256; it += C.G) { if (it < 256) moba_prep_item(C, it >> 7, (it >> 4) & 7, it & 15, rep_); else gla_prep_item(C, (it - 256) >> 7, ((it - 256) >> 1) & 63, it & 1); }); SEAM(3);
    if (IN(4)) REP(4, p4_phase(C, rep_)); SEAM(4);
    if (IN(5)) REP(5, p5_phase(C)); SEAM(5);
    if (IN(6)) REP(6, for (int it = C.vcu; it < 1024; it += C.G) gla_out_item(C, it >> 9, (it >> 6) & 7, it & 63)); SEAM(6);
    if (IN(7)) REP(7, pg8::Gemm g{C.CONCAT, C.WOUT, T, D, D}; pg8::StaticOrder S; S.init(T, D, C.G, (int)blockIdx.x); pg8::EpiResGate E{C.x, C.out, D, C.MOD + 2 * D, NMOD, SEQ / 256};
                 pg8::gemm_phase<pg8::EpiResGate, pg8::StaticOrder, PG8_ALIGN, PG8_SP2>(C.lds, g, S, E)); SEAM(7);
    if (IN(8)) REP(8, norm_mod_phase<false>(C, C.out, C.g2, 3 * D, 4 * D, C.H)); SEAM(8);
    if (IN(9)) REP(9, pg8::Gemm g{C.H, C.WQ, T, D, D}; pg8::StaticOrder S; S.init(T, D, C.G, (int)blockIdx.x); pg8::EpiBf16<0> E{(bf16*)C.QP, D, nullptr, 0, 0, 1.f};
                 pg8::gemm_phase<pg8::EpiBf16<0>, pg8::StaticOrder, PG8_ALIGN, PG8_SP2>(C.lds, g, S, E)); SEAM(9);
    if (IN(10)) REP(10, for (int it = C.gw; it < 256 * 8; it += C.ngw) peer_topk_item(C, it >> 3, it & 7)); SEAM(10);
    if (IN(11)) REP(11, peer_expert_phase<0>(C, nullptr, rep_)); SEAM(11);
    if (IN(12)) REP(12, peer_expert_phase<1>(C, rep_ ? C.QP : C.out, rep_));
#undef IN
#undef SEAM
}

extern "C" void kernel_launch(void* const* d_in, const int* in_sizes, int n_in, void* d_out, int out_size, void* d_ws, size_t ws_size, hipStream_t stream) {
    static int grid = 0;
    if (grid == 0) {
        if (n_in != 18 || in_sizes[0] != T * D || out_size != T * D || ws_size < WS_END) { fprintf(stderr, "kernel_launch: shape/workspace mismatch (n_in %d, in0 %d, out %d, ws %zu, need %zu); nothing launched\n", n_in, n_in > 0 ? in_sizes[0] : -1, out_size, ws_size, (size_t)WS_END); grid = -1; return; }
        int dev = 0, cus = 0, per_cu = 0;
        if (hipGetDevice(&dev) != hipSuccess || hipDeviceGetAttribute(&cus, hipDeviceAttributeMultiprocessorCount, dev) != hipSuccess) { fprintf(stderr, "kernel_launch: device query failed\n"); grid = -1; return; }
        if (hipFuncSetAttribute((const void*)fwd_kernel, hipFuncAttributeMaxDynamicSharedMemorySize, LDS_BYTES) != hipSuccess) { fprintf(stderr, "kernel_launch: hipFuncSetAttribute failed\n"); grid = -1; return; }
        if (hipOccupancyMaxActiveBlocksPerMultiprocessor(&per_cu, (const void*)fwd_kernel, NTHREADS, LDS_BYTES) != hipSuccess || per_cu < 1) { fprintf(stderr, "kernel_launch: occupancy query reports %d workgroups per CU\n", per_cu); (void)hipGetLastError(); grid = -1; return; }
        grid = cus;
    }
    if (grid < 0) return;
    if (hipMemsetAsync((char*)d_ws + WS_CTL, 0, CTL_ZERO_BYTES, stream) != hipSuccess) { fprintf(stderr, "kernel_launch: memset failed\n"); return; }
    Args a{};
    for (int i = 0; i < 18; ++i) a.in[i] = d_in[i];
    a.out = (float*)d_out; a.ws = (unsigned char*)d_ws;
#if MK_N_LAUNCHES == 1
    a.ph_lo = 0; a.ph_hi = N_PHASES;
    void* kargs[] = {&a};
    hipError_t le = hipLaunchCooperativeKernel((const void*)fwd_kernel, dim3(grid), dim3(NTHREADS), kargs, LDS_BYTES, stream);
    if (le != hipSuccess) fprintf(stderr, "kernel_launch: cooperative launch failed: %s (grid %d)\n", hipGetErrorName(le), grid);
#else
    for (int p = 0; p < N_PHASES; ++p) { a.ph_lo = p; a.ph_hi = p + 1; hipLaunchKernelGGL(fwd_kernel, dim3(grid), dim3(NTHREADS), LDS_BYTES, stream, a); }
#endif
}
```

```cpp
#define REPEATMASK 0
#include <hip/hip_runtime.h>
#include <hip/hip_bf16.h>
#include <cstdio>
#include <cstdint>
#include <cmath>
namespace pg8 {
#define PG8_LAS __attribute__((address_space(3)))
typedef unsigned short bf16_t;
typedef short bf16x8 __attribute__((ext_vector_type(8)));
typedef float f32x4 __attribute__((ext_vector_type(4)));
typedef unsigned u32x4 __attribute__((ext_vector_type(4)));
constexpr int BM = 256, BK = 64, HALF = 128, HTB = HALF * BK * 2  , STAGE_BYTES = 8 * HTB, NXCD = 8, WGM = 8;

__host__ __device__ __forceinline__ int lds_byte(int r, int c) { const int st = (r >> 4) * 2 + (c >> 5), rr = r & 15, cc = c & 31, ob = rr * 64 + cc * 2; return st * 1024 + (ob ^ (((ob >> 9) & 1) << 5)); }
__host__ __device__ __forceinline__ void stage_rc(int b, int& R, int& C) { const int st = b / 1024, sb = b % 1024, swz = sb ^ (((sb >> 9) & 1) << 5); R = (st >> 1) * 16 + swz / 64; C = (st & 1) * 32 + (swz % 64) / 2; }
__host__ __device__ __forceinline__ int perm32(int rho) { const int n = rho >> 4, i = rho & 15; return 8 * (i >> 2) + 4 * n + (i & 3); }

struct Unit { int pm, pn; };
struct Gemm { const bf16_t* A; const bf16_t* Bt; int M, N, K; };

struct StaticOrder {
    int nM, nN, nwg, G, c;
    __host__ __device__ void init(int M, int N, int G_, int c_) { nM = M / BM; nN = N / BM; nwg = nM * nN; G = G_; c = c_; }
    __host__ __device__ bool next(int i, Unit& u) const {
        const long L = (long)i * G + c; if (L >= nwg) return false;
        int wgid = (int)L; { const int q = nwg / NXCD, r = nwg % NXCD, xcd = wgid % NXCD, off = wgid / NXCD; wgid = (xcd < r ? xcd * (q + 1) : r * (q + 1) + (xcd - r) * q) + off; }
        const int nig = WGM * nN, gid = wgid / nig, fm = gid * WGM, gsz = (nM - fm) < WGM ? (nM - fm) : WGM;
        u.pm = fm + ((wgid % nig) % gsz); u.pn = (wgid % nig) / gsz; return true;
    }
    __device__ __forceinline__ void a_ready(const Unit&) const {}
    __device__ __forceinline__ void done(const Unit&) const {}
};

__device__ __forceinline__ unsigned cvt_pk_bf16(float lo, float hi) { unsigned r; asm volatile("v_cvt_pk_bf16_f32 %0, %1, %2" : "=v"(r) : "v"(lo), "v"(hi)); return r; }
typedef float f32x2 __attribute__((ext_vector_type(2)));
__device__ __forceinline__ f32x2 gelu_pk(f32x2 v) {
    const f32x2 av = __builtin_elementwise_abs(v), d = av * 0.2316418882f + 1.0f;
    f32x2 t; t.x = __builtin_amdgcn_rcpf(d.x); t.y = __builtin_amdgcn_rcpf(d.y);
    f32x2 q = t * 0.5307027145f + (-0.7265760135f); q = q * t + 0.7107068705f; q = q * t + (-0.142248368f); q = q * t + 0.127414796f; q = q * t;
    const f32x2 s = (v * v) * (-0.72134752044f);
    f32x2 e; e.x = __builtin_amdgcn_exp2f(s.x); e.y = __builtin_amdgcn_exp2f(s.y);
    const f32x2 m = v * (q * e), r = v - m;
    f32x2 o; o.x = v.x < 0.f ? m.x : r.x; o.y = v.y < 0.f ? m.y : r.y; return o;
}

template <int ACT  > struct EpiBf16 {
    static constexpr bool PERM = true, AFTER_DRAIN = false; static_assert(ACT == 0 || ACT == 1, "EpiBf16: ACT is 0 (none) or 1 (gelu_pk)");
    bf16_t* O; int ldc; const float* bias; int split_cols; size_t split_stride; float scale0;
    __device__ __forceinline__ void operator()(const f32x4 (&acc)[2][2][4][2], const Unit& u, int wr, int wc, int fr, int fq) const {
        const int row0 = u.pm * BM + wr * 64 + fr; int colt = u.pn * BM; bf16_t* base = O;
        float sc = 1.f; if (split_cols) { const int t = colt / split_cols; base += (size_t)t * split_stride; colt -= t * split_cols; if (t == 0) sc = scale0; }
        const int col0 = colt + wc * 32 + 8 * fq, bcol0 = u.pn * BM + wc * 32 + 8 * fq;
        f32x4 bv[2][2];
#pragma unroll
        for (int bj = 0; bj < 2; ++bj)
#pragma unroll
            for (int n = 0; n < 2; ++n) bv[bj][n] = bias ? *(const f32x4*)(bias + bcol0 + bj * HALF + 4 * n) : (f32x4){0.f, 0.f, 0.f, 0.f};
#pragma unroll
        for (int ai = 0; ai < 2; ++ai)
#pragma unroll
            for (int m = 0; m < 4; ++m) { bf16_t* rowp = base + (size_t)(row0 + ai * HALF + m * 16) * ldc + col0;
#pragma unroll
                for (int bj = 0; bj < 2; ++bj) { f32x4 v0 = acc[ai][bj][m][0] + bv[bj][0], v1 = acc[ai][bj][m][1] + bv[bj][1];
                    if (ACT == 1) { f32x2 a = gelu_pk((f32x2){v0[0], v0[1]}), b = gelu_pk((f32x2){v0[2], v0[3]}), c = gelu_pk((f32x2){v1[0], v1[1]}), d = gelu_pk((f32x2){v1[2], v1[3]});
                        v0 = (f32x4){a.x, a.y, b.x, b.y}; v1 = (f32x4){c.x, c.y, d.x, d.y}; }
                    v0 = v0 * sc; v1 = v1 * sc; u32x4 w; w.x = cvt_pk_bf16(v0[0], v0[1]); w.y = cvt_pk_bf16(v0[2], v0[3]); w.z = cvt_pk_bf16(v1[0], v1[1]); w.w = cvt_pk_bf16(v1[2], v1[3]);
                    *(u32x4*)(rowp + bj * HALF) = w; } }
    }
};
struct EpiF32 {
    static constexpr bool PERM = false, AFTER_DRAIN = false;
    float* C; int ldc; const float* bias;
    __device__ __forceinline__ void operator()(const f32x4 (&acc)[2][2][4][2], const Unit& u, int wr, int wc, int fr, int fq) const {
        const int row0 = u.pm * BM + wr * 64 + fr, col0 = u.pn * BM + wc * 32 + 4 * fq;
        f32x4 bv[2][2];
#pragma unroll
        for (int bj = 0; bj < 2; ++bj)
#pragma unroll
            for (int n = 0; n < 2; ++n) bv[bj][n] = bias ? *(const f32x4*)(bias + col0 + bj * HALF + n * 16) : (f32x4){0.f, 0.f, 0.f, 0.f};
#pragma unroll
        for (int ai = 0; ai < 2; ++ai)
#pragma unroll
            for (int m = 0; m < 4; ++m) { float* rowp = C + (size_t)(row0 + ai * HALF + m * 16) * ldc + col0;
#pragma unroll
                for (int bj = 0; bj < 2; ++bj)
#pragma unroll
                    for (int n = 0; n < 2; ++n) *(f32x4*)(rowp + bj * HALF + n * 16) = acc[ai][bj][m][n] + bv[bj][n]; }
    }
};
struct EpiResGate {
    static constexpr bool PERM = false, AFTER_DRAIN = false;
    const float* X; float* O; int ldc; const float* gate; int gate_stride, tiles_per_batch;
    __device__ __forceinline__ void operator()(const f32x4 (&acc)[2][2][4][2], const Unit& u, int wr, int wc, int fr, int fq) const {
        const int row0 = u.pm * BM + wr * 64 + fr, col0 = u.pn * BM + wc * 32 + 4 * fq;
        const float* gp = gate + (size_t)(u.pm / tiles_per_batch) * gate_stride;
        f32x4 gv[2][2];
#pragma unroll
        for (int bj = 0; bj < 2; ++bj)
#pragma unroll
            for (int n = 0; n < 2; ++n) gv[bj][n] = *(const f32x4*)(gp + col0 + bj * HALF + n * 16);
        f32x4 xv[2][2][2];
#define ERG_LOAD(idx, slot) do { const size_t off_ = (size_t)(row0 + ((idx) >> 2) * HALF + ((idx) & 3) * 16) * ldc + col0; _Pragma("unroll") for (int bj = 0; bj < 2; ++bj) _Pragma("unroll") for (int n = 0; n < 2; ++n) xv[slot][bj][n] = *(const f32x4*)(X + off_ + bj * HALF + n * 16); } while (0)
        ERG_LOAD(0, 0); ERG_LOAD(1, 1);
#pragma unroll
        for (int idx = 0; idx < 8; ++idx) { const int ai = idx >> 2, m = idx & 3; const size_t off = (size_t)(row0 + ai * HALF + m * 16) * ldc + col0;
#pragma unroll
            for (int bj = 0; bj < 2; ++bj)
#pragma unroll
                for (int n = 0; n < 2; ++n) *(f32x4*)(O + off + bj * HALF + n * 16) = xv[idx & 1][bj][n] + gv[bj][n] * acc[ai][bj][m][n];
            if (idx + 2 < 8) ERG_LOAD(idx + 2, idx & 1); }
#undef ERG_LOAD
    }
};

struct EpiLdsTile {
    static constexpr bool PERM = true, AFTER_DRAIN = true;
    __device__ __forceinline__ void operator()(const f32x4 (&)[2][2][4][2], const Unit&, int, int, int, int) const {}
    __device__ __forceinline__ void fused(f32x4 (&acc)[2][2][4][2], const Unit&, int wr, int wc, int fr, int fq, PG8_LAS unsigned char* lds, int, int) const {
#pragma unroll
        for (int ai = 0; ai < 2; ++ai)
#pragma unroll
            for (int m = 0; m < 4; ++m) { const int row = ai * HALF + wr * 64 + m * 16 + fr;
#pragma unroll
                for (int bj = 0; bj < 2; ++bj) { const f32x4 v0 = acc[ai][bj][m][0], v1 = acc[ai][bj][m][1]; u32x4 w; w.x = cvt_pk_bf16(v0[0], v0[1]); w.y = cvt_pk_bf16(v0[2], v0[3]); w.z = cvt_pk_bf16(v1[0], v1[1]); w.w = cvt_pk_bf16(v1[2], v1[3]);
                    const int chunk = 16 * bj + 4 * wc + fq; *(PG8_LAS u32x4*)(lds + row * 512 + 16 * (chunk ^ (row & 15))) = w; } }
    }
};

template <class Epi, class Sched, bool ALIGN_EPI = false, bool SP2 = false>
__device__ __forceinline__ void gemm_phase(PG8_LAS unsigned char* lds, const Gemm g, const Sched& S, const Epi& E) {
    const int tid = threadIdx.x, wid = __builtin_amdgcn_readfirstlane(tid >> 6), lane = tid & 63, wr = wid >> 2, wc = wid & 3, fr = lane & 15, fq = lane >> 4;
    const int K = g.K, nt = K / BK;
    unsigned voffA[2], voffB[2];
#pragma unroll
    for (int i = 0; i < 2; ++i) { int R, C; stage_rc(tid * 16 + i * 8192, R, C); const int Rb = Epi::PERM ? ((R & ~31) + perm32(R & 31)) : R;
        voffA[i] = (unsigned)(R * K + C) * 2u; voffB[i] = (unsigned)(Rb * K + C) * 2u; }
    const size_t kstep = (size_t)(BK * 2);
    const size_t hstep = (size_t)HALF * K * 2;
    const size_t tstep = 2 * hstep;
    const unsigned ldsw = (unsigned)wid * 1024u;
    const int aoff = lds_byte(wr * 64 + fr, fq * 8), boff = lds_byte(wc * 32 + fr, fq * 8);
#define PG8_SA(b, h) (((b) * 2 + (h)) * HTB)
#define PG8_SB(b, h) ((4 + (b) * 2 + (h)) * HTB)
#define PG8_STAGE(bufoff, gbase, voff) do { _Pragma("unroll") for (int _i = 0; _i < 2; ++_i) \
        __builtin_amdgcn_global_load_lds((const unsigned*)((const char*)(gbase) + (voff)[_i]), (PG8_LAS unsigned*)(lds + (bufoff) + ldsw + _i * 8192), 16, 0, 0); } while (0)
#define PG8_LDA(dst, b, h) do { _Pragma("unroll") for (int m = 0; m < 4; ++m) _Pragma("unroll") for (int k = 0; k < 2; ++k) dst[m][k] = *(const PG8_LAS bf16x8*)(lds + PG8_SA(b, h) + aoff + m * 2048 + k * 1024); } while (0)
#define PG8_LDB(dst, b, h) do { _Pragma("unroll") for (int n = 0; n < 2; ++n) _Pragma("unroll") for (int k = 0; k < 2; ++k) dst[n][k] = *(const PG8_LAS bf16x8*)(lds + PG8_SB(b, h) + boff + n * 2048 + k * 1024); } while (0)
#define PG8_MMA(ai, bj, At, Bt) do { __builtin_amdgcn_s_setprio(1); _Pragma("unroll") for (int m = 0; m < 4; ++m) _Pragma("unroll") for (int n = 0; n < 2; ++n) _Pragma("unroll") for (int k = 0; k < 2; ++k) \
        acc[ai][bj][m][n] = __builtin_amdgcn_mfma_f32_16x16x32_bf16(Bt[n][k], At[m][k], acc[ai][bj][m][n], 0, 0, 0); __builtin_amdgcn_s_setprio(0); } while (0)
#define PG8_WAIT_V(n) asm volatile("s_waitcnt vmcnt(" #n ")" ::: "memory")
#define PG8_WAIT_L(n) asm volatile("s_waitcnt lgkmcnt(" #n ")" ::: "memory")
#define PG8_BAR __builtin_amdgcn_s_barrier()
#define PG8_SCHED __builtin_amdgcn_sched_barrier(0)
    Unit cur, nxt; int ui = 0;
    if (!S.next(0, cur)) return;
    f32x4 acc[2][2][4][2];
#pragma unroll
    for (int a = 0; a < 2; ++a)
#pragma unroll
        for (int b = 0; b < 2; ++b)
#pragma unroll
            for (int m = 0; m < 4; ++m)
#pragma unroll
                for (int n = 0; n < 2; ++n) acc[a][b][m][n] = (f32x4){0.f, 0.f, 0.f, 0.f};
    bf16x8 At[4][2], B0[2][2], B1[2][2];
    const char* cA = (const char*)g.A + (size_t)cur.pm * tstep; const char* cB = (const char*)g.Bt + (size_t)cur.pn * tstep;
    S.a_ready(cur);
    if constexpr (SP2) {
        PG8_STAGE(PG8_SB(0, 0), cB, voffB); PG8_STAGE(PG8_SB(0, 1), cB + hstep, voffB); PG8_STAGE(PG8_SA(0, 0), cA, voffA); PG8_STAGE(PG8_SA(0, 1), cA + hstep, voffA);
        if (wr == 1) PG8_BAR;
        PG8_WAIT_V(2); PG8_BAR;
        PG8_STAGE(PG8_SB(1, 0), cB + kstep, voffB); PG8_STAGE(PG8_SA(1, 0), cA + kstep, voffA); PG8_STAGE(PG8_SB(1, 1), cB + hstep + kstep, voffB);
        PG8_WAIT_V(6); PG8_BAR;
    } else {
        PG8_STAGE(PG8_SB(0, 0), cB, voffB); PG8_STAGE(PG8_SA(0, 0), cA, voffA); PG8_STAGE(PG8_SB(0, 1), cB + hstep, voffB); PG8_STAGE(PG8_SA(0, 1), cA + hstep, voffA);
        if (wr == 1) PG8_BAR;
        PG8_WAIT_V(4); PG8_BAR;
        PG8_STAGE(PG8_SB(1, 0), cB + kstep, voffB); PG8_STAGE(PG8_SA(1, 0), cA + kstep, voffA); PG8_STAGE(PG8_SB(1, 1), cB + hstep + kstep, voffB);
        PG8_WAIT_V(6); PG8_BAR;
    }
    for (;;) {
        const bool has_next = S.next(ui + 1, nxt);
        const char* nA = has_next ? (const char*)g.A + (size_t)nxt.pm * tstep : cA; const char* nB = has_next ? (const char*)g.Bt + (size_t)nxt.pn * tstep : cB;
        for (int t = 0; t < nt; t += 2) {
            const bool last = (t == nt - 2);
            const char* a1 = cA + (size_t)(t + 1) * kstep;
            const char* a2 = last ? nA : cA + (size_t)(t + 2) * kstep; const char* b2 = last ? nB : cB + (size_t)(t + 2) * kstep;
            const char* a3 = a2 + kstep; const char* b3 = b2 + kstep;
            if (last && has_next) S.a_ready(nxt);
            if constexpr (SP2) {
            PG8_LDB(B0, 0, 0); PG8_LDB(B1, 0, 1); PG8_SCHED; PG8_LDA(At, 0, 0); PG8_STAGE(PG8_SA(1, 1), a1 + hstep, voffA);
            PG8_WAIT_V(8); PG8_WAIT_L(0); PG8_BAR; PG8_MMA(0, 0, At, B0); PG8_MMA(0, 1, At, B1); PG8_BAR; PG8_SCHED;
            PG8_LDA(At, 0, 1); PG8_STAGE(PG8_SB(0, 0), b2, voffB); PG8_STAGE(PG8_SB(0, 1), b2 + hstep, voffB); PG8_STAGE(PG8_SA(0, 0), a2, voffA);
            PG8_WAIT_V(8); PG8_WAIT_L(0); PG8_BAR; PG8_MMA(1, 0, At, B0); PG8_MMA(1, 1, At, B1); PG8_BAR; PG8_SCHED;
            PG8_LDB(B0, 1, 0); PG8_LDB(B1, 1, 1); PG8_SCHED; PG8_LDA(At, 1, 0); PG8_STAGE(PG8_SA(0, 1), a2 + hstep, voffA);
            PG8_WAIT_V(8); PG8_WAIT_L(0); PG8_BAR; PG8_MMA(0, 0, At, B0); PG8_MMA(0, 1, At, B1); PG8_BAR; PG8_SCHED;
            PG8_LDA(At, 1, 1); PG8_STAGE(PG8_SB(1, 0), b3, voffB); PG8_STAGE(PG8_SB(1, 1), b3 + hstep, voffB); PG8_STAGE(PG8_SA(1, 0), a3, voffA);
            PG8_WAIT_V(8); PG8_WAIT_L(0); PG8_BAR; PG8_MMA(1, 0, At, B0); PG8_MMA(1, 1, At, B1); PG8_BAR; PG8_SCHED;
            } else {
            PG8_LDB(B0, 0, 0); PG8_SCHED; PG8_LDA(At, 0, 0); PG8_STAGE(PG8_SA(1, 1), a1 + hstep, voffA);
            PG8_WAIT_L(8); PG8_BAR; PG8_WAIT_L(0); PG8_MMA(0, 0, At, B0); PG8_BAR; PG8_SCHED;
            PG8_LDB(B1, 0, 1); PG8_STAGE(PG8_SB(0, 0), b2, voffB);
            PG8_BAR; PG8_WAIT_L(0); PG8_MMA(0, 1, At, B1); PG8_BAR;
            PG8_LDA(At, 0, 1); PG8_STAGE(PG8_SA(0, 0), a2, voffA);
            PG8_BAR; PG8_WAIT_L(0); PG8_MMA(1, 0, At, B0); PG8_BAR; PG8_SCHED;
            PG8_STAGE(PG8_SB(0, 1), b2 + hstep, voffB);
            PG8_WAIT_V(6); PG8_BAR; PG8_MMA(1, 1, At, B1); PG8_BAR;
            PG8_LDB(B0, 1, 0); PG8_SCHED; PG8_LDA(At, 1, 0); PG8_STAGE(PG8_SA(0, 1), a2 + hstep, voffA);
            PG8_WAIT_L(8); PG8_BAR; PG8_WAIT_L(0); PG8_MMA(0, 0, At, B0); PG8_BAR; PG8_SCHED;
            PG8_LDB(B1, 1, 1); PG8_STAGE(PG8_SB(1, 0), b3, voffB);
            PG8_BAR; PG8_WAIT_L(0); PG8_MMA(0, 1, At, B1); PG8_BAR;
            PG8_LDA(At, 1, 1); PG8_STAGE(PG8_SA(1, 0), a3, voffA);
            PG8_BAR; PG8_WAIT_L(0); PG8_MMA(1, 0, At, B0); PG8_BAR; PG8_SCHED;
            PG8_STAGE(PG8_SB(1, 1), b3 + hstep, voffB);
            PG8_WAIT_V(6); PG8_BAR; PG8_MMA(1, 1, At, B1); PG8_BAR;
            }
        }
        if constexpr (ALIGN_EPI) { if (wr == 0) PG8_BAR; }
        if constexpr (!Epi::AFTER_DRAIN) { E(acc, cur, wr, wc, fr, fq); S.done(cur); }
        if (!has_next) break;
#pragma unroll
        for (int a = 0; a < 2; ++a)
#pragma unroll
            for (int b = 0; b < 2; ++b)
#pragma unroll
                for (int m = 0; m < 4; ++m)
#pragma unroll
                    for (int n = 0; n < 2; ++n) acc[a][b][m][n] = (f32x4){0.f, 0.f, 0.f, 0.f};
        cur = nxt; cA = nA; cB = nB; ++ui;
        if constexpr (ALIGN_EPI) { if (wr == 1) PG8_BAR; }
    }
    PG8_WAIT_V(0);
    if constexpr (!ALIGN_EPI) { if (wr == 0) PG8_BAR; }
    PG8_BAR;
    if constexpr (Epi::AFTER_DRAIN) { E.fused(acc, cur, wr, wc, fr, fq, lds, wid, lane); S.done(cur); }
#undef PG8_SA
#undef PG8_SB
#undef PG8_STAGE
#undef PG8_LDA
#undef PG8_LDB
#undef PG8_MMA
#undef PG8_WAIT_V
#undef PG8_WAIT_L
#undef PG8_BAR
#undef PG8_SCHED
}
}

#ifndef PG8_SP2
#define PG8_SP2 true
#endif
#ifndef PG8_ALIGN
#define PG8_ALIGN true
#endif
constexpr int NWAVES = 8, NTHREADS = NWAVES * 64;
constexpr int BATCH = 2, SEQ = 4096, T = BATCH * SEQ, D = 2048;
constexpr int INW = 6160, NPROJ = 6144;
constexpr int GQ = 0, GK = 512, GV = 1024, GG = 2048, MQ = 3072, MK = 4096, MV = 5120;
constexpr int GA_SRC = 3072;
constexpr int NH = 8, NEXP = 16384, NMOD = 6 * D;
constexpr float EPS = 1e-6f;
#ifndef MK_N_LAUNCHES
#define MK_N_LAUNCHES 1
#endif
constexpr int N_PHASES = 13;
#ifndef PROBE_TS
#define PROBE_TS -1
#endif
constexpr int NSL = 8, SLW = 256, PCH = 64, NCHUNK = (BATCH * SEQ) / PCH;

constexpr size_t MiB = 1u << 20;
constexpr size_t WS_CTL = 0, CTL_ZERO_BYTES = 1 * MiB;
constexpr size_t WS_WIN = 1 * MiB, WS_WGA = 25 * MiB, WS_WOUT = 26 * MiB, WS_WQ = 34 * MiB, WS_KEYS = 42 * MiB, WS_CS = 43 * MiB, WS_KMEAN = 44 * MiB, WS_DEC = 45 * MiB;
constexpr size_t WS_UB = 46 * MiB, WS_VB = 110 * MiB, WS_H = 174 * MiB, WS_CONCAT = 206 * MiB, WS_BCUM = 238 * MiB, WS_UT = 254 * MiB, WS_ST = 286 * MiB, WS_PROJ = 302 * MiB;
constexpr size_t WS_QP = WS_PROJ, WS_EXP = 366 * MiB, WS_GATE = 370 * MiB, WS_GU = 374 * MiB, WS_ACT = 378 * MiB, WS_HQ = 382 * MiB, WS_QDEC = 398 * MiB, WS_KDEC = 406 * MiB, WS_KUPD = 414 * MiB, WS_PART = 422 * MiB, WS_ML = 486 * MiB, WS_LIST = 488 * MiB, WS_SEL = 492 * MiB, WS_END = 493 * MiB;
constexpr size_t WS_US = WS_UB + 40 * MiB, WS_VS = WS_VB + 40 * MiB, WS_HS = WS_VB + 41 * MiB;
constexpr int CW_BAR = 4096, CW_Q = 8192, CW_QA = 12288, CW_QB = 13312, CW_LCNT = 14336, CW_MOD = 16384;
static_assert((CW_MOD + 2 * BATCH * NMOD) * 4 <= (int)CTL_ZERO_BYTES, "CTL words inside the memset region");
constexpr size_t WS_MODF = 45 * MiB + 512 * 1024;

constexpr int RING_BYTES = 131072, MISC_OFF = RING_BYTES + 320, LDS_BYTES = 147456;

#define GAS __attribute__((address_space(1)))
#define LAS __attribute__((address_space(3)))
typedef unsigned short bf16;
typedef unsigned v4u __attribute__((ext_vector_type(4)));
typedef unsigned v2u __attribute__((ext_vector_type(2)));
typedef float f32x4 __attribute__((ext_vector_type(4)));
typedef float f32x2 __attribute__((ext_vector_type(2)));
typedef float f32x16 __attribute__((ext_vector_type(16)));
typedef short bf16x8 __attribute__((ext_vector_type(8)));
typedef short s16x4 __attribute__((ext_vector_type(4)));
typedef __bf16 bf16x2_t __attribute__((ext_vector_type(2)));
typedef GAS unsigned gu32;
#define LDS_WAIT() asm volatile("s_waitcnt lgkmcnt(0)" ::: "memory")
#define VM_WAIT() asm volatile("s_waitcnt vmcnt(0)" ::: "memory")
__device__ __forceinline__ unsigned pk2(float lo, float hi) { f32x2 v = {lo, hi}; bf16x2_t b = __builtin_convertvector(v, bf16x2_t); return __builtin_bit_cast(unsigned, b); }
__device__ __forceinline__ float bflo(unsigned u) { return __uint_as_float(u << 16); }
__device__ __forceinline__ float bfhi(unsigned u) { return __uint_as_float(u & 0xffff0000u); }
__device__ __forceinline__ float bf1(short s) { return __uint_as_float(((unsigned)(unsigned short)s) << 16); }
__device__ __forceinline__ bf16x8 pack8(float a0, float a1, float a2, float a3, float a4, float a5, float a6, float a7) { v4u w; w.x = pk2(a0, a1); w.y = pk2(a2, a3); w.z = pk2(a4, a5); w.w = pk2(a6, a7); return __builtin_bit_cast(bf16x8, w); }
__device__ __forceinline__ int crow(int r, int hi) { return (r & 3) + 8 * (r >> 2) + 4 * hi; }
__device__ __forceinline__ float wave_sum(float v) {
#pragma unroll
    for (int o = 1; o < 64; o <<= 1) v += __shfl_xor(v, o);
    return v;
}
typedef short v4i16_t __attribute__((ext_vector_type(4)));
__device__ __forceinline__ s16x4 vtr(const LAS unsigned char* p) { return __builtin_bit_cast(s16x4, __builtin_amdgcn_ds_read_tr16_b64_v4i16((LAS v4i16_t*)p)); }
__device__ __forceinline__ bf16x8 cat4(s16x4 lo, s16x4 hi) { return (bf16x8){lo[0], lo[1], lo[2], lo[3], hi[0], hi[1], hi[2], hi[3]}; }
#define MFMA32(a, b, c) __builtin_amdgcn_mfma_f32_32x32x16_bf16((a), (b), (c), 0, 0, 0)
#define XB_TMO      128
#define XB_XCNT(j)  (256  + 64 * (j))
#define XB_XSUB(j)  (1280 + 64 * (j))
#define XB_XGEN(j)  (2304 + 64 * (j))
#define XB_TOP      3328
#define XB_TOPGEN   3392
#define XCD_BAR_WORDS 3456
#define XB_SPIN_CAP (1u << 18)

__device__ __forceinline__ unsigned xb_ld(unsigned* p)              { return __hip_atomic_load(p, __ATOMIC_RELAXED, __HIP_MEMORY_SCOPE_AGENT); }
__device__ __forceinline__ unsigned xb_add(unsigned* p, unsigned v) { return __hip_atomic_fetch_add(p, v, __ATOMIC_RELAXED, __HIP_MEMORY_SCOPE_AGENT); }
__device__ __forceinline__ unsigned xb_xcc_id() { return (unsigned)__builtin_amdgcn_s_getreg((3 << 11) | 20) & 0xFu; }
#define XB_SPIN(cond, bar) do { unsigned _sp = 0; while (cond) { __builtin_amdgcn_s_sleep(1); \
    if ((++_sp & 255u) == 0u) { if (xb_ld(&(bar)[XB_TMO])) break; if (_sp > XB_SPIN_CAP) { atomicAdd(&(bar)[XB_TMO], 1u); break; } } } } while (0)

struct XcdBarrier {
    unsigned* bar; unsigned x;
    volatile LAS unsigned* st;
};

__device__ __forceinline__ XcdBarrier xcd_barrier_post(unsigned* bar, volatile LAS unsigned* st) {
    XcdBarrier b; b.bar = bar; b.x = xb_xcc_id(); b.st = st;
    if (threadIdx.x == 0) (void)xb_add(&bar[XB_XCNT(b.x)], 1u);
    return b;
}
__device__ __forceinline__ void xcd_barrier_complete(unsigned* bar, unsigned x, unsigned& nloc, unsigned& nx) {
    const unsigned G = gridDim.x * gridDim.y * gridDim.z;
    unsigned sum, cnt, mine, sp = 0u;
    for (;;) {
        sum = 0u; cnt = 0u; mine = 0u;
#pragma unroll
        for (unsigned j = 0; j < 16; ++j) { const unsigned c = xb_ld(&bar[XB_XCNT(j)]); sum += c; cnt += (c > 0u) ? 1u : 0u; mine = (j == x) ? c : mine; }
        if (sum == G) break;
        __builtin_amdgcn_s_sleep(1);
        if ((++sp & 255u) == 0u) { if (xb_ld(&bar[XB_TMO])) break; if (sp > XB_SPIN_CAP) { atomicAdd(&bar[XB_TMO], 1u); break; } }
    }
    nloc = mine > 0u ? mine : 1u; nx = cnt > 0u ? cnt : 1u;
}

__device__ __forceinline__ void xcd_barrier(const XcdBarrier& b) {
    asm volatile("s_waitcnt vmcnt(0)" ::: "memory");
    __syncthreads();
    if (threadIdx.x == 0) {
        unsigned* bar = b.bar;
        __builtin_amdgcn_s_waitcnt(0);
        unsigned nloc = b.st[0], nx = b.st[1];
        if (nloc == 0u) { xcd_barrier_complete(bar, b.x, nloc, nx); b.st[0] = nloc; b.st[1] = nx; }
        const unsigned old = xb_add(&bar[XB_XSUB(b.x)], 1u);
        const unsigned gen = old / nloc;
        if (old + 1u == (gen + 1u) * nloc) {
            __builtin_amdgcn_fence(__ATOMIC_RELEASE, "agent");
            asm volatile("s_waitcnt vmcnt(0)" ::: "memory");
            const unsigned og = xb_add(&bar[XB_TOP], 1u);
            const unsigned tg = og / nx;
            if (og + 1u == (tg + 1u) * nx) xb_add(&bar[XB_TOPGEN], 1u);
            else XB_SPIN(xb_ld(&bar[XB_TOPGEN]) == tg, bar);
            __builtin_amdgcn_fence(__ATOMIC_ACQUIRE, "agent");
            xb_add(&bar[XB_XGEN(b.x)], 1u);
            asm volatile("s_waitcnt vmcnt(0)" ::: "memory");
        } else {
            XB_SPIN(xb_ld(&bar[XB_XGEN(b.x)]) == gen, bar);
            __builtin_amdgcn_fence(__ATOMIC_ACQUIRE, "agent");
            asm volatile("s_waitcnt vmcnt(0)" ::: "memory");
        }
    }
    __syncthreads();
}

struct Ctx {
    LAS unsigned char* lds;
    int tid, lane, wave, vcu, G, gw, ngw;
    const float *x, *c; const int* pos; const float *w_ada, *b_ada, *g1, *w_in, *w_a2, *b_a, *gla_g, *qg, *kg, *w_out, *g2, *w_q, *keys, *pu, *pv;
    float* out;
    unsigned* ctl; long long* MODI; float* MOD;
    bf16 *WIN, *WGA, *WOUT, *WQ, *KEYSB, *H, *CONCAT, *PROJ, *ST, *QDEC, *KDEC, *KUPD, *PART; float* ML; unsigned short *LIST, *SEL;
    unsigned char *UQ, *VQ, *HQ;
    float *CS, *KMEAN, *DEC, *BCUM, *UT, *QP, *GATE, *GU, *US, *VS, *HS; int *EXPI, *ACT;
};

__device__ __forceinline__ void transpose_item(const float* W, int ldw, int K, bf16* WT, int dst_row0, int k0, int n0, LAS float* scr, int lane) {
#pragma unroll 8
    for (int i = 0; i < 32; ++i) { const int kk = 2 * i + (lane >> 5); scr[kk * 33 + (lane & 31)] = W[(size_t)(k0 + kk) * ldw + n0 + (lane & 31)]; }
    LDS_WAIT(); asm volatile("" ::: "memory");
    const int c = lane & 7;
#pragma unroll
    for (int j = 0; j < 4; ++j) { const int n = (lane >> 3) + 8 * j; const LAS float* s = scr + (8 * c) * 33 + n;
        v4u o; o.x = pk2(s[0 * 33], s[1 * 33]); o.y = pk2(s[2 * 33], s[3 * 33]); o.z = pk2(s[4 * 33], s[5 * 33]); o.w = pk2(s[6 * 33], s[7 * 33]);
        *(v4u*)(WT + (size_t)(dst_row0 + n) * K + k0 + 8 * c) = o; }
    LDS_WAIT(); asm volatile("" ::: "memory");
}
__device__ __forceinline__ void convert_item(const float* src, bf16* dst, size_t item, int lane) {
    const f32x4* s = (const f32x4*)(src + item * 8192) + 2 * lane; v4u* d = (v4u*)(dst + item * 8192) + lane;
#pragma unroll 4
    for (int it = 0; it < 16; ++it) { const f32x4 a = s[it * 128], b = s[it * 128 + 1]; v4u o; o.x = pk2(a.x, a.y); o.y = pk2(a.z, a.w); o.z = pk2(b.x, b.y); o.w = pk2(b.z, b.w); d[it * 64] = o; }
}
__device__ __forceinline__ float wave_max(float v) {
#pragma unroll
    for (int o = 1; o < 64; o <<= 1) v = fmaxf(v, __shfl_xor(v, o));
    return v;
}
__device__ __forceinline__ void quant_store(const f32x4 (&v)[8], unsigned char* dst, float* scales, int row, size_t nrows, int lane, int bias) {
    float am = 0.f;
#pragma unroll
    for (int j = 0; j < 8; ++j) am = fmaxf(am, fmaxf(fmaxf(fabsf(v[j].x), fabsf(v[j].y)), fmaxf(fabsf(v[j].z), fabsf(v[j].w))));
    am = wave_max(am);
    const float inv = am > 0.f ? 127.f / am : 0.f;
    if (lane == 0) scales[row] = am > 0.f ? am / 127.f : 1.f;
#pragma unroll
    for (int j = 0; j < 8; ++j) { const int q0 = (int)rintf(v[j].x * inv) + bias, q1 = (int)rintf(v[j].y * inv) + bias, q2 = (int)rintf(v[j].z * inv) + bias, q3 = (int)rintf(v[j].w * inv) + bias;
        *(unsigned*)(dst + ((size_t)j * nrows + row) * 256 + 4 * lane) = (unsigned)(q0 & 0xff) | ((unsigned)(q1 & 0xff) << 8) | ((unsigned)(q2 & 0xff) << 16) | ((unsigned)(q3 & 0xff) << 24); }
}
__device__ __forceinline__ void quant_row(const float* src, unsigned char* dst, float* scales, int row, size_t nrows, int lane, int bias) {
    const f32x4* s = (const f32x4*)src + lane; f32x4 v[8];
#pragma unroll
    for (int j = 0; j < 8; ++j) v[j] = s[64 * j];
    quant_store(v, dst, scales, row, nrows, lane, bias);
}
__device__ __forceinline__ void p0_phase(const Ctx& C, int rep) {
    const int lane = C.lane, gw = C.gw, ngw = C.ngw;
    LAS float* sc = (LAS float*)C.lds;
    LAS float* part = sc + BATCH * D;
    for (int i = C.tid; i < BATCH * D; i += NTHREADS) { const float v = C.c[i]; sc[i] = v / (1.f + __expf(-v)); }
    __syncthreads();
    for (int it = C.vcu; it < 192; it += C.G) {
        const int cq = lane & 15, rg = lane >> 4, col = it * 64 + 4 * cq, r0 = 256 * C.wave + rg;
        const f32x4* w = (const f32x4*)(C.w_ada + (size_t)r0 * NMOD + col); const LAS float* s0 = sc + r0; const LAS float* s1 = sc + D + r0;
        f32x4 a0 = {0.f, 0.f, 0.f, 0.f}, a1 = a0;
#pragma unroll 16
        for (int k = 0; k < 64; ++k) { const f32x4 wv = w[(size_t)k * NMOD]; a0 += s0[4 * k] * wv; a1 += s1[4 * k] * wv; }
#pragma unroll
        for (int q = 0; q < 4; ++q) { a0[q] += __shfl_xor(a0[q], 16); a0[q] += __shfl_xor(a0[q], 32); a1[q] += __shfl_xor(a1[q], 16); a1[q] += __shfl_xor(a1[q], 32); }
        if (rg == 0) { *(LAS f32x4*)(part + (C.wave * 2 + 0) * 64 + 4 * cq) = a0; *(LAS f32x4*)(part + (C.wave * 2 + 1) * 64 + 4 * cq) = a1; }
        __syncthreads();
        if (C.tid < 128) { const int bb = C.tid >> 6, cl = C.tid & 63; float s = 0.f;
#pragma unroll
            for (int ww = 0; ww < 8; ++ww) s += part[(ww * 2 + bb) * 64 + cl];
            C.MOD[bb * NMOD + it * 64 + cl] = s + C.b_ada[it * 64 + cl]; }
        __syncthreads();
    }
    LAS float* scr = (LAS float*)(C.lds + C.wave * 16384);
    constexpr int I_IN = 32 * 192, I_SQ = 32 * 64;
    for (int it = gw; it < I_IN + 2 * I_SQ; it += ngw) {
        int r = it;
        if (r < I_IN) { const int kb = r / 192, nb = r % 192, n0 = 32 * nb; transpose_item(C.w_in, INW, D, C.WIN, n0, 64 * kb, n0 < 3072 ? n0 : n0 + 16, scr, lane); continue; } r -= I_IN;
        if (r < I_SQ) { transpose_item(C.w_out, D, D, C.WOUT, 32 * (r % 64), 64 * (r / 64), 32 * (r % 64), scr, lane); continue; } r -= I_SQ;
        transpose_item(C.w_q, D, D, C.WQ, 32 * (r % 64), 64 * (r / 64), 32 * (r % 64), scr, lane);
    }
    for (int it = gw; it < 32; it += ngw) { const int k = it * 64 + lane; const f32x4* s = (const f32x4*)(C.w_in + (size_t)k * INW + GA_SRC);
#pragma unroll
        for (int q = 0; q < 4; ++q) { const f32x4 v = s[q]; C.WGA[(4 * q + 0) * D + k] = (bf16)(pk2(v.x, 0.f) & 0xffff); C.WGA[(4 * q + 1) * D + k] = (bf16)(pk2(v.y, 0.f) & 0xffff);
            C.WGA[(4 * q + 2) * D + k] = (bf16)(pk2(v.z, 0.f) & 0xffff); C.WGA[(4 * q + 3) * D + k] = (bf16)(pk2(v.w, 0.f) & 0xffff); } }
    for (int it = gw; it < NEXP; it += ngw) {
        const f32x4* su = (const f32x4*)(C.pu + (size_t)it * D) + lane; const f32x4* sv = (const f32x4*)(C.pv + (size_t)it * D) + lane; f32x4 vu[8], vv[8];
#pragma unroll
        for (int j = 0; j < 8; ++j) { vu[j] = su[64 * j]; vv[j] = sv[64 * j]; }
        quant_store(vu, C.UQ, C.US, it, NEXP, lane, 0); quant_store(vv, C.VQ, C.VS, it, NEXP, lane, 0);
    }
    for (int it = gw; it < 32; it += ngw) convert_item(C.keys, C.KEYSB, it, lane);
    for (int idx = C.vcu * NTHREADS + C.tid; idx < T * 16; idx += C.G * NTHREADS) {
        const int t = idx >> 4, f = idx & 15; const float inv = powf(500000.0f, -(float)f * 0.0625f); const float ang = (float)C.pos[t] * inv;
        C.CS[2 * idx] = cosf(ang); C.CS[2 * idx + 1] = sinf(ang);
    }
}

__device__ __forceinline__ float modi_to_f32(long long v) { return (float)(int)(v >> 32) * 0.00390625f + (float)(unsigned)v * 9.094947017729282e-13f; }
template <bool FIRST> __device__ __forceinline__ void norm_mod_phase(const Ctx& C, const float* X, const float* g, int shift_off, int scale_off, bf16* O) {
    LAS float* lg = (LAS float*)C.lds; LAS float* lsh = lg + D; LAS float* lsc = lsh + BATCH * D;
    for (int i = C.tid; i < D; i += NTHREADS) lg[i] = g[i];
    for (int i = C.tid; i < BATCH * D; i += NTHREADS) { const int b = i / D, j = i % D;
        lsh[i] = C.MOD[b * NMOD + shift_off + j]; lsc[i] = 1.f + C.MOD[b * NMOD + scale_off + j]; }
    __syncthreads();
    for (int m = C.gw; m < T; m += C.ngw) {
        const int b = m / SEQ; const f32x4* xr = (const f32x4*)(X + (size_t)m * D) + C.lane;
        f32x4 v[8]; float ss = 0.f;
#pragma unroll
        for (int j = 0; j < 8; ++j) { v[j] = xr[64 * j]; ss += (v[j].x * v[j].x + v[j].y * v[j].y) + (v[j].z * v[j].z + v[j].w * v[j].w); }
        const float rstd = rsqrtf(wave_sum(ss) * (1.f / D) + EPS);
        const LAS f32x4* g4 = (const LAS f32x4*)lg + C.lane; const LAS f32x4* sh4 = (const LAS f32x4*)(lsh + b * D) + C.lane; const LAS f32x4* sc4 = (const LAS f32x4*)(lsc + b * D) + C.lane;
        v2u* o8 = (v2u*)(O + (size_t)m * D) + C.lane;
#pragma unroll
        for (int j = 0; j < 8; ++j) { const f32x4 y = v[j] * rstd * g4[64 * j] * sc4[64 * j] + sh4[64 * j]; v2u w; w.x = pk2(y.x, y.y); w.y = pk2(y.z, y.w); o8[64 * j] = w; v[j] = y; }
        if (!FIRST) quant_store(v, C.HQ, C.HS, m, T, C.lane, 0);
    }
    __syncthreads();
}

__device__ __forceinline__ void gla_prep_item(const Ctx& C, int b, int n, int ch) {
    const int lane = C.lane, w = C.wave, fr = lane & 15, fq = lane >> 4, rt = w & 3, kh = w >> 2; const size_t t0 = (size_t)b * SEQ + 64 * n;
    const bf16* ap = C.H + (t0 + 16 * rt + fr) * D + kh * 1024 + 8 * fq; const bf16* bp = C.WGA + fr * D + kh * 1024 + 8 * fq;
    f32x4 acc = {0.f, 0.f, 0.f, 0.f};
#pragma unroll 16
    for (int s = 0; s < 32; ++s) acc = __builtin_amdgcn_mfma_f32_16x16x32_bf16(*(const bf16x8*)(ap + 32 * s), *(const bf16x8*)(bp + 32 * s), acc, 0, 0, 0);
    LAS float* gaP = (LAS float*)C.lds;
#pragma unroll
    for (int r = 0; r < 4; ++r) gaP[kh * 1024 + (16 * rt + 4 * fq + r) * 16 + fr] = acc[r];
    __syncthreads();
    const int c = C.tid & 255, th = C.tid >> 8, col = ch * 256 + c; float wc[16];
#pragma unroll
    for (int r = 0; r < 16; ++r) wc[r] = C.w_a2[r * 512 + col];
    const float ba = C.b_a[col]; float cum = 0.f, la[32];
#pragma unroll
    for (int k = 0; k < 32; ++k) { const int tok = 32 * th + k;
        const LAS f32x4* g0 = (const LAS f32x4*)(gaP + tok * 16); const LAS f32x4* g1 = (const LAS f32x4*)(gaP + 1024 + tok * 16); float z = ba;
#pragma unroll
        for (int q = 0; q < 4; ++q) { const f32x4 gv = g0[q] + g1[q]; z += gv.x * wc[4 * q] + gv.y * wc[4 * q + 1] + gv.z * wc[4 * q + 2] + gv.w * wc[4 * q + 3]; }
        cum += (fminf(z, 0.f) - __logf(1.f + __expf(-fabsf(z)))) * 0.0625f; la[k] = cum; }
    if (th == 0) gaP[2048 + c] = cum;
    __syncthreads();
    const float base = th ? gaP[2048 + c] : 0.f;
    if (th == 1) gaP[2048 + 256 + c] = cum + base;
    __syncthreads();
    const float blast = gaP[2048 + 256 + c];
    if (th == 1) C.DEC[((size_t)(b * NH + (col >> 6)) * 64 + n) * 64 + (col & 63)] = __expf(blast);
    const bf16* qp = C.PROJ + (t0 + 32 * th) * NPROJ + GQ + col; const bf16* kp = C.PROJ + (t0 + 32 * th) * NPROJ + GK + col;
    bf16* qo = C.QDEC + (t0 + 32 * th) * 512 + col; bf16* ko = C.KDEC + (t0 + 32 * th) * 512 + col; bf16* uo = C.KUPD + (t0 + 32 * th) * 512 + col;
    unsigned short qr[32], kr[32];
#pragma unroll
    for (int k = 0; k < 32; ++k) { qr[k] = qp[(size_t)k * NPROJ]; kr[k] = kp[(size_t)k * NPROJ]; }
#pragma unroll
    for (int k = 0; k < 32; ++k) { const float bb = la[k] + base, qv = __uint_as_float((unsigned)qr[k] << 16), kv = __uint_as_float((unsigned)kr[k] << 16);
        qo[(size_t)k * 512] = (bf16)(pk2(qv * 0.125f * __expf(bb), 0.f) & 0xffffu); ko[(size_t)k * 512] = (bf16)(pk2(kv * __expf(-bb), 0.f) & 0xffffu); uo[(size_t)k * 512] = (bf16)(pk2(kv * __expf(blast - bb), 0.f) & 0xffffu); }
    __syncthreads();
}
__device__ __forceinline__ void moba_prep_item(const Ctx& C, int b, int h, int blk, int rep) {
    const int lane = C.lane, w = C.wave, i = lane & 15, tg = lane >> 4; const size_t t0 = (size_t)b * SEQ + 256 * blk;
    float qg[8], kg[8], km[8];
#pragma unroll
    for (int j = 0; j < 8; ++j) { qg[j] = C.qg[8 * i + j]; kg[j] = C.kg[8 * i + j]; km[j] = 0.f; }
    v4u rawq[8], rawk[8];
#pragma unroll
    for (int it = 0; it < 8; ++it) { const size_t tok = t0 + 32 * w + 4 * it + tg; rawq[it] = *(const v4u*)(C.PROJ + tok * NPROJ + MQ + h * 128 + 8 * i); rawk[it] = *(const v4u*)(C.PROJ + tok * NPROJ + MK + h * 128 + 8 * i); }
#pragma unroll
    for (int it = 0; it < 8; ++it) {
        const size_t tok = t0 + 32 * w + 4 * it + tg;
        float cs[16];
        if (i < 4) { const f32x4* cp = (const f32x4*)(C.CS + tok * 32 + (i & 1) * 16);
#pragma unroll
            for (int q = 0; q < 4; ++q) { const f32x4 v = cp[q]; cs[4 * q] = v.x; cs[4 * q + 1] = v.y; cs[4 * q + 2] = v.z; cs[4 * q + 3] = v.w; } }
        else {
#pragma unroll
            for (int q = 0; q < 16; ++q) cs[q] = 0.f; }
#pragma unroll
        for (int which = 0; which < 2; ++which) {
            bf16* p = C.PROJ + tok * NPROJ + (which ? MK : MQ) + h * 128 + 8 * i;
            const v4u raw = which ? rawk[it] : rawq[it]; float xv[8];
            xv[0] = bflo(raw.x); xv[1] = bfhi(raw.x); xv[2] = bflo(raw.y); xv[3] = bfhi(raw.y); xv[4] = bflo(raw.z); xv[5] = bfhi(raw.z); xv[6] = bflo(raw.w); xv[7] = bfhi(raw.w);
            float ss = 0.f;
#pragma unroll
            for (int j = 0; j < 8; ++j) ss += xv[j] * xv[j];
            ss += __shfl_xor(ss, 1); ss += __shfl_xor(ss, 2); ss += __shfl_xor(ss, 4); ss += __shfl_xor(ss, 8);
            const float rstd = rsqrtf(ss * (1.f / 128.f) + EPS);
#pragma unroll
            for (int j = 0; j < 8; ++j) xv[j] = xv[j] * rstd * (which ? kg[j] : qg[j]);
#pragma unroll
            for (int j = 0; j < 8; ++j) { const float o = __shfl_xor(xv[j], 2); const float cv = cs[2 * j], sv = cs[2 * j + 1];
                if (i < 2) xv[j] = xv[j] * cv - o * sv; else if (i < 4) xv[j] = xv[j] * cv + o * sv; }
            v4u o; o.x = pk2(xv[0], xv[1]); o.y = pk2(xv[2], xv[3]); o.z = pk2(xv[4], xv[5]); o.w = pk2(xv[6], xv[7]);
            if (rep) *(v4u*)(C.CONCAT + tok * D + which * 1024 + h * 128 + 8 * i) = o; else *(v4u*)p = o;
            if (which) {
#pragma unroll
                for (int j = 0; j < 8; ++j) km[j] += xv[j]; }
        }
    }
    LAS float* red = (LAS float*)C.lds;
#pragma unroll
    for (int j = 0; j < 8; ++j) { km[j] += __shfl_xor(km[j], 16); km[j] += __shfl_xor(km[j], 32); }
    if (lane < 16) {
#pragma unroll
        for (int j = 0; j < 8; ++j) red[w * 128 + 8 * i + j] = km[j]; }
    __syncthreads();
    if (C.tid < 128) { float s = 0.f;
#pragma unroll
        for (int ww = 0; ww < 8; ++ww) s += red[ww * 128 + C.tid];
        C.KMEAN[((size_t)(b * NH + h) * 16 + blk) * 128 + C.tid] = s * (1.f / 256.f); }
    __syncthreads();
}

constexpr int KP = 272, VP = 320;
__device__ __forceinline__ void moba_select_item(const Ctx& C, int b, int h, int qb, int rep) {
    const int lane = C.lane, w = C.wave, r = lane & 31, hh = lane >> 5; const size_t tb = (size_t)b * SEQ; const int qtok = qb * 256 + 32 * w + r;
    bf16x8 qf[8];
    { const bf16* qrow = C.PROJ + MQ + h * 128 + (tb + qtok) * NPROJ + 8 * hh;
#pragma unroll
      for (int s = 0; s < 8; ++s) qf[s] = *(const bf16x8*)(qrow + 16 * s); }
    float g0 = -INFINITY, g1 = -INFINITY, g2 = -INFINITY; int i0 = -1, i1 = -1, i2 = -1;
    LAS float* kml = (LAS float*)C.lds;
    for (int i = C.tid; i < qb * 128; i += NTHREADS) kml[i] = C.KMEAN[((size_t)(b * NH + h) * 16) * 128 + i];
    __syncthreads();
    const LAS float* km = kml + 8 * hh;
    for (int j = 0; j < qb; ++j) {
        float acc = 0.f;
#pragma unroll
        for (int s = 0; s < 8; ++s) { const f32x4 k0 = *(const LAS f32x4*)(km + j * 128 + 16 * s), k1 = *(const LAS f32x4*)(km + j * 128 + 16 * s + 4);
            acc += bf1(qf[s][0]) * k0.x + bf1(qf[s][1]) * k0.y + bf1(qf[s][2]) * k0.z + bf1(qf[s][3]) * k0.w + bf1(qf[s][4]) * k1.x + bf1(qf[s][5]) * k1.y + bf1(qf[s][6]) * k1.z + bf1(qf[s][7]) * k1.w; }
        acc += __shfl_xor(acc, 32);
        if (acc > g0) { g2 = g1; i2 = i1; g1 = g0; i1 = i0; g0 = acc; i0 = j; }
        else if (acc > g1) { g2 = g1; i2 = i1; g1 = acc; i1 = j; }
        else if (acc > g2) { g2 = acc; i2 = j; }
    }
    __syncthreads();
    const int np = (i0 >= 0) + (i1 >= 0) + (i2 >= 0);
    if (hh == 0) C.SEL[(tb + qtok) * NH + h] = (unsigned short)((i0 & 15) | ((i1 & 15) << 4) | ((i2 & 15) << 8) | (np << 12));
    unsigned* lc = C.ctl + (rep ? 16384 : CW_LCNT) + ((b * NH + h) * 16) * 8; int nv = 0;
#pragma unroll
    for (int j = 0; j < 15; ++j) { const unsigned long long mk = __ballot(hh == 0 && (i0 == j || i1 == j || i2 == j)); nv = (lane == j) ? (int)__popcll(mk) : nv; }
    int basev = 0; if (lane < 15 && nv > 0) basev = (int)atomicAdd(lc + lane * 8, (unsigned)nv);
    unsigned short* lp = C.LIST + (size_t)((b * NH + h) * 16) * 4096 + (rep ? 256 * 4096 : 0);
#pragma unroll
    for (int j = 0; j < 15; ++j) { const int bj = __builtin_amdgcn_readlane(basev, j); const bool pj = hh == 0 && (i0 == j || i1 == j || i2 == j); const unsigned long long mk = __ballot(pj);
        if (pj) { const int slot = (i0 == j) ? 0 : (i1 == j) ? 1 : 2;
            const int pos = bj + (int)__builtin_amdgcn_mbcnt_hi((unsigned)(mk >> 32), __builtin_amdgcn_mbcnt_lo((unsigned)mk, 0u));
            lp[j * 4096 + pos] = (unsigned short)(qtok | (slot << 12)); } }
}
__device__ __forceinline__ void moba_attn_item(const Ctx& C, int b, int h, int kblk, bool own, int sub) {
    const int lane = C.lane, w = C.wave, r = lane & 31, hh = lane >> 5; const size_t tb = (size_t)b * SEQ; const int li = (b * NH + h) * 16 + kblk;
    { const char* kp = (const char*)(C.PROJ + (tb + kblk * 256) * NPROJ + MK + h * 128); const char* vp = (const char*)(C.PROJ + (tb + kblk * 256) * NPROJ + MV + h * 128);
#pragma unroll
      for (int i = 0; i < 8; ++i) { const int p = w + 8 * i, row = 4 * p + (lane >> 4), cp = lane & 15;
          __builtin_amdgcn_global_load_lds((const unsigned*)(kp + (size_t)row * (NPROJ * 2) + 16 * (cp ^ (row & 15))), (LAS unsigned*)(C.lds + p * 1024), 16, 0, 0);
          __builtin_amdgcn_global_load_lds((const unsigned*)(vp + (size_t)row * (NPROJ * 2) + 16 * (cp ^ ((row & 3) << 2))), (LAS unsigned*)(C.lds + 65536 + p * 1024), 16, 0, 0); } }
    const int cnt = own ? 256 : (int)C.ctl[CW_LCNT + li * 8], e = 256 * sub + 32 * w + r; const bool valid = e < cnt, wave_on = 256 * sub + 32 * w < cnt;
    int qtok, slot;
    if (own) { qtok = kblk * 256 + 32 * w + r; slot = 3; } else { const int ent = C.LIST[(size_t)li * 4096 + (valid ? e : 256 * sub)]; qtok = ent & 4095; slot = ent >> 12; }
    bf16x8 qf[8];
    { const bf16* qrow = C.PROJ + MQ + h * 128 + (tb + qtok) * NPROJ + 8 * hh;
#pragma unroll
      for (int s = 0; s < 8; ++s) qf[s] = *(const bf16x8*)(qrow + 16 * s); }
    __syncthreads();
    if (wave_on) {
        float m_run = -1e30f, l_run = 0.f; f32x16 o[4];
#pragma unroll
        for (int dt = 0; dt < 4; ++dt)
#pragma unroll
            for (int q = 0; q < 16; ++q) o[dt][q] = 0.f;
        const float c2 = 0.08838834764831845f * 1.4426950408889634f;
        const int xr = r & 15, vq = (lane & 15) >> 2, qi = 32 * w + r, ntile = own ? ((32 * w + 31) >> 6) + 1 : 4;
        const int kfo = r * 256, vfo = 65536 + (4 * hh + vq) * 256 + 32 * ((lane >> 4) & 1) + 8 * (lane & 3);
        for (int t = 0; t < ntile; ++t) {
            const LAS unsigned char* kb = C.lds + kfo + t * 16384;
            f32x16 p0, p1;
#pragma unroll
            for (int q = 0; q < 16; ++q) { p0[q] = 0.f; p1[q] = 0.f; }
#pragma unroll
            for (int ss = 0; ss < 8; ++ss) { const int co = ((2 * ss + hh) ^ xr) << 4; const bf16x8 a0 = *(const LAS bf16x8*)(kb + co), a1 = *(const LAS bf16x8*)(kb + 32 * 256 + co);
                p0 = MFMA32(a0, qf[ss], p0); p1 = MFMA32(a1, qf[ss], p1); }
            if (own) {
#pragma unroll
                for (int q = 0; q < 16; ++q) { const int kk = 64 * t + crow(q, hh); if (kk > qi) p0[q] = -INFINITY; if (kk + 32 > qi) p1[q] = -INFINITY; } }
            float mx = fmaxf(p0[0], p1[0]);
#pragma unroll
            for (int q = 1; q < 16; ++q) mx = fmaxf(mx, fmaxf(p0[q], p1[q]));
            { auto rr = __builtin_amdgcn_permlane32_swap(__float_as_uint(mx), __float_as_uint(mx), false, false); mx = fmaxf(__uint_as_float(rr[0]), __uint_as_float(rr[1])); }
            const float m_new = fmaxf(m_run, mx * c2), alpha = __builtin_amdgcn_exp2f(m_run - m_new);
            m_run = m_new; float rs = 0.f;
#pragma unroll
            for (int q = 0; q < 16; ++q) { p0[q] = __builtin_amdgcn_exp2f(p0[q] * c2 - m_new); p1[q] = __builtin_amdgcn_exp2f(p1[q] * c2 - m_new); rs += p0[q] + p1[q]; }
            l_run = l_run * alpha + rs;
            if (__ballot(alpha != 1.f) != 0ull) {
#pragma unroll
                for (int dt = 0; dt < 4; ++dt)
#pragma unroll
                    for (int q = 0; q < 16; ++q) o[dt][q] *= alpha; }
            bf16x8 pf[4];
            pf[0] = pack8(p0[0], p0[1], p0[2], p0[3], p0[4], p0[5], p0[6], p0[7]); pf[1] = pack8(p0[8], p0[9], p0[10], p0[11], p0[12], p0[13], p0[14], p0[15]);
            pf[2] = pack8(p1[0], p1[1], p1[2], p1[3], p1[4], p1[5], p1[6], p1[7]); pf[3] = pack8(p1[8], p1[9], p1[10], p1[11], p1[12], p1[13], p1[14], p1[15]);
            const LAS unsigned char* vb = C.lds + vfo + t * 16384;
#pragma unroll
            for (int dt = 0; dt < 4; ++dt) { const LAS unsigned char* vd = vb + 64 * (dt ^ vq);
#pragma unroll
                for (int kk = 0; kk < 4; ++kk) { const s16x4 lo = vtr(vd + (16 * kk) * 256), hi = vtr(vd + (16 * kk + 8) * 256); o[dt] = MFMA32(cat4(lo, hi), pf[kk], o[dt]); } }
        }
        l_run += __shfl_xor(l_run, 32);
        if (valid) { const float inv = 1.f / l_run; const size_t row = ((tb + qtok) * NH + h) * 4 + slot; bf16* op = C.PART + row * 128 + 4 * hh;
#pragma unroll
            for (int dt = 0; dt < 4; ++dt)
#pragma unroll
                for (int k4 = 0; k4 < 4; ++k4) { v2u wv; wv.x = pk2(o[dt][4 * k4] * inv, o[dt][4 * k4 + 1] * inv); wv.y = pk2(o[dt][4 * k4 + 2] * inv, o[dt][4 * k4 + 3] * inv); *(v2u*)(op + 32 * dt + 8 * k4) = wv; }
            if (hh == 0) *(f32x2*)(C.ML + row * 2) = (f32x2){m_run, l_run}; }
    }
    __syncthreads();
}
__device__ __forceinline__ void moba_merge_token(const Ctx& C, size_t t) {
    const int lane = C.lane, hd = lane >> 3, dc = lane & 7; const size_t row0 = (t * NH + hd) * 4;
    const unsigned short sel = C.SEL[t * NH + hd]; f32x2 ml[4]; v4u pa[4], pc[4];
#pragma unroll
    for (int s = 0; s < 4; ++s) { ml[s] = *(const f32x2*)(C.ML + (row0 + s) * 2); const v4u* pp = (const v4u*)(C.PART + (row0 + s) * 128 + 16 * dc); pa[s] = pp[0]; pc[s] = pp[1]; }
    const int np = sel >> 12; float M = -1e30f, wg[4], wsum = 0.f;
#pragma unroll
    for (int s = 0; s < 4; ++s) { const bool v = (s == 3) || (s < np); ml[s].x = v ? ml[s].x : -1e30f; ml[s].y = v ? ml[s].y : 0.f; M = fmaxf(M, ml[s].x); }
#pragma unroll
    for (int s = 0; s < 4; ++s) { wg[s] = ml[s].y * __builtin_amdgcn_exp2f(ml[s].x - M); wsum += wg[s]; }
    const float inv = 1.f / wsum; float acc[16];
#pragma unroll
    for (int q = 0; q < 16; ++q) acc[q] = 0.f;
#pragma unroll
    for (int s = 0; s < 4; ++s) { const unsigned vm = ((s == 3) || (s < np)) ? 0xffffffffu : 0u; const float ws_ = wg[s] * inv; v4u a = pa[s], c = pc[s];
        a.x &= vm; a.y &= vm; a.z &= vm; a.w &= vm; c.x &= vm; c.y &= vm; c.z &= vm; c.w &= vm;
        acc[0] += ws_ * bflo(a.x); acc[1] += ws_ * bfhi(a.x); acc[2] += ws_ * bflo(a.y); acc[3] += ws_ * bfhi(a.y); acc[4] += ws_ * bflo(a.z); acc[5] += ws_ * bfhi(a.z); acc[6] += ws_ * bflo(a.w); acc[7] += ws_ * bfhi(a.w);
        acc[8] += ws_ * bflo(c.x); acc[9] += ws_ * bfhi(c.x); acc[10] += ws_ * bflo(c.y); acc[11] += ws_ * bfhi(c.y); acc[12] += ws_ * bflo(c.z); acc[13] += ws_ * bfhi(c.z); acc[14] += ws_ * bflo(c.w); acc[15] += ws_ * bfhi(c.w); }
    v4u o0, o1; o0.x = pk2(acc[0], acc[1]); o0.y = pk2(acc[2], acc[3]); o0.z = pk2(acc[4], acc[5]); o0.w = pk2(acc[6], acc[7]); o1.x = pk2(acc[8], acc[9]); o1.y = pk2(acc[10], acc[11]); o1.z = pk2(acc[12], acc[13]); o1.w = pk2(acc[14], acc[15]);
    v4u* op = (v4u*)(C.CONCAT + t * D + 1024 + hd * 128 + 16 * dc); op[0] = o0; op[1] = o1;
}

constexpr int GKP = 192;
__device__ __forceinline__ void gla_v_to_lds(const Ctx& C, size_t t0, int h, int off) {
#pragma unroll
    for (int pp = 0; pp < 2; ++pp) { const int p = C.tid + 512 * pp; const v4u v = *(const v4u*)(C.PROJ + (t0 + (p >> 4)) * NPROJ + GV + h * 128 + 8 * (p & 15)); *(LAS v4u*)(C.lds + off + (p >> 4) * VP + 16 * (p & 15)) = v; }
}
__device__ __forceinline__ void gla_u_item(const Ctx& C, int b, int h, int n) {
    const int tid = C.tid, lane = C.lane, w = C.wave, r = lane & 31, hh = lane >> 5; const size_t t0 = (size_t)b * SEQ + 64 * n; const int bhn = (b * NH + h) * 64 + n;
    constexpr int KT = 0, VT = 64 * GKP;
    { const int tok = tid >> 3, ch = tid & 7; *(LAS v4u*)(C.lds + KT + tok * GKP + 16 * ch) = *(const v4u*)(C.KUPD + (t0 + tok) * 512 + h * 64 + 8 * ch); }
    gla_v_to_lds(C, t0, h, VT);
    __syncthreads();
    const int mt = w & 3, nt = w >> 2, q = (lane & 15) >> 2, cb = (16 * ((lane >> 4) & 1) + 4 * (lane & 3)) * 2;
    const LAS unsigned char* va = C.lds + VT + (4 * hh + q) * VP + cb + mt * 64; const LAS unsigned char* ka = C.lds + KT + (4 * hh + q) * GKP + cb + nt * 64;
    f32x16 acc;
#pragma unroll
    for (int i = 0; i < 16; ++i) acc[i] = 0.f;
#pragma unroll
    for (int s = 0; s < 4; ++s) acc = MFMA32(cat4(vtr(va + 16 * s * VP), vtr(va + (16 * s + 8) * VP)), cat4(vtr(ka + 16 * s * GKP), vtr(ka + (16 * s + 8) * GKP)), acc);
    float* up = C.UT + (size_t)bhn * 8192 + (32 * mt) * 64 + 32 * nt + r;
#pragma unroll
    for (int i = 0; i < 16; ++i) up[crow(i, hh) * 64] = acc[i];
    __syncthreads();
}
__device__ __forceinline__ void p5_attn_phase(const Ctx& C, int rep) {
    volatile LAS int* qslot = (volatile LAS int*)(C.lds + MISC_OFF + 64);
    LAS int* pfx = (LAS int*)(C.lds + RING_BYTES + 1024);
    if (C.tid < 256) { const int c = ((C.tid & 15) < 15) ? (int)C.ctl[CW_LCNT + C.tid * 8] : 0; pfx[1 + C.tid] = (c + 255) >> 8; }
    __syncthreads();
    if (C.tid == 0) { int s = 0; pfx[0] = 0; for (int i = 1; i <= 256; ++i) { s += pfx[i]; pfx[i] = s; } }
    __syncthreads();
    const int npast = pfx[256]; unsigned* cnt = C.ctl + CW_Q + 64 * rep;
    for (;;) {
        __syncthreads();
        if (C.tid == 0) { const int id = (int)atomicAdd(cnt, 1u); int a0 = -1, a1 = 0;
            if (id < 256) { a0 = id; a1 = -1; }
            else if (id < 256 + npast) { const int p = id - 256; int lo = 0, hi = 256; while (hi - lo > 1) { const int mid = (lo + hi) >> 1; if (pfx[mid] <= p) lo = mid; else hi = mid; } a0 = lo; a1 = p - pfx[lo]; }
            else if (id < 256 + npast + 1024) { a0 = 256 + (id - 256 - npast); a1 = 0; }
            qslot[0] = a0; qslot[1] = a1; }
        __syncthreads();
        const int a0 = qslot[0], a1 = qslot[1];
        if (a0 < 0) break;
        if (a0 < 256) moba_attn_item(C, a0 >> 7, (a0 >> 4) & 7, a0 & 15, a1 < 0, a1 < 0 ? 0 : a1);
        else { const int g = a0 - 256; gla_u_item(C, g >> 9, (g >> 6) & 7, g & 63); }
    }
}

__device__ __forceinline__ void p5_phase(const Ctx& C) {
    for (int idx = C.vcu * NTHREADS + C.tid; idx < 16 * 8192; idx += C.G * NTHREADS) {
        const int bh = idx >> 13, rem = idx & 8191, dk = rem & 63; float s = 0.f;
        const float* up = C.UT + (size_t)bh * 64 * 8192 + rem; const float* dp = C.DEC + (size_t)bh * 64 * 64 + dk; bf16* sp = C.ST + (size_t)bh * 64 * 8192 + rem;
#pragma unroll 16
        for (int n = 0; n < 64; ++n) { sp[(size_t)n * 8192] = (bf16)(pk2(s, 0.f) & 0xffffu); s = dp[n * 64] * s + up[(size_t)n * 8192]; }
    }
}

__device__ __forceinline__ void gla_out_item(const Ctx& C, int b, int h, int n) {
    const int lane = C.lane, w = C.wave, r = lane & 31, hh = lane >> 5, dvt = w & 3, lt = w >> 2; const size_t t0 = (size_t)b * SEQ + 64 * n; const int bhn = (b * NH + h) * 64 + n;
    constexpr int VT = 0, RED = 64 * VP;
    const size_t tl = t0 + 32 * lt + r;
    v4u vraw[2]; bf16x8 qd[4], kd[2][4];
#pragma unroll
    for (int pp = 0; pp < 2; ++pp) { const int p = C.tid + 512 * pp; vraw[pp] = *(const v4u*)(C.PROJ + (t0 + (p >> 4)) * NPROJ + GV + h * 128 + 8 * (p & 15)); }
#pragma unroll
    for (int s = 0; s < 4; ++s) { qd[s] = *(const bf16x8*)(C.QDEC + tl * 512 + h * 64 + 16 * s + 8 * hh); kd[1][s] = *(const bf16x8*)(C.KDEC + tl * 512 + h * 64 + 16 * s + 8 * hh);
        kd[0][s] = *(const bf16x8*)(C.KDEC + (t0 + r) * 512 + h * 64 + 16 * s + 8 * hh); }
#pragma unroll
    for (int pp = 0; pp < 2; ++pp) { const int p = C.tid + 512 * pp; *(LAS v4u*)(C.lds + VT + (p >> 4) * VP + 16 * (p & 15)) = vraw[pp]; }
    bf16x8 sfr[4]; v2u graw[4]; f32x4 gn[4];
    { const bf16* sp = C.ST + (size_t)bhn * 8192 + (32 * dvt + r) * 64 + 8 * hh;
#pragma unroll
      for (int s = 0; s < 4; ++s) sfr[s] = *(const bf16x8*)(sp + 16 * s);
#pragma unroll
      for (int k4 = 0; k4 < 4; ++k4) { const int d0 = 32 * dvt + 8 * k4 + 4 * hh; graw[k4] = *(const v2u*)(C.PROJ + tl * NPROJ + GG + h * 128 + d0); gn[k4] = *(const f32x4*)(C.gla_g + d0); } }
    __syncthreads();
    f32x16 o;
#pragma unroll
    for (int i = 0; i < 16; ++i) o[i] = 0.f;
    const LAS unsigned char* va = C.lds + VT + (4 * hh + ((lane & 15) >> 2)) * VP + (16 * ((lane >> 4) & 1) + 4 * (lane & 3)) * 2 + dvt * 64;
#pragma unroll
    for (int mt = 0; mt < 2; ++mt) {
        if (mt > lt) break;
        const bool diag = (mt == lt); f32x16 X;
#pragma unroll
        for (int i = 0; i < 16; ++i) X[i] = 0.f;
#pragma unroll
        for (int s = 0; s < 4; ++s) X = MFMA32(diag ? kd[1][s] : kd[0][s], qd[s], X);
        if (diag) {
#pragma unroll
            for (int i = 0; i < 16; ++i) if (crow(i, hh) > r) X[i] = 0.f; }
        const bf16x8 pf0 = pack8(X[0], X[1], X[2], X[3], X[4], X[5], X[6], X[7]), pf1 = pack8(X[8], X[9], X[10], X[11], X[12], X[13], X[14], X[15]);
        o = MFMA32(cat4(vtr(va + (32 * mt) * VP), vtr(va + (32 * mt + 8) * VP)), pf0, o);
        o = MFMA32(cat4(vtr(va + (32 * mt + 16) * VP), vtr(va + (32 * mt + 24) * VP)), pf1, o);
    }
#pragma unroll
    for (int s = 0; s < 4; ++s) o = MFMA32(sfr[s], qd[s], o);
    float ss = 0.f;
#pragma unroll
    for (int i = 0; i < 16; ++i) ss += o[i] * o[i];
    ss += __shfl_xor(ss, 32);
    LAS float* red = (LAS float*)(C.lds + RED);
    if (hh == 0) red[dvt * 64 + 32 * lt + r] = ss;
    __syncthreads();
    const int l = 32 * lt + r; const float rstd = rsqrtf((red[l] + red[64 + l] + red[128 + l] + red[192 + l]) * (1.f / 128.f) + EPS);
#pragma unroll
    for (int k4 = 0; k4 < 4; ++k4) { const int d0 = 32 * dvt + 8 * k4 + 4 * hh;
        const float ga = bflo(graw[k4].x), gb = bfhi(graw[k4].x), gc = bflo(graw[k4].y), gd = bfhi(graw[k4].y); const f32x4 gnv = gn[k4];
        const float y0 = o[4 * k4] * rstd * gnv.x * (ga / (1.f + __expf(-ga))), y1 = o[4 * k4 + 1] * rstd * gnv.y * (gb / (1.f + __expf(-gb)));
        const float y2 = o[4 * k4 + 2] * rstd * gnv.z * (gc / (1.f + __expf(-gc))), y3 = o[4 * k4 + 3] * rstd * gnv.w * (gd / (1.f + __expf(-gd)));
        v2u wv; wv.x = pk2(y0, y1); wv.y = pk2(y2, y3); *(v2u*)(C.CONCAT + tl * D + h * 128 + d0) = wv; }
    __syncthreads();
}

#define INS16(L, xin) do { int x_ = (xin); _Pragma("unroll") for (int i_ = 0; i_ < 16; ++i_) { const int hi_ = max(L[i_], x_); x_ = min(L[i_], x_); L[i_] = hi_; } } while (0)
#define CE_DESC(a, b) do { const int hi_ = max(a, b), lo_ = min(a, b); a = hi_; b = lo_; } while (0)
#define BITONIC_MERGE16(L) do { _Pragma("unroll") for (int j_ = 8; j_ > 0; j_ >>= 1) _Pragma("unroll") for (int i_ = 0; i_ < 16; ++i_) if ((i_ & j_) == 0) CE_DESC(L[i_], L[i_ | j_]); } while (0)
#define SORT16(L) do { _Pragma("unroll") for (int k_ = 2; k_ <= 16; k_ <<= 1) _Pragma("unroll") for (int j_ = k_ >> 1; j_ > 0; j_ >>= 1) _Pragma("unroll") for (int i_ = 0; i_ < 16; ++i_) { const int l_ = i_ ^ j_; \
        if (l_ > i_) { if ((i_ & k_) == 0) CE_DESC(L[i_], L[l_]); else CE_DESC(L[l_], L[i_]); } } } while (0)
#define MERGE16(L, M) do { _Pragma("unroll") for (int i_ = 0; i_ < 16; ++i_) L[i_] = max(L[i_], M[15 - i_]); BITONIC_MERGE16(L); } while (0)
__device__ __forceinline__ int ord_key(float v) { int u = __float_as_int(v); return u ^ ((u >> 31) & 0x7fffffff); }
__device__ __forceinline__ float ord_val(int k, int mask) { int u = k & ~mask; return __int_as_float(u ^ ((u >> 31) & 0x7fffffff)); }
__device__ __forceinline__ void peer_topk_item(const Ctx& C, int tg, int hd, const LAS unsigned char* qlds, int lrow0) {
    const int lane = C.lane, r = lane & 31, hh = lane >> 5; const size_t tok = (size_t)tg * 32 + r;
    int La[16], Lb[16];
#pragma unroll
    for (int c = 0; c < 2; ++c) {
        int L[16];
#pragma unroll
        for (int i = 0; i < 16; ++i) L[i] = (int)0x80000000;
        bf16x8 qf[8];
        { const int row = lrow0 + r;
#pragma unroll
          for (int s = 0; s < 8; ++s) qf[s] = *(const LAS bf16x8*)(qlds + row * 512 + 16 * ((16 * c + 2 * s + hh) ^ (row & 15))); }
        int G[16];
        bf16x8 kfA[8], kfB[8];
#define PT_KLOAD(dst, kt) do { const bf16* kp_ = C.KEYSB + ((size_t)(hd * 2 + c) * 128 + 32 * (kt) + r) * 128 + 8 * hh; _Pragma("unroll") for (int s = 0; s < 8; ++s) dst[s] = *(const bf16x8*)(kp_ + 16 * s); } while (0)
#define PT_TILE(src, kt) do { f32x16 X; _Pragma("unroll") for (int i = 0; i < 16; ++i) X[i] = 0.f; _Pragma("unroll") for (int s = 0; s < 8; ++s) X = MFMA32(src[s], qf[s], X); \
            _Pragma("unroll") for (int i = 0; i < 16; ++i) G[i] = (ord_key(X[i]) & ~127) | (32 * (kt) + crow(i, hh)); SORT16(G); MERGE16(L, G); } while (0)
        PT_KLOAD(kfA, 0);
#pragma unroll 1
        for (int k2 = 0; k2 < 2; ++k2) {
            PT_KLOAD(kfB, 2 * k2 + 1);
            PT_TILE(kfA, 2 * k2);
            if (k2 == 0) PT_KLOAD(kfA, 2);
            PT_TILE(kfB, 2 * k2 + 1);
        }
#undef PT_KLOAD
#undef PT_TILE
        int M[16];
#pragma unroll
        for (int i = 0; i < 16; ++i) M[i] = __shfl_xor(L[i], 32);
        MERGE16(L, M);
#pragma unroll
        for (int i = 0; i < 16; ++i) { if (c == 0) La[i] = L[i]; else Lb[i] = L[i]; }
    }
    float sa[16], sb[16]; int Lc[16];
#pragma unroll
    for (int i = 0; i < 16; ++i) { sa[i] = ord_val(La[i], 127); sb[i] = ord_val(Lb[i], 127); Lc[i] = (int)0x80000000; }
#pragma unroll
    for (int i = 0; i < 16; ++i)
#pragma unroll
        for (int j = 0; j < 16; ++j) if ((i + 1) * (j + 1) <= 16) INS16(Lc, (ord_key(sa[i] + sb[j]) & ~255) | (i * 16 + j));
    float e[16], sum = 0.f; int ex[16]; const float mx = ord_val(Lc[0], 255);
#pragma unroll
    for (int i = 0; i < 16; ++i) {
        e[i] = __expf(ord_val(Lc[i], 255) - mx); sum += e[i];
        const int ii = (Lc[i] >> 4) & 15, jj = Lc[i] & 15; int i1 = 0, i2 = 0;
#pragma unroll
        for (int q = 0; q < 16; ++q) { i1 = (ii == q) ? (La[q] & 127) : i1; i2 = (jj == q) ? (Lb[q] & 127) : i2; }
        ex[i] = i1 * 128 + i2;
    }
    const float inv = 1.f / sum;
    if (hh == 0) {
        v4u* ep = (v4u*)(C.EXPI + tok * 128 + hd * 16); f32x4* gp = (f32x4*)(C.GATE + tok * 128 + hd * 16); f32x4* up = (f32x4*)(C.GU + tok * 128 + hd * 16); v4u* ap = (v4u*)(C.ACT + tok * 128 + hd * 16);
        const float hs = C.HS[tok];
#pragma unroll
        for (int q = 0; q < 4; ++q) { ep[q] = (v4u){(unsigned)ex[4 * q], (unsigned)ex[4 * q + 1], (unsigned)ex[4 * q + 2], (unsigned)ex[4 * q + 3]};
            gp[q] = (f32x4){e[4 * q] * inv * C.VS[ex[4 * q]], e[4 * q + 1] * inv * C.VS[ex[4 * q + 1]], e[4 * q + 2] * inv * C.VS[ex[4 * q + 2]], e[4 * q + 3] * inv * C.VS[ex[4 * q + 3]]};
            up[q] = (f32x4){hs * C.US[ex[4 * q]], hs * C.US[ex[4 * q + 1]], hs * C.US[ex[4 * q + 2]], hs * C.US[ex[4 * q + 3]]};
            ap[q] = (v4u){0u, 0u, 0u, 0u}; }
    }
}

__device__ __forceinline__ int peer_dequeue(const Ctx& C, unsigned* cnt, int xcc) {
    volatile LAS int* slot = (volatile LAS int*)(C.lds + MISC_OFF + 64);
    __syncthreads();
    if (C.tid == 0) { int res = -1;
        for (int s = 0; s < NSL; ++s) { const int sl = (xcc + s) & (NSL - 1);
            if (__hip_atomic_load(cnt + 64 * sl, __ATOMIC_RELAXED, __HIP_MEMORY_SCOPE_AGENT) >= (unsigned)NCHUNK) continue;
            const unsigned id = atomicAdd(cnt + 64 * sl, 1u); if (id < (unsigned)NCHUNK) { res = sl * NCHUNK + (int)id; break; } }
        *slot = res; }
    __syncthreads();
    return *slot;
}
#define ROWSUM16(d) do { d += __builtin_amdgcn_update_dpp(0, d, 0x121, 0xf, 0xf, false); d += __builtin_amdgcn_update_dpp(0, d, 0x122, 0xf, 0xf, false); \
                         d += __builtin_amdgcn_update_dpp(0, d, 0x124, 0xf, 0xf, false); d += __builtin_amdgcn_update_dpp(0, d, 0x128, 0xf, 0xf, false); } while (0)
#define PA_ISSUE1(buf, esrc, j_) buf[j_] = *(const v4u*)(tab + (size_t)__builtin_amdgcn_ds_swizzle(esrc, ((j_) << 5) | 0x10) * SLW)
#define PA_ISSUE(buf, esrc) do { PA_ISSUE1(buf, esrc, 0); PA_ISSUE1(buf, esrc, 1); PA_ISSUE1(buf, esrc, 2); PA_ISSUE1(buf, esrc, 3); PA_ISSUE1(buf, esrc, 4); PA_ISSUE1(buf, esrc, 5); PA_ISSUE1(buf, esrc, 6); PA_ISSUE1(buf, esrc, 7); \
        PA_ISSUE1(buf, esrc, 8); PA_ISSUE1(buf, esrc, 9); PA_ISSUE1(buf, esrc, 10); PA_ISSUE1(buf, esrc, 11); PA_ISSUE1(buf, esrc, 12); PA_ISSUE1(buf, esrc, 13); PA_ISSUE1(buf, esrc, 14); PA_ISSUE1(buf, esrc, 15); } while (0)
#define PA_COMPUTE(buf, hq_, dstv) do { _Pragma("unroll") for (int j_ = 0; j_ < 16; ++j_) { const v4u u_ = buf[j_]; \
        int d_ = __builtin_amdgcn_sdot4((int)hq_.x, (int)u_.x, 0, false); d_ = __builtin_amdgcn_sdot4((int)hq_.y, (int)u_.y, d_, false); d_ = __builtin_amdgcn_sdot4((int)hq_.z, (int)u_.z, d_, false); d_ = __builtin_amdgcn_sdot4((int)hq_.w, (int)u_.w, d_, false); \
        ROWSUM16(d_); dstv = (i == j_) ? d_ : dstv; } } while (0)
__device__ __forceinline__ void peer_a_chunk(const Ctx& C, int t0, int x, int* act) {
    const int lane = C.lane, i = lane & 15;
    v4u hq[8]; int el[8], eh[8];
#pragma unroll
    for (int tt = 0; tt < 8; ++tt) { hq[tt] = __builtin_nontemporal_load((const v4u*)(C.HQ + ((size_t)x * T + t0 + tt) * SLW + 16 * i)); el[tt] = __builtin_nontemporal_load(C.EXPI + (size_t)(t0 + tt) * 128 + lane); eh[tt] = __builtin_nontemporal_load(C.EXPI + (size_t)(t0 + tt) * 128 + 64 + lane); }
    const unsigned char* tab = C.UQ + (size_t)x * NEXP * SLW + 16 * i;
    v4u bA[16], bB[16];
    PA_ISSUE(bA, el[0]);
#pragma unroll
    for (int tt = 0; tt < 8; ++tt) {
        PA_ISSUE(bB, eh[tt]);
        int r_lo = 0, r_hi = 0;
        PA_COMPUTE(bA, hq[tt], r_lo);
        if (tt + 1 < 8) PA_ISSUE(bA, el[tt + 1]);
        PA_COMPUTE(bB, hq[tt], r_hi);
        atomicAdd(act + (size_t)(t0 + tt) * 128 + lane, r_lo); atomicAdd(act + (size_t)(t0 + tt) * 128 + 64 + lane, r_hi);
    }
}
#undef PA_ISSUE
#undef PA_ISSUE1
#undef PA_COMPUTE
#define PB_ISSUE(buf, esrc) do { _Pragma("unroll") for (int j_ = 0; j_ < 16; ++j_) { const int e_ = __builtin_amdgcn_ds_bpermute(4 * (16 * (j_ >> 2) + 4 * g + (j_ & 3)), esrc); buf[j_] = *(const v4u*)(tab + (size_t)e_ * SLW); } } while (0)
#define PB_TR4(r0_, r1_, r2_, r3_, wp_, base) do { const unsigned t0_ = __builtin_amdgcn_perm(r1_, r0_, 0x05010400u), t1_ = __builtin_amdgcn_perm(r1_, r0_, 0x07030602u), t2_ = __builtin_amdgcn_perm(r3_, r2_, 0x05010400u), t3_ = __builtin_amdgcn_perm(r3_, r2_, 0x07030602u); \
        c[(base)] = __builtin_amdgcn_sdot4((int)__builtin_amdgcn_perm(t2_, t0_, 0x05040100u), wp_, c[(base)], false); c[(base) + 1] = __builtin_amdgcn_sdot4((int)__builtin_amdgcn_perm(t2_, t0_, 0x07060302u), wp_, c[(base) + 1], false); \
        c[(base) + 2] = __builtin_amdgcn_sdot4((int)__builtin_amdgcn_perm(t3_, t1_, 0x05040100u), wp_, c[(base) + 2], false); c[(base) + 3] = __builtin_amdgcn_sdot4((int)__builtin_amdgcn_perm(t3_, t1_, 0x07060302u), wp_, c[(base) + 3], false); } while (0)
#define PB_COMPUTE(buf, psrc) do { _Pragma("unroll") for (int jb_ = 0; jb_ < 4; ++jb_) { const int wp_ = __builtin_amdgcn_ds_bpermute(4 * (16 * jb_ + 4 * g), (int)psrc); \
        PB_TR4(buf[4 * jb_].x, buf[4 * jb_ + 1].x, buf[4 * jb_ + 2].x, buf[4 * jb_ + 3].x, wp_, 0); PB_TR4(buf[4 * jb_].y, buf[4 * jb_ + 1].y, buf[4 * jb_ + 2].y, buf[4 * jb_ + 3].y, wp_, 4); \
        PB_TR4(buf[4 * jb_].z, buf[4 * jb_ + 1].z, buf[4 * jb_ + 2].z, buf[4 * jb_ + 3].z, wp_, 8); PB_TR4(buf[4 * jb_].w, buf[4 * jb_ + 1].w, buf[4 * jb_ + 2].w, buf[4 * jb_ + 3].w, wp_, 12); } } while (0)
__device__ __forceinline__ int isum_swap16(int v) { auto r = __builtin_amdgcn_permlane16_swap((unsigned)v, (unsigned)v, false, false); return (int)r[0] + (int)r[1]; }
__device__ __forceinline__ int isum_swap32(int v) { auto r = __builtin_amdgcn_permlane32_swap((unsigned)v, (unsigned)v, false, false); return (int)r[0] + (int)r[1]; }
__device__ __forceinline__ void peer_b_chunk(const Ctx& C, int t0, int x, float* dst) {
    const int lane = C.lane, i = lane & 15, g = lane >> 4, b = t0 / SEQ;
    int el[8], eh[8]; unsigned pl[8], ph[8]; float ws[8];
#pragma unroll
    for (int tt = 0; tt < 8; ++tt) { const size_t o = (size_t)(t0 + tt) * 128 + lane;
        el[tt] = __builtin_nontemporal_load(C.EXPI + o); eh[tt] = __builtin_nontemporal_load(C.EXPI + o + 64);
        const float a_lo = (float)__builtin_nontemporal_load(C.ACT + o) * __builtin_nontemporal_load(C.GU + o), a_hi = (float)__builtin_nontemporal_load(C.ACT + o + 64) * __builtin_nontemporal_load(C.GU + o + 64);
        const float w_lo = __builtin_nontemporal_load(C.GATE + o) * 0.5f * a_lo * (1.f + erff(a_lo * 0.70710678118654752f)), w_hi = __builtin_nontemporal_load(C.GATE + o + 64) * 0.5f * a_hi * (1.f + erff(a_hi * 0.70710678118654752f));
        const float wm = wave_max(fmaxf(fabsf(w_lo), fabsf(w_hi))), winv = wm > 0.f ? 127.f / wm : 0.f; ws[tt] = wm * (1.f / 127.f);
        unsigned p_lo = (unsigned)((int)rintf(w_lo * winv) & 0xff), p_hi = (unsigned)((int)rintf(w_hi * winv) & 0xff);
        p_lo |= (unsigned)__builtin_amdgcn_update_dpp(0, (int)p_lo, 0xB1, 0xf, 0xf, false) << 8; p_lo |= (unsigned)__builtin_amdgcn_update_dpp(0, (int)p_lo, 0x4E, 0xf, 0xf, false) << 16;
        p_hi |= (unsigned)__builtin_amdgcn_update_dpp(0, (int)p_hi, 0xB1, 0xf, 0xf, false) << 8; p_hi |= (unsigned)__builtin_amdgcn_update_dpp(0, (int)p_hi, 0x4E, 0xf, 0xf, false) << 16;
        pl[tt] = p_lo; ph[tt] = p_hi; }
    const unsigned char* tab = C.VQ + (size_t)x * NEXP * SLW + 16 * i;
    const int d0 = x * SLW + 16 * i + 4 * g; const f32x4 gm = *(const f32x4*)(C.MOD + b * NMOD + 5 * D + d0);
    v4u bA[16], bB[16];
    PB_ISSUE(bA, el[0]);
#pragma unroll
    for (int tt = 0; tt < 8; ++tt) {
        PB_ISSUE(bB, eh[tt]);
        const size_t off = (size_t)(t0 + tt) * D + d0; const f32x4 x1 = __builtin_nontemporal_load((const f32x4*)(C.out + off));
        int c[16];
#pragma unroll
        for (int q = 0; q < 16; ++q) c[q] = 0;
        PB_COMPUTE(bA, pl[tt]);
        if (tt + 1 < 8) PB_ISSUE(bA, el[tt + 1]);
        PB_COMPUTE(bB, ph[tt]);
#pragma unroll
        for (int q = 0; q < 16; ++q) c[q] = isum_swap32(isum_swap16(c[q]));
        f32x4 o;
#pragma unroll
        for (int q = 0; q < 4; ++q) o[q] = (float)(g == 0 ? c[q] : g == 1 ? c[4 + q] : g == 2 ? c[8 + q] : c[12 + q]) * ws[tt];
        __builtin_nontemporal_store(x1 + gm * o, (f32x4*)(dst + off));
    }
}
#undef PB_ISSUE
#undef PB_COMPUTE
#undef PB_TR4
template <int STAGE> __device__ __forceinline__ void peer_expert_phase(const Ctx& C, float* dst, int rep) {
    const int xcc = (int)(xb_xcc_id() & (NSL - 1)); unsigned* cnt = C.ctl + (STAGE == 0 ? CW_QA : CW_QB) + 64 * NSL * rep;
    for (;;) {
        const int id = peer_dequeue(C, cnt, xcc); if (id < 0) break;
        const int x = id / NCHUNK, t0 = (id % NCHUNK) * PCH + C.wave * (PCH / NWAVES);
        if (STAGE == 0) peer_a_chunk(C, t0, x, rep ? (int*)C.QP : C.ACT); else peer_b_chunk(C, t0, x, dst);
    }
}

__device__ __forceinline__ void first_unit(int nM, int nN, int G, int c, int& pm, int& pn) {
    const int nwg = nM * nN; if (c >= nwg) { pm = -1; pn = 0; return; }
    int wgid = c; { const int q = nwg / 8, r = nwg % 8, xcd = wgid % 8, off = wgid / 8; wgid = (xcd < r ? xcd * (q + 1) : r * (q + 1) + (xcd - r) * q) + off; }
    const int nig = 8 * nN, gid = wgid / nig, fm = gid * 8, gsz = (nM - fm) < 8 ? (nM - fm) : 8;
    pm = fm + ((wgid % nig) % gsz); pn = (wgid % nig) / gsz; (void)G;
}
struct Args { const void* in[18]; float* out; unsigned char* ws; int ph_lo, ph_hi; };
__global__ void __launch_bounds__(NTHREADS, 2) fwd_kernel(Args args) {
    extern __shared__ __attribute__((aligned(16))) unsigned char lds[];
    Ctx C;
    C.lds = (LAS unsigned char*)lds; C.tid = threadIdx.x; C.lane = C.tid & 63; C.wave = __builtin_amdgcn_readfirstlane(C.tid >> 6);
    C.G = gridDim.x; { const int bx = blockIdx.x; C.vcu = (C.G % 8 == 0) ? (bx % 8) * (C.G / 8) + bx / 8 : bx; }
    C.gw = C.vcu * NWAVES + C.wave; C.ngw = C.G * NWAVES;
    C.x = (const float*)args.in[0]; C.c = (const float*)args.in[1]; C.pos = (const int*)args.in[2]; C.w_ada = (const float*)args.in[3]; C.b_ada = (const float*)args.in[4]; C.g1 = (const float*)args.in[5];
    C.w_in = (const float*)args.in[6]; C.w_a2 = (const float*)args.in[7]; C.b_a = (const float*)args.in[8]; C.gla_g = (const float*)args.in[9]; C.qg = (const float*)args.in[10]; C.kg = (const float*)args.in[11];
    C.w_out = (const float*)args.in[12]; C.g2 = (const float*)args.in[13]; C.w_q = (const float*)args.in[14]; C.keys = (const float*)args.in[15]; C.pu = (const float*)args.in[16]; C.pv = (const float*)args.in[17];
    C.out = args.out; unsigned char* ws = args.ws;
#define CTX_WS_PTRS() do { C.ctl = (unsigned*)(ws + WS_CTL); C.MODI = (long long*)(C.ctl + CW_MOD); C.MOD = (float*)(ws + WS_MODF); C.WIN = (bf16*)(ws + WS_WIN); C.WGA = (bf16*)(ws + WS_WGA); C.WOUT = (bf16*)(ws + WS_WOUT); C.WQ = (bf16*)(ws + WS_WQ); C.KEYSB = (bf16*)(ws + WS_KEYS); C.UQ = ws + WS_UB; C.VQ = ws + WS_VB; C.HQ = ws + WS_HQ; C.US = (float*)(ws + WS_US); C.VS = (float*)(ws + WS_VS); C.HS = (float*)(ws + WS_HS); C.GU = (float*)(ws + WS_GU); C.ACT = (int*)(ws + WS_ACT); C.QDEC = (bf16*)(ws + WS_QDEC); C.KDEC = (bf16*)(ws + WS_KDEC); C.KUPD = (bf16*)(ws + WS_KUPD); C.PART = (bf16*)(ws + WS_PART); C.ML = (float*)(ws + WS_ML); C.LIST = (unsigned short*)(ws + WS_LIST); C.SEL = (unsigned short*)(ws + WS_SEL); C.H = (bf16*)(ws + WS_H); C.CONCAT = (bf16*)(ws + WS_CONCAT); C.PROJ = (bf16*)(ws + WS_PROJ); C.ST = (bf16*)(ws + WS_ST); C.CS = (float*)(ws + WS_CS); C.KMEAN = (float*)(ws + WS_KMEAN); C.DEC = (float*)(ws + WS_DEC); C.BCUM = (float*)(ws + WS_BCUM); C.UT = (float*)(ws + WS_UT); C.QP = (float*)(ws + WS_QP); C.GATE = (float*)(ws + WS_GATE); C.EXPI = (int*)(ws + WS_EXP); } while (0)
    CTX_WS_PTRS();
    for (int u = C.tid; u < (LDS_BYTES - RING_BYTES) / 4; u += NTHREADS) ((LAS unsigned*)(C.lds + RING_BYTES))[u] = 0u;
    __syncthreads();
    const int lo = args.ph_lo, hi = args.ph_hi;
    if (PROBE_TS >= 0 && blockIdx.x == 0 && threadIdx.x == 0) ((volatile LAS unsigned long long*)(C.lds + RING_BYTES + 8192))[0] = __builtin_amdgcn_s_memrealtime();
    XcdBarrier bar; bar.bar = C.ctl + CW_BAR; bar.x = 0; bar.st = nullptr;
    if (hi - lo > 1) bar = xcd_barrier_post(C.ctl + CW_BAR, (volatile LAS unsigned*)(C.lds + MISC_OFF) + 8);
#ifndef SKIPMASK
#define SKIPMASK 0
#endif
#ifndef REPEATMASK
#define REPEATMASK 0
#endif
#define IN(k) (!((SKIPMASK >> (k)) & 1) && lo <= (k) && (k) < hi)
#define REP(k, ...) do { if ((REPEATMASK >> (k)) & 1) { const int rep_ = 1; (void)rep_; __VA_ARGS__; xcd_barrier(bar); } { const int rep_ = 0; (void)rep_; __VA_ARGS__; } } while (0)
#define SEAM(k) do { if (IN(k) && IN((k) + 1)) xcd_barrier(bar); if (PROBE_TS >= 0 && blockIdx.x == 0 && threadIdx.x == 0) ((volatile LAS unsigned long long*)(C.lds + RING_BYTES + 8192))[(k) + 1] = __builtin_amdgcn_s_memrealtime(); { int t_ = C.tid; asm volatile("" : "+v"(t_)); C.tid = t_; C.lane = t_ & 63; } CTX_WS_PTRS(); } while (0)
    if (IN(0)) REP(0, p0_phase(C, rep_)); SEAM(0);
    if (IN(1)) REP(1, norm_mod_phase<true>(C, C.x, C.g1, 0, D, C.H)); SEAM(1);
    if (IN(2)) REP(2, pg8::Gemm g{C.H, C.WIN, T, NPROJ, D}; pg8::StaticOrder S; S.init(T, NPROJ, C.G, (int)blockIdx.x); pg8::EpiBf16<0> E{C.PROJ, NPROJ, nullptr, 0, 0, 1.f};
                 pg8::gemm_phase<pg8::EpiBf16<0>, pg8::StaticOrder, PG8_ALIGN, PG8_SP2>(C.lds, g, S, E)); SEAM(2);
    if (IN(3)) REP(3, for (int it = C.vcu; it < 256 + 256; it += C.G) { if (it < 256) moba_prep_item(C, it >> 7, (it >> 4) & 7, it & 15, rep_); else gla_prep_item(C, (it - 256) >> 7, ((it - 256) >> 1) & 63, it & 1); }); SEAM(3);
    if (IN(4)) REP(4, for (int it = C.vcu; it < 256; it += C.G) moba_select_item(C, it >> 7, (it >> 4) & 7, it & 15, rep_)); SEAM(4);
    if (IN(5)) REP(5, p5_attn_phase(C, rep_)); SEAM(5);
    if (IN(6)) REP(6, p5_phase(C)); SEAM(6);
    if (IN(7)) REP(7, for (int it = C.vcu; it < 1024; it += C.G) gla_out_item(C, it >> 9, (it >> 6) & 7, it & 63); for (int t = C.gw; t < T; t += C.ngw) moba_merge_token(C, (size_t)t)); SEAM(7);
    if (IN(8)) REP(8, pg8::Gemm g{C.CONCAT, C.WOUT, T, D, D}; pg8::StaticOrder S; S.init(T, D, C.G, (int)blockIdx.x); pg8::EpiResGate E{C.x, C.out, D, C.MOD + 2 * D, NMOD, SEQ / 256};
                 pg8::gemm_phase<pg8::EpiResGate, pg8::StaticOrder, PG8_ALIGN, PG8_SP2>(C.lds, g, S, E)); SEAM(8);
    if (IN(9)) REP(9, norm_mod_phase<false>(C, C.out, C.g2, 3 * D, 4 * D, C.H)); SEAM(9);
    if (IN(10)) REP(10, int upm_ = -1; int upn_ = 0; first_unit(T / 256, D / 256, C.G, (int)blockIdx.x, upm_, upn_);
                 { pg8::Gemm g{C.H, C.WQ, T, D, D}; pg8::StaticOrder S; S.init(T, D, C.G, (int)blockIdx.x); pg8::EpiLdsTile E{}; pg8::gemm_phase<pg8::EpiLdsTile, pg8::StaticOrder, false, PG8_SP2>(C.lds, g, S, E); }
                 __syncthreads(); if (upm_ >= 0) peer_topk_item(C, upm_ * 8 + C.wave, upn_, C.lds, 32 * C.wave); __syncthreads()); SEAM(10);
    if (IN(11)) REP(11, peer_expert_phase<0>(C, nullptr, rep_)); SEAM(11);
    if (IN(12)) REP(12, peer_expert_phase<1>(C, rep_ ? C.QP : C.out, rep_));
    if (PROBE_TS >= 0) { xcd_barrier(bar); if (blockIdx.x == 0 && threadIdx.x == 0) { volatile LAS unsigned long long* ts = (volatile LAS unsigned long long*)(C.lds + RING_BYTES + 8192); const unsigned long long tend = __builtin_amdgcn_s_memrealtime();
        const unsigned long long d = (PROBE_TS == 12 ? tend : ts[PROBE_TS + 1]) - ts[PROBE_TS]; C.out[0] += (float)d * 0.001f; } }
#undef IN
#undef SEAM
}

extern "C" void kernel_launch(void* const* d_in, const int* in_sizes, int n_in, void* d_out, int out_size, void* d_ws, size_t ws_size, hipStream_t stream) {
    static int grid = 0;
    if (grid == 0) {
        if (n_in != 18 || in_sizes[0] != T * D || out_size != T * D || ws_size < WS_END) { fprintf(stderr, "kernel_launch: shape/workspace mismatch (n_in %d, in0 %d, out %d, ws %zu, need %zu); nothing launched\n", n_in, n_in > 0 ? in_sizes[0] : -1, out_size, ws_size, (size_t)WS_END); grid = -1; return; }
        int dev = 0, cus = 0, per_cu = 0;
        if (hipGetDevice(&dev) != hipSuccess || hipDeviceGetAttribute(&cus, hipDeviceAttributeMultiprocessorCount, dev) != hipSuccess) { fprintf(stderr, "kernel_launch: device query failed\n"); grid = -1; return; }
        if (hipFuncSetAttribute((const void*)fwd_kernel, hipFuncAttributeMaxDynamicSharedMemorySize, LDS_BYTES) != hipSuccess) { fprintf(stderr, "kernel_launch: hipFuncSetAttribute failed\n"); grid = -1; return; }
        if (hipOccupancyMaxActiveBlocksPerMultiprocessor(&per_cu, (const void*)fwd_kernel, NTHREADS, LDS_BYTES) != hipSuccess || per_cu < 1) { fprintf(stderr, "kernel_launch: occupancy query reports %d workgroups per CU\n", per_cu); (void)hipGetLastError(); grid = -1; return; }
        grid = cus;
    }
    if (grid < 0) return;
    if (hipMemsetAsync((char*)d_ws + WS_CTL, 0, CTL_ZERO_BYTES, stream) != hipSuccess) { fprintf(stderr, "kernel_launch: memset failed\n"); return; }
    Args a{};
    for (int i = 0; i < 18; ++i) a.in[i] = d_in[i];
    a.out = (float*)d_out; a.ws = (unsigned char*)d_ws;
#if MK_N_LAUNCHES == 1
    a.ph_lo = 0; a.ph_hi = N_PHASES;
    void* kargs[] = {&a};
#if defined(MK_PLAIN_LAUNCH)
    (void)kargs; hipLaunchKernelGGL(fwd_kernel, dim3(grid), dim3(NTHREADS), LDS_BYTES, stream, a);
#else
    hipError_t le = hipLaunchCooperativeKernel((const void*)fwd_kernel, dim3(grid), dim3(NTHREADS), kargs, LDS_BYTES, stream);
    if (le != hipSuccess) fprintf(stderr, "kernel_launch: cooperative launch failed: %s (grid %d)\n", hipGetErrorName(le), grid);
#endif
#else
    for (int p = 0; p < N_PHASES; ++p) { a.ph_lo = p; a.ph_hi = p + 1; hipLaunchKernelGGL(fwd_kernel, dim3(grid), dim3(NTHREADS), LDS_BYTES, stream, a); }
#endif
}
```

```cpp
#define REPEATMASK 0
#include <hip/hip_runtime.h>
#include <hip/hip_bf16.h>
#include <cstdio>
#include <cstdint>
#include <cmath>
namespace pg8 {
#define PG8_LAS __attribute__((address_space(3)))
typedef unsigned short bf16_t;
typedef short bf16x8 __attribute__((ext_vector_type(8)));
typedef float f32x4 __attribute__((ext_vector_type(4)));
typedef unsigned u32x4 __attribute__((ext_vector_type(4)));
constexpr int BM = 256, BK = 64, HALF = 128, HTB = HALF * BK * 2  , STAGE_BYTES = 8 * HTB, NXCD = 8, WGM = 8;

__host__ __device__ __forceinline__ int lds_byte(int r, int c) { const int st = (r >> 4) * 2 + (c >> 5), rr = r & 15, cc = c & 31, ob = rr * 64 + cc * 2; return st * 1024 + (ob ^ (((ob >> 9) & 1) << 5)); }
__host__ __device__ __forceinline__ void stage_rc(int b, int& R, int& C) { const int st = b / 1024, sb = b % 1024, swz = sb ^ (((sb >> 9) & 1) << 5); R = (st >> 1) * 16 + swz / 64; C = (st & 1) * 32 + (swz % 64) / 2; }
__host__ __device__ __forceinline__ int perm32(int rho) { const int n = rho >> 4, i = rho & 15; return 8 * (i >> 2) + 4 * n + (i & 3); }

struct Unit { int pm, pn; };
struct Gemm { const bf16_t* A; const bf16_t* Bt; int M, N, K; };

struct StaticOrder {
    int nM, nN, nwg, G, c;
    __host__ __device__ void init(int M, int N, int G_, int c_) { nM = M / BM; nN = N / BM; nwg = nM * nN; G = G_; c = c_; }
    __host__ __device__ bool next(int i, Unit& u) const {
        const long L = (long)i * G + c; if (L >= nwg) return false;
        int wgid = (int)L; { const int q = nwg / NXCD, r = nwg % NXCD, xcd = wgid % NXCD, off = wgid / NXCD; wgid = (xcd < r ? xcd * (q + 1) : r * (q + 1) + (xcd - r) * q) + off; }
        const int nig = WGM * nN, gid = wgid / nig, fm = gid * WGM, gsz = (nM - fm) < WGM ? (nM - fm) : WGM;
        u.pm = fm + ((wgid % nig) % gsz); u.pn = (wgid % nig) / gsz; return true;
    }
    __device__ __forceinline__ void a_ready(const Unit&) const {}
    __device__ __forceinline__ void done(const Unit&) const {}
};

__device__ __forceinline__ unsigned cvt_pk_bf16(float lo, float hi) { unsigned r; asm volatile("v_cvt_pk_bf16_f32 %0, %1, %2" : "=v"(r) : "v"(lo), "v"(hi)); return r; }
typedef float f32x2 __attribute__((ext_vector_type(2)));
__device__ __forceinline__ f32x2 gelu_pk(f32x2 v) {
    const f32x2 av = __builtin_elementwise_abs(v), d = av * 0.2316418882f + 1.0f;
    f32x2 t; t.x = __builtin_amdgcn_rcpf(d.x); t.y = __builtin_amdgcn_rcpf(d.y);
    f32x2 q = t * 0.5307027145f + (-0.7265760135f); q = q * t + 0.7107068705f; q = q * t + (-0.142248368f); q = q * t + 0.127414796f; q = q * t;
    const f32x2 s = (v * v) * (-0.72134752044f);
    f32x2 e; e.x = __builtin_amdgcn_exp2f(s.x); e.y = __builtin_amdgcn_exp2f(s.y);
    const f32x2 m = v * (q * e), r = v - m;
    f32x2 o; o.x = v.x < 0.f ? m.x : r.x; o.y = v.y < 0.f ? m.y : r.y; return o;
}

template <int ACT  > struct EpiBf16 {
    static constexpr bool PERM = true, AFTER_DRAIN = false; static_assert(ACT == 0 || ACT == 1, "EpiBf16: ACT is 0 (none) or 1 (gelu_pk)");
    bf16_t* O; int ldc; const float* bias; int split_cols; size_t split_stride; float scale0;
    __device__ __forceinline__ void operator()(const f32x4 (&acc)[2][2][4][2], const Unit& u, int wr, int wc, int fr, int fq) const {
        const int row0 = u.pm * BM + wr * 64 + fr; int colt = u.pn * BM; bf16_t* base = O;
        float sc = 1.f; if (split_cols) { const int t = colt / split_cols; base += (size_t)t * split_stride; colt -= t * split_cols; if (t == 0) sc = scale0; }
        const int col0 = colt + wc * 32 + 8 * fq, bcol0 = u.pn * BM + wc * 32 + 8 * fq;
        f32x4 bv[2][2];
#pragma unroll
        for (int bj = 0; bj < 2; ++bj)
#pragma unroll
            for (int n = 0; n < 2; ++n) bv[bj][n] = bias ? *(const f32x4*)(bias + bcol0 + bj * HALF + 4 * n) : (f32x4){0.f, 0.f, 0.f, 0.f};
#pragma unroll
        for (int ai = 0; ai < 2; ++ai)
#pragma unroll
            for (int m = 0; m < 4; ++m) { bf16_t* rowp = base + (size_t)(row0 + ai * HALF + m * 16) * ldc + col0;
#pragma unroll
                for (int bj = 0; bj < 2; ++bj) { f32x4 v0 = acc[ai][bj][m][0] + bv[bj][0], v1 = acc[ai][bj][m][1] + bv[bj][1];
                    if (ACT == 1) { f32x2 a = gelu_pk((f32x2){v0[0], v0[1]}), b = gelu_pk((f32x2){v0[2], v0[3]}), c = gelu_pk((f32x2){v1[0], v1[1]}), d = gelu_pk((f32x2){v1[2], v1[3]});
                        v0 = (f32x4){a.x, a.y, b.x, b.y}; v1 = (f32x4){c.x, c.y, d.x, d.y}; }
                    v0 = v0 * sc; v1 = v1 * sc; u32x4 w; w.x = cvt_pk_bf16(v0[0], v0[1]); w.y = cvt_pk_bf16(v0[2], v0[3]); w.z = cvt_pk_bf16(v1[0], v1[1]); w.w = cvt_pk_bf16(v1[2], v1[3]);
                    *(u32x4*)(rowp + bj * HALF) = w; } }
    }
};
struct EpiF32 {
    static constexpr bool PERM = false, AFTER_DRAIN = false;
    float* C; int ldc; const float* bias;
    __device__ __forceinline__ void operator()(const f32x4 (&acc)[2][2][4][2], const Unit& u, int wr, int wc, int fr, int fq) const {
        const int row0 = u.pm * BM + wr * 64 + fr, col0 = u.pn * BM + wc * 32 + 4 * fq;
        f32x4 bv[2][2];
#pragma unroll
        for (int bj = 0; bj < 2; ++bj)
#pragma unroll
            for (int n = 0; n < 2; ++n) bv[bj][n] = bias ? *(const f32x4*)(bias + col0 + bj * HALF + n * 16) : (f32x4){0.f, 0.f, 0.f, 0.f};
#pragma unroll
        for (int ai = 0; ai < 2; ++ai)
#pragma unroll
            for (int m = 0; m < 4; ++m) { float* rowp = C + (size_t)(row0 + ai * HALF + m * 16) * ldc + col0;
#pragma unroll
                for (int bj = 0; bj < 2; ++bj)
#pragma unroll
                    for (int n = 0; n < 2; ++n) *(f32x4*)(rowp + bj * HALF + n * 16) = acc[ai][bj][m][n] + bv[bj][n]; }
    }
};
struct EpiResGate {
    static constexpr bool PERM = false, AFTER_DRAIN = false;
    const float* X; float* O; int ldc; const float* gate; int gate_stride, tiles_per_batch;
    __device__ __forceinline__ void operator()(const f32x4 (&acc)[2][2][4][2], const Unit& u, int wr, int wc, int fr, int fq) const {
        const int row0 = u.pm * BM + wr * 64 + fr, col0 = u.pn * BM + wc * 32 + 4 * fq;
        const float* gp = gate + (size_t)(u.pm / tiles_per_batch) * gate_stride;
        f32x4 gv[2][2];
#pragma unroll
        for (int bj = 0; bj < 2; ++bj)
#pragma unroll
            for (int n = 0; n < 2; ++n) gv[bj][n] = *(const f32x4*)(gp + col0 + bj * HALF + n * 16);
        f32x4 xv[2][2][2];
#define ERG_LOAD(idx, slot) do { const size_t off_ = (size_t)(row0 + ((idx) >> 2) * HALF + ((idx) & 3) * 16) * ldc + col0; _Pragma("unroll") for (int bj = 0; bj < 2; ++bj) _Pragma("unroll") for (int n = 0; n < 2; ++n) xv[slot][bj][n] = *(const f32x4*)(X + off_ + bj * HALF + n * 16); } while (0)
        ERG_LOAD(0, 0); ERG_LOAD(1, 1);
#pragma unroll
        for (int idx = 0; idx < 8; ++idx) { const int ai = idx >> 2, m = idx & 3; const size_t off = (size_t)(row0 + ai * HALF + m * 16) * ldc + col0;
#pragma unroll
            for (int bj = 0; bj < 2; ++bj)
#pragma unroll
                for (int n = 0; n < 2; ++n) *(f32x4*)(O + off + bj * HALF + n * 16) = xv[idx & 1][bj][n] + gv[bj][n] * acc[ai][bj][m][n];
            if (idx + 2 < 8) ERG_LOAD(idx + 2, idx & 1); }
#undef ERG_LOAD
    }
};

struct EpiLdsTile {
    static constexpr bool PERM = true, AFTER_DRAIN = true;
    __device__ __forceinline__ void operator()(const f32x4 (&)[2][2][4][2], const Unit&, int, int, int, int) const {}
    __device__ __forceinline__ void fused(f32x4 (&acc)[2][2][4][2], const Unit&, int wr, int wc, int fr, int fq, PG8_LAS unsigned char* lds, int, int) const {
#pragma unroll
        for (int ai = 0; ai < 2; ++ai)
#pragma unroll
            for (int m = 0; m < 4; ++m) { const int row = ai * HALF + wr * 64 + m * 16 + fr;
#pragma unroll
                for (int bj = 0; bj < 2; ++bj) { const f32x4 v0 = acc[ai][bj][m][0], v1 = acc[ai][bj][m][1]; u32x4 w; w.x = cvt_pk_bf16(v0[0], v0[1]); w.y = cvt_pk_bf16(v0[2], v0[3]); w.z = cvt_pk_bf16(v1[0], v1[1]); w.w = cvt_pk_bf16(v1[2], v1[3]);
                    const int chunk = 16 * bj + 4 * wc + fq; *(PG8_LAS u32x4*)(lds + row * 512 + 16 * (chunk ^ (row & 15))) = w; } }
    }
};

template <class Epi, class Sched, bool ALIGN_EPI = false, bool SP2 = false>
__device__ __forceinline__ void gemm_phase(PG8_LAS unsigned char* lds, const Gemm g, const Sched& S, const Epi& E) {
    const int tid = threadIdx.x, wid = __builtin_amdgcn_readfirstlane(tid >> 6), lane = tid & 63, wr = wid >> 2, wc = wid & 3, fr = lane & 15, fq = lane >> 4;
    const int K = g.K, nt = K / BK;
    unsigned voffA[2], voffB[2];
#pragma unroll
    for (int i = 0; i < 2; ++i) { int R, C; stage_rc(tid * 16 + i * 8192, R, C); const int Rb = Epi::PERM ? ((R & ~31) + perm32(R & 31)) : R;
        voffA[i] = (unsigned)(R * K + C) * 2u; voffB[i] = (unsigned)(Rb * K + C) * 2u; }
    const size_t kstep = (size_t)(BK * 2);
    const size_t hstep = (size_t)HALF * K * 2;
    const size_t tstep = 2 * hstep;
    const unsigned ldsw = (unsigned)wid * 1024u;
    const int aoff = lds_byte(wr * 64 + fr, fq * 8), boff = lds_byte(wc * 32 + fr, fq * 8);
#define PG8_SA(b, h) (((b) * 2 + (h)) * HTB)
#define PG8_SB(b, h) ((4 + (b) * 2 + (h)) * HTB)
#define PG8_STAGE(bufoff, gbase, voff) do { _Pragma("unroll") for (int _i = 0; _i < 2; ++_i) \
        __builtin_amdgcn_global_load_lds((const unsigned*)((const char*)(gbase) + (voff)[_i]), (PG8_LAS unsigned*)(lds + (bufoff) + ldsw + _i * 8192), 16, 0, 0); } while (0)
#define PG8_LDA(dst, b, h) do { _Pragma("unroll") for (int m = 0; m < 4; ++m) _Pragma("unroll") for (int k = 0; k < 2; ++k) dst[m][k] = *(const PG8_LAS bf16x8*)(lds + PG8_SA(b, h) + aoff + m * 2048 + k * 1024); } while (0)
#define PG8_LDB(dst, b, h) do { _Pragma("unroll") for (int n = 0; n < 2; ++n) _Pragma("unroll") for (int k = 0; k < 2; ++k) dst[n][k] = *(const PG8_LAS bf16x8*)(lds + PG8_SB(b, h) + boff + n * 2048 + k * 1024); } while (0)
#define PG8_MMA(ai, bj, At, Bt) do { __builtin_amdgcn_s_setprio(1); _Pragma("unroll") for (int m = 0; m < 4; ++m) _Pragma("unroll") for (int n = 0; n < 2; ++n) _Pragma("unroll") for (int k = 0; k < 2; ++k) \
        acc[ai][bj][m][n] = __builtin_amdgcn_mfma_f32_16x16x32_bf16(Bt[n][k], At[m][k], acc[ai][bj][m][n], 0, 0, 0); __builtin_amdgcn_s_setprio(0); } while (0)
#define PG8_WAIT_V(n) asm volatile("s_waitcnt vmcnt(" #n ")" ::: "memory")
#define PG8_WAIT_L(n) asm volatile("s_waitcnt lgkmcnt(" #n ")" ::: "memory")
#define PG8_BAR __builtin_amdgcn_s_barrier()
#define PG8_SCHED __builtin_amdgcn_sched_barrier(0)
    Unit cur, nxt; int ui = 0;
    if (!S.next(0, cur)) return;
    f32x4 acc[2][2][4][2];
#pragma unroll
    for (int a = 0; a < 2; ++a)
#pragma unroll
        for (int b = 0; b < 2; ++b)
#pragma unroll
            for (int m = 0; m < 4; ++m)
#pragma unroll
                for (int n = 0; n < 2; ++n) acc[a][b][m][n] = (f32x4){0.f, 0.f, 0.f, 0.f};
    bf16x8 At[4][2], B0[2][2], B1[2][2];
    const char* cA = (const char*)g.A + (size_t)cur.pm * tstep; const char* cB = (const char*)g.Bt + (size_t)cur.pn * tstep;
    S.a_ready(cur);
    if constexpr (SP2) {
        PG8_STAGE(PG8_SB(0, 0), cB, voffB); PG8_STAGE(PG8_SB(0, 1), cB + hstep, voffB); PG8_STAGE(PG8_SA(0, 0), cA, voffA); PG8_STAGE(PG8_SA(0, 1), cA + hstep, voffA);
        if (wr == 1) PG8_BAR;
        PG8_WAIT_V(2); PG8_BAR;
        PG8_STAGE(PG8_SB(1, 0), cB + kstep, voffB); PG8_STAGE(PG8_SA(1, 0), cA + kstep, voffA); PG8_STAGE(PG8_SB(1, 1), cB + hstep + kstep, voffB);
        PG8_WAIT_V(6); PG8_BAR;
    } else {
        PG8_STAGE(PG8_SB(0, 0), cB, voffB); PG8_STAGE(PG8_SA(0, 0), cA, voffA); PG8_STAGE(PG8_SB(0, 1), cB + hstep, voffB); PG8_STAGE(PG8_SA(0, 1), cA + hstep, voffA);
        if (wr == 1) PG8_BAR;
        PG8_WAIT_V(4); PG8_BAR;
        PG8_STAGE(PG8_SB(1, 0), cB + kstep, voffB); PG8_STAGE(PG8_SA(1, 0), cA + kstep, voffA); PG8_STAGE(PG8_SB(1, 1), cB + hstep + kstep, voffB);
        PG8_WAIT_V(6); PG8_BAR;
    }
    for (;;) {
        const bool has_next = S.next(ui + 1, nxt);
        const char* nA = has_next ? (const char*)g.A + (size_t)nxt.pm * tstep : cA; const char* nB = has_next ? (const char*)g.Bt + (size_t)nxt.pn * tstep : cB;
        for (int t = 0; t < nt; t += 2) {
            const bool last = (t == nt - 2);
            const char* a1 = cA + (size_t)(t + 1) * kstep;
            const char* a2 = last ? nA : cA + (size_t)(t + 2) * kstep; const char* b2 = last ? nB : cB + (size_t)(t + 2) * kstep;
            const char* a3 = a2 + kstep; const char* b3 = b2 + kstep;
            if (last && has_next) S.a_ready(nxt);
            if constexpr (SP2) {
            PG8_LDB(B0, 0, 0); PG8_LDB(B1, 0, 1); PG8_SCHED; PG8_LDA(At, 0, 0); PG8_STAGE(PG8_SA(1, 1), a1 + hstep, voffA);
            PG8_WAIT_V(8); PG8_WAIT_L(0); PG8_BAR; PG8_MMA(0, 0, At, B0); PG8_MMA(0, 1, At, B1); PG8_BAR; PG8_SCHED;
            PG8_LDA(At, 0, 1); PG8_STAGE(PG8_SB(0, 0), b2, voffB); PG8_STAGE(PG8_SB(0, 1), b2 + hstep, voffB); PG8_STAGE(PG8_SA(0, 0), a2, voffA);
            PG8_WAIT_V(8); PG8_WAIT_L(0); PG8_BAR; PG8_MMA(1, 0, At, B0); PG8_MMA(1, 1, At, B1); PG8_BAR; PG8_SCHED;
            PG8_LDB(B0, 1, 0); PG8_LDB(B1, 1, 1); PG8_SCHED; PG8_LDA(At, 1, 0); PG8_STAGE(PG8_SA(0, 1), a2 + hstep, voffA);
            PG8_WAIT_V(8); PG8_WAIT_L(0); PG8_BAR; PG8_MMA(0, 0, At, B0); PG8_MMA(0, 1, At, B1); PG8_BAR; PG8_SCHED;
            PG8_LDA(At, 1, 1); PG8_STAGE(PG8_SB(1, 0), b3, voffB); PG8_STAGE(PG8_SB(1, 1), b3 + hstep, voffB); PG8_STAGE(PG8_SA(1, 0), a3, voffA);
            PG8_WAIT_V(8); PG8_WAIT_L(0); PG8_BAR; PG8_MMA(1, 0, At, B0); PG8_MMA(1, 1, At, B1); PG8_BAR; PG8_SCHED;
            } else {
            PG8_LDB(B0, 0, 0); PG8_SCHED; PG8_LDA(At, 0, 0); PG8_STAGE(PG8_SA(1, 1), a1 + hstep, voffA);
            PG8_WAIT_L(8); PG8_BAR; PG8_WAIT_L(0); PG8_MMA(0, 0, At, B0); PG8_BAR; PG8_SCHED;
            PG8_LDB(B1, 0, 1); PG8_STAGE(PG8_SB(0, 0), b2, voffB);
            PG8_BAR; PG8_WAIT_L(0); PG8_MMA(0, 1, At, B1); PG8_BAR;
            PG8_LDA(At, 0, 1); PG8_STAGE(PG8_SA(0, 0), a2, voffA);
            PG8_BAR; PG8_WAIT_L(0); PG8_MMA(1, 0, At, B0); PG8_BAR; PG8_SCHED;
            PG8_STAGE(PG8_SB(0, 1), b2 + hstep, voffB);
            PG8_WAIT_V(6); PG8_BAR; PG8_MMA(1, 1, At, B1); PG8_BAR;
            PG8_LDB(B0, 1, 0); PG8_SCHED; PG8_LDA(At, 1, 0); PG8_STAGE(PG8_SA(0, 1), a2 + hstep, voffA);
            PG8_WAIT_L(8); PG8_BAR; PG8_WAIT_L(0); PG8_MMA(0, 0, At, B0); PG8_BAR; PG8_SCHED;
            PG8_LDB(B1, 1, 1); PG8_STAGE(PG8_SB(1, 0), b3, voffB);
            PG8_BAR; PG8_WAIT_L(0); PG8_MMA(0, 1, At, B1); PG8_BAR;
            PG8_LDA(At, 1, 1); PG8_STAGE(PG8_SA(1, 0), a3, voffA);
            PG8_BAR; PG8_WAIT_L(0); PG8_MMA(1, 0, At, B0); PG8_BAR; PG8_SCHED;
            PG8_STAGE(PG8_SB(1, 1), b3 + hstep, voffB);
            PG8_WAIT_V(6); PG8_BAR; PG8_MMA(1, 1, At, B1); PG8_BAR;
            }
        }
        if constexpr (ALIGN_EPI) { if (wr == 0) PG8_BAR; }
        if constexpr (!Epi::AFTER_DRAIN) { E(acc, cur, wr, wc, fr, fq); S.done(cur); }
        if (!has_next) break;
#pragma unroll
        for (int a = 0; a < 2; ++a)
#pragma unroll
            for (int b = 0; b < 2; ++b)
#pragma unroll
                for (int m = 0; m < 4; ++m)
#pragma unroll
                    for (int n = 0; n < 2; ++n) acc[a][b][m][n] = (f32x4){0.f, 0.f, 0.f, 0.f};
        cur = nxt; cA = nA; cB = nB; ++ui;
        if constexpr (ALIGN_EPI) { if (wr == 1) PG8_BAR; }
    }
    PG8_WAIT_V(0);
    if constexpr (!ALIGN_EPI) { if (wr == 0) PG8_BAR; }
    PG8_BAR;
    if constexpr (Epi::AFTER_DRAIN) { E.fused(acc, cur, wr, wc, fr, fq, lds, wid, lane); S.done(cur); }
#undef PG8_SA
#undef PG8_SB
#undef PG8_STAGE
#undef PG8_LDA
#undef PG8_LDB
#undef PG8_MMA
#undef PG8_WAIT_V
#undef PG8_WAIT_L
#undef PG8_BAR
#undef PG8_SCHED
}
}

#ifndef PG8_SP2
#define PG8_SP2 true
#endif
#ifndef PG8_ALIGN
#define PG8_ALIGN true
#endif
constexpr int NWAVES = 8, NTHREADS = NWAVES * 64;
constexpr int BATCH = 2, SEQ = 4096, T = BATCH * SEQ, D = 2048;
constexpr int INW = 6160, NPROJ = 6144;
constexpr int GQ = 0, GK = 512, GV = 1024, GG = 2048, MQ = 3072, MK = 4096, MV = 5120;
constexpr int GA_SRC = 3072;
constexpr int NH = 8, NEXP = 16384, NMOD = 6 * D;
constexpr float EPS = 1e-6f;
#ifndef MK_N_LAUNCHES
#define MK_N_LAUNCHES 1
#endif
constexpr int N_PHASES = 13;
#ifndef P3_GLA_TWICE
#define P3_GLA_TWICE 0
#endif
#ifndef PROBE_TS
#define PROBE_TS -1
#endif
constexpr int NSL = 8, SLW = 256, PCH = 64, NCHUNK = (BATCH * SEQ) / PCH;

constexpr size_t MiB = 1u << 20;
constexpr size_t WS_CTL = 0, CTL_ZERO_BYTES = 1 * MiB;
constexpr size_t WS_WIN = 1 * MiB, WS_WGA = 25 * MiB, WS_WOUT = 26 * MiB, WS_WQ = 34 * MiB, WS_KEYS = 42 * MiB, WS_CS = 43 * MiB, WS_KMEAN = 44 * MiB, WS_DEC = 45 * MiB;
constexpr size_t WS_UB = 46 * MiB, WS_VB = 110 * MiB, WS_H = 174 * MiB, WS_CONCAT = 206 * MiB, WS_BCUM = 238 * MiB, WS_UT = 254 * MiB, WS_ST = 286 * MiB, WS_PROJ = 302 * MiB;
constexpr size_t WS_QP = WS_PROJ, WS_EXP = 366 * MiB, WS_GATE = 370 * MiB, WS_GU = 374 * MiB, WS_ACT = 378 * MiB, WS_HQ = 382 * MiB, WS_QDEC = 398 * MiB, WS_KDEC = 406 * MiB, WS_KUPD = 414 * MiB, WS_PART = 422 * MiB, WS_ML = 486 * MiB, WS_LIST = 488 * MiB, WS_SEL = 492 * MiB, WS_PW = 493 * MiB, WS_WSC = 494 * MiB, WS_END = 495 * MiB;
constexpr size_t WS_US = WS_UB + 40 * MiB, WS_VS = WS_VB + 40 * MiB, WS_HS = WS_VB + 41 * MiB;
constexpr int CW_BAR = 4096, CW_Q = 8192, CW_QA = 12288, CW_QB = 13312, CW_LCNT = 14336, CW_MOD = 16384;
static_assert((CW_MOD + 2 * BATCH * NMOD) * 4 <= (int)CTL_ZERO_BYTES, "CTL words inside the memset region");
constexpr size_t WS_MODF = 45 * MiB + 512 * 1024;

constexpr int RING_BYTES = 131072, MISC_OFF = RING_BYTES + 320, LDS_BYTES = 147456;

#define GAS __attribute__((address_space(1)))
#define LAS __attribute__((address_space(3)))
typedef unsigned short bf16;
typedef unsigned v4u __attribute__((ext_vector_type(4)));
typedef unsigned v2u __attribute__((ext_vector_type(2)));
typedef float f32x4 __attribute__((ext_vector_type(4)));
typedef float f32x2 __attribute__((ext_vector_type(2)));
typedef float f32x16 __attribute__((ext_vector_type(16)));
typedef short bf16x8 __attribute__((ext_vector_type(8)));
typedef short s16x4 __attribute__((ext_vector_type(4)));
typedef __bf16 bf16x2_t __attribute__((ext_vector_type(2)));
typedef GAS unsigned gu32;
#define LDS_WAIT() asm volatile("s_waitcnt lgkmcnt(0)" ::: "memory")
#define VM_WAIT() asm volatile("s_waitcnt vmcnt(0)" ::: "memory")
__device__ __forceinline__ unsigned pk2(float lo, float hi) { f32x2 v = {lo, hi}; bf16x2_t b = __builtin_convertvector(v, bf16x2_t); return __builtin_bit_cast(unsigned, b); }
__device__ __forceinline__ float bflo(unsigned u) { return __uint_as_float(u << 16); }
__device__ __forceinline__ float bfhi(unsigned u) { return __uint_as_float(u & 0xffff0000u); }
__device__ __forceinline__ float bf1(short s) { return __uint_as_float(((unsigned)(unsigned short)s) << 16); }
__device__ __forceinline__ bf16x8 pack8(float a0, float a1, float a2, float a3, float a4, float a5, float a6, float a7) { v4u w; w.x = pk2(a0, a1); w.y = pk2(a2, a3); w.z = pk2(a4, a5); w.w = pk2(a6, a7); return __builtin_bit_cast(bf16x8, w); }
__device__ __forceinline__ int crow(int r, int hi) { return (r & 3) + 8 * (r >> 2) + 4 * hi; }
__device__ __forceinline__ float wave_sum(float v) {
#pragma unroll
    for (int o = 1; o < 64; o <<= 1) v += __shfl_xor(v, o);
    return v;
}
typedef short v4i16_t __attribute__((ext_vector_type(4)));
__device__ __forceinline__ s16x4 vtr(const LAS unsigned char* p) { return __builtin_bit_cast(s16x4, __builtin_amdgcn_ds_read_tr16_b64_v4i16((LAS v4i16_t*)p)); }
__device__ __forceinline__ bf16x8 cat4(s16x4 lo, s16x4 hi) { return (bf16x8){lo[0], lo[1], lo[2], lo[3], hi[0], hi[1], hi[2], hi[3]}; }
#define MFMA32(a, b, c) __builtin_amdgcn_mfma_f32_32x32x16_bf16((a), (b), (c), 0, 0, 0)
#define XB_TMO      128
#define XB_XCNT(j)  (256  + 64 * (j))
#define XB_XSUB(j)  (1280 + 64 * (j))
#define XB_XGEN(j)  (2304 + 64 * (j))
#define XB_TOP      3328
#define XB_TOPGEN   3392
#define XCD_BAR_WORDS 3456
#define XB_SPIN_CAP (1u << 18)

__device__ __forceinline__ unsigned xb_ld(unsigned* p)              { return __hip_atomic_load(p, __ATOMIC_RELAXED, __HIP_MEMORY_SCOPE_AGENT); }
__device__ __forceinline__ unsigned xb_add(unsigned* p, unsigned v) { return __hip_atomic_fetch_add(p, v, __ATOMIC_RELAXED, __HIP_MEMORY_SCOPE_AGENT); }
__device__ __forceinline__ unsigned xb_xcc_id() { return (unsigned)__builtin_amdgcn_s_getreg((3 << 11) | 20) & 0xFu; }
#define XB_SPIN(cond, bar) do { unsigned _sp = 0; while (cond) { __builtin_amdgcn_s_sleep(1); \
    if ((++_sp & 255u) == 0u) { if (xb_ld(&(bar)[XB_TMO])) break; if (_sp > XB_SPIN_CAP) { atomicAdd(&(bar)[XB_TMO], 1u); break; } } } } while (0)

struct XcdBarrier {
    unsigned* bar; unsigned x;
    volatile LAS unsigned* st;
};

__device__ __forceinline__ XcdBarrier xcd_barrier_post(unsigned* bar, volatile LAS unsigned* st) {
    XcdBarrier b; b.bar = bar; b.x = xb_xcc_id(); b.st = st;
    if (threadIdx.x == 0) (void)xb_add(&bar[XB_XCNT(b.x)], 1u);
    return b;
}
__device__ __forceinline__ void xcd_barrier_complete(unsigned* bar, unsigned x, unsigned& nloc, unsigned& nx) {
    const unsigned G = gridDim.x * gridDim.y * gridDim.z;
    unsigned sum, cnt, mine, sp = 0u;
    for (;;) {
        sum = 0u; cnt = 0u; mine = 0u;
#pragma unroll
        for (unsigned j = 0; j < 16; ++j) { const unsigned c = xb_ld(&bar[XB_XCNT(j)]); sum += c; cnt += (c > 0u) ? 1u : 0u; mine = (j == x) ? c : mine; }
        if (sum == G) break;
        __builtin_amdgcn_s_sleep(1);
        if ((++sp & 255u) == 0u) { if (xb_ld(&bar[XB_TMO])) break; if (sp > XB_SPIN_CAP) { atomicAdd(&bar[XB_TMO], 1u); break; } }
    }
    nloc = mine > 0u ? mine : 1u; nx = cnt > 0u ? cnt : 1u;
}

__device__ __forceinline__ void xcd_barrier(const XcdBarrier& b) {
    asm volatile("s_waitcnt vmcnt(0)" ::: "memory");
    __syncthreads();
    if (threadIdx.x == 0) {
        unsigned* bar = b.bar;
        __builtin_amdgcn_s_waitcnt(0);
        unsigned nloc = b.st[0], nx = b.st[1];
        if (nloc == 0u) { xcd_barrier_complete(bar, b.x, nloc, nx); b.st[0] = nloc; b.st[1] = nx; }
        const unsigned old = xb_add(&bar[XB_XSUB(b.x)], 1u);
        const unsigned gen = old / nloc;
        if (old + 1u == (gen + 1u) * nloc) {
            __builtin_amdgcn_fence(__ATOMIC_RELEASE, "agent");
            asm volatile("s_waitcnt vmcnt(0)" ::: "memory");
            const unsigned og = xb_add(&bar[XB_TOP], 1u);
            const unsigned tg = og / nx;
            if (og + 1u == (tg + 1u) * nx) xb_add(&bar[XB_TOPGEN], 1u);
            else XB_SPIN(xb_ld(&bar[XB_TOPGEN]) == tg, bar);
            __builtin_amdgcn_fence(__ATOMIC_ACQUIRE, "agent");
            xb_add(&bar[XB_XGEN(b.x)], 1u);
            asm volatile("s_waitcnt vmcnt(0)" ::: "memory");
        } else {
            XB_SPIN(xb_ld(&bar[XB_XGEN(b.x)]) == gen, bar);
            __builtin_amdgcn_fence(__ATOMIC_ACQUIRE, "agent");
            asm volatile("s_waitcnt vmcnt(0)" ::: "memory");
        }
    }
    __syncthreads();
}

struct Ctx {
    LAS unsigned char* lds;
    int tid, lane, wave, vcu, G, gw, ngw;
    const float *x, *c; const int* pos; const float *w_ada, *b_ada, *g1, *w_in, *w_a2, *b_a, *gla_g, *qg, *kg, *w_out, *g2, *w_q, *keys, *pu, *pv;
    float* out;
    unsigned* ctl; long long* MODI; float* MOD;
    bf16 *WIN, *WGA, *WOUT, *WQ, *KEYSB, *H, *CONCAT, *PROJ, *ST, *QDEC, *KDEC, *KUPD, *PART; float* ML; unsigned short *LIST, *SEL; unsigned* PW; float* WSC;
    unsigned char *UQ, *VQ, *HQ;
    float *CS, *KMEAN, *DEC, *BCUM, *UT, *QP, *GATE, *GU, *US, *VS, *HS; int *EXPI, *ACT;
};

__device__ __forceinline__ void transpose_item(const float* W, int ldw, int K, bf16* WT, int dst_row0, int k0, int n0, LAS float* scr, int lane) {
#pragma unroll 8
    for (int i = 0; i < 32; ++i) { const int kk = 2 * i + (lane >> 5); scr[kk * 33 + (lane & 31)] = W[(size_t)(k0 + kk) * ldw + n0 + (lane & 31)]; }
    LDS_WAIT(); asm volatile("" ::: "memory");
    const int c = lane & 7;
#pragma unroll
    for (int j = 0; j < 4; ++j) { const int n = (lane >> 3) + 8 * j; const LAS float* s = scr + (8 * c) * 33 + n;
        v4u o; o.x = pk2(s[0 * 33], s[1 * 33]); o.y = pk2(s[2 * 33], s[3 * 33]); o.z = pk2(s[4 * 33], s[5 * 33]); o.w = pk2(s[6 * 33], s[7 * 33]);
        *(v4u*)(WT + (size_t)(dst_row0 + n) * K + k0 + 8 * c) = o; }
    LDS_WAIT(); asm volatile("" ::: "memory");
}
__device__ __forceinline__ void convert_item(const float* src, bf16* dst, size_t item, int lane) {
    const f32x4* s = (const f32x4*)(src + item * 8192) + 2 * lane; v4u* d = (v4u*)(dst + item * 8192) + lane;
#pragma unroll 4
    for (int it = 0; it < 16; ++it) { const f32x4 a = s[it * 128], b = s[it * 128 + 1]; v4u o; o.x = pk2(a.x, a.y); o.y = pk2(a.z, a.w); o.z = pk2(b.x, b.y); o.w = pk2(b.z, b.w); d[it * 64] = o; }
}
__device__ __forceinline__ float wave_max(float v) {
#pragma unroll
    for (int o = 1; o < 64; o <<= 1) v = fmaxf(v, __shfl_xor(v, o));
    return v;
}
__device__ __forceinline__ void quant_store(const f32x4 (&v)[8], unsigned char* dst, float* scales, int row, size_t nrows, int lane, int bias) {
    float am = 0.f;
#pragma unroll
    for (int j = 0; j < 8; ++j) am = fmaxf(am, fmaxf(fmaxf(fabsf(v[j].x), fabsf(v[j].y)), fmaxf(fabsf(v[j].z), fabsf(v[j].w))));
    am = wave_max(am);
    const float inv = am > 0.f ? 127.f / am : 0.f;
    if (lane == 0) scales[row] = am > 0.f ? am / 127.f : 1.f;
#pragma unroll
    for (int j = 0; j < 8; ++j) { const int q0 = (int)rintf(v[j].x * inv) + bias, q1 = (int)rintf(v[j].y * inv) + bias, q2 = (int)rintf(v[j].z * inv) + bias, q3 = (int)rintf(v[j].w * inv) + bias;
        *(unsigned*)(dst + ((size_t)j * nrows + row) * 256 + 4 * lane) = (unsigned)(q0 & 0xff) | ((unsigned)(q1 & 0xff) << 8) | ((unsigned)(q2 & 0xff) << 16) | ((unsigned)(q3 & 0xff) << 24); }
}
__device__ __forceinline__ void quant_row(const float* src, unsigned char* dst, float* scales, int row, size_t nrows, int lane, int bias) {
    const f32x4* s = (const f32x4*)src + lane; f32x4 v[8];
#pragma unroll
    for (int j = 0; j < 8; ++j) v[j] = s[64 * j];
    quant_store(v, dst, scales, row, nrows, lane, bias);
}
__device__ __forceinline__ void p0_phase(const Ctx& C, int rep) {
    const int lane = C.lane, gw = C.gw, ngw = C.ngw;
    LAS float* sc = (LAS float*)C.lds;
    LAS float* part = sc + BATCH * D;
    for (int i = C.tid; i < BATCH * D; i += NTHREADS) { const float v = C.c[i]; sc[i] = v / (1.f + __expf(-v)); }
    __syncthreads();
    for (int it = C.vcu; it < 192; it += C.G) {
        const int cq = lane & 15, rg = lane >> 4, col = it * 64 + 4 * cq, r0 = 256 * C.wave + rg;
        const f32x4* w = (const f32x4*)(C.w_ada + (size_t)r0 * NMOD + col); const LAS float* s0 = sc + r0; const LAS float* s1 = sc + D + r0;
        f32x4 a0 = {0.f, 0.f, 0.f, 0.f}, a1 = a0;
#pragma unroll 16
        for (int k = 0; k < 64; ++k) { const f32x4 wv = w[(size_t)k * NMOD]; a0 += s0[4 * k] * wv; a1 += s1[4 * k] * wv; }
#pragma unroll
        for (int q = 0; q < 4; ++q) { a0[q] += __shfl_xor(a0[q], 16); a0[q] += __shfl_xor(a0[q], 32); a1[q] += __shfl_xor(a1[q], 16); a1[q] += __shfl_xor(a1[q], 32); }
        if (rg == 0) { *(LAS f32x4*)(part + (C.wave * 2 + 0) * 64 + 4 * cq) = a0; *(LAS f32x4*)(part + (C.wave * 2 + 1) * 64 + 4 * cq) = a1; }
        __syncthreads();
        if (C.tid < 128) { const int bb = C.tid >> 6, cl = C.tid & 63; float s = 0.f;
#pragma unroll
            for (int ww = 0; ww < 8; ++ww) s += part[(ww * 2 + bb) * 64 + cl];
            C.MOD[bb * NMOD + it * 64 + cl] = s + C.b_ada[it * 64 + cl]; }
        __syncthreads();
    }
    LAS float* scr = (LAS float*)(C.lds + C.wave * 16384);
    constexpr int I_IN = 32 * 192, I_SQ = 32 * 64;
    for (int it = gw; it < I_IN + 2 * I_SQ; it += ngw) {
        int r = it;
        if (r < I_IN) { const int kb = r / 192, nb = r % 192, n0 = 32 * nb; transpose_item(C.w_in, INW, D, C.WIN, n0, 64 * kb, n0 < 3072 ? n0 : n0 + 16, scr, lane); continue; } r -= I_IN;
        if (r < I_SQ) { transpose_item(C.w_out, D, D, C.WOUT, 32 * (r % 64), 64 * (r / 64), 32 * (r % 64), scr, lane); continue; } r -= I_SQ;
        transpose_item(C.w_q, D, D, C.WQ, 32 * (r % 64), 64 * (r / 64), 32 * (r % 64), scr, lane);
    }
    for (int it = gw; it < 32; it += ngw) { const int k = it * 64 + lane; const f32x4* s = (const f32x4*)(C.w_in + (size_t)k * INW + GA_SRC);
#pragma unroll
        for (int q = 0; q < 4; ++q) { const f32x4 v = s[q]; C.WGA[(4 * q + 0) * D + k] = (bf16)(pk2(v.x, 0.f) & 0xffff); C.WGA[(4 * q + 1) * D + k] = (bf16)(pk2(v.y, 0.f) & 0xffff);
            C.WGA[(4 * q + 2) * D + k] = (bf16)(pk2(v.z, 0.f) & 0xffff); C.WGA[(4 * q + 3) * D + k] = (bf16)(pk2(v.w, 0.f) & 0xffff); } }
    for (int it = gw; it < NEXP; it += ngw) {
        const f32x4* su = (const f32x4*)(C.pu + (size_t)it * D) + lane; const f32x4* sv = (const f32x4*)(C.pv + (size_t)it * D) + lane; f32x4 vu[8], vv[8];
#pragma unroll
        for (int j = 0; j < 8; ++j) { vu[j] = su[64 * j]; vv[j] = sv[64 * j]; }
        quant_store(vu, C.UQ, C.US, it, NEXP, lane, 0); quant_store(vv, C.VQ, C.VS, it, NEXP, lane, 0);
    }
    for (int it = gw; it < 32; it += ngw) convert_item(C.keys, C.KEYSB, it, lane);
    for (int idx = C.vcu * NTHREADS + C.tid; idx < T * 16; idx += C.G * NTHREADS) {
        const int t = idx >> 4, f = idx & 15; const float inv = powf(500000.0f, -(float)f * 0.0625f); const float ang = (float)C.pos[t] * inv;
        C.CS[2 * idx] = cosf(ang); C.CS[2 * idx + 1] = sinf(ang);
    }
}

__device__ __forceinline__ float modi_to_f32(long long v) { return (float)(int)(v >> 32) * 0.00390625f + (float)(unsigned)v * 9.094947017729282e-13f; }
template <bool FIRST> __device__ __forceinline__ void norm_mod_phase(const Ctx& C, const float* X, const float* g, int shift_off, int scale_off, bf16* O) {
    LAS float* lg = (LAS float*)C.lds; LAS float* lsh = lg + D; LAS float* lsc = lsh + BATCH * D;
    for (int i = C.tid; i < D; i += NTHREADS) lg[i] = g[i];
    for (int i = C.tid; i < BATCH * D; i += NTHREADS) { const int b = i / D, j = i % D;
        lsh[i] = C.MOD[b * NMOD + shift_off + j]; lsc[i] = 1.f + C.MOD[b * NMOD + scale_off + j]; }
    __syncthreads();
    for (int m = C.gw; m < T; m += C.ngw) {
        const int b = m / SEQ; const f32x4* xr = (const f32x4*)(X + (size_t)m * D) + C.lane;
        f32x4 v[8]; float ss = 0.f;
#pragma unroll
        for (int j = 0; j < 8; ++j) { v[j] = xr[64 * j]; ss += (v[j].x * v[j].x + v[j].y * v[j].y) + (v[j].z * v[j].z + v[j].w * v[j].w); }
        const float rstd = rsqrtf(wave_sum(ss) * (1.f / D) + EPS);
        const LAS f32x4* g4 = (const LAS f32x4*)lg + C.lane; const LAS f32x4* sh4 = (const LAS f32x4*)(lsh + b * D) + C.lane; const LAS f32x4* sc4 = (const LAS f32x4*)(lsc + b * D) + C.lane;
        v2u* o8 = (v2u*)(O + (size_t)m * D) + C.lane;
#pragma unroll
        for (int j = 0; j < 8; ++j) { const f32x4 y = v[j] * rstd * g4[64 * j] * sc4[64 * j] + sh4[64 * j]; v2u w; w.x = pk2(y.x, y.y); w.y = pk2(y.z, y.w); o8[64 * j] = w; v[j] = y; }
        if (!FIRST) quant_store(v, C.HQ, C.HS, m, T, C.lane, 0);
    }
    __syncthreads();
}

__device__ __forceinline__ void gla_prep_item(const Ctx& C, int b, int n, int ch) {
    const int lane = C.lane, w = C.wave, fr = lane & 15, fq = lane >> 4, rt = w & 3, kh = w >> 2; const size_t t0 = (size_t)b * SEQ + 64 * n;
    const bf16* ap = C.H + (t0 + 16 * rt + fr) * D + kh * 1024 + 8 * fq; const bf16* bp = C.WGA + fr * D + kh * 1024 + 8 * fq;
    f32x4 acc = {0.f, 0.f, 0.f, 0.f};
#pragma unroll 16
    for (int s = 0; s < 32; ++s) acc = __builtin_amdgcn_mfma_f32_16x16x32_bf16(*(const bf16x8*)(ap + 32 * s), *(const bf16x8*)(bp + 32 * s), acc, 0, 0, 0);
    LAS float* gaP = (LAS float*)C.lds;
#pragma unroll
    for (int r = 0; r < 4; ++r) gaP[kh * 1024 + (16 * rt + 4 * fq + r) * 16 + fr] = acc[r];
    __syncthreads();
    const int c = C.tid & 255, th = C.tid >> 8, col = ch * 256 + c; float wc[16];
#pragma unroll
    for (int r = 0; r < 16; ++r) wc[r] = C.w_a2[r * 512 + col];
    const float ba = C.b_a[col]; float cum = 0.f, la[32];
#pragma unroll
    for (int k = 0; k < 32; ++k) { const int tok = 32 * th + k;
        const LAS f32x4* g0 = (const LAS f32x4*)(gaP + tok * 16); const LAS f32x4* g1 = (const LAS f32x4*)(gaP + 1024 + tok * 16); float z = ba;
#pragma unroll
        for (int q = 0; q < 4; ++q) { const f32x4 gv = g0[q] + g1[q]; z += gv.x * wc[4 * q] + gv.y * wc[4 * q + 1] + gv.z * wc[4 * q + 2] + gv.w * wc[4 * q + 3]; }
        cum += (fminf(z, 0.f) - __logf(1.f + __expf(-fabsf(z)))) * 0.0625f; la[k] = cum; }
    if (th == 0) gaP[2048 + c] = cum;
    __syncthreads();
    const float base = th ? gaP[2048 + c] : 0.f;
    if (th == 1) gaP[2048 + 256 + c] = cum + base;
    __syncthreads();
    const float blast = gaP[2048 + 256 + c];
    if (th == 1) C.DEC[((size_t)(b * NH + (col >> 6)) * 64 + n) * 64 + (col & 63)] = __expf(blast);
    const bf16* qp = C.PROJ + (t0 + 32 * th) * NPROJ + GQ + col; const bf16* kp = C.PROJ + (t0 + 32 * th) * NPROJ + GK + col;
    bf16* qo = C.QDEC + (t0 + 32 * th) * 512 + col; bf16* ko = C.KDEC + (t0 + 32 * th) * 512 + col; bf16* uo = C.KUPD + (t0 + 32 * th) * 512 + col;
    unsigned short qr[32], kr[32];
#pragma unroll
    for (int k = 0; k < 32; ++k) { qr[k] = qp[(size_t)k * NPROJ]; kr[k] = kp[(size_t)k * NPROJ]; }
#pragma unroll
    for (int k = 0; k < 32; ++k) { const float bb = la[k] + base, qv = __uint_as_float((unsigned)qr[k] << 16), kv = __uint_as_float((unsigned)kr[k] << 16);
        qo[(size_t)k * 512] = (bf16)(pk2(qv * 0.125f * __expf(bb), 0.f) & 0xffffu); ko[(size_t)k * 512] = (bf16)(pk2(kv * __expf(-bb), 0.f) & 0xffffu); uo[(size_t)k * 512] = (bf16)(pk2(kv * __expf(blast - bb), 0.f) & 0xffffu); }
    __syncthreads();
}
__device__ __forceinline__ void moba_prep_item(const Ctx& C, int b, int h, int blk, int rep) {
    const int lane = C.lane, w = C.wave, i = lane & 15, tg = lane >> 4; const size_t t0 = (size_t)b * SEQ + 256 * blk;
    float qg[8], kg[8], km[8];
#pragma unroll
    for (int j = 0; j < 8; ++j) { qg[j] = C.qg[8 * i + j]; kg[j] = C.kg[8 * i + j]; km[j] = 0.f; }
    v4u rawq[8], rawk[8];
#pragma unroll
    for (int it = 0; it < 8; ++it) { const size_t tok = t0 + 32 * w + 4 * it + tg; rawq[it] = *(const v4u*)(C.PROJ + tok * NPROJ + MQ + h * 128 + 8 * i); rawk[it] = *(const v4u*)(C.PROJ + tok * NPROJ + MK + h * 128 + 8 * i); }
#pragma unroll
    for (int it = 0; it < 8; ++it) {
        const size_t tok = t0 + 32 * w + 4 * it + tg;
        float cs[16];
        if (i < 4) { const f32x4* cp = (const f32x4*)(C.CS + tok * 32 + (i & 1) * 16);
#pragma unroll
            for (int q = 0; q < 4; ++q) { const f32x4 v = cp[q]; cs[4 * q] = v.x; cs[4 * q + 1] = v.y; cs[4 * q + 2] = v.z; cs[4 * q + 3] = v.w; } }
        else {
#pragma unroll
            for (int q = 0; q < 16; ++q) cs[q] = 0.f; }
#pragma unroll
        for (int which = 0; which < 2; ++which) {
            bf16* p = C.PROJ + tok * NPROJ + (which ? MK : MQ) + h * 128 + 8 * i;
            const v4u raw = which ? rawk[it] : rawq[it]; float xv[8];
            xv[0] = bflo(raw.x); xv[1] = bfhi(raw.x); xv[2] = bflo(raw.y); xv[3] = bfhi(raw.y); xv[4] = bflo(raw.z); xv[5] = bfhi(raw.z); xv[6] = bflo(raw.w); xv[7] = bfhi(raw.w);
            float ss = 0.f;
#pragma unroll
            for (int j = 0; j < 8; ++j) ss += xv[j] * xv[j];
            ss += __shfl_xor(ss, 1); ss += __shfl_xor(ss, 2); ss += __shfl_xor(ss, 4); ss += __shfl_xor(ss, 8);
            const float rstd = rsqrtf(ss * (1.f / 128.f) + EPS);
#pragma unroll
            for (int j = 0; j < 8; ++j) xv[j] = xv[j] * rstd * (which ? kg[j] : qg[j]);
#pragma unroll
            for (int j = 0; j < 8; ++j) { const float o = __shfl_xor(xv[j], 2); const float cv = cs[2 * j], sv = cs[2 * j + 1];
                if (i < 2) xv[j] = xv[j] * cv - o * sv; else if (i < 4) xv[j] = xv[j] * cv + o * sv; }
            v4u o; o.x = pk2(xv[0], xv[1]); o.y = pk2(xv[2], xv[3]); o.z = pk2(xv[4], xv[5]); o.w = pk2(xv[6], xv[7]);
            if (rep) *(v4u*)(C.CONCAT + tok * D + which * 1024 + h * 128 + 8 * i) = o; else *(v4u*)p = o;
            if (which) {
#pragma unroll
                for (int j = 0; j < 8; ++j) km[j] += xv[j]; }
        }
    }
    LAS float* red = (LAS float*)C.lds;
#pragma unroll
    for (int j = 0; j < 8; ++j) { km[j] += __shfl_xor(km[j], 16); km[j] += __shfl_xor(km[j], 32); }
    if (lane < 16) {
#pragma unroll
        for (int j = 0; j < 8; ++j) red[w * 128 + 8 * i + j] = km[j]; }
    __syncthreads();
    if (C.tid < 128) { float s = 0.f;
#pragma unroll
        for (int ww = 0; ww < 8; ++ww) s += red[ww * 128 + C.tid];
        C.KMEAN[((size_t)(b * NH + h) * 16 + blk) * 128 + C.tid] = s * (1.f / 256.f); }
    __syncthreads();
}

constexpr int KP = 272, VP = 320;
__device__ __forceinline__ void moba_select_item(const Ctx& C, int b, int h, int qb, int rep) {
    const int lane = C.lane, w = C.wave, r = lane & 31, hh = lane >> 5; const size_t tb = (size_t)b * SEQ; const int qtok = qb * 256 + 32 * w + r;
    bf16x8 qf[8];
    { const bf16* qrow = C.PROJ + MQ + h * 128 + (tb + qtok) * NPROJ + 8 * hh;
#pragma unroll
      for (int s = 0; s < 8; ++s) qf[s] = *(const bf16x8*)(qrow + 16 * s); }
    float g0 = -INFINITY, g1 = -INFINITY, g2 = -INFINITY; int i0 = -1, i1 = -1, i2 = -1;
    LAS float* kml = (LAS float*)C.lds;
    for (int i = C.tid; i < qb * 128; i += NTHREADS) kml[i] = C.KMEAN[((size_t)(b * NH + h) * 16) * 128 + i];
    __syncthreads();
    const LAS float* km = kml + 8 * hh;
    for (int j = 0; j < qb; ++j) {
        float acc = 0.f;
#pragma unroll
        for (int s = 0; s < 8; ++s) { const f32x4 k0 = *(const LAS f32x4*)(km + j * 128 + 16 * s), k1 = *(const LAS f32x4*)(km + j * 128 + 16 * s + 4);
            acc += bf1(qf[s][0]) * k0.x + bf1(qf[s][1]) * k0.y + bf1(qf[s][2]) * k0.z + bf1(qf[s][3]) * k0.w + bf1(qf[s][4]) * k1.x + bf1(qf[s][5]) * k1.y + bf1(qf[s][6]) * k1.z + bf1(qf[s][7]) * k1.w; }
        acc += __shfl_xor(acc, 32);
        if (acc > g0) { g2 = g1; i2 = i1; g1 = g0; i1 = i0; g0 = acc; i0 = j; }
        else if (acc > g1) { g2 = g1; i2 = i1; g1 = acc; i1 = j; }
        else if (acc > g2) { g2 = acc; i2 = j; }
    }
    __syncthreads();
    const int np = (i0 >= 0) + (i1 >= 0) + (i2 >= 0);
    if (hh == 0) C.SEL[(tb + qtok) * NH + h] = (unsigned short)((i0 & 15) | ((i1 & 15) << 4) | ((i2 & 15) << 8) | (np << 12));
    unsigned* lc = C.ctl + (rep ? 16384 : CW_LCNT) + ((b * NH + h) * 16) * 8; int nv = 0;
#pragma unroll
    for (int j = 0; j < 15; ++j) { const unsigned long long mk = __ballot(hh == 0 && (i0 == j || i1 == j || i2 == j)); nv = (lane == j) ? (int)__popcll(mk) : nv; }
    int basev = 0; if (lane < 15 && nv > 0) basev = (int)atomicAdd(lc + lane * 8, (unsigned)nv);
    unsigned short* lp = C.LIST + (size_t)((b * NH + h) * 16) * 4096 + (rep ? 256 * 4096 : 0);
#pragma unroll
    for (int j = 0; j < 15; ++j) { const int bj = __builtin_amdgcn_readlane(basev, j); const bool pj = hh == 0 && (i0 == j || i1 == j || i2 == j); const unsigned long long mk = __ballot(pj);
        if (pj) { const int slot = (i0 == j) ? 0 : (i1 == j) ? 1 : 2;
            const int pos = bj + (int)__builtin_amdgcn_mbcnt_hi((unsigned)(mk >> 32), __builtin_amdgcn_mbcnt_lo((unsigned)mk, 0u));
            lp[j * 4096 + pos] = (unsigned short)(qtok | (slot << 12)); } }
}
__device__ __forceinline__ void moba_attn_item(const Ctx& C, int b, int h, int kblk, bool own, int sub) {
    const int lane = C.lane, w = C.wave, r = lane & 31, hh = lane >> 5; const size_t tb = (size_t)b * SEQ; const int li = (b * NH + h) * 16 + kblk;
    { const char* kp = (const char*)(C.PROJ + (tb + kblk * 256) * NPROJ + MK + h * 128); const char* vp = (const char*)(C.PROJ + (tb + kblk * 256) * NPROJ + MV + h * 128);
#pragma unroll
      for (int i = 0; i < 8; ++i) { const int p = w + 8 * i, row = 4 * p + (lane >> 4), cp = lane & 15;
          __builtin_amdgcn_global_load_lds((const unsigned*)(kp + (size_t)row * (NPROJ * 2) + 16 * (cp ^ (row & 15))), (LAS unsigned*)(C.lds + p * 1024), 16, 0, 0);
          __builtin_amdgcn_global_load_lds((const unsigned*)(vp + (size_t)row * (NPROJ * 2) + 16 * (cp ^ ((row & 3) << 2))), (LAS unsigned*)(C.lds + 65536 + p * 1024), 16, 0, 0); } }
    const int cnt = own ? 256 : (int)C.ctl[CW_LCNT + li * 8], e = 256 * sub + 32 * w + r; const bool valid = e < cnt, wave_on = 256 * sub + 32 * w < cnt;
    int qtok, slot;
    if (own) { qtok = kblk * 256 + 32 * w + r; slot = 3; } else { const int ent = C.LIST[(size_t)li * 4096 + (valid ? e : 256 * sub)]; qtok = ent & 4095; slot = ent >> 12; }
    bf16x8 qf[8];
    { const bf16* qrow = C.PROJ + MQ + h * 128 + (tb + qtok) * NPROJ + 8 * hh;
#pragma unroll
      for (int s = 0; s < 8; ++s) qf[s] = *(const bf16x8*)(qrow + 16 * s); }
    __syncthreads();
    if (wave_on) {
        float m_run = -1e30f, l_run = 0.f; f32x16 o[4];
#pragma unroll
        for (int dt = 0; dt < 4; ++dt)
#pragma unroll
            for (int q = 0; q < 16; ++q) o[dt][q] = 0.f;
        const float c2 = 0.08838834764831845f * 1.4426950408889634f;
        const int xr = r & 15, vq = (lane & 15) >> 2, qi = 32 * w + r, ntile = own ? ((32 * w + 31) >> 6) + 1 : 4;
        const int kfo = r * 256, vfo = 65536 + (4 * hh + vq) * 256 + 32 * ((lane >> 4) & 1) + 8 * (lane & 3);
        for (int t = 0; t < ntile; ++t) {
            const LAS unsigned char* kb = C.lds + kfo + t * 16384;
            f32x16 p0, p1;
#pragma unroll
            for (int q = 0; q < 16; ++q) { p0[q] = 0.f; p1[q] = 0.f; }
#pragma unroll
            for (int ss = 0; ss < 8; ++ss) { const int co = ((2 * ss + hh) ^ xr) << 4; const bf16x8 a0 = *(const LAS bf16x8*)(kb + co), a1 = *(const LAS bf16x8*)(kb + 32 * 256 + co);
                p0 = MFMA32(a0, qf[ss], p0); p1 = MFMA32(a1, qf[ss], p1); }
            if (own) {
#pragma unroll
                for (int q = 0; q < 16; ++q) { const int kk = 64 * t + crow(q, hh); if (kk > qi) p0[q] = -INFINITY; if (kk + 32 > qi) p1[q] = -INFINITY; } }
            float mx = fmaxf(p0[0], p1[0]);
#pragma unroll
            for (int q = 1; q < 16; ++q) mx = fmaxf(mx, fmaxf(p0[q], p1[q]));
            { auto rr = __builtin_amdgcn_permlane32_swap(__float_as_uint(mx), __float_as_uint(mx), false, false); mx = fmaxf(__uint_as_float(rr[0]), __uint_as_float(rr[1])); }
            const float m_new = fmaxf(m_run, mx * c2), alpha = __builtin_amdgcn_exp2f(m_run - m_new);
            m_run = m_new; float rs = 0.f;
#pragma unroll
            for (int q = 0; q < 16; ++q) { p0[q] = __builtin_amdgcn_exp2f(p0[q] * c2 - m_new); p1[q] = __builtin_amdgcn_exp2f(p1[q] * c2 - m_new); rs += p0[q] + p1[q]; }
            l_run = l_run * alpha + rs;
            if (__ballot(alpha != 1.f) != 0ull) {
#pragma unroll
                for (int dt = 0; dt < 4; ++dt)
#pragma unroll
                    for (int q = 0; q < 16; ++q) o[dt][q] *= alpha; }
            bf16x8 pf[4];
            pf[0] = pack8(p0[0], p0[1], p0[2], p0[3], p0[4], p0[5], p0[6], p0[7]); pf[1] = pack8(p0[8], p0[9], p0[10], p0[11], p0[12], p0[13], p0[14], p0[15]);
            pf[2] = pack8(p1[0], p1[1], p1[2], p1[3], p1[4], p1[5], p1[6], p1[7]); pf[3] = pack8(p1[8], p1[9], p1[10], p1[11], p1[12], p1[13], p1[14], p1[15]);
            const LAS unsigned char* vb = C.lds + vfo + t * 16384;
#pragma unroll
            for (int dt = 0; dt < 4; ++dt) { const LAS unsigned char* vd = vb + 64 * (dt ^ vq);
#pragma unroll
                for (int kk = 0; kk < 4; ++kk) { const s16x4 lo = vtr(vd + (16 * kk) * 256), hi = vtr(vd + (16 * kk + 8) * 256); o[dt] = MFMA32(cat4(lo, hi), pf[kk], o[dt]); } }
        }
        l_run += __shfl_xor(l_run, 32);
        if (valid) { const float inv = 1.f / l_run; const size_t row = ((tb + qtok) * NH + h) * 4 + slot; bf16* op = C.PART + row * 128 + 4 * hh;
#pragma unroll
            for (int dt = 0; dt < 4; ++dt)
#pragma unroll
                for (int k4 = 0; k4 < 4; ++k4) { v2u wv; wv.x = pk2(o[dt][4 * k4] * inv, o[dt][4 * k4 + 1] * inv); wv.y = pk2(o[dt][4 * k4 + 2] * inv, o[dt][4 * k4 + 3] * inv); *(v2u*)(op + 32 * dt + 8 * k4) = wv; }
            if (hh == 0) *(f32x2*)(C.ML + row * 2) = (f32x2){m_run, l_run}; }
    }
    __syncthreads();
}
__device__ __forceinline__ void moba_merge_token(const Ctx& C, size_t t) {
    const int lane = C.lane, hd = lane >> 3, dc = lane & 7; const size_t row0 = (t * NH + hd) * 4;
    const unsigned short sel = C.SEL[t * NH + hd]; f32x2 ml[4]; v4u pa[4], pc[4];
#pragma unroll
    for (int s = 0; s < 4; ++s) { ml[s] = *(const f32x2*)(C.ML + (row0 + s) * 2); const v4u* pp = (const v4u*)(C.PART + (row0 + s) * 128 + 16 * dc); pa[s] = pp[0]; pc[s] = pp[1]; }
    const int np = sel >> 12; float M = -1e30f, wg[4], wsum = 0.f;
#pragma unroll
    for (int s = 0; s < 4; ++s) { const bool v = (s == 3) || (s < np); ml[s].x = v ? ml[s].x : -1e30f; ml[s].y = v ? ml[s].y : 0.f; M = fmaxf(M, ml[s].x); }
#pragma unroll
    for (int s = 0; s < 4; ++s) { wg[s] = ml[s].y * __builtin_amdgcn_exp2f(ml[s].x - M); wsum += wg[s]; }
    const float inv = 1.f / wsum; float acc[16];
#pragma unroll
    for (int q = 0; q < 16; ++q) acc[q] = 0.f;
#pragma unroll
    for (int s = 0; s < 4; ++s) { const unsigned vm = ((s == 3) || (s < np)) ? 0xffffffffu : 0u; const float ws_ = wg[s] * inv; v4u a = pa[s], c = pc[s];
        a.x &= vm; a.y &= vm; a.z &= vm; a.w &= vm; c.x &= vm; c.y &= vm; c.z &= vm; c.w &= vm;
        acc[0] += ws_ * bflo(a.x); acc[1] += ws_ * bfhi(a.x); acc[2] += ws_ * bflo(a.y); acc[3] += ws_ * bfhi(a.y); acc[4] += ws_ * bflo(a.z); acc[5] += ws_ * bfhi(a.z); acc[6] += ws_ * bflo(a.w); acc[7] += ws_ * bfhi(a.w);
        acc[8] += ws_ * bflo(c.x); acc[9] += ws_ * bfhi(c.x); acc[10] += ws_ * bflo(c.y); acc[11] += ws_ * bfhi(c.y); acc[12] += ws_ * bflo(c.z); acc[13] += ws_ * bfhi(c.z); acc[14] += ws_ * bflo(c.w); acc[15] += ws_ * bfhi(c.w); }
    v4u o0, o1; o0.x = pk2(acc[0], acc[1]); o0.y = pk2(acc[2], acc[3]); o0.z = pk2(acc[4], acc[5]); o0.w = pk2(acc[6], acc[7]); o1.x = pk2(acc[8], acc[9]); o1.y = pk2(acc[10], acc[11]); o1.z = pk2(acc[12], acc[13]); o1.w = pk2(acc[14], acc[15]);
    v4u* op = (v4u*)(C.CONCAT + t * D + 1024 + hd * 128 + 16 * dc); op[0] = o0; op[1] = o1;
}

constexpr int GKP = 192;
__device__ __forceinline__ void gla_v_to_lds(const Ctx& C, size_t t0, int h, int off) {
#pragma unroll
    for (int pp = 0; pp < 2; ++pp) { const int p = C.tid + 512 * pp; const v4u v = *(const v4u*)(C.PROJ + (t0 + (p >> 4)) * NPROJ + GV + h * 128 + 8 * (p & 15)); *(LAS v4u*)(C.lds + off + (p >> 4) * VP + 16 * (p & 15)) = v; }
}
__device__ __forceinline__ void gla_u_item(const Ctx& C, int b, int h, int n) {
    const int tid = C.tid, lane = C.lane, w = C.wave, r = lane & 31, hh = lane >> 5; const size_t t0 = (size_t)b * SEQ + 64 * n; const int bhn = (b * NH + h) * 64 + n;
    constexpr int KT = 0, VT = 64 * GKP;
    { const int tok = tid >> 3, ch = tid & 7; *(LAS v4u*)(C.lds + KT + tok * GKP + 16 * ch) = *(const v4u*)(C.KUPD + (t0 + tok) * 512 + h * 64 + 8 * ch); }
    gla_v_to_lds(C, t0, h, VT);
    __syncthreads();
    const int mt = w & 3, nt = w >> 2, q = (lane & 15) >> 2, cb = (16 * ((lane >> 4) & 1) + 4 * (lane & 3)) * 2;
    const LAS unsigned char* va = C.lds + VT + (4 * hh + q) * VP + cb + mt * 64; const LAS unsigned char* ka = C.lds + KT + (4 * hh + q) * GKP + cb + nt * 64;
    f32x16 acc;
#pragma unroll
    for (int i = 0; i < 16; ++i) acc[i] = 0.f;
#pragma unroll
    for (int s = 0; s < 4; ++s) acc = MFMA32(cat4(vtr(va + 16 * s * VP), vtr(va + (16 * s + 8) * VP)), cat4(vtr(ka + 16 * s * GKP), vtr(ka + (16 * s + 8) * GKP)), acc);
    float* up = C.UT + (size_t)bhn * 8192 + (32 * mt) * 64 + 32 * nt + r;
#pragma unroll
    for (int i = 0; i < 16; ++i) up[crow(i, hh) * 64] = acc[i];
    __syncthreads();
}
__device__ __forceinline__ void gla_scan_item(const Ctx& C, int id) {
    { const int idx = id * NTHREADS + C.tid;
        const int bh = idx >> 13, rem = idx & 8191, dk = rem & 63; float s = 0.f;
        const float* up = C.UT + (size_t)bh * 64 * 8192 + rem; const float* dp = C.DEC + (size_t)bh * 64 * 64 + dk; bf16* sp = C.ST + (size_t)bh * 64 * 8192 + rem;
#pragma unroll 16
        for (int n = 0; n < 64; ++n) { sp[(size_t)n * 8192] = (bf16)(pk2(s, 0.f) & 0xffffu); s = dp[n * 64] * s + up[(size_t)n * 8192]; }
    }
}

__device__ __forceinline__ void p5_attn_phase(const Ctx& C, int rep) {
    volatile LAS int* qslot = (volatile LAS int*)(C.lds + MISC_OFF + 64);
    LAS int* pfx = (LAS int*)(C.lds + RING_BYTES + 1024);
    if (C.tid < 256) { const int c = ((C.tid & 15) < 15) ? (int)C.ctl[CW_LCNT + C.tid * 8] : 0; pfx[1 + C.tid] = (c + 255) >> 8; }
    __syncthreads();
    if (C.tid == 0) { int s = 0; pfx[0] = 0; for (int i = 1; i <= 256; ++i) { s += pfx[i]; pfx[i] = s; } }
    __syncthreads();
    const int npast = pfx[256]; unsigned* cnt = C.ctl + CW_Q + 64 * rep;
    for (;;) {
        __syncthreads();
        if (C.tid == 0) { const int id = (int)atomicAdd(cnt, 1u); int a0 = -1, a1 = 0;
            if (id < 256) { a0 = 512 + id; }
            else if (id < 512) { a0 = id - 256; a1 = -1; }
            else if (id < 512 + npast) { const int p = id - 512; int lo = 0, hi = 256; while (hi - lo > 1) { const int mid = (lo + hi) >> 1; if (pfx[mid] <= p) lo = mid; else hi = mid; } a0 = lo; a1 = p - pfx[lo]; }
            qslot[0] = a0; qslot[1] = a1; }
        __syncthreads();
        const int a0 = qslot[0], a1 = qslot[1];
        if (a0 < 0) break;
        if (a0 < 256) moba_attn_item(C, a0 >> 7, (a0 >> 4) & 7, a0 & 15, a1 < 0, a1 < 0 ? 0 : a1);
        else gla_scan_item(C, a0 - 512);
    }
}

__device__ __forceinline__ void gla_out_item(const Ctx& C, int b, int h, int n) {
    const int lane = C.lane, w = C.wave, r = lane & 31, hh = lane >> 5, dvt = w & 3, lt = w >> 2; const size_t t0 = (size_t)b * SEQ + 64 * n; const int bhn = (b * NH + h) * 64 + n;
    constexpr int VT = 0, RED = 64 * VP;
    const size_t tl = t0 + 32 * lt + r;
    v4u vraw[2]; bf16x8 qd[4], kd[2][4];
#pragma unroll
    for (int pp = 0; pp < 2; ++pp) { const int p = C.tid + 512 * pp; vraw[pp] = *(const v4u*)(C.PROJ + (t0 + (p >> 4)) * NPROJ + GV + h * 128 + 8 * (p & 15)); }
#pragma unroll
    for (int s = 0; s < 4; ++s) { qd[s] = *(const bf16x8*)(C.QDEC + tl * 512 + h * 64 + 16 * s + 8 * hh); kd[1][s] = *(const bf16x8*)(C.KDEC + tl * 512 + h * 64 + 16 * s + 8 * hh);
        kd[0][s] = *(const bf16x8*)(C.KDEC + (t0 + r) * 512 + h * 64 + 16 * s + 8 * hh); }
#pragma unroll
    for (int pp = 0; pp < 2; ++pp) { const int p = C.tid + 512 * pp; *(LAS v4u*)(C.lds + VT + (p >> 4) * VP + 16 * (p & 15)) = vraw[pp]; }
    bf16x8 sfr[4]; v2u graw[4]; f32x4 gn[4];
    { const bf16* sp = C.ST + (size_t)bhn * 8192 + (32 * dvt + r) * 64 + 8 * hh;
#pragma unroll
      for (int s = 0; s < 4; ++s) sfr[s] = *(const bf16x8*)(sp + 16 * s);
#pragma unroll
      for (int k4 = 0; k4 < 4; ++k4) { const int d0 = 32 * dvt + 8 * k4 + 4 * hh; graw[k4] = *(const v2u*)(C.PROJ + tl * NPROJ + GG + h * 128 + d0); gn[k4] = *(const f32x4*)(C.gla_g + d0); } }
    __syncthreads();
    f32x16 o;
#pragma unroll
    for (int i = 0; i < 16; ++i) o[i] = 0.f;
    const LAS unsigned char* va = C.lds + VT + (4 * hh + ((lane & 15) >> 2)) * VP + (16 * ((lane >> 4) & 1) + 4 * (lane & 3)) * 2 + dvt * 64;
#pragma unroll
    for (int mt = 0; mt < 2; ++mt) {
        if (mt > lt) break;
        const bool diag = (mt == lt); f32x16 X;
#pragma unroll
        for (int i = 0; i < 16; ++i) X[i] = 0.f;
#pragma unroll
        for (int s = 0; s < 4; ++s) X = MFMA32(diag ? kd[1][s] : kd[0][s], qd[s], X);
        if (diag) {
#pragma unroll
            for (int i = 0; i < 16; ++i) if (crow(i, hh) > r) X[i] = 0.f; }
        const bf16x8 pf0 = pack8(X[0], X[1], X[2], X[3], X[4], X[5], X[6], X[7]), pf1 = pack8(X[8], X[9], X[10], X[11], X[12], X[13], X[14], X[15]);
        o = MFMA32(cat4(vtr(va + (32 * mt) * VP), vtr(va + (32 * mt + 8) * VP)), pf0, o);
        o = MFMA32(cat4(vtr(va + (32 * mt + 16) * VP), vtr(va + (32 * mt + 24) * VP)), pf1, o);
    }
#pragma unroll
    for (int s = 0; s < 4; ++s) o = MFMA32(sfr[s], qd[s], o);
    float ss = 0.f;
#pragma unroll
    for (int i = 0; i < 16; ++i) ss += o[i] * o[i];
    ss += __shfl_xor(ss, 32);
    LAS float* red = (LAS float*)(C.lds + RED);
    if (hh == 0) red[dvt * 64 + 32 * lt + r] = ss;
    __syncthreads();
    const int l = 32 * lt + r; const float rstd = rsqrtf((red[l] + red[64 + l] + red[128 + l] + red[192 + l]) * (1.f / 128.f) + EPS);
#pragma unroll
    for (int k4 = 0; k4 < 4; ++k4) { const int d0 = 32 * dvt + 8 * k4 + 4 * hh;
        const float ga = bflo(graw[k4].x), gb = bfhi(graw[k4].x), gc = bflo(graw[k4].y), gd = bfhi(graw[k4].y); const f32x4 gnv = gn[k4];
        const float y0 = o[4 * k4] * rstd * gnv.x * (ga / (1.f + __expf(-ga))), y1 = o[4 * k4 + 1] * rstd * gnv.y * (gb / (1.f + __expf(-gb)));
        const float y2 = o[4 * k4 + 2] * rstd * gnv.z * (gc / (1.f + __expf(-gc))), y3 = o[4 * k4 + 3] * rstd * gnv.w * (gd / (1.f + __expf(-gd)));
        v2u wv; wv.x = pk2(y0, y1); wv.y = pk2(y2, y3); *(v2u*)(C.CONCAT + tl * D + h * 128 + d0) = wv; }
    __syncthreads();
}

#define INS16(L, xin) do { int x_ = (xin); _Pragma("unroll") for (int i_ = 0; i_ < 16; ++i_) { const int hi_ = max(L[i_], x_); x_ = min(L[i_], x_); L[i_] = hi_; } } while (0)
#define CE_DESC(a, b) do { const int hi_ = max(a, b), lo_ = min(a, b); a = hi_; b = lo_; } while (0)
#define BITONIC_MERGE16(L) do { _Pragma("unroll") for (int j_ = 8; j_ > 0; j_ >>= 1) _Pragma("unroll") for (int i_ = 0; i_ < 16; ++i_) if ((i_ & j_) == 0) CE_DESC(L[i_], L[i_ | j_]); } while (0)
#define SORT16(L) do { _Pragma("unroll") for (int k_ = 2; k_ <= 16; k_ <<= 1) _Pragma("unroll") for (int j_ = k_ >> 1; j_ > 0; j_ >>= 1) _Pragma("unroll") for (int i_ = 0; i_ < 16; ++i_) { const int l_ = i_ ^ j_; \
        if (l_ > i_) { if ((i_ & k_) == 0) CE_DESC(L[i_], L[l_]); else CE_DESC(L[l_], L[i_]); } } } while (0)
#define MERGE16(L, M) do { _Pragma("unroll") for (int i_ = 0; i_ < 16; ++i_) L[i_] = max(L[i_], M[15 - i_]); BITONIC_MERGE16(L); } while (0)
__device__ __forceinline__ int ord_key(float v) { int u = __float_as_int(v); return u ^ ((u >> 31) & 0x7fffffff); }
__device__ __forceinline__ float ord_val(int k, int mask) { int u = k & ~mask; return __int_as_float(u ^ ((u >> 31) & 0x7fffffff)); }
__device__ __forceinline__ void peer_topk_item(const Ctx& C, int tg, int hd, const LAS unsigned char* qlds, int lrow0) {
    const int lane = C.lane, r = lane & 31, hh = lane >> 5; const size_t tok = (size_t)tg * 32 + r;
    int La[16], Lb[16];
#pragma unroll
    for (int c = 0; c < 2; ++c) {
        int L[16];
#pragma unroll
        for (int i = 0; i < 16; ++i) L[i] = (int)0x80000000;
        bf16x8 qf[8];
        { const int row = lrow0 + r;
#pragma unroll
          for (int s = 0; s < 8; ++s) qf[s] = *(const LAS bf16x8*)(qlds + row * 512 + 16 * ((16 * c + 2 * s + hh) ^ (row & 15))); }
        int G[16];
        bf16x8 kfA[8], kfB[8];
#define PT_KLOAD(dst, kt) do { const bf16* kp_ = C.KEYSB + ((size_t)(hd * 2 + c) * 128 + 32 * (kt) + r) * 128 + 8 * hh; _Pragma("unroll") for (int s = 0; s < 8; ++s) dst[s] = *(const bf16x8*)(kp_ + 16 * s); } while (0)
#define PT_TILE(src, kt) do { f32x16 X; _Pragma("unroll") for (int i = 0; i < 16; ++i) X[i] = 0.f; _Pragma("unroll") for (int s = 0; s < 8; ++s) X = MFMA32(src[s], qf[s], X); \
            _Pragma("unroll") for (int i = 0; i < 16; ++i) G[i] = (ord_key(X[i]) & ~127) | (32 * (kt) + crow(i, hh)); SORT16(G); MERGE16(L, G); } while (0)
        PT_KLOAD(kfA, 0);
#pragma unroll 1
        for (int k2 = 0; k2 < 2; ++k2) {
            PT_KLOAD(kfB, 2 * k2 + 1);
            PT_TILE(kfA, 2 * k2);
            if (k2 == 0) PT_KLOAD(kfA, 2);
            PT_TILE(kfB, 2 * k2 + 1);
        }
#undef PT_KLOAD
#undef PT_TILE
        int M[16];
#pragma unroll
        for (int i = 0; i < 16; ++i) M[i] = __shfl_xor(L[i], 32);
        MERGE16(L, M);
#pragma unroll
        for (int i = 0; i < 16; ++i) { if (c == 0) La[i] = L[i]; else Lb[i] = L[i]; }
    }
    float sa[16], sb[16]; int Lc[16];
#pragma unroll
    for (int i = 0; i < 16; ++i) { sa[i] = ord_val(La[i], 127); sb[i] = ord_val(Lb[i], 127); Lc[i] = (int)0x80000000; }
#pragma unroll
    for (int i = 0; i < 16; ++i)
#pragma unroll
        for (int j = 0; j < 16; ++j) if ((i + 1) * (j + 1) <= 16) INS16(Lc, (ord_key(sa[i] + sb[j]) & ~255) | (i * 16 + j));
    float e[16], sum = 0.f; int ex[16]; const float mx = ord_val(Lc[0], 255);
#pragma unroll
    for (int i = 0; i < 16; ++i) {
        e[i] = __expf(ord_val(Lc[i], 255) - mx); sum += e[i];
        const int ii = (Lc[i] >> 4) & 15, jj = Lc[i] & 15; int i1 = 0, i2 = 0;
#pragma unroll
        for (int q = 0; q < 16; ++q) { i1 = (ii == q) ? (La[q] & 127) : i1; i2 = (jj == q) ? (Lb[q] & 127) : i2; }
        ex[i] = i1 * 128 + i2;
    }
    const float inv = 1.f / sum;
    if (hh == 0) {
        v4u* ep = (v4u*)(C.EXPI + tok * 128 + hd * 16); f32x4* gp = (f32x4*)(C.GATE + tok * 128 + hd * 16); f32x4* up = (f32x4*)(C.GU + tok * 128 + hd * 16); v4u* ap = (v4u*)(C.ACT + tok * 128 + hd * 16);
        const float hs = C.HS[tok];
#pragma unroll
        for (int q = 0; q < 4; ++q) { ep[q] = (v4u){(unsigned)ex[4 * q], (unsigned)ex[4 * q + 1], (unsigned)ex[4 * q + 2], (unsigned)ex[4 * q + 3]};
            gp[q] = (f32x4){e[4 * q] * inv * C.VS[ex[4 * q]], e[4 * q + 1] * inv * C.VS[ex[4 * q + 1]], e[4 * q + 2] * inv * C.VS[ex[4 * q + 2]], e[4 * q + 3] * inv * C.VS[ex[4 * q + 3]]};
            up[q] = (f32x4){hs * C.US[ex[4 * q]], hs * C.US[ex[4 * q + 1]], hs * C.US[ex[4 * q + 2]], hs * C.US[ex[4 * q + 3]]};
            ap[q] = (v4u){0u, 0u, 0u, 0u}; }
    }
}

__device__ __forceinline__ int peer_dequeue(const Ctx& C, unsigned* cnt, int xcc) {
    volatile LAS int* slot = (volatile LAS int*)(C.lds + MISC_OFF + 64);
    __syncthreads();
    if (C.tid == 0) { int res = -1;
        for (int s = 0; s < NSL; ++s) { const int sl = (xcc + s) & (NSL - 1);
            if (__hip_atomic_load(cnt + 64 * sl, __ATOMIC_RELAXED, __HIP_MEMORY_SCOPE_AGENT) >= (unsigned)NCHUNK) continue;
            const unsigned id = atomicAdd(cnt + 64 * sl, 1u); if (id < (unsigned)NCHUNK) { res = sl * NCHUNK + (int)id; break; } }
        *slot = res; }
    __syncthreads();
    return *slot;
}
#define ROWSUM16(d) do { d += __builtin_amdgcn_update_dpp(0, d, 0x121, 0xf, 0xf, false); d += __builtin_amdgcn_update_dpp(0, d, 0x122, 0xf, 0xf, false); \
                         d += __builtin_amdgcn_update_dpp(0, d, 0x124, 0xf, 0xf, false); d += __builtin_amdgcn_update_dpp(0, d, 0x128, 0xf, 0xf, false); } while (0)
#define PA_ISSUE1(buf, esrc, j_) buf[j_] = *(const v4u*)(tab + (size_t)__builtin_amdgcn_ds_swizzle(esrc, ((j_) << 5) | 0x10) * SLW)
#define PA_ISSUE(buf, esrc) do { PA_ISSUE1(buf, esrc, 0); PA_ISSUE1(buf, esrc, 1); PA_ISSUE1(buf, esrc, 2); PA_ISSUE1(buf, esrc, 3); PA_ISSUE1(buf, esrc, 4); PA_ISSUE1(buf, esrc, 5); PA_ISSUE1(buf, esrc, 6); PA_ISSUE1(buf, esrc, 7); \
        PA_ISSUE1(buf, esrc, 8); PA_ISSUE1(buf, esrc, 9); PA_ISSUE1(buf, esrc, 10); PA_ISSUE1(buf, esrc, 11); PA_ISSUE1(buf, esrc, 12); PA_ISSUE1(buf, esrc, 13); PA_ISSUE1(buf, esrc, 14); PA_ISSUE1(buf, esrc, 15); } while (0)
#define PA_COMPUTE(buf, hq_, dstv) do { _Pragma("unroll") for (int j_ = 0; j_ < 16; ++j_) { const v4u u_ = buf[j_]; \
        int d_ = __builtin_amdgcn_sdot4((int)hq_.x, (int)u_.x, 0, false); d_ = __builtin_amdgcn_sdot4((int)hq_.y, (int)u_.y, d_, false); d_ = __builtin_amdgcn_sdot4((int)hq_.z, (int)u_.z, d_, false); d_ = __builtin_amdgcn_sdot4((int)hq_.w, (int)u_.w, d_, false); \
        ROWSUM16(d_); dstv = (i == j_) ? d_ : dstv; } } while (0)
__device__ __forceinline__ void peer_a_chunk(const Ctx& C, int t0, int x, int* act) {
    const int lane = C.lane, i = lane & 15;
    v4u hq[8]; int el[8], eh[8];
#pragma unroll
    for (int tt = 0; tt < 8; ++tt) { hq[tt] = __builtin_nontemporal_load((const v4u*)(C.HQ + ((size_t)x * T + t0 + tt) * SLW + 16 * i)); el[tt] = __builtin_nontemporal_load(C.EXPI + (size_t)(t0 + tt) * 128 + lane); eh[tt] = __builtin_nontemporal_load(C.EXPI + (size_t)(t0 + tt) * 128 + 64 + lane); }
    const unsigned char* tab = C.UQ + (size_t)x * NEXP * SLW + 16 * i;
    v4u bA[16], bB[16];
    PA_ISSUE(bA, el[0]);
#pragma unroll
    for (int tt = 0; tt < 8; ++tt) {
        PA_ISSUE(bB, eh[tt]);
        int r_lo = 0, r_hi = 0;
        PA_COMPUTE(bA, hq[tt], r_lo);
        if (tt + 1 < 8) PA_ISSUE(bA, el[tt + 1]);
        PA_COMPUTE(bB, hq[tt], r_hi);
        atomicAdd(act + (size_t)(t0 + tt) * 128 + lane, r_lo); atomicAdd(act + (size_t)(t0 + tt) * 128 + 64 + lane, r_hi);
    }
}
#undef PA_ISSUE
#undef PA_ISSUE1
#undef PA_COMPUTE
__device__ __forceinline__ void peer_weights_token(const Ctx& C, size_t t) {
    const int lane = C.lane; const size_t o = t * 128 + lane;
    const float a_lo = (float)C.ACT[o] * C.GU[o], a_hi = (float)C.ACT[o + 64] * C.GU[o + 64];
    const float w_lo = C.GATE[o] * 0.5f * a_lo * (1.f + erff(a_lo * 0.70710678118654752f)), w_hi = C.GATE[o + 64] * 0.5f * a_hi * (1.f + erff(a_hi * 0.70710678118654752f));
    const float wm = wave_max(fmaxf(fabsf(w_lo), fabsf(w_hi))), winv = wm > 0.f ? 127.f / wm : 0.f;
    unsigned p_lo = (unsigned)((int)rintf(w_lo * winv) & 0xff), p_hi = (unsigned)((int)rintf(w_hi * winv) & 0xff);
    p_lo |= (unsigned)__builtin_amdgcn_update_dpp(0, (int)p_lo, 0xB1, 0xf, 0xf, false) << 8; p_lo |= (unsigned)__builtin_amdgcn_update_dpp(0, (int)p_lo, 0x4E, 0xf, 0xf, false) << 16;
    p_hi |= (unsigned)__builtin_amdgcn_update_dpp(0, (int)p_hi, 0xB1, 0xf, 0xf, false) << 8; p_hi |= (unsigned)__builtin_amdgcn_update_dpp(0, (int)p_hi, 0x4E, 0xf, 0xf, false) << 16;
    if ((lane & 3) == 0) { C.PW[t * 32 + (lane >> 2)] = p_lo; C.PW[t * 32 + 16 + (lane >> 2)] = p_hi; }
    if (lane == 0) C.WSC[t] = wm * (1.f / 127.f);
}
#define PB_ISSUE(buf, esrc) do { _Pragma("unroll") for (int j_ = 0; j_ < 16; ++j_) { const int e_ = __builtin_amdgcn_ds_bpermute(4 * (16 * (j_ >> 2) + 4 * g + (j_ & 3)), esrc); buf[j_] = *(const v4u*)(tab + (size_t)e_ * SLW); } } while (0)
#define PB_TR4(r0_, r1_, r2_, r3_, wp_, base) do { const unsigned t0_ = __builtin_amdgcn_perm(r1_, r0_, 0x05010400u), t1_ = __builtin_amdgcn_perm(r1_, r0_, 0x07030602u), t2_ = __builtin_amdgcn_perm(r3_, r2_, 0x05010400u), t3_ = __builtin_amdgcn_perm(r3_, r2_, 0x07030602u); \
        c[(base)] = __builtin_amdgcn_sdot4((int)__builtin_amdgcn_perm(t2_, t0_, 0x05040100u), wp_, c[(base)], false); c[(base) + 1] = __builtin_amdgcn_sdot4((int)__builtin_amdgcn_perm(t2_, t0_, 0x07060302u), wp_, c[(base) + 1], false); \
        c[(base) + 2] = __builtin_amdgcn_sdot4((int)__builtin_amdgcn_perm(t3_, t1_, 0x05040100u), wp_, c[(base) + 2], false); c[(base) + 3] = __builtin_amdgcn_sdot4((int)__builtin_amdgcn_perm(t3_, t1_, 0x07060302u), wp_, c[(base) + 3], false); } while (0)
#define PB_COMPUTE(buf, psrc) do { _Pragma("unroll") for (int jb_ = 0; jb_ < 4; ++jb_) { const int wp_ = __builtin_amdgcn_ds_bpermute(4 * (16 * jb_ + 4 * g), (int)psrc); \
        PB_TR4(buf[4 * jb_].x, buf[4 * jb_ + 1].x, buf[4 * jb_ + 2].x, buf[4 * jb_ + 3].x, wp_, 0); PB_TR4(buf[4 * jb_].y, buf[4 * jb_ + 1].y, buf[4 * jb_ + 2].y, buf[4 * jb_ + 3].y, wp_, 4); \
        PB_TR4(buf[4 * jb_].z, buf[4 * jb_ + 1].z, buf[4 * jb_ + 2].z, buf[4 * jb_ + 3].z, wp_, 8); PB_TR4(buf[4 * jb_].w, buf[4 * jb_ + 1].w, buf[4 * jb_ + 2].w, buf[4 * jb_ + 3].w, wp_, 12); } } while (0)
__device__ __forceinline__ int isum_swap16(int v) { auto r = __builtin_amdgcn_permlane16_swap((unsigned)v, (unsigned)v, false, false); return (int)r[0] + (int)r[1]; }
__device__ __forceinline__ int isum_swap32(int v) { auto r = __builtin_amdgcn_permlane32_swap((unsigned)v, (unsigned)v, false, false); return (int)r[0] + (int)r[1]; }
__device__ __forceinline__ void peer_b_chunk(const Ctx& C, int t0, int x, float* dst) {
    const int lane = C.lane, i = lane & 15, g = lane >> 4, b = t0 / SEQ;
    int el[8], eh[8]; unsigned pl[8], ph[8]; float ws[8];
#pragma unroll
    for (int tt = 0; tt < 8; ++tt) { const size_t o = (size_t)(t0 + tt) * 128 + lane;
        el[tt] = __builtin_nontemporal_load(C.EXPI + o); eh[tt] = __builtin_nontemporal_load(C.EXPI + o + 64);
        const unsigned p_lo = C.PW[(size_t)(t0 + tt) * 32 + (lane >> 2)], p_hi = C.PW[(size_t)(t0 + tt) * 32 + 16 + (lane >> 2)]; ws[tt] = C.WSC[t0 + tt];
        pl[tt] = p_lo; ph[tt] = p_hi; }
    const unsigned char* tab = C.VQ + (size_t)x * NEXP * SLW + 16 * i;
    const int d0 = x * SLW + 16 * i + 4 * g; const f32x4 gm = *(const f32x4*)(C.MOD + b * NMOD + 5 * D + d0);
    v4u bA[16], bB[16];
    PB_ISSUE(bA, el[0]);
#pragma unroll
    for (int tt = 0; tt < 8; ++tt) {
        PB_ISSUE(bB, eh[tt]);
        const size_t off = (size_t)(t0 + tt) * D + d0; const f32x4 x1 = __builtin_nontemporal_load((const f32x4*)(C.out + off));
        int c[16];
#pragma unroll
        for (int q = 0; q < 16; ++q) c[q] = 0;
        PB_COMPUTE(bA, pl[tt]);
        if (tt + 1 < 8) PB_ISSUE(bA, el[tt + 1]);
        PB_COMPUTE(bB, ph[tt]);
#pragma unroll
        for (int q = 0; q < 16; ++q) c[q] = isum_swap32(isum_swap16(c[q]));
        f32x4 o;
#pragma unroll
        for (int q = 0; q < 4; ++q) o[q] = (float)(g == 0 ? c[q] : g == 1 ? c[4 + q] : g == 2 ? c[8 + q] : c[12 + q]) * ws[tt];
        __builtin_nontemporal_store(x1 + gm * o, (f32x4*)(dst + off));
    }
}
#undef PB_ISSUE
#undef PB_COMPUTE
#undef PB_TR4
template <int STAGE> __device__ __forceinline__ void peer_expert_phase(const Ctx& C, float* dst, int rep) {
    const int xcc = (int)(xb_xcc_id() & (NSL - 1)); unsigned* cnt = C.ctl + (STAGE == 0 ? CW_QA : CW_QB) + 64 * NSL * rep;
    for (;;) {
        const int id = peer_dequeue(C, cnt, xcc); if (id < 0) break;
        const int x = id / NCHUNK, t0 = (id % NCHUNK) * PCH + C.wave * (PCH / NWAVES);
        if (STAGE == 0) peer_a_chunk(C, t0, x, rep ? (int*)C.QP : C.ACT); else peer_b_chunk(C, t0, x, dst);
    }
}

__device__ __forceinline__ void first_unit(int nM, int nN, int G, int c, int& pm, int& pn) {
    const int nwg = nM * nN; if (c >= nwg) { pm = -1; pn = 0; return; }
    int wgid = c; { const int q = nwg / 8, r = nwg % 8, xcd = wgid % 8, off = wgid / 8; wgid = (xcd < r ? xcd * (q + 1) : r * (q + 1) + (xcd - r) * q) + off; }
    const int nig = 8 * nN, gid = wgid / nig, fm = gid * 8, gsz = (nM - fm) < 8 ? (nM - fm) : 8;
    pm = fm + ((wgid % nig) % gsz); pn = (wgid % nig) / gsz; (void)G;
}
struct Args { const void* in[18]; float* out; unsigned char* ws; int ph_lo, ph_hi; };
__global__ void __launch_bounds__(NTHREADS, 2) fwd_kernel(Args args) {
    extern __shared__ __attribute__((aligned(16))) unsigned char lds[];
    Ctx C;
    C.lds = (LAS unsigned char*)lds; C.tid = threadIdx.x; C.lane = C.tid & 63; C.wave = __builtin_amdgcn_readfirstlane(C.tid >> 6);
    C.G = gridDim.x; { const int bx = blockIdx.x; C.vcu = (C.G % 8 == 0) ? (bx % 8) * (C.G / 8) + bx / 8 : bx; }
    C.gw = C.vcu * NWAVES + C.wave; C.ngw = C.G * NWAVES;
    C.x = (const float*)args.in[0]; C.c = (const float*)args.in[1]; C.pos = (const int*)args.in[2]; C.w_ada = (const float*)args.in[3]; C.b_ada = (const float*)args.in[4]; C.g1 = (const float*)args.in[5];
    C.w_in = (const float*)args.in[6]; C.w_a2 = (const float*)args.in[7]; C.b_a = (const float*)args.in[8]; C.gla_g = (const float*)args.in[9]; C.qg = (const float*)args.in[10]; C.kg = (const float*)args.in[11];
    C.w_out = (const float*)args.in[12]; C.g2 = (const float*)args.in[13]; C.w_q = (const float*)args.in[14]; C.keys = (const float*)args.in[15]; C.pu = (const float*)args.in[16]; C.pv = (const float*)args.in[17];
    C.out = args.out; unsigned char* ws = args.ws;
#define CTX_WS_PTRS() do { C.ctl = (unsigned*)(ws + WS_CTL); C.MODI = (long long*)(C.ctl + CW_MOD); C.MOD = (float*)(ws + WS_MODF); C.WIN = (bf16*)(ws + WS_WIN); C.WGA = (bf16*)(ws + WS_WGA); C.WOUT = (bf16*)(ws + WS_WOUT); C.WQ = (bf16*)(ws + WS_WQ); C.KEYSB = (bf16*)(ws + WS_KEYS); C.UQ = ws + WS_UB; C.VQ = ws + WS_VB; C.HQ = ws + WS_HQ; C.US = (float*)(ws + WS_US); C.VS = (float*)(ws + WS_VS); C.HS = (float*)(ws + WS_HS); C.GU = (float*)(ws + WS_GU); C.PW = (unsigned*)(ws + WS_PW); C.WSC = (float*)(ws + WS_WSC); C.ACT = (int*)(ws + WS_ACT); C.QDEC = (bf16*)(ws + WS_QDEC); C.KDEC = (bf16*)(ws + WS_KDEC); C.KUPD = (bf16*)(ws + WS_KUPD); C.PART = (bf16*)(ws + WS_PART); C.ML = (float*)(ws + WS_ML); C.LIST = (unsigned short*)(ws + WS_LIST); C.SEL = (unsigned short*)(ws + WS_SEL); C.H = (bf16*)(ws + WS_H); C.CONCAT = (bf16*)(ws + WS_CONCAT); C.PROJ = (bf16*)(ws + WS_PROJ); C.ST = (bf16*)(ws + WS_ST); C.CS = (float*)(ws + WS_CS); C.KMEAN = (float*)(ws + WS_KMEAN); C.DEC = (float*)(ws + WS_DEC); C.BCUM = (float*)(ws + WS_BCUM); C.UT = (float*)(ws + WS_UT); C.QP = (float*)(ws + WS_QP); C.GATE = (float*)(ws + WS_GATE); C.EXPI = (int*)(ws + WS_EXP); } while (0)
    CTX_WS_PTRS();
    for (int u = C.tid; u < (LDS_BYTES - RING_BYTES) / 4; u += NTHREADS) ((LAS unsigned*)(C.lds + RING_BYTES))[u] = 0u;
    __syncthreads();
    const int lo = args.ph_lo, hi = args.ph_hi;
    if (PROBE_TS >= 0 && blockIdx.x == 0 && threadIdx.x == 0) ((volatile LAS unsigned long long*)(C.lds + RING_BYTES + 8192))[0] = __builtin_amdgcn_s_memrealtime();
    XcdBarrier bar; bar.bar = C.ctl + CW_BAR; bar.x = 0; bar.st = nullptr;
    if (hi - lo > 1) bar = xcd_barrier_post(C.ctl + CW_BAR, (volatile LAS unsigned*)(C.lds + MISC_OFF) + 8);
#ifndef SKIPMASK
#define SKIPMASK 0
#endif
#ifndef REPEATMASK
#define REPEATMASK 0
#endif
#define IN(k) (!((SKIPMASK >> (k)) & 1) && lo <= (k) && (k) < hi)
#define REP(k, ...) do { if ((REPEATMASK >> (k)) & 1) { const int rep_ = 1; (void)rep_; __VA_ARGS__; xcd_barrier(bar); } { const int rep_ = 0; (void)rep_; __VA_ARGS__; } } while (0)
#define SEAM(k) do { if (IN(k) && IN((k) + 1)) xcd_barrier(bar); if (PROBE_TS >= 0 && blockIdx.x == 0 && threadIdx.x == 0) ((volatile LAS unsigned long long*)(C.lds + RING_BYTES + 8192))[(k) + 1] = __builtin_amdgcn_s_memrealtime(); { int t_ = C.tid; asm volatile("" : "+v"(t_)); C.tid = t_; C.lane = t_ & 63; } CTX_WS_PTRS(); } while (0)
    if (IN(0)) REP(0, p0_phase(C, rep_)); SEAM(0);
    if (IN(1)) REP(1, norm_mod_phase<true>(C, C.x, C.g1, 0, D, C.H)); SEAM(1);
    if (IN(2)) REP(2, pg8::Gemm g{C.H, C.WIN, T, NPROJ, D}; pg8::StaticOrder S; S.init(T, NPROJ, C.G, (int)blockIdx.x); pg8::EpiBf16<0> E{C.PROJ, NPROJ, nullptr, 0, 0, 1.f};
                 pg8::gemm_phase<pg8::EpiBf16<0>, pg8::StaticOrder, PG8_ALIGN, PG8_SP2>(C.lds, g, S, E)); SEAM(2);
    if (IN(3)) REP(3, for (int it = C.vcu; it < 256 + 256; it += C.G) { if (it < 256) moba_prep_item(C, it >> 7, (it >> 4) & 7, it & 15, rep_); else gla_prep_item(C, (it - 256) >> 7, ((it - 256) >> 1) & 63, it & 1); }); SEAM(3);
    if (IN(4)) REP(4, for (int it = C.vcu; it < 256 + 1024; it += C.G) { if (it < 256) moba_select_item(C, it >> 7, (it >> 4) & 7, it & 15, rep_); else { const int g_ = it - 256; gla_u_item(C, g_ >> 9, (g_ >> 6) & 7, g_ & 63); } }); SEAM(4);
    if (IN(5)) REP(5, p5_attn_phase(C, rep_)); SEAM(5);
    if (IN(6)) REP(6, for (int it = C.vcu; it < 1024; it += C.G) gla_out_item(C, it >> 9, (it >> 6) & 7, it & 63); for (int t = C.gw; t < T; t += C.ngw) moba_merge_token(C, (size_t)t)); SEAM(6);
    if (IN(7)) REP(7, pg8::Gemm g{C.CONCAT, C.WOUT, T, D, D}; pg8::StaticOrder S; S.init(T, D, C.G, (int)blockIdx.x); pg8::EpiResGate E{C.x, C.out, D, C.MOD + 2 * D, NMOD, SEQ / 256};
                 pg8::gemm_phase<pg8::EpiResGate, pg8::StaticOrder, PG8_ALIGN, PG8_SP2>(C.lds, g, S, E)); SEAM(7);
    if (IN(8)) REP(8, norm_mod_phase<false>(C, C.out, C.g2, 3 * D, 4 * D, C.H)); SEAM(8);
    if (IN(9)) REP(9, int upm_ = -1; int upn_ = 0; first_unit(T / 256, D / 256, C.G, (int)blockIdx.x, upm_, upn_);
                 { pg8::Gemm g{C.H, C.WQ, T, D, D}; pg8::StaticOrder S; S.init(T, D, C.G, (int)blockIdx.x); pg8::EpiLdsTile E{}; pg8::gemm_phase<pg8::EpiLdsTile, pg8::StaticOrder, false, PG8_SP2>(C.lds, g, S, E); }
                 __syncthreads(); if (upm_ >= 0) peer_topk_item(C, upm_ * 8 + C.wave, upn_, C.lds, 32 * C.wave); __syncthreads()); SEAM(9);
    if (IN(10)) REP(10, peer_expert_phase<0>(C, nullptr, rep_)); SEAM(10);
    if (IN(11)) REP(11, for (int t = C.gw; t < T; t += C.ngw) peer_weights_token(C, (size_t)t)); SEAM(11);
    if (IN(12)) REP(12, peer_expert_phase<1>(C, rep_ ? C.QP : C.out, rep_));
    if (PROBE_TS >= 0) { xcd_barrier(bar); if (blockIdx.x == 0 && threadIdx.x == 0) { volatile LAS unsigned long long* ts = (volatile LAS unsigned long long*)(C.lds + RING_BYTES + 8192); const unsigned long long tend = __builtin_amdgcn_s_memrealtime();
        const unsigned long long d = (PROBE_TS == 12 ? tend : ts[PROBE_TS + 1]) - ts[PROBE_TS]; C.out[0] += (float)d * 0.001f; } }
#undef IN
#undef SEAM
}

extern "C" void kernel_launch(void* const* d_in, const int* in_sizes, int n_in, void* d_out, int out_size, void* d_ws, size_t ws_size, hipStream_t stream) {
    static int grid = 0;
    if (grid == 0) {
        if (n_in != 18 || in_sizes[0] != T * D || out_size != T * D || ws_size < WS_END) { fprintf(stderr, "kernel_launch: shape/workspace mismatch (n_in %d, in0 %d, out %d, ws %zu, need %zu); nothing launched\n", n_in, n_in > 0 ? in_sizes[0] : -1, out_size, ws_size, (size_t)WS_END); grid = -1; return; }
        int dev = 0, cus = 0, per_cu = 0;
        if (hipGetDevice(&dev) != hipSuccess || hipDeviceGetAttribute(&cus, hipDeviceAttributeMultiprocessorCount, dev) != hipSuccess) { fprintf(stderr, "kernel_launch: device query failed\n"); grid = -1; return; }
        if (hipFuncSetAttribute((const void*)fwd_kernel, hipFuncAttributeMaxDynamicSharedMemorySize, LDS_BYTES) != hipSuccess) { fprintf(stderr, "kernel_launch: hipFuncSetAttribute failed\n"); grid = -1; return; }
        if (hipOccupancyMaxActiveBlocksPerMultiprocessor(&per_cu, (const void*)fwd_kernel, NTHREADS, LDS_BYTES) != hipSuccess || per_cu < 1) { fprintf(stderr, "kernel_launch: occupancy query reports %d workgroups per CU\n", per_cu); (void)hipGetLastError(); grid = -1; return; }
        grid = cus;
    }
    if (grid < 0) return;
    if (hipMemsetAsync((char*)d_ws + WS_CTL, 0, CTL_ZERO_BYTES, stream) != hipSuccess) { fprintf(stderr, "kernel_launch: memset failed\n"); return; }
    Args a{};
    for (int i = 0; i < 18; ++i) a.in[i] = d_in[i];
    a.out = (float*)d_out; a.ws = (unsigned char*)d_ws;
#if MK_N_LAUNCHES == 1
    a.ph_lo = 0; a.ph_hi = N_PHASES;
    void* kargs[] = {&a};
#if defined(MK_PLAIN_LAUNCH)
    (void)kargs; hipLaunchKernelGGL(fwd_kernel, dim3(grid), dim3(NTHREADS), LDS_BYTES, stream, a);
#else
    hipError_t le = hipLaunchCooperativeKernel((const void*)fwd_kernel, dim3(grid), dim3(NTHREADS), kargs, LDS_BYTES, stream);
    if (le != hipSuccess) fprintf(stderr, "kernel_launch: cooperative launch failed: %s (grid %d)\n", hipGetErrorName(le), grid);
#endif
#else
    for (int p = 0; p < N_PHASES; ++p) { a.ph_lo = p; a.ph_hi = p + 1; hipLaunchKernelGGL(fwd_kernel, dim3(grid), dim3(NTHREADS), LDS_BYTES, stream, a); }
#endif
}
```

```cpp
#include <hip/hip_runtime.h>
#include <hip/hip_bf16.h>
#include <cstdio>
#include <cstdint>
#include <cmath>
namespace pg8 {
#define PG8_LAS __attribute__((address_space(3)))
typedef unsigned short bf16_t;
typedef short bf16x8 __attribute__((ext_vector_type(8)));
typedef float f32x4 __attribute__((ext_vector_type(4)));
typedef unsigned u32x4 __attribute__((ext_vector_type(4)));
constexpr int BM = 256, BK = 64, HALF = 128, HTB = HALF * BK * 2  , STAGE_BYTES = 8 * HTB, NXCD = 8, WGM = 8;

__host__ __device__ __forceinline__ int lds_byte(int r, int c) { const int st = (r >> 4) * 2 + (c >> 5), rr = r & 15, cc = c & 31, ob = rr * 64 + cc * 2; return st * 1024 + (ob ^ (((ob >> 9) & 1) << 5)); }
__host__ __device__ __forceinline__ void stage_rc(int b, int& R, int& C) { const int st = b / 1024, sb = b % 1024, swz = sb ^ (((sb >> 9) & 1) << 5); R = (st >> 1) * 16 + swz / 64; C = (st & 1) * 32 + (swz % 64) / 2; }
__host__ __device__ __forceinline__ int perm32(int rho) { const int n = rho >> 4, i = rho & 15; return 8 * (i >> 2) + 4 * n + (i & 3); }

struct Unit { int pm, pn; };
struct Gemm { const bf16_t* A; const bf16_t* Bt; int M, N, K; };

struct StaticOrder {
    int nM, nN, nwg, G, c;
    __host__ __device__ void init(int M, int N, int G_, int c_) { nM = M / BM; nN = N / BM; nwg = nM * nN; G = G_; c = c_; }
    __host__ __device__ bool next(int i, Unit& u) const {
        const long L = (long)i * G + c; if (L >= nwg) return false;
        int wgid = (int)L; { const int q = nwg / NXCD, r = nwg % NXCD, xcd = wgid % NXCD, off = wgid / NXCD; wgid = (xcd < r ? xcd * (q + 1) : r * (q + 1) + (xcd - r) * q) + off; }
        const int nig = WGM * nN, gid = wgid / nig, fm = gid * WGM, gsz = (nM - fm) < WGM ? (nM - fm) : WGM;
        u.pm = fm + ((wgid % nig) % gsz); u.pn = (wgid % nig) / gsz; return true;
    }
    __device__ __forceinline__ void a_ready(const Unit&) const {}
    __device__ __forceinline__ void done(const Unit&) const {}
};

__device__ __forceinline__ unsigned cvt_pk_bf16(float lo, float hi) { unsigned r; asm volatile("v_cvt_pk_bf16_f32 %0, %1, %2" : "=v"(r) : "v"(lo), "v"(hi)); return r; }
typedef float f32x2 __attribute__((ext_vector_type(2)));
__device__ __forceinline__ f32x2 gelu_pk(f32x2 v) {
    const f32x2 av = __builtin_elementwise_abs(v), d = av * 0.2316418882f + 1.0f;
    f32x2 t; t.x = __builtin_amdgcn_rcpf(d.x); t.y = __builtin_amdgcn_rcpf(d.y);
    f32x2 q = t * 0.5307027145f + (-0.7265760135f); q = q * t + 0.7107068705f; q = q * t + (-0.142248368f); q = q * t + 0.127414796f; q = q * t;
    const f32x2 s = (v * v) * (-0.72134752044f);
    f32x2 e; e.x = __builtin_amdgcn_exp2f(s.x); e.y = __builtin_amdgcn_exp2f(s.y);
    const f32x2 m = v * (q * e), r = v - m;
    f32x2 o; o.x = v.x < 0.f ? m.x : r.x; o.y = v.y < 0.f ? m.y : r.y; return o;
}

template <int ACT  > struct EpiBf16 {
    static constexpr bool PERM = true, AFTER_DRAIN = false; static_assert(ACT == 0 || ACT == 1, "EpiBf16: ACT is 0 (none) or 1 (gelu_pk)");
    bf16_t* O; int ldc; const float* bias; int split_cols; size_t split_stride; float scale0;
    __device__ __forceinline__ void operator()(const f32x4 (&acc)[2][2][4][2], const Unit& u, int wr, int wc, int fr, int fq) const {
        const int row0 = u.pm * BM + wr * 64 + fr; int colt = u.pn * BM; bf16_t* base = O;
        float sc = 1.f; if (split_cols) { const int t = colt / split_cols; base += (size_t)t * split_stride; colt -= t * split_cols; if (t == 0) sc = scale0; }
        const int col0 = colt + wc * 32 + 8 * fq, bcol0 = u.pn * BM + wc * 32 + 8 * fq;
        f32x4 bv[2][2];
#pragma unroll
        for (int bj = 0; bj < 2; ++bj)
#pragma unroll
            for (int n = 0; n < 2; ++n) bv[bj][n] = bias ? *(const f32x4*)(bias + bcol0 + bj * HALF + 4 * n) : (f32x4){0.f, 0.f, 0.f, 0.f};
#pragma unroll
        for (int ai = 0; ai < 2; ++ai)
#pragma unroll
            for (int m = 0; m < 4; ++m) { bf16_t* rowp = base + (size_t)(row0 + ai * HALF + m * 16) * ldc + col0;
#pragma unroll
                for (int bj = 0; bj < 2; ++bj) { f32x4 v0 = acc[ai][bj][m][0] + bv[bj][0], v1 = acc[ai][bj][m][1] + bv[bj][1];
                    if (ACT == 1) { f32x2 a = gelu_pk((f32x2){v0[0], v0[1]}), b = gelu_pk((f32x2){v0[2], v0[3]}), c = gelu_pk((f32x2){v1[0], v1[1]}), d = gelu_pk((f32x2){v1[2], v1[3]});
                        v0 = (f32x4){a.x, a.y, b.x, b.y}; v1 = (f32x4){c.x, c.y, d.x, d.y}; }
                    v0 = v0 * sc; v1 = v1 * sc; u32x4 w; w.x = cvt_pk_bf16(v0[0], v0[1]); w.y = cvt_pk_bf16(v0[2], v0[3]); w.z = cvt_pk_bf16(v1[0], v1[1]); w.w = cvt_pk_bf16(v1[2], v1[3]);
                    *(u32x4*)(rowp + bj * HALF) = w; } }
    }
};
struct EpiF32 {
    static constexpr bool PERM = false, AFTER_DRAIN = false;
    float* C; int ldc; const float* bias;
    __device__ __forceinline__ void operator()(const f32x4 (&acc)[2][2][4][2], const Unit& u, int wr, int wc, int fr, int fq) const {
        const int row0 = u.pm * BM + wr * 64 + fr, col0 = u.pn * BM + wc * 32 + 4 * fq;
        f32x4 bv[2][2];
#pragma unroll
        for (int bj = 0; bj < 2; ++bj)
#pragma unroll
            for (int n = 0; n < 2; ++n) bv[bj][n] = bias ? *(const f32x4*)(bias + col0 + bj * HALF + n * 16) : (f32x4){0.f, 0.f, 0.f, 0.f};
#pragma unroll
        for (int ai = 0; ai < 2; ++ai)
#pragma unroll
            for (int m = 0; m < 4; ++m) { float* rowp = C + (size_t)(row0 + ai * HALF + m * 16) * ldc + col0;
#pragma unroll
                for (int bj = 0; bj < 2; ++bj)
#pragma unroll
                    for (int n = 0; n < 2; ++n) *(f32x4*)(rowp + bj * HALF + n * 16) = acc[ai][bj][m][n] + bv[bj][n]; }
    }
};
struct EpiResGate {
    static constexpr bool PERM = false, AFTER_DRAIN = false;
    const float* X; float* O; int ldc; const float* gate; int gate_stride, tiles_per_batch;
    __device__ __forceinline__ void operator()(const f32x4 (&acc)[2][2][4][2], const Unit& u, int wr, int wc, int fr, int fq) const {
        const int row0 = u.pm * BM + wr * 64 + fr, col0 = u.pn * BM + wc * 32 + 4 * fq;
        const float* gp = gate + (size_t)(u.pm / tiles_per_batch) * gate_stride;
        f32x4 gv[2][2];
#pragma unroll
        for (int bj = 0; bj < 2; ++bj)
#pragma unroll
            for (int n = 0; n < 2; ++n) gv[bj][n] = *(const f32x4*)(gp + col0 + bj * HALF + n * 16);
        f32x4 xv[2][2][2];
#define ERG_LOAD(idx, slot) do { const size_t off_ = (size_t)(row0 + ((idx) >> 2) * HALF + ((idx) & 3) * 16) * ldc + col0; _Pragma("unroll") for (int bj = 0; bj < 2; ++bj) _Pragma("unroll") for (int n = 0; n < 2; ++n) xv[slot][bj][n] = *(const f32x4*)(X + off_ + bj * HALF + n * 16); } while (0)
        ERG_LOAD(0, 0); ERG_LOAD(1, 1);
#pragma unroll
        for (int idx = 0; idx < 8; ++idx) { const int ai = idx >> 2, m = idx & 3; const size_t off = (size_t)(row0 + ai * HALF + m * 16) * ldc + col0;
#pragma unroll
            for (int bj = 0; bj < 2; ++bj)
#pragma unroll
                for (int n = 0; n < 2; ++n) *(f32x4*)(O + off + bj * HALF + n * 16) = xv[idx & 1][bj][n] + gv[bj][n] * acc[ai][bj][m][n];
            if (idx + 2 < 8) ERG_LOAD(idx + 2, idx & 1); }
#undef ERG_LOAD
    }
};

struct EpiLdsTile {
    static constexpr bool PERM = true, AFTER_DRAIN = true;
    __device__ __forceinline__ void operator()(const f32x4 (&)[2][2][4][2], const Unit&, int, int, int, int) const {}
    __device__ __forceinline__ void fused(f32x4 (&acc)[2][2][4][2], const Unit&, int wr, int wc, int fr, int fq, PG8_LAS unsigned char* lds, int, int) const {
#pragma unroll
        for (int ai = 0; ai < 2; ++ai)
#pragma unroll
            for (int m = 0; m < 4; ++m) { const int row = ai * HALF + wr * 64 + m * 16 + fr;
#pragma unroll
                for (int bj = 0; bj < 2; ++bj) { const f32x4 v0 = acc[ai][bj][m][0], v1 = acc[ai][bj][m][1]; u32x4 w; w.x = cvt_pk_bf16(v0[0], v0[1]); w.y = cvt_pk_bf16(v0[2], v0[3]); w.z = cvt_pk_bf16(v1[0], v1[1]); w.w = cvt_pk_bf16(v1[2], v1[3]);
                    const int chunk = 16 * bj + 4 * wc + fq; *(PG8_LAS u32x4*)(lds + row * 512 + 16 * (chunk ^ (row & 15))) = w; } }
    }
};

template <class Epi, class Sched, bool ALIGN_EPI = false, bool SP2 = false>
__device__ __forceinline__ void gemm_phase(PG8_LAS unsigned char* lds, const Gemm g, const Sched& S, const Epi& E) {
    const int tid = threadIdx.x, wid = __builtin_amdgcn_readfirstlane(tid >> 6), lane = tid & 63, wr = wid >> 2, wc = wid & 3, fr = lane & 15, fq = lane >> 4;
    const int K = g.K, nt = K / BK;
    unsigned voffA[2], voffB[2];
#pragma unroll
    for (int i = 0; i < 2; ++i) { int R, C; stage_rc(tid * 16 + i * 8192, R, C); const int Rb = Epi::PERM ? ((R & ~31) + perm32(R & 31)) : R;
        voffA[i] = (unsigned)(R * K + C) * 2u; voffB[i] = (unsigned)(Rb * K + C) * 2u; }
    const size_t kstep = (size_t)(BK * 2);
    const size_t hstep = (size_t)HALF * K * 2;
    const size_t tstep = 2 * hstep;
    const unsigned ldsw = (unsigned)wid * 1024u;
    const int aoff = lds_byte(wr * 64 + fr, fq * 8), boff = lds_byte(wc * 32 + fr, fq * 8);
#define PG8_SA(b, h) (((b) * 2 + (h)) * HTB)
#define PG8_SB(b, h) ((4 + (b) * 2 + (h)) * HTB)
#define PG8_STAGE(bufoff, gbase, voff) do { _Pragma("unroll") for (int _i = 0; _i < 2; ++_i) \
        __builtin_amdgcn_global_load_lds((const unsigned*)((const char*)(gbase) + (voff)[_i]), (PG8_LAS unsigned*)(lds + (bufoff) + ldsw + _i * 8192), 16, 0, 0); } while (0)
#define PG8_LDA(dst, b, h) do { _Pragma("unroll") for (int m = 0; m < 4; ++m) _Pragma("unroll") for (int k = 0; k < 2; ++k) dst[m][k] = *(const PG8_LAS bf16x8*)(lds + PG8_SA(b, h) + aoff + m * 2048 + k * 1024); } while (0)
#define PG8_LDB(dst, b, h) do { _Pragma("unroll") for (int n = 0; n < 2; ++n) _Pragma("unroll") for (int k = 0; k < 2; ++k) dst[n][k] = *(const PG8_LAS bf16x8*)(lds + PG8_SB(b, h) + boff + n * 2048 + k * 1024); } while (0)
#define PG8_MMA(ai, bj, At, Bt) do { __builtin_amdgcn_s_setprio(1); _Pragma("unroll") for (int m = 0; m < 4; ++m) _Pragma("unroll") for (int n = 0; n < 2; ++n) _Pragma("unroll") for (int k = 0; k < 2; ++k) \
        acc[ai][bj][m][n] = __builtin_amdgcn_mfma_f32_16x16x32_bf16(Bt[n][k], At[m][k], acc[ai][bj][m][n], 0, 0, 0); __builtin_amdgcn_s_setprio(0); } while (0)
#define PG8_WAIT_V(n) asm volatile("s_waitcnt vmcnt(" #n ")" ::: "memory")
#define PG8_WAIT_L(n) asm volatile("s_waitcnt lgkmcnt(" #n ")" ::: "memory")
#define PG8_BAR __builtin_amdgcn_s_barrier()
#define PG8_SCHED __builtin_amdgcn_sched_barrier(0)
    Unit cur, nxt; int ui = 0;
    if (!S.next(0, cur)) return;
    f32x4 acc[2][2][4][2];
#pragma unroll
    for (int a = 0; a < 2; ++a)
#pragma unroll
        for (int b = 0; b < 2; ++b)
#pragma unroll
            for (int m = 0; m < 4; ++m)
#pragma unroll
                for (int n = 0; n < 2; ++n) acc[a][b][m][n] = (f32x4){0.f, 0.f, 0.f, 0.f};
    bf16x8 At[4][2], B0[2][2], B1[2][2];
    const char* cA = (const char*)g.A + (size_t)cur.pm * tstep; const char* cB = (const char*)g.Bt + (size_t)cur.pn * tstep;
    S.a_ready(cur);
    if constexpr (SP2) {
        PG8_STAGE(PG8_SB(0, 0), cB, voffB); PG8_STAGE(PG8_SB(0, 1), cB + hstep, voffB); PG8_STAGE(PG8_SA(0, 0), cA, voffA); PG8_STAGE(PG8_SA(0, 1), cA + hstep, voffA);
        if (wr == 1) PG8_BAR;
        PG8_WAIT_V(2); PG8_BAR;
        PG8_STAGE(PG8_SB(1, 0), cB + kstep, voffB); PG8_STAGE(PG8_SA(1, 0), cA + kstep, voffA); PG8_STAGE(PG8_SB(1, 1), cB + hstep + kstep, voffB);
        PG8_WAIT_V(6); PG8_BAR;
    } else {
        PG8_STAGE(PG8_SB(0, 0), cB, voffB); PG8_STAGE(PG8_SA(0, 0), cA, voffA); PG8_STAGE(PG8_SB(0, 1), cB + hstep, voffB); PG8_STAGE(PG8_SA(0, 1), cA + hstep, voffA);
        if (wr == 1) PG8_BAR;
        PG8_WAIT_V(4); PG8_BAR;
        PG8_STAGE(PG8_SB(1, 0), cB + kstep, voffB); PG8_STAGE(PG8_SA(1, 0), cA + kstep, voffA); PG8_STAGE(PG8_SB(1, 1), cB + hstep + kstep, voffB);
        PG8_WAIT_V(6); PG8_BAR;
    }
    for (;;) {
        const bool has_next = S.next(ui + 1, nxt);
        const char* nA = has_next ? (const char*)g.A + (size_t)nxt.pm * tstep : cA; const char* nB = has_next ? (const char*)g.Bt + (size_t)nxt.pn * tstep : cB;
        for (int t = 0; t < nt; t += 2) {
            const bool last = (t == nt - 2);
            const char* a1 = cA + (size_t)(t + 1) * kstep;
            const char* a2 = last ? nA : cA + (size_t)(t + 2) * kstep; const char* b2 = last ? nB : cB + (size_t)(t + 2) * kstep;
            const char* a3 = a2 + kstep; const char* b3 = b2 + kstep;
            if (last && has_next) S.a_ready(nxt);
            if constexpr (SP2) {
            PG8_LDB(B0, 0, 0); PG8_LDB(B1, 0, 1); PG8_SCHED; PG8_LDA(At, 0, 0); PG8_STAGE(PG8_SA(1, 1), a1 + hstep, voffA);
            PG8_WAIT_V(8); PG8_WAIT_L(0); PG8_BAR; PG8_MMA(0, 0, At, B0); PG8_MMA(0, 1, At, B1); PG8_BAR; PG8_SCHED;
            PG8_LDA(At, 0, 1); PG8_STAGE(PG8_SB(0, 0), b2, voffB); PG8_STAGE(PG8_SB(0, 1), b2 + hstep, voffB); PG8_STAGE(PG8_SA(0, 0), a2, voffA);
            PG8_WAIT_V(8); PG8_WAIT_L(0); PG8_BAR; PG8_MMA(1, 0, At, B0); PG8_MMA(1, 1, At, B1); PG8_BAR; PG8_SCHED;
            PG8_LDB(B0, 1, 0); PG8_LDB(B1, 1, 1); PG8_SCHED; PG8_LDA(At, 1, 0); PG8_STAGE(PG8_SA(0, 1), a2 + hstep, voffA);
            PG8_WAIT_V(8); PG8_WAIT_L(0); PG8_BAR; PG8_MMA(0, 0, At, B0); PG8_MMA(0, 1, At, B1); PG8_BAR; PG8_SCHED;
            PG8_LDA(At, 1, 1); PG8_STAGE(PG8_SB(1, 0), b3, voffB); PG8_STAGE(PG8_SB(1, 1), b3 + hstep, voffB); PG8_STAGE(PG8_SA(1, 0), a3, voffA);
            PG8_WAIT_V(8); PG8_WAIT_L(0); PG8_BAR; PG8_MMA(1, 0, At, B0); PG8_MMA(1, 1, At, B1); PG8_BAR; PG8_SCHED;
            } else {
            PG8_LDB(B0, 0, 0); PG8_SCHED; PG8_LDA(At, 0, 0); PG8_STAGE(PG8_SA(1, 1), a1 + hstep, voffA);
            PG8_WAIT_L(8); PG8_BAR; PG8_WAIT_L(0); PG8_MMA(0, 0, At, B0); PG8_BAR; PG8_SCHED;
            PG8_LDB(B1, 0, 1); PG8_STAGE(PG8_SB(0, 0), b2, voffB);
            PG8_BAR; PG8_WAIT_L(0); PG8_MMA(0, 1, At, B1); PG8_BAR;
            PG8_LDA(At, 0, 1); PG8_STAGE(PG8_SA(0, 0), a2, voffA);
            PG8_BAR; PG8_WAIT_L(0); PG8_MMA(1, 0, At, B0); PG8_BAR; PG8_SCHED;
            PG8_STAGE(PG8_SB(0, 1), b2 + hstep, voffB);
            PG8_WAIT_V(6); PG8_BAR; PG8_MMA(1, 1, At, B1); PG8_BAR;
            PG8_LDB(B0, 1, 0); PG8_SCHED; PG8_LDA(At, 1, 0); PG8_STAGE(PG8_SA(0, 1), a2 + hstep, voffA);
            PG8_WAIT_L(8); PG8_BAR; PG8_WAIT_L(0); PG8_MMA(0, 0, At, B0); PG8_BAR; PG8_SCHED;
            PG8_LDB(B1, 1, 1); PG8_STAGE(PG8_SB(1, 0), b3, voffB);
            PG8_BAR; PG8_WAIT_L(0); PG8_MMA(0, 1, At, B1); PG8_BAR;
            PG8_LDA(At, 1, 1); PG8_STAGE(PG8_SA(1, 0), a3, voffA);
            PG8_BAR; PG8_WAIT_L(0); PG8_MMA(1, 0, At, B0); PG8_BAR; PG8_SCHED;
            PG8_STAGE(PG8_SB(1, 1), b3 + hstep, voffB);
            PG8_WAIT_V(6); PG8_BAR; PG8_MMA(1, 1, At, B1); PG8_BAR;
            }
        }
        if constexpr (ALIGN_EPI) { if (wr == 0) PG8_BAR; }
        if constexpr (!Epi::AFTER_DRAIN) { E(acc, cur, wr, wc, fr, fq); S.done(cur); }
        if (!has_next) break;
#pragma unroll
        for (int a = 0; a < 2; ++a)
#pragma unroll
            for (int b = 0; b < 2; ++b)
#pragma unroll
                for (int m = 0; m < 4; ++m)
#pragma unroll
                    for (int n = 0; n < 2; ++n) acc[a][b][m][n] = (f32x4){0.f, 0.f, 0.f, 0.f};
        cur = nxt; cA = nA; cB = nB; ++ui;
        if constexpr (ALIGN_EPI) { if (wr == 1) PG8_BAR; }
    }
    PG8_WAIT_V(0);
    if constexpr (!ALIGN_EPI) { if (wr == 0) PG8_BAR; }
    PG8_BAR;
    if constexpr (Epi::AFTER_DRAIN) { E.fused(acc, cur, wr, wc, fr, fq, lds, wid, lane); S.done(cur); }
#undef PG8_SA
#undef PG8_SB
#undef PG8_STAGE
#undef PG8_LDA
#undef PG8_LDB
#undef PG8_MMA
#undef PG8_WAIT_V
#undef PG8_WAIT_L
#undef PG8_BAR
#undef PG8_SCHED
}
}

#ifndef PG8_SP2
#define PG8_SP2 true
#endif
#ifndef PG8_ALIGN
#define PG8_ALIGN true
#endif
constexpr int NWAVES = 8, NTHREADS = NWAVES * 64;
constexpr int BATCH = 2, SEQ = 4096, T = BATCH * SEQ, D = 2048;
constexpr int INW = 6160, NPROJ = 6144;
constexpr int GQ = 0, GK = 512, GV = 1024, GG = 2048, MQ = 3072, MK = 4096, MV = 5120;
constexpr int GA_SRC = 3072;
constexpr int NH = 8, NEXP = 16384, NMOD = 6 * D;
constexpr float EPS = 1e-6f;
#ifndef MK_N_LAUNCHES
#define MK_N_LAUNCHES 1
#endif
constexpr int N_PHASES = 13;
#ifndef P3_GLA_TWICE
#define P3_GLA_TWICE 0
#endif
#ifndef PROBE_TS
#define PROBE_TS -1
#endif
constexpr int NSL = 8, SLW = 256, PCH = 128, NCHUNK = (BATCH * SEQ) / PCH;

constexpr size_t MiB = 1u << 20;
constexpr size_t WS_CTL = 0, CTL_ZERO_BYTES = 128 * 1024;
constexpr size_t WS_WIN = 1 * MiB, WS_WGA = 25 * MiB, WS_WOUT = 26 * MiB, WS_WQ = 34 * MiB, WS_KEYS = 42 * MiB, WS_CS = 43 * MiB, WS_KMEAN = 44 * MiB, WS_DEC = 45 * MiB;
constexpr size_t WS_UB = 46 * MiB, WS_VB = 110 * MiB, WS_H = 174 * MiB, WS_CONCAT = 206 * MiB, WS_BCUM = 238 * MiB, WS_UT = 254 * MiB, WS_ST = 286 * MiB, WS_PROJ = 302 * MiB;
constexpr size_t WS_QP = WS_PROJ, WS_EXP = 366 * MiB, WS_GATE = 370 * MiB, WS_GU = 374 * MiB, WS_ACT = 378 * MiB, WS_HQ = 382 * MiB, WS_QDEC = 398 * MiB, WS_KDEC = 406 * MiB, WS_KUPD = 414 * MiB, WS_PART = 422 * MiB, WS_ML = 486 * MiB, WS_LIST = 488 * MiB, WS_SEL = 492 * MiB, WS_PW = 493 * MiB, WS_WSC = 494 * MiB, WS_END = 495 * MiB;
constexpr size_t WS_US = WS_UB + 40 * MiB, WS_VS = WS_VB + 40 * MiB, WS_HS = WS_VB + 41 * MiB;
constexpr int CW_BAR = 4096, CW_Q = 8192, CW_QA = 12288, CW_QB = 13312, CW_LCNT = 14336, CW_MOD = 16384;
static_assert((CW_MOD + 2048) * 4 <= (int)CTL_ZERO_BYTES, "CTL words inside the memset region");
constexpr size_t WS_MODF = 45 * MiB + 512 * 1024;

constexpr int RING_BYTES = 131072, MISC_OFF = RING_BYTES + 320, LDS_BYTES = 147456;

#define GAS __attribute__((address_space(1)))
#define LAS __attribute__((address_space(3)))
typedef unsigned short bf16;
typedef unsigned v4u __attribute__((ext_vector_type(4)));
typedef unsigned v2u __attribute__((ext_vector_type(2)));
typedef float f32x4 __attribute__((ext_vector_type(4)));
typedef float f32x2 __attribute__((ext_vector_type(2)));
typedef float f32x16 __attribute__((ext_vector_type(16)));
typedef short bf16x8 __attribute__((ext_vector_type(8)));
typedef short s16x4 __attribute__((ext_vector_type(4)));
typedef __bf16 bf16x2_t __attribute__((ext_vector_type(2)));
typedef GAS unsigned gu32;
#define LDS_WAIT() asm volatile("s_waitcnt lgkmcnt(0)" ::: "memory")
#define VM_WAIT() asm volatile("s_waitcnt vmcnt(0)" ::: "memory")
__device__ __forceinline__ unsigned pk2(float lo, float hi) { f32x2 v = {lo, hi}; bf16x2_t b = __builtin_convertvector(v, bf16x2_t); return __builtin_bit_cast(unsigned, b); }
__device__ __forceinline__ float bflo(unsigned u) { return __uint_as_float(u << 16); }
__device__ __forceinline__ float bfhi(unsigned u) { return __uint_as_float(u & 0xffff0000u); }
__device__ __forceinline__ float bf1(short s) { return __uint_as_float(((unsigned)(unsigned short)s) << 16); }
__device__ __forceinline__ bf16x8 pack8(float a0, float a1, float a2, float a3, float a4, float a5, float a6, float a7) { v4u w; w.x = pk2(a0, a1); w.y = pk2(a2, a3); w.z = pk2(a4, a5); w.w = pk2(a6, a7); return __builtin_bit_cast(bf16x8, w); }
__device__ __forceinline__ int crow(int r, int hi) { return (r & 3) + 8 * (r >> 2) + 4 * hi; }
__device__ __forceinline__ float wave_sum(float v) {
#pragma unroll
    for (int o = 1; o < 64; o <<= 1) v += __shfl_xor(v, o);
    return v;
}
typedef short v4i16_t __attribute__((ext_vector_type(4)));
__device__ __forceinline__ s16x4 vtr(const LAS unsigned char* p) { return __builtin_bit_cast(s16x4, __builtin_amdgcn_ds_read_tr16_b64_v4i16((LAS v4i16_t*)p)); }
__device__ __forceinline__ bf16x8 cat4(s16x4 lo, s16x4 hi) { return (bf16x8){lo[0], lo[1], lo[2], lo[3], hi[0], hi[1], hi[2], hi[3]}; }
#define MFMA32(a, b, c) __builtin_amdgcn_mfma_f32_32x32x16_bf16((a), (b), (c), 0, 0, 0)
#define XB_TMO      128
#define XB_XCNT(j)  (256  + 64 * (j))
#define XB_XSUB(j)  (1280 + 64 * (j))
#define XB_XGEN(j)  (2304 + 64 * (j))
#define XB_TOP      3328
#define XB_TOPGEN   3392
#define XCD_BAR_WORDS 3456
#define XB_SPIN_CAP (1u << 18)

__device__ __forceinline__ unsigned xb_ld(unsigned* p)              { return __hip_atomic_load(p, __ATOMIC_RELAXED, __HIP_MEMORY_SCOPE_AGENT); }
__device__ __forceinline__ unsigned xb_add(unsigned* p, unsigned v) { return __hip_atomic_fetch_add(p, v, __ATOMIC_RELAXED, __HIP_MEMORY_SCOPE_AGENT); }
__device__ __forceinline__ unsigned xb_xcc_id() { return (unsigned)__builtin_amdgcn_s_getreg((3 << 11) | 20) & 0xFu; }
#define XB_SPIN(cond, bar) do { unsigned _sp = 0; while (cond) { __builtin_amdgcn_s_sleep(1); \
    if ((++_sp & 255u) == 0u) { if (xb_ld(&(bar)[XB_TMO])) break; if (_sp > XB_SPIN_CAP) { atomicAdd(&(bar)[XB_TMO], 1u); break; } } } } while (0)

struct XcdBarrier {
    unsigned* bar; unsigned x;
    volatile LAS unsigned* st;
};

__device__ __forceinline__ XcdBarrier xcd_barrier_post(unsigned* bar, volatile LAS unsigned* st) {
    XcdBarrier b; b.bar = bar; b.x = xb_xcc_id(); b.st = st;
    if (threadIdx.x == 0) (void)xb_add(&bar[XB_XCNT(b.x)], 1u);
    return b;
}
__device__ __forceinline__ void xcd_barrier_complete(unsigned* bar, unsigned x, unsigned& nloc, unsigned& nx) {
    const unsigned G = gridDim.x * gridDim.y * gridDim.z;
    unsigned sum, cnt, mine, sp = 0u;
    for (;;) {
        sum = 0u; cnt = 0u; mine = 0u;
#pragma unroll
        for (unsigned j = 0; j < 16; ++j) { const unsigned c = xb_ld(&bar[XB_XCNT(j)]); sum += c; cnt += (c > 0u) ? 1u : 0u; mine = (j == x) ? c : mine; }
        if (sum == G) break;
        __builtin_amdgcn_s_sleep(1);
        if ((++sp & 255u) == 0u) { if (xb_ld(&bar[XB_TMO])) break; if (sp > XB_SPIN_CAP) { atomicAdd(&bar[XB_TMO], 1u); break; } }
    }
    nloc = mine > 0u ? mine : 1u; nx = cnt > 0u ? cnt : 1u;
}

__device__ __forceinline__ void xcd_barrier(const XcdBarrier& b) {
    asm volatile("s_waitcnt vmcnt(0)" ::: "memory");
    __syncthreads();
    if (threadIdx.x == 0) {
        unsigned* bar = b.bar;
        __builtin_amdgcn_s_waitcnt(0);
        unsigned nloc = b.st[0], nx = b.st[1];
        if (nloc == 0u) { xcd_barrier_complete(bar, b.x, nloc, nx); b.st[0] = nloc; b.st[1] = nx; }
        const unsigned old = xb_add(&bar[XB_XSUB(b.x)], 1u);
        const unsigned gen = old / nloc;
        if (old + 1u == (gen + 1u) * nloc) {
            __builtin_amdgcn_fence(__ATOMIC_RELEASE, "agent");
            asm volatile("s_waitcnt vmcnt(0)" ::: "memory");
            const unsigned og = xb_add(&bar[XB_TOP], 1u);
            const unsigned tg = og / nx;
            if (og + 1u == (tg + 1u) * nx) xb_add(&bar[XB_TOPGEN], 1u);
            else XB_SPIN(xb_ld(&bar[XB_TOPGEN]) == tg, bar);
            __builtin_amdgcn_fence(__ATOMIC_ACQUIRE, "agent");
            xb_add(&bar[XB_XGEN(b.x)], 1u);
            asm volatile("s_waitcnt vmcnt(0)" ::: "memory");
        } else {
            XB_SPIN(xb_ld(&bar[XB_XGEN(b.x)]) == gen, bar);
            __builtin_amdgcn_fence(__ATOMIC_ACQUIRE, "agent");
            asm volatile("s_waitcnt vmcnt(0)" ::: "memory");
        }
    }
    __syncthreads();
}

struct Ctx {
    LAS unsigned char* lds;
    int tid, lane, wave, vcu, G, gw, ngw;
    const float *x, *c; const int* pos; const float *w_ada, *b_ada, *g1, *w_in, *w_a2, *b_a, *gla_g, *qg, *kg, *w_out, *g2, *w_q, *keys, *pu, *pv;
    float* out;
    unsigned* ctl; long long* MODI; float* MOD;
    bf16 *WIN, *WGA, *WOUT, *WQ, *KEYSB, *H, *CONCAT, *PROJ, *ST, *QDEC, *KDEC, *KUPD, *PART; float* ML; unsigned short *LIST, *SEL; unsigned* PW; float* WSC;
    unsigned char *UQ, *VQ, *HQ;
    float *CS, *KMEAN, *DEC, *BCUM, *UT, *QP, *GATE, *GU, *US, *VS, *HS; int *EXPI, *ACT;
};

__device__ __forceinline__ void transpose_item(const float* W, int ldw, int K, bf16* WT, int dst_row0, int k0, int n0, LAS float* scr, int lane) {
#pragma unroll 8
    for (int i = 0; i < 32; ++i) { const int kk = 2 * i + (lane >> 5); scr[kk * 33 + (lane & 31)] = W[(size_t)(k0 + kk) * ldw + n0 + (lane & 31)]; }
    LDS_WAIT(); asm volatile("" ::: "memory");
    const int c = lane & 7;
#pragma unroll
    for (int j = 0; j < 4; ++j) { const int n = (lane >> 3) + 8 * j; const LAS float* s = scr + (8 * c) * 33 + n;
        v4u o; o.x = pk2(s[0 * 33], s[1 * 33]); o.y = pk2(s[2 * 33], s[3 * 33]); o.z = pk2(s[4 * 33], s[5 * 33]); o.w = pk2(s[6 * 33], s[7 * 33]);
        *(v4u*)(WT + (size_t)(dst_row0 + n) * K + k0 + 8 * c) = o; }
    LDS_WAIT(); asm volatile("" ::: "memory");
}
__device__ __forceinline__ void convert_item(const float* src, bf16* dst, size_t item, int lane) {
    const f32x4* s = (const f32x4*)(src + item * 8192) + 2 * lane; v4u* d = (v4u*)(dst + item * 8192) + lane;
#pragma unroll 4
    for (int it = 0; it < 16; ++it) { const f32x4 a = s[it * 128], b = s[it * 128 + 1]; v4u o; o.x = pk2(a.x, a.y); o.y = pk2(a.z, a.w); o.z = pk2(b.x, b.y); o.w = pk2(b.z, b.w); d[it * 64] = o; }
}
__device__ __forceinline__ float wave_max(float v) {
#pragma unroll
    for (int o = 1; o < 64; o <<= 1) v = fmaxf(v, __shfl_xor(v, o));
    return v;
}
__device__ __forceinline__ void quant_store(const f32x4 (&v)[8], unsigned char* dst, float* scales, int row, size_t nrows, int lane, int bias) {
    float am = 0.f;
#pragma unroll
    for (int j = 0; j < 8; ++j) am = fmaxf(am, fmaxf(fmaxf(fabsf(v[j].x), fabsf(v[j].y)), fmaxf(fabsf(v[j].z), fabsf(v[j].w))));
    am = wave_max(am);
    const float inv = am > 0.f ? 127.f / am : 0.f;
    if (lane == 0) scales[row] = am > 0.f ? am / 127.f : 1.f;
#pragma unroll
    for (int j = 0; j < 8; ++j) { const int q0 = (int)rintf(v[j].x * inv) + bias, q1 = (int)rintf(v[j].y * inv) + bias, q2 = (int)rintf(v[j].z * inv) + bias, q3 = (int)rintf(v[j].w * inv) + bias;
        *(unsigned*)(dst + ((size_t)j * nrows + row) * 256 + 4 * lane) = (unsigned)(q0 & 0xff) | ((unsigned)(q1 & 0xff) << 8) | ((unsigned)(q2 & 0xff) << 16) | ((unsigned)(q3 & 0xff) << 24); }
}
__device__ __forceinline__ void quant_row(const float* src, unsigned char* dst, float* scales, int row, size_t nrows, int lane, int bias) {
    const f32x4* s = (const f32x4*)src + lane; f32x4 v[8];
#pragma unroll
    for (int j = 0; j < 8; ++j) v[j] = s[64 * j];
    quant_store(v, dst, scales, row, nrows, lane, bias);
}
__device__ __forceinline__ void p0_phase(const Ctx& C, int rep) {
    const int lane = C.lane, gw = C.gw, ngw = C.ngw;
    LAS float* sc = (LAS float*)C.lds;
    LAS float* part = sc + BATCH * D;
    for (int i = C.tid; i < BATCH * D; i += NTHREADS) { const float v = C.c[i]; sc[i] = v / (1.f + __expf(-v)); }
    __syncthreads();
    for (int it = C.vcu; it < 192; it += C.G) {
        const int cq = lane & 15, rg = lane >> 4, col = it * 64 + 4 * cq, r0 = 256 * C.wave + rg;
        const f32x4* w = (const f32x4*)(C.w_ada + (size_t)r0 * NMOD + col); const LAS float* s0 = sc + r0; const LAS float* s1 = sc + D + r0;
        f32x4 a0 = {0.f, 0.f, 0.f, 0.f}, a1 = a0;
#pragma unroll 16
        for (int k = 0; k < 64; ++k) { const f32x4 wv = w[(size_t)k * NMOD]; a0 += s0[4 * k] * wv; a1 += s1[4 * k] * wv; }
#pragma unroll
        for (int q = 0; q < 4; ++q) { a0[q] += __shfl_xor(a0[q], 16); a0[q] += __shfl_xor(a0[q], 32); a1[q] += __shfl_xor(a1[q], 16); a1[q] += __shfl_xor(a1[q], 32); }
        if (rg == 0) { *(LAS f32x4*)(part + (C.wave * 2 + 0) * 64 + 4 * cq) = a0; *(LAS f32x4*)(part + (C.wave * 2 + 1) * 64 + 4 * cq) = a1; }
        __syncthreads();
        if (C.tid < 128) { const int bb = C.tid >> 6, cl = C.tid & 63; float s = 0.f;
#pragma unroll
            for (int ww = 0; ww < 8; ++ww) s += part[(ww * 2 + bb) * 64 + cl];
            C.MOD[bb * NMOD + it * 64 + cl] = s + C.b_ada[it * 64 + cl]; }
        __syncthreads();
    }
    LAS float* scr = (LAS float*)(C.lds + C.wave * 16384);
    constexpr int I_IN = 32 * 192, I_SQ = 32 * 64;
    for (int it = gw; it < I_IN + 2 * I_SQ; it += ngw) {
        int r = it;
        if (r < I_IN) { const int kb = r / 192, nb = r % 192, n0 = 32 * nb; transpose_item(C.w_in, INW, D, C.WIN, n0, 64 * kb, n0 < 3072 ? n0 : n0 + 16, scr, lane); continue; } r -= I_IN;
        if (r < I_SQ) { transpose_item(C.w_out, D, D, C.WOUT, 32 * (r % 64), 64 * (r / 64), 32 * (r % 64), scr, lane); continue; } r -= I_SQ;
        transpose_item(C.w_q, D, D, C.WQ, 32 * (r % 64), 64 * (r / 64), 32 * (r % 64), scr, lane);
    }
    for (int it = gw; it < 32; it += ngw) { const int k = it * 64 + lane; const f32x4* s = (const f32x4*)(C.w_in + (size_t)k * INW + GA_SRC);
#pragma unroll
        for (int q = 0; q < 4; ++q) { const f32x4 v = s[q]; C.WGA[(4 * q + 0) * D + k] = (bf16)(pk2(v.x, 0.f) & 0xffff); C.WGA[(4 * q + 1) * D + k] = (bf16)(pk2(v.y, 0.f) & 0xffff);
            C.WGA[(4 * q + 2) * D + k] = (bf16)(pk2(v.z, 0.f) & 0xffff); C.WGA[(4 * q + 3) * D + k] = (bf16)(pk2(v.w, 0.f) & 0xffff); } }
    for (int it = gw; it < NEXP; it += ngw) {
        const f32x4* su = (const f32x4*)(C.pu + (size_t)it * D) + lane; const f32x4* sv = (const f32x4*)(C.pv + (size_t)it * D) + lane; f32x4 vu[8], vv[8];
#pragma unroll
        for (int j = 0; j < 8; ++j) { vu[j] = su[64 * j]; vv[j] = sv[64 * j]; }
        quant_store(vu, C.UQ, C.US, it, NEXP, lane, 0); quant_store(vv, C.VQ, C.VS, it, NEXP, lane, 0);
    }
    for (int it = gw; it < 32; it += ngw) convert_item(C.keys, C.KEYSB, it, lane);
    for (int idx = C.vcu * NTHREADS + C.tid; idx < T * 16; idx += C.G * NTHREADS) {
        const int t = idx >> 4, f = idx & 15; const float inv = powf(500000.0f, -(float)f * 0.0625f); const float ang = (float)C.pos[t] * inv;
        C.CS[2 * idx] = cosf(ang); C.CS[2 * idx + 1] = sinf(ang);
    }
}

__device__ __forceinline__ float modi_to_f32(long long v) { return (float)(int)(v >> 32) * 0.00390625f + (float)(unsigned)v * 9.094947017729282e-13f; }
template <bool FIRST> __device__ __forceinline__ void norm_mod_phase(const Ctx& C, const float* X, const float* g, int shift_off, int scale_off, bf16* O) {
    LAS float* lg = (LAS float*)C.lds; LAS float* lsh = lg + D; LAS float* lsc = lsh + BATCH * D;
    for (int i = C.tid; i < D; i += NTHREADS) lg[i] = g[i];
    for (int i = C.tid; i < BATCH * D; i += NTHREADS) { const int b = i / D, j = i % D;
        lsh[i] = C.MOD[b * NMOD + shift_off + j]; lsc[i] = 1.f + C.MOD[b * NMOD + scale_off + j]; }
    __syncthreads();
    for (int m = C.gw; m < T; m += C.ngw) {
        const int b = m / SEQ; const f32x4* xr = (const f32x4*)(X + (size_t)m * D) + C.lane;
        f32x4 v[8]; float ss = 0.f;
#pragma unroll
        for (int j = 0; j < 8; ++j) { v[j] = xr[64 * j]; ss += (v[j].x * v[j].x + v[j].y * v[j].y) + (v[j].z * v[j].z + v[j].w * v[j].w); }
        const float rstd = rsqrtf(wave_sum(ss) * (1.f / D) + EPS);
        const LAS f32x4* g4 = (const LAS f32x4*)lg + C.lane; const LAS f32x4* sh4 = (const LAS f32x4*)(lsh + b * D) + C.lane; const LAS f32x4* sc4 = (const LAS f32x4*)(lsc + b * D) + C.lane;
        v2u* o8 = (v2u*)(O + (size_t)m * D) + C.lane;
#pragma unroll
        for (int j = 0; j < 8; ++j) { const f32x4 y = v[j] * rstd * g4[64 * j] * sc4[64 * j] + sh4[64 * j]; v2u w; w.x = pk2(y.x, y.y); w.y = pk2(y.z, y.w); o8[64 * j] = w; v[j] = y; }
        if (!FIRST) quant_store(v, C.HQ, C.HS, m, T, C.lane, 0);
    }
    __syncthreads();
}

__device__ __forceinline__ void gla_prep_item(const Ctx& C, int b, int n, int ch) {
    const int lane = C.lane, w = C.wave, fr = lane & 15, fq = lane >> 4, rt = w & 3, kh = w >> 2; const size_t t0 = (size_t)b * SEQ + 64 * n;
    const bf16* ap = C.H + (t0 + 16 * rt + fr) * D + kh * 1024 + 8 * fq; const bf16* bp = C.WGA + fr * D + kh * 1024 + 8 * fq;
    f32x4 acc = {0.f, 0.f, 0.f, 0.f};
#pragma unroll 16
    for (int s = 0; s < 32; ++s) acc = __builtin_amdgcn_mfma_f32_16x16x32_bf16(*(const bf16x8*)(ap + 32 * s), *(const bf16x8*)(bp + 32 * s), acc, 0, 0, 0);
    LAS float* gaP = (LAS float*)C.lds;
#pragma unroll
    for (int r = 0; r < 4; ++r) gaP[kh * 1024 + (16 * rt + 4 * fq + r) * 16 + fr] = acc[r];
    __syncthreads();
    const int c = C.tid & 255, th = C.tid >> 8, col = ch * 256 + c; float wc[16];
#pragma unroll
    for (int r = 0; r < 16; ++r) wc[r] = C.w_a2[r * 512 + col];
    const float ba = C.b_a[col]; float cum = 0.f, la[32];
#pragma unroll
    for (int k = 0; k < 32; ++k) { const int tok = 32 * th + k;
        const LAS f32x4* g0 = (const LAS f32x4*)(gaP + tok * 16); const LAS f32x4* g1 = (const LAS f32x4*)(gaP + 1024 + tok * 16); float z = ba;
#pragma unroll
        for (int q = 0; q < 4; ++q) { const f32x4 gv = g0[q] + g1[q]; z += gv.x * wc[4 * q] + gv.y * wc[4 * q + 1] + gv.z * wc[4 * q + 2] + gv.w * wc[4 * q + 3]; }
        cum += (fminf(z, 0.f) - __logf(1.f + __expf(-fabsf(z)))) * 0.0625f; la[k] = cum; }
    if (th == 0) gaP[2048 + c] = cum;
    __syncthreads();
    const float base = th ? gaP[2048 + c] : 0.f;
    if (th == 1) gaP[2048 + 256 + c] = cum + base;
    __syncthreads();
    const float blast = gaP[2048 + 256 + c];
    if (th == 1) C.DEC[((size_t)(b * NH + (col >> 6)) * 64 + n) * 64 + (col & 63)] = __expf(blast);
    const bf16* qp = C.PROJ + (t0 + 32 * th) * NPROJ + GQ + col; const bf16* kp = C.PROJ + (t0 + 32 * th) * NPROJ + GK + col;
    bf16* qo = C.QDEC + (t0 + 32 * th) * 512 + col; bf16* ko = C.KDEC + (t0 + 32 * th) * 512 + col; bf16* uo = C.KUPD + (t0 + 32 * th) * 512 + col;
    unsigned short qr[32], kr[32];
#pragma unroll
    for (int k = 0; k < 32; ++k) { qr[k] = qp[(size_t)k * NPROJ]; kr[k] = kp[(size_t)k * NPROJ]; }
#pragma unroll
    for (int k = 0; k < 32; ++k) { const float bb = la[k] + base, qv = __uint_as_float((unsigned)qr[k] << 16), kv = __uint_as_float((unsigned)kr[k] << 16);
        qo[(size_t)k * 512] = (bf16)(pk2(qv * 0.125f * __expf(bb), 0.f) & 0xffffu); ko[(size_t)k * 512] = (bf16)(pk2(kv * __expf(-bb), 0.f) & 0xffffu); uo[(size_t)k * 512] = (bf16)(pk2(kv * __expf(blast - bb), 0.f) & 0xffffu); }
    __syncthreads();
}
__device__ __forceinline__ void moba_prep_item(const Ctx& C, int b, int h, int blk, int rep) {
    const int lane = C.lane, w = C.wave, i = lane & 15, tg = lane >> 4; const size_t t0 = (size_t)b * SEQ + 256 * blk;
    float qg[8], kg[8], km[8];
#pragma unroll
    for (int j = 0; j < 8; ++j) { qg[j] = C.qg[8 * i + j]; kg[j] = C.kg[8 * i + j]; km[j] = 0.f; }
    v4u rawq[8], rawk[8];
#pragma unroll
    for (int it = 0; it < 8; ++it) { const size_t tok = t0 + 32 * w + 4 * it + tg; rawq[it] = *(const v4u*)(C.PROJ + tok * NPROJ + MQ + h * 128 + 8 * i); rawk[it] = *(const v4u*)(C.PROJ + tok * NPROJ + MK + h * 128 + 8 * i); }
#pragma unroll
    for (int it = 0; it < 8; ++it) {
        const size_t tok = t0 + 32 * w + 4 * it + tg;
        float cs[16];
        if (i < 4) { const f32x4* cp = (const f32x4*)(C.CS + tok * 32 + (i & 1) * 16);
#pragma unroll
            for (int q = 0; q < 4; ++q) { const f32x4 v = cp[q]; cs[4 * q] = v.x; cs[4 * q + 1] = v.y; cs[4 * q + 2] = v.z; cs[4 * q + 3] = v.w; } }
        else {
#pragma unroll
            for (int q = 0; q < 16; ++q) cs[q] = 0.f; }
#pragma unroll
        for (int which = 0; which < 2; ++which) {
            bf16* p = C.PROJ + tok * NPROJ + (which ? MK : MQ) + h * 128 + 8 * i;
            const v4u raw = which ? rawk[it] : rawq[it]; float xv[8];
            xv[0] = bflo(raw.x); xv[1] = bfhi(raw.x); xv[2] = bflo(raw.y); xv[3] = bfhi(raw.y); xv[4] = bflo(raw.z); xv[5] = bfhi(raw.z); xv[6] = bflo(raw.w); xv[7] = bfhi(raw.w);
            float ss = 0.f;
#pragma unroll
            for (int j = 0; j < 8; ++j) ss += xv[j] * xv[j];
            ss += __shfl_xor(ss, 1); ss += __shfl_xor(ss, 2); ss += __shfl_xor(ss, 4); ss += __shfl_xor(ss, 8);
            const float rstd = rsqrtf(ss * (1.f / 128.f) + EPS);
#pragma unroll
            for (int j = 0; j < 8; ++j) xv[j] = xv[j] * rstd * (which ? kg[j] : qg[j]);
#pragma unroll
            for (int j = 0; j < 8; ++j) { const float o = __shfl_xor(xv[j], 2); const float cv = cs[2 * j], sv = cs[2 * j + 1];
                if (i < 2) xv[j] = xv[j] * cv - o * sv; else if (i < 4) xv[j] = xv[j] * cv + o * sv; }
            v4u o; o.x = pk2(xv[0], xv[1]); o.y = pk2(xv[2], xv[3]); o.z = pk2(xv[4], xv[5]); o.w = pk2(xv[6], xv[7]);
            if (rep) *(v4u*)(C.CONCAT + tok * D + which * 1024 + h * 128 + 8 * i) = o; else *(v4u*)p = o;
            if (which) {
#pragma unroll
                for (int j = 0; j < 8; ++j) km[j] += xv[j]; }
        }
    }
    LAS float* red = (LAS float*)C.lds;
#pragma unroll
    for (int j = 0; j < 8; ++j) { km[j] += __shfl_xor(km[j], 16); km[j] += __shfl_xor(km[j], 32); }
    if (lane < 16) {
#pragma unroll
        for (int j = 0; j < 8; ++j) red[w * 128 + 8 * i + j] = km[j]; }
    __syncthreads();
    if (C.tid < 128) { float s = 0.f;
#pragma unroll
        for (int ww = 0; ww < 8; ++ww) s += red[ww * 128 + C.tid];
        C.KMEAN[((size_t)(b * NH + h) * 16 + blk) * 128 + C.tid] = s * (1.f / 256.f); }
    __syncthreads();
}


constexpr int KP = 272, VP = 320;
__device__ __forceinline__ void moba_select_item(const Ctx& C, int b, int h, int qb, int rep) {
    const int lane = C.lane, w = C.wave, r = lane & 31, hh = lane >> 5; const size_t tb = (size_t)b * SEQ; const int qtok = qb * 256 + 32 * w + r;
    bf16x8 qf[8];
    { const bf16* qrow = C.PROJ + MQ + h * 128 + (tb + qtok) * NPROJ + 8 * hh;
#pragma unroll
      for (int s = 0; s < 8; ++s) qf[s] = *(const bf16x8*)(qrow + 16 * s); }
    float g0 = -INFINITY, g1 = -INFINITY, g2 = -INFINITY; int i0 = -1, i1 = -1, i2 = -1;
    LAS float* kml = (LAS float*)C.lds;
    for (int i = C.tid; i < qb * 128; i += NTHREADS) kml[i] = C.KMEAN[((size_t)(b * NH + h) * 16) * 128 + i];
    __syncthreads();
    const LAS float* km = kml + 8 * hh;
    for (int j = 0; j < qb; ++j) {
        float acc = 0.f;
#pragma unroll
        for (int s = 0; s < 8; ++s) { const f32x4 k0 = *(const LAS f32x4*)(km + j * 128 + 16 * s), k1 = *(const LAS f32x4*)(km + j * 128 + 16 * s + 4);
            acc += bf1(qf[s][0]) * k0.x + bf1(qf[s][1]) * k0.y + bf1(qf[s][2]) * k0.z + bf1(qf[s][3]) * k0.w + bf1(qf[s][4]) * k1.x + bf1(qf[s][5]) * k1.y + bf1(qf[s][6]) * k1.z + bf1(qf[s][7]) * k1.w; }
        acc += __shfl_xor(acc, 32);
        if (acc > g0) { g2 = g1; i2 = i1; g1 = g0; i1 = i0; g0 = acc; i0 = j; }
        else if (acc > g1) { g2 = g1; i2 = i1; g1 = acc; i1 = j; }
        else if (acc > g2) { g2 = acc; i2 = j; }
    }
    __syncthreads();
    const int np = (i0 >= 0) + (i1 >= 0) + (i2 >= 0);
    if (hh == 0) C.SEL[(tb + qtok) * NH + h] = (unsigned short)((i0 & 15) | ((i1 & 15) << 4) | ((i2 & 15) << 8) | (np << 12));
    unsigned* lc = C.ctl + (rep ? 16384 : CW_LCNT) + ((b * NH + h) * 16) * 8; int nv = 0;
#pragma unroll
    for (int j = 0; j < 15; ++j) { const unsigned long long mk = __ballot(hh == 0 && (i0 == j || i1 == j || i2 == j)); nv = (lane == j) ? (int)__popcll(mk) : nv; }
    int basev = 0; if (lane < 15 && nv > 0) basev = (int)atomicAdd(lc + lane * 8, (unsigned)nv);
    unsigned short* lp = C.LIST + (size_t)((b * NH + h) * 16) * 4096 + (rep ? 256 * 4096 : 0);
#pragma unroll
    for (int j = 0; j < 15; ++j) { const int bj = __builtin_amdgcn_readlane(basev, j); const bool pj = hh == 0 && (i0 == j || i1 == j || i2 == j); const unsigned long long mk = __ballot(pj);
        if (pj) { const int slot = (i0 == j) ? 0 : (i1 == j) ? 1 : 2;
            const int pos = bj + (int)__builtin_amdgcn_mbcnt_hi((unsigned)(mk >> 32), __builtin_amdgcn_mbcnt_lo((unsigned)mk, 0u));
            lp[j * 4096 + pos] = (unsigned short)(qtok | (slot << 12)); } }
}
__device__ __forceinline__ void moba_attn_item(const Ctx& C, int b, int h, int kblk, bool own, int sub) {
    const int lane = C.lane, w = C.wave, r = lane & 31, hh = lane >> 5; const size_t tb = (size_t)b * SEQ; const int li = (b * NH + h) * 16 + kblk;
    { const char* kp = (const char*)(C.PROJ + (tb + kblk * 256) * NPROJ + MK + h * 128); const char* vp = (const char*)(C.PROJ + (tb + kblk * 256) * NPROJ + MV + h * 128);
#pragma unroll
      for (int i = 0; i < 8; ++i) { const int p = w + 8 * i, row = 4 * p + (lane >> 4), cp = lane & 15;
          __builtin_amdgcn_global_load_lds((const unsigned*)(kp + (size_t)row * (NPROJ * 2) + 16 * (cp ^ (row & 15))), (LAS unsigned*)(C.lds + p * 1024), 16, 0, 0);
          __builtin_amdgcn_global_load_lds((const unsigned*)(vp + (size_t)row * (NPROJ * 2) + 16 * (cp ^ ((row & 3) << 2))), (LAS unsigned*)(C.lds + 65536 + p * 1024), 16, 0, 0); } }
    const int cnt = own ? 256 : (int)C.ctl[CW_LCNT + li * 8], e = 256 * sub + 32 * w + r; const bool valid = e < cnt, wave_on = 256 * sub + 32 * w < cnt;
    int qtok, slot;
    if (own) { qtok = kblk * 256 + 32 * w + r; slot = 3; } else { const int ent = C.LIST[(size_t)li * 4096 + (valid ? e : 256 * sub)]; qtok = ent & 4095; slot = ent >> 12; }
    bf16x8 qf[8];
    { const bf16* qrow = C.PROJ + MQ + h * 128 + (tb + qtok) * NPROJ + 8 * hh;
#pragma unroll
      for (int s = 0; s < 8; ++s) qf[s] = *(const bf16x8*)(qrow + 16 * s); }
    __syncthreads();
    if (wave_on) {
        float m_run = -1e30f, l_run = 0.f; f32x16 o[4];
#pragma unroll
        for (int dt = 0; dt < 4; ++dt)
#pragma unroll
            for (int q = 0; q < 16; ++q) o[dt][q] = 0.f;
        const float c2 = 0.08838834764831845f * 1.4426950408889634f;
        const int xr = r & 15, vq = (lane & 15) >> 2, qi = 32 * w + r, ntile = own ? ((32 * w + 31) >> 6) + 1 : 4;
        const int kfo = r * 256, vfo = 65536 + (4 * hh + vq) * 256 + 32 * ((lane >> 4) & 1) + 8 * (lane & 3);
        for (int t = 0; t < ntile; ++t) {
            const LAS unsigned char* kb = C.lds + kfo + t * 16384;
            f32x16 p0, p1;
#pragma unroll
            for (int q = 0; q < 16; ++q) { p0[q] = 0.f; p1[q] = 0.f; }
#pragma unroll
            for (int ss = 0; ss < 8; ++ss) { const int co = ((2 * ss + hh) ^ xr) << 4; const bf16x8 a0 = *(const LAS bf16x8*)(kb + co), a1 = *(const LAS bf16x8*)(kb + 32 * 256 + co);
                p0 = MFMA32(a0, qf[ss], p0); p1 = MFMA32(a1, qf[ss], p1); }
            if (own) {
#pragma unroll
                for (int q = 0; q < 16; ++q) { const int kk = 64 * t + crow(q, hh); if (kk > qi) p0[q] = -INFINITY; if (kk + 32 > qi) p1[q] = -INFINITY; } }
            float mx = fmaxf(p0[0], p1[0]);
#pragma unroll
            for (int q = 1; q < 16; ++q) mx = fmaxf(mx, fmaxf(p0[q], p1[q]));
            { auto rr = __builtin_amdgcn_permlane32_swap(__float_as_uint(mx), __float_as_uint(mx), false, false); mx = fmaxf(__uint_as_float(rr[0]), __uint_as_float(rr[1])); }
            const float m_new = fmaxf(m_run, mx * c2), alpha = __builtin_amdgcn_exp2f(m_run - m_new);
            m_run = m_new; float rs = 0.f;
#pragma unroll
            for (int q = 0; q < 16; ++q) { p0[q] = __builtin_amdgcn_exp2f(p0[q] * c2 - m_new); p1[q] = __builtin_amdgcn_exp2f(p1[q] * c2 - m_new); rs += p0[q] + p1[q]; }
            l_run = l_run * alpha + rs;
            if (__ballot(alpha != 1.f) != 0ull) {
#pragma unroll
                for (int dt = 0; dt < 4; ++dt)
#pragma unroll
                    for (int q = 0; q < 16; ++q) o[dt][q] *= alpha; }
            bf16x8 pf[4];
            pf[0] = pack8(p0[0], p0[1], p0[2], p0[3], p0[4], p0[5], p0[6], p0[7]); pf[1] = pack8(p0[8], p0[9], p0[10], p0[11], p0[12], p0[13], p0[14], p0[15]);
            pf[2] = pack8(p1[0], p1[1], p1[2], p1[3], p1[4], p1[5], p1[6], p1[7]); pf[3] = pack8(p1[8], p1[9], p1[10], p1[11], p1[12], p1[13], p1[14], p1[15]);
            const LAS unsigned char* vb = C.lds + vfo + t * 16384;
#pragma unroll
            for (int dt = 0; dt < 4; ++dt) { const LAS unsigned char* vd = vb + 64 * (dt ^ vq);
#pragma unroll
                for (int kk = 0; kk < 4; ++kk) { const s16x4 lo = vtr(vd + (16 * kk) * 256), hi = vtr(vd + (16 * kk + 8) * 256); o[dt] = MFMA32(cat4(lo, hi), pf[kk], o[dt]); } }
        }
        l_run += __shfl_xor(l_run, 32);
        if (valid) { const float inv = 1.f / l_run; const size_t row = ((tb + qtok) * NH + h) * 4 + slot; bf16* op = C.PART + row * 128 + 4 * hh;
#pragma unroll
            for (int dt = 0; dt < 4; ++dt)
#pragma unroll
                for (int k4 = 0; k4 < 4; ++k4) { v2u wv; wv.x = pk2(o[dt][4 * k4] * inv, o[dt][4 * k4 + 1] * inv); wv.y = pk2(o[dt][4 * k4 + 2] * inv, o[dt][4 * k4 + 3] * inv); *(v2u*)(op + 32 * dt + 8 * k4) = wv; }
            if (hh == 0) *(f32x2*)(C.ML + row * 2) = (f32x2){m_run, l_run}; }
    }
    __syncthreads();
}
__device__ __forceinline__ void moba_merge_token(const Ctx& C, size_t t) {
    const int lane = C.lane, hd = lane >> 3, dc = lane & 7; const size_t row0 = (t * NH + hd) * 4;
    const unsigned short sel = C.SEL[t * NH + hd]; f32x2 ml[4]; v4u pa[4], pc[4];
#pragma unroll
    for (int s = 0; s < 4; ++s) { ml[s] = *(const f32x2*)(C.ML + (row0 + s) * 2); const v4u* pp = (const v4u*)(C.PART + (row0 + s) * 128 + 16 * dc); pa[s] = pp[0]; pc[s] = pp[1]; }
    const int np = sel >> 12; float M = -1e30f, wg[4], wsum = 0.f;
#pragma unroll
    for (int s = 0; s < 4; ++s) { const bool v = (s == 3) || (s < np); ml[s].x = v ? ml[s].x : -1e30f; ml[s].y = v ? ml[s].y : 0.f; M = fmaxf(M, ml[s].x); }
#pragma unroll
    for (int s = 0; s < 4; ++s) { wg[s] = ml[s].y * __builtin_amdgcn_exp2f(ml[s].x - M); wsum += wg[s]; }
    const float inv = 1.f / wsum; float acc[16];
#pragma unroll
    for (int q = 0; q < 16; ++q) acc[q] = 0.f;
#pragma unroll
    for (int s = 0; s < 4; ++s) { const unsigned vm = ((s == 3) || (s < np)) ? 0xffffffffu : 0u; const float ws_ = wg[s] * inv; v4u a = pa[s], c = pc[s];
        a.x &= vm; a.y &= vm; a.z &= vm; a.w &= vm; c.x &= vm; c.y &= vm; c.z &= vm; c.w &= vm;
        acc[0] += ws_ * bflo(a.x); acc[1] += ws_ * bfhi(a.x); acc[2] += ws_ * bflo(a.y); acc[3] += ws_ * bfhi(a.y); acc[4] += ws_ * bflo(a.z); acc[5] += ws_ * bfhi(a.z); acc[6] += ws_ * bflo(a.w); acc[7] += ws_ * bfhi(a.w);
        acc[8] += ws_ * bflo(c.x); acc[9] += ws_ * bfhi(c.x); acc[10] += ws_ * bflo(c.y); acc[11] += ws_ * bfhi(c.y); acc[12] += ws_ * bflo(c.z); acc[13] += ws_ * bfhi(c.z); acc[14] += ws_ * bflo(c.w); acc[15] += ws_ * bfhi(c.w); }
    v4u o0, o1; o0.x = pk2(acc[0], acc[1]); o0.y = pk2(acc[2], acc[3]); o0.z = pk2(acc[4], acc[5]); o0.w = pk2(acc[6], acc[7]); o1.x = pk2(acc[8], acc[9]); o1.y = pk2(acc[10], acc[11]); o1.z = pk2(acc[12], acc[13]); o1.w = pk2(acc[14], acc[15]);
    v4u* op = (v4u*)(C.CONCAT + t * D + 1024 + hd * 128 + 16 * dc); op[0] = o0; op[1] = o1;
}

constexpr int GKP = 192;
__device__ __forceinline__ void gla_v_to_lds(const Ctx& C, size_t t0, int h, int off) {
#pragma unroll
    for (int pp = 0; pp < 2; ++pp) { const int p = C.tid + 512 * pp; const v4u v = *(const v4u*)(C.PROJ + (t0 + (p >> 4)) * NPROJ + GV + h * 128 + 8 * (p & 15)); *(LAS v4u*)(C.lds + off + (p >> 4) * VP + 16 * (p & 15)) = v; }
}
__device__ __forceinline__ void gla_u_item(const Ctx& C, int b, int h, int n4) {
    const int tid = C.tid, lane = C.lane, w = C.wave, r = lane & 31, hh = lane >> 5;
    v4u kr[4], vr[4][2];
#pragma unroll
    for (int c = 0; c < 4; ++c) { const size_t t0 = (size_t)b * SEQ + 64 * (4 * n4 + c); const int tok = tid >> 3, ch = tid & 7;
        kr[c] = *(const v4u*)(C.KUPD + (t0 + tok) * 512 + h * 64 + 8 * ch);
#pragma unroll
        for (int pp = 0; pp < 2; ++pp) { const int p = tid + 512 * pp; vr[c][pp] = *(const v4u*)(C.PROJ + (t0 + (p >> 4)) * NPROJ + GV + h * 128 + 8 * (p & 15)); } }
#pragma unroll
    for (int c = 0; c < 4; ++c) { const int tok = tid >> 3, ch = tid & 7; *(LAS v4u*)(C.lds + c * 32768 + tok * GKP + 16 * ch) = kr[c];
#pragma unroll
        for (int pp = 0; pp < 2; ++pp) { const int p = tid + 512 * pp; *(LAS v4u*)(C.lds + c * 32768 + 64 * GKP + (p >> 4) * VP + 16 * (p & 15)) = vr[c][pp]; } }
    __syncthreads();
    const int mt = w & 3, nt = w >> 2, q = (lane & 15) >> 2, cb = (16 * ((lane >> 4) & 1) + 4 * (lane & 3)) * 2;
#pragma unroll
    for (int c = 0; c < 4; ++c) {
        const LAS unsigned char* va = C.lds + c * 32768 + 64 * GKP + (4 * hh + q) * VP + cb + mt * 64; const LAS unsigned char* ka = C.lds + c * 32768 + (4 * hh + q) * GKP + cb + nt * 64;
        f32x16 acc;
#pragma unroll
        for (int i = 0; i < 16; ++i) acc[i] = 0.f;
#pragma unroll
        for (int s = 0; s < 4; ++s) acc = MFMA32(cat4(vtr(va + 16 * s * VP), vtr(va + (16 * s + 8) * VP)), cat4(vtr(ka + 16 * s * GKP), vtr(ka + (16 * s + 8) * GKP)), acc);
        float* up = C.UT + (size_t)((b * NH + h) * 64 + 4 * n4 + c) * 8192 + (32 * mt) * 64 + 32 * nt + r;
#pragma unroll
        for (int i = 0; i < 16; ++i) up[crow(i, hh) * 64] = acc[i];
    }
    __syncthreads();
}
__device__ __forceinline__ void gla_scan_item(const Ctx& C, int id) {
    { const int idx = id * NTHREADS + C.tid;
        const int bh = idx >> 13, rem = idx & 8191, dk = rem & 63; float s = 0.f;
        const float* up = C.UT + (size_t)bh * 64 * 8192 + rem; const float* dp = C.DEC + (size_t)bh * 64 * 64 + dk; bf16* sp = C.ST + (size_t)bh * 64 * 8192 + rem;
#pragma unroll 16
        for (int n = 0; n < 64; ++n) { sp[(size_t)n * 8192] = (bf16)(pk2(s, 0.f) & 0xffffu); s = dp[n * 64] * s + up[(size_t)n * 8192]; }
    }
}

__device__ __forceinline__ void p5_attn_phase(const Ctx& C, int rep) {
    volatile LAS int* qslot = (volatile LAS int*)(C.lds + MISC_OFF + 64);
    LAS int* pfx = (LAS int*)(C.lds + RING_BYTES + 1024);
    if (C.tid < 256) { const int c = ((C.tid & 15) < 15) ? (int)C.ctl[CW_LCNT + C.tid * 8] : 0; pfx[1 + C.tid] = (c + 255) >> 8; }
    __syncthreads();
    if (C.tid == 0) { int s = 0; pfx[0] = 0; for (int i = 1; i <= 256; ++i) { s += pfx[i]; pfx[i] = s; } }
    __syncthreads();
    const int npast = pfx[256]; unsigned* cnt = C.ctl + CW_Q + 64 * rep;
    for (;;) {
        __syncthreads();
        if (C.tid == 0) { const int id = (int)atomicAdd(cnt, 1u); int a0 = -1, a1 = 0;
            if (id < 256) { a0 = 512 + id; }
            else if (id < 512) { a0 = id - 256; a1 = -1; }
            else if (id < 512 + npast) { const int p = id - 512; int lo = 0, hi = 256; while (hi - lo > 1) { const int mid = (lo + hi) >> 1; if (pfx[mid] <= p) lo = mid; else hi = mid; } a0 = lo; a1 = p - pfx[lo]; }
            qslot[0] = a0; qslot[1] = a1; }
        __syncthreads();
        const int a0 = qslot[0], a1 = qslot[1];
        if (a0 < 0) break;
        if (a0 < 256) moba_attn_item(C, a0 >> 7, (a0 >> 4) & 7, a0 & 15, a1 < 0, a1 < 0 ? 0 : a1);
        else gla_scan_item(C, a0 - 512);
    }
}

__device__ __forceinline__ void gla_out_item(const Ctx& C, int b, int h, int n) {
    const int lane = C.lane, w = C.wave, r = lane & 31, hh = lane >> 5, dvt = w & 3, lt = w >> 2; const size_t t0 = (size_t)b * SEQ + 64 * n; const int bhn = (b * NH + h) * 64 + n;
    constexpr int VT = 0, RED = 64 * VP;
    const size_t tl = t0 + 32 * lt + r;
    v4u vraw[2]; bf16x8 qd[4], kd[2][4];
#pragma unroll
    for (int pp = 0; pp < 2; ++pp) { const int p = C.tid + 512 * pp; vraw[pp] = *(const v4u*)(C.PROJ + (t0 + (p >> 4)) * NPROJ + GV + h * 128 + 8 * (p & 15)); }
#pragma unroll
    for (int s = 0; s < 4; ++s) { qd[s] = *(const bf16x8*)(C.QDEC + tl * 512 + h * 64 + 16 * s + 8 * hh); kd[1][s] = *(const bf16x8*)(C.KDEC + tl * 512 + h * 64 + 16 * s + 8 * hh);
        kd[0][s] = *(const bf16x8*)(C.KDEC + (t0 + r) * 512 + h * 64 + 16 * s + 8 * hh); }
#pragma unroll
    for (int pp = 0; pp < 2; ++pp) { const int p = C.tid + 512 * pp; *(LAS v4u*)(C.lds + VT + (p >> 4) * VP + 16 * (p & 15)) = vraw[pp]; }
    bf16x8 sfr[4]; v2u graw[4]; f32x4 gn[4];
    { const bf16* sp = C.ST + (size_t)bhn * 8192 + (32 * dvt + r) * 64 + 8 * hh;
#pragma unroll
      for (int s = 0; s < 4; ++s) sfr[s] = *(const bf16x8*)(sp + 16 * s);
#pragma unroll
      for (int k4 = 0; k4 < 4; ++k4) { const int d0 = 32 * dvt + 8 * k4 + 4 * hh; graw[k4] = *(const v2u*)(C.PROJ + tl * NPROJ + GG + h * 128 + d0); gn[k4] = *(const f32x4*)(C.gla_g + d0); } }
    __syncthreads();
    f32x16 o;
#pragma unroll
    for (int i = 0; i < 16; ++i) o[i] = 0.f;
    const LAS unsigned char* va = C.lds + VT + (4 * hh + ((lane & 15) >> 2)) * VP + (16 * ((lane >> 4) & 1) + 4 * (lane & 3)) * 2 + dvt * 64;
#pragma unroll
    for (int mt = 0; mt < 2; ++mt) {
        if (mt > lt) break;
        const bool diag = (mt == lt); f32x16 X;
#pragma unroll
        for (int i = 0; i < 16; ++i) X[i] = 0.f;
#pragma unroll
        for (int s = 0; s < 4; ++s) X = MFMA32(diag ? kd[1][s] : kd[0][s], qd[s], X);
        if (diag) {
#pragma unroll
            for (int i = 0; i < 16; ++i) if (crow(i, hh) > r) X[i] = 0.f; }
        const bf16x8 pf0 = pack8(X[0], X[1], X[2], X[3], X[4], X[5], X[6], X[7]), pf1 = pack8(X[8], X[9], X[10], X[11], X[12], X[13], X[14], X[15]);
        o = MFMA32(cat4(vtr(va + (32 * mt) * VP), vtr(va + (32 * mt + 8) * VP)), pf0, o);
        o = MFMA32(cat4(vtr(va + (32 * mt + 16) * VP), vtr(va + (32 * mt + 24) * VP)), pf1, o);
    }
#pragma unroll
    for (int s = 0; s < 4; ++s) o = MFMA32(sfr[s], qd[s], o);
    float ss = 0.f;
#pragma unroll
    for (int i = 0; i < 16; ++i) ss += o[i] * o[i];
    ss += __shfl_xor(ss, 32);
    LAS float* red = (LAS float*)(C.lds + RED);
    if (hh == 0) red[dvt * 64 + 32 * lt + r] = ss;
    __syncthreads();
    const int l = 32 * lt + r; const float rstd = rsqrtf((red[l] + red[64 + l] + red[128 + l] + red[192 + l]) * (1.f / 128.f) + EPS);
#pragma unroll
    for (int k4 = 0; k4 < 4; ++k4) { const int d0 = 32 * dvt + 8 * k4 + 4 * hh;
        const float ga = bflo(graw[k4].x), gb = bfhi(graw[k4].x), gc = bflo(graw[k4].y), gd = bfhi(graw[k4].y); const f32x4 gnv = gn[k4];
        const float y0 = o[4 * k4] * rstd * gnv.x * (ga / (1.f + __expf(-ga))), y1 = o[4 * k4 + 1] * rstd * gnv.y * (gb / (1.f + __expf(-gb)));
        const float y2 = o[4 * k4 + 2] * rstd * gnv.z * (gc / (1.f + __expf(-gc))), y3 = o[4 * k4 + 3] * rstd * gnv.w * (gd / (1.f + __expf(-gd)));
        v2u wv; wv.x = pk2(y0, y1); wv.y = pk2(y2, y3); *(v2u*)(C.CONCAT + tl * D + h * 128 + d0) = wv; }
    __syncthreads();
}

#define INS16(L, xin) do { int x_ = (xin); _Pragma("unroll") for (int i_ = 0; i_ < 16; ++i_) { const int hi_ = max(L[i_], x_); x_ = min(L[i_], x_); L[i_] = hi_; } } while (0)
#define CE_DESC(a, b) do { const int hi_ = max(a, b), lo_ = min(a, b); a = hi_; b = lo_; } while (0)
#define BITONIC_MERGE16(L) do { _Pragma("unroll") for (int j_ = 8; j_ > 0; j_ >>= 1) _Pragma("unroll") for (int i_ = 0; i_ < 16; ++i_) if ((i_ & j_) == 0) CE_DESC(L[i_], L[i_ | j_]); } while (0)
#define SORT16(L) do { _Pragma("unroll") for (int k_ = 2; k_ <= 16; k_ <<= 1) _Pragma("unroll") for (int j_ = k_ >> 1; j_ > 0; j_ >>= 1) _Pragma("unroll") for (int i_ = 0; i_ < 16; ++i_) { const int l_ = i_ ^ j_; \
        if (l_ > i_) { if ((i_ & k_) == 0) CE_DESC(L[i_], L[l_]); else CE_DESC(L[l_], L[i_]); } } } while (0)
#define MERGE16(L, M) do { _Pragma("unroll") for (int i_ = 0; i_ < 16; ++i_) L[i_] = max(L[i_], M[15 - i_]); BITONIC_MERGE16(L); } while (0)
__device__ __forceinline__ int ord_key(float v) { int u = __float_as_int(v); return u ^ ((u >> 31) & 0x7fffffff); }
__device__ __forceinline__ float ord_val(int k, int mask) { int u = k & ~mask; return __int_as_float(u ^ ((u >> 31) & 0x7fffffff)); }
__device__ __forceinline__ void peer_topk_item(const Ctx& C, int tg, int hd, const LAS unsigned char* qlds, int lrow0) {
    const int lane = C.lane, r = lane & 31, hh = lane >> 5; const size_t tok = (size_t)tg * 32 + r;
    int La[16], Lb[16];
#pragma unroll
    for (int c = 0; c < 2; ++c) {
        int L[16];
#pragma unroll
        for (int i = 0; i < 16; ++i) L[i] = (int)0x80000000;
        bf16x8 qf[8];
        { const int row = lrow0 + r;
#pragma unroll
          for (int s = 0; s < 8; ++s) qf[s] = *(const LAS bf16x8*)(qlds + row * 512 + 16 * ((16 * c + 2 * s + hh) ^ (row & 15))); }
        int G[16];
        bf16x8 kfA[8], kfB[8];
#define PT_KLOAD(dst, kt) do { const bf16* kp_ = C.KEYSB + ((size_t)(hd * 2 + c) * 128 + 32 * (kt) + r) * 128 + 8 * hh; _Pragma("unroll") for (int s = 0; s < 8; ++s) dst[s] = *(const bf16x8*)(kp_ + 16 * s); } while (0)
#define PT_TILE(src, kt) do { f32x16 X; _Pragma("unroll") for (int i = 0; i < 16; ++i) X[i] = 0.f; _Pragma("unroll") for (int s = 0; s < 8; ++s) X = MFMA32(src[s], qf[s], X); \
            _Pragma("unroll") for (int i = 0; i < 16; ++i) G[i] = (ord_key(X[i]) & ~127) | (32 * (kt) + crow(i, hh)); SORT16(G); MERGE16(L, G); } while (0)
        PT_KLOAD(kfA, 0);
#pragma unroll 1
        for (int k2 = 0; k2 < 2; ++k2) {
            PT_KLOAD(kfB, 2 * k2 + 1);
            PT_TILE(kfA, 2 * k2);
            if (k2 == 0) PT_KLOAD(kfA, 2);
            PT_TILE(kfB, 2 * k2 + 1);
        }
#undef PT_KLOAD
#undef PT_TILE
        int M[16];
#pragma unroll
        for (int i = 0; i < 16; ++i) M[i] = __shfl_xor(L[i], 32);
        MERGE16(L, M);
#pragma unroll
        for (int i = 0; i < 16; ++i) { if (c == 0) La[i] = L[i]; else Lb[i] = L[i]; }
    }
    float sa[16], sb[16]; int Lc[16];
#pragma unroll
    for (int i = 0; i < 16; ++i) { sa[i] = ord_val(La[i], 127); sb[i] = ord_val(Lb[i], 127); Lc[i] = (int)0x80000000; }
#pragma unroll
    for (int i = 0; i < 16; ++i)
#pragma unroll
        for (int j = 0; j < 16; ++j) if ((i + 1) * (j + 1) <= 16) INS16(Lc, (ord_key(sa[i] + sb[j]) & ~255) | (i * 16 + j));
    float e[16], sum = 0.f; int ex[16]; const float mx = ord_val(Lc[0], 255);
#pragma unroll
    for (int i = 0; i < 16; ++i) {
        e[i] = __expf(ord_val(Lc[i], 255) - mx); sum += e[i];
        const int ii = (Lc[i] >> 4) & 15, jj = Lc[i] & 15; int i1 = 0, i2 = 0;
#pragma unroll
        for (int q = 0; q < 16; ++q) { i1 = (ii == q) ? (La[q] & 127) : i1; i2 = (jj == q) ? (Lb[q] & 127) : i2; }
        ex[i] = i1 * 128 + i2;
    }
    const float inv = 1.f / sum;
    if (hh == 0) {
        v4u* ep = (v4u*)(C.EXPI + tok * 128 + hd * 16); f32x4* gp = (f32x4*)(C.GATE + tok * 128 + hd * 16); f32x4* up = (f32x4*)(C.GU + tok * 128 + hd * 16); v4u* ap = (v4u*)(C.ACT + tok * 128 + hd * 16);
        const float hs = C.HS[tok];
#pragma unroll
        for (int q = 0; q < 4; ++q) { ep[q] = (v4u){(unsigned)ex[4 * q], (unsigned)ex[4 * q + 1], (unsigned)ex[4 * q + 2], (unsigned)ex[4 * q + 3]};
            gp[q] = (f32x4){e[4 * q] * inv * C.VS[ex[4 * q]], e[4 * q + 1] * inv * C.VS[ex[4 * q + 1]], e[4 * q + 2] * inv * C.VS[ex[4 * q + 2]], e[4 * q + 3] * inv * C.VS[ex[4 * q + 3]]};
            up[q] = (f32x4){hs * C.US[ex[4 * q]], hs * C.US[ex[4 * q + 1]], hs * C.US[ex[4 * q + 2]], hs * C.US[ex[4 * q + 3]]};
            ap[q] = (v4u){0u, 0u, 0u, 0u}; }
    }
}

__device__ __forceinline__ int peer_dequeue(const Ctx& C, unsigned* cnt, int xcc) {
    volatile LAS int* slot = (volatile LAS int*)(C.lds + MISC_OFF + 64);
    __syncthreads();
    if (C.tid == 0) { int res = -1;
        for (int s = 0; s < NSL; ++s) { const int sl = (xcc + s) & (NSL - 1);
            if (__hip_atomic_load(cnt + 64 * sl, __ATOMIC_RELAXED, __HIP_MEMORY_SCOPE_AGENT) >= (unsigned)NCHUNK) continue;
            const unsigned id = atomicAdd(cnt + 64 * sl, 1u); if (id < (unsigned)NCHUNK) { res = sl * NCHUNK + (int)id; break; } }
        *slot = res; }
    __syncthreads();
    return *slot;
}
#define ROWSUM16(d) do { d += __builtin_amdgcn_update_dpp(0, d, 0x121, 0xf, 0xf, false); d += __builtin_amdgcn_update_dpp(0, d, 0x122, 0xf, 0xf, false); \
                         d += __builtin_amdgcn_update_dpp(0, d, 0x124, 0xf, 0xf, false); d += __builtin_amdgcn_update_dpp(0, d, 0x128, 0xf, 0xf, false); } while (0)
#define PA_ISSUE1(buf, esrc, j_) buf[j_] = *(const v4u*)(tab + (size_t)__builtin_amdgcn_ds_swizzle(esrc, ((j_) << 5) | 0x10) * SLW)
#define PA_ISSUE(buf, esrc) do { PA_ISSUE1(buf, esrc, 0); PA_ISSUE1(buf, esrc, 1); PA_ISSUE1(buf, esrc, 2); PA_ISSUE1(buf, esrc, 3); PA_ISSUE1(buf, esrc, 4); PA_ISSUE1(buf, esrc, 5); PA_ISSUE1(buf, esrc, 6); PA_ISSUE1(buf, esrc, 7); \
        PA_ISSUE1(buf, esrc, 8); PA_ISSUE1(buf, esrc, 9); PA_ISSUE1(buf, esrc, 10); PA_ISSUE1(buf, esrc, 11); PA_ISSUE1(buf, esrc, 12); PA_ISSUE1(buf, esrc, 13); PA_ISSUE1(buf, esrc, 14); PA_ISSUE1(buf, esrc, 15); } while (0)
#define PA_COMPUTE(buf, hq_, dstv) do { _Pragma("unroll") for (int j_ = 0; j_ < 16; ++j_) { const v4u u_ = buf[j_]; \
        int d_ = __builtin_amdgcn_sdot4((int)hq_.x, (int)u_.x, 0, false); d_ = __builtin_amdgcn_sdot4((int)hq_.y, (int)u_.y, d_, false); d_ = __builtin_amdgcn_sdot4((int)hq_.z, (int)u_.z, d_, false); d_ = __builtin_amdgcn_sdot4((int)hq_.w, (int)u_.w, d_, false); \
        ROWSUM16(d_); dstv = (i == j_) ? d_ : dstv; } } while (0)
__device__ __forceinline__ void peer_a_chunk(const Ctx& C, int t0, int x, int* act) {
    const int lane = C.lane, i = lane & 15;
    v4u hq[8]; int el[8], eh[8];
#pragma unroll
    for (int tt = 0; tt < 8; ++tt) { hq[tt] = __builtin_nontemporal_load((const v4u*)(C.HQ + ((size_t)x * T + t0 + tt) * SLW + 16 * i)); el[tt] = __builtin_nontemporal_load(C.EXPI + (size_t)(t0 + tt) * 128 + lane); eh[tt] = __builtin_nontemporal_load(C.EXPI + (size_t)(t0 + tt) * 128 + 64 + lane); }
    const unsigned char* tab = C.UQ + (size_t)x * NEXP * SLW + 16 * i;
    v4u bA[16], bB[16];
    PA_ISSUE(bA, el[0]);
#pragma unroll
    for (int tt = 0; tt < 8; ++tt) {
        PA_ISSUE(bB, eh[tt]);
        int r_lo = 0, r_hi = 0;
        PA_COMPUTE(bA, hq[tt], r_lo);
        if (tt + 1 < 8) PA_ISSUE(bA, el[tt + 1]);
        PA_COMPUTE(bB, hq[tt], r_hi);
        atomicAdd(act + (size_t)(t0 + tt) * 128 + lane, r_lo); atomicAdd(act + (size_t)(t0 + tt) * 128 + 64 + lane, r_hi);
    }
}
#undef PA_ISSUE
#undef PA_ISSUE1
#undef PA_COMPUTE
__device__ __forceinline__ void peer_weights_token(const Ctx& C, size_t t) {
    const int lane = C.lane; const size_t o = t * 128 + lane;
    const float a_lo = (float)C.ACT[o] * C.GU[o], a_hi = (float)C.ACT[o + 64] * C.GU[o + 64];
    const float w_lo = C.GATE[o] * 0.5f * a_lo * (1.f + erff(a_lo * 0.70710678118654752f)), w_hi = C.GATE[o + 64] * 0.5f * a_hi * (1.f + erff(a_hi * 0.70710678118654752f));
    const float wm = wave_max(fmaxf(fabsf(w_lo), fabsf(w_hi))), winv = wm > 0.f ? 127.f / wm : 0.f;
    unsigned p_lo = (unsigned)((int)rintf(w_lo * winv) & 0xff), p_hi = (unsigned)((int)rintf(w_hi * winv) & 0xff);
    p_lo |= (unsigned)__builtin_amdgcn_update_dpp(0, (int)p_lo, 0xB1, 0xf, 0xf, false) << 8; p_lo |= (unsigned)__builtin_amdgcn_update_dpp(0, (int)p_lo, 0x4E, 0xf, 0xf, false) << 16;
    p_hi |= (unsigned)__builtin_amdgcn_update_dpp(0, (int)p_hi, 0xB1, 0xf, 0xf, false) << 8; p_hi |= (unsigned)__builtin_amdgcn_update_dpp(0, (int)p_hi, 0x4E, 0xf, 0xf, false) << 16;
    if ((lane & 3) == 0) { C.PW[t * 32 + (lane >> 2)] = p_lo; C.PW[t * 32 + 16 + (lane >> 2)] = p_hi; }
    if (lane == 0) C.WSC[t] = wm * (1.f / 127.f);
}
#define PB_ISSUE(buf, esrc) do { _Pragma("unroll") for (int j_ = 0; j_ < 16; ++j_) { const int e_ = __builtin_amdgcn_ds_bpermute(4 * (16 * (j_ >> 2) + 4 * g + (j_ & 3)), esrc); buf[j_] = *(const v4u*)(tab + (size_t)e_ * SLW); } } while (0)
#define PB_TR4(r0_, r1_, r2_, r3_, wp_, base) do { const unsigned t0_ = __builtin_amdgcn_perm(r1_, r0_, 0x05010400u), t1_ = __builtin_amdgcn_perm(r1_, r0_, 0x07030602u), t2_ = __builtin_amdgcn_perm(r3_, r2_, 0x05010400u), t3_ = __builtin_amdgcn_perm(r3_, r2_, 0x07030602u); \
        c[(base)] = __builtin_amdgcn_sdot4((int)__builtin_amdgcn_perm(t2_, t0_, 0x05040100u), wp_, c[(base)], false); c[(base) + 1] = __builtin_amdgcn_sdot4((int)__builtin_amdgcn_perm(t2_, t0_, 0x07060302u), wp_, c[(base) + 1], false); \
        c[(base) + 2] = __builtin_amdgcn_sdot4((int)__builtin_amdgcn_perm(t3_, t1_, 0x05040100u), wp_, c[(base) + 2], false); c[(base) + 3] = __builtin_amdgcn_sdot4((int)__builtin_amdgcn_perm(t3_, t1_, 0x07060302u), wp_, c[(base) + 3], false); } while (0)
#define PB_COMPUTE(buf, psrc) do { _Pragma("unroll") for (int jb_ = 0; jb_ < 4; ++jb_) { const int wp_ = __builtin_amdgcn_ds_bpermute(4 * (16 * jb_ + 4 * g), (int)psrc); \
        PB_TR4(buf[4 * jb_].x, buf[4 * jb_ + 1].x, buf[4 * jb_ + 2].x, buf[4 * jb_ + 3].x, wp_, 0); PB_TR4(buf[4 * jb_].y, buf[4 * jb_ + 1].y, buf[4 * jb_ + 2].y, buf[4 * jb_ + 3].y, wp_, 4); \
        PB_TR4(buf[4 * jb_].z, buf[4 * jb_ + 1].z, buf[4 * jb_ + 2].z, buf[4 * jb_ + 3].z, wp_, 8); PB_TR4(buf[4 * jb_].w, buf[4 * jb_ + 1].w, buf[4 * jb_ + 2].w, buf[4 * jb_ + 3].w, wp_, 12); } } while (0)
__device__ __forceinline__ int isum_swap16(int v) { auto r = __builtin_amdgcn_permlane16_swap((unsigned)v, (unsigned)v, false, false); return (int)r[0] + (int)r[1]; }
__device__ __forceinline__ int isum_swap32(int v) { auto r = __builtin_amdgcn_permlane32_swap((unsigned)v, (unsigned)v, false, false); return (int)r[0] + (int)r[1]; }
__device__ __forceinline__ void peer_b_chunk(const Ctx& C, int t0, int x, float* dst) {
    const int lane = C.lane, i = lane & 15, g = lane >> 4, b = t0 / SEQ;
    int el[8], eh[8]; unsigned pl[8], ph[8]; float ws[8];
#pragma unroll
    for (int tt = 0; tt < 8; ++tt) { const size_t o = (size_t)(t0 + tt) * 128 + lane;
        el[tt] = __builtin_nontemporal_load(C.EXPI + o); eh[tt] = __builtin_nontemporal_load(C.EXPI + o + 64);
        const unsigned p_lo = C.PW[(size_t)(t0 + tt) * 32 + (lane >> 2)], p_hi = C.PW[(size_t)(t0 + tt) * 32 + 16 + (lane >> 2)]; ws[tt] = C.WSC[t0 + tt];
        pl[tt] = p_lo; ph[tt] = p_hi; }
    const unsigned char* tab = C.VQ + (size_t)x * NEXP * SLW + 16 * i;
    const int d0 = x * SLW + 16 * i + 4 * g; const f32x4 gm = *(const f32x4*)(C.MOD + b * NMOD + 5 * D + d0);
    v4u bA[16], bB[16];
    PB_ISSUE(bA, el[0]);
#pragma unroll
    for (int tt = 0; tt < 8; ++tt) {
        PB_ISSUE(bB, eh[tt]);
        const size_t off = (size_t)(t0 + tt) * D + d0; const f32x4 x1 = __builtin_nontemporal_load((const f32x4*)(C.out + off));
        int c[16];
#pragma unroll
        for (int q = 0; q < 16; ++q) c[q] = 0;
        PB_COMPUTE(bA, pl[tt]);
        if (tt + 1 < 8) PB_ISSUE(bA, el[tt + 1]);
        PB_COMPUTE(bB, ph[tt]);
#pragma unroll
        for (int q = 0; q < 16; ++q) c[q] = isum_swap32(isum_swap16(c[q]));
        f32x4 o;
#pragma unroll
        for (int q = 0; q < 4; ++q) o[q] = (float)(g == 0 ? c[q] : g == 1 ? c[4 + q] : g == 2 ? c[8 + q] : c[12 + q]) * ws[tt];
        __builtin_nontemporal_store(x1 + gm * o, (f32x4*)(dst + off));
    }
}
#undef PB_ISSUE
#undef PB_COMPUTE
#undef PB_TR4
template <int STAGE> __device__ __forceinline__ void peer_expert_phase(const Ctx& C, float* dst, int rep) {
    const int xcc = (int)(xb_xcc_id() & (NSL - 1)); unsigned* cnt = C.ctl + (STAGE == 0 ? CW_QA : CW_QB) + 64 * NSL * rep;
    for (;;) {
        const int id = peer_dequeue(C, cnt, xcc); if (id < 0) break;
        const int x = id / NCHUNK, t0 = (id % NCHUNK) * PCH + C.wave * (PCH / NWAVES);
        for (int sub = 0; sub < PCH / NWAVES; sub += 8) { if (STAGE == 0) peer_a_chunk(C, t0 + sub, x, rep ? (int*)C.QP : C.ACT); else peer_b_chunk(C, t0 + sub, x, dst); }
    }
}

__device__ __forceinline__ void first_unit(int nM, int nN, int G, int c, int& pm, int& pn) {
    const int nwg = nM * nN; if (c >= nwg) { pm = -1; pn = 0; return; }
    int wgid = c; { const int q = nwg / 8, r = nwg % 8, xcd = wgid % 8, off = wgid / 8; wgid = (xcd < r ? xcd * (q + 1) : r * (q + 1) + (xcd - r) * q) + off; }
    const int nig = 8 * nN, gid = wgid / nig, fm = gid * 8, gsz = (nM - fm) < 8 ? (nM - fm) : 8;
    pm = fm + ((wgid % nig) % gsz); pn = (wgid % nig) / gsz; (void)G;
}
struct Args { const void* in[18]; float* out; unsigned char* ws; int ph_lo, ph_hi; };
__global__ void __launch_bounds__(NTHREADS, 2) fwd_kernel(Args args) {
    extern __shared__ __attribute__((aligned(16))) unsigned char lds[];
    Ctx C;
    C.lds = (LAS unsigned char*)lds; C.tid = threadIdx.x; C.lane = C.tid & 63; C.wave = __builtin_amdgcn_readfirstlane(C.tid >> 6);
    C.G = gridDim.x; { const int bx = blockIdx.x; C.vcu = (C.G % 8 == 0) ? (bx % 8) * (C.G / 8) + bx / 8 : bx; }
    C.gw = C.vcu * NWAVES + C.wave; C.ngw = C.G * NWAVES;
    C.x = (const float*)args.in[0]; C.c = (const float*)args.in[1]; C.pos = (const int*)args.in[2]; C.w_ada = (const float*)args.in[3]; C.b_ada = (const float*)args.in[4]; C.g1 = (const float*)args.in[5];
    C.w_in = (const float*)args.in[6]; C.w_a2 = (const float*)args.in[7]; C.b_a = (const float*)args.in[8]; C.gla_g = (const float*)args.in[9]; C.qg = (const float*)args.in[10]; C.kg = (const float*)args.in[11];
    C.w_out = (const float*)args.in[12]; C.g2 = (const float*)args.in[13]; C.w_q = (const float*)args.in[14]; C.keys = (const float*)args.in[15]; C.pu = (const float*)args.in[16]; C.pv = (const float*)args.in[17];
    C.out = args.out; unsigned char* ws = args.ws;
#define CTX_WS_PTRS() do { C.ctl = (unsigned*)(ws + WS_CTL); C.MODI = (long long*)(C.ctl + CW_MOD); C.MOD = (float*)(ws + WS_MODF); C.WIN = (bf16*)(ws + WS_WIN); C.WGA = (bf16*)(ws + WS_WGA); C.WOUT = (bf16*)(ws + WS_WOUT); C.WQ = (bf16*)(ws + WS_WQ); C.KEYSB = (bf16*)(ws + WS_KEYS); C.UQ = ws + WS_UB; C.VQ = ws + WS_VB; C.HQ = ws + WS_HQ; C.US = (float*)(ws + WS_US); C.VS = (float*)(ws + WS_VS); C.HS = (float*)(ws + WS_HS); C.GU = (float*)(ws + WS_GU); C.PW = (unsigned*)(ws + WS_PW); C.WSC = (float*)(ws + WS_WSC); C.ACT = (int*)(ws + WS_ACT); C.QDEC = (bf16*)(ws + WS_QDEC); C.KDEC = (bf16*)(ws + WS_KDEC); C.KUPD = (bf16*)(ws + WS_KUPD); C.PART = (bf16*)(ws + WS_PART); C.ML = (float*)(ws + WS_ML); C.LIST = (unsigned short*)(ws + WS_LIST); C.SEL = (unsigned short*)(ws + WS_SEL); C.H = (bf16*)(ws + WS_H); C.CONCAT = (bf16*)(ws + WS_CONCAT); C.PROJ = (bf16*)(ws + WS_PROJ); C.ST = (bf16*)(ws + WS_ST); C.CS = (float*)(ws + WS_CS); C.KMEAN = (float*)(ws + WS_KMEAN); C.DEC = (float*)(ws + WS_DEC); C.BCUM = (float*)(ws + WS_BCUM); C.UT = (float*)(ws + WS_UT); C.QP = (float*)(ws + WS_QP); C.GATE = (float*)(ws + WS_GATE); C.EXPI = (int*)(ws + WS_EXP); } while (0)
    CTX_WS_PTRS();
    for (int u = C.tid; u < (LDS_BYTES - RING_BYTES) / 4; u += NTHREADS) ((LAS unsigned*)(C.lds + RING_BYTES))[u] = 0u;
    __syncthreads();
    const int lo = args.ph_lo, hi = args.ph_hi;
    if (PROBE_TS >= 0 && blockIdx.x == 0 && threadIdx.x == 0) ((volatile LAS unsigned long long*)(C.lds + RING_BYTES + 8192))[0] = __builtin_amdgcn_s_memrealtime();
    XcdBarrier bar; bar.bar = C.ctl + CW_BAR; bar.x = 0; bar.st = nullptr;
    if (hi - lo > 1) bar = xcd_barrier_post(C.ctl + CW_BAR, (volatile LAS unsigned*)(C.lds + MISC_OFF) + 8);
#ifndef SKIPMASK
#define SKIPMASK 0
#endif
#ifndef REPEATMASK
#define REPEATMASK 0
#endif
#define IN(k) (!((SKIPMASK >> (k)) & 1) && lo <= (k) && (k) < hi)
#define REP(k, ...) do { if ((REPEATMASK >> (k)) & 1) { const int rep_ = 1; (void)rep_; __VA_ARGS__; xcd_barrier(bar); } { const int rep_ = 0; (void)rep_; __VA_ARGS__; } } while (0)
#define SEAM(k) do { if (IN(k) && IN((k) + 1)) xcd_barrier(bar); if (PROBE_TS >= 0 && blockIdx.x == 0 && threadIdx.x == 0) ((volatile LAS unsigned long long*)(C.lds + RING_BYTES + 8192))[(k) + 1] = __builtin_amdgcn_s_memrealtime(); { int t_ = C.tid; asm volatile("" : "+v"(t_)); C.tid = t_; C.lane = t_ & 63; } CTX_WS_PTRS(); } while (0)
    if (IN(0)) REP(0, p0_phase(C, rep_)); SEAM(0);
    if (IN(1)) REP(1, norm_mod_phase<true>(C, C.x, C.g1, 0, D, C.H)); SEAM(1);
    if (IN(2)) REP(2, pg8::Gemm g{C.H, C.WIN, T, NPROJ, D}; pg8::StaticOrder S; S.init(T, NPROJ, C.G, (int)blockIdx.x); pg8::EpiBf16<0> E{C.PROJ, NPROJ, nullptr, 0, 0, 1.f};
                 pg8::gemm_phase<pg8::EpiBf16<0>, pg8::StaticOrder, PG8_ALIGN, PG8_SP2>(C.lds, g, S, E)); SEAM(2);
    if (IN(3)) REP(3, for (int it = C.vcu; it < 256 + 256; it += C.G) { if (it < 256) moba_prep_item(C, it >> 7, (it >> 4) & 7, it & 15, rep_); else gla_prep_item(C, (it - 256) >> 7, ((it - 256) >> 1) & 63, it & 1); }); SEAM(3);
    if (IN(4)) REP(4, for (int it = C.vcu; it < 256 + 256; it += C.G) { if (it < 256) moba_select_item(C, it >> 7, (it >> 4) & 7, it & 15, rep_); else { const int g_ = it - 256; gla_u_item(C, g_ >> 7, (g_ >> 4) & 7, g_ & 15); } }); SEAM(4);
    if (IN(5)) REP(5, p5_attn_phase(C, rep_)); SEAM(5);
    if (IN(6)) REP(6, for (int it = C.vcu; it < 1024; it += C.G) gla_out_item(C, it >> 9, (it >> 6) & 7, it & 63); for (int t = C.gw; t < T; t += C.ngw) moba_merge_token(C, (size_t)t)); SEAM(6);
    if (IN(7)) REP(7, pg8::Gemm g{C.CONCAT, C.WOUT, T, D, D}; pg8::StaticOrder S; S.init(T, D, C.G, (int)blockIdx.x); pg8::EpiResGate E{C.x, C.out, D, C.MOD + 2 * D, NMOD, SEQ / 256};
                 pg8::gemm_phase<pg8::EpiResGate, pg8::StaticOrder, PG8_ALIGN, PG8_SP2>(C.lds, g, S, E)); SEAM(7);
    if (IN(8)) REP(8, norm_mod_phase<false>(C, C.out, C.g2, 3 * D, 4 * D, C.H)); SEAM(8);
    if (IN(9)) REP(9, int upm_ = -1; int upn_ = 0; first_unit(T / 256, D / 256, C.G, (int)blockIdx.x, upm_, upn_);
                 { pg8::Gemm g{C.H, C.WQ, T, D, D}; pg8::StaticOrder S; S.init(T, D, C.G, (int)blockIdx.x); pg8::EpiLdsTile E{}; pg8::gemm_phase<pg8::EpiLdsTile, pg8::StaticOrder, false, PG8_SP2>(C.lds, g, S, E); }
                 __syncthreads(); if (upm_ >= 0) peer_topk_item(C, upm_ * 8 + C.wave, upn_, C.lds, 32 * C.wave); __syncthreads()); SEAM(9);
    if (IN(10)) REP(10, peer_expert_phase<0>(C, nullptr, rep_)); SEAM(10);
    if (IN(11)) REP(11, for (int t = C.gw; t < T; t += C.ngw) peer_weights_token(C, (size_t)t)); SEAM(11);
    if (IN(12)) REP(12, peer_expert_phase<1>(C, rep_ ? C.QP : C.out, rep_));
    if (PROBE_TS >= 0) { xcd_barrier(bar); if (blockIdx.x == 0 && threadIdx.x == 0) { volatile LAS unsigned long long* ts = (volatile LAS unsigned long long*)(C.lds + RING_BYTES + 8192); const unsigned long long tend = __builtin_amdgcn_s_memrealtime();
        const unsigned long long d = (PROBE_TS == 12 ? tend : ts[PROBE_TS + 1]) - ts[PROBE_TS]; C.out[0] += (float)d * 0.001f; } }
#undef IN
#undef SEAM
}

extern "C" void kernel_launch(void* const* d_in, const int* in_sizes, int n_in, void* d_out, int out_size, void* d_ws, size_t ws_size, hipStream_t stream) {
    static int grid = 0;
    if (grid == 0) {
        if (n_in != 18 || in_sizes[0] != T * D || out_size != T * D || ws_size < WS_END) { fprintf(stderr, "kernel_launch: shape/workspace mismatch (n_in %d, in0 %d, out %d, ws %zu, need %zu); nothing launched\n", n_in, n_in > 0 ? in_sizes[0] : -1, out_size, ws_size, (size_t)WS_END); grid = -1; return; }
        int dev = 0, cus = 0, per_cu = 0;
        if (hipGetDevice(&dev) != hipSuccess || hipDeviceGetAttribute(&cus, hipDeviceAttributeMultiprocessorCount, dev) != hipSuccess) { fprintf(stderr, "kernel_launch: device query failed\n"); grid = -1; return; }
        if (hipFuncSetAttribute((const void*)fwd_kernel, hipFuncAttributeMaxDynamicSharedMemorySize, LDS_BYTES) != hipSuccess) { fprintf(stderr, "kernel_launch: hipFuncSetAttribute failed\n"); grid = -1; return; }
        if (hipOccupancyMaxActiveBlocksPerMultiprocessor(&per_cu, (const void*)fwd_kernel, NTHREADS, LDS_BYTES) != hipSuccess || per_cu < 1) { fprintf(stderr, "kernel_launch: occupancy query reports %d workgroups per CU\n", per_cu); (void)hipGetLastError(); grid = -1; return; }
        grid = cus;
    }
    if (grid < 0) return;
    if (hipMemsetAsync((char*)d_ws + WS_CTL, 0, CTL_ZERO_BYTES, stream) != hipSuccess) { fprintf(stderr, "kernel_launch: memset failed\n"); return; }
    Args a{};
    for (int i = 0; i < 18; ++i) a.in[i] = d_in[i];
    a.out = (float*)d_out; a.ws = (unsigned char*)d_ws;
#if MK_N_LAUNCHES == 1
    a.ph_lo = 0; a.ph_hi = N_PHASES;
    void* kargs[] = {&a};
#if defined(MK_PLAIN_LAUNCH)
    (void)kargs; hipLaunchKernelGGL(fwd_kernel, dim3(grid), dim3(NTHREADS), LDS_BYTES, stream, a);
#else
    hipError_t le = hipLaunchCooperativeKernel((const void*)fwd_kernel, dim3(grid), dim3(NTHREADS), kargs, LDS_BYTES, stream);
    if (le != hipSuccess) fprintf(stderr, "kernel_launch: cooperative launch failed: %s (grid %d)\n", hipGetErrorName(le), grid);
#endif
#else
    for (int p = 0; p < N_PHASES; ++p) { a.ph_lo = p; a.ph_hi = p + 1; hipLaunchKernelGGL(fwd_kernel, dim3(grid), dim3(NTHREADS), LDS_BYTES, stream, a); }
#endif
}
```

```cpp
#include <hip/hip_runtime.h>
#include <hip/hip_bf16.h>
#include <cstdio>
#include <cstdint>
#include <cmath>
namespace pg8 {
#define PG8_LAS __attribute__((address_space(3)))
typedef unsigned short bf16_t;
typedef short bf16x8 __attribute__((ext_vector_type(8)));
typedef float f32x4 __attribute__((ext_vector_type(4)));
typedef unsigned u32x4 __attribute__((ext_vector_type(4)));
constexpr int BM = 256, BK = 64, HALF = 128, HTB = HALF * BK * 2  , STAGE_BYTES = 8 * HTB, NXCD = 8, WGM = 8;

__host__ __device__ __forceinline__ int lds_byte(int r, int c) { const int st = (r >> 4) * 2 + (c >> 5), rr = r & 15, cc = c & 31, ob = rr * 64 + cc * 2; return st * 1024 + (ob ^ (((ob >> 9) & 1) << 5)); }
__host__ __device__ __forceinline__ void stage_rc(int b, int& R, int& C) { const int st = b / 1024, sb = b % 1024, swz = sb ^ (((sb >> 9) & 1) << 5); R = (st >> 1) * 16 + swz / 64; C = (st & 1) * 32 + (swz % 64) / 2; }
__host__ __device__ __forceinline__ int perm32(int rho) { const int n = rho >> 4, i = rho & 15; return 8 * (i >> 2) + 4 * n + (i & 3); }

struct Unit { int pm, pn; };
struct Gemm { const bf16_t* A; const bf16_t* Bt; int M, N, K; };

struct StaticOrder {
    int nM, nN, nwg, G, c;
    __host__ __device__ void init(int M, int N, int G_, int c_) { nM = M / BM; nN = N / BM; nwg = nM * nN; G = G_; c = c_; }
    __host__ __device__ bool next(int i, Unit& u) const {
        const long L = (long)i * G + c; if (L >= nwg) return false;
        int wgid = (int)L; { const int q = nwg / NXCD, r = nwg % NXCD, xcd = wgid % NXCD, off = wgid / NXCD; wgid = (xcd < r ? xcd * (q + 1) : r * (q + 1) + (xcd - r) * q) + off; }
        const int nig = WGM * nN, gid = wgid / nig, fm = gid * WGM, gsz = (nM - fm) < WGM ? (nM - fm) : WGM;
        u.pm = fm + ((wgid % nig) % gsz); u.pn = (wgid % nig) / gsz; return true;
    }
    __device__ __forceinline__ void a_ready(const Unit&) const {}
    __device__ __forceinline__ void done(const Unit&) const {}
};

__device__ __forceinline__ unsigned cvt_pk_bf16(float lo, float hi) { unsigned r; asm volatile("v_cvt_pk_bf16_f32 %0, %1, %2" : "=v"(r) : "v"(lo), "v"(hi)); return r; }
typedef float f32x2 __attribute__((ext_vector_type(2)));
__device__ __forceinline__ f32x2 gelu_pk(f32x2 v) {
    const f32x2 av = __builtin_elementwise_abs(v), d = av * 0.2316418882f + 1.0f;
    f32x2 t; t.x = __builtin_amdgcn_rcpf(d.x); t.y = __builtin_amdgcn_rcpf(d.y);
    f32x2 q = t * 0.5307027145f + (-0.7265760135f); q = q * t + 0.7107068705f; q = q * t + (-0.142248368f); q = q * t + 0.127414796f; q = q * t;
    const f32x2 s = (v * v) * (-0.72134752044f);
    f32x2 e; e.x = __builtin_amdgcn_exp2f(s.x); e.y = __builtin_amdgcn_exp2f(s.y);
    const f32x2 m = v * (q * e), r = v - m;
    f32x2 o; o.x = v.x < 0.f ? m.x : r.x; o.y = v.y < 0.f ? m.y : r.y; return o;
}

template <int ACT  > struct EpiBf16 {
    static constexpr bool PERM = true, AFTER_DRAIN = false; static_assert(ACT == 0 || ACT == 1, "EpiBf16: ACT is 0 (none) or 1 (gelu_pk)");
    bf16_t* O; int ldc; const float* bias; int split_cols; size_t split_stride; float scale0;
    __device__ __forceinline__ void operator()(const f32x4 (&acc)[2][2][4][2], const Unit& u, int wr, int wc, int fr, int fq) const {
        const int row0 = u.pm * BM + wr * 64 + fr; int colt = u.pn * BM; bf16_t* base = O;
        float sc = 1.f; if (split_cols) { const int t = colt / split_cols; base += (size_t)t * split_stride; colt -= t * split_cols; if (t == 0) sc = scale0; }
        const int col0 = colt + wc * 32 + 8 * fq, bcol0 = u.pn * BM + wc * 32 + 8 * fq;
        f32x4 bv[2][2];
#pragma unroll
        for (int bj = 0; bj < 2; ++bj)
#pragma unroll
            for (int n = 0; n < 2; ++n) bv[bj][n] = bias ? *(const f32x4*)(bias + bcol0 + bj * HALF + 4 * n) : (f32x4){0.f, 0.f, 0.f, 0.f};
#pragma unroll
        for (int ai = 0; ai < 2; ++ai)
#pragma unroll
            for (int m = 0; m < 4; ++m) { bf16_t* rowp = base + (size_t)(row0 + ai * HALF + m * 16) * ldc + col0;
#pragma unroll
                for (int bj = 0; bj < 2; ++bj) { f32x4 v0 = acc[ai][bj][m][0] + bv[bj][0], v1 = acc[ai][bj][m][1] + bv[bj][1];
                    if (ACT == 1) { f32x2 a = gelu_pk((f32x2){v0[0], v0[1]}), b = gelu_pk((f32x2){v0[2], v0[3]}), c = gelu_pk((f32x2){v1[0], v1[1]}), d = gelu_pk((f32x2){v1[2], v1[3]});
                        v0 = (f32x4){a.x, a.y, b.x, b.y}; v1 = (f32x4){c.x, c.y, d.x, d.y}; }
                    v0 = v0 * sc; v1 = v1 * sc; u32x4 w; w.x = cvt_pk_bf16(v0[0], v0[1]); w.y = cvt_pk_bf16(v0[2], v0[3]); w.z = cvt_pk_bf16(v1[0], v1[1]); w.w = cvt_pk_bf16(v1[2], v1[3]);
                    *(u32x4*)(rowp + bj * HALF) = w; } }
    }
};
struct EpiF32 {
    static constexpr bool PERM = false, AFTER_DRAIN = false;
    float* C; int ldc; const float* bias;
    __device__ __forceinline__ void operator()(const f32x4 (&acc)[2][2][4][2], const Unit& u, int wr, int wc, int fr, int fq) const {
        const int row0 = u.pm * BM + wr * 64 + fr, col0 = u.pn * BM + wc * 32 + 4 * fq;
        f32x4 bv[2][2];
#pragma unroll
        for (int bj = 0; bj < 2; ++bj)
#pragma unroll
            for (int n = 0; n < 2; ++n) bv[bj][n] = bias ? *(const f32x4*)(bias + col0 + bj * HALF + n * 16) : (f32x4){0.f, 0.f, 0.f, 0.f};
#pragma unroll
        for (int ai = 0; ai < 2; ++ai)
#pragma unroll
            for (int m = 0; m < 4; ++m) { float* rowp = C + (size_t)(row0 + ai * HALF + m * 16) * ldc + col0;
#pragma unroll
                for (int bj = 0; bj < 2; ++bj)
#pragma unroll
                    for (int n = 0; n < 2; ++n) *(f32x4*)(rowp + bj * HALF + n * 16) = acc[ai][bj][m][n] + bv[bj][n]; }
    }
};
struct EpiResGate {
    static constexpr bool PERM = false, AFTER_DRAIN = false;
    const float* X; float* O; int ldc; const float* gate; int gate_stride, tiles_per_batch;
    __device__ __forceinline__ void operator()(const f32x4 (&acc)[2][2][4][2], const Unit& u, int wr, int wc, int fr, int fq) const {
        const int row0 = u.pm * BM + wr * 64 + fr, col0 = u.pn * BM + wc * 32 + 4 * fq;
        const float* gp = gate + (size_t)(u.pm / tiles_per_batch) * gate_stride;
        f32x4 gv[2][2];
#pragma unroll
        for (int bj = 0; bj < 2; ++bj)
#pragma unroll
            for (int n = 0; n < 2; ++n) gv[bj][n] = *(const f32x4*)(gp + col0 + bj * HALF + n * 16);
        f32x4 xv[2][2][2];
#define ERG_LOAD(idx, slot) do { const size_t off_ = (size_t)(row0 + ((idx) >> 2) * HALF + ((idx) & 3) * 16) * ldc + col0; _Pragma("unroll") for (int bj = 0; bj < 2; ++bj) _Pragma("unroll") for (int n = 0; n < 2; ++n) xv[slot][bj][n] = *(const f32x4*)(X + off_ + bj * HALF + n * 16); } while (0)
        ERG_LOAD(0, 0); ERG_LOAD(1, 1);
#pragma unroll
        for (int idx = 0; idx < 8; ++idx) { const int ai = idx >> 2, m = idx & 3; const size_t off = (size_t)(row0 + ai * HALF + m * 16) * ldc + col0;
#pragma unroll
            for (int bj = 0; bj < 2; ++bj)
#pragma unroll
                for (int n = 0; n < 2; ++n) *(f32x4*)(O + off + bj * HALF + n * 16) = xv[idx & 1][bj][n] + gv[bj][n] * acc[ai][bj][m][n];
            if (idx + 2 < 8) ERG_LOAD(idx + 2, idx & 1); }
#undef ERG_LOAD
    }
};

struct EpiLdsTile {
    static constexpr bool PERM = true, AFTER_DRAIN = true;
    __device__ __forceinline__ void operator()(const f32x4 (&)[2][2][4][2], const Unit&, int, int, int, int) const {}
    __device__ __forceinline__ void fused(f32x4 (&acc)[2][2][4][2], const Unit&, int wr, int wc, int fr, int fq, PG8_LAS unsigned char* lds, int, int) const {
#pragma unroll
        for (int ai = 0; ai < 2; ++ai)
#pragma unroll
            for (int m = 0; m < 4; ++m) { const int row = ai * HALF + wr * 64 + m * 16 + fr;
#pragma unroll
                for (int bj = 0; bj < 2; ++bj) { const f32x4 v0 = acc[ai][bj][m][0], v1 = acc[ai][bj][m][1]; u32x4 w; w.x = cvt_pk_bf16(v0[0], v0[1]); w.y = cvt_pk_bf16(v0[2], v0[3]); w.z = cvt_pk_bf16(v1[0], v1[1]); w.w = cvt_pk_bf16(v1[2], v1[3]);
                    const int chunk = 16 * bj + 4 * wc + fq; *(PG8_LAS u32x4*)(lds + row * 512 + 16 * (chunk ^ (row & 15))) = w; } }
    }
};

template <class Epi, class Sched, bool ALIGN_EPI = false, bool SP2 = false>
__device__ __forceinline__ void gemm_phase(PG8_LAS unsigned char* lds, const Gemm g, const Sched& S, const Epi& E) {
    const int tid = threadIdx.x, wid = __builtin_amdgcn_readfirstlane(tid >> 6), lane = tid & 63, wr = wid >> 2, wc = wid & 3, fr = lane & 15, fq = lane >> 4;
    const int K = g.K, nt = K / BK;
    unsigned voffA[2], voffB[2];
#pragma unroll
    for (int i = 0; i < 2; ++i) { int R, C; stage_rc(tid * 16 + i * 8192, R, C); const int Rb = Epi::PERM ? ((R & ~31) + perm32(R & 31)) : R;
        voffA[i] = (unsigned)(R * K + C) * 2u; voffB[i] = (unsigned)(Rb * K + C) * 2u; }
    const size_t kstep = (size_t)(BK * 2);
    const size_t hstep = (size_t)HALF * K * 2;
    const size_t tstep = 2 * hstep;
    const unsigned ldsw = (unsigned)wid * 1024u;
    const int aoff = lds_byte(wr * 64 + fr, fq * 8), boff = lds_byte(wc * 32 + fr, fq * 8);
#define PG8_SA(b, h) (((b) * 2 + (h)) * HTB)
#define PG8_SB(b, h) ((4 + (b) * 2 + (h)) * HTB)
#define PG8_STAGE(bufoff, gbase, voff) do { _Pragma("unroll") for (int _i = 0; _i < 2; ++_i) \
        __builtin_amdgcn_global_load_lds((const unsigned*)((const char*)(gbase) + (voff)[_i]), (PG8_LAS unsigned*)(lds + (bufoff) + ldsw + _i * 8192), 16, 0, 0); } while (0)
#define PG8_LDA(dst, b, h) do { _Pragma("unroll") for (int m = 0; m < 4; ++m) _Pragma("unroll") for (int k = 0; k < 2; ++k) dst[m][k] = *(const PG8_LAS bf16x8*)(lds + PG8_SA(b, h) + aoff + m * 2048 + k * 1024); } while (0)
#define PG8_LDB(dst, b, h) do { _Pragma("unroll") for (int n = 0; n < 2; ++n) _Pragma("unroll") for (int k = 0; k < 2; ++k) dst[n][k] = *(const PG8_LAS bf16x8*)(lds + PG8_SB(b, h) + boff + n * 2048 + k * 1024); } while (0)
#define PG8_MMA(ai, bj, At, Bt) do { __builtin_amdgcn_s_setprio(1); _Pragma("unroll") for (int m = 0; m < 4; ++m) _Pragma("unroll") for (int n = 0; n < 2; ++n) _Pragma("unroll") for (int k = 0; k < 2; ++k) \
        acc[ai][bj][m][n] = __builtin_amdgcn_mfma_f32_16x16x32_bf16(Bt[n][k], At[m][k], acc[ai][bj][m][n], 0, 0, 0); __builtin_amdgcn_s_setprio(0); } while (0)
#define PG8_WAIT_V(n) asm volatile("s_waitcnt vmcnt(" #n ")" ::: "memory")
#define PG8_WAIT_L(n) asm volatile("s_waitcnt lgkmcnt(" #n ")" ::: "memory")
#define PG8_BAR __builtin_amdgcn_s_barrier()
#define PG8_SCHED __builtin_amdgcn_sched_barrier(0)
    Unit cur, nxt; int ui = 0;
    if (!S.next(0, cur)) return;
    f32x4 acc[2][2][4][2];
#pragma unroll
    for (int a = 0; a < 2; ++a)
#pragma unroll
        for (int b = 0; b < 2; ++b)
#pragma unroll
            for (int m = 0; m < 4; ++m)
#pragma unroll
                for (int n = 0; n < 2; ++n) acc[a][b][m][n] = (f32x4){0.f, 0.f, 0.f, 0.f};
    bf16x8 At[4][2], B0[2][2], B1[2][2];
    const char* cA = (const char*)g.A + (size_t)cur.pm * tstep; const char* cB = (const char*)g.Bt + (size_t)cur.pn * tstep;
    S.a_ready(cur);
    if constexpr (SP2) {
        PG8_STAGE(PG8_SB(0, 0), cB, voffB); PG8_STAGE(PG8_SB(0, 1), cB + hstep, voffB); PG8_STAGE(PG8_SA(0, 0), cA, voffA); PG8_STAGE(PG8_SA(0, 1), cA + hstep, voffA);
        if (wr == 1) PG8_BAR;
        PG8_WAIT_V(2); PG8_BAR;
        PG8_STAGE(PG8_SB(1, 0), cB + kstep, voffB); PG8_STAGE(PG8_SA(1, 0), cA + kstep, voffA); PG8_STAGE(PG8_SB(1, 1), cB + hstep + kstep, voffB);
        PG8_WAIT_V(6); PG8_BAR;
    } else {
        PG8_STAGE(PG8_SB(0, 0), cB, voffB); PG8_STAGE(PG8_SA(0, 0), cA, voffA); PG8_STAGE(PG8_SB(0, 1), cB + hstep, voffB); PG8_STAGE(PG8_SA(0, 1), cA + hstep, voffA);
        if (wr == 1) PG8_BAR;
        PG8_WAIT_V(4); PG8_BAR;
        PG8_STAGE(PG8_SB(1, 0), cB + kstep, voffB); PG8_STAGE(PG8_SA(1, 0), cA + kstep, voffA); PG8_STAGE(PG8_SB(1, 1), cB + hstep + kstep, voffB);
        PG8_WAIT_V(6); PG8_BAR;
    }
    for (;;) {
        const bool has_next = S.next(ui + 1, nxt);
        const char* nA = has_next ? (const char*)g.A + (size_t)nxt.pm * tstep : cA; const char* nB = has_next ? (const char*)g.Bt + (size_t)nxt.pn * tstep : cB;
        for (int t = 0; t < nt; t += 2) {
            const bool last = (t == nt - 2);
            const char* a1 = cA + (size_t)(t + 1) * kstep;
            const char* a2 = last ? nA : cA + (size_t)(t + 2) * kstep; const char* b2 = last ? nB : cB + (size_t)(t + 2) * kstep;
            const char* a3 = a2 + kstep; const char* b3 = b2 + kstep;
            if (last && has_next) S.a_ready(nxt);
            if constexpr (SP2) {
            PG8_LDB(B0, 0, 0); PG8_LDB(B1, 0, 1); PG8_SCHED; PG8_LDA(At, 0, 0); PG8_STAGE(PG8_SA(1, 1), a1 + hstep, voffA);
            PG8_WAIT_V(8); PG8_WAIT_L(0); PG8_BAR; PG8_MMA(0, 0, At, B0); PG8_MMA(0, 1, At, B1); PG8_BAR; PG8_SCHED;
            PG8_LDA(At, 0, 1); PG8_STAGE(PG8_SB(0, 0), b2, voffB); PG8_STAGE(PG8_SB(0, 1), b2 + hstep, voffB); PG8_STAGE(PG8_SA(0, 0), a2, voffA);
            PG8_WAIT_V(8); PG8_WAIT_L(0); PG8_BAR; PG8_MMA(1, 0, At, B0); PG8_MMA(1, 1, At, B1); PG8_BAR; PG8_SCHED;
            PG8_LDB(B0, 1, 0); PG8_LDB(B1, 1, 1); PG8_SCHED; PG8_LDA(At, 1, 0); PG8_STAGE(PG8_SA(0, 1), a2 + hstep, voffA);
            PG8_WAIT_V(8); PG8_WAIT_L(0); PG8_BAR; PG8_MMA(0, 0, At, B0); PG8_MMA(0, 1, At, B1); PG8_BAR; PG8_SCHED;
            PG8_LDA(At, 1, 1); PG8_STAGE(PG8_SB(1, 0), b3, voffB); PG8_STAGE(PG8_SB(1, 1), b3 + hstep, voffB); PG8_STAGE(PG8_SA(1, 0), a3, voffA);
            PG8_WAIT_V(8); PG8_WAIT_L(0); PG8_BAR; PG8_MMA(1, 0, At, B0); PG8_MMA(1, 1, At, B1); PG8_BAR; PG8_SCHED;
            } else {
            PG8_LDB(B0, 0, 0); PG8_SCHED; PG8_LDA(At, 0, 0); PG8_STAGE(PG8_SA(1, 1), a1 + hstep, voffA);
            PG8_WAIT_L(8); PG8_BAR; PG8_WAIT_L(0); PG8_MMA(0, 0, At, B0); PG8_BAR; PG8_SCHED;
            PG8_LDB(B1, 0, 1); PG8_STAGE(PG8_SB(0, 0), b2, voffB);
            PG8_BAR; PG8_WAIT_L(0); PG8_MMA(0, 1, At, B1); PG8_BAR;
            PG8_LDA(At, 0, 1); PG8_STAGE(PG8_SA(0, 0), a2, voffA);
            PG8_BAR; PG8_WAIT_L(0); PG8_MMA(1, 0, At, B0); PG8_BAR; PG8_SCHED;
            PG8_STAGE(PG8_SB(0, 1), b2 + hstep, voffB);
            PG8_WAIT_V(6); PG8_BAR; PG8_MMA(1, 1, At, B1); PG8_BAR;
            PG8_LDB(B0, 1, 0); PG8_SCHED; PG8_LDA(At, 1, 0); PG8_STAGE(PG8_SA(0, 1), a2 + hstep, voffA);
            PG8_WAIT_L(8); PG8_BAR; PG8_WAIT_L(0); PG8_MMA(0, 0, At, B0); PG8_BAR; PG8_SCHED;
            PG8_LDB(B1, 1, 1); PG8_STAGE(PG8_SB(1, 0), b3, voffB);
            PG8_BAR; PG8_WAIT_L(0); PG8_MMA(0, 1, At, B1); PG8_BAR;
            PG8_LDA(At, 1, 1); PG8_STAGE(PG8_SA(1, 0), a3, voffA);
            PG8_BAR; PG8_WAIT_L(0); PG8_MMA(1, 0, At, B0); PG8_BAR; PG8_SCHED;
            PG8_STAGE(PG8_SB(1, 1), b3 + hstep, voffB);
            PG8_WAIT_V(6); PG8_BAR; PG8_MMA(1, 1, At, B1); PG8_BAR;
            }
        }
        if constexpr (ALIGN_EPI) { if (wr == 0) PG8_BAR; }
        if constexpr (!Epi::AFTER_DRAIN) { E(acc, cur, wr, wc, fr, fq); S.done(cur); }
        if (!has_next) break;
#pragma unroll
        for (int a = 0; a < 2; ++a)
#pragma unroll
            for (int b = 0; b < 2; ++b)
#pragma unroll
                for (int m = 0; m < 4; ++m)
#pragma unroll
                    for (int n = 0; n < 2; ++n) acc[a][b][m][n] = (f32x4){0.f, 0.f, 0.f, 0.f};
        cur = nxt; cA = nA; cB = nB; ++ui;
        if constexpr (ALIGN_EPI) { if (wr == 1) PG8_BAR; }
    }
    PG8_WAIT_V(0);
    if constexpr (!ALIGN_EPI) { if (wr == 0) PG8_BAR; }
    PG8_BAR;
    if constexpr (Epi::AFTER_DRAIN) { E.fused(acc, cur, wr, wc, fr, fq, lds, wid, lane); S.done(cur); }
#undef PG8_SA
#undef PG8_SB
#undef PG8_STAGE
#undef PG8_LDA
#undef PG8_LDB
#undef PG8_MMA
#undef PG8_WAIT_V
#undef PG8_WAIT_L
#undef PG8_BAR
#undef PG8_SCHED
}
}

#ifndef PG8_SP2
#define PG8_SP2 true
#endif
#ifndef PG8_ALIGN
#define PG8_ALIGN true
#endif
constexpr int NWAVES = 8, NTHREADS = NWAVES * 64;
constexpr int BATCH = 2, SEQ = 4096, T = BATCH * SEQ, D = 2048;
constexpr int INW = 6160, NPROJ = 6144;
constexpr int GQ = 0, GK = 512, GV = 1024, GG = 2048, MQ = 3072, MK = 4096, MV = 5120;
constexpr int GA_SRC = 3072;
constexpr int NH = 8, NEXP = 16384, NMOD = 6 * D;
constexpr float EPS = 1e-6f;
#ifndef MK_N_LAUNCHES
#define MK_N_LAUNCHES 1
#endif
constexpr int N_PHASES = 13;
#ifndef P3_GLA_TWICE
#define P3_GLA_TWICE 0
#endif
#ifndef PROBE_TS
#define PROBE_TS -1
#endif
constexpr int NSL = 8, SLW = 256, PCH = 128, NCHUNK = (BATCH * SEQ) / PCH;

constexpr size_t MiB = 1u << 20;
constexpr size_t WS_CTL = 0, CTL_ZERO_BYTES = 128 * 1024;
constexpr size_t WS_WIN = 1 * MiB, WS_WGA = 25 * MiB, WS_WOUT = 26 * MiB, WS_WQ = 34 * MiB, WS_KEYS = 42 * MiB, WS_CS = 43 * MiB, WS_KMEAN = 44 * MiB, WS_DEC = 45 * MiB;
constexpr size_t WS_UB = 46 * MiB, WS_VB = 110 * MiB, WS_H = 174 * MiB, WS_CONCAT = 206 * MiB, WS_BCUM = 238 * MiB, WS_UT = 254 * MiB, WS_ST = 286 * MiB, WS_PROJ = 302 * MiB;
constexpr size_t WS_QP = WS_PROJ, WS_EXP = 366 * MiB, WS_GATE = 370 * MiB, WS_GU = 374 * MiB, WS_ACT = 378 * MiB, WS_HQ = 382 * MiB, WS_QDEC = 398 * MiB, WS_KDEC = 406 * MiB, WS_KUPD = 414 * MiB, WS_PART = 422 * MiB, WS_ML = 486 * MiB, WS_LIST = 488 * MiB, WS_SEL = 492 * MiB, WS_PW = 493 * MiB, WS_WSC = 494 * MiB, WS_END = 495 * MiB;
constexpr size_t WS_US = WS_UB + 40 * MiB, WS_VS = WS_VB + 40 * MiB, WS_HS = WS_VB + 41 * MiB;
constexpr int CW_BAR = 4096, CW_Q = 8192, CW_QA = 12288, CW_QB = 13312, CW_LCNT = 14336, CW_MOD = 16384;
static_assert((CW_MOD + 2048) * 4 <= (int)CTL_ZERO_BYTES, "CTL words inside the memset region");
constexpr size_t WS_MODF = 45 * MiB + 512 * 1024;

constexpr int RING_BYTES = 131072, MISC_OFF = RING_BYTES + 320, LDS_BYTES = 147456;

#define GAS __attribute__((address_space(1)))
#define LAS __attribute__((address_space(3)))
typedef unsigned short bf16;
typedef unsigned v4u __attribute__((ext_vector_type(4)));
typedef unsigned v2u __attribute__((ext_vector_type(2)));
typedef float f32x4 __attribute__((ext_vector_type(4)));
typedef float f32x2 __attribute__((ext_vector_type(2)));
typedef float f32x16 __attribute__((ext_vector_type(16)));
typedef short bf16x8 __attribute__((ext_vector_type(8)));
typedef short s16x4 __attribute__((ext_vector_type(4)));
typedef __bf16 bf16x2_t __attribute__((ext_vector_type(2)));
typedef GAS unsigned gu32;
#define LDS_WAIT() asm volatile("s_waitcnt lgkmcnt(0)" ::: "memory")
#define VM_WAIT() asm volatile("s_waitcnt vmcnt(0)" ::: "memory")
__device__ __forceinline__ unsigned pk2(float lo, float hi) { f32x2 v = {lo, hi}; bf16x2_t b = __builtin_convertvector(v, bf16x2_t); return __builtin_bit_cast(unsigned, b); }
__device__ __forceinline__ float bflo(unsigned u) { return __uint_as_float(u << 16); }
__device__ __forceinline__ float bfhi(unsigned u) { return __uint_as_float(u & 0xffff0000u); }
__device__ __forceinline__ float bf1(short s) { return __uint_as_float(((unsigned)(unsigned short)s) << 16); }
__device__ __forceinline__ bf16x8 pack8(float a0, float a1, float a2, float a3, float a4, float a5, float a6, float a7) { v4u w; w.x = pk2(a0, a1); w.y = pk2(a2, a3); w.z = pk2(a4, a5); w.w = pk2(a6, a7); return __builtin_bit_cast(bf16x8, w); }
__device__ __forceinline__ int crow(int r, int hi) { return (r & 3) + 8 * (r >> 2) + 4 * hi; }
__device__ __forceinline__ float wave_sum(float v) {
#pragma unroll
    for (int o = 1; o < 64; o <<= 1) v += __shfl_xor(v, o);
    return v;
}
typedef short v4i16_t __attribute__((ext_vector_type(4)));
__device__ __forceinline__ s16x4 vtr(const LAS unsigned char* p) { return __builtin_bit_cast(s16x4, __builtin_amdgcn_ds_read_tr16_b64_v4i16((LAS v4i16_t*)p)); }
__device__ __forceinline__ bf16x8 cat4(s16x4 lo, s16x4 hi) { return (bf16x8){lo[0], lo[1], lo[2], lo[3], hi[0], hi[1], hi[2], hi[3]}; }
#define MFMA32(a, b, c) __builtin_amdgcn_mfma_f32_32x32x16_bf16((a), (b), (c), 0, 0, 0)
#define XB_TMO      128
#define XB_XCNT(j)  (256  + 64 * (j))
#define XB_XSUB(j)  (1280 + 64 * (j))
#define XB_XGEN(j)  (2304 + 64 * (j))
#define XB_TOP      3328
#define XB_TOPGEN   3392
#define XCD_BAR_WORDS 3456
#define XB_SPIN_CAP (1u << 18)

__device__ __forceinline__ unsigned xb_ld(unsigned* p)              { return __hip_atomic_load(p, __ATOMIC_RELAXED, __HIP_MEMORY_SCOPE_AGENT); }
__device__ __forceinline__ unsigned xb_add(unsigned* p, unsigned v) { return __hip_atomic_fetch_add(p, v, __ATOMIC_RELAXED, __HIP_MEMORY_SCOPE_AGENT); }
__device__ __forceinline__ unsigned xb_xcc_id() { return (unsigned)__builtin_amdgcn_s_getreg((3 << 11) | 20) & 0xFu; }
#define XB_SPIN(cond, bar) do { unsigned _sp = 0; while (cond) { __builtin_amdgcn_s_sleep(1); \
    if ((++_sp & 255u) == 0u) { if (xb_ld(&(bar)[XB_TMO])) break; if (_sp > XB_SPIN_CAP) { atomicAdd(&(bar)[XB_TMO], 1u); break; } } } } while (0)

struct XcdBarrier {
    unsigned* bar; unsigned x;
    volatile LAS unsigned* st;
};

__device__ __forceinline__ XcdBarrier xcd_barrier_post(unsigned* bar, volatile LAS unsigned* st) {
    XcdBarrier b; b.bar = bar; b.x = xb_xcc_id(); b.st = st;
    if (threadIdx.x == 0) (void)xb_add(&bar[XB_XCNT(b.x)], 1u);
    return b;
}
__device__ __forceinline__ void xcd_barrier_complete(unsigned* bar, unsigned x, unsigned& nloc, unsigned& nx) {
    const unsigned G = gridDim.x * gridDim.y * gridDim.z;
    unsigned sum, cnt, mine, sp = 0u;
    for (;;) {
        sum = 0u; cnt = 0u; mine = 0u;
#pragma unroll
        for (unsigned j = 0; j < 16; ++j) { const unsigned c = xb_ld(&bar[XB_XCNT(j)]); sum += c; cnt += (c > 0u) ? 1u : 0u; mine = (j == x) ? c : mine; }
        if (sum == G) break;
        __builtin_amdgcn_s_sleep(1);
        if ((++sp & 255u) == 0u) { if (xb_ld(&bar[XB_TMO])) break; if (sp > XB_SPIN_CAP) { atomicAdd(&bar[XB_TMO], 1u); break; } }
    }
    nloc = mine > 0u ? mine : 1u; nx = cnt > 0u ? cnt : 1u;
}

__device__ __forceinline__ void xcd_barrier(const XcdBarrier& b) {
    asm volatile("s_waitcnt vmcnt(0)" ::: "memory");
    __syncthreads();
    if (threadIdx.x == 0) {
        unsigned* bar = b.bar;
        __builtin_amdgcn_s_waitcnt(0);
        unsigned nloc = b.st[0], nx = b.st[1];
        if (nloc == 0u) { xcd_barrier_complete(bar, b.x, nloc, nx); b.st[0] = nloc; b.st[1] = nx; }
        const unsigned old = xb_add(&bar[XB_XSUB(b.x)], 1u);
        const unsigned gen = old / nloc;
        if (old + 1u == (gen + 1u) * nloc) {
            __builtin_amdgcn_fence(__ATOMIC_RELEASE, "agent");
            asm volatile("s_waitcnt vmcnt(0)" ::: "memory");
            const unsigned og = xb_add(&bar[XB_TOP], 1u);
            const unsigned tg = og / nx;
            if (og + 1u == (tg + 1u) * nx) xb_add(&bar[XB_TOPGEN], 1u);
            else XB_SPIN(xb_ld(&bar[XB_TOPGEN]) == tg, bar);
            __builtin_amdgcn_fence(__ATOMIC_ACQUIRE, "agent");
            xb_add(&bar[XB_XGEN(b.x)], 1u);
            asm volatile("s_waitcnt vmcnt(0)" ::: "memory");
        } else {
            XB_SPIN(xb_ld(&bar[XB_XGEN(b.x)]) == gen, bar);
            __builtin_amdgcn_fence(__ATOMIC_ACQUIRE, "agent");
            asm volatile("s_waitcnt vmcnt(0)" ::: "memory");
        }
    }
    __syncthreads();
}

struct Ctx {
    LAS unsigned char* lds;
    int tid, lane, wave, vcu, G, gw, ngw;
    const float *x, *c; const int* pos; const float *w_ada, *b_ada, *g1, *w_in, *w_a2, *b_a, *gla_g, *qg, *kg, *w_out, *g2, *w_q, *keys, *pu, *pv;
    float* out;
    unsigned* ctl; long long* MODI; float* MOD;
    bf16 *WIN, *WGA, *WOUT, *WQ, *KEYSB, *H, *CONCAT, *PROJ, *ST, *QDEC, *KDEC, *KUPD, *PART; float* ML; unsigned short *LIST, *SEL; unsigned* PW; float* WSC;
    unsigned char *UQ, *VQ, *HQ;
    float *CS, *KMEAN, *DEC, *BCUM, *UT, *QP, *GATE, *GU, *US, *VS, *HS; int *EXPI, *ACT;
};

__device__ __forceinline__ void transpose_item(const float* W, int ldw, int K, bf16* WT, int dst_row0, int k0, int n0, LAS float* scr, int lane) {
#pragma unroll 8
    for (int i = 0; i < 32; ++i) { const int kk = 2 * i + (lane >> 5); scr[kk * 33 + (lane & 31)] = W[(size_t)(k0 + kk) * ldw + n0 + (lane & 31)]; }
    LDS_WAIT(); asm volatile("" ::: "memory");
    const int c = lane & 7;
#pragma unroll
    for (int j = 0; j < 4; ++j) { const int n = (lane >> 3) + 8 * j; const LAS float* s = scr + (8 * c) * 33 + n;
        v4u o; o.x = pk2(s[0 * 33], s[1 * 33]); o.y = pk2(s[2 * 33], s[3 * 33]); o.z = pk2(s[4 * 33], s[5 * 33]); o.w = pk2(s[6 * 33], s[7 * 33]);
        *(v4u*)(WT + (size_t)(dst_row0 + n) * K + k0 + 8 * c) = o; }
    LDS_WAIT(); asm volatile("" ::: "memory");
}
__device__ __forceinline__ void convert_item(const float* src, bf16* dst, size_t item, int lane) {
    const f32x4* s = (const f32x4*)(src + item * 8192) + 2 * lane; v4u* d = (v4u*)(dst + item * 8192) + lane;
#pragma unroll 4
    for (int it = 0; it < 16; ++it) { const f32x4 a = s[it * 128], b = s[it * 128 + 1]; v4u o; o.x = pk2(a.x, a.y); o.y = pk2(a.z, a.w); o.z = pk2(b.x, b.y); o.w = pk2(b.z, b.w); d[it * 64] = o; }
}
__device__ __forceinline__ float wave_max(float v) {
#pragma unroll
    for (int o = 1; o < 64; o <<= 1) v = fmaxf(v, __shfl_xor(v, o));
    return v;
}
__device__ __forceinline__ void quant_store(const f32x4 (&v)[8], unsigned char* dst, float* scales, int row, size_t nrows, int lane, int bias) {
    float am = 0.f;
#pragma unroll
    for (int j = 0; j < 8; ++j) am = fmaxf(am, fmaxf(fmaxf(fabsf(v[j].x), fabsf(v[j].y)), fmaxf(fabsf(v[j].z), fabsf(v[j].w))));
    am = wave_max(am);
    const float inv = am > 0.f ? 127.f / am : 0.f;
    if (lane == 0) scales[row] = am > 0.f ? am / 127.f : 1.f;
#pragma unroll
    for (int j = 0; j < 8; ++j) { const int q0 = (int)rintf(v[j].x * inv) + bias, q1 = (int)rintf(v[j].y * inv) + bias, q2 = (int)rintf(v[j].z * inv) + bias, q3 = (int)rintf(v[j].w * inv) + bias;
        *(unsigned*)(dst + ((size_t)j * nrows + row) * 256 + 4 * lane) = (unsigned)(q0 & 0xff) | ((unsigned)(q1 & 0xff) << 8) | ((unsigned)(q2 & 0xff) << 16) | ((unsigned)(q3 & 0xff) << 24); }
}
__device__ __forceinline__ void quant_row(const float* src, unsigned char* dst, float* scales, int row, size_t nrows, int lane, int bias) {
    const f32x4* s = (const f32x4*)src + lane; f32x4 v[8];
#pragma unroll
    for (int j = 0; j < 8; ++j) v[j] = s[64 * j];
    quant_store(v, dst, scales, row, nrows, lane, bias);
}
__device__ __forceinline__ void p0_phase(const Ctx& C, int rep) {
    const int lane = C.lane, gw = C.gw, ngw = C.ngw;
    LAS float* sc = (LAS float*)C.lds;
    LAS float* part = sc + BATCH * D;
    for (int i = C.tid; i < BATCH * D; i += NTHREADS) { const float v = C.c[i]; sc[i] = v / (1.f + __expf(-v)); }
    __syncthreads();
    for (int it = C.vcu; it < 192; it += C.G) {
        const int cq = lane & 15, rg = lane >> 4, col = it * 64 + 4 * cq, r0 = 256 * C.wave + rg;
        const f32x4* w = (const f32x4*)(C.w_ada + (size_t)r0 * NMOD + col); const LAS float* s0 = sc + r0; const LAS float* s1 = sc + D + r0;
        f32x4 a0 = {0.f, 0.f, 0.f, 0.f}, a1 = a0;
#pragma unroll 16
        for (int k = 0; k < 64; ++k) { const f32x4 wv = w[(size_t)k * NMOD]; a0 += s0[4 * k] * wv; a1 += s1[4 * k] * wv; }
#pragma unroll
        for (int q = 0; q < 4; ++q) { a0[q] += __shfl_xor(a0[q], 16); a0[q] += __shfl_xor(a0[q], 32); a1[q] += __shfl_xor(a1[q], 16); a1[q] += __shfl_xor(a1[q], 32); }
        if (rg == 0) { *(LAS f32x4*)(part + (C.wave * 2 + 0) * 64 + 4 * cq) = a0; *(LAS f32x4*)(part + (C.wave * 2 + 1) * 64 + 4 * cq) = a1; }
        __syncthreads();
        if (C.tid < 128) { const int bb = C.tid >> 6, cl = C.tid & 63; float s = 0.f;
#pragma unroll
            for (int ww = 0; ww < 8; ++ww) s += part[(ww * 2 + bb) * 64 + cl];
            C.MOD[bb * NMOD + it * 64 + cl] = s + C.b_ada[it * 64 + cl]; }
        __syncthreads();
    }
    LAS float* scr = (LAS float*)(C.lds + C.wave * 16384);
    constexpr int I_IN = 32 * 192, I_SQ = 32 * 64;
    for (int it = gw; it < I_IN + 2 * I_SQ; it += ngw) {
        int r = it;
        if (r < I_IN) { const int kb = r / 192, nb = r % 192, n0 = 32 * nb; transpose_item(C.w_in, INW, D, C.WIN, n0, 64 * kb, n0 < 3072 ? n0 : n0 + 16, scr, lane); continue; } r -= I_IN;
        if (r < I_SQ) { transpose_item(C.w_out, D, D, C.WOUT, 32 * (r % 64), 64 * (r / 64), 32 * (r % 64), scr, lane); continue; } r -= I_SQ;
        transpose_item(C.w_q, D, D, C.WQ, 32 * (r % 64), 64 * (r / 64), 32 * (r % 64), scr, lane);
    }
    for (int it = gw; it < 32; it += ngw) { const int k = it * 64 + lane; const f32x4* s = (const f32x4*)(C.w_in + (size_t)k * INW + GA_SRC);
#pragma unroll
        for (int q = 0; q < 4; ++q) { const f32x4 v = s[q]; C.WGA[(4 * q + 0) * D + k] = (bf16)(pk2(v.x, 0.f) & 0xffff); C.WGA[(4 * q + 1) * D + k] = (bf16)(pk2(v.y, 0.f) & 0xffff);
            C.WGA[(4 * q + 2) * D + k] = (bf16)(pk2(v.z, 0.f) & 0xffff); C.WGA[(4 * q + 3) * D + k] = (bf16)(pk2(v.w, 0.f) & 0xffff); } }
    for (int it = gw; it < NEXP; it += ngw) {
        const f32x4* su = (const f32x4*)(C.pu + (size_t)it * D) + lane; const f32x4* sv = (const f32x4*)(C.pv + (size_t)it * D) + lane; f32x4 vu[8], vv[8];
#pragma unroll
        for (int j = 0; j < 8; ++j) { vu[j] = su[64 * j]; vv[j] = sv[64 * j]; }
        quant_store(vu, C.UQ, C.US, it, NEXP, lane, 0); quant_store(vv, C.VQ, C.VS, it, NEXP, lane, 0);
    }
    for (int it = gw; it < 32; it += ngw) convert_item(C.keys, C.KEYSB, it, lane);
    for (int idx = C.vcu * NTHREADS + C.tid; idx < T * 16; idx += C.G * NTHREADS) {
        const int t = idx >> 4, f = idx & 15; const float inv = powf(500000.0f, -(float)f * 0.0625f); const float ang = (float)C.pos[t] * inv;
        C.CS[2 * idx] = cosf(ang); C.CS[2 * idx + 1] = sinf(ang);
    }
}

__device__ __forceinline__ float modi_to_f32(long long v) { return (float)(int)(v >> 32) * 0.00390625f + (float)(unsigned)v * 9.094947017729282e-13f; }
template <bool FIRST> __device__ __forceinline__ void norm_mod_phase(const Ctx& C, const float* X, const float* g, int shift_off, int scale_off, bf16* O) {
    LAS float* lg = (LAS float*)C.lds; LAS float* lsh = lg + D; LAS float* lsc = lsh + BATCH * D;
    for (int i = C.tid; i < D; i += NTHREADS) lg[i] = g[i];
    for (int i = C.tid; i < BATCH * D; i += NTHREADS) { const int b = i / D, j = i % D;
        lsh[i] = C.MOD[b * NMOD + shift_off + j]; lsc[i] = 1.f + C.MOD[b * NMOD + scale_off + j]; }
    __syncthreads();
    for (int m = C.gw; m < T; m += C.ngw) {
        const int b = m / SEQ; const f32x4* xr = (const f32x4*)(X + (size_t)m * D) + C.lane;
        f32x4 v[8]; float ss = 0.f;
#pragma unroll
        for (int j = 0; j < 8; ++j) { v[j] = xr[64 * j]; ss += (v[j].x * v[j].x + v[j].y * v[j].y) + (v[j].z * v[j].z + v[j].w * v[j].w); }
        const float rstd = rsqrtf(wave_sum(ss) * (1.f / D) + EPS);
        const LAS f32x4* g4 = (const LAS f32x4*)lg + C.lane; const LAS f32x4* sh4 = (const LAS f32x4*)(lsh + b * D) + C.lane; const LAS f32x4* sc4 = (const LAS f32x4*)(lsc + b * D) + C.lane;
        v2u* o8 = (v2u*)(O + (size_t)m * D) + C.lane;
#pragma unroll
        for (int j = 0; j < 8; ++j) { const f32x4 y = v[j] * rstd * g4[64 * j] * sc4[64 * j] + sh4[64 * j]; v2u w; w.x = pk2(y.x, y.y); w.y = pk2(y.z, y.w); o8[64 * j] = w; v[j] = y; }
        if (!FIRST) quant_store(v, C.HQ, C.HS, m, T, C.lane, 0);
    }
    __syncthreads();
}

__device__ __forceinline__ void gla_prep_item(const Ctx& C, int b, int n, int ch) {
    const int lane = C.lane, w = C.wave, fr = lane & 15, fq = lane >> 4, rt = w & 3, kh = w >> 2; const size_t t0 = (size_t)b * SEQ + 64 * n;
    const bf16* ap = C.H + (t0 + 16 * rt + fr) * D + kh * 1024 + 8 * fq; const bf16* bp = C.WGA + fr * D + kh * 1024 + 8 * fq;
    f32x4 acc = {0.f, 0.f, 0.f, 0.f};
#pragma unroll 16
    for (int s = 0; s < 32; ++s) acc = __builtin_amdgcn_mfma_f32_16x16x32_bf16(*(const bf16x8*)(ap + 32 * s), *(const bf16x8*)(bp + 32 * s), acc, 0, 0, 0);
    LAS float* gaP = (LAS float*)C.lds;
#pragma unroll
    for (int r = 0; r < 4; ++r) gaP[kh * 1024 + (16 * rt + 4 * fq + r) * 16 + fr] = acc[r];
    __syncthreads();
    const int cq = C.tid & 63, tg = C.tid >> 6, col = ch * 256 + 4 * cq; f32x4 wc[16];
#pragma unroll
    for (int r = 0; r < 16; ++r) wc[r] = *(const f32x4*)(C.w_a2 + r * 512 + col);
    const f32x4 ba = *(const f32x4*)(C.b_a + col); f32x4 cum = {0.f, 0.f, 0.f, 0.f}, la[8];
    v2u qraw[8], kraw[8];
#pragma unroll
    for (int k = 0; k < 8; ++k) { const size_t tok = t0 + 8 * tg + k; qraw[k] = *(const v2u*)(C.PROJ + tok * NPROJ + GQ + col); kraw[k] = *(const v2u*)(C.PROJ + tok * NPROJ + GK + col); }
#pragma unroll
    for (int k = 0; k < 8; ++k) { const int tok = 8 * tg + k;
        const LAS f32x4* g0 = (const LAS f32x4*)(gaP + tok * 16); const LAS f32x4* g1 = (const LAS f32x4*)(gaP + 1024 + tok * 16); f32x4 z = ba;
#pragma unroll
        for (int q = 0; q < 4; ++q) { const f32x4 gv = g0[q] + g1[q]; z += gv.x * wc[4 * q] + gv.y * wc[4 * q + 1] + gv.z * wc[4 * q + 2] + gv.w * wc[4 * q + 3]; }
#pragma unroll
        for (int j = 0; j < 4; ++j) cum[j] += (fminf(z[j], 0.f) - __logf(1.f + __expf(-fabsf(z[j])))) * 0.0625f;
        la[k] = cum; }
    *(LAS f32x4*)(gaP + 2048 + tg * 256 + 4 * cq) = cum;
    __syncthreads();
    f32x4 base = {0.f, 0.f, 0.f, 0.f}, blast = base;
#pragma unroll
    for (int g = 0; g < 8; ++g) { const f32x4 pt = *(const LAS f32x4*)(gaP + 2048 + g * 256 + 4 * cq); blast += pt; if (g < tg) base += pt; }
    if (tg == 7) *(f32x4*)(C.DEC + ((size_t)(b * NH + (col >> 6)) * 64 + n) * 64 + (col & 63)) = (f32x4){__expf(blast.x), __expf(blast.y), __expf(blast.z), __expf(blast.w)};
#pragma unroll
    for (int k = 0; k < 8; ++k) { const size_t tok = t0 + 8 * tg + k; const f32x4 bb = la[k] + base;
        const float q0 = bflo(qraw[k].x), q1 = bfhi(qraw[k].x), q2 = bflo(qraw[k].y), q3 = bfhi(qraw[k].y), k0 = bflo(kraw[k].x), k1 = bfhi(kraw[k].x), k2 = bflo(kraw[k].y), k3 = bfhi(kraw[k].y);
        v2u o; o.x = pk2(q0 * 0.125f * __expf(bb.x), q1 * 0.125f * __expf(bb.y)); o.y = pk2(q2 * 0.125f * __expf(bb.z), q3 * 0.125f * __expf(bb.w)); *(v2u*)(C.QDEC + tok * 512 + col) = o;
        o.x = pk2(k0 * __expf(-bb.x), k1 * __expf(-bb.y)); o.y = pk2(k2 * __expf(-bb.z), k3 * __expf(-bb.w)); *(v2u*)(C.KDEC + tok * 512 + col) = o;
        o.x = pk2(k0 * __expf(blast.x - bb.x), k1 * __expf(blast.y - bb.y)); o.y = pk2(k2 * __expf(blast.z - bb.z), k3 * __expf(blast.w - bb.w)); *(v2u*)(C.KUPD + tok * 512 + col) = o; }
    __syncthreads();
}
__device__ __forceinline__ void moba_prep_item(const Ctx& C, int b, int h, int blk, int rep) {
    const int lane = C.lane, w = C.wave, i = lane & 15, tg = lane >> 4; const size_t t0 = (size_t)b * SEQ + 256 * blk;
    float qg[8], kg[8], km[8];
#pragma unroll
    for (int j = 0; j < 8; ++j) { qg[j] = C.qg[8 * i + j]; kg[j] = C.kg[8 * i + j]; km[j] = 0.f; }
    v4u rawq[8], rawk[8];
#pragma unroll
    for (int it = 0; it < 8; ++it) { const size_t tok = t0 + 32 * w + 4 * it + tg; rawq[it] = *(const v4u*)(C.PROJ + tok * NPROJ + MQ + h * 128 + 8 * i); rawk[it] = *(const v4u*)(C.PROJ + tok * NPROJ + MK + h * 128 + 8 * i); }
#pragma unroll
    for (int it = 0; it < 8; ++it) {
        const size_t tok = t0 + 32 * w + 4 * it + tg;
        float cs[16];
        if (i < 4) { const f32x4* cp = (const f32x4*)(C.CS + tok * 32 + (i & 1) * 16);
#pragma unroll
            for (int q = 0; q < 4; ++q) { const f32x4 v = cp[q]; cs[4 * q] = v.x; cs[4 * q + 1] = v.y; cs[4 * q + 2] = v.z; cs[4 * q + 3] = v.w; } }
        else {
#pragma unroll
            for (int q = 0; q < 16; ++q) cs[q] = 0.f; }
#pragma unroll
        for (int which = 0; which < 2; ++which) {
            bf16* p = C.PROJ + tok * NPROJ + (which ? MK : MQ) + h * 128 + 8 * i;
            const v4u raw = which ? rawk[it] : rawq[it]; float xv[8];
            xv[0] = bflo(raw.x); xv[1] = bfhi(raw.x); xv[2] = bflo(raw.y); xv[3] = bfhi(raw.y); xv[4] = bflo(raw.z); xv[5] = bfhi(raw.z); xv[6] = bflo(raw.w); xv[7] = bfhi(raw.w);
            float ss = 0.f;
#pragma unroll
            for (int j = 0; j < 8; ++j) ss += xv[j] * xv[j];
            ss += __shfl_xor(ss, 1); ss += __shfl_xor(ss, 2); ss += __shfl_xor(ss, 4); ss += __shfl_xor(ss, 8);
            const float rstd = rsqrtf(ss * (1.f / 128.f) + EPS);
#pragma unroll
            for (int j = 0; j < 8; ++j) xv[j] = xv[j] * rstd * (which ? kg[j] : qg[j]);
#pragma unroll
            for (int j = 0; j < 8; ++j) { const float o = __shfl_xor(xv[j], 2); const float cv = cs[2 * j], sv = cs[2 * j + 1];
                if (i < 2) xv[j] = xv[j] * cv - o * sv; else if (i < 4) xv[j] = xv[j] * cv + o * sv; }
            v4u o; o.x = pk2(xv[0], xv[1]); o.y = pk2(xv[2], xv[3]); o.z = pk2(xv[4], xv[5]); o.w = pk2(xv[6], xv[7]);
            if (rep) *(v4u*)(C.CONCAT + tok * D + which * 1024 + h * 128 + 8 * i) = o; else *(v4u*)p = o;
            if (which) {
#pragma unroll
                for (int j = 0; j < 8; ++j) km[j] += xv[j]; }
        }
    }
    LAS float* red = (LAS float*)C.lds;
#pragma unroll
    for (int j = 0; j < 8; ++j) { km[j] += __shfl_xor(km[j], 16); km[j] += __shfl_xor(km[j], 32); }
    if (lane < 16) {
#pragma unroll
        for (int j = 0; j < 8; ++j) red[w * 128 + 8 * i + j] = km[j]; }
    __syncthreads();
    if (C.tid < 128) { float s = 0.f;
#pragma unroll
        for (int ww = 0; ww < 8; ++ww) s += red[ww * 128 + C.tid];
        C.KMEAN[((size_t)(b * NH + h) * 16 + blk) * 128 + C.tid] = s * (1.f / 256.f); }
    __syncthreads();
}


constexpr int KP = 272, VP = 320;
__device__ __forceinline__ void moba_select_item(const Ctx& C, int b, int h, int qb, int rep) {
    const int lane = C.lane, w = C.wave, r = lane & 31, hh = lane >> 5; const size_t tb = (size_t)b * SEQ; const int qtok = qb * 256 + 32 * w + r;
    bf16x8 qf[8];
    { const bf16* qrow = C.PROJ + MQ + h * 128 + (tb + qtok) * NPROJ + 8 * hh;
#pragma unroll
      for (int s = 0; s < 8; ++s) qf[s] = *(const bf16x8*)(qrow + 16 * s); }
    float g0 = -INFINITY, g1 = -INFINITY, g2 = -INFINITY; int i0 = -1, i1 = -1, i2 = -1;
    LAS float* kml = (LAS float*)C.lds;
    for (int i = C.tid; i < qb * 128; i += NTHREADS) kml[i] = C.KMEAN[((size_t)(b * NH + h) * 16) * 128 + i];
    __syncthreads();
    const LAS float* km = kml + 8 * hh;
    for (int j = 0; j < qb; ++j) {
        float acc = 0.f;
#pragma unroll
        for (int s = 0; s < 8; ++s) { const f32x4 k0 = *(const LAS f32x4*)(km + j * 128 + 16 * s), k1 = *(const LAS f32x4*)(km + j * 128 + 16 * s + 4);
            acc += bf1(qf[s][0]) * k0.x + bf1(qf[s][1]) * k0.y + bf1(qf[s][2]) * k0.z + bf1(qf[s][3]) * k0.w + bf1(qf[s][4]) * k1.x + bf1(qf[s][5]) * k1.y + bf1(qf[s][6]) * k1.z + bf1(qf[s][7]) * k1.w; }
        acc += __shfl_xor(acc, 32);
        if (acc > g0) { g2 = g1; i2 = i1; g1 = g0; i1 = i0; g0 = acc; i0 = j; }
        else if (acc > g1) { g2 = g1; i2 = i1; g1 = acc; i1 = j; }
        else if (acc > g2) { g2 = acc; i2 = j; }
    }
    __syncthreads();
    const int np = (i0 >= 0) + (i1 >= 0) + (i2 >= 0);
    if (hh == 0) C.SEL[(tb + qtok) * NH + h] = (unsigned short)((i0 & 15) | ((i1 & 15) << 4) | ((i2 & 15) << 8) | (np << 12));
    unsigned* lc = C.ctl + (rep ? 16384 : CW_LCNT) + ((b * NH + h) * 16) * 8; int nv = 0;
#pragma unroll
    for (int j = 0; j < 15; ++j) { const unsigned long long mk = __ballot(hh == 0 && (i0 == j || i1 == j || i2 == j)); nv = (lane == j) ? (int)__popcll(mk) : nv; }
    int basev = 0; if (lane < 15 && nv > 0) basev = (int)atomicAdd(lc + lane * 8, (unsigned)nv);
    unsigned short* lp = C.LIST + (size_t)((b * NH + h) * 16) * 4096 + (rep ? 256 * 4096 : 0);
#pragma unroll
    for (int j = 0; j < 15; ++j) { const int bj = __builtin_amdgcn_readlane(basev, j); const bool pj = hh == 0 && (i0 == j || i1 == j || i2 == j); const unsigned long long mk = __ballot(pj);
        if (pj) { const int slot = (i0 == j) ? 0 : (i1 == j) ? 1 : 2;
            const int pos = bj + (int)__builtin_amdgcn_mbcnt_hi((unsigned)(mk >> 32), __builtin_amdgcn_mbcnt_lo((unsigned)mk, 0u));
            lp[j * 4096 + pos] = (unsigned short)(qtok | (slot << 12)); } }
}
__device__ __forceinline__ void moba_attn_item(const Ctx& C, int b, int h, int kblk, bool own, int sub) {
    const int lane = C.lane, w = C.wave, r = lane & 31, hh = lane >> 5; const size_t tb = (size_t)b * SEQ; const int li = (b * NH + h) * 16 + kblk;
    { const char* kp = (const char*)(C.PROJ + (tb + kblk * 256) * NPROJ + MK + h * 128); const char* vp = (const char*)(C.PROJ + (tb + kblk * 256) * NPROJ + MV + h * 128);
#pragma unroll
      for (int i = 0; i < 8; ++i) { const int p = w + 8 * i, row = 4 * p + (lane >> 4), cp = lane & 15;
          __builtin_amdgcn_global_load_lds((const unsigned*)(kp + (size_t)row * (NPROJ * 2) + 16 * (cp ^ (row & 15))), (LAS unsigned*)(C.lds + p * 1024), 16, 0, 0);
          __builtin_amdgcn_global_load_lds((const unsigned*)(vp + (size_t)row * (NPROJ * 2) + 16 * (cp ^ ((row & 3) << 2))), (LAS unsigned*)(C.lds + 65536 + p * 1024), 16, 0, 0); } }
    const int cnt = own ? 256 : (int)C.ctl[CW_LCNT + li * 8], e = 256 * sub + 32 * w + r; const bool valid = e < cnt, wave_on = 256 * sub + 32 * w < cnt;
    int qtok, slot;
    if (own) { qtok = kblk * 256 + 32 * w + r; slot = 3; } else { const int ent = C.LIST[(size_t)li * 4096 + (valid ? e : 256 * sub)]; qtok = ent & 4095; slot = ent >> 12; }
    bf16x8 qf[8];
    { const bf16* qrow = C.PROJ + MQ + h * 128 + (tb + qtok) * NPROJ + 8 * hh;
#pragma unroll
      for (int s = 0; s < 8; ++s) qf[s] = *(const bf16x8*)(qrow + 16 * s); }
    __syncthreads();
    if (wave_on) {
        float m_run = -1e30f, l_run = 0.f; f32x16 o[4];
#pragma unroll
        for (int dt = 0; dt < 4; ++dt)
#pragma unroll
            for (int q = 0; q < 16; ++q) o[dt][q] = 0.f;
        const float c2 = 0.08838834764831845f * 1.4426950408889634f;
        const int xr = r & 15, vq = (lane & 15) >> 2, qi = 32 * w + r, ntile = own ? ((32 * w + 31) >> 6) + 1 : 4;
        const int kfo = r * 256, vfo = 65536 + (4 * hh + vq) * 256 + 32 * ((lane >> 4) & 1) + 8 * (lane & 3);
        for (int t = 0; t < ntile; ++t) {
            const LAS unsigned char* kb = C.lds + kfo + t * 16384;
            f32x16 p0, p1;
#pragma unroll
            for (int q = 0; q < 16; ++q) { p0[q] = 0.f; p1[q] = 0.f; }
#pragma unroll
            for (int ss = 0; ss < 8; ++ss) { const int co = ((2 * ss + hh) ^ xr) << 4; const bf16x8 a0 = *(const LAS bf16x8*)(kb + co), a1 = *(const LAS bf16x8*)(kb + 32 * 256 + co);
                p0 = MFMA32(a0, qf[ss], p0); p1 = MFMA32(a1, qf[ss], p1); }
            if (own) {
#pragma unroll
                for (int q = 0; q < 16; ++q) { const int kk = 64 * t + crow(q, hh); if (kk > qi) p0[q] = -INFINITY; if (kk + 32 > qi) p1[q] = -INFINITY; } }
            float mx = fmaxf(p0[0], p1[0]);
#pragma unroll
            for (int q = 1; q < 16; ++q) mx = fmaxf(mx, fmaxf(p0[q], p1[q]));
            { auto rr = __builtin_amdgcn_permlane32_swap(__float_as_uint(mx), __float_as_uint(mx), false, false); mx = fmaxf(__uint_as_float(rr[0]), __uint_as_float(rr[1])); }
            const float m_new = fmaxf(m_run, mx * c2), alpha = __builtin_amdgcn_exp2f(m_run - m_new);
            m_run = m_new; float rs = 0.f;
#pragma unroll
            for (int q = 0; q < 16; ++q) { p0[q] = __builtin_amdgcn_exp2f(p0[q] * c2 - m_new); p1[q] = __builtin_amdgcn_exp2f(p1[q] * c2 - m_new); rs += p0[q] + p1[q]; }
            l_run = l_run * alpha + rs;
            if (__ballot(alpha != 1.f) != 0ull) {
#pragma unroll
                for (int dt = 0; dt < 4; ++dt)
#pragma unroll
                    for (int q = 0; q < 16; ++q) o[dt][q] *= alpha; }
            bf16x8 pf[4];
            pf[0] = pack8(p0[0], p0[1], p0[2], p0[3], p0[4], p0[5], p0[6], p0[7]); pf[1] = pack8(p0[8], p0[9], p0[10], p0[11], p0[12], p0[13], p0[14], p0[15]);
            pf[2] = pack8(p1[0], p1[1], p1[2], p1[3], p1[4], p1[5], p1[6], p1[7]); pf[3] = pack8(p1[8], p1[9], p1[10], p1[11], p1[12], p1[13], p1[14], p1[15]);
            const LAS unsigned char* vb = C.lds + vfo + t * 16384;
#pragma unroll
            for (int dt = 0; dt < 4; ++dt) { const LAS unsigned char* vd = vb + 64 * (dt ^ vq);
#pragma unroll
                for (int kk = 0; kk < 4; ++kk) { const s16x4 lo = vtr(vd + (16 * kk) * 256), hi = vtr(vd + (16 * kk + 8) * 256); o[dt] = MFMA32(cat4(lo, hi), pf[kk], o[dt]); } }
        }
        l_run += __shfl_xor(l_run, 32);
        if (valid) { const float inv = 1.f / l_run; const size_t row = ((tb + qtok) * NH + h) * 4 + slot; bf16* op = C.PART + row * 128 + 4 * hh;
#pragma unroll
            for (int dt = 0; dt < 4; ++dt)
#pragma unroll
                for (int k4 = 0; k4 < 4; ++k4) { v2u wv; wv.x = pk2(o[dt][4 * k4] * inv, o[dt][4 * k4 + 1] * inv); wv.y = pk2(o[dt][4 * k4 + 2] * inv, o[dt][4 * k4 + 3] * inv); *(v2u*)(op + 32 * dt + 8 * k4) = wv; }
            if (hh == 0) *(f32x2*)(C.ML + row * 2) = (f32x2){m_run, l_run}; }
    }
    __syncthreads();
}
__device__ __forceinline__ void moba_merge_token(const Ctx& C, size_t t) {
    const int lane = C.lane, hd = lane >> 3, dc = lane & 7; const size_t row0 = (t * NH + hd) * 4;
    const unsigned short sel = C.SEL[t * NH + hd]; f32x2 ml[4]; v4u pa[4], pc[4];
#pragma unroll
    for (int s = 0; s < 4; ++s) { ml[s] = *(const f32x2*)(C.ML + (row0 + s) * 2); const v4u* pp = (const v4u*)(C.PART + (row0 + s) * 128 + 16 * dc); pa[s] = pp[0]; pc[s] = pp[1]; }
    const int np = sel >> 12; float M = -1e30f, wg[4], wsum = 0.f;
#pragma unroll
    for (int s = 0; s < 4; ++s) { const bool v = (s == 3) || (s < np); ml[s].x = v ? ml[s].x : -1e30f; ml[s].y = v ? ml[s].y : 0.f; M = fmaxf(M, ml[s].x); }
#pragma unroll
    for (int s = 0; s < 4; ++s) { wg[s] = ml[s].y * __builtin_amdgcn_exp2f(ml[s].x - M); wsum += wg[s]; }
    const float inv = 1.f / wsum; float acc[16];
#pragma unroll
    for (int q = 0; q < 16; ++q) acc[q] = 0.f;
#pragma unroll
    for (int s = 0; s < 4; ++s) { const unsigned vm = ((s == 3) || (s < np)) ? 0xffffffffu : 0u; const float ws_ = wg[s] * inv; v4u a = pa[s], c = pc[s];
        a.x &= vm; a.y &= vm; a.z &= vm; a.w &= vm; c.x &= vm; c.y &= vm; c.z &= vm; c.w &= vm;
        acc[0] += ws_ * bflo(a.x); acc[1] += ws_ * bfhi(a.x); acc[2] += ws_ * bflo(a.y); acc[3] += ws_ * bfhi(a.y); acc[4] += ws_ * bflo(a.z); acc[5] += ws_ * bfhi(a.z); acc[6] += ws_ * bflo(a.w); acc[7] += ws_ * bfhi(a.w);
        acc[8] += ws_ * bflo(c.x); acc[9] += ws_ * bfhi(c.x); acc[10] += ws_ * bflo(c.y); acc[11] += ws_ * bfhi(c.y); acc[12] += ws_ * bflo(c.z); acc[13] += ws_ * bfhi(c.z); acc[14] += ws_ * bflo(c.w); acc[15] += ws_ * bfhi(c.w); }
    v4u o0, o1; o0.x = pk2(acc[0], acc[1]); o0.y = pk2(acc[2], acc[3]); o0.z = pk2(acc[4], acc[5]); o0.w = pk2(acc[6], acc[7]); o1.x = pk2(acc[8], acc[9]); o1.y = pk2(acc[10], acc[11]); o1.z = pk2(acc[12], acc[13]); o1.w = pk2(acc[14], acc[15]);
    v4u* op = (v4u*)(C.CONCAT + t * D + 1024 + hd * 128 + 16 * dc); op[0] = o0; op[1] = o1;
}

constexpr int GKP = 192;
__device__ __forceinline__ void gla_v_to_lds(const Ctx& C, size_t t0, int h, int off) {
#pragma unroll
    for (int pp = 0; pp < 2; ++pp) { const int p = C.tid + 512 * pp; const v4u v = *(const v4u*)(C.PROJ + (t0 + (p >> 4)) * NPROJ + GV + h * 128 + 8 * (p & 15)); *(LAS v4u*)(C.lds + off + (p >> 4) * VP + 16 * (p & 15)) = v; }
}
__device__ __forceinline__ void gla_u_item(const Ctx& C, int b, int h, int n4) {
    const int tid = C.tid, lane = C.lane, w = C.wave, r = lane & 31, hh = lane >> 5;
    v4u kr[4], vr[4][2];
#pragma unroll
    for (int c = 0; c < 4; ++c) { const size_t t0 = (size_t)b * SEQ + 64 * (4 * n4 + c); const int tok = tid >> 3, ch = tid & 7;
        kr[c] = *(const v4u*)(C.KUPD + (t0 + tok) * 512 + h * 64 + 8 * ch);
#pragma unroll
        for (int pp = 0; pp < 2; ++pp) { const int p = tid + 512 * pp; vr[c][pp] = *(const v4u*)(C.PROJ + (t0 + (p >> 4)) * NPROJ + GV + h * 128 + 8 * (p & 15)); } }
#pragma unroll
    for (int c = 0; c < 4; ++c) { const int tok = tid >> 3, ch = tid & 7; *(LAS v4u*)(C.lds + c * 32768 + tok * GKP + 16 * ch) = kr[c];
#pragma unroll
        for (int pp = 0; pp < 2; ++pp) { const int p = tid + 512 * pp; *(LAS v4u*)(C.lds + c * 32768 + 64 * GKP + (p >> 4) * VP + 16 * (p & 15)) = vr[c][pp]; } }
    __syncthreads();
    const int mt = w & 3, nt = w >> 2, q = (lane & 15) >> 2, cb = (16 * ((lane >> 4) & 1) + 4 * (lane & 3)) * 2;
#pragma unroll
    for (int c = 0; c < 4; ++c) {
        const LAS unsigned char* va = C.lds + c * 32768 + 64 * GKP + (4 * hh + q) * VP + cb + mt * 64; const LAS unsigned char* ka = C.lds + c * 32768 + (4 * hh + q) * GKP + cb + nt * 64;
        f32x16 acc;
#pragma unroll
        for (int i = 0; i < 16; ++i) acc[i] = 0.f;
#pragma unroll
        for (int s = 0; s < 4; ++s) acc = MFMA32(cat4(vtr(va + 16 * s * VP), vtr(va + (16 * s + 8) * VP)), cat4(vtr(ka + 16 * s * GKP), vtr(ka + (16 * s + 8) * GKP)), acc);
        float* up = C.UT + (size_t)((b * NH + h) * 64 + 4 * n4 + c) * 8192 + (32 * mt) * 64 + 32 * nt + r;
#pragma unroll
        for (int i = 0; i < 16; ++i) up[crow(i, hh) * 64] = acc[i];
    }
    __syncthreads();
}
__device__ __forceinline__ void gla_scan_item(const Ctx& C, int id) {
    { const int idx = id * NTHREADS + C.tid;
        const int bh = idx >> 13, rem = idx & 8191, dk = rem & 63; float s = 0.f;
        const float* up = C.UT + (size_t)bh * 64 * 8192 + rem; const float* dp = C.DEC + (size_t)bh * 64 * 64 + dk; bf16* sp = C.ST + (size_t)bh * 64 * 8192 + rem;
#pragma unroll 16
        for (int n = 0; n < 64; ++n) { sp[(size_t)n * 8192] = (bf16)(pk2(s, 0.f) & 0xffffu); s = dp[n * 64] * s + up[(size_t)n * 8192]; }
    }
}

__device__ __forceinline__ void p5_attn_phase(const Ctx& C, int rep) {
    volatile LAS int* qslot = (volatile LAS int*)(C.lds + MISC_OFF + 64);
    LAS int* pfx = (LAS int*)(C.lds + RING_BYTES + 1024);
    if (C.tid < 256) { const int c = ((C.tid & 15) < 15) ? (int)C.ctl[CW_LCNT + C.tid * 8] : 0; pfx[1 + C.tid] = (c + 255) >> 8; }
    __syncthreads();
    if (C.tid == 0) { int s = 0; pfx[0] = 0; for (int i = 1; i <= 256; ++i) { s += pfx[i]; pfx[i] = s; } }
    __syncthreads();
    const int npast = pfx[256]; unsigned* cnt = C.ctl + CW_Q + 64 * rep;
#define P5_DRAW() (int)atomicAdd(cnt, 1u)
#define P5_DECODE(id, a0, a1) do { a0 = -1; a1 = 0; \
        if ((id) < 256) { a0 = 512 + (id); }                                   \
        else if ((id) < 512) { a0 = (id) - 256; a1 = -1; }                     \
        else if ((id) < 512 + npast) { const int p_ = (id) - 512; int lo_ = 0, hi_ = 256; while (hi_ - lo_ > 1) { const int mid_ = (lo_ + hi_) >> 1; if (pfx[mid_] <= p_) lo_ = mid_; else hi_ = mid_; } a0 = lo_; a1 = p_ - pfx[lo_]; } } while (0)
    if (C.tid == 0) { const int id = P5_DRAW(); int a0, a1; P5_DECODE(id, a0, a1); qslot[0] = a0; qslot[1] = a1; }
    __syncthreads();
    for (;;) {
        const int a0 = qslot[0], a1 = qslot[1];
        if (a0 < 0) break;
        int idn = 0; if (C.tid == 0) idn = P5_DRAW();
        __syncthreads();
        if (a0 < 256) moba_attn_item(C, a0 >> 7, (a0 >> 4) & 7, a0 & 15, a1 < 0, a1 < 0 ? 0 : a1);
        else gla_scan_item(C, a0 - 512);
        if (C.tid == 0) { int b0, b1; P5_DECODE(idn, b0, b1); qslot[0] = b0; qslot[1] = b1; }
        __syncthreads();
    }
#undef P5_DRAW
#undef P5_DECODE
}

__device__ __forceinline__ void gla_out_item(const Ctx& C, int b, int h, int n) {
    const int lane = C.lane, w = C.wave, r = lane & 31, hh = lane >> 5, dvt = w & 3, lt = w >> 2; const size_t t0 = (size_t)b * SEQ + 64 * n; const int bhn = (b * NH + h) * 64 + n;
    constexpr int VT = 0, RED = 64 * VP;
    const size_t tl = t0 + 32 * lt + r;
    v4u vraw[2]; bf16x8 qd[4], kd[2][4];
#pragma unroll
    for (int pp = 0; pp < 2; ++pp) { const int p = C.tid + 512 * pp; vraw[pp] = *(const v4u*)(C.PROJ + (t0 + (p >> 4)) * NPROJ + GV + h * 128 + 8 * (p & 15)); }
#pragma unroll
    for (int s = 0; s < 4; ++s) { qd[s] = *(const bf16x8*)(C.QDEC + tl * 512 + h * 64 + 16 * s + 8 * hh); kd[1][s] = *(const bf16x8*)(C.KDEC + tl * 512 + h * 64 + 16 * s + 8 * hh);
        kd[0][s] = *(const bf16x8*)(C.KDEC + (t0 + r) * 512 + h * 64 + 16 * s + 8 * hh); }
#pragma unroll
    for (int pp = 0; pp < 2; ++pp) { const int p = C.tid + 512 * pp; *(LAS v4u*)(C.lds + VT + (p >> 4) * VP + 16 * (p & 15)) = vraw[pp]; }
    bf16x8 sfr[4]; v2u graw[4]; f32x4 gn[4];
    { const bf16* sp = C.ST + (size_t)bhn * 8192 + (32 * dvt + r) * 64 + 8 * hh;
#pragma unroll
      for (int s = 0; s < 4; ++s) sfr[s] = *(const bf16x8*)(sp + 16 * s);
#pragma unroll
      for (int k4 = 0; k4 < 4; ++k4) { const int d0 = 32 * dvt + 8 * k4 + 4 * hh; graw[k4] = *(const v2u*)(C.PROJ + tl * NPROJ + GG + h * 128 + d0); gn[k4] = *(const f32x4*)(C.gla_g + d0); } }
    __syncthreads();
    f32x16 o;
#pragma unroll
    for (int i = 0; i < 16; ++i) o[i] = 0.f;
    const LAS unsigned char* va = C.lds + VT + (4 * hh + ((lane & 15) >> 2)) * VP + (16 * ((lane >> 4) & 1) + 4 * (lane & 3)) * 2 + dvt * 64;
#pragma unroll
    for (int mt = 0; mt < 2; ++mt) {
        if (mt > lt) break;
        const bool diag = (mt == lt); f32x16 X;
#pragma unroll
        for (int i = 0; i < 16; ++i) X[i] = 0.f;
#pragma unroll
        for (int s = 0; s < 4; ++s) X = MFMA32(diag ? kd[1][s] : kd[0][s], qd[s], X);
        if (diag) {
#pragma unroll
            for (int i = 0; i < 16; ++i) if (crow(i, hh) > r) X[i] = 0.f; }
        const bf16x8 pf0 = pack8(X[0], X[1], X[2], X[3], X[4], X[5], X[6], X[7]), pf1 = pack8(X[8], X[9], X[10], X[11], X[12], X[13], X[14], X[15]);
        o = MFMA32(cat4(vtr(va + (32 * mt) * VP), vtr(va + (32 * mt + 8) * VP)), pf0, o);
        o = MFMA32(cat4(vtr(va + (32 * mt + 16) * VP), vtr(va + (32 * mt + 24) * VP)), pf1, o);
    }
#pragma unroll
    for (int s = 0; s < 4; ++s) o = MFMA32(sfr[s], qd[s], o);
    float ss = 0.f;
#pragma unroll
    for (int i = 0; i < 16; ++i) ss += o[i] * o[i];
    ss += __shfl_xor(ss, 32);
    LAS float* red = (LAS float*)(C.lds + RED);
    if (hh == 0) red[dvt * 64 + 32 * lt + r] = ss;
    __syncthreads();
    const int l = 32 * lt + r; const float rstd = rsqrtf((red[l] + red[64 + l] + red[128 + l] + red[192 + l]) * (1.f / 128.f) + EPS);
#pragma unroll
    for (int k4 = 0; k4 < 4; ++k4) { const int d0 = 32 * dvt + 8 * k4 + 4 * hh;
        const float ga = bflo(graw[k4].x), gb = bfhi(graw[k4].x), gc = bflo(graw[k4].y), gd = bfhi(graw[k4].y); const f32x4 gnv = gn[k4];
        const float y0 = o[4 * k4] * rstd * gnv.x * (ga / (1.f + __expf(-ga))), y1 = o[4 * k4 + 1] * rstd * gnv.y * (gb / (1.f + __expf(-gb)));
        const float y2 = o[4 * k4 + 2] * rstd * gnv.z * (gc / (1.f + __expf(-gc))), y3 = o[4 * k4 + 3] * rstd * gnv.w * (gd / (1.f + __expf(-gd)));
        v2u wv; wv.x = pk2(y0, y1); wv.y = pk2(y2, y3); *(v2u*)(C.CONCAT + tl * D + h * 128 + d0) = wv; }
    __syncthreads();
}


#define INS16(L, xin) do { int x_ = (xin); _Pragma("unroll") for (int i_ = 0; i_ < 16; ++i_) { const int hi_ = max(L[i_], x_); x_ = min(L[i_], x_); L[i_] = hi_; } } while (0)
#define CE_DESC(a, b) do { const int hi_ = max(a, b), lo_ = min(a, b); a = hi_; b = lo_; } while (0)
#define BITONIC_MERGE16(L) do { _Pragma("unroll") for (int j_ = 8; j_ > 0; j_ >>= 1) _Pragma("unroll") for (int i_ = 0; i_ < 16; ++i_) if ((i_ & j_) == 0) CE_DESC(L[i_], L[i_ | j_]); } while (0)
#define SORT16(L) do { _Pragma("unroll") for (int k_ = 2; k_ <= 16; k_ <<= 1) _Pragma("unroll") for (int j_ = k_ >> 1; j_ > 0; j_ >>= 1) _Pragma("unroll") for (int i_ = 0; i_ < 16; ++i_) { const int l_ = i_ ^ j_; \
        if (l_ > i_) { if ((i_ & k_) == 0) CE_DESC(L[i_], L[l_]); else CE_DESC(L[l_], L[i_]); } } } while (0)
#define MERGE16(L, M) do { _Pragma("unroll") for (int i_ = 0; i_ < 16; ++i_) L[i_] = max(L[i_], M[15 - i_]); BITONIC_MERGE16(L); } while (0)
__device__ __forceinline__ int ord_key(float v) { int u = __float_as_int(v); return u ^ ((u >> 31) & 0x7fffffff); }
__device__ __forceinline__ float ord_val(int k, int mask) { int u = k & ~mask; return __int_as_float(u ^ ((u >> 31) & 0x7fffffff)); }
__device__ __forceinline__ void peer_topk_item(const Ctx& C, int tg, int hd, const LAS unsigned char* qlds, int lrow0) {
    const int lane = C.lane, r = lane & 31, hh = lane >> 5; const size_t tok = (size_t)tg * 32 + r;
    int La[16], Lb[16];
#pragma unroll
    for (int c = 0; c < 2; ++c) {
        int L[16];
#pragma unroll
        for (int i = 0; i < 16; ++i) L[i] = (int)0x80000000;
        bf16x8 qf[8];
        { const int row = lrow0 + r;
#pragma unroll
          for (int s = 0; s < 8; ++s) qf[s] = *(const LAS bf16x8*)(qlds + row * 512 + 16 * ((16 * c + 2 * s + hh) ^ (row & 15))); }
        int G[16];
        bf16x8 kfA[8], kfB[8];
#define PT_KLOAD(dst, kt) do { const bf16* kp_ = C.KEYSB + ((size_t)(hd * 2 + c) * 128 + 32 * (kt) + r) * 128 + 8 * hh; _Pragma("unroll") for (int s = 0; s < 8; ++s) dst[s] = *(const bf16x8*)(kp_ + 16 * s); } while (0)
#define PT_TILE(src, kt) do { f32x16 X; _Pragma("unroll") for (int i = 0; i < 16; ++i) X[i] = 0.f; _Pragma("unroll") for (int s = 0; s < 8; ++s) X = MFMA32(src[s], qf[s], X); \
            _Pragma("unroll") for (int i = 0; i < 16; ++i) G[i] = (ord_key(X[i]) & ~127) | (32 * (kt) + crow(i, hh)); SORT16(G); MERGE16(L, G); } while (0)
        PT_KLOAD(kfA, 0);
#pragma unroll 1
        for (int k2 = 0; k2 < 2; ++k2) {
            PT_KLOAD(kfB, 2 * k2 + 1);
            PT_TILE(kfA, 2 * k2);
            if (k2 == 0) PT_KLOAD(kfA, 2);
            PT_TILE(kfB, 2 * k2 + 1);
        }
#undef PT_KLOAD
#undef PT_TILE
        int M[16];
#pragma unroll
        for (int i = 0; i < 16; ++i) M[i] = __shfl_xor(L[i], 32);
        MERGE16(L, M);
#pragma unroll
        for (int i = 0; i < 16; ++i) { if (c == 0) La[i] = L[i]; else Lb[i] = L[i]; }
    }
    float sa[16], sb[16]; int Lc[16];
#pragma unroll
    for (int i = 0; i < 16; ++i) { sa[i] = ord_val(La[i], 127); sb[i] = ord_val(Lb[i], 127); Lc[i] = (int)0x80000000; }
#pragma unroll
    for (int i = 0; i < 16; ++i)
#pragma unroll
        for (int j = 0; j < 16; ++j) if ((i + 1) * (j + 1) <= 16) INS16(Lc, (ord_key(sa[i] + sb[j]) & ~255) | (i * 16 + j));
    float e[16], sum = 0.f; int ex[16]; const float mx = ord_val(Lc[0], 255);
#pragma unroll
    for (int i = 0; i < 16; ++i) {
        e[i] = __expf(ord_val(Lc[i], 255) - mx); sum += e[i];
        const int ii = (Lc[i] >> 4) & 15, jj = Lc[i] & 15; int i1 = 0, i2 = 0;
#pragma unroll
        for (int q = 0; q < 16; ++q) { i1 = (ii == q) ? (La[q] & 127) : i1; i2 = (jj == q) ? (Lb[q] & 127) : i2; }
        ex[i] = i1 * 128 + i2;
    }
    const float inv = 1.f / sum;
    if (hh == 0) {
        v4u* ep = (v4u*)(C.EXPI + tok * 128 + hd * 16); f32x4* gp = (f32x4*)(C.GATE + tok * 128 + hd * 16); f32x4* up = (f32x4*)(C.GU + tok * 128 + hd * 16); v4u* ap = (v4u*)(C.ACT + tok * 128 + hd * 16);
        const float hs = C.HS[tok];
#pragma unroll
        for (int q = 0; q < 4; ++q) { ep[q] = (v4u){(unsigned)ex[4 * q], (unsigned)ex[4 * q + 1], (unsigned)ex[4 * q + 2], (unsigned)ex[4 * q + 3]};
            gp[q] = (f32x4){e[4 * q] * inv * C.VS[ex[4 * q]], e[4 * q + 1] * inv * C.VS[ex[4 * q + 1]], e[4 * q + 2] * inv * C.VS[ex[4 * q + 2]], e[4 * q + 3] * inv * C.VS[ex[4 * q + 3]]};
            up[q] = (f32x4){hs * C.US[ex[4 * q]], hs * C.US[ex[4 * q + 1]], hs * C.US[ex[4 * q + 2]], hs * C.US[ex[4 * q + 3]]};
            ap[q] = (v4u){0u, 0u, 0u, 0u}; }
    }
}

__device__ __forceinline__ int peer_dequeue(const Ctx& C, unsigned* cnt, int xcc) {
    volatile LAS int* slot = (volatile LAS int*)(C.lds + MISC_OFF + 64);
    __syncthreads();
    if (C.tid == 0) { int res = -1;
        for (int s = 0; s < NSL; ++s) { const int sl = (xcc + s) & (NSL - 1);
            if (__hip_atomic_load(cnt + 64 * sl, __ATOMIC_RELAXED, __HIP_MEMORY_SCOPE_AGENT) >= (unsigned)NCHUNK) continue;
            const unsigned id = atomicAdd(cnt + 64 * sl, 1u); if (id < (unsigned)NCHUNK) { res = sl * NCHUNK + (int)id; break; } }
        *slot = res; }
    __syncthreads();
    return *slot;
}
#define ROWSUM16(d) do { d += __builtin_amdgcn_update_dpp(0, d, 0x121, 0xf, 0xf, false); d += __builtin_amdgcn_update_dpp(0, d, 0x122, 0xf, 0xf, false); \
                         d += __builtin_amdgcn_update_dpp(0, d, 0x124, 0xf, 0xf, false); d += __builtin_amdgcn_update_dpp(0, d, 0x128, 0xf, 0xf, false); } while (0)
#define PA_ISSUE1(buf, esrc, j_) buf[j_] = *(const v4u*)(tab + (size_t)__builtin_amdgcn_ds_swizzle(esrc, ((j_) << 5) | 0x10) * SLW)
#define PA_ISSUE(buf, esrc) do { PA_ISSUE1(buf, esrc, 0); PA_ISSUE1(buf, esrc, 1); PA_ISSUE1(buf, esrc, 2); PA_ISSUE1(buf, esrc, 3); PA_ISSUE1(buf, esrc, 4); PA_ISSUE1(buf, esrc, 5); PA_ISSUE1(buf, esrc, 6); PA_ISSUE1(buf, esrc, 7); \
        PA_ISSUE1(buf, esrc, 8); PA_ISSUE1(buf, esrc, 9); PA_ISSUE1(buf, esrc, 10); PA_ISSUE1(buf, esrc, 11); PA_ISSUE1(buf, esrc, 12); PA_ISSUE1(buf, esrc, 13); PA_ISSUE1(buf, esrc, 14); PA_ISSUE1(buf, esrc, 15); } while (0)
#define PA_COMPUTE(buf, hq_, dstv) do { _Pragma("unroll") for (int j_ = 0; j_ < 16; ++j_) { const v4u u_ = buf[j_]; \
        int d_ = __builtin_amdgcn_sdot4((int)hq_.x, (int)u_.x, 0, false); d_ = __builtin_amdgcn_sdot4((int)hq_.y, (int)u_.y, d_, false); d_ = __builtin_amdgcn_sdot4((int)hq_.z, (int)u_.z, d_, false); d_ = __builtin_amdgcn_sdot4((int)hq_.w, (int)u_.w, d_, false); \
        ROWSUM16(d_); dstv = (i == j_) ? d_ : dstv; } } while (0)
__device__ __forceinline__ void peer_a_chunk(const Ctx& C, int t0, int x, int* act) {
    const int lane = C.lane, i = lane & 15;
    v4u hq[8]; int el[8], eh[8];
#pragma unroll
    for (int tt = 0; tt < 8; ++tt) { hq[tt] = __builtin_nontemporal_load((const v4u*)(C.HQ + ((size_t)x * T + t0 + tt) * SLW + 16 * i)); el[tt] = __builtin_nontemporal_load(C.EXPI + (size_t)(t0 + tt) * 128 + lane); eh[tt] = __builtin_nontemporal_load(C.EXPI + (size_t)(t0 + tt) * 128 + 64 + lane); }
    const unsigned char* tab = C.UQ + (size_t)x * NEXP * SLW + 16 * i;
    v4u bA[16], bB[16];
    PA_ISSUE(bA, el[0]);
#pragma unroll
    for (int tt = 0; tt < 8; ++tt) {
        PA_ISSUE(bB, eh[tt]);
        int r_lo = 0, r_hi = 0;
        PA_COMPUTE(bA, hq[tt], r_lo);
        if (tt + 1 < 8) PA_ISSUE(bA, el[tt + 1]);
        PA_COMPUTE(bB, hq[tt], r_hi);
        atomicAdd(act + (size_t)(t0 + tt) * 128 + lane, r_lo); atomicAdd(act + (size_t)(t0 + tt) * 128 + 64 + lane, r_hi);
    }
}
#undef PA_ISSUE
#undef PA_ISSUE1
#undef PA_COMPUTE
__device__ __forceinline__ void peer_weights_token(const Ctx& C, size_t t) {
    const int lane = C.lane; const size_t o = t * 128 + lane;
    const float a_lo = (float)C.ACT[o] * C.GU[o], a_hi = (float)C.ACT[o + 64] * C.GU[o + 64];
    const float w_lo = C.GATE[o] * 0.5f * a_lo * (1.f + erff(a_lo * 0.70710678118654752f)), w_hi = C.GATE[o + 64] * 0.5f * a_hi * (1.f + erff(a_hi * 0.70710678118654752f));
    const float wm = wave_max(fmaxf(fabsf(w_lo), fabsf(w_hi))), winv = wm > 0.f ? 127.f / wm : 0.f;
    unsigned p_lo = (unsigned)((int)rintf(w_lo * winv) & 0xff), p_hi = (unsigned)((int)rintf(w_hi * winv) & 0xff);
    p_lo |= (unsigned)__builtin_amdgcn_update_dpp(0, (int)p_lo, 0xB1, 0xf, 0xf, false) << 8; p_lo |= (unsigned)__builtin_amdgcn_update_dpp(0, (int)p_lo, 0x4E, 0xf, 0xf, false) << 16;
    p_hi |= (unsigned)__builtin_amdgcn_update_dpp(0, (int)p_hi, 0xB1, 0xf, 0xf, false) << 8; p_hi |= (unsigned)__builtin_amdgcn_update_dpp(0, (int)p_hi, 0x4E, 0xf, 0xf, false) << 16;
    if ((lane & 3) == 0) { C.PW[t * 32 + (lane >> 2)] = p_lo; C.PW[t * 32 + 16 + (lane >> 2)] = p_hi; }
    if (lane == 0) C.WSC[t] = wm * (1.f / 127.f);
}
#define PB_ISSUE(buf, esrc) do { _Pragma("unroll") for (int j_ = 0; j_ < 16; ++j_) { const int e_ = __builtin_amdgcn_ds_bpermute(4 * (16 * (j_ >> 2) + 4 * g + (j_ & 3)), esrc); buf[j_] = *(const v4u*)(tab + (size_t)e_ * SLW); } } while (0)
#define PB_TR4(r0_, r1_, r2_, r3_, wp_, base) do { const unsigned t0_ = __builtin_amdgcn_perm(r1_, r0_, 0x05010400u), t1_ = __builtin_amdgcn_perm(r1_, r0_, 0x07030602u), t2_ = __builtin_amdgcn_perm(r3_, r2_, 0x05010400u), t3_ = __builtin_amdgcn_perm(r3_, r2_, 0x07030602u); \
        c[(base)] = __builtin_amdgcn_sdot4((int)__builtin_amdgcn_perm(t2_, t0_, 0x05040100u), wp_, c[(base)], false); c[(base) + 1] = __builtin_amdgcn_sdot4((int)__builtin_amdgcn_perm(t2_, t0_, 0x07060302u), wp_, c[(base) + 1], false); \
        c[(base) + 2] = __builtin_amdgcn_sdot4((int)__builtin_amdgcn_perm(t3_, t1_, 0x05040100u), wp_, c[(base) + 2], false); c[(base) + 3] = __builtin_amdgcn_sdot4((int)__builtin_amdgcn_perm(t3_, t1_, 0x07060302u), wp_, c[(base) + 3], false); } while (0)
#define PB_COMPUTE(buf, psrc) do { _Pragma("unroll") for (int jb_ = 0; jb_ < 4; ++jb_) { const int wp_ = __builtin_amdgcn_ds_bpermute(4 * (16 * jb_ + 4 * g), (int)psrc); \
        PB_TR4(buf[4 * jb_].x, buf[4 * jb_ + 1].x, buf[4 * jb_ + 2].x, buf[4 * jb_ + 3].x, wp_, 0); PB_TR4(buf[4 * jb_].y, buf[4 * jb_ + 1].y, buf[4 * jb_ + 2].y, buf[4 * jb_ + 3].y, wp_, 4); \
        PB_TR4(buf[4 * jb_].z, buf[4 * jb_ + 1].z, buf[4 * jb_ + 2].z, buf[4 * jb_ + 3].z, wp_, 8); PB_TR4(buf[4 * jb_].w, buf[4 * jb_ + 1].w, buf[4 * jb_ + 2].w, buf[4 * jb_ + 3].w, wp_, 12); } } while (0)
__device__ __forceinline__ int isum_swap16(int v) { auto r = __builtin_amdgcn_permlane16_swap((unsigned)v, (unsigned)v, false, false); return (int)r[0] + (int)r[1]; }
__device__ __forceinline__ int isum_swap32(int v) { auto r = __builtin_amdgcn_permlane32_swap((unsigned)v, (unsigned)v, false, false); return (int)r[0] + (int)r[1]; }
__device__ __forceinline__ void peer_b_chunk(const Ctx& C, int t0, int x, float* dst) {
    const int lane = C.lane, i = lane & 15, g = lane >> 4, b = t0 / SEQ;
    int el[8], eh[8]; unsigned pl[8], ph[8]; float ws[8];
#pragma unroll
    for (int tt = 0; tt < 8; ++tt) { const size_t o = (size_t)(t0 + tt) * 128 + lane;
        el[tt] = __builtin_nontemporal_load(C.EXPI + o); eh[tt] = __builtin_nontemporal_load(C.EXPI + o + 64);
        const unsigned p_lo = C.PW[(size_t)(t0 + tt) * 32 + (lane >> 2)], p_hi = C.PW[(size_t)(t0 + tt) * 32 + 16 + (lane >> 2)]; ws[tt] = C.WSC[t0 + tt];
        pl[tt] = p_lo; ph[tt] = p_hi; }
    const unsigned char* tab = C.VQ + (size_t)x * NEXP * SLW + 16 * i;
    const int d0 = x * SLW + 16 * i + 4 * g; const f32x4 gm = *(const f32x4*)(C.MOD + b * NMOD + 5 * D + d0);
    v4u bA[16], bB[16];
    PB_ISSUE(bA, el[0]);
#pragma unroll
    for (int tt = 0; tt < 8; ++tt) {
        PB_ISSUE(bB, eh[tt]);
        const size_t off = (size_t)(t0 + tt) * D + d0; const f32x4 x1 = __builtin_nontemporal_load((const f32x4*)(C.out + off));
        int c[16];
#pragma unroll
        for (int q = 0; q < 16; ++q) c[q] = 0;
        PB_COMPUTE(bA, pl[tt]);
        if (tt + 1 < 8) PB_ISSUE(bA, el[tt + 1]);
        PB_COMPUTE(bB, ph[tt]);
#pragma unroll
        for (int q = 0; q < 16; ++q) c[q] = isum_swap32(isum_swap16(c[q]));
        f32x4 o;
#pragma unroll
        for (int q = 0; q < 4; ++q) o[q] = (float)(g == 0 ? c[q] : g == 1 ? c[4 + q] : g == 2 ? c[8 + q] : c[12 + q]) * ws[tt];
        __builtin_nontemporal_store(x1 + gm * o, (f32x4*)(dst + off));
    }
}
#undef PB_ISSUE
#undef PB_COMPUTE
#undef PB_TR4
template <int STAGE> __device__ __forceinline__ void peer_expert_phase(const Ctx& C, float* dst, int rep) {
    const int xcc = (int)(xb_xcc_id() & (NSL - 1)); unsigned* cnt = C.ctl + (STAGE == 0 ? CW_QA : CW_QB) + 64 * NSL * rep;
    for (;;) {
        const int id = peer_dequeue(C, cnt, xcc); if (id < 0) break;
        const int x = id / NCHUNK, t0 = (id % NCHUNK) * PCH + C.wave * (PCH / NWAVES);
        for (int sub = 0; sub < PCH / NWAVES; sub += 8) { if (STAGE == 0) peer_a_chunk(C, t0 + sub, x, rep ? (int*)C.QP : C.ACT); else peer_b_chunk(C, t0 + sub, x, dst); }
    }
}

__device__ __forceinline__ void first_unit(int nM, int nN, int G, int c, int& pm, int& pn) {
    const int nwg = nM * nN; if (c >= nwg) { pm = -1; pn = 0; return; }
    int wgid = c; { const int q = nwg / 8, r = nwg % 8, xcd = wgid % 8, off = wgid / 8; wgid = (xcd < r ? xcd * (q + 1) : r * (q + 1) + (xcd - r) * q) + off; }
    const int nig = 8 * nN, gid = wgid / nig, fm = gid * 8, gsz = (nM - fm) < 8 ? (nM - fm) : 8;
    pm = fm + ((wgid % nig) % gsz); pn = (wgid % nig) / gsz; (void)G;
}
struct Args { const void* in[18]; float* out; unsigned char* ws; int ph_lo, ph_hi; };
__global__ void __launch_bounds__(NTHREADS, 2) fwd_kernel(Args args) {
    extern __shared__ __attribute__((aligned(16))) unsigned char lds[];
    Ctx C;
    C.lds = (LAS unsigned char*)lds; C.tid = threadIdx.x; C.lane = C.tid & 63; C.wave = __builtin_amdgcn_readfirstlane(C.tid >> 6);
    C.G = gridDim.x; { const int bx = blockIdx.x; C.vcu = (C.G % 8 == 0) ? (bx % 8) * (C.G / 8) + bx / 8 : bx; }
    C.gw = C.vcu * NWAVES + C.wave; C.ngw = C.G * NWAVES;
    C.x = (const float*)args.in[0]; C.c = (const float*)args.in[1]; C.pos = (const int*)args.in[2]; C.w_ada = (const float*)args.in[3]; C.b_ada = (const float*)args.in[4]; C.g1 = (const float*)args.in[5];
    C.w_in = (const float*)args.in[6]; C.w_a2 = (const float*)args.in[7]; C.b_a = (const float*)args.in[8]; C.gla_g = (const float*)args.in[9]; C.qg = (const float*)args.in[10]; C.kg = (const float*)args.in[11];
    C.w_out = (const float*)args.in[12]; C.g2 = (const float*)args.in[13]; C.w_q = (const float*)args.in[14]; C.keys = (const float*)args.in[15]; C.pu = (const float*)args.in[16]; C.pv = (const float*)args.in[17];
    C.out = args.out; unsigned char* ws = args.ws;
#define CTX_WS_PTRS() do { C.ctl = (unsigned*)(ws + WS_CTL); C.MODI = (long long*)(C.ctl + CW_MOD); C.MOD = (float*)(ws + WS_MODF); C.WIN = (bf16*)(ws + WS_WIN); C.WGA = (bf16*)(ws + WS_WGA); C.WOUT = (bf16*)(ws + WS_WOUT); C.WQ = (bf16*)(ws + WS_WQ); C.KEYSB = (bf16*)(ws + WS_KEYS); C.UQ = ws + WS_UB; C.VQ = ws + WS_VB; C.HQ = ws + WS_HQ; C.US = (float*)(ws + WS_US); C.VS = (float*)(ws + WS_VS); C.HS = (float*)(ws + WS_HS); C.GU = (float*)(ws + WS_GU); C.PW = (unsigned*)(ws + WS_PW); C.WSC = (float*)(ws + WS_WSC); C.ACT = (int*)(ws + WS_ACT); C.QDEC = (bf16*)(ws + WS_QDEC); C.KDEC = (bf16*)(ws + WS_KDEC); C.KUPD = (bf16*)(ws + WS_KUPD); C.PART = (bf16*)(ws + WS_PART); C.ML = (float*)(ws + WS_ML); C.LIST = (unsigned short*)(ws + WS_LIST); C.SEL = (unsigned short*)(ws + WS_SEL); C.H = (bf16*)(ws + WS_H); C.CONCAT = (bf16*)(ws + WS_CONCAT); C.PROJ = (bf16*)(ws + WS_PROJ); C.ST = (bf16*)(ws + WS_ST); C.CS = (float*)(ws + WS_CS); C.KMEAN = (float*)(ws + WS_KMEAN); C.DEC = (float*)(ws + WS_DEC); C.BCUM = (float*)(ws + WS_BCUM); C.UT = (float*)(ws + WS_UT); C.QP = (float*)(ws + WS_QP); C.GATE = (float*)(ws + WS_GATE); C.EXPI = (int*)(ws + WS_EXP); } while (0)
    CTX_WS_PTRS();
    for (int u = C.tid; u < (LDS_BYTES - RING_BYTES) / 4; u += NTHREADS) ((LAS unsigned*)(C.lds + RING_BYTES))[u] = 0u;
    __syncthreads();
    const int lo = args.ph_lo, hi = args.ph_hi;
    if (PROBE_TS >= 0 && blockIdx.x == 0 && threadIdx.x == 0) ((volatile LAS unsigned long long*)(C.lds + RING_BYTES + 8192))[0] = __builtin_amdgcn_s_memrealtime();
    XcdBarrier bar; bar.bar = C.ctl + CW_BAR; bar.x = 0; bar.st = nullptr;
    if (hi - lo > 1) bar = xcd_barrier_post(C.ctl + CW_BAR, (volatile LAS unsigned*)(C.lds + MISC_OFF) + 8);
#ifndef SKIPMASK
#define SKIPMASK 0
#endif
#ifndef REPEATMASK
#define REPEATMASK 0
#endif
#define IN(k) (!((SKIPMASK >> (k)) & 1) && lo <= (k) && (k) < hi)
#define REP(k, ...) do { if ((REPEATMASK >> (k)) & 1) { const int rep_ = 1; (void)rep_; __VA_ARGS__; xcd_barrier(bar); } { const int rep_ = 0; (void)rep_; __VA_ARGS__; } } while (0)
#define SEAM(k) do { if (IN(k) && IN((k) + 1)) xcd_barrier(bar); if (PROBE_TS >= 0 && blockIdx.x == 0 && threadIdx.x == 0) ((volatile LAS unsigned long long*)(C.lds + RING_BYTES + 8192))[(k) + 1] = __builtin_amdgcn_s_memrealtime(); { int t_ = C.tid; asm volatile("" : "+v"(t_)); C.tid = t_; C.lane = t_ & 63; } CTX_WS_PTRS(); } while (0)
    if (IN(0)) REP(0, p0_phase(C, rep_)); SEAM(0);
    if (IN(1)) REP(1, norm_mod_phase<true>(C, C.x, C.g1, 0, D, C.H)); SEAM(1);
    if (IN(2)) REP(2, pg8::Gemm g{C.H, C.WIN, T, NPROJ, D}; pg8::StaticOrder S; S.init(T, NPROJ, C.G, (int)blockIdx.x); pg8::EpiBf16<0> E{C.PROJ, NPROJ, nullptr, 0, 0, 1.f};
                 pg8::gemm_phase<pg8::EpiBf16<0>, pg8::StaticOrder, PG8_ALIGN, PG8_SP2>(C.lds, g, S, E)); SEAM(2);
    if (IN(3)) REP(3, for (int it = C.vcu; it < 256 + 256; it += C.G) { if (it < 256) moba_prep_item(C, it >> 7, (it >> 4) & 7, it & 15, rep_); else gla_prep_item(C, (it - 256) >> 7, ((it - 256) >> 1) & 63, it & 1); }); SEAM(3);
    if (IN(4)) REP(4, for (int it = C.vcu; it < 256 + 256; it += C.G) { if (it < 256) moba_select_item(C, it >> 7, (it >> 4) & 7, it & 15, rep_); else { const int g_ = it - 256; gla_u_item(C, g_ >> 7, (g_ >> 4) & 7, g_ & 15); } }); SEAM(4);
    if (IN(5)) REP(5, p5_attn_phase(C, rep_)); SEAM(5);
    if (IN(6)) REP(6, for (int it = C.vcu; it < 1024; it += C.G) gla_out_item(C, it >> 9, (it >> 6) & 7, it & 63); for (int t = C.gw; t < T; t += C.ngw) moba_merge_token(C, (size_t)t)); SEAM(6);
    if (IN(7)) REP(7, pg8::Gemm g{C.CONCAT, C.WOUT, T, D, D}; pg8::StaticOrder S; S.init(T, D, C.G, (int)blockIdx.x); pg8::EpiResGate E{C.x, C.out, D, C.MOD + 2 * D, NMOD, SEQ / 256};
                 pg8::gemm_phase<pg8::EpiResGate, pg8::StaticOrder, PG8_ALIGN, PG8_SP2>(C.lds, g, S, E)); SEAM(7);
    if (IN(8)) REP(8, norm_mod_phase<false>(C, C.out, C.g2, 3 * D, 4 * D, C.H)); SEAM(8);
    if (IN(9)) REP(9, int upm_ = -1; int upn_ = 0; first_unit(T / 256, D / 256, C.G, (int)blockIdx.x, upm_, upn_);
                 { pg8::Gemm g{C.H, C.WQ, T, D, D}; pg8::StaticOrder S; S.init(T, D, C.G, (int)blockIdx.x); pg8::EpiLdsTile E{}; pg8::gemm_phase<pg8::EpiLdsTile, pg8::StaticOrder, false, PG8_SP2>(C.lds, g, S, E); }
                 __syncthreads(); if (upm_ >= 0) peer_topk_item(C, upm_ * 8 + C.wave, upn_, C.lds, 32 * C.wave); __syncthreads()); SEAM(9);
    if (IN(10)) REP(10, peer_expert_phase<0>(C, nullptr, rep_)); SEAM(10);
    if (IN(11)) REP(11, for (int t = C.gw; t < T; t += C.ngw) peer_weights_token(C, (size_t)t)); SEAM(11);
    if (IN(12)) REP(12, peer_expert_phase<1>(C, rep_ ? C.QP : C.out, rep_));
    if (PROBE_TS >= 0) { xcd_barrier(bar); if (blockIdx.x == 0 && threadIdx.x == 0) { volatile LAS unsigned long long* ts = (volatile LAS unsigned long long*)(C.lds + RING_BYTES + 8192); const unsigned long long tend = __builtin_amdgcn_s_memrealtime();
        const unsigned long long d = (PROBE_TS == 12 ? tend : ts[PROBE_TS + 1]) - ts[PROBE_TS]; C.out[0] += (float)d * 0.001f; } }
#undef IN
#undef SEAM
}

extern "C" void kernel_launch(void* const* d_in, const int* in_sizes, int n_in, void* d_out, int out_size, void* d_ws, size_t ws_size, hipStream_t stream) {
    static int grid = 0;
    if (grid == 0) {
        if (n_in != 18 || in_sizes[0] != T * D || out_size != T * D || ws_size < WS_END) { fprintf(stderr, "kernel_launch: shape/workspace mismatch (n_in %d, in0 %d, out %d, ws %zu, need %zu); nothing launched\n", n_in, n_in > 0 ? in_sizes[0] : -1, out_size, ws_size, (size_t)WS_END); grid = -1; return; }
        int dev = 0, cus = 0, per_cu = 0;
        if (hipGetDevice(&dev) != hipSuccess || hipDeviceGetAttribute(&cus, hipDeviceAttributeMultiprocessorCount, dev) != hipSuccess) { fprintf(stderr, "kernel_launch: device query failed\n"); grid = -1; return; }
        if (hipFuncSetAttribute((const void*)fwd_kernel, hipFuncAttributeMaxDynamicSharedMemorySize, LDS_BYTES) != hipSuccess) { fprintf(stderr, "kernel_launch: hipFuncSetAttribute failed\n"); grid = -1; return; }
        if (hipOccupancyMaxActiveBlocksPerMultiprocessor(&per_cu, (const void*)fwd_kernel, NTHREADS, LDS_BYTES) != hipSuccess || per_cu < 1) { fprintf(stderr, "kernel_launch: occupancy query reports %d workgroups per CU\n", per_cu); (void)hipGetLastError(); grid = -1; return; }
        grid = cus;
    }
    if (grid < 0) return;
    if (hipMemsetAsync((char*)d_ws + WS_CTL, 0, CTL_ZERO_BYTES, stream) != hipSuccess) { fprintf(stderr, "kernel_launch: memset failed\n"); return; }
    Args a{};
    for (int i = 0; i < 18; ++i) a.in[i] = d_in[i];
    a.out = (float*)d_out; a.ws = (unsigned char*)d_ws;
#if MK_N_LAUNCHES == 1
    a.ph_lo = 0; a.ph_hi = N_PHASES;
    void* kargs[] = {&a};
#if defined(MK_PLAIN_LAUNCH)
    (void)kargs; hipLaunchKernelGGL(fwd_kernel, dim3(grid), dim3(NTHREADS), LDS_BYTES, stream, a);
#else
    hipError_t le = hipLaunchCooperativeKernel((const void*)fwd_kernel, dim3(grid), dim3(NTHREADS), kargs, LDS_BYTES, stream);
    if (le != hipSuccess) fprintf(stderr, "kernel_launch: cooperative launch failed: %s (grid %d)\n", hipGetErrorName(le), grid);
#endif
#else
    for (int p = 0; p < N_PHASES; ++p) { a.ph_lo = p; a.ph_hi = p + 1; hipLaunchKernelGGL(fwd_kernel, dim3(grid), dim3(NTHREADS), LDS_BYTES, stream, a); }
#endif
}
```

```cpp
#include <hip/hip_runtime.h>
#include <hip/hip_bf16.h>
#include <cstdio>
#include <cstdint>
#include <cmath>
namespace pg8 {
#define PG8_LAS __attribute__((address_space(3)))
typedef unsigned short bf16_t;
typedef short bf16x8 __attribute__((ext_vector_type(8)));
typedef float f32x4 __attribute__((ext_vector_type(4)));
typedef unsigned u32x4 __attribute__((ext_vector_type(4)));
constexpr int BM = 256, BK = 64, HALF = 128, HTB = HALF * BK * 2  , STAGE_BYTES = 8 * HTB, NXCD = 8, WGM = 8;

__host__ __device__ __forceinline__ int lds_byte(int r, int c) { const int st = (r >> 4) * 2 + (c >> 5), rr = r & 15, cc = c & 31, ob = rr * 64 + cc * 2; return st * 1024 + (ob ^ (((ob >> 9) & 1) << 5)); }
__host__ __device__ __forceinline__ void stage_rc(int b, int& R, int& C) { const int st = b / 1024, sb = b % 1024, swz = sb ^ (((sb >> 9) & 1) << 5); R = (st >> 1) * 16 + swz / 64; C = (st & 1) * 32 + (swz % 64) / 2; }
__host__ __device__ __forceinline__ int perm32(int rho) { const int n = rho >> 4, i = rho & 15; return 8 * (i >> 2) + 4 * n + (i & 3); }

struct Unit { int pm, pn; };
struct Gemm { const bf16_t* A; const bf16_t* Bt; int M, N, K; int a_pitch; size_t a_pair; };

struct StaticOrder {
    int nM, nN, nwg, G, c;
    __host__ __device__ void init(int M, int N, int G_, int c_) { nM = M / BM; nN = N / BM; nwg = nM * nN; G = G_; c = c_; }
    __host__ __device__ bool next(int i, Unit& u) const {
        const long L = (long)i * G + c; if (L >= nwg) return false;
        int wgid = (int)L; { const int q = nwg / NXCD, r = nwg % NXCD, xcd = wgid % NXCD, off = wgid / NXCD; wgid = (xcd < r ? xcd * (q + 1) : r * (q + 1) + (xcd - r) * q) + off; }
        const int nig = WGM * nN, gid = wgid / nig, fm = gid * WGM, gsz = (nM - fm) < WGM ? (nM - fm) : WGM;
        u.pm = fm + ((wgid % nig) % gsz); u.pn = (wgid % nig) / gsz; return true;
    }
    __device__ __forceinline__ void a_ready(const Unit&) const {}
    __device__ __forceinline__ void done(const Unit&) const {}
};

__device__ __forceinline__ unsigned cvt_pk_bf16(float lo, float hi) { unsigned r; asm volatile("v_cvt_pk_bf16_f32 %0, %1, %2" : "=v"(r) : "v"(lo), "v"(hi)); return r; }
typedef float f32x2 __attribute__((ext_vector_type(2)));
__device__ __forceinline__ f32x2 gelu_pk(f32x2 v) {
    const f32x2 av = __builtin_elementwise_abs(v), d = av * 0.2316418882f + 1.0f;
    f32x2 t; t.x = __builtin_amdgcn_rcpf(d.x); t.y = __builtin_amdgcn_rcpf(d.y);
    f32x2 q = t * 0.5307027145f + (-0.7265760135f); q = q * t + 0.7107068705f; q = q * t + (-0.142248368f); q = q * t + 0.127414796f; q = q * t;
    const f32x2 s = (v * v) * (-0.72134752044f);
    f32x2 e; e.x = __builtin_amdgcn_exp2f(s.x); e.y = __builtin_amdgcn_exp2f(s.y);
    const f32x2 m = v * (q * e), r = v - m;
    f32x2 o; o.x = v.x < 0.f ? m.x : r.x; o.y = v.y < 0.f ? m.y : r.y; return o;
}

template <int ACT  > struct EpiBf16 {
    static constexpr bool PERM = true, AFTER_DRAIN = false, I8 = false; static_assert(ACT == 0 || ACT == 1, "EpiBf16: ACT is 0 (none) or 1 (gelu_pk)");
    bf16_t* O; int ldc; const float* bias; int split_cols; size_t split_stride; float scale0;
    __device__ __forceinline__ void operator()(const f32x4 (&acc)[2][2][4][2], const Unit& u, int wr, int wc, int fr, int fq) const {
        const int row0 = u.pm * BM + wr * 64 + fr; int colt = u.pn * BM; bf16_t* base = O;
        float sc = 1.f; if (split_cols) { const int t = colt / split_cols; base += (size_t)t * split_stride; colt -= t * split_cols; if (t == 0) sc = scale0; }
        const int col0 = colt + wc * 32 + 8 * fq, bcol0 = u.pn * BM + wc * 32 + 8 * fq;
        f32x4 bv[2][2];
#pragma unroll
        for (int bj = 0; bj < 2; ++bj)
#pragma unroll
            for (int n = 0; n < 2; ++n) bv[bj][n] = bias ? *(const f32x4*)(bias + bcol0 + bj * HALF + 4 * n) : (f32x4){0.f, 0.f, 0.f, 0.f};
#pragma unroll
        for (int ai = 0; ai < 2; ++ai)
#pragma unroll
            for (int m = 0; m < 4; ++m) { bf16_t* rowp = base + (size_t)(row0 + ai * HALF + m * 16) * ldc + col0;
#pragma unroll
                for (int bj = 0; bj < 2; ++bj) { f32x4 v0 = acc[ai][bj][m][0] + bv[bj][0], v1 = acc[ai][bj][m][1] + bv[bj][1];
                    if (ACT == 1) { f32x2 a = gelu_pk((f32x2){v0[0], v0[1]}), b = gelu_pk((f32x2){v0[2], v0[3]}), c = gelu_pk((f32x2){v1[0], v1[1]}), d = gelu_pk((f32x2){v1[2], v1[3]});
                        v0 = (f32x4){a.x, a.y, b.x, b.y}; v1 = (f32x4){c.x, c.y, d.x, d.y}; }
                    v0 = v0 * sc; v1 = v1 * sc; u32x4 w; w.x = cvt_pk_bf16(v0[0], v0[1]); w.y = cvt_pk_bf16(v0[2], v0[3]); w.z = cvt_pk_bf16(v1[0], v1[1]); w.w = cvt_pk_bf16(v1[2], v1[3]);
                    *(u32x4*)(rowp + bj * HALF) = w; } }
    }
};

typedef int i32x4 __attribute__((ext_vector_type(4)));
struct EpiBf16Q {
    static constexpr bool PERM = true, AFTER_DRAIN = false, I8 = true;
    bf16_t* O; int ldc; const float* rs; const float* cs;
    __device__ __forceinline__ void operator()(const f32x4 (&acc)[2][2][4][2], const Unit& u, int wr, int wc, int fr, int fq) const {
        const int row0 = u.pm * BM + wr * 64 + fr, col0 = u.pn * BM + wc * 32 + 8 * fq;
        f32x4 cv[2][2];
#pragma unroll
        for (int bj = 0; bj < 2; ++bj)
#pragma unroll
            for (int n = 0; n < 2; ++n) cv[bj][n] = *(const f32x4*)(cs + col0 + bj * HALF + 4 * n);
        float rv[8];
#pragma unroll
        for (int i = 0; i < 8; ++i) rv[i] = rs[row0 + (i >> 2) * HALF + (i & 3) * 16];
#pragma unroll
        for (int ai = 0; ai < 2; ++ai)
#pragma unroll
            for (int m = 0; m < 4; ++m) { bf16_t* rowp = O + (size_t)(row0 + ai * HALF + m * 16) * ldc + col0; const float s = rv[ai * 4 + m];
#pragma unroll
                for (int bj = 0; bj < 2; ++bj) { const f32x4 v0 = __builtin_convertvector(__builtin_bit_cast(i32x4, acc[ai][bj][m][0]), f32x4) * s * cv[bj][0], v1 = __builtin_convertvector(__builtin_bit_cast(i32x4, acc[ai][bj][m][1]), f32x4) * s * cv[bj][1];
                    u32x4 w; w.x = cvt_pk_bf16(v0[0], v0[1]); w.y = cvt_pk_bf16(v0[2], v0[3]); w.z = cvt_pk_bf16(v1[0], v1[1]); w.w = cvt_pk_bf16(v1[2], v1[3]);
                    *(u32x4*)(rowp + bj * HALF) = w; } }
    }
};
struct EpiF32 {
    static constexpr bool PERM = false, AFTER_DRAIN = false, I8 = false;
    float* C; int ldc; const float* bias;
    __device__ __forceinline__ void operator()(const f32x4 (&acc)[2][2][4][2], const Unit& u, int wr, int wc, int fr, int fq) const {
        const int row0 = u.pm * BM + wr * 64 + fr, col0 = u.pn * BM + wc * 32 + 4 * fq;
        f32x4 bv[2][2];
#pragma unroll
        for (int bj = 0; bj < 2; ++bj)
#pragma unroll
            for (int n = 0; n < 2; ++n) bv[bj][n] = bias ? *(const f32x4*)(bias + col0 + bj * HALF + n * 16) : (f32x4){0.f, 0.f, 0.f, 0.f};
#pragma unroll
        for (int ai = 0; ai < 2; ++ai)
#pragma unroll
            for (int m = 0; m < 4; ++m) { float* rowp = C + (size_t)(row0 + ai * HALF + m * 16) * ldc + col0;
#pragma unroll
                for (int bj = 0; bj < 2; ++bj)
#pragma unroll
                    for (int n = 0; n < 2; ++n) *(f32x4*)(rowp + bj * HALF + n * 16) = acc[ai][bj][m][n] + bv[bj][n]; }
    }
};
struct EpiResGate {
    static constexpr bool PERM = false, AFTER_DRAIN = false, I8 = false;
    const float* X; float* O; int ldc; const float* gate; int gate_stride, tiles_per_batch;
    __device__ __forceinline__ void operator()(const f32x4 (&acc)[2][2][4][2], const Unit& u, int wr, int wc, int fr, int fq) const {
        const int row0 = u.pm * BM + wr * 64 + fr, col0 = u.pn * BM + wc * 32 + 4 * fq;
        const float* gp = gate + (size_t)(u.pm / tiles_per_batch) * gate_stride;
        f32x4 gv[2][2];
#pragma unroll
        for (int bj = 0; bj < 2; ++bj)
#pragma unroll
            for (int n = 0; n < 2; ++n) gv[bj][n] = *(const f32x4*)(gp + col0 + bj * HALF + n * 16);
        f32x4 xv[2][2][2];
#define ERG_LOAD(idx, slot) do { const size_t off_ = (size_t)(row0 + ((idx) >> 2) * HALF + ((idx) & 3) * 16) * ldc + col0; _Pragma("unroll") for (int bj = 0; bj < 2; ++bj) _Pragma("unroll") for (int n = 0; n < 2; ++n) xv[slot][bj][n] = *(const f32x4*)(X + off_ + bj * HALF + n * 16); } while (0)
        ERG_LOAD(0, 0); ERG_LOAD(1, 1);
#pragma unroll
        for (int idx = 0; idx < 8; ++idx) { const int ai = idx >> 2, m = idx & 3; const size_t off = (size_t)(row0 + ai * HALF + m * 16) * ldc + col0;
#pragma unroll
            for (int bj = 0; bj < 2; ++bj)
#pragma unroll
                for (int n = 0; n < 2; ++n) *(f32x4*)(O + off + bj * HALF + n * 16) = xv[idx & 1][bj][n] + gv[bj][n] * acc[ai][bj][m][n];
            if (idx + 2 < 8) ERG_LOAD(idx + 2, idx & 1); }
#undef ERG_LOAD
    }
};

struct EpiLdsTile {
    static constexpr bool PERM = true, AFTER_DRAIN = true, I8 = false;
    __device__ __forceinline__ void operator()(const f32x4 (&)[2][2][4][2], const Unit&, int, int, int, int) const {}
    __device__ __forceinline__ void fused(f32x4 (&acc)[2][2][4][2], const Unit&, int wr, int wc, int fr, int fq, PG8_LAS unsigned char* lds, int, int) const {
#pragma unroll
        for (int ai = 0; ai < 2; ++ai)
#pragma unroll
            for (int m = 0; m < 4; ++m) { const int row = ai * HALF + wr * 64 + m * 16 + fr;
#pragma unroll
                for (int bj = 0; bj < 2; ++bj) { const f32x4 v0 = acc[ai][bj][m][0], v1 = acc[ai][bj][m][1]; u32x4 w; w.x = cvt_pk_bf16(v0[0], v0[1]); w.y = cvt_pk_bf16(v0[2], v0[3]); w.z = cvt_pk_bf16(v1[0], v1[1]); w.w = cvt_pk_bf16(v1[2], v1[3]);
                    const int chunk = 16 * bj + 4 * wc + fq; *(PG8_LAS u32x4*)(lds + row * 512 + 16 * (chunk ^ (row & 15))) = w; } }
    }
};

struct EpiLdsTileQ {
    static constexpr bool PERM = true, AFTER_DRAIN = true, I8 = true;
    const float* rs; const float* cs;
    __device__ __forceinline__ void operator()(const f32x4 (&)[2][2][4][2], const Unit&, int, int, int, int) const {}
    __device__ __forceinline__ void fused(f32x4 (&acc)[2][2][4][2], const Unit& u, int wr, int wc, int fr, int fq, PG8_LAS unsigned char* lds, int, int) const {
        f32x4 cv[2][2];
#pragma unroll
        for (int bj = 0; bj < 2; ++bj)
#pragma unroll
            for (int n = 0; n < 2; ++n) cv[bj][n] = *(const f32x4*)(cs + u.pn * BM + bj * HALF + wc * 32 + 8 * fq + 4 * n);
#pragma unroll
        for (int ai = 0; ai < 2; ++ai)
#pragma unroll
            for (int m = 0; m < 4; ++m) { const int row = ai * HALF + wr * 64 + m * 16 + fr; const float s = rs[u.pm * BM + row];
#pragma unroll
                for (int bj = 0; bj < 2; ++bj) { const f32x4 v0 = __builtin_convertvector(__builtin_bit_cast(i32x4, acc[ai][bj][m][0]), f32x4) * s * cv[bj][0], v1 = __builtin_convertvector(__builtin_bit_cast(i32x4, acc[ai][bj][m][1]), f32x4) * s * cv[bj][1];
                    u32x4 w; w.x = cvt_pk_bf16(v0[0], v0[1]); w.y = cvt_pk_bf16(v0[2], v0[3]); w.z = cvt_pk_bf16(v1[0], v1[1]); w.w = cvt_pk_bf16(v1[2], v1[3]);
                    const int chunk = 16 * bj + 4 * wc + fq; *(PG8_LAS u32x4*)(lds + row * 512 + 16 * (chunk ^ (row & 15))) = w; } }
    }
};

template <class Epi, class Sched, bool ALIGN_EPI = false, bool SP2 = false>
__device__ __forceinline__ void gemm_phase(PG8_LAS unsigned char* lds, const Gemm g, const Sched& S, const Epi& E) {
    const int tid = threadIdx.x, wid = __builtin_amdgcn_readfirstlane(tid >> 6), lane = tid & 63, wr = wid >> 2, wc = wid & 3, fr = lane & 15, fq = lane >> 4;
    const int K = g.K, nt = K / BK;
    const int apitch = g.a_pitch ? g.a_pitch : K * 2; const size_t apair = g.a_pair ? g.a_pair : (size_t)(BK * 4);
    unsigned voffA[2], voffB[2];
#pragma unroll
    for (int i = 0; i < 2; ++i) { int R, C; stage_rc(tid * 16 + i * 8192, R, C); const int Rb = Epi::PERM ? ((R & ~31) + perm32(R & 31)) : R;
        voffA[i] = (unsigned)R * (unsigned)apitch + (unsigned)C * 2u; voffB[i] = (unsigned)(Rb * K + C) * 2u; }
    const size_t kstep = (size_t)(BK * 2);
    const size_t hstepB = (size_t)HALF * K * 2, hstepA = (size_t)HALF * apitch;
    const size_t tstepB = 2 * hstepB, tstepA = 2 * hstepA;
    const unsigned ldsw = (unsigned)wid * 1024u;
    const int aoff = lds_byte(wr * 64 + fr, fq * 8), boff = lds_byte(wc * 32 + fr, fq * 8);
#define PG8_SA(b, h) (((b) * 2 + (h)) * HTB)
#define PG8_SB(b, h) ((4 + (b) * 2 + (h)) * HTB)
#define PG8_STAGE(bufoff, gbase, voff) do { _Pragma("unroll") for (int _i = 0; _i < 2; ++_i) \
        __builtin_amdgcn_global_load_lds((const unsigned*)((const char*)(gbase) + (voff)[_i]), (PG8_LAS unsigned*)(lds + (bufoff) + ldsw + _i * 8192), 16, 0, 0); } while (0)
#define PG8_LDA(dst, b, h) do { _Pragma("unroll") for (int m = 0; m < 4; ++m) _Pragma("unroll") for (int k = 0; k < 2; ++k) dst[m][k] = *(const PG8_LAS bf16x8*)(lds + PG8_SA(b, h) + aoff + m * 2048 + k * 1024); } while (0)
#define PG8_LDB(dst, b, h) do { _Pragma("unroll") for (int n = 0; n < 2; ++n) _Pragma("unroll") for (int k = 0; k < 2; ++k) dst[n][k] = *(const PG8_LAS bf16x8*)(lds + PG8_SB(b, h) + boff + n * 2048 + k * 1024); } while (0)
#define PG8_MMA(ai, bj, At, Bt) do { __builtin_amdgcn_s_setprio(1); _Pragma("unroll") for (int m = 0; m < 4; ++m) _Pragma("unroll") for (int n = 0; n < 2; ++n) _Pragma("unroll") for (int k = 0; k < 2; ++k) \
        { if constexpr (Epi::I8) acc[ai][bj][m][n] = __builtin_bit_cast(f32x4, __builtin_amdgcn_mfma_i32_16x16x64_i8(__builtin_bit_cast(i32x4, Bt[n][k]), __builtin_bit_cast(i32x4, At[m][k]), __builtin_bit_cast(i32x4, acc[ai][bj][m][n]), 0, 0, 0)); \
          else acc[ai][bj][m][n] = __builtin_amdgcn_mfma_f32_16x16x32_bf16(Bt[n][k], At[m][k], acc[ai][bj][m][n], 0, 0, 0); } __builtin_amdgcn_s_setprio(0); } while (0)
#define PG8_WAIT_V(n) asm volatile("s_waitcnt vmcnt(" #n ")" ::: "memory")
#define PG8_WAIT_L(n) asm volatile("s_waitcnt lgkmcnt(" #n ")" ::: "memory")
#define PG8_BAR __builtin_amdgcn_s_barrier()
#define PG8_SCHED __builtin_amdgcn_sched_barrier(0)
    Unit cur, nxt; int ui = 0;
    if (!S.next(0, cur)) return;
    f32x4 acc[2][2][4][2];
#pragma unroll
    for (int a = 0; a < 2; ++a)
#pragma unroll
        for (int b = 0; b < 2; ++b)
#pragma unroll
            for (int m = 0; m < 4; ++m)
#pragma unroll
                for (int n = 0; n < 2; ++n) acc[a][b][m][n] = (f32x4){0.f, 0.f, 0.f, 0.f};
    bf16x8 At[4][2], B0[2][2], B1[2][2];
    const char* cA = (const char*)g.A + (size_t)cur.pm * tstepA; const char* cB = (const char*)g.Bt + (size_t)cur.pn * tstepB;
    S.a_ready(cur);
    if constexpr (SP2) {
        PG8_STAGE(PG8_SB(0, 0), cB, voffB); PG8_STAGE(PG8_SB(0, 1), cB + hstepB, voffB); PG8_STAGE(PG8_SA(0, 0), cA, voffA); PG8_STAGE(PG8_SA(0, 1), cA + hstepA, voffA);
        if (wr == 1) PG8_BAR;
        PG8_WAIT_V(2); PG8_BAR;
        PG8_STAGE(PG8_SB(1, 0), cB + kstep, voffB); PG8_STAGE(PG8_SA(1, 0), cA + kstep, voffA); PG8_STAGE(PG8_SB(1, 1), cB + hstepB + kstep, voffB);
        PG8_WAIT_V(6); PG8_BAR;
    } else {
        PG8_STAGE(PG8_SB(0, 0), cB, voffB); PG8_STAGE(PG8_SA(0, 0), cA, voffA); PG8_STAGE(PG8_SB(0, 1), cB + hstepB, voffB); PG8_STAGE(PG8_SA(0, 1), cA + hstepA, voffA);
        if (wr == 1) PG8_BAR;
        PG8_WAIT_V(4); PG8_BAR;
        PG8_STAGE(PG8_SB(1, 0), cB + kstep, voffB); PG8_STAGE(PG8_SA(1, 0), cA + kstep, voffA); PG8_STAGE(PG8_SB(1, 1), cB + hstepB + kstep, voffB);
        PG8_WAIT_V(6); PG8_BAR;
    }
    for (;;) {
        const bool has_next = S.next(ui + 1, nxt);
        const char* nA = has_next ? (const char*)g.A + (size_t)nxt.pm * tstepA : cA; const char* nB = has_next ? (const char*)g.Bt + (size_t)nxt.pn * tstepB : cB;
        for (int t = 0; t < nt; t += 2) {
            const bool last = (t == nt - 2);
            const char* a1 = cA + (size_t)(t >> 1) * apair + kstep;
            const char* a2 = last ? nA : cA + (size_t)((t >> 1) + 1) * apair; const char* b2 = last ? nB : cB + (size_t)(t + 2) * kstep;
            const char* a3 = a2 + kstep; const char* b3 = b2 + kstep;
            if (last && has_next) S.a_ready(nxt);
            if constexpr (SP2) {
            PG8_LDB(B0, 0, 0); PG8_LDB(B1, 0, 1); PG8_SCHED; PG8_LDA(At, 0, 0); PG8_STAGE(PG8_SA(1, 1), a1 + hstepA, voffA);
            PG8_WAIT_V(8); PG8_WAIT_L(0); PG8_BAR; PG8_MMA(0, 0, At, B0); PG8_MMA(0, 1, At, B1); PG8_BAR; PG8_SCHED;
            PG8_LDA(At, 0, 1); PG8_STAGE(PG8_SB(0, 0), b2, voffB); PG8_STAGE(PG8_SB(0, 1), b2 + hstepB, voffB); PG8_STAGE(PG8_SA(0, 0), a2, voffA);
            PG8_WAIT_V(8); PG8_WAIT_L(0); PG8_BAR; PG8_MMA(1, 0, At, B0); PG8_MMA(1, 1, At, B1); PG8_BAR; PG8_SCHED;
            PG8_LDB(B0, 1, 0); PG8_LDB(B1, 1, 1); PG8_SCHED; PG8_LDA(At, 1, 0); PG8_STAGE(PG8_SA(0, 1), a2 + hstepA, voffA);
            PG8_WAIT_V(8); PG8_WAIT_L(0); PG8_BAR; PG8_MMA(0, 0, At, B0); PG8_MMA(0, 1, At, B1); PG8_BAR; PG8_SCHED;
            PG8_LDA(At, 1, 1); PG8_STAGE(PG8_SB(1, 0), b3, voffB); PG8_STAGE(PG8_SB(1, 1), b3 + hstepB, voffB); PG8_STAGE(PG8_SA(1, 0), a3, voffA);
            PG8_WAIT_V(8); PG8_WAIT_L(0); PG8_BAR; PG8_MMA(1, 0, At, B0); PG8_MMA(1, 1, At, B1); PG8_BAR; PG8_SCHED;
            } else {
            PG8_LDB(B0, 0, 0); PG8_SCHED; PG8_LDA(At, 0, 0); PG8_STAGE(PG8_SA(1, 1), a1 + hstepA, voffA);
            PG8_WAIT_L(8); PG8_BAR; PG8_WAIT_L(0); PG8_MMA(0, 0, At, B0); PG8_BAR; PG8_SCHED;
            PG8_LDB(B1, 0, 1); PG8_STAGE(PG8_SB(0, 0), b2, voffB);
            PG8_BAR; PG8_WAIT_L(0); PG8_MMA(0, 1, At, B1); PG8_BAR;
            PG8_LDA(At, 0, 1); PG8_STAGE(PG8_SA(0, 0), a2, voffA);
            PG8_BAR; PG8_WAIT_L(0); PG8_MMA(1, 0, At, B0); PG8_BAR; PG8_SCHED;
            PG8_STAGE(PG8_SB(0, 1), b2 + hstepB, voffB);
            PG8_WAIT_V(6); PG8_BAR; PG8_MMA(1, 1, At, B1); PG8_BAR;
            PG8_LDB(B0, 1, 0); PG8_SCHED; PG8_LDA(At, 1, 0); PG8_STAGE(PG8_SA(0, 1), a2 + hstepA, voffA);
            PG8_WAIT_L(8); PG8_BAR; PG8_WAIT_L(0); PG8_MMA(0, 0, At, B0); PG8_BAR; PG8_SCHED;
            PG8_LDB(B1, 1, 1); PG8_STAGE(PG8_SB(1, 0), b3, voffB);
            PG8_BAR; PG8_WAIT_L(0); PG8_MMA(0, 1, At, B1); PG8_BAR;
            PG8_LDA(At, 1, 1); PG8_STAGE(PG8_SA(1, 0), a3, voffA);
            PG8_BAR; PG8_WAIT_L(0); PG8_MMA(1, 0, At, B0); PG8_BAR; PG8_SCHED;
            PG8_STAGE(PG8_SB(1, 1), b3 + hstepB, voffB);
            PG8_WAIT_V(6); PG8_BAR; PG8_MMA(1, 1, At, B1); PG8_BAR;
            }
        }
        if constexpr (ALIGN_EPI) { if (wr == 0) PG8_BAR; }
        if constexpr (!Epi::AFTER_DRAIN) { E(acc, cur, wr, wc, fr, fq); S.done(cur); }
        if (!has_next) break;
#pragma unroll
        for (int a = 0; a < 2; ++a)
#pragma unroll
            for (int b = 0; b < 2; ++b)
#pragma unroll
                for (int m = 0; m < 4; ++m)
#pragma unroll
                    for (int n = 0; n < 2; ++n) acc[a][b][m][n] = (f32x4){0.f, 0.f, 0.f, 0.f};
        cur = nxt; cA = nA; cB = nB; ++ui;
        if constexpr (ALIGN_EPI) { if (wr == 1) PG8_BAR; }
    }
    PG8_WAIT_V(0);
    if constexpr (!ALIGN_EPI) { if (wr == 0) PG8_BAR; }
    PG8_BAR;
    if constexpr (Epi::AFTER_DRAIN) { E.fused(acc, cur, wr, wc, fr, fq, lds, wid, lane); S.done(cur); }
#undef PG8_SA
#undef PG8_SB
#undef PG8_STAGE
#undef PG8_LDA
#undef PG8_LDB
#undef PG8_MMA
#undef PG8_WAIT_V
#undef PG8_WAIT_L
#undef PG8_BAR
#undef PG8_SCHED
}
}

#ifndef PG8_SP2
#define PG8_SP2 true
#endif
#ifndef PG8_ALIGN
#define PG8_ALIGN true
#endif
constexpr int NWAVES = 8, NTHREADS = NWAVES * 64;
constexpr int BATCH = 2, SEQ = 4096, T = BATCH * SEQ, D = 2048;
constexpr int INW = 6160, NPROJ = 6144;
constexpr int GQ = 0, GK = 512, GV = 1024, GG = 2048, MQ = 3072, MK = 4096, MV = 5120;
constexpr int GA_SRC = 3072;
constexpr int NH = 8, NEXP = 16384, NMOD = 6 * D;
constexpr float EPS = 1e-6f;
#ifndef MK_N_LAUNCHES
#define MK_N_LAUNCHES 1
#endif
constexpr int N_PHASES = 13;
#ifndef P3_GLA_TWICE
#define P3_GLA_TWICE 0
#endif
#ifndef PROBE_TS
#define PROBE_TS -1
#endif
constexpr int NSL = 8, SLW = 256, PCH = 128, NCHUNK = (BATCH * SEQ) / PCH;

constexpr size_t MiB = 1u << 20;
constexpr size_t WS_CTL = 0, CTL_ZERO_BYTES = 128 * 1024;
constexpr size_t WS_WIN = 1 * MiB, WS_WGA = 25 * MiB, WS_WOUT = 26 * MiB, WS_WQ = 34 * MiB, WS_KEYS = 42 * MiB, WS_CS = 43 * MiB, WS_KMEAN = 44 * MiB, WS_DEC = 45 * MiB;
constexpr size_t WS_UB = 46 * MiB, WS_VB = 110 * MiB, WS_H = 174 * MiB, WS_CONCAT = 206 * MiB, WS_BCUM = 238 * MiB, WS_UT = 254 * MiB, WS_ST = 286 * MiB, WS_PROJ = 302 * MiB;
constexpr size_t WS_QP = WS_PROJ, WS_EXP = 366 * MiB, WS_GATE = 370 * MiB, WS_GU = 374 * MiB, WS_ACT = 378 * MiB, WS_HQ = WS_H, WS_QDEC = 398 * MiB, WS_KDEC = 406 * MiB, WS_KUPD = 414 * MiB, WS_PART = 422 * MiB, WS_ML = 486 * MiB, WS_LIST = 488 * MiB, WS_SEL = 492 * MiB, WS_PW = 493 * MiB, WS_WSC = 494 * MiB, WS_END = 495 * MiB;
constexpr size_t WS_WINS = WS_WIN + 13 * MiB, WS_WQS = WS_WQ + 5 * MiB;
constexpr size_t WS_US = WS_UB + 40 * MiB, WS_VS = WS_VB + 40 * MiB, WS_HS = WS_VB + 41 * MiB;
constexpr int CW_BAR = 4096, CW_Q = 8192, CW_QA = 12288, CW_QB = 13312, CW_LCNT = 14336, CW_MOD = 16384;
static_assert((CW_MOD + 2048) * 4 <= (int)CTL_ZERO_BYTES, "CTL words inside the memset region");
constexpr size_t WS_MODF = 45 * MiB + 512 * 1024;

constexpr int RING_BYTES = 131072, MISC_OFF = RING_BYTES + 320, LDS_BYTES = 147456;

#define GAS __attribute__((address_space(1)))
#define LAS __attribute__((address_space(3)))
typedef unsigned short bf16;
typedef unsigned v4u __attribute__((ext_vector_type(4)));
typedef unsigned v2u __attribute__((ext_vector_type(2)));
typedef float f32x4 __attribute__((ext_vector_type(4)));
typedef float f32x2 __attribute__((ext_vector_type(2)));
typedef float f32x16 __attribute__((ext_vector_type(16)));
typedef short bf16x8 __attribute__((ext_vector_type(8)));
typedef short s16x4 __attribute__((ext_vector_type(4)));
typedef __bf16 bf16x2_t __attribute__((ext_vector_type(2)));
typedef GAS unsigned gu32;
#define LDS_WAIT() asm volatile("s_waitcnt lgkmcnt(0)" ::: "memory")
#define VM_WAIT() asm volatile("s_waitcnt vmcnt(0)" ::: "memory")
__device__ __forceinline__ unsigned pk2(float lo, float hi) { f32x2 v = {lo, hi}; bf16x2_t b = __builtin_convertvector(v, bf16x2_t); return __builtin_bit_cast(unsigned, b); }
__device__ __forceinline__ float bflo(unsigned u) { return __uint_as_float(u << 16); }
__device__ __forceinline__ float bfhi(unsigned u) { return __uint_as_float(u & 0xffff0000u); }
__device__ __forceinline__ float bf1(short s) { return __uint_as_float(((unsigned)(unsigned short)s) << 16); }
__device__ __forceinline__ bf16x8 pack8(float a0, float a1, float a2, float a3, float a4, float a5, float a6, float a7) { v4u w; w.x = pk2(a0, a1); w.y = pk2(a2, a3); w.z = pk2(a4, a5); w.w = pk2(a6, a7); return __builtin_bit_cast(bf16x8, w); }
__device__ __forceinline__ int crow(int r, int hi) { return (r & 3) + 8 * (r >> 2) + 4 * hi; }
__device__ __forceinline__ float wave_sum(float v) {
#pragma unroll
    for (int o = 1; o < 64; o <<= 1) v += __shfl_xor(v, o);
    return v;
}
typedef short v4i16_t __attribute__((ext_vector_type(4)));
__device__ __forceinline__ s16x4 vtr(const LAS unsigned char* p) { return __builtin_bit_cast(s16x4, __builtin_amdgcn_ds_read_tr16_b64_v4i16((LAS v4i16_t*)p)); }
__device__ __forceinline__ bf16x8 cat4(s16x4 lo, s16x4 hi) { return (bf16x8){lo[0], lo[1], lo[2], lo[3], hi[0], hi[1], hi[2], hi[3]}; }
#define MFMA32(a, b, c) __builtin_amdgcn_mfma_f32_32x32x16_bf16((a), (b), (c), 0, 0, 0)
#define XB_TMO      128
#define XB_XCNT(j)  (256  + 64 * (j))
#define XB_XSUB(j)  (1280 + 64 * (j))
#define XB_XGEN(j)  (2304 + 64 * (j))
#define XB_TOP      3328
#define XB_TOPGEN   3392
#define XCD_BAR_WORDS 3456
#define XB_SPIN_CAP (1u << 18)

__device__ __forceinline__ unsigned xb_ld(unsigned* p)              { return __hip_atomic_load(p, __ATOMIC_RELAXED, __HIP_MEMORY_SCOPE_AGENT); }
__device__ __forceinline__ unsigned xb_add(unsigned* p, unsigned v) { return __hip_atomic_fetch_add(p, v, __ATOMIC_RELAXED, __HIP_MEMORY_SCOPE_AGENT); }
__device__ __forceinline__ unsigned xb_xcc_id() { return (unsigned)__builtin_amdgcn_s_getreg((3 << 11) | 20) & 0xFu; }
#define XB_SPIN(cond, bar) do { unsigned _sp = 0; while (cond) { __builtin_amdgcn_s_sleep(1); \
    if ((++_sp & 255u) == 0u) { if (xb_ld(&(bar)[XB_TMO])) break; if (_sp > XB_SPIN_CAP) { atomicAdd(&(bar)[XB_TMO], 1u); break; } } } } while (0)

struct XcdBarrier {
    unsigned* bar; unsigned x;
    volatile LAS unsigned* st;
};

__device__ __forceinline__ XcdBarrier xcd_barrier_post(unsigned* bar, volatile LAS unsigned* st) {
    XcdBarrier b; b.bar = bar; b.x = xb_xcc_id(); b.st = st;
    if (threadIdx.x == 0) (void)xb_add(&bar[XB_XCNT(b.x)], 1u);
    return b;
}
__device__ __forceinline__ void xcd_barrier_complete(unsigned* bar, unsigned x, unsigned& nloc, unsigned& nx) {
    const unsigned G = gridDim.x * gridDim.y * gridDim.z;
    unsigned sum, cnt, mine, sp = 0u;
    for (;;) {
        sum = 0u; cnt = 0u; mine = 0u;
#pragma unroll
        for (unsigned j = 0; j < 16; ++j) { const unsigned c = xb_ld(&bar[XB_XCNT(j)]); sum += c; cnt += (c > 0u) ? 1u : 0u; mine = (j == x) ? c : mine; }
        if (sum == G) break;
        __builtin_amdgcn_s_sleep(1);
        if ((++sp & 255u) == 0u) { if (xb_ld(&bar[XB_TMO])) break; if (sp > XB_SPIN_CAP) { atomicAdd(&bar[XB_TMO], 1u); break; } }
    }
    nloc = mine > 0u ? mine : 1u; nx = cnt > 0u ? cnt : 1u;
}

__device__ __forceinline__ void xcd_barrier(const XcdBarrier& b) {
    asm volatile("s_waitcnt vmcnt(0)" ::: "memory");
    __syncthreads();
    if (threadIdx.x == 0) {
        unsigned* bar = b.bar;
        __builtin_amdgcn_s_waitcnt(0);
        unsigned nloc = b.st[0], nx = b.st[1];
        if (nloc == 0u) { xcd_barrier_complete(bar, b.x, nloc, nx); b.st[0] = nloc; b.st[1] = nx; }
        const unsigned old = xb_add(&bar[XB_XSUB(b.x)], 1u);
        const unsigned gen = old / nloc;
        if (old + 1u == (gen + 1u) * nloc) {
            __builtin_amdgcn_fence(__ATOMIC_RELEASE, "agent");
            asm volatile("s_waitcnt vmcnt(0)" ::: "memory");
            const unsigned og = xb_add(&bar[XB_TOP], 1u);
            const unsigned tg = og / nx;
            if (og + 1u == (tg + 1u) * nx) xb_add(&bar[XB_TOPGEN], 1u);
            else XB_SPIN(xb_ld(&bar[XB_TOPGEN]) == tg, bar);
            __builtin_amdgcn_fence(__ATOMIC_ACQUIRE, "agent");
            xb_add(&bar[XB_XGEN(b.x)], 1u);
            asm volatile("s_waitcnt vmcnt(0)" ::: "memory");
        } else {
            XB_SPIN(xb_ld(&bar[XB_XGEN(b.x)]) == gen, bar);
            __builtin_amdgcn_fence(__ATOMIC_ACQUIRE, "agent");
            asm volatile("s_waitcnt vmcnt(0)" ::: "memory");
        }
    }
    __syncthreads();
}

struct Ctx {
    LAS unsigned char* lds;
    int tid, lane, wave, vcu, G, gw, ngw;
    const float *x, *c; const int* pos; const float *w_ada, *b_ada, *g1, *w_in, *w_a2, *b_a, *gla_g, *qg, *kg, *w_out, *g2, *w_q, *keys, *pu, *pv;
    float* out;
    unsigned* ctl; long long* MODI; float* MOD;
    bf16 *WIN, *WGA, *WOUT, *WQ, *KEYSB, *H, *CONCAT, *PROJ, *ST, *QDEC, *KDEC, *KUPD, *PART; float* ML; unsigned short *LIST, *SEL; unsigned* PW; float* WSC;
    unsigned char *UQ, *VQ, *HQ, *WINQ, *WQQ; float *WINS, *WQS;
    float *CS, *KMEAN, *DEC, *BCUM, *UT, *QP, *GATE, *GU, *US, *VS, *HS; int *EXPI, *ACT;
};

__device__ __forceinline__ void transpose_item(const float* W, int ldw, int K, bf16* WT, int dst_row0, int k0, int n0, LAS float* scr, int lane) {
#pragma unroll 8
    for (int i = 0; i < 32; ++i) { const int kk = 2 * i + (lane >> 5); scr[kk * 33 + (lane & 31)] = W[(size_t)(k0 + kk) * ldw + n0 + (lane & 31)]; }
    LDS_WAIT(); asm volatile("" ::: "memory");
    const int c = lane & 7;
#pragma unroll
    for (int j = 0; j < 4; ++j) { const int n = (lane >> 3) + 8 * j; const LAS float* s = scr + (8 * c) * 33 + n;
        v4u o; o.x = pk2(s[0 * 33], s[1 * 33]); o.y = pk2(s[2 * 33], s[3 * 33]); o.z = pk2(s[4 * 33], s[5 * 33]); o.w = pk2(s[6 * 33], s[7 * 33]);
        *(v4u*)(WT + (size_t)(dst_row0 + n) * K + k0 + 8 * c) = o; }
    LDS_WAIT(); asm volatile("" ::: "memory");
}
__device__ __forceinline__ void quant_cols_item(const Ctx& C, const float* W, int ldw, int src_col0, unsigned char* WT, float* scales, int dst_row0) {
    const int lane = C.lane, w = C.wave, c = lane & 7;
    LAS float* scr = (LAS float*)(C.lds + w * 16384); LAS float* red = (LAS float*)(C.lds + 12288);
    float vals[4][4][8]; float mx[4] = {0.f, 0.f, 0.f, 0.f};
#pragma unroll
    for (int sb = 0; sb < 4; ++sb) { const int k0 = 256 * w + 64 * sb;
#pragma unroll 8
        for (int i = 0; i < 32; ++i) { const int kk = 2 * i + (lane >> 5); scr[kk * 33 + (lane & 31)] = W[(size_t)(k0 + kk) * ldw + src_col0 + (lane & 31)]; }
        LDS_WAIT(); asm volatile("" ::: "memory");
#pragma unroll
        for (int j = 0; j < 4; ++j) { const LAS float* sp = scr + (8 * c) * 33 + (lane >> 3) + 8 * j;
#pragma unroll
            for (int q = 0; q < 8; ++q) { const float v = sp[q * 33]; vals[sb][j][q] = v; mx[j] = fmaxf(mx[j], fabsf(v)); } }
        LDS_WAIT(); asm volatile("" ::: "memory"); }
#pragma unroll
    for (int j = 0; j < 4; ++j) { mx[j] = fmaxf(mx[j], __shfl_xor(mx[j], 1)); mx[j] = fmaxf(mx[j], __shfl_xor(mx[j], 2)); mx[j] = fmaxf(mx[j], __shfl_xor(mx[j], 4)); }
    __syncthreads();
    if (c == 0) {
#pragma unroll
        for (int j = 0; j < 4; ++j) red[w * 32 + (lane >> 3) + 8 * j] = mx[j]; }
    __syncthreads();
#pragma unroll
    for (int j = 0; j < 4; ++j) { const int n = (lane >> 3) + 8 * j; float am = 0.f;
#pragma unroll
        for (int ww = 0; ww < 8; ++ww) am = fmaxf(am, red[ww * 32 + n]);
        const float inv = am > 0.f ? 127.f / am : 0.f;
        if (w == 0 && c == 0) scales[dst_row0 + n] = am > 0.f ? am / 127.f : 1.f;
#pragma unroll
        for (int sb = 0; sb < 4; ++sb) { unsigned o[2];
#pragma unroll
            for (int h = 0; h < 2; ++h) { const int q0 = (int)rintf(vals[sb][j][4 * h] * inv), q1 = (int)rintf(vals[sb][j][4 * h + 1] * inv), q2 = (int)rintf(vals[sb][j][4 * h + 2] * inv), q3 = (int)rintf(vals[sb][j][4 * h + 3] * inv);
                o[h] = (unsigned)(q0 & 0xff) | ((unsigned)(q1 & 0xff) << 8) | ((unsigned)(q2 & 0xff) << 16) | ((unsigned)(q3 & 0xff) << 24); }
            *(v2u*)(WT + (size_t)(dst_row0 + n) * D + 256 * w + 64 * sb + 8 * c) = (v2u){o[0], o[1]}; } }
    __syncthreads();
}
__device__ __forceinline__ void convert_item(const float* src, bf16* dst, size_t item, int lane) {
    const f32x4* s = (const f32x4*)(src + item * 8192) + 2 * lane; v4u* d = (v4u*)(dst + item * 8192) + lane;
#pragma unroll 4
    for (int it = 0; it < 16; ++it) { const f32x4 a = s[it * 128], b = s[it * 128 + 1]; v4u o; o.x = pk2(a.x, a.y); o.y = pk2(a.z, a.w); o.z = pk2(b.x, b.y); o.w = pk2(b.z, b.w); d[it * 64] = o; }
}
__device__ __forceinline__ float wave_max(float v) {
#pragma unroll
    for (int o = 1; o < 64; o <<= 1) v = fmaxf(v, __shfl_xor(v, o));
    return v;
}
__device__ __forceinline__ void quant_store(const f32x4 (&v)[8], unsigned char* dst, float* scales, int row, size_t nrows, int lane, int bias) {
    float am = 0.f;
#pragma unroll
    for (int j = 0; j < 8; ++j) am = fmaxf(am, fmaxf(fmaxf(fabsf(v[j].x), fabsf(v[j].y)), fmaxf(fabsf(v[j].z), fabsf(v[j].w))));
    am = wave_max(am);
    const float inv = am > 0.f ? 127.f / am : 0.f;
    if (lane == 0) scales[row] = am > 0.f ? am / 127.f : 1.f;
#pragma unroll
    for (int j = 0; j < 8; ++j) { const int q0 = (int)rintf(v[j].x * inv) + bias, q1 = (int)rintf(v[j].y * inv) + bias, q2 = (int)rintf(v[j].z * inv) + bias, q3 = (int)rintf(v[j].w * inv) + bias;
        *(unsigned*)(dst + ((size_t)j * nrows + row) * 256 + 4 * lane) = (unsigned)(q0 & 0xff) | ((unsigned)(q1 & 0xff) << 8) | ((unsigned)(q2 & 0xff) << 16) | ((unsigned)(q3 & 0xff) << 24); }
}
__device__ __forceinline__ void quant_row(const float* src, unsigned char* dst, float* scales, int row, size_t nrows, int lane, int bias) {
    const f32x4* s = (const f32x4*)src + lane; f32x4 v[8];
#pragma unroll
    for (int j = 0; j < 8; ++j) v[j] = s[64 * j];
    quant_store(v, dst, scales, row, nrows, lane, bias);
}
__device__ __forceinline__ void p0_phase(const Ctx& C, int rep) {
    const int lane = C.lane, gw = C.gw, ngw = C.ngw;
    LAS float* sc = (LAS float*)C.lds;
    LAS float* part = sc + BATCH * D;
    for (int i = C.tid; i < BATCH * D; i += NTHREADS) { const float v = C.c[i]; sc[i] = v / (1.f + __expf(-v)); }
    __syncthreads();
    for (int it = C.vcu; it < 192; it += C.G) {
        const int cq = lane & 15, rg = lane >> 4, col = it * 64 + 4 * cq, r0 = 256 * C.wave + rg;
        const f32x4* w = (const f32x4*)(C.w_ada + (size_t)r0 * NMOD + col); const LAS float* s0 = sc + r0; const LAS float* s1 = sc + D + r0;
        f32x4 a0 = {0.f, 0.f, 0.f, 0.f}, a1 = a0;
#pragma unroll 16
        for (int k = 0; k < 64; ++k) { const f32x4 wv = w[(size_t)k * NMOD]; a0 += s0[4 * k] * wv; a1 += s1[4 * k] * wv; }
#pragma unroll
        for (int q = 0; q < 4; ++q) { a0[q] += __shfl_xor(a0[q], 16); a0[q] += __shfl_xor(a0[q], 32); a1[q] += __shfl_xor(a1[q], 16); a1[q] += __shfl_xor(a1[q], 32); }
        if (rg == 0) { *(LAS f32x4*)(part + (C.wave * 2 + 0) * 64 + 4 * cq) = a0; *(LAS f32x4*)(part + (C.wave * 2 + 1) * 64 + 4 * cq) = a1; }
        __syncthreads();
        if (C.tid < 128) { const int bb = C.tid >> 6, cl = C.tid & 63; float s = 0.f;
#pragma unroll
            for (int ww = 0; ww < 8; ++ww) s += part[(ww * 2 + bb) * 64 + cl];
            C.MOD[bb * NMOD + it * 64 + cl] = s + C.b_ada[it * 64 + cl]; }
        __syncthreads();
    }
    for (int it = C.vcu; it < 192 + 64; it += C.G) {
        if (it < 192) { const int n0 = 32 * it; quant_cols_item(C, C.w_in, INW, n0 < 3072 ? n0 : n0 + 16, C.WINQ, C.WINS, n0); }
        else quant_cols_item(C, C.w_q, D, 32 * (it - 192), C.WQQ, C.WQS, 32 * (it - 192));
    }
    LAS float* scr = (LAS float*)(C.lds + C.wave * 16384);
    constexpr int I_SQ = 32 * 64;
    for (int it = gw; it < I_SQ; it += ngw) transpose_item(C.w_out, D, D, C.WOUT, 32 * (it % 64), 64 * (it / 64), 32 * (it % 64), scr, lane);
    for (int it = gw; it < 32; it += ngw) { const int k = it * 64 + lane; const f32x4* s = (const f32x4*)(C.w_in + (size_t)k * INW + GA_SRC);
#pragma unroll
        for (int q = 0; q < 4; ++q) { const f32x4 v = s[q]; C.WGA[(4 * q + 0) * D + k] = (bf16)(pk2(v.x, 0.f) & 0xffff); C.WGA[(4 * q + 1) * D + k] = (bf16)(pk2(v.y, 0.f) & 0xffff);
            C.WGA[(4 * q + 2) * D + k] = (bf16)(pk2(v.z, 0.f) & 0xffff); C.WGA[(4 * q + 3) * D + k] = (bf16)(pk2(v.w, 0.f) & 0xffff); } }
    for (int it = gw; it < NEXP; it += ngw) {
        const f32x4* su = (const f32x4*)(C.pu + (size_t)it * D) + lane; const f32x4* sv = (const f32x4*)(C.pv + (size_t)it * D) + lane; f32x4 vu[8], vv[8];
#pragma unroll
        for (int j = 0; j < 8; ++j) { vu[j] = su[64 * j]; vv[j] = sv[64 * j]; }
        quant_store(vu, C.UQ, C.US, it, NEXP, lane, 0); quant_store(vv, C.VQ, C.VS, it, NEXP, lane, 0);
    }
    for (int it = gw; it < 32; it += ngw) convert_item(C.keys, C.KEYSB, it, lane);
    for (int idx = C.vcu * NTHREADS + C.tid; idx < T * 16; idx += C.G * NTHREADS) {
        const int t = idx >> 4, f = idx & 15; const float inv = powf(500000.0f, -(float)f * 0.0625f); const float ang = (float)C.pos[t] * inv;
        C.CS[2 * idx] = cosf(ang); C.CS[2 * idx + 1] = sinf(ang);
    }
}

__device__ __forceinline__ float modi_to_f32(long long v) { return (float)(int)(v >> 32) * 0.00390625f + (float)(unsigned)v * 9.094947017729282e-13f; }
template <bool FIRST> __device__ __forceinline__ void norm_mod_phase(const Ctx& C, const float* X, const float* g, int shift_off, int scale_off, bf16* O) {
    LAS float* lg = (LAS float*)C.lds; LAS float* lsh = lg + D; LAS float* lsc = lsh + BATCH * D;
    for (int i = C.tid; i < D; i += NTHREADS) lg[i] = g[i];
    for (int i = C.tid; i < BATCH * D; i += NTHREADS) { const int b = i / D, j = i % D;
        lsh[i] = C.MOD[b * NMOD + shift_off + j]; lsc[i] = 1.f + C.MOD[b * NMOD + scale_off + j]; }
    __syncthreads();
    for (int m = C.gw; m < T; m += C.ngw) {
        const int b = m / SEQ; const f32x4* xr = (const f32x4*)(X + (size_t)m * D) + C.lane;
        f32x4 v[8]; float ss = 0.f;
#pragma unroll
        for (int j = 0; j < 8; ++j) { v[j] = xr[64 * j]; ss += (v[j].x * v[j].x + v[j].y * v[j].y) + (v[j].z * v[j].z + v[j].w * v[j].w); }
        const float rstd = rsqrtf(wave_sum(ss) * (1.f / D) + EPS);
        const LAS f32x4* g4 = (const LAS f32x4*)lg + C.lane; const LAS f32x4* sh4 = (const LAS f32x4*)(lsh + b * D) + C.lane; const LAS f32x4* sc4 = (const LAS f32x4*)(lsc + b * D) + C.lane;
#pragma unroll
        for (int j = 0; j < 8; ++j) { v[j] = v[j] * rstd * g4[64 * j] * sc4[64 * j] + sh4[64 * j]; }
        quant_store(v, C.HQ, C.HS, m, T, C.lane, 0);
    }
    __syncthreads();
}

__device__ __forceinline__ bf16x8 i8_to_bf16x8(unsigned lo, unsigned hi) {
    v4u w; w.x = pk2((float)((int)(lo << 24) >> 24), (float)((int)(lo << 16) >> 24)); w.y = pk2((float)((int)(lo << 8) >> 24), (float)((int)lo >> 24));
    w.z = pk2((float)((int)(hi << 24) >> 24), (float)((int)(hi << 16) >> 24)); w.w = pk2((float)((int)(hi << 8) >> 24), (float)((int)hi >> 24)); return __builtin_bit_cast(bf16x8, w); }
__device__ __forceinline__ void gla_prep_item(const Ctx& C, int b, int n, int ch) {
    const int lane = C.lane, w = C.wave, fr = lane & 15, fq = lane >> 4, rt = w & 3, kh = w >> 2; const size_t t0 = (size_t)b * SEQ + 64 * n;
    const unsigned char* ap = C.HQ + ((size_t)(kh * 4) * T + t0 + 16 * rt + fr) * 256 + 16 * fq; const bf16* bp = C.WGA + fr * D + kh * 1024 + 16 * fq;
    f32x4 acc = {0.f, 0.f, 0.f, 0.f};
#pragma unroll 8
    for (int s = 0; s < 16; ++s) { const v4u a = *(const v4u*)(ap + (size_t)(s >> 2) * T * 256 + (s & 3) * 64); const bf16x8 b0 = *(const bf16x8*)(bp + 64 * s), b1 = *(const bf16x8*)(bp + 64 * s + 8);
        acc = __builtin_amdgcn_mfma_f32_16x16x32_bf16(i8_to_bf16x8(a.x, a.y), b0, acc, 0, 0, 0); acc = __builtin_amdgcn_mfma_f32_16x16x32_bf16(i8_to_bf16x8(a.z, a.w), b1, acc, 0, 0, 0); }
#pragma unroll
    for (int r = 0; r < 4; ++r) acc[r] *= C.HS[t0 + 16 * rt + 4 * fq + r];
    LAS float* gaP = (LAS float*)C.lds;
#pragma unroll
    for (int r = 0; r < 4; ++r) gaP[kh * 1024 + (16 * rt + 4 * fq + r) * 16 + fr] = acc[r];
    __syncthreads();
    const int c = C.tid & 255, th = C.tid >> 8, col = ch * 256 + c; float wc[16];
#pragma unroll
    for (int r = 0; r < 16; ++r) wc[r] = C.w_a2[r * 512 + col];
    const float ba = C.b_a[col]; float cum = 0.f, la[32];
#pragma unroll
    for (int k = 0; k < 32; ++k) { const int tok = 32 * th + k;
        const LAS f32x4* g0 = (const LAS f32x4*)(gaP + tok * 16); const LAS f32x4* g1 = (const LAS f32x4*)(gaP + 1024 + tok * 16); float z = ba;
#pragma unroll
        for (int q = 0; q < 4; ++q) { const f32x4 gv = g0[q] + g1[q]; z += gv.x * wc[4 * q] + gv.y * wc[4 * q + 1] + gv.z * wc[4 * q + 2] + gv.w * wc[4 * q + 3]; }
        cum += (fminf(z, 0.f) - __logf(1.f + __expf(-fabsf(z)))) * 0.0625f; la[k] = cum; }
    if (th == 0) gaP[2048 + c] = cum;
    __syncthreads();
    const float base = th ? gaP[2048 + c] : 0.f;
    if (th == 1) gaP[2048 + 256 + c] = cum + base;
    __syncthreads();
    const float blast = gaP[2048 + 256 + c];
    if (th == 1) C.DEC[((size_t)(b * NH + (col >> 6)) * 64 + n) * 64 + (col & 63)] = __expf(blast);
    const bf16* qp = C.PROJ + (t0 + 32 * th) * NPROJ + GQ + col; const bf16* kp = C.PROJ + (t0 + 32 * th) * NPROJ + GK + col;
    bf16* qo = C.QDEC + (t0 + 32 * th) * 512 + col; bf16* ko = C.KDEC + (t0 + 32 * th) * 512 + col; bf16* uo = C.KUPD + (t0 + 32 * th) * 512 + col;
    unsigned short qr[32], kr[32];
#pragma unroll
    for (int k = 0; k < 32; ++k) { qr[k] = qp[(size_t)k * NPROJ]; kr[k] = kp[(size_t)k * NPROJ]; }
#pragma unroll
    for (int k = 0; k < 32; ++k) { const float bb = la[k] + base, qv = __uint_as_float((unsigned)qr[k] << 16), kv = __uint_as_float((unsigned)kr[k] << 16);
        qo[(size_t)k * 512] = (bf16)(pk2(qv * 0.125f * __expf(bb), 0.f) & 0xffffu); ko[(size_t)k * 512] = (bf16)(pk2(kv * __expf(-bb), 0.f) & 0xffffu); uo[(size_t)k * 512] = (bf16)(pk2(kv * __expf(blast - bb), 0.f) & 0xffffu); }
    __syncthreads();
}
__device__ __forceinline__ void moba_prep_item(const Ctx& C, int b, int h, int blk, int rep) {
    const int lane = C.lane, w = C.wave, i = lane & 15, tg = lane >> 4; const size_t t0 = (size_t)b * SEQ + 256 * blk;
    float qg[8], kg[8], km[8];
#pragma unroll
    for (int j = 0; j < 8; ++j) { qg[j] = C.qg[8 * i + j]; kg[j] = C.kg[8 * i + j]; km[j] = 0.f; }
    v4u rawq[8], rawk[8];
#pragma unroll
    for (int it = 0; it < 8; ++it) { const size_t tok = t0 + 32 * w + 4 * it + tg; rawq[it] = *(const v4u*)(C.PROJ + tok * NPROJ + MQ + h * 128 + 8 * i); rawk[it] = *(const v4u*)(C.PROJ + tok * NPROJ + MK + h * 128 + 8 * i); }
#pragma unroll
    for (int it = 0; it < 8; ++it) {
        const size_t tok = t0 + 32 * w + 4 * it + tg;
        float cs[16];
        if (i < 4) { const f32x4* cp = (const f32x4*)(C.CS + tok * 32 + (i & 1) * 16);
#pragma unroll
            for (int q = 0; q < 4; ++q) { const f32x4 v = cp[q]; cs[4 * q] = v.x; cs[4 * q + 1] = v.y; cs[4 * q + 2] = v.z; cs[4 * q + 3] = v.w; } }
        else {
#pragma unroll
            for (int q = 0; q < 16; ++q) cs[q] = 0.f; }
#pragma unroll
        for (int which = 0; which < 2; ++which) {
            bf16* p = C.PROJ + tok * NPROJ + (which ? MK : MQ) + h * 128 + 8 * i;
            const v4u raw = which ? rawk[it] : rawq[it]; float xv[8];
            xv[0] = bflo(raw.x); xv[1] = bfhi(raw.x); xv[2] = bflo(raw.y); xv[3] = bfhi(raw.y); xv[4] = bflo(raw.z); xv[5] = bfhi(raw.z); xv[6] = bflo(raw.w); xv[7] = bfhi(raw.w);
            float ss = 0.f;
#pragma unroll
            for (int j = 0; j < 8; ++j) ss += xv[j] * xv[j];
            ss += __shfl_xor(ss, 1); ss += __shfl_xor(ss, 2); ss += __shfl_xor(ss, 4); ss += __shfl_xor(ss, 8);
            const float rstd = rsqrtf(ss * (1.f / 128.f) + EPS);
#pragma unroll
            for (int j = 0; j < 8; ++j) xv[j] = xv[j] * rstd * (which ? kg[j] : qg[j]);
#pragma unroll
            for (int j = 0; j < 8; ++j) { const float o = __shfl_xor(xv[j], 2); const float cv = cs[2 * j], sv = cs[2 * j + 1];
                if (i < 2) xv[j] = xv[j] * cv - o * sv; else if (i < 4) xv[j] = xv[j] * cv + o * sv; }
            v4u o; o.x = pk2(xv[0], xv[1]); o.y = pk2(xv[2], xv[3]); o.z = pk2(xv[4], xv[5]); o.w = pk2(xv[6], xv[7]);
            if (rep) *(v4u*)(C.CONCAT + tok * D + which * 1024 + h * 128 + 8 * i) = o; else *(v4u*)p = o;
            if (which) {
#pragma unroll
                for (int j = 0; j < 8; ++j) km[j] += xv[j]; }
        }
    }
    LAS float* red = (LAS float*)C.lds;
#pragma unroll
    for (int j = 0; j < 8; ++j) { km[j] += __shfl_xor(km[j], 16); km[j] += __shfl_xor(km[j], 32); }
    if (lane < 16) {
#pragma unroll
        for (int j = 0; j < 8; ++j) red[w * 128 + 8 * i + j] = km[j]; }
    __syncthreads();
    if (C.tid < 128) { float s = 0.f;
#pragma unroll
        for (int ww = 0; ww < 8; ++ww) s += red[ww * 128 + C.tid];
        C.KMEAN[((size_t)(b * NH + h) * 16 + blk) * 128 + C.tid] = s * (1.f / 256.f); }
    __syncthreads();
}


constexpr int KP = 272, VP = 320;
__device__ __forceinline__ void moba_select_item(const Ctx& C, int b, int h, int qb, int rep) {
    const int lane = C.lane, w = C.wave, r = lane & 31, hh = lane >> 5; const size_t tb = (size_t)b * SEQ; const int qtok = qb * 256 + 32 * w + r;
    bf16x8 qf[8];
    { const bf16* qrow = C.PROJ + MQ + h * 128 + (tb + qtok) * NPROJ + 8 * hh;
#pragma unroll
      for (int s = 0; s < 8; ++s) qf[s] = *(const bf16x8*)(qrow + 16 * s); }
    float g0 = -INFINITY, g1 = -INFINITY, g2 = -INFINITY; int i0 = -1, i1 = -1, i2 = -1;
    LAS float* kml = (LAS float*)C.lds;
    for (int i = C.tid; i < qb * 128; i += NTHREADS) kml[i] = C.KMEAN[((size_t)(b * NH + h) * 16) * 128 + i];
    __syncthreads();
    const LAS float* km = kml + 8 * hh;
    for (int j = 0; j < qb; ++j) {
        float acc = 0.f;
#pragma unroll
        for (int s = 0; s < 8; ++s) { const f32x4 k0 = *(const LAS f32x4*)(km + j * 128 + 16 * s), k1 = *(const LAS f32x4*)(km + j * 128 + 16 * s + 4);
            acc += bf1(qf[s][0]) * k0.x + bf1(qf[s][1]) * k0.y + bf1(qf[s][2]) * k0.z + bf1(qf[s][3]) * k0.w + bf1(qf[s][4]) * k1.x + bf1(qf[s][5]) * k1.y + bf1(qf[s][6]) * k1.z + bf1(qf[s][7]) * k1.w; }
        acc += __shfl_xor(acc, 32);
        if (acc > g0) { g2 = g1; i2 = i1; g1 = g0; i1 = i0; g0 = acc; i0 = j; }
        else if (acc > g1) { g2 = g1; i2 = i1; g1 = acc; i1 = j; }
        else if (acc > g2) { g2 = acc; i2 = j; }
    }
    __syncthreads();
    const int np = (i0 >= 0) + (i1 >= 0) + (i2 >= 0);
    if (hh == 0) C.SEL[(tb + qtok) * NH + h] = (unsigned short)((i0 & 15) | ((i1 & 15) << 4) | ((i2 & 15) << 8) | (np << 12));
    unsigned* lc = C.ctl + (rep ? 16384 : CW_LCNT) + ((b * NH + h) * 16) * 8; int nv = 0;
#pragma unroll
    for (int j = 0; j < 15; ++j) { const unsigned long long mk = __ballot(hh == 0 && (i0 == j || i1 == j || i2 == j)); nv = (lane == j) ? (int)__popcll(mk) : nv; }
    int basev = 0; if (lane < 15 && nv > 0) basev = (int)atomicAdd(lc + lane * 8, (unsigned)nv);
    unsigned short* lp = C.LIST + (size_t)((b * NH + h) * 16) * 4096 + (rep ? 256 * 4096 : 0);
#pragma unroll
    for (int j = 0; j < 15; ++j) { const int bj = __builtin_amdgcn_readlane(basev, j); const bool pj = hh == 0 && (i0 == j || i1 == j || i2 == j); const unsigned long long mk = __ballot(pj);
        if (pj) { const int slot = (i0 == j) ? 0 : (i1 == j) ? 1 : 2;
            const int pos = bj + (int)__builtin_amdgcn_mbcnt_hi((unsigned)(mk >> 32), __builtin_amdgcn_mbcnt_lo((unsigned)mk, 0u));
            lp[j * 4096 + pos] = (unsigned short)(qtok | (slot << 12)); } }
}
__device__ __forceinline__ void moba_attn_item(const Ctx& C, int b, int h, int kblk, bool own, int sub) {
    const int lane = C.lane, w = C.wave, r = lane & 31, hh = lane >> 5; const size_t tb = (size_t)b * SEQ; const int li = (b * NH + h) * 16 + kblk;
    { const char* kp = (const char*)(C.PROJ + (tb + kblk * 256) * NPROJ + MK + h * 128); const char* vp = (const char*)(C.PROJ + (tb + kblk * 256) * NPROJ + MV + h * 128);
#pragma unroll
      for (int i = 0; i < 8; ++i) { const int p = w + 8 * i, row = 4 * p + (lane >> 4), cp = lane & 15;
          __builtin_amdgcn_global_load_lds((const unsigned*)(kp + (size_t)row * (NPROJ * 2) + 16 * (cp ^ (row & 15))), (LAS unsigned*)(C.lds + p * 1024), 16, 0, 0);
          __builtin_amdgcn_global_load_lds((const unsigned*)(vp + (size_t)row * (NPROJ * 2) + 16 * (cp ^ ((row & 3) << 2))), (LAS unsigned*)(C.lds + 65536 + p * 1024), 16, 0, 0); } }
    const int cnt = own ? 256 : (int)C.ctl[CW_LCNT + li * 8], e = 256 * sub + 32 * w + r; const bool valid = e < cnt, wave_on = 256 * sub + 32 * w < cnt;
    int qtok, slot;
    if (own) { qtok = kblk * 256 + 32 * w + r; slot = 3; } else { const int ent = C.LIST[(size_t)li * 4096 + (valid ? e : 256 * sub)]; qtok = ent & 4095; slot = ent >> 12; }
    bf16x8 qf[8];
    { const bf16* qrow = C.PROJ + MQ + h * 128 + (tb + qtok) * NPROJ + 8 * hh;
#pragma unroll
      for (int s = 0; s < 8; ++s) qf[s] = *(const bf16x8*)(qrow + 16 * s); }
    __syncthreads();
    if (wave_on) {
        float m_run = -1e30f, l_run = 0.f; f32x16 o[4];
#pragma unroll
        for (int dt = 0; dt < 4; ++dt)
#pragma unroll
            for (int q = 0; q < 16; ++q) o[dt][q] = 0.f;
        const float c2 = 0.08838834764831845f * 1.4426950408889634f;
        const int xr = r & 15, vq = (lane & 15) >> 2, qi = 32 * w + r, ntile = own ? ((32 * w + 31) >> 6) + 1 : 4;
        const int kfo = r * 256, vfo = 65536 + (4 * hh + vq) * 256 + 32 * ((lane >> 4) & 1) + 8 * (lane & 3);
        for (int t = 0; t < ntile; ++t) {
            const LAS unsigned char* kb = C.lds + kfo + t * 16384;
            f32x16 p0, p1;
#pragma unroll
            for (int q = 0; q < 16; ++q) { p0[q] = 0.f; p1[q] = 0.f; }
#pragma unroll
            for (int ss = 0; ss < 8; ++ss) { const int co = ((2 * ss + hh) ^ xr) << 4; const bf16x8 a0 = *(const LAS bf16x8*)(kb + co), a1 = *(const LAS bf16x8*)(kb + 32 * 256 + co);
                p0 = MFMA32(a0, qf[ss], p0); p1 = MFMA32(a1, qf[ss], p1); }
            if (own) {
#pragma unroll
                for (int q = 0; q < 16; ++q) { const int kk = 64 * t + crow(q, hh); if (kk > qi) p0[q] = -INFINITY; if (kk + 32 > qi) p1[q] = -INFINITY; } }
            float mx = fmaxf(p0[0], p1[0]);
#pragma unroll
            for (int q = 1; q < 16; ++q) mx = fmaxf(mx, fmaxf(p0[q], p1[q]));
            { auto rr = __builtin_amdgcn_permlane32_swap(__float_as_uint(mx), __float_as_uint(mx), false, false); mx = fmaxf(__uint_as_float(rr[0]), __uint_as_float(rr[1])); }
            const float m_new = fmaxf(m_run, mx * c2), alpha = __builtin_amdgcn_exp2f(m_run - m_new);
            m_run = m_new; float rs = 0.f;
#pragma unroll
            for (int q = 0; q < 16; ++q) { p0[q] = __builtin_amdgcn_exp2f(p0[q] * c2 - m_new); p1[q] = __builtin_amdgcn_exp2f(p1[q] * c2 - m_new); rs += p0[q] + p1[q]; }
            l_run = l_run * alpha + rs;
            if (__ballot(alpha != 1.f) != 0ull) {
#pragma unroll
                for (int dt = 0; dt < 4; ++dt)
#pragma unroll
                    for (int q = 0; q < 16; ++q) o[dt][q] *= alpha; }
            bf16x8 pf[4];
            pf[0] = pack8(p0[0], p0[1], p0[2], p0[3], p0[4], p0[5], p0[6], p0[7]); pf[1] = pack8(p0[8], p0[9], p0[10], p0[11], p0[12], p0[13], p0[14], p0[15]);
            pf[2] = pack8(p1[0], p1[1], p1[2], p1[3], p1[4], p1[5], p1[6], p1[7]); pf[3] = pack8(p1[8], p1[9], p1[10], p1[11], p1[12], p1[13], p1[14], p1[15]);
            const LAS unsigned char* vb = C.lds + vfo + t * 16384;
#pragma unroll
            for (int dt = 0; dt < 4; ++dt) { const LAS unsigned char* vd = vb + 64 * (dt ^ vq);
#pragma unroll
                for (int kk = 0; kk < 4; ++kk) { const s16x4 lo = vtr(vd + (16 * kk) * 256), hi = vtr(vd + (16 * kk + 8) * 256); o[dt] = MFMA32(cat4(lo, hi), pf[kk], o[dt]); } }
        }
        l_run += __shfl_xor(l_run, 32);
        if (valid) { const float inv = 1.f / l_run; const size_t row = ((tb + qtok) * NH + h) * 4 + slot; bf16* op = C.PART + row * 128 + 4 * hh;
#pragma unroll
            for (int dt = 0; dt < 4; ++dt)
#pragma unroll
                for (int k4 = 0; k4 < 4; ++k4) { v2u wv; wv.x = pk2(o[dt][4 * k4] * inv, o[dt][4 * k4 + 1] * inv); wv.y = pk2(o[dt][4 * k4 + 2] * inv, o[dt][4 * k4 + 3] * inv); *(v2u*)(op + 32 * dt + 8 * k4) = wv; }
            if (hh == 0) *(f32x2*)(C.ML + row * 2) = (f32x2){m_run, l_run}; }
    }
    __syncthreads();
}
__device__ __forceinline__ void moba_merge_token(const Ctx& C, size_t t) {
    const int lane = C.lane, hd = lane >> 3, dc = lane & 7; const size_t row0 = (t * NH + hd) * 4;
    const unsigned short sel = C.SEL[t * NH + hd]; f32x2 ml[4]; v4u pa[4], pc[4];
#pragma unroll
    for (int s = 0; s < 4; ++s) { ml[s] = *(const f32x2*)(C.ML + (row0 + s) * 2); const v4u* pp = (const v4u*)(C.PART + (row0 + s) * 128 + 16 * dc); pa[s] = pp[0]; pc[s] = pp[1]; }
    const int np = sel >> 12; float M = -1e30f, wg[4], wsum = 0.f;
#pragma unroll
    for (int s = 0; s < 4; ++s) { const bool v = (s == 3) || (s < np); ml[s].x = v ? ml[s].x : -1e30f; ml[s].y = v ? ml[s].y : 0.f; M = fmaxf(M, ml[s].x); }
#pragma unroll
    for (int s = 0; s < 4; ++s) { wg[s] = ml[s].y * __builtin_amdgcn_exp2f(ml[s].x - M); wsum += wg[s]; }
    const float inv = 1.f / wsum; float acc[16];
#pragma unroll
    for (int q = 0; q < 16; ++q) acc[q] = 0.f;
#pragma unroll
    for (int s = 0; s < 4; ++s) { const unsigned vm = ((s == 3) || (s < np)) ? 0xffffffffu : 0u; const float ws_ = wg[s] * inv; v4u a = pa[s], c = pc[s];
        a.x &= vm; a.y &= vm; a.z &= vm; a.w &= vm; c.x &= vm; c.y &= vm; c.z &= vm; c.w &= vm;
        acc[0] += ws_ * bflo(a.x); acc[1] += ws_ * bfhi(a.x); acc[2] += ws_ * bflo(a.y); acc[3] += ws_ * bfhi(a.y); acc[4] += ws_ * bflo(a.z); acc[5] += ws_ * bfhi(a.z); acc[6] += ws_ * bflo(a.w); acc[7] += ws_ * bfhi(a.w);
        acc[8] += ws_ * bflo(c.x); acc[9] += ws_ * bfhi(c.x); acc[10] += ws_ * bflo(c.y); acc[11] += ws_ * bfhi(c.y); acc[12] += ws_ * bflo(c.z); acc[13] += ws_ * bfhi(c.z); acc[14] += ws_ * bflo(c.w); acc[15] += ws_ * bfhi(c.w); }
    v4u o0, o1; o0.x = pk2(acc[0], acc[1]); o0.y = pk2(acc[2], acc[3]); o0.z = pk2(acc[4], acc[5]); o0.w = pk2(acc[6], acc[7]); o1.x = pk2(acc[8], acc[9]); o1.y = pk2(acc[10], acc[11]); o1.z = pk2(acc[12], acc[13]); o1.w = pk2(acc[14], acc[15]);
    v4u* op = (v4u*)(C.CONCAT + t * D + 1024 + hd * 128 + 16 * dc); op[0] = o0; op[1] = o1;
}

constexpr int GKP = 192;
__device__ __forceinline__ void gla_v_to_lds(const Ctx& C, size_t t0, int h, int off) {
#pragma unroll
    for (int pp = 0; pp < 2; ++pp) { const int p = C.tid + 512 * pp; const v4u v = *(const v4u*)(C.PROJ + (t0 + (p >> 4)) * NPROJ + GV + h * 128 + 8 * (p & 15)); *(LAS v4u*)(C.lds + off + (p >> 4) * VP + 16 * (p & 15)) = v; }
}
__device__ __forceinline__ void gla_u_item(const Ctx& C, int b, int h, int n4) {
    const int tid = C.tid, lane = C.lane, w = C.wave, r = lane & 31, hh = lane >> 5;
    v4u kr[4], vr[4][2];
#pragma unroll
    for (int c = 0; c < 4; ++c) { const size_t t0 = (size_t)b * SEQ + 64 * (4 * n4 + c); const int tok = tid >> 3, ch = tid & 7;
        kr[c] = *(const v4u*)(C.KUPD + (t0 + tok) * 512 + h * 64 + 8 * ch);
#pragma unroll
        for (int pp = 0; pp < 2; ++pp) { const int p = tid + 512 * pp; vr[c][pp] = *(const v4u*)(C.PROJ + (t0 + (p >> 4)) * NPROJ + GV + h * 128 + 8 * (p & 15)); } }
#pragma unroll
    for (int c = 0; c < 4; ++c) { const int tok = tid >> 3, ch = tid & 7; *(LAS v4u*)(C.lds + c * 32768 + tok * GKP + 16 * ch) = kr[c];
#pragma unroll
        for (int pp = 0; pp < 2; ++pp) { const int p = tid + 512 * pp; *(LAS v4u*)(C.lds + c * 32768 + 64 * GKP + (p >> 4) * VP + 16 * (p & 15)) = vr[c][pp]; } }
    __syncthreads();
    const int mt = w & 3, nt = w >> 2, q = (lane & 15) >> 2, cb = (16 * ((lane >> 4) & 1) + 4 * (lane & 3)) * 2;
#pragma unroll
    for (int c = 0; c < 4; ++c) {
        const LAS unsigned char* va = C.lds + c * 32768 + 64 * GKP + (4 * hh + q) * VP + cb + mt * 64; const LAS unsigned char* ka = C.lds + c * 32768 + (4 * hh + q) * GKP + cb + nt * 64;
        f32x16 acc;
#pragma unroll
        for (int i = 0; i < 16; ++i) acc[i] = 0.f;
#pragma unroll
        for (int s = 0; s < 4; ++s) acc = MFMA32(cat4(vtr(va + 16 * s * VP), vtr(va + (16 * s + 8) * VP)), cat4(vtr(ka + 16 * s * GKP), vtr(ka + (16 * s + 8) * GKP)), acc);
        float* up = C.UT + (size_t)((b * NH + h) * 64 + 4 * n4 + c) * 8192 + (32 * mt) * 64 + 32 * nt + r;
#pragma unroll
        for (int i = 0; i < 16; ++i) up[crow(i, hh) * 64] = acc[i];
    }
    __syncthreads();
}
__device__ __forceinline__ void gla_scan_item(const Ctx& C, int id) {
    { const int idx = id * NTHREADS + C.tid;
        const int bh = idx >> 13, rem = idx & 8191, dk = rem & 63; float s = 0.f;
        const float* up = C.UT + (size_t)bh * 64 * 8192 + rem; const float* dp = C.DEC + (size_t)bh * 64 * 64 + dk; bf16* sp = C.ST + (size_t)bh * 64 * 8192 + rem;
#pragma unroll 16
        for (int n = 0; n < 64; ++n) { sp[(size_t)n * 8192] = (bf16)(pk2(s, 0.f) & 0xffffu); s = dp[n * 64] * s + up[(size_t)n * 8192]; }
    }
}

__device__ __forceinline__ void p5_attn_phase(const Ctx& C, int rep) {
    volatile LAS int* qslot = (volatile LAS int*)(C.lds + MISC_OFF + 64);
    LAS int* pfx = (LAS int*)(C.lds + RING_BYTES + 1024);
    if (C.tid < 256) { const int c = ((C.tid & 15) < 15) ? (int)C.ctl[CW_LCNT + C.tid * 8] : 0; pfx[1 + C.tid] = (c + 255) >> 8; }
    __syncthreads();
    if (C.tid == 0) { int s = 0; pfx[0] = 0; for (int i = 1; i <= 256; ++i) { s += pfx[i]; pfx[i] = s; } }
    __syncthreads();
    const int npast = pfx[256]; unsigned* cnt = C.ctl + CW_Q + 64 * rep;
    for (;;) {
        __syncthreads();
        if (C.tid == 0) { const int id = (int)atomicAdd(cnt, 1u); int a0 = -1, a1 = 0;
            if (id < 256) { a0 = 512 + id; }
            else if (id < 512) { a0 = id - 256; a1 = -1; }
            else if (id < 512 + npast) { const int p = id - 512; int lo = 0, hi = 256; while (hi - lo > 1) { const int mid = (lo + hi) >> 1; if (pfx[mid] <= p) lo = mid; else hi = mid; } a0 = lo; a1 = p - pfx[lo]; }
            qslot[0] = a0; qslot[1] = a1; }
        __syncthreads();
        const int a0 = qslot[0], a1 = qslot[1];
        if (a0 < 0) break;
        if (a0 < 256) moba_attn_item(C, a0 >> 7, (a0 >> 4) & 7, a0 & 15, a1 < 0, a1 < 0 ? 0 : a1);
        else gla_scan_item(C, a0 - 512);
    }
}

__device__ __forceinline__ void gla_out_item(const Ctx& C, int b, int h, int n) {
    const int lane = C.lane, w = C.wave, r = lane & 31, hh = lane >> 5, dvt = w & 3, lt = w >> 2; const size_t t0 = (size_t)b * SEQ + 64 * n; const int bhn = (b * NH + h) * 64 + n;
    constexpr int VT = 0, RED = 64 * VP;
    const size_t tl = t0 + 32 * lt + r;
    v4u vraw[2]; bf16x8 qd[4], kd[2][4];
#pragma unroll
    for (int pp = 0; pp < 2; ++pp) { const int p = C.tid + 512 * pp; vraw[pp] = *(const v4u*)(C.PROJ + (t0 + (p >> 4)) * NPROJ + GV + h * 128 + 8 * (p & 15)); }
#pragma unroll
    for (int s = 0; s < 4; ++s) { qd[s] = *(const bf16x8*)(C.QDEC + tl * 512 + h * 64 + 16 * s + 8 * hh); kd[1][s] = *(const bf16x8*)(C.KDEC + tl * 512 + h * 64 + 16 * s + 8 * hh);
        kd[0][s] = *(const bf16x8*)(C.KDEC + (t0 + r) * 512 + h * 64 + 16 * s + 8 * hh); }
#pragma unroll
    for (int pp = 0; pp < 2; ++pp) { const int p = C.tid + 512 * pp; *(LAS v4u*)(C.lds + VT + (p >> 4) * VP + 16 * (p & 15)) = vraw[pp]; }
    bf16x8 sfr[4]; v2u graw[4]; f32x4 gn[4];
    { const bf16* sp = C.ST + (size_t)bhn * 8192 + (32 * dvt + r) * 64 + 8 * hh;
#pragma unroll
      for (int s = 0; s < 4; ++s) sfr[s] = *(const bf16x8*)(sp + 16 * s);
#pragma unroll
      for (int k4 = 0; k4 < 4; ++k4) { const int d0 = 32 * dvt + 8 * k4 + 4 * hh; graw[k4] = *(const v2u*)(C.PROJ + tl * NPROJ + GG + h * 128 + d0); gn[k4] = *(const f32x4*)(C.gla_g + d0); } }
    __syncthreads();
    f32x16 o;
#pragma unroll
    for (int i = 0; i < 16; ++i) o[i] = 0.f;
    const LAS unsigned char* va = C.lds + VT + (4 * hh + ((lane & 15) >> 2)) * VP + (16 * ((lane >> 4) & 1) + 4 * (lane & 3)) * 2 + dvt * 64;
#pragma unroll
    for (int mt = 0; mt < 2; ++mt) {
        if (mt > lt) break;
        const bool diag = (mt == lt); f32x16 X;
#pragma unroll
        for (int i = 0; i < 16; ++i) X[i] = 0.f;
#pragma unroll
        for (int s = 0; s < 4; ++s) X = MFMA32(diag ? kd[1][s] : kd[0][s], qd[s], X);
        if (diag) {
#pragma unroll
            for (int i = 0; i < 16; ++i) if (crow(i, hh) > r) X[i] = 0.f; }
        const bf16x8 pf0 = pack8(X[0], X[1], X[2], X[3], X[4], X[5], X[6], X[7]), pf1 = pack8(X[8], X[9], X[10], X[11], X[12], X[13], X[14], X[15]);
        o = MFMA32(cat4(vtr(va + (32 * mt) * VP), vtr(va + (32 * mt + 8) * VP)), pf0, o);
        o = MFMA32(cat4(vtr(va + (32 * mt + 16) * VP), vtr(va + (32 * mt + 24) * VP)), pf1, o);
    }
#pragma unroll
    for (int s = 0; s < 4; ++s) o = MFMA32(sfr[s], qd[s], o);
    float ss = 0.f;
#pragma unroll
    for (int i = 0; i < 16; ++i) ss += o[i] * o[i];
    ss += __shfl_xor(ss, 32);
    LAS float* red = (LAS float*)(C.lds + RED);
    if (hh == 0) red[dvt * 64 + 32 * lt + r] = ss;
    __syncthreads();
    const int l = 32 * lt + r; const float rstd = rsqrtf((red[l] + red[64 + l] + red[128 + l] + red[192 + l]) * (1.f / 128.f) + EPS);
#pragma unroll
    for (int k4 = 0; k4 < 4; ++k4) { const int d0 = 32 * dvt + 8 * k4 + 4 * hh;
        const float ga = bflo(graw[k4].x), gb = bfhi(graw[k4].x), gc = bflo(graw[k4].y), gd = bfhi(graw[k4].y); const f32x4 gnv = gn[k4];
        const float y0 = o[4 * k4] * rstd * gnv.x * (ga / (1.f + __expf(-ga))), y1 = o[4 * k4 + 1] * rstd * gnv.y * (gb / (1.f + __expf(-gb)));
        const float y2 = o[4 * k4 + 2] * rstd * gnv.z * (gc / (1.f + __expf(-gc))), y3 = o[4 * k4 + 3] * rstd * gnv.w * (gd / (1.f + __expf(-gd)));
        v2u wv; wv.x = pk2(y0, y1); wv.y = pk2(y2, y3); *(v2u*)(C.CONCAT + tl * D + h * 128 + d0) = wv; }
    __syncthreads();
}


#define INS16(L, xin) do { int x_ = (xin); _Pragma("unroll") for (int i_ = 0; i_ < 16; ++i_) { const int hi_ = max(L[i_], x_); x_ = min(L[i_], x_); L[i_] = hi_; } } while (0)
#define CE_DESC(a, b) do { const int hi_ = max(a, b), lo_ = min(a, b); a = hi_; b = lo_; } while (0)
#define BITONIC_MERGE16(L) do { _Pragma("unroll") for (int j_ = 8; j_ > 0; j_ >>= 1) _Pragma("unroll") for (int i_ = 0; i_ < 16; ++i_) if ((i_ & j_) == 0) CE_DESC(L[i_], L[i_ | j_]); } while (0)
#define SORT16(L) do { _Pragma("unroll") for (int k_ = 2; k_ <= 16; k_ <<= 1) _Pragma("unroll") for (int j_ = k_ >> 1; j_ > 0; j_ >>= 1) _Pragma("unroll") for (int i_ = 0; i_ < 16; ++i_) { const int l_ = i_ ^ j_; \
        if (l_ > i_) { if ((i_ & k_) == 0) CE_DESC(L[i_], L[l_]); else CE_DESC(L[l_], L[i_]); } } } while (0)
#define MERGE16(L, M) do { _Pragma("unroll") for (int i_ = 0; i_ < 16; ++i_) L[i_] = max(L[i_], M[15 - i_]); BITONIC_MERGE16(L); } while (0)
__device__ __forceinline__ int ord_key(float v) { int u = __float_as_int(v); return u ^ ((u >> 31) & 0x7fffffff); }
__device__ __forceinline__ float ord_val(int k, int mask) { int u = k & ~mask; return __int_as_float(u ^ ((u >> 31) & 0x7fffffff)); }
__device__ __forceinline__ void peer_topk_item(const Ctx& C, int tg, int hd, const LAS unsigned char* qlds, int lrow0) {
    const int lane = C.lane, r = lane & 31, hh = lane >> 5; const size_t tok = (size_t)tg * 32 + r;
    int La[16], Lb[16];
#pragma unroll
    for (int c = 0; c < 2; ++c) {
        int L[16];
#pragma unroll
        for (int i = 0; i < 16; ++i) L[i] = (int)0x80000000;
        bf16x8 qf[8];
        { const int row = lrow0 + r;
#pragma unroll
          for (int s = 0; s < 8; ++s) qf[s] = *(const LAS bf16x8*)(qlds + row * 512 + 16 * ((16 * c + 2 * s + hh) ^ (row & 15))); }
        int G[16];
        bf16x8 kfA[8], kfB[8];
#define PT_KLOAD(dst, kt) do { const bf16* kp_ = C.KEYSB + ((size_t)(hd * 2 + c) * 128 + 32 * (kt) + r) * 128 + 8 * hh; _Pragma("unroll") for (int s = 0; s < 8; ++s) dst[s] = *(const bf16x8*)(kp_ + 16 * s); } while (0)
#define PT_TILE(src, kt) do { f32x16 X; _Pragma("unroll") for (int i = 0; i < 16; ++i) X[i] = 0.f; _Pragma("unroll") for (int s = 0; s < 8; ++s) X = MFMA32(src[s], qf[s], X); \
            _Pragma("unroll") for (int i = 0; i < 16; ++i) G[i] = (ord_key(X[i]) & ~127) | (32 * (kt) + crow(i, hh)); SORT16(G); MERGE16(L, G); } while (0)
        PT_KLOAD(kfA, 0);
#pragma unroll 1
        for (int k2 = 0; k2 < 2; ++k2) {
            PT_KLOAD(kfB, 2 * k2 + 1);
            PT_TILE(kfA, 2 * k2);
            if (k2 == 0) PT_KLOAD(kfA, 2);
            PT_TILE(kfB, 2 * k2 + 1);
        }
#undef PT_KLOAD
#undef PT_TILE
        int M[16];
#pragma unroll
        for (int i = 0; i < 16; ++i) M[i] = __shfl_xor(L[i], 32);
        MERGE16(L, M);
#pragma unroll
        for (int i = 0; i < 16; ++i) { if (c == 0) La[i] = L[i]; else Lb[i] = L[i]; }
    }
    float sa[16], sb[16]; int Lc[16];
#pragma unroll
    for (int i = 0; i < 16; ++i) { sa[i] = ord_val(La[i], 127); sb[i] = ord_val(Lb[i], 127); Lc[i] = (int)0x80000000; }
#pragma unroll
    for (int i = 0; i < 16; ++i)
#pragma unroll
        for (int j = 0; j < 16; ++j) if ((i + 1) * (j + 1) <= 16) INS16(Lc, (ord_key(sa[i] + sb[j]) & ~255) | (i * 16 + j));
    float e[16], sum = 0.f; int ex[16]; const float mx = ord_val(Lc[0], 255);
#pragma unroll
    for (int i = 0; i < 16; ++i) {
        e[i] = __expf(ord_val(Lc[i], 255) - mx); sum += e[i];
        const int ii = (Lc[i] >> 4) & 15, jj = Lc[i] & 15; int i1 = 0, i2 = 0;
#pragma unroll
        for (int q = 0; q < 16; ++q) { i1 = (ii == q) ? (La[q] & 127) : i1; i2 = (jj == q) ? (Lb[q] & 127) : i2; }
        ex[i] = i1 * 128 + i2;
    }
    const float inv = 1.f / sum;
    if (hh == 0) {
        v4u* ep = (v4u*)(C.EXPI + tok * 128 + hd * 16); f32x4* gp = (f32x4*)(C.GATE + tok * 128 + hd * 16); f32x4* up = (f32x4*)(C.GU + tok * 128 + hd * 16); v4u* ap = (v4u*)(C.ACT + tok * 128 + hd * 16);
        const float hs = C.HS[tok];
#pragma unroll
        for (int q = 0; q < 4; ++q) { ep[q] = (v4u){(unsigned)ex[4 * q], (unsigned)ex[4 * q + 1], (unsigned)ex[4 * q + 2], (unsigned)ex[4 * q + 3]};
            gp[q] = (f32x4){e[4 * q] * inv * C.VS[ex[4 * q]], e[4 * q + 1] * inv * C.VS[ex[4 * q + 1]], e[4 * q + 2] * inv * C.VS[ex[4 * q + 2]], e[4 * q + 3] * inv * C.VS[ex[4 * q + 3]]};
            up[q] = (f32x4){hs * C.US[ex[4 * q]], hs * C.US[ex[4 * q + 1]], hs * C.US[ex[4 * q + 2]], hs * C.US[ex[4 * q + 3]]};
            ap[q] = (v4u){0u, 0u, 0u, 0u}; }
    }
}

__device__ __forceinline__ int peer_dequeue(const Ctx& C, unsigned* cnt, int xcc) {
    volatile LAS int* slot = (volatile LAS int*)(C.lds + MISC_OFF + 64);
    __syncthreads();
    if (C.tid == 0) { int res = -1;
        for (int s = 0; s < NSL; ++s) { const int sl = (xcc + s) & (NSL - 1);
            if (__hip_atomic_load(cnt + 64 * sl, __ATOMIC_RELAXED, __HIP_MEMORY_SCOPE_AGENT) >= (unsigned)NCHUNK) continue;
            const unsigned id = atomicAdd(cnt + 64 * sl, 1u); if (id < (unsigned)NCHUNK) { res = sl * NCHUNK + (int)id; break; } }
        *slot = res; }
    __syncthreads();
    return *slot;
}
#define ROWSUM16(d) do { d += __builtin_amdgcn_update_dpp(0, d, 0x121, 0xf, 0xf, false); d += __builtin_amdgcn_update_dpp(0, d, 0x122, 0xf, 0xf, false); \
                         d += __builtin_amdgcn_update_dpp(0, d, 0x124, 0xf, 0xf, false); d += __builtin_amdgcn_update_dpp(0, d, 0x128, 0xf, 0xf, false); } while (0)
#define PA_ISSUE1(buf, esrc, j_) buf[j_] = *(const v4u*)(tab + (size_t)__builtin_amdgcn_ds_swizzle(esrc, ((j_) << 5) | 0x10) * SLW)
#define PA_ISSUE(buf, esrc) do { PA_ISSUE1(buf, esrc, 0); PA_ISSUE1(buf, esrc, 1); PA_ISSUE1(buf, esrc, 2); PA_ISSUE1(buf, esrc, 3); PA_ISSUE1(buf, esrc, 4); PA_ISSUE1(buf, esrc, 5); PA_ISSUE1(buf, esrc, 6); PA_ISSUE1(buf, esrc, 7); \
        PA_ISSUE1(buf, esrc, 8); PA_ISSUE1(buf, esrc, 9); PA_ISSUE1(buf, esrc, 10); PA_ISSUE1(buf, esrc, 11); PA_ISSUE1(buf, esrc, 12); PA_ISSUE1(buf, esrc, 13); PA_ISSUE1(buf, esrc, 14); PA_ISSUE1(buf, esrc, 15); } while (0)
#define PA_COMPUTE(buf, hq_, dstv) do { _Pragma("unroll") for (int j_ = 0; j_ < 16; ++j_) { const v4u u_ = buf[j_]; \
        int d_ = __builtin_amdgcn_sdot4((int)hq_.x, (int)u_.x, 0, false); d_ = __builtin_amdgcn_sdot4((int)hq_.y, (int)u_.y, d_, false); d_ = __builtin_amdgcn_sdot4((int)hq_.z, (int)u_.z, d_, false); d_ = __builtin_amdgcn_sdot4((int)hq_.w, (int)u_.w, d_, false); \
        ROWSUM16(d_); dstv = (i == j_) ? d_ : dstv; } } while (0)
__device__ __forceinline__ void peer_a_chunk(const Ctx& C, int t0, int x, int* act) {
    const int lane = C.lane, i = lane & 15;
    v4u hq[8]; int el[8], eh[8];
#pragma unroll
    for (int tt = 0; tt < 8; ++tt) { hq[tt] = __builtin_nontemporal_load((const v4u*)(C.HQ + ((size_t)x * T + t0 + tt) * SLW + 16 * i)); el[tt] = __builtin_nontemporal_load(C.EXPI + (size_t)(t0 + tt) * 128 + lane); eh[tt] = __builtin_nontemporal_load(C.EXPI + (size_t)(t0 + tt) * 128 + 64 + lane); }
    const unsigned char* tab = C.UQ + (size_t)x * NEXP * SLW + 16 * i;
    v4u bA[16], bB[16];
    PA_ISSUE(bA, el[0]);
#pragma unroll
    for (int tt = 0; tt < 8; ++tt) {
        PA_ISSUE(bB, eh[tt]);
        int r_lo = 0, r_hi = 0;
        PA_COMPUTE(bA, hq[tt], r_lo);
        if (tt + 1 < 8) PA_ISSUE(bA, el[tt + 1]);
        PA_COMPUTE(bB, hq[tt], r_hi);
        atomicAdd(act + (size_t)(t0 + tt) * 128 + lane, r_lo); atomicAdd(act + (size_t)(t0 + tt) * 128 + 64 + lane, r_hi);
    }
}
#undef PA_ISSUE
#undef PA_ISSUE1
#undef PA_COMPUTE
__device__ __forceinline__ void peer_weights_token(const Ctx& C, size_t t) {
    const int lane = C.lane; const size_t o = t * 128 + lane;
    const float a_lo = (float)C.ACT[o] * C.GU[o], a_hi = (float)C.ACT[o + 64] * C.GU[o + 64];
    const float w_lo = C.GATE[o] * 0.5f * a_lo * (1.f + erff(a_lo * 0.70710678118654752f)), w_hi = C.GATE[o + 64] * 0.5f * a_hi * (1.f + erff(a_hi * 0.70710678118654752f));
    const float wm = wave_max(fmaxf(fabsf(w_lo), fabsf(w_hi))), winv = wm > 0.f ? 127.f / wm : 0.f;
    unsigned p_lo = (unsigned)((int)rintf(w_lo * winv) & 0xff), p_hi = (unsigned)((int)rintf(w_hi * winv) & 0xff);
    p_lo |= (unsigned)__builtin_amdgcn_update_dpp(0, (int)p_lo, 0xB1, 0xf, 0xf, false) << 8; p_lo |= (unsigned)__builtin_amdgcn_update_dpp(0, (int)p_lo, 0x4E, 0xf, 0xf, false) << 16;
    p_hi |= (unsigned)__builtin_amdgcn_update_dpp(0, (int)p_hi, 0xB1, 0xf, 0xf, false) << 8; p_hi |= (unsigned)__builtin_amdgcn_update_dpp(0, (int)p_hi, 0x4E, 0xf, 0xf, false) << 16;
    if ((lane & 3) == 0) { C.PW[t * 32 + (lane >> 2)] = p_lo; C.PW[t * 32 + 16 + (lane >> 2)] = p_hi; }
    if (lane == 0) C.WSC[t] = wm * (1.f / 127.f);
}
#define PB_ISSUE(buf, esrc) do { _Pragma("unroll") for (int j_ = 0; j_ < 16; ++j_) { const int e_ = __builtin_amdgcn_ds_bpermute(4 * (16 * (j_ >> 2) + 4 * g + (j_ & 3)), esrc); buf[j_] = *(const v4u*)(tab + (size_t)e_ * SLW); } } while (0)
#define PB_TR4(r0_, r1_, r2_, r3_, wp_, base) do { const unsigned t0_ = __builtin_amdgcn_perm(r1_, r0_, 0x05010400u), t1_ = __builtin_amdgcn_perm(r1_, r0_, 0x07030602u), t2_ = __builtin_amdgcn_perm(r3_, r2_, 0x05010400u), t3_ = __builtin_amdgcn_perm(r3_, r2_, 0x07030602u); \
        c[(base)] = __builtin_amdgcn_sdot4((int)__builtin_amdgcn_perm(t2_, t0_, 0x05040100u), wp_, c[(base)], false); c[(base) + 1] = __builtin_amdgcn_sdot4((int)__builtin_amdgcn_perm(t2_, t0_, 0x07060302u), wp_, c[(base) + 1], false); \
        c[(base) + 2] = __builtin_amdgcn_sdot4((int)__builtin_amdgcn_perm(t3_, t1_, 0x05040100u), wp_, c[(base) + 2], false); c[(base) + 3] = __builtin_amdgcn_sdot4((int)__builtin_amdgcn_perm(t3_, t1_, 0x07060302u), wp_, c[(base) + 3], false); } while (0)
#define PB_COMPUTE(buf, psrc) do { _Pragma("unroll") for (int jb_ = 0; jb_ < 4; ++jb_) { const int wp_ = __builtin_amdgcn_ds_bpermute(4 * (16 * jb_ + 4 * g), (int)psrc); \
        PB_TR4(buf[4 * jb_].x, buf[4 * jb_ + 1].x, buf[4 * jb_ + 2].x, buf[4 * jb_ + 3].x, wp_, 0); PB_TR4(buf[4 * jb_].y, buf[4 * jb_ + 1].y, buf[4 * jb_ + 2].y, buf[4 * jb_ + 3].y, wp_, 4); \
        PB_TR4(buf[4 * jb_].z, buf[4 * jb_ + 1].z, buf[4 * jb_ + 2].z, buf[4 * jb_ + 3].z, wp_, 8); PB_TR4(buf[4 * jb_].w, buf[4 * jb_ + 1].w, buf[4 * jb_ + 2].w, buf[4 * jb_ + 3].w, wp_, 12); } } while (0)
__device__ __forceinline__ int isum_swap16(int v) { auto r = __builtin_amdgcn_permlane16_swap((unsigned)v, (unsigned)v, false, false); return (int)r[0] + (int)r[1]; }
__device__ __forceinline__ int isum_swap32(int v) { auto r = __builtin_amdgcn_permlane32_swap((unsigned)v, (unsigned)v, false, false); return (int)r[0] + (int)r[1]; }
__device__ __forceinline__ void peer_b_chunk(const Ctx& C, int t0, int x, float* dst) {
    const int lane = C.lane, i = lane & 15, g = lane >> 4, b = t0 / SEQ;
    int el[8], eh[8]; unsigned pl[8], ph[8]; float ws[8];
#pragma unroll
    for (int tt = 0; tt < 8; ++tt) { const size_t o = (size_t)(t0 + tt) * 128 + lane;
        el[tt] = __builtin_nontemporal_load(C.EXPI + o); eh[tt] = __builtin_nontemporal_load(C.EXPI + o + 64);
        const unsigned p_lo = C.PW[(size_t)(t0 + tt) * 32 + (lane >> 2)], p_hi = C.PW[(size_t)(t0 + tt) * 32 + 16 + (lane >> 2)]; ws[tt] = C.WSC[t0 + tt];
        pl[tt] = p_lo; ph[tt] = p_hi; }
    const unsigned char* tab = C.VQ + (size_t)x * NEXP * SLW + 16 * i;
    const int d0 = x * SLW + 16 * i + 4 * g; const f32x4 gm = *(const f32x4*)(C.MOD + b * NMOD + 5 * D + d0);
    v4u bA[16], bB[16];
    PB_ISSUE(bA, el[0]);
#pragma unroll
    for (int tt = 0; tt < 8; ++tt) {
        PB_ISSUE(bB, eh[tt]);
        const size_t off = (size_t)(t0 + tt) * D + d0; const f32x4 x1 = __builtin_nontemporal_load((const f32x4*)(C.out + off));
        int c[16];
#pragma unroll
        for (int q = 0; q < 16; ++q) c[q] = 0;
        PB_COMPUTE(bA, pl[tt]);
        if (tt + 1 < 8) PB_ISSUE(bA, el[tt + 1]);
        PB_COMPUTE(bB, ph[tt]);
#pragma unroll
        for (int q = 0; q < 16; ++q) c[q] = isum_swap32(isum_swap16(c[q]));
        f32x4 o;
#pragma unroll
        for (int q = 0; q < 4; ++q) o[q] = (float)(g == 0 ? c[q] : g == 1 ? c[4 + q] : g == 2 ? c[8 + q] : c[12 + q]) * ws[tt];
        __builtin_nontemporal_store(x1 + gm * o, (f32x4*)(dst + off));
    }
}
#undef PB_ISSUE
#undef PB_COMPUTE
#undef PB_TR4
template <int STAGE> __device__ __forceinline__ void peer_expert_phase(const Ctx& C, float* dst, int rep) {
    const int xcc = (int)(xb_xcc_id() & (NSL - 1)); unsigned* cnt = C.ctl + (STAGE == 0 ? CW_QA : CW_QB) + 64 * NSL * rep;
    for (;;) {
        const int id = peer_dequeue(C, cnt, xcc); if (id < 0) break;
        const int x = id / NCHUNK, t0 = (id % NCHUNK) * PCH + C.wave * (PCH / NWAVES);
        for (int sub = 0; sub < PCH / NWAVES; sub += 8) { if (STAGE == 0) peer_a_chunk(C, t0 + sub, x, rep ? (int*)C.QP : C.ACT); else peer_b_chunk(C, t0 + sub, x, dst); }
    }
}

__device__ __forceinline__ void first_unit(int nM, int nN, int G, int c, int& pm, int& pn) {
    const int nwg = nM * nN; if (c >= nwg) { pm = -1; pn = 0; return; }
    int wgid = c; { const int q = nwg / 8, r = nwg % 8, xcd = wgid % 8, off = wgid / 8; wgid = (xcd < r ? xcd * (q + 1) : r * (q + 1) + (xcd - r) * q) + off; }
    const int nig = 8 * nN, gid = wgid / nig, fm = gid * 8, gsz = (nM - fm) < 8 ? (nM - fm) : 8;
    pm = fm + ((wgid % nig) % gsz); pn = (wgid % nig) / gsz; (void)G;
}
struct Args { const void* in[18]; float* out; unsigned char* ws; int ph_lo, ph_hi; };
__global__ void __launch_bounds__(NTHREADS, 2) fwd_kernel(Args args) {
    extern __shared__ __attribute__((aligned(16))) unsigned char lds[];
    Ctx C;
    C.lds = (LAS unsigned char*)lds; C.tid = threadIdx.x; C.lane = C.tid & 63; C.wave = __builtin_amdgcn_readfirstlane(C.tid >> 6);
    C.G = gridDim.x; { const int bx = blockIdx.x; C.vcu = (C.G % 8 == 0) ? (bx % 8) * (C.G / 8) + bx / 8 : bx; }
    C.gw = C.vcu * NWAVES + C.wave; C.ngw = C.G * NWAVES;
    C.x = (const float*)args.in[0]; C.c = (const float*)args.in[1]; C.pos = (const int*)args.in[2]; C.w_ada = (const float*)args.in[3]; C.b_ada = (const float*)args.in[4]; C.g1 = (const float*)args.in[5];
    C.w_in = (const float*)args.in[6]; C.w_a2 = (const float*)args.in[7]; C.b_a = (const float*)args.in[8]; C.gla_g = (const float*)args.in[9]; C.qg = (const float*)args.in[10]; C.kg = (const float*)args.in[11];
    C.w_out = (const float*)args.in[12]; C.g2 = (const float*)args.in[13]; C.w_q = (const float*)args.in[14]; C.keys = (const float*)args.in[15]; C.pu = (const float*)args.in[16]; C.pv = (const float*)args.in[17];
    C.out = args.out; unsigned char* ws = args.ws;
#define CTX_WS_PTRS() do { C.ctl = (unsigned*)(ws + WS_CTL); C.MODI = (long long*)(C.ctl + CW_MOD); C.MOD = (float*)(ws + WS_MODF); C.WIN = (bf16*)(ws + WS_WIN); C.WGA = (bf16*)(ws + WS_WGA); C.WOUT = (bf16*)(ws + WS_WOUT); C.WQ = (bf16*)(ws + WS_WQ); C.KEYSB = (bf16*)(ws + WS_KEYS); C.UQ = ws + WS_UB; C.VQ = ws + WS_VB; C.HQ = ws + WS_HQ; C.WINQ = ws + WS_WIN; C.WQQ = ws + WS_WQ; C.WINS = (float*)(ws + WS_WINS); C.WQS = (float*)(ws + WS_WQS); C.US = (float*)(ws + WS_US); C.VS = (float*)(ws + WS_VS); C.HS = (float*)(ws + WS_HS); C.GU = (float*)(ws + WS_GU); C.PW = (unsigned*)(ws + WS_PW); C.WSC = (float*)(ws + WS_WSC); C.ACT = (int*)(ws + WS_ACT); C.QDEC = (bf16*)(ws + WS_QDEC); C.KDEC = (bf16*)(ws + WS_KDEC); C.KUPD = (bf16*)(ws + WS_KUPD); C.PART = (bf16*)(ws + WS_PART); C.ML = (float*)(ws + WS_ML); C.LIST = (unsigned short*)(ws + WS_LIST); C.SEL = (unsigned short*)(ws + WS_SEL); C.H = (bf16*)(ws + WS_H); C.CONCAT = (bf16*)(ws + WS_CONCAT); C.PROJ = (bf16*)(ws + WS_PROJ); C.ST = (bf16*)(ws + WS_ST); C.CS = (float*)(ws + WS_CS); C.KMEAN = (float*)(ws + WS_KMEAN); C.DEC = (float*)(ws + WS_DEC); C.BCUM = (float*)(ws + WS_BCUM); C.UT = (float*)(ws + WS_UT); C.QP = (float*)(ws + WS_QP); C.GATE = (float*)(ws + WS_GATE); C.EXPI = (int*)(ws + WS_EXP); } while (0)
    CTX_WS_PTRS();
    for (int u = C.tid; u < (LDS_BYTES - RING_BYTES) / 4; u += NTHREADS) ((LAS unsigned*)(C.lds + RING_BYTES))[u] = 0u;
    __syncthreads();
    const int lo = args.ph_lo, hi = args.ph_hi;
    if (PROBE_TS >= 0 && blockIdx.x == 0 && threadIdx.x == 0) ((volatile LAS unsigned long long*)(C.lds + RING_BYTES + 8192))[0] = __builtin_amdgcn_s_memrealtime();
    XcdBarrier bar; bar.bar = C.ctl + CW_BAR; bar.x = 0; bar.st = nullptr;
    if (hi - lo > 1) bar = xcd_barrier_post(C.ctl + CW_BAR, (volatile LAS unsigned*)(C.lds + MISC_OFF) + 8);
#ifndef SKIPMASK
#define SKIPMASK 0
#endif
#ifndef REPEATMASK
#define REPEATMASK 0
#endif
#define IN(k) (!((SKIPMASK >> (k)) & 1) && lo <= (k) && (k) < hi)
#define REP(k, ...) do { if ((REPEATMASK >> (k)) & 1) { const int rep_ = 1; (void)rep_; __VA_ARGS__; xcd_barrier(bar); } { const int rep_ = 0; (void)rep_; __VA_ARGS__; } } while (0)
#define SEAM(k) do { if (IN(k) && IN((k) + 1)) xcd_barrier(bar); if (PROBE_TS >= 0 && blockIdx.x == 0 && threadIdx.x == 0) ((volatile LAS unsigned long long*)(C.lds + RING_BYTES + 8192))[(k) + 1] = __builtin_amdgcn_s_memrealtime(); { int t_ = C.tid; asm volatile("" : "+v"(t_)); C.tid = t_; C.lane = t_ & 63; } CTX_WS_PTRS(); } while (0)
    if (IN(0)) REP(0, p0_phase(C, rep_)); SEAM(0);
    if (IN(1)) REP(1, norm_mod_phase<true>(C, C.x, C.g1, 0, D, C.H)); SEAM(1);
    if (IN(2)) REP(2, pg8::Gemm g{(const bf16*)C.HQ, (const bf16*)C.WINQ, T, NPROJ, D / 2, 256, (size_t)T * 256}; pg8::StaticOrder S; S.init(T, NPROJ, C.G, (int)blockIdx.x); pg8::EpiBf16Q E{C.PROJ, NPROJ, C.HS, C.WINS};
                 pg8::gemm_phase<pg8::EpiBf16Q, pg8::StaticOrder, PG8_ALIGN, PG8_SP2>(C.lds, g, S, E)); SEAM(2);
    if (IN(3)) REP(3, for (int it = C.vcu; it < 256 + 256; it += C.G) { if (it < 256) moba_prep_item(C, it >> 7, (it >> 4) & 7, it & 15, rep_); else gla_prep_item(C, (it - 256) >> 7, ((it - 256) >> 1) & 63, it & 1); }); SEAM(3);
    if (IN(4)) REP(4, for (int it = C.vcu; it < 256 + 256; it += C.G) { if (it < 256) moba_select_item(C, it >> 7, (it >> 4) & 7, it & 15, rep_); else { const int g_ = it - 256; gla_u_item(C, g_ >> 7, (g_ >> 4) & 7, g_ & 15); } }); SEAM(4);
    if (IN(5)) REP(5, p5_attn_phase(C, rep_)); SEAM(5);
    if (IN(6)) REP(6, for (int it = C.vcu; it < 1024; it += C.G) gla_out_item(C, it >> 9, (it >> 6) & 7, it & 63); for (int t = C.gw; t < T; t += C.ngw) moba_merge_token(C, (size_t)t)); SEAM(6);
    if (IN(7)) REP(7, pg8::Gemm g{C.CONCAT, C.WOUT, T, D, D}; pg8::StaticOrder S; S.init(T, D, C.G, (int)blockIdx.x); pg8::EpiResGate E{C.x, C.out, D, C.MOD + 2 * D, NMOD, SEQ / 256};
                 pg8::gemm_phase<pg8::EpiResGate, pg8::StaticOrder, PG8_ALIGN, PG8_SP2>(C.lds, g, S, E)); SEAM(7);
    if (IN(8)) REP(8, norm_mod_phase<false>(C, C.out, C.g2, 3 * D, 4 * D, C.H)); SEAM(8);
    if (IN(9)) REP(9, int upm_ = -1; int upn_ = 0; first_unit(T / 256, D / 256, C.G, (int)blockIdx.x, upm_, upn_);
                 { pg8::Gemm g{(const bf16*)C.HQ, (const bf16*)C.WQQ, T, D, D / 2, 256, (size_t)T * 256}; pg8::StaticOrder S; S.init(T, D, C.G, (int)blockIdx.x); pg8::EpiLdsTileQ E{C.HS, C.WQS}; pg8::gemm_phase<pg8::EpiLdsTileQ, pg8::StaticOrder, false, PG8_SP2>(C.lds, g, S, E); }
                 __syncthreads(); if (upm_ >= 0) peer_topk_item(C, upm_ * 8 + C.wave, upn_, C.lds, 32 * C.wave); __syncthreads()); SEAM(9);
    if (IN(10)) REP(10, peer_expert_phase<0>(C, nullptr, rep_)); SEAM(10);
    if (IN(11)) REP(11, for (int t = C.gw; t < T; t += C.ngw) peer_weights_token(C, (size_t)t)); SEAM(11);
    if (IN(12)) REP(12, peer_expert_phase<1>(C, rep_ ? C.QP : C.out, rep_));
    if (PROBE_TS >= 0) { xcd_barrier(bar); if (blockIdx.x == 0 && threadIdx.x == 0) { volatile LAS unsigned long long* ts = (volatile LAS unsigned long long*)(C.lds + RING_BYTES + 8192); const unsigned long long tend = __builtin_amdgcn_s_memrealtime();
        const unsigned long long d = (PROBE_TS == 12 ? tend : ts[PROBE_TS + 1]) - ts[PROBE_TS]; C.out[0] += (float)d * 0.001f; } }
#undef IN
#undef SEAM
}

extern "C" void kernel_launch(void* const* d_in, const int* in_sizes, int n_in, void* d_out, int out_size, void* d_ws, size_t ws_size, hipStream_t stream) {
    static int grid = 0;
    if (grid == 0) {
        if (n_in != 18 || in_sizes[0] != T * D || out_size != T * D || ws_size < WS_END) { fprintf(stderr, "kernel_launch: shape/workspace mismatch (n_in %d, in0 %d, out %d, ws %zu, need %zu); nothing launched\n", n_in, n_in > 0 ? in_sizes[0] : -1, out_size, ws_size, (size_t)WS_END); grid = -1; return; }
        int dev = 0, cus = 0, per_cu = 0;
        if (hipGetDevice(&dev) != hipSuccess || hipDeviceGetAttribute(&cus, hipDeviceAttributeMultiprocessorCount, dev) != hipSuccess) { fprintf(stderr, "kernel_launch: device query failed\n"); grid = -1; return; }
        if (hipFuncSetAttribute((const void*)fwd_kernel, hipFuncAttributeMaxDynamicSharedMemorySize, LDS_BYTES) != hipSuccess) { fprintf(stderr, "kernel_launch: hipFuncSetAttribute failed\n"); grid = -1; return; }
        if (hipOccupancyMaxActiveBlocksPerMultiprocessor(&per_cu, (const void*)fwd_kernel, NTHREADS, LDS_BYTES) != hipSuccess || per_cu < 1) { fprintf(stderr, "kernel_launch: occupancy query reports %d workgroups per CU\n", per_cu); (void)hipGetLastError(); grid = -1; return; }
        grid = cus;
    }
    if (grid < 0) return;
    if (hipMemsetAsync((char*)d_ws + WS_CTL, 0, CTL_ZERO_BYTES, stream) != hipSuccess) { fprintf(stderr, "kernel_launch: memset failed\n"); return; }
    Args a{};
    for (int i = 0; i < 18; ++i) a.in[i] = d_in[i];
    a.out = (float*)d_out; a.ws = (unsigned char*)d_ws;
#if MK_N_LAUNCHES == 1
    a.ph_lo = 0; a.ph_hi = N_PHASES;
    void* kargs[] = {&a};
#if defined(MK_PLAIN_LAUNCH)
    (void)kargs; hipLaunchKernelGGL(fwd_kernel, dim3(grid), dim3(NTHREADS), LDS_BYTES, stream, a);
#else
    hipError_t le = hipLaunchCooperativeKernel((const void*)fwd_kernel, dim3(grid), dim3(NTHREADS), kargs, LDS_BYTES, stream);
    if (le != hipSuccess) fprintf(stderr, "kernel_launch: cooperative launch failed: %s (grid %d)\n", hipGetErrorName(le), grid);
#endif
#else
    for (int p = 0; p < N_PHASES; ++p) { a.ph_lo = p; a.ph_hi = p + 1; hipLaunchKernelGGL(fwd_kernel, dim3(grid), dim3(NTHREADS), LDS_BYTES, stream, a); }
#endif
}
```

```cpp
#include <hip/hip_runtime.h>
#include <hip/hip_bf16.h>
#include <cstdio>
#include <cstdint>
#include <cmath>
namespace pg8 {
#define PG8_LAS __attribute__((address_space(3)))
typedef unsigned short bf16_t;
typedef short bf16x8 __attribute__((ext_vector_type(8)));
typedef float f32x4 __attribute__((ext_vector_type(4)));
typedef unsigned u32x4 __attribute__((ext_vector_type(4)));
constexpr int BM = 256, BK = 64, HALF = 128, HTB = HALF * BK * 2  , STAGE_BYTES = 8 * HTB, NXCD = 8, WGM = 8;

__host__ __device__ __forceinline__ int lds_byte(int r, int c) { const int st = (r >> 4) * 2 + (c >> 5), rr = r & 15, cc = c & 31, ob = rr * 64 + cc * 2; return st * 1024 + (ob ^ (((ob >> 9) & 1) << 5)); }
__host__ __device__ __forceinline__ void stage_rc(int b, int& R, int& C) { const int st = b / 1024, sb = b % 1024, swz = sb ^ (((sb >> 9) & 1) << 5); R = (st >> 1) * 16 + swz / 64; C = (st & 1) * 32 + (swz % 64) / 2; }
__host__ __device__ __forceinline__ int perm32(int rho) { const int n = rho >> 4, i = rho & 15; return 8 * (i >> 2) + 4 * n + (i & 3); }

struct Unit { int pm, pn; };
struct Gemm { const bf16_t* A; const bf16_t* Bt; int M, N, K; int a_pitch; size_t a_pair; };

struct StaticOrder {
    int nM, nN, nwg, G, c;
    __host__ __device__ void init(int M, int N, int G_, int c_) { nM = M / BM; nN = N / BM; nwg = nM * nN; G = G_; c = c_; }
    __host__ __device__ bool next(int i, Unit& u) const {
        const long L = (long)i * G + c; if (L >= nwg) return false;
        int wgid = (int)L; { const int q = nwg / NXCD, r = nwg % NXCD, xcd = wgid % NXCD, off = wgid / NXCD; wgid = (xcd < r ? xcd * (q + 1) : r * (q + 1) + (xcd - r) * q) + off; }
        const int nig = WGM * nN, gid = wgid / nig, fm = gid * WGM, gsz = (nM - fm) < WGM ? (nM - fm) : WGM;
        u.pm = fm + ((wgid % nig) % gsz); u.pn = (wgid % nig) / gsz; return true;
    }
    __device__ __forceinline__ void a_ready(const Unit&) const {}
    __device__ __forceinline__ void done(const Unit&) const {}
};

__device__ __forceinline__ unsigned cvt_pk_bf16(float lo, float hi) { unsigned r; asm volatile("v_cvt_pk_bf16_f32 %0, %1, %2" : "=v"(r) : "v"(lo), "v"(hi)); return r; }
typedef float f32x2 __attribute__((ext_vector_type(2)));
__device__ __forceinline__ f32x2 gelu_pk(f32x2 v) {
    const f32x2 av = __builtin_elementwise_abs(v), d = av * 0.2316418882f + 1.0f;
    f32x2 t; t.x = __builtin_amdgcn_rcpf(d.x); t.y = __builtin_amdgcn_rcpf(d.y);
    f32x2 q = t * 0.5307027145f + (-0.7265760135f); q = q * t + 0.7107068705f; q = q * t + (-0.142248368f); q = q * t + 0.127414796f; q = q * t;
    const f32x2 s = (v * v) * (-0.72134752044f);
    f32x2 e; e.x = __builtin_amdgcn_exp2f(s.x); e.y = __builtin_amdgcn_exp2f(s.y);
    const f32x2 m = v * (q * e), r = v - m;
    f32x2 o; o.x = v.x < 0.f ? m.x : r.x; o.y = v.y < 0.f ? m.y : r.y; return o;
}

template <int ACT  > struct EpiBf16 {
    static constexpr bool PERM = true, AFTER_DRAIN = false, I8 = false; static_assert(ACT == 0 || ACT == 1, "EpiBf16: ACT is 0 (none) or 1 (gelu_pk)");
    bf16_t* O; int ldc; const float* bias; int split_cols; size_t split_stride; float scale0;
    __device__ __forceinline__ void operator()(const f32x4 (&acc)[2][2][4][2], const Unit& u, int wr, int wc, int fr, int fq) const {
        const int row0 = u.pm * BM + wr * 64 + fr; int colt = u.pn * BM; bf16_t* base = O;
        float sc = 1.f; if (split_cols) { const int t = colt / split_cols; base += (size_t)t * split_stride; colt -= t * split_cols; if (t == 0) sc = scale0; }
        const int col0 = colt + wc * 32 + 8 * fq, bcol0 = u.pn * BM + wc * 32 + 8 * fq;
        f32x4 bv[2][2];
#pragma unroll
        for (int bj = 0; bj < 2; ++bj)
#pragma unroll
            for (int n = 0; n < 2; ++n) bv[bj][n] = bias ? *(const f32x4*)(bias + bcol0 + bj * HALF + 4 * n) : (f32x4){0.f, 0.f, 0.f, 0.f};
#pragma unroll
        for (int ai = 0; ai < 2; ++ai)
#pragma unroll
            for (int m = 0; m < 4; ++m) { bf16_t* rowp = base + (size_t)(row0 + ai * HALF + m * 16) * ldc + col0;
#pragma unroll
                for (int bj = 0; bj < 2; ++bj) { f32x4 v0 = acc[ai][bj][m][0] + bv[bj][0], v1 = acc[ai][bj][m][1] + bv[bj][1];
                    if (ACT == 1) { f32x2 a = gelu_pk((f32x2){v0[0], v0[1]}), b = gelu_pk((f32x2){v0[2], v0[3]}), c = gelu_pk((f32x2){v1[0], v1[1]}), d = gelu_pk((f32x2){v1[2], v1[3]});
                        v0 = (f32x4){a.x, a.y, b.x, b.y}; v1 = (f32x4){c.x, c.y, d.x, d.y}; }
                    v0 = v0 * sc; v1 = v1 * sc; u32x4 w; w.x = cvt_pk_bf16(v0[0], v0[1]); w.y = cvt_pk_bf16(v0[2], v0[3]); w.z = cvt_pk_bf16(v1[0], v1[1]); w.w = cvt_pk_bf16(v1[2], v1[3]);
                    *(u32x4*)(rowp + bj * HALF) = w; } }
    }
};

typedef int i32x4 __attribute__((ext_vector_type(4)));
struct EpiBf16Q {
    static constexpr bool PERM = true, AFTER_DRAIN = false, I8 = true;
    bf16_t* O; int ldc; const float* rs; const float* cs;
    __device__ __forceinline__ void operator()(const f32x4 (&acc)[2][2][4][2], const Unit& u, int wr, int wc, int fr, int fq) const {
        const int row0 = u.pm * BM + wr * 64 + fr, col0 = u.pn * BM + wc * 32 + 8 * fq;
        f32x4 cv[2][2];
#pragma unroll
        for (int bj = 0; bj < 2; ++bj)
#pragma unroll
            for (int n = 0; n < 2; ++n) cv[bj][n] = *(const f32x4*)(cs + col0 + bj * HALF + 4 * n);
        float rv[8];
#pragma unroll
        for (int i = 0; i < 8; ++i) rv[i] = rs[row0 + (i >> 2) * HALF + (i & 3) * 16];
#pragma unroll
        for (int ai = 0; ai < 2; ++ai)
#pragma unroll
            for (int m = 0; m < 4; ++m) { bf16_t* rowp = O + (size_t)(row0 + ai * HALF + m * 16) * ldc + col0; const float s = rv[ai * 4 + m];
#pragma unroll
                for (int bj = 0; bj < 2; ++bj) { const f32x4 v0 = __builtin_convertvector(__builtin_bit_cast(i32x4, acc[ai][bj][m][0]), f32x4) * s * cv[bj][0], v1 = __builtin_convertvector(__builtin_bit_cast(i32x4, acc[ai][bj][m][1]), f32x4) * s * cv[bj][1];
                    u32x4 w; w.x = cvt_pk_bf16(v0[0], v0[1]); w.y = cvt_pk_bf16(v0[2], v0[3]); w.z = cvt_pk_bf16(v1[0], v1[1]); w.w = cvt_pk_bf16(v1[2], v1[3]);
                    *(u32x4*)(rowp + bj * HALF) = w; } }
    }
};
struct EpiF32 {
    static constexpr bool PERM = false, AFTER_DRAIN = false, I8 = false;
    float* C; int ldc; const float* bias;
    __device__ __forceinline__ void operator()(const f32x4 (&acc)[2][2][4][2], const Unit& u, int wr, int wc, int fr, int fq) const {
        const int row0 = u.pm * BM + wr * 64 + fr, col0 = u.pn * BM + wc * 32 + 4 * fq;
        f32x4 bv[2][2];
#pragma unroll
        for (int bj = 0; bj < 2; ++bj)
#pragma unroll
            for (int n = 0; n < 2; ++n) bv[bj][n] = bias ? *(const f32x4*)(bias + col0 + bj * HALF + n * 16) : (f32x4){0.f, 0.f, 0.f, 0.f};
#pragma unroll
        for (int ai = 0; ai < 2; ++ai)
#pragma unroll
            for (int m = 0; m < 4; ++m) { float* rowp = C + (size_t)(row0 + ai * HALF + m * 16) * ldc + col0;
#pragma unroll
                for (int bj = 0; bj < 2; ++bj)
#pragma unroll
                    for (int n = 0; n < 2; ++n) *(f32x4*)(rowp + bj * HALF + n * 16) = acc[ai][bj][m][n] + bv[bj][n]; }
    }
};
struct EpiResGate {
    static constexpr bool PERM = true, AFTER_DRAIN = false, I8 = false;
    const float* X; bf16_t* O; int ldc; const float* gate; int gate_stride, tiles_per_batch;
    __device__ __forceinline__ void operator()(const f32x4 (&acc)[2][2][4][2], const Unit& u, int wr, int wc, int fr, int fq) const {
        const int row0 = u.pm * BM + wr * 64 + fr, col0 = u.pn * BM + wc * 32 + 8 * fq;
        const float* gp = gate + (size_t)(u.pm / tiles_per_batch) * gate_stride;
        f32x4 gv[2][2];
#pragma unroll
        for (int bj = 0; bj < 2; ++bj)
#pragma unroll
            for (int n = 0; n < 2; ++n) gv[bj][n] = *(const f32x4*)(gp + col0 + bj * HALF + n * 4);
        f32x4 xv[2][2][2];
#define ERG_LOAD(idx, slot) do { const size_t off_ = (size_t)(row0 + ((idx) >> 2) * HALF + ((idx) & 3) * 16) * ldc + col0; _Pragma("unroll") for (int bj = 0; bj < 2; ++bj) _Pragma("unroll") for (int n = 0; n < 2; ++n) xv[slot][bj][n] = *(const f32x4*)(X + off_ + bj * HALF + n * 4); } while (0)
        ERG_LOAD(0, 0); ERG_LOAD(1, 1);
#pragma unroll
        for (int idx = 0; idx < 8; ++idx) { const int ai = idx >> 2, m = idx & 3; const size_t off = (size_t)(row0 + ai * HALF + m * 16) * ldc + col0;
#pragma unroll
            for (int bj = 0; bj < 2; ++bj) { const f32x4 y0 = xv[idx & 1][bj][0] + gv[bj][0] * acc[ai][bj][m][0], y1 = xv[idx & 1][bj][1] + gv[bj][1] * acc[ai][bj][m][1];
                u32x4 wv; wv.x = cvt_pk_bf16(y0[0], y0[1]); wv.y = cvt_pk_bf16(y0[2], y0[3]); wv.z = cvt_pk_bf16(y1[0], y1[1]); wv.w = cvt_pk_bf16(y1[2], y1[3]); *(u32x4*)(O + off + bj * HALF) = wv; }
            if (idx + 2 < 8) ERG_LOAD(idx + 2, idx & 1); }
#undef ERG_LOAD
    }
};

struct EpiLdsTile {
    static constexpr bool PERM = true, AFTER_DRAIN = true, I8 = false;
    __device__ __forceinline__ void operator()(const f32x4 (&)[2][2][4][2], const Unit&, int, int, int, int) const {}
    __device__ __forceinline__ void fused(f32x4 (&acc)[2][2][4][2], const Unit&, int wr, int wc, int fr, int fq, PG8_LAS unsigned char* lds, int, int) const {
#pragma unroll
        for (int ai = 0; ai < 2; ++ai)
#pragma unroll
            for (int m = 0; m < 4; ++m) { const int row = ai * HALF + wr * 64 + m * 16 + fr;
#pragma unroll
                for (int bj = 0; bj < 2; ++bj) { const f32x4 v0 = acc[ai][bj][m][0], v1 = acc[ai][bj][m][1]; u32x4 w; w.x = cvt_pk_bf16(v0[0], v0[1]); w.y = cvt_pk_bf16(v0[2], v0[3]); w.z = cvt_pk_bf16(v1[0], v1[1]); w.w = cvt_pk_bf16(v1[2], v1[3]);
                    const int chunk = 16 * bj + 4 * wc + fq; *(PG8_LAS u32x4*)(lds + row * 512 + 16 * (chunk ^ (row & 15))) = w; } }
    }
};

struct EpiLdsTileQ {
    static constexpr bool PERM = true, AFTER_DRAIN = true, I8 = true;
    const float* rs; const float* cs;
    __device__ __forceinline__ void operator()(const f32x4 (&)[2][2][4][2], const Unit&, int, int, int, int) const {}
    __device__ __forceinline__ void fused(f32x4 (&acc)[2][2][4][2], const Unit& u, int wr, int wc, int fr, int fq, PG8_LAS unsigned char* lds, int, int) const {
        f32x4 cv[2][2];
#pragma unroll
        for (int bj = 0; bj < 2; ++bj)
#pragma unroll
            for (int n = 0; n < 2; ++n) cv[bj][n] = *(const f32x4*)(cs + u.pn * BM + bj * HALF + wc * 32 + 8 * fq + 4 * n);
#pragma unroll
        for (int ai = 0; ai < 2; ++ai)
#pragma unroll
            for (int m = 0; m < 4; ++m) { const int row = ai * HALF + wr * 64 + m * 16 + fr; const float s = rs[u.pm * BM + row];
#pragma unroll
                for (int bj = 0; bj < 2; ++bj) { const f32x4 v0 = __builtin_convertvector(__builtin_bit_cast(i32x4, acc[ai][bj][m][0]), f32x4) * s * cv[bj][0], v1 = __builtin_convertvector(__builtin_bit_cast(i32x4, acc[ai][bj][m][1]), f32x4) * s * cv[bj][1];
                    u32x4 w; w.x = cvt_pk_bf16(v0[0], v0[1]); w.y = cvt_pk_bf16(v0[2], v0[3]); w.z = cvt_pk_bf16(v1[0], v1[1]); w.w = cvt_pk_bf16(v1[2], v1[3]);
                    const int chunk = 16 * bj + 4 * wc + fq; *(PG8_LAS u32x4*)(lds + row * 512 + 16 * (chunk ^ (row & 15))) = w; } }
    }
};

template <class Epi, class Sched, bool ALIGN_EPI = false, bool SP2 = false>
__device__ __forceinline__ void gemm_phase(PG8_LAS unsigned char* lds, const Gemm g, const Sched& S, const Epi& E) {
    const int tid = threadIdx.x, wid = __builtin_amdgcn_readfirstlane(tid >> 6), lane = tid & 63, wr = wid >> 2, wc = wid & 3, fr = lane & 15, fq = lane >> 4;
    const int K = g.K, nt = K / BK;
    const int apitch = g.a_pitch ? g.a_pitch : K * 2; const size_t apair = g.a_pair ? g.a_pair : (size_t)(BK * 4);
    unsigned voffA[2], voffB[2];
#pragma unroll
    for (int i = 0; i < 2; ++i) { int R, C; stage_rc(tid * 16 + i * 8192, R, C); const int Rb = Epi::PERM ? ((R & ~31) + perm32(R & 31)) : R;
        voffA[i] = (unsigned)R * (unsigned)apitch + (unsigned)C * 2u; voffB[i] = (unsigned)(Rb * K + C) * 2u; }
    const size_t kstep = (size_t)(BK * 2);
    const size_t hstepB = (size_t)HALF * K * 2, hstepA = (size_t)HALF * apitch;
    const size_t tstepB = 2 * hstepB, tstepA = 2 * hstepA;
    const unsigned ldsw = (unsigned)wid * 1024u;
    const int aoff = lds_byte(wr * 64 + fr, fq * 8), boff = lds_byte(wc * 32 + fr, fq * 8);
#define PG8_SA(b, h) (((b) * 2 + (h)) * HTB)
#define PG8_SB(b, h) ((4 + (b) * 2 + (h)) * HTB)
#define PG8_STAGE(bufoff, gbase, voff) do { _Pragma("unroll") for (int _i = 0; _i < 2; ++_i) \
        __builtin_amdgcn_global_load_lds((const unsigned*)((const char*)(gbase) + (voff)[_i]), (PG8_LAS unsigned*)(lds + (bufoff) + ldsw + _i * 8192), 16, 0, 0); } while (0)
#define PG8_LDA(dst, b, h) do { _Pragma("unroll") for (int m = 0; m < 4; ++m) _Pragma("unroll") for (int k = 0; k < 2; ++k) dst[m][k] = *(const PG8_LAS bf16x8*)(lds + PG8_SA(b, h) + aoff + m * 2048 + k * 1024); } while (0)
#define PG8_LDB(dst, b, h) do { _Pragma("unroll") for (int n = 0; n < 2; ++n) _Pragma("unroll") for (int k = 0; k < 2; ++k) dst[n][k] = *(const PG8_LAS bf16x8*)(lds + PG8_SB(b, h) + boff + n * 2048 + k * 1024); } while (0)
#define PG8_MMA(ai, bj, At, Bt) do { __builtin_amdgcn_s_setprio(1); _Pragma("unroll") for (int m = 0; m < 4; ++m) _Pragma("unroll") for (int n = 0; n < 2; ++n) _Pragma("unroll") for (int k = 0; k < 2; ++k) \
        { if constexpr (Epi::I8) acc[ai][bj][m][n] = __builtin_bit_cast(f32x4, __builtin_amdgcn_mfma_i32_16x16x64_i8(__builtin_bit_cast(i32x4, Bt[n][k]), __builtin_bit_cast(i32x4, At[m][k]), __builtin_bit_cast(i32x4, acc[ai][bj][m][n]), 0, 0, 0)); \
          else acc[ai][bj][m][n] = __builtin_amdgcn_mfma_f32_16x16x32_bf16(Bt[n][k], At[m][k], acc[ai][bj][m][n], 0, 0, 0); } __builtin_amdgcn_s_setprio(0); } while (0)
#define PG8_WAIT_V(n) asm volatile("s_waitcnt vmcnt(" #n ")" ::: "memory")
#define PG8_WAIT_L(n) asm volatile("s_waitcnt lgkmcnt(" #n ")" ::: "memory")
#define PG8_BAR __builtin_amdgcn_s_barrier()
#define PG8_SCHED __builtin_amdgcn_sched_barrier(0)
    Unit cur, nxt; int ui = 0;
    if (!S.next(0, cur)) return;
    f32x4 acc[2][2][4][2];
#pragma unroll
    for (int a = 0; a < 2; ++a)
#pragma unroll
        for (int b = 0; b < 2; ++b)
#pragma unroll
            for (int m = 0; m < 4; ++m)
#pragma unroll
                for (int n = 0; n < 2; ++n) acc[a][b][m][n] = (f32x4){0.f, 0.f, 0.f, 0.f};
    bf16x8 At[4][2], B0[2][2], B1[2][2];
    const char* cA = (const char*)g.A + (size_t)cur.pm * tstepA; const char* cB = (const char*)g.Bt + (size_t)cur.pn * tstepB;
    S.a_ready(cur);
    if constexpr (SP2) {
        PG8_STAGE(PG8_SB(0, 0), cB, voffB); PG8_STAGE(PG8_SB(0, 1), cB + hstepB, voffB); PG8_STAGE(PG8_SA(0, 0), cA, voffA); PG8_STAGE(PG8_SA(0, 1), cA + hstepA, voffA);
        if (wr == 1) PG8_BAR;
        PG8_WAIT_V(2); PG8_BAR;
        PG8_STAGE(PG8_SB(1, 0), cB + kstep, voffB); PG8_STAGE(PG8_SA(1, 0), cA + kstep, voffA); PG8_STAGE(PG8_SB(1, 1), cB + hstepB + kstep, voffB);
        PG8_WAIT_V(6); PG8_BAR;
    } else {
        PG8_STAGE(PG8_SB(0, 0), cB, voffB); PG8_STAGE(PG8_SA(0, 0), cA, voffA); PG8_STAGE(PG8_SB(0, 1), cB + hstepB, voffB); PG8_STAGE(PG8_SA(0, 1), cA + hstepA, voffA);
        if (wr == 1) PG8_BAR;
        PG8_WAIT_V(4); PG8_BAR;
        PG8_STAGE(PG8_SB(1, 0), cB + kstep, voffB); PG8_STAGE(PG8_SA(1, 0), cA + kstep, voffA); PG8_STAGE(PG8_SB(1, 1), cB + hstepB + kstep, voffB);
        PG8_WAIT_V(6); PG8_BAR;
    }
    for (;;) {
        const bool has_next = S.next(ui + 1, nxt);
        const char* nA = has_next ? (const char*)g.A + (size_t)nxt.pm * tstepA : cA; const char* nB = has_next ? (const char*)g.Bt + (size_t)nxt.pn * tstepB : cB;
        for (int t = 0; t < nt; t += 2) {
            const bool last = (t == nt - 2);
            const char* a1 = cA + (size_t)(t >> 1) * apair + kstep;
            const char* a2 = last ? nA : cA + (size_t)((t >> 1) + 1) * apair; const char* b2 = last ? nB : cB + (size_t)(t + 2) * kstep;
            const char* a3 = a2 + kstep; const char* b3 = b2 + kstep;
            if (last && has_next) S.a_ready(nxt);
            if constexpr (SP2) {
            PG8_LDB(B0, 0, 0); PG8_LDB(B1, 0, 1); PG8_SCHED; PG8_LDA(At, 0, 0); PG8_STAGE(PG8_SA(1, 1), a1 + hstepA, voffA);
            PG8_WAIT_V(8); PG8_WAIT_L(0); PG8_BAR; PG8_MMA(0, 0, At, B0); PG8_MMA(0, 1, At, B1); PG8_BAR; PG8_SCHED;
            PG8_LDA(At, 0, 1); PG8_STAGE(PG8_SB(0, 0), b2, voffB); PG8_STAGE(PG8_SB(0, 1), b2 + hstepB, voffB); PG8_STAGE(PG8_SA(0, 0), a2, voffA);
            PG8_WAIT_V(8); PG8_WAIT_L(0); PG8_BAR; PG8_MMA(1, 0, At, B0); PG8_MMA(1, 1, At, B1); PG8_BAR; PG8_SCHED;
            PG8_LDB(B0, 1, 0); PG8_LDB(B1, 1, 1); PG8_SCHED; PG8_LDA(At, 1, 0); PG8_STAGE(PG8_SA(0, 1), a2 + hstepA, voffA);
            PG8_WAIT_V(8); PG8_WAIT_L(0); PG8_BAR; PG8_MMA(0, 0, At, B0); PG8_MMA(0, 1, At, B1); PG8_BAR; PG8_SCHED;
            PG8_LDA(At, 1, 1); PG8_STAGE(PG8_SB(1, 0), b3, voffB); PG8_STAGE(PG8_SB(1, 1), b3 + hstepB, voffB); PG8_STAGE(PG8_SA(1, 0), a3, voffA);
            PG8_WAIT_V(8); PG8_WAIT_L(0); PG8_BAR; PG8_MMA(1, 0, At, B0); PG8_MMA(1, 1, At, B1); PG8_BAR; PG8_SCHED;
            } else {
            PG8_LDB(B0, 0, 0); PG8_SCHED; PG8_LDA(At, 0, 0); PG8_STAGE(PG8_SA(1, 1), a1 + hstepA, voffA);
            PG8_WAIT_L(8); PG8_BAR; PG8_WAIT_L(0); PG8_MMA(0, 0, At, B0); PG8_BAR; PG8_SCHED;
            PG8_LDB(B1, 0, 1); PG8_STAGE(PG8_SB(0, 0), b2, voffB);
            PG8_BAR; PG8_WAIT_L(0); PG8_MMA(0, 1, At, B1); PG8_BAR;
            PG8_LDA(At, 0, 1); PG8_STAGE(PG8_SA(0, 0), a2, voffA);
            PG8_BAR; PG8_WAIT_L(0); PG8_MMA(1, 0, At, B0); PG8_BAR; PG8_SCHED;
            PG8_STAGE(PG8_SB(0, 1), b2 + hstepB, voffB);
            PG8_WAIT_V(6); PG8_BAR; PG8_MMA(1, 1, At, B1); PG8_BAR;
            PG8_LDB(B0, 1, 0); PG8_SCHED; PG8_LDA(At, 1, 0); PG8_STAGE(PG8_SA(0, 1), a2 + hstepA, voffA);
            PG8_WAIT_L(8); PG8_BAR; PG8_WAIT_L(0); PG8_MMA(0, 0, At, B0); PG8_BAR; PG8_SCHED;
            PG8_LDB(B1, 1, 1); PG8_STAGE(PG8_SB(1, 0), b3, voffB);
            PG8_BAR; PG8_WAIT_L(0); PG8_MMA(0, 1, At, B1); PG8_BAR;
            PG8_LDA(At, 1, 1); PG8_STAGE(PG8_SA(1, 0), a3, voffA);
            PG8_BAR; PG8_WAIT_L(0); PG8_MMA(1, 0, At, B0); PG8_BAR; PG8_SCHED;
            PG8_STAGE(PG8_SB(1, 1), b3 + hstepB, voffB);
            PG8_WAIT_V(6); PG8_BAR; PG8_MMA(1, 1, At, B1); PG8_BAR;
            }
        }
        if constexpr (ALIGN_EPI) { if (wr == 0) PG8_BAR; }
        if constexpr (!Epi::AFTER_DRAIN) { E(acc, cur, wr, wc, fr, fq); S.done(cur); }
        if (!has_next) break;
#pragma unroll
        for (int a = 0; a < 2; ++a)
#pragma unroll
            for (int b = 0; b < 2; ++b)
#pragma unroll
                for (int m = 0; m < 4; ++m)
#pragma unroll
                    for (int n = 0; n < 2; ++n) acc[a][b][m][n] = (f32x4){0.f, 0.f, 0.f, 0.f};
        cur = nxt; cA = nA; cB = nB; ++ui;
        if constexpr (ALIGN_EPI) { if (wr == 1) PG8_BAR; }
    }
    PG8_WAIT_V(0);
    if constexpr (!ALIGN_EPI) { if (wr == 0) PG8_BAR; }
    PG8_BAR;
    if constexpr (Epi::AFTER_DRAIN) { E.fused(acc, cur, wr, wc, fr, fq, lds, wid, lane); S.done(cur); }
#undef PG8_SA
#undef PG8_SB
#undef PG8_STAGE
#undef PG8_LDA
#undef PG8_LDB
#undef PG8_MMA
#undef PG8_WAIT_V
#undef PG8_WAIT_L
#undef PG8_BAR
#undef PG8_SCHED
}
}

#ifndef PG8_SP2
#define PG8_SP2 true
#endif
#ifndef PG8_ALIGN
#define PG8_ALIGN true
#endif
constexpr int NWAVES = 8, NTHREADS = NWAVES * 64;
constexpr int BATCH = 2, SEQ = 4096, T = BATCH * SEQ, D = 2048;
constexpr int INW = 6160, NPROJ = 6144;
constexpr int GQ = 0, GK = 512, GV = 1024, GG = 2048, MQ = 3072, MK = 4096, MV = 5120;
constexpr int GA_SRC = 3072;
constexpr int NH = 8, NEXP = 16384, NMOD = 6 * D;
constexpr float EPS = 1e-6f;
#ifndef MK_N_LAUNCHES
#define MK_N_LAUNCHES 1
#endif
constexpr int N_PHASES = 13;
#ifndef P3_GLA_TWICE
#define P3_GLA_TWICE 0
#endif
#ifndef PROBE_EMASK
#define PROBE_EMASK 0x3fff
#endif
#ifndef P10_PASSES
#define P10_PASSES 1
#endif
#ifndef PROBE_SA
#define PROBE_SA -1
#define PROBE_SB 0
#endif
#ifndef PROBE_BLK
#define PROBE_BLK 0
#endif
#ifndef PROBE_ARR
#define PROBE_ARR 0
#endif
#ifndef PROBE_TS
#define PROBE_TS -1
#endif
#define SUBTS(k) do { if (PROBE_SA >= 0 && blockIdx.x == PROBE_BLK && threadIdx.x == 0) ((volatile LAS unsigned long long*)(C.lds + RING_BYTES + 8192))[40 + (k)] = __builtin_amdgcn_s_memrealtime(); } while (0)
constexpr int NSL = 8, SLW = 256, PCH = 128, NCHUNK = (BATCH * SEQ) / PCH;

constexpr size_t MiB = 1u << 20;
constexpr size_t WS_CTL = 0, CTL_ZERO_BYTES = 128 * 1024;
constexpr size_t WS_WIN = 1 * MiB, WS_WGA = 25 * MiB, WS_WOUT = 26 * MiB, WS_WQ = 34 * MiB, WS_KEYS = 42 * MiB, WS_CS = 43 * MiB, WS_KMEAN = 44 * MiB, WS_DEC = 45 * MiB;
constexpr size_t WS_UB = 46 * MiB, WS_VB = 110 * MiB, WS_H = 174 * MiB, WS_CONCAT = 206 * MiB, WS_BCUM = 238 * MiB, WS_UT = 254 * MiB, WS_ST = 286 * MiB, WS_PROJ = 302 * MiB;
constexpr size_t WS_QP = WS_PROJ, WS_EXP = 366 * MiB, WS_GATE = 370 * MiB, WS_GU = 374 * MiB, WS_ACT = 302 * MiB, WS_HQ = WS_H, WS_QDEC = 398 * MiB, WS_KDEC = 406 * MiB, WS_KUPD = 414 * MiB, WS_PART = 422 * MiB, WS_ML = 486 * MiB, WS_LIST = 488 * MiB, WS_SEL = 492 * MiB, WS_PW = 493 * MiB, WS_WSC = 494 * MiB, WS_END = 495 * MiB;
constexpr size_t WS_MODP = 44 * MiB + 512 * 1024;
constexpr size_t WS_X1B = 334 * MiB;
constexpr size_t WS_WINS = WS_WIN + 13 * MiB, WS_WQS = WS_WQ + 5 * MiB;
constexpr size_t WS_US = WS_UB + 40 * MiB, WS_VS = WS_VB + 40 * MiB, WS_HS = WS_VB + 41 * MiB;
constexpr int CW_BAR = 4096, CW_Q = 8192, CW_QA = 12288, CW_QB = 13312, CW_LCNT = 14336, CW_MOD = 16384;
static_assert((CW_MOD + 2048) * 4 <= (int)CTL_ZERO_BYTES, "CTL words inside the memset region");
constexpr size_t WS_MODF = 45 * MiB + 512 * 1024;

constexpr int RING_BYTES = 131072, MISC_OFF = RING_BYTES + 320, LDS_BYTES = 147456;

#define GAS __attribute__((address_space(1)))
#define LAS __attribute__((address_space(3)))
typedef unsigned short bf16;
typedef unsigned v4u __attribute__((ext_vector_type(4)));
typedef unsigned v2u __attribute__((ext_vector_type(2)));
typedef float f32x4 __attribute__((ext_vector_type(4)));
typedef float f32x2 __attribute__((ext_vector_type(2)));
typedef float f32x16 __attribute__((ext_vector_type(16)));
typedef short bf16x8 __attribute__((ext_vector_type(8)));
typedef short s16x4 __attribute__((ext_vector_type(4)));
typedef __bf16 bf16x2_t __attribute__((ext_vector_type(2)));
typedef GAS unsigned gu32;
#define LDS_WAIT() asm volatile("s_waitcnt lgkmcnt(0)" ::: "memory")
#define VM_WAIT() asm volatile("s_waitcnt vmcnt(0)" ::: "memory")
__device__ __forceinline__ unsigned pk2(float lo, float hi) { f32x2 v = {lo, hi}; bf16x2_t b = __builtin_convertvector(v, bf16x2_t); return __builtin_bit_cast(unsigned, b); }
__device__ __forceinline__ float bflo(unsigned u) { return __uint_as_float(u << 16); }
__device__ __forceinline__ float bfhi(unsigned u) { return __uint_as_float(u & 0xffff0000u); }
__device__ __forceinline__ float bf1(short s) { return __uint_as_float(((unsigned)(unsigned short)s) << 16); }
__device__ __forceinline__ bf16x8 pack8(float a0, float a1, float a2, float a3, float a4, float a5, float a6, float a7) { v4u w; w.x = pk2(a0, a1); w.y = pk2(a2, a3); w.z = pk2(a4, a5); w.w = pk2(a6, a7); return __builtin_bit_cast(bf16x8, w); }
__device__ __forceinline__ int crow(int r, int hi) { return (r & 3) + 8 * (r >> 2) + 4 * hi; }
#define DPP_ROR(v, n) __int_as_float(__builtin_amdgcn_update_dpp(0, __float_as_int(v), 0x120 + (n), 0xf, 0xf, false))
__device__ __forceinline__ float wave_sum(float v) {
    v += DPP_ROR(v, 8); v += DPP_ROR(v, 4); v += DPP_ROR(v, 2); v += DPP_ROR(v, 1);
    { auto r = __builtin_amdgcn_permlane16_swap(__float_as_uint(v), __float_as_uint(v), false, false); v = __uint_as_float(r[0]) + __uint_as_float(r[1]); }
    { auto r = __builtin_amdgcn_permlane32_swap(__float_as_uint(v), __float_as_uint(v), false, false); v = __uint_as_float(r[0]) + __uint_as_float(r[1]); }
    return v;
}
__device__ __forceinline__ float wave_max(float v) {
    v = fmaxf(v, DPP_ROR(v, 8)); v = fmaxf(v, DPP_ROR(v, 4)); v = fmaxf(v, DPP_ROR(v, 2)); v = fmaxf(v, DPP_ROR(v, 1));
    { auto r = __builtin_amdgcn_permlane16_swap(__float_as_uint(v), __float_as_uint(v), false, false); v = fmaxf(__uint_as_float(r[0]), __uint_as_float(r[1])); }
    { auto r = __builtin_amdgcn_permlane32_swap(__float_as_uint(v), __float_as_uint(v), false, false); v = fmaxf(__uint_as_float(r[0]), __uint_as_float(r[1])); }
    return v;
}
typedef short v4i16_t __attribute__((ext_vector_type(4)));
__device__ __forceinline__ s16x4 vtr(const LAS unsigned char* p) { return __builtin_bit_cast(s16x4, __builtin_amdgcn_ds_read_tr16_b64_v4i16((LAS v4i16_t*)p)); }
__device__ __forceinline__ bf16x8 cat4(s16x4 lo, s16x4 hi) { return (bf16x8){lo[0], lo[1], lo[2], lo[3], hi[0], hi[1], hi[2], hi[3]}; }
#define MFMA32(a, b, c) __builtin_amdgcn_mfma_f32_32x32x16_bf16((a), (b), (c), 0, 0, 0)
#define XB_TMO      128
#define XB_XCNT(j)  (256  + 64 * (j))
#define XB_XSUB(j)  (1280 + 64 * (j))
#define XB_XGEN(j)  (2304 + 64 * (j))
#define XB_TOP      3328
#define XB_TOPGEN   3392
#define XCD_BAR_WORDS 3456
#define XB_SPIN_CAP (1u << 18)

__device__ __forceinline__ unsigned xb_ld(unsigned* p)              { return __hip_atomic_load(p, __ATOMIC_RELAXED, __HIP_MEMORY_SCOPE_AGENT); }
__device__ __forceinline__ unsigned xb_add(unsigned* p, unsigned v) { return __hip_atomic_fetch_add(p, v, __ATOMIC_RELAXED, __HIP_MEMORY_SCOPE_AGENT); }
__device__ __forceinline__ unsigned xb_xcc_id() { return (unsigned)__builtin_amdgcn_s_getreg((3 << 11) | 20) & 0xFu; }
#define XB_SPIN(cond, bar) do { unsigned _sp = 0; while (cond) { __builtin_amdgcn_s_sleep(1); \
    if ((++_sp & 255u) == 0u) { if (xb_ld(&(bar)[XB_TMO])) break; if (_sp > XB_SPIN_CAP) { atomicAdd(&(bar)[XB_TMO], 1u); break; } } } } while (0)

struct XcdBarrier {
    unsigned* bar; unsigned x;
    volatile LAS unsigned* st;
};

__device__ __forceinline__ XcdBarrier xcd_barrier_post(unsigned* bar, volatile LAS unsigned* st) {
    XcdBarrier b; b.bar = bar; b.x = xb_xcc_id(); b.st = st;
    if (threadIdx.x == 0) (void)xb_add(&bar[XB_XCNT(b.x)], 1u);
    return b;
}
__device__ __forceinline__ void xcd_barrier_complete(unsigned* bar, unsigned x, unsigned& nloc, unsigned& nx) {
    const unsigned G = gridDim.x * gridDim.y * gridDim.z;
    unsigned sum, cnt, mine, sp = 0u;
    for (;;) {
        sum = 0u; cnt = 0u; mine = 0u;
#pragma unroll
        for (unsigned j = 0; j < 16; ++j) { const unsigned c = xb_ld(&bar[XB_XCNT(j)]); sum += c; cnt += (c > 0u) ? 1u : 0u; mine = (j == x) ? c : mine; }
        if (sum == G) break;
        __builtin_amdgcn_s_sleep(1);
        if ((++sp & 255u) == 0u) { if (xb_ld(&bar[XB_TMO])) break; if (sp > XB_SPIN_CAP) { atomicAdd(&bar[XB_TMO], 1u); break; } }
    }
    nloc = mine > 0u ? mine : 1u; nx = cnt > 0u ? cnt : 1u;
}

__device__ __forceinline__ void xcd_barrier(const XcdBarrier& b) {
    asm volatile("s_waitcnt vmcnt(0)" ::: "memory");
    __syncthreads();
    if (threadIdx.x == 0) {
        unsigned* bar = b.bar;
        __builtin_amdgcn_s_waitcnt(0);
        unsigned nloc = b.st[0], nx = b.st[1];
        if (nloc == 0u) { xcd_barrier_complete(bar, b.x, nloc, nx); b.st[0] = nloc; b.st[1] = nx; }
        const unsigned old = xb_add(&bar[XB_XSUB(b.x)], 1u);
        const unsigned gen = old / nloc;
        if (old + 1u == (gen + 1u) * nloc) {
            __builtin_amdgcn_fence(__ATOMIC_RELEASE, "agent");
            asm volatile("s_waitcnt vmcnt(0)" ::: "memory");
            const unsigned og = xb_add(&bar[XB_TOP], 1u);
            const unsigned tg = og / nx;
            if (og + 1u == (tg + 1u) * nx) xb_add(&bar[XB_TOPGEN], 1u);
            else XB_SPIN(xb_ld(&bar[XB_TOPGEN]) == tg, bar);
            __builtin_amdgcn_fence(__ATOMIC_ACQUIRE, "agent");
            xb_add(&bar[XB_XGEN(b.x)], 1u);
            asm volatile("s_waitcnt vmcnt(0)" ::: "memory");
        } else {
            XB_SPIN(xb_ld(&bar[XB_XGEN(b.x)]) == gen, bar);
            __builtin_amdgcn_fence(__ATOMIC_ACQUIRE, "agent");
            asm volatile("s_waitcnt vmcnt(0)" ::: "memory");
        }
    }
    __syncthreads();
}

struct Ctx {
    LAS unsigned char* lds;
    int tid, lane, wave, vcu, G, gw, ngw;
    const float *x, *c; const int* pos; const float *w_ada, *b_ada, *g1, *w_in, *w_a2, *b_a, *gla_g, *qg, *kg, *w_out, *g2, *w_q, *keys, *pu, *pv;
    float* out;
    unsigned* ctl; long long* MODI; float* MOD; float* MODP;
    bf16 *WIN, *WGA, *WOUT, *WQ, *KEYSB, *H, *CONCAT, *PROJ, *ST, *QDEC, *KDEC, *KUPD, *PART; float* ML; unsigned short *LIST, *SEL; unsigned* PW; float* WSC;
    unsigned char *UQ, *VQ, *HQ, *WINQ, *WQQ; float *WINS, *WQS; bf16* X1B; unsigned* UVS;
    float *CS, *KMEAN, *DEC, *BCUM, *UT, *QP, *GATE, *GU, *US, *VS, *HS; int *EXPI, *ACT;
};

__device__ __forceinline__ void transpose_item(const float* W, int ldw, int K, bf16* WT, int dst_row0, int k0, int n0, LAS float* scr, int lane) {
#pragma unroll 8
    for (int i = 0; i < 32; ++i) { const int kk = 2 * i + (lane >> 5); scr[kk * 33 + (lane & 31)] = W[(size_t)(k0 + kk) * ldw + n0 + (lane & 31)]; }
    LDS_WAIT(); asm volatile("" ::: "memory");
    const int c = lane & 7;
#pragma unroll
    for (int j = 0; j < 4; ++j) { const int n = (lane >> 3) + 8 * j; const LAS float* s = scr + (8 * c) * 33 + n;
        v4u o; o.x = pk2(s[0 * 33], s[1 * 33]); o.y = pk2(s[2 * 33], s[3 * 33]); o.z = pk2(s[4 * 33], s[5 * 33]); o.w = pk2(s[6 * 33], s[7 * 33]);
        *(v4u*)(WT + (size_t)(dst_row0 + n) * K + k0 + 8 * c) = o; }
    LDS_WAIT(); asm volatile("" ::: "memory");
}
__device__ __forceinline__ void quant_cols_item(const Ctx& C, const float* W, int ldw, int src_col0, unsigned char* WT, float* scales, int dst_row0) {
    const int lane = C.lane, w = C.wave, c = lane & 7;
    LAS float* scr = (LAS float*)(C.lds + w * 16384); LAS float* red = (LAS float*)(C.lds + 12288);
    unsigned vp[4][4][4]; float mx[4] = {0.f, 0.f, 0.f, 0.f};
    f32x4 ld[8], nx[8];
    const float* wp = W + (size_t)(256 * w + (lane >> 3)) * ldw + src_col0 + 4 * c;
#pragma unroll
    for (int i = 0; i < 8; ++i) ld[i] = *(const f32x4*)(wp + (size_t)(8 * i) * ldw);
#pragma unroll
    for (int sb = 0; sb < 4; ++sb) {
        if (sb < 3) {
#pragma unroll
            for (int i = 0; i < 8; ++i) nx[i] = *(const f32x4*)(wp + (size_t)(64 * (sb + 1) + 8 * i) * ldw); }
#pragma unroll
        for (int i = 0; i < 8; ++i) { LAS float* dp = scr + (8 * i + (lane >> 3)) * 33 + 4 * c; dp[0] = ld[i].x; dp[1] = ld[i].y; dp[2] = ld[i].z; dp[3] = ld[i].w; }
        LDS_WAIT(); asm volatile("" ::: "memory");
#pragma unroll
        for (int j = 0; j < 4; ++j) { const LAS float* sp = scr + (8 * c) * 33 + (lane >> 3) + 8 * j;
#pragma unroll
            for (int q = 0; q < 4; ++q) { const float v0 = sp[(2 * q) * 33], v1 = sp[(2 * q + 1) * 33]; vp[sb][j][q] = pk2(v0, v1); mx[j] = fmaxf(mx[j], fmaxf(fabsf(v0), fabsf(v1))); } }
        LDS_WAIT(); asm volatile("" ::: "memory");
#pragma unroll
        for (int i = 0; i < 8; ++i) ld[i] = nx[i]; }
#pragma unroll
    for (int j = 0; j < 4; ++j) { mx[j] = fmaxf(mx[j], __shfl_xor(mx[j], 1)); mx[j] = fmaxf(mx[j], __shfl_xor(mx[j], 2)); mx[j] = fmaxf(mx[j], __shfl_xor(mx[j], 4)); }
    __syncthreads();
    if (c == 0) {
#pragma unroll
        for (int j = 0; j < 4; ++j) red[w * 32 + (lane >> 3) + 8 * j] = mx[j]; }
    __syncthreads();
#pragma unroll
    for (int j = 0; j < 4; ++j) { const int n = (lane >> 3) + 8 * j; float am = 0.f;
#pragma unroll
        for (int ww = 0; ww < 8; ++ww) am = fmaxf(am, red[ww * 32 + n]);
        const float inv = am > 0.f ? 127.f / am : 0.f;
        if (w == 0 && c == 0) scales[dst_row0 + n] = am > 0.f ? am / 127.f : 1.f;
#pragma unroll
        for (int sb = 0; sb < 4; ++sb) { unsigned o[2];
#pragma unroll
            for (int h = 0; h < 2; ++h) { const int q0 = (int)rintf(bflo(vp[sb][j][2 * h]) * inv), q1 = (int)rintf(bfhi(vp[sb][j][2 * h]) * inv), q2 = (int)rintf(bflo(vp[sb][j][2 * h + 1]) * inv), q3 = (int)rintf(bfhi(vp[sb][j][2 * h + 1]) * inv);
                o[h] = (unsigned)(q0 & 0xff) | ((unsigned)(q1 & 0xff) << 8) | ((unsigned)(q2 & 0xff) << 16) | ((unsigned)(q3 & 0xff) << 24); }
            *(v2u*)(WT + (size_t)(dst_row0 + n) * D + 256 * w + 64 * sb + 8 * c) = (v2u){o[0], o[1]}; } }
    __syncthreads();
}
__device__ __forceinline__ void convert_item(const float* src, bf16* dst, size_t item, int lane) {
    const f32x4* s = (const f32x4*)(src + item * 8192) + 2 * lane; v4u* d = (v4u*)(dst + item * 8192) + lane;
#pragma unroll 4
    for (int it = 0; it < 16; ++it) { const f32x4 a = s[it * 128], b = s[it * 128 + 1]; v4u o; o.x = pk2(a.x, a.y); o.y = pk2(a.z, a.w); o.z = pk2(b.x, b.y); o.w = pk2(b.z, b.w); d[it * 64] = o; }
}
__device__ __forceinline__ void quant_store(const f32x4 (&v)[8], unsigned char* dst, float* scales, int row, size_t nrows, int lane, int bias) {
    float am = 0.f;
#pragma unroll
    for (int j = 0; j < 8; ++j) am = fmaxf(am, fmaxf(fmaxf(fabsf(v[j].x), fabsf(v[j].y)), fmaxf(fabsf(v[j].z), fabsf(v[j].w))));
    am = wave_max(am);
    const float inv = am > 0.f ? 127.f / am : 0.f;
    if (lane == 0) scales[row] = am > 0.f ? am / 127.f : 1.f;
#pragma unroll
    for (int j = 0; j < 8; ++j) { const int q0 = (int)rintf(v[j].x * inv) + bias, q1 = (int)rintf(v[j].y * inv) + bias, q2 = (int)rintf(v[j].z * inv) + bias, q3 = (int)rintf(v[j].w * inv) + bias;
        *(unsigned*)(dst + ((size_t)j * nrows + row) * 256 + 4 * lane) = (unsigned)(q0 & 0xff) | ((unsigned)(q1 & 0xff) << 8) | ((unsigned)(q2 & 0xff) << 16) | ((unsigned)(q3 & 0xff) << 24); }
}
__device__ __forceinline__ unsigned quant_store_t(const f32x4 (&v)[8], unsigned char* dst, int row, size_t nrows, int lane) {
    float am = 0.f;
#pragma unroll
    for (int j = 0; j < 8; ++j) am = fmaxf(am, fmaxf(fmaxf(fabsf(v[j].x), fabsf(v[j].y)), fmaxf(fabsf(v[j].z), fabsf(v[j].w))));
    am = wave_max(am);
    const unsigned scb = am > 0.f ? (pk2(am * (1.f / 127.f), 0.f) & 0xffffu) : 0x3f80u; const float scf = __uint_as_float(scb << 16), inv = am > 0.f ? 1.f / scf : 0.f;
#pragma unroll
    for (int j = 0; j < 8; ++j) { const int q0 = (int)rintf(v[j].x * inv), q1 = (int)rintf(v[j].y * inv), q2 = (int)rintf(v[j].z * inv), q3 = (int)rintf(v[j].w * inv);
        *(unsigned*)(dst + ((size_t)j * nrows + row) * 256 + 4 * lane) = (unsigned)(q0 & 0xff) | ((unsigned)(q1 & 0xff) << 8) | ((unsigned)(q2 & 0xff) << 16) | ((unsigned)(q3 & 0xff) << 24); }
    return scb;
}
__device__ __forceinline__ void quant_row(const float* src, unsigned char* dst, float* scales, int row, size_t nrows, int lane, int bias) {
    const f32x4* s = (const f32x4*)src + lane; f32x4 v[8];
#pragma unroll
    for (int j = 0; j < 8; ++j) v[j] = s[64 * j];
    quant_store(v, dst, scales, row, nrows, lane, bias);
}
__device__ __forceinline__ void p0_phase(const Ctx& C, int rep) {
    const int lane = C.lane, gw = C.gw, ngw = C.ngw;
    LAS float* sc = (LAS float*)C.lds;
    LAS float* part = sc + BATCH * D;
    for (int i = C.tid; i < BATCH * D; i += NTHREADS) { const float v = C.c[i]; sc[i] = v / (1.f + __expf(-v)); }
    __syncthreads();
    for (int it = C.vcu; it < 768; it += C.G) {
        const int cg = it % 192, rq = it / 192;
        const int cq = lane & 15, rg = lane >> 4, col = cg * 64 + 4 * cq, r0 = 512 * rq + 64 * C.wave + rg;
        const f32x4* w = (const f32x4*)(C.w_ada + (size_t)r0 * NMOD + col); const LAS float* s0 = sc + r0; const LAS float* s1 = sc + D + r0;
        f32x4 a0 = {0.f, 0.f, 0.f, 0.f}, a1 = a0;
#pragma unroll 16
        for (int k = 0; k < 16; ++k) { const f32x4 wv = w[(size_t)k * NMOD]; a0 += s0[4 * k] * wv; a1 += s1[4 * k] * wv; }
#pragma unroll
        for (int q = 0; q < 4; ++q) { a0[q] += __shfl_xor(a0[q], 16); a0[q] += __shfl_xor(a0[q], 32); a1[q] += __shfl_xor(a1[q], 16); a1[q] += __shfl_xor(a1[q], 32); }
        if (rg == 0) { *(LAS f32x4*)(part + (C.wave * 2 + 0) * 64 + 4 * cq) = a0; *(LAS f32x4*)(part + (C.wave * 2 + 1) * 64 + 4 * cq) = a1; }
        __syncthreads();
        if (C.tid < 128) { const int bb = C.tid >> 6, cl = C.tid & 63; float s = 0.f;
#pragma unroll
            for (int ww = 0; ww < 8; ++ww) s += part[(ww * 2 + bb) * 64 + cl];
            C.MODP[(size_t)(rq * 2 + bb) * NMOD + cg * 64 + cl] = s; }
        __syncthreads();
    }
    for (int it = C.vcu; it < 192 + 64; it += C.G) {
        const bool isin = it < 192; const int n0 = 32 * (isin ? it : it - 192);
        quant_cols_item(C, isin ? C.w_in : C.w_q, isin ? INW : D, isin && n0 >= 3072 ? n0 + 16 : n0, isin ? C.WINQ : C.WQQ, isin ? C.WINS : C.WQS, n0);
    }
    LAS float* scr = (LAS float*)(C.lds + C.wave * 16384);
    constexpr int I_SQ = 32 * 64;
    for (int it = gw; it < I_SQ; it += ngw) transpose_item(C.w_out, D, D, C.WOUT, 32 * (it % 64), 64 * (it / 64), 32 * (it % 64), scr, lane);
    for (int it = gw; it < 32; it += ngw) { const int k = it * 64 + lane; const f32x4* s = (const f32x4*)(C.w_in + (size_t)k * INW + GA_SRC);
#pragma unroll
        for (int q = 0; q < 4; ++q) { const f32x4 v = s[q]; C.WGA[(4 * q + 0) * D + k] = (bf16)(pk2(v.x, 0.f) & 0xffff); C.WGA[(4 * q + 1) * D + k] = (bf16)(pk2(v.y, 0.f) & 0xffff);
            C.WGA[(4 * q + 2) * D + k] = (bf16)(pk2(v.z, 0.f) & 0xffff); C.WGA[(4 * q + 3) * D + k] = (bf16)(pk2(v.w, 0.f) & 0xffff); } }
    for (int k_ = 0, per_ = (NEXP + ngw - 1) / ngw; k_ < per_; ++k_) { const int it = gw * per_ + k_; if (it >= NEXP) break;
        const f32x4* su = (const f32x4*)(C.pu + (size_t)it * D) + lane; const f32x4* sv = (const f32x4*)(C.pv + (size_t)it * D) + lane; f32x4 vu[8], vv[8];
#pragma unroll
        for (int j = 0; j < 8; ++j) { vu[j] = su[64 * j]; vv[j] = sv[64 * j]; }
        const unsigned su_ = quant_store_t(vu, C.UQ, it, NEXP, lane), sv_ = quant_store_t(vv, C.VQ, it, NEXP, lane); if (lane == 0) C.UVS[it] = su_ | (sv_ << 16);
    }
    for (int it = gw; it < 32; it += ngw) convert_item(C.keys, C.KEYSB, it, lane);
    for (int idx = C.vcu * NTHREADS + C.tid; idx < T * 16; idx += C.G * NTHREADS) {
        const int t = idx >> 4, f = idx & 15; const float inv = powf(500000.0f, -(float)f * 0.0625f); const float ang = (float)C.pos[t] * inv;
        C.CS[2 * idx] = cosf(ang); C.CS[2 * idx + 1] = sinf(ang);
    }
}

__device__ __forceinline__ float modi_to_f32(long long v) { return (float)(int)(v >> 32) * 0.00390625f + (float)(unsigned)v * 9.094947017729282e-13f; }
template <bool FIRST> __device__ __forceinline__ void norm_mod_phase(const Ctx& C, const float* X, const float* g, int shift_off, int scale_off, bf16* O) {
    LAS float* lg = (LAS float*)C.lds; LAS float* lsh = lg + D; LAS float* lsc = lsh + BATCH * D;
    for (int i = C.tid; i < D; i += NTHREADS) lg[i] = g[i];
    for (int i = C.tid; i < BATCH * D; i += NTHREADS) { const int b = i / D, j = i % D;
        if (FIRST) { float sh = C.b_ada[shift_off + j], sv = C.b_ada[scale_off + j];
#pragma unroll
            for (int rq = 0; rq < 4; ++rq) { sh += C.MODP[(size_t)(rq * 2 + b) * NMOD + shift_off + j]; sv += C.MODP[(size_t)(rq * 2 + b) * NMOD + scale_off + j]; }
            lsh[i] = sh; lsc[i] = 1.f + sv; }
        else { lsh[i] = C.MOD[b * NMOD + shift_off + j]; lsc[i] = 1.f + C.MOD[b * NMOD + scale_off + j]; } }
    if (FIRST) for (int i = C.vcu * NTHREADS + C.tid; i < BATCH * NMOD; i += C.G * NTHREADS) {
        float v = C.b_ada[i % NMOD];
#pragma unroll
        for (int rq = 0; rq < 4; ++rq) v += C.MODP[(size_t)rq * 2 * NMOD + i];
        C.MOD[i] = v; }
    __syncthreads();
    if (FIRST) {
        for (int m = C.gw; m < T; m += C.ngw) {
            const int b = m / SEQ; f32x4 v[8]; float ss = 0.f;
            const f32x4* xr = (const f32x4*)(X + (size_t)m * D) + C.lane;
#pragma unroll
            for (int j = 0; j < 8; ++j) v[j] = xr[64 * j];
#pragma unroll
            for (int j = 0; j < 8; ++j) ss += (v[j].x * v[j].x + v[j].y * v[j].y) + (v[j].z * v[j].z + v[j].w * v[j].w);
            const float rstd = rsqrtf(wave_sum(ss) * (1.f / D) + EPS);
            const LAS f32x4* g4 = (const LAS f32x4*)lg + C.lane; const LAS f32x4* sh4 = (const LAS f32x4*)(lsh + b * D) + C.lane; const LAS f32x4* sc4 = (const LAS f32x4*)(lsc + b * D) + C.lane;
#pragma unroll
            for (int j = 0; j < 8; ++j) { v[j] = v[j] * rstd * g4[64 * j] * sc4[64 * j] + sh4[64 * j]; }
            quant_store(v, C.HQ, C.HS, m, T, C.lane, 0);
        }
    } else {
        for (int m = C.gw; m < T; m += 2 * C.ngw) {
            const int m2 = (m + C.ngw < T) ? m + C.ngw : m; v2u rw[2][8];
#pragma unroll
            for (int rr = 0; rr < 2; ++rr) { const v2u* xr = (const v2u*)(C.X1B + (size_t)(rr ? m2 : m) * D) + C.lane;
#pragma unroll
                for (int j = 0; j < 8; ++j) rw[rr][j] = xr[64 * j]; }
#pragma unroll
            for (int rr = 0; rr < 2; ++rr) { const int mm = rr ? m2 : m; if (rr && m2 == m) break;
                const int b = mm / SEQ; f32x4 v[8]; float ss = 0.f;
#pragma unroll
                for (int j = 0; j < 8; ++j) v[j] = (f32x4){bflo(rw[rr][j].x), bfhi(rw[rr][j].x), bflo(rw[rr][j].y), bfhi(rw[rr][j].y)};
#pragma unroll
                for (int j = 0; j < 8; ++j) ss += (v[j].x * v[j].x + v[j].y * v[j].y) + (v[j].z * v[j].z + v[j].w * v[j].w);
                const float rstd = rsqrtf(wave_sum(ss) * (1.f / D) + EPS);
                const LAS f32x4* g4 = (const LAS f32x4*)lg + C.lane; const LAS f32x4* sh4 = (const LAS f32x4*)(lsh + b * D) + C.lane; const LAS f32x4* sc4 = (const LAS f32x4*)(lsc + b * D) + C.lane;
#pragma unroll
                for (int j = 0; j < 8; ++j) { v[j] = v[j] * rstd * g4[64 * j] * sc4[64 * j] + sh4[64 * j]; }
                quant_store(v, C.HQ, C.HS, mm, T, C.lane, 0); }
        }
    }
    __syncthreads();
}

__device__ __forceinline__ bf16x8 i8_to_bf16x8(unsigned lo, unsigned hi) {
    v4u w; w.x = pk2((float)((int)(lo << 24) >> 24), (float)((int)(lo << 16) >> 24)); w.y = pk2((float)((int)(lo << 8) >> 24), (float)((int)lo >> 24));
    w.z = pk2((float)((int)(hi << 24) >> 24), (float)((int)(hi << 16) >> 24)); w.w = pk2((float)((int)(hi << 8) >> 24), (float)((int)hi >> 24)); return __builtin_bit_cast(bf16x8, w); }
__device__ __forceinline__ void gla_prep_item(const Ctx& C, int b, int n, int ch) {
    const int lane = C.lane, w = C.wave, fr = lane & 15, fq = lane >> 4, rt = w & 3, kh = w >> 2, r32 = lane & 31, hh = lane >> 5; const size_t t0 = (size_t)b * SEQ + 64 * n;
    const int c = C.tid & 255, th = C.tid >> 8, col = ch * 256 + c;
    float wb[8];
#pragma unroll
    for (int s = 0; s < 8; ++s) wb[s] = C.w_a2[(2 * s + hh) * 512 + ch * 256 + 32 * w + r32];
    const float bz = C.b_a[ch * 256 + 32 * w + r32];
    const bf16* qp = C.PROJ + (t0 + 32 * th) * NPROJ + GQ + col; const bf16* kp = C.PROJ + (t0 + 32 * th) * NPROJ + GK + col;
    unsigned short qr[32], kr[32];
#pragma unroll
    for (int k = 0; k < 32; ++k) { qr[k] = qp[(size_t)k * NPROJ]; kr[k] = kp[(size_t)k * NPROJ]; }
    const unsigned char* ap = C.HQ + ((size_t)(kh * 4) * T + t0 + 16 * rt + fr) * 256 + 16 * fq; const bf16* bp = C.WGA + fr * D + kh * 1024 + 16 * fq;
    f32x4 acc = {0.f, 0.f, 0.f, 0.f};
#pragma unroll 8
    for (int s = 0; s < 16; ++s) { const v4u a = *(const v4u*)(ap + (size_t)(s >> 2) * T * 256 + (s & 3) * 64); const bf16x8 b0 = *(const bf16x8*)(bp + 64 * s), b1 = *(const bf16x8*)(bp + 64 * s + 8);
        acc = __builtin_amdgcn_mfma_f32_16x16x32_bf16(i8_to_bf16x8(a.x, a.y), b0, acc, 0, 0, 0); acc = __builtin_amdgcn_mfma_f32_16x16x32_bf16(i8_to_bf16x8(a.z, a.w), b1, acc, 0, 0, 0); }
#pragma unroll
    for (int r = 0; r < 4; ++r) acc[r] *= C.HS[t0 + 16 * rt + 4 * fq + r];
    LAS float* gaT = (LAS float*)C.lds;
    LAS float* tot = gaT + 2304; LAS float* zt = (LAS float*)(C.lds + 16384);
#pragma unroll
    for (int r = 0; r < 4; ++r) gaT[kh * 1088 + fr * 65 + 16 * rt + 4 * fq + r] = acc[r];
    __syncthreads();
#pragma unroll
    for (int rt2 = 0; rt2 < 2; ++rt2) { f32x16 z;
#pragma unroll
        for (int q = 0; q < 16; ++q) z[q] = bz;
#pragma unroll
        for (int s = 0; s < 8; ++s) { const int ai = (2 * s + hh) * 65 + 32 * rt2 + r32; z = __builtin_amdgcn_mfma_f32_32x32x2f32(gaT[ai] + gaT[1088 + ai], wb[s], z, 0, 0, 0); }
#pragma unroll
        for (int q = 0; q < 16; ++q) zt[(32 * rt2 + crow(q, hh)) * 256 + 32 * w + r32] = z[q]; }
    __syncthreads();
    float cum = 0.f, la[32];
#pragma unroll
    for (int k = 0; k < 32; ++k) { const float z = zt[(32 * th + k) * 256 + c]; cum += (fminf(z, 0.f) - __logf(1.f + __expf(-fabsf(z)))) * 0.0625f; la[k] = cum; }
    if (th == 0) tot[c] = cum;
    __syncthreads();
    const float base = th ? tot[c] : 0.f;
    if (th == 1) tot[256 + c] = cum + base;
    __syncthreads();
    const float blast = tot[256 + c];
    bf16* qo = C.QDEC + (t0 + 32 * th) * 512 + col; bf16* ko = C.KDEC + (t0 + 32 * th) * 512 + col; bf16* uo = C.KUPD + (t0 + 32 * th) * 512 + col;
#pragma unroll
    for (int k = 0; k < 32; ++k) { const float bb = la[k] + base, qv = __uint_as_float((unsigned)qr[k] << 16), kv = __uint_as_float((unsigned)kr[k] << 16);
        qo[(size_t)k * 512] = (bf16)(pk2(qv * 0.125f * __expf(bb), 0.f) & 0xffffu); ko[(size_t)k * 512] = (bf16)(pk2(kv * __expf(-bb), 0.f) & 0xffffu); uo[(size_t)k * 512] = (bf16)(pk2(kv * __expf(blast - bb), 0.f) & 0xffffu); }
    if (th == 1) C.DEC[((size_t)(b * NH + (col >> 6)) * 64 + n) * 64 + (col & 63)] = __expf(blast);
    __syncthreads();
}
__device__ __forceinline__ void moba_prep_item(const Ctx& C, int b, int h, int blk, int rep) {
    const int lane = C.lane, w = C.wave, i = lane & 15, tg = lane >> 4; const size_t t0 = (size_t)b * SEQ + 256 * blk;
    float qg[8], kg[8], km[8];
#pragma unroll
    for (int j = 0; j < 8; ++j) { qg[j] = C.qg[8 * i + j]; kg[j] = C.kg[8 * i + j]; km[j] = 0.f; }
    v4u rawq[8], rawk[8]; f32x2 csa[8], csb[8]; const int fa = 8 * (i & 1) + (i >> 2);
#pragma unroll
    for (int it = 0; it < 8; ++it) { const size_t tok = t0 + 32 * w + 4 * it + tg; rawq[it] = *(const v4u*)(C.PROJ + tok * NPROJ + MQ + h * 128 + 8 * i); rawk[it] = *(const v4u*)(C.PROJ + tok * NPROJ + MK + h * 128 + 8 * i);
        csa[it] = *(const f32x2*)(C.CS + tok * 32 + 2 * fa); csb[it] = *(const f32x2*)(C.CS + tok * 32 + 2 * (fa + 4)); }
    const float sgn = i < 2 ? -1.f : 1.f; const bool rot = i < 4;
#define MP_ROR(v, n) __int_as_float(__builtin_amdgcn_update_dpp(0, __float_as_int(v), 0x120 + (n), 0xf, 0xf, false))
#pragma unroll
    for (int it = 0; it < 8; ++it) {
        const size_t tok = t0 + 32 * w + 4 * it + tg;
        { float a_ = csa[it].x, b_ = csa[it].y, c_ = csb[it].x, d_ = csb[it].y; asm volatile("" : "+v"(a_), "+v"(b_), "+v"(c_), "+v"(d_) :: "memory"); csa[it].x = a_; csa[it].y = b_; csb[it].x = c_; csb[it].y = d_; }
        float cv[8], sv[8];
        cv[0] = csa[it].x; sv[0] = csa[it].y; cv[4] = csb[it].x; sv[4] = csb[it].y;
        cv[1] = MP_ROR(csa[it].x, 12); sv[1] = MP_ROR(csa[it].y, 12); cv[2] = MP_ROR(csa[it].x, 8); sv[2] = MP_ROR(csa[it].y, 8); cv[3] = MP_ROR(csa[it].x, 4); sv[3] = MP_ROR(csa[it].y, 4);
        cv[5] = MP_ROR(csb[it].x, 12); sv[5] = MP_ROR(csb[it].y, 12); cv[6] = MP_ROR(csb[it].x, 8); sv[6] = MP_ROR(csb[it].y, 8); cv[7] = MP_ROR(csb[it].x, 4); sv[7] = MP_ROR(csb[it].y, 4);
#pragma unroll
        for (int which = 0; which < 2; ++which) {
            bf16* p = C.PROJ + tok * NPROJ + (which ? MK : MQ) + h * 128 + 8 * i;
            const v4u raw = which ? rawk[it] : rawq[it]; float xv[8];
            xv[0] = bflo(raw.x); xv[1] = bfhi(raw.x); xv[2] = bflo(raw.y); xv[3] = bfhi(raw.y); xv[4] = bflo(raw.z); xv[5] = bfhi(raw.z); xv[6] = bflo(raw.w); xv[7] = bfhi(raw.w);
            float ss = 0.f;
#pragma unroll
            for (int j = 0; j < 8; ++j) ss += xv[j] * xv[j];
            ss += MP_ROR(ss, 8); ss += MP_ROR(ss, 4); ss += MP_ROR(ss, 2); ss += MP_ROR(ss, 1);
            const float rstd = rsqrtf(ss * (1.f / 128.f) + EPS);
#pragma unroll
            for (int j = 0; j < 8; ++j) xv[j] = xv[j] * rstd * (which ? kg[j] : qg[j]);
#pragma unroll
            for (int j = 0; j < 8; ++j) { const float o = __int_as_float(__builtin_amdgcn_update_dpp(0, __float_as_int(xv[j]), 0x4E, 0xf, 0xf, false));
                const float rv = xv[j] * cv[j] + sgn * (o * sv[j]); xv[j] = rot ? rv : xv[j]; }
            v4u o; o.x = pk2(xv[0], xv[1]); o.y = pk2(xv[2], xv[3]); o.z = pk2(xv[4], xv[5]); o.w = pk2(xv[6], xv[7]);
            if (rep) *(v4u*)(C.CONCAT + tok * D + which * 1024 + h * 128 + 8 * i) = o; else *(v4u*)p = o;
            if (which) {
#pragma unroll
                for (int j = 0; j < 8; ++j) km[j] += xv[j]; }
        }
    }
#undef MP_ROR
    LAS float* red = (LAS float*)C.lds;
#pragma unroll
    for (int j = 0; j < 8; ++j) { km[j] += __shfl_xor(km[j], 16); km[j] += __shfl_xor(km[j], 32); }
    if (lane < 16) {
#pragma unroll
        for (int j = 0; j < 8; ++j) red[w * 128 + 8 * i + j] = km[j]; }
    __syncthreads();
    if (C.tid < 128) { float s = 0.f;
#pragma unroll
        for (int ww = 0; ww < 8; ++ww) s += red[ww * 128 + C.tid];
        C.KMEAN[((size_t)(b * NH + h) * 16 + blk) * 128 + C.tid] = s * (1.f / 256.f); }
    __syncthreads();
}


constexpr int KP = 272, VP = 320;
__device__ __forceinline__ void moba_select_item(const Ctx& C, int b, int h, int qb, int rep) {
    const int lane = C.lane, w = C.wave, r = lane & 31, hh = lane >> 5; const size_t tb = (size_t)b * SEQ; const int qtok = qb * 256 + 32 * w + r;
    bf16x8 qf[8];
    { const bf16* qrow = C.PROJ + MQ + h * 128 + (tb + qtok) * NPROJ + 8 * hh;
#pragma unroll
      for (int s = 0; s < 8; ++s) qf[s] = *(const bf16x8*)(qrow + 16 * s); }
    float g0 = -INFINITY, g1 = -INFINITY, g2 = -INFINITY; int i0 = -1, i1 = -1, i2 = -1;
    { const int j = C.tid >> 4, d0 = (C.tid & 15) * 8; float v[8];
#pragma unroll
      for (int q = 0; q < 8; ++q) v[q] = 0.f;
      if (j < qb) { const f32x4* kp = (const f32x4*)(C.KMEAN + ((size_t)(b * NH + h) * 16 + j) * 128 + d0); const f32x4 a = kp[0], c4 = kp[1]; v[0] = a.x; v[1] = a.y; v[2] = a.z; v[3] = a.w; v[4] = c4.x; v[5] = c4.y; v[6] = c4.z; v[7] = c4.w; }
      v4u hi_, lo_; unsigned hw[4], lw[4];
#pragma unroll
      for (int q = 0; q < 4; ++q) { hw[q] = pk2(v[2 * q], v[2 * q + 1]); lw[q] = pk2(v[2 * q] - bflo(hw[q]), v[2 * q + 1] - bfhi(hw[q])); }
      hi_ = (v4u){hw[0], hw[1], hw[2], hw[3]}; lo_ = (v4u){lw[0], lw[1], lw[2], lw[3]};
      *(LAS v4u*)(C.lds + j * 272 + 2 * d0) = hi_; *(LAS v4u*)(C.lds + 8704 + j * 272 + 2 * d0) = lo_; }
    __syncthreads();
    { f32x16 X;
#pragma unroll
      for (int q = 0; q < 16; ++q) X[q] = 0.f;
#pragma unroll
      for (int s = 0; s < 8; ++s) { const bf16x8 ah = *(const LAS bf16x8*)(C.lds + r * 272 + 32 * s + 16 * hh), al = *(const LAS bf16x8*)(C.lds + 8704 + r * 272 + 32 * s + 16 * hh);
          X = MFMA32(ah, qf[s], X); X = MFMA32(al, qf[s], X); }
      float sc[16];
#pragma unroll
      for (int q = 0; q < 8; ++q) { auto rr = __builtin_amdgcn_permlane32_swap(__float_as_uint(X[q]), __float_as_uint(X[q]), false, false); const float oth = __uint_as_float(rr[1]);
          sc[(q & 3) + 8 * (q >> 2)] = X[q]; sc[(q & 3) + 8 * (q >> 2) + 4] = oth; }
#pragma unroll
      for (int j = 0; j < 15; ++j) if (j < qb) { const float acc = sc[j];
          if (acc > g0) { g2 = g1; i2 = i1; g1 = g0; i1 = i0; g0 = acc; i0 = j; }
          else if (acc > g1) { g2 = g1; i2 = i1; g1 = acc; i1 = j; }
          else if (acc > g2) { g2 = acc; i2 = j; } } }
    __syncthreads();
    const int np = (i0 >= 0) + (i1 >= 0) + (i2 >= 0);
    if (hh == 0) C.SEL[(tb + qtok) * NH + h] = (unsigned short)((i0 & 15) | ((i1 & 15) << 4) | ((i2 & 15) << 8) | (np << 12));
    unsigned* lc = C.ctl + (rep ? 16384 : CW_LCNT) + ((b * NH + h) * 16) * 8; int nv = 0;
#pragma unroll
    for (int j = 0; j < 15; ++j) { const unsigned long long mk = __ballot(hh == 0 && (i0 == j || i1 == j || i2 == j)); nv = (lane == j) ? (int)__popcll(mk) : nv; }
    int basev = 0; if (lane < 15 && nv > 0) basev = (int)atomicAdd(lc + lane * 8, (unsigned)nv);
    unsigned short* lp = C.LIST + (size_t)((b * NH + h) * 16) * 4096 + (rep ? 256 * 4096 : 0);
#pragma unroll
    for (int j = 0; j < 15; ++j) { const int bj = __builtin_amdgcn_readlane(basev, j); const bool pj = hh == 0 && (i0 == j || i1 == j || i2 == j); const unsigned long long mk = __ballot(pj);
        if (pj) { const int slot = (i0 == j) ? 0 : (i1 == j) ? 1 : 2;
            const int pos = bj + (int)__builtin_amdgcn_mbcnt_hi((unsigned)(mk >> 32), __builtin_amdgcn_mbcnt_lo((unsigned)mk, 0u));
            lp[j * 4096 + pos] = (unsigned short)(qtok | (slot << 12)); } }
}
__device__ __forceinline__ void p5_publish_next(const Ctx& C, int id, int npast, const LAS int* pfx, volatile LAS int* qslot) {
    if (C.tid == 0) { int a0 = -1, a1 = 0;
        if (id < 256) { a0 = id; a1 = -1; }
        else if (id < 256 + npast) { const int p = id - 256; int lo = 0, hi = 256; while (hi - lo > 1) { const int mid = (lo + hi) >> 1; if (pfx[mid] <= p) lo = mid; else hi = mid; } a0 = lo; a1 = p - pfx[lo]; }
        else if (id < 512 + npast) { a0 = 512 + (id - 256 - npast); }
        qslot[0] = a0; qslot[1] = a1; }
}
struct AttnQ { int qtok, slot; bool valid, wave_on; bf16x8 qf[8]; };
__device__ __forceinline__ int attn_list_load(const Ctx& C, const LAS int* cntl, int a0, int a1) {
    if (a0 < 0 || a0 >= 256 || a1 < 0) return 0;
    const int e = 256 * a1 + 32 * C.wave + (C.lane & 31); return (int)C.LIST[(size_t)a0 * 4096 + (e < cntl[a0] ? e : 256 * a1)];
}
__device__ __forceinline__ void attn_q_load(const Ctx& C, const LAS int* cntl, int a0, int a1, int ent, AttnQ& q) {
    if (a0 < 0 || a0 >= 256) return;
    const int w = C.wave, r = C.lane & 31, hh = C.lane >> 5, b = a0 >> 7, h = (a0 >> 4) & 7, kblk = a0 & 15;
    if (a1 < 0) { q.qtok = kblk * 256 + 32 * w + r; q.slot = 3; q.valid = true; q.wave_on = true; }
    else { const int cnt = cntl[a0], e = 256 * a1 + 32 * w + r; q.valid = e < cnt; q.wave_on = 256 * a1 + 32 * w < cnt; q.qtok = ent & 4095; q.slot = ent >> 12; }
    const bf16* qrow = C.PROJ + MQ + h * 128 + ((size_t)b * SEQ + q.qtok) * NPROJ + 8 * hh;
#pragma unroll
    for (int s = 0; s < 8; ++s) q.qf[s] = *(const bf16x8*)(qrow + 16 * s);
}
__device__ __forceinline__ void moba_attn_item(const Ctx& C, const LAS int* cntl, int b, int h, int kblk, bool own, const AttnQ& Q, int nid, int npast, const LAS int* pfx, volatile LAS int* qslot, int& na0, int& na1, AttnQ& NQ) {
    const int lane = C.lane, w = C.wave, r = lane & 31, hh = lane >> 5; const size_t tb = (size_t)b * SEQ;
    SUBTS(6);
    { const char* kp = (const char*)(C.PROJ + (tb + kblk * 256) * NPROJ + MK + h * 128); const char* vp = (const char*)(C.PROJ + (tb + kblk * 256) * NPROJ + MV + h * 128);
#pragma unroll
      for (int i = 0; i < 8; ++i) { const int p = w + 8 * i, row = 4 * p + (lane >> 4), cp = lane & 15;
          __builtin_amdgcn_global_load_lds((const unsigned*)(kp + (size_t)row * (NPROJ * 2) + 16 * (cp ^ (row & 15))), (LAS unsigned*)(C.lds + p * 1024), 16, 0, 0);
          __builtin_amdgcn_global_load_lds((const unsigned*)(vp + (size_t)row * (NPROJ * 2) + 16 * (cp ^ ((row & 3) << 2))), (LAS unsigned*)(C.lds + 65536 + p * 1024), 16, 0, 0); } }
    const bool valid = Q.valid, wave_on = Q.wave_on; const int qtok = Q.qtok, slot = Q.slot;
    bf16x8 qf[8];
#pragma unroll
    for (int s = 0; s < 8; ++s) qf[s] = Q.qf[s];
    p5_publish_next(C, nid, npast, pfx, qslot);
    __syncthreads();
    na0 = qslot[0]; na1 = qslot[1];
    const int nent = attn_list_load(C, cntl, na0, na1);
    SUBTS(7);
    float m_run = -1e30f, l_run = 0.f; f32x16 o[4];
    if (wave_on) {
#pragma unroll
        for (int dt = 0; dt < 4; ++dt)
#pragma unroll
            for (int q = 0; q < 16; ++q) o[dt][q] = 0.f;
        const float c2 = 0.08838834764831845f * 1.4426950408889634f;
        const int xr = r & 15, vq = (lane & 15) >> 2, qi = 32 * w + r, ntile = own ? ((32 * w + 31) >> 6) + 1 : 4;
        const int kfo = r * 256, vfo = 65536 + (4 * hh + vq) * 256 + 32 * ((lane >> 4) & 1) + 8 * (lane & 3);
        const LAS unsigned char* kad[8]; const LAS unsigned char* vad[4];
#pragma unroll
        for (int ss = 0; ss < 8; ++ss) kad[ss] = C.lds + kfo + (((2 * ss + hh) ^ xr) << 4);
#pragma unroll
        for (int dt = 0; dt < 4; ++dt) vad[dt] = C.lds + vfo + 64 * (dt ^ vq);
        for (int t = 0; t < ntile; ++t) {
            const int toff = t * 16384;
            f32x16 p0, p1;
#pragma unroll
            for (int q = 0; q < 16; ++q) { p0[q] = 0.f; p1[q] = 0.f; }
#pragma unroll
            for (int ss = 0; ss < 8; ++ss) { const LAS unsigned char* ka = kad[ss] + toff; const bf16x8 a0 = *(const LAS bf16x8*)ka, a1 = *(const LAS bf16x8*)(ka + 32 * 256);
                p0 = MFMA32(a0, qf[ss], p0); p1 = MFMA32(a1, qf[ss], p1); }
            if (own) {
#pragma unroll
                for (int q = 0; q < 16; ++q) { const int kk = 64 * t + crow(q, hh); if (kk > qi) p0[q] = -INFINITY; if (kk + 32 > qi) p1[q] = -INFINITY; } }
            float mx = fmaxf(p0[0], p1[0]), mxb = fmaxf(p0[1], p1[1]);
#pragma unroll
            for (int q = 2; q < 16; q += 2) { float r_, r2_; asm("v_max3_f32 %0, %1, %2, %3" : "=v"(r_) : "v"(mx), "v"(p0[q]), "v"(p1[q])); asm("v_max3_f32 %0, %1, %2, %3" : "=v"(r2_) : "v"(mxb), "v"(p0[q + 1]), "v"(p1[q + 1])); mx = r_; mxb = r2_; }
            mx = fmaxf(mx, mxb);
            { auto rr = __builtin_amdgcn_permlane32_swap(__float_as_uint(mx), __float_as_uint(mx), false, false); mx = fmaxf(__uint_as_float(rr[0]), __uint_as_float(rr[1])); }
            const float tmax = mx * c2; float alpha = 1.f;
            if (__ballot(tmax - m_run > 8.f) != 0ull) { const float m_new = fmaxf(m_run, tmax); alpha = __builtin_amdgcn_exp2f(m_run - m_new); m_run = m_new;
#pragma unroll
                for (int dt = 0; dt < 4; ++dt)
#pragma unroll
                    for (int q = 0; q < 16; ++q) o[dt][q] *= alpha; }
            float rs = 0.f;
#pragma unroll
            for (int q = 0; q < 16; ++q) { p0[q] = __builtin_amdgcn_exp2f(p0[q] * c2 - m_run); p1[q] = __builtin_amdgcn_exp2f(p1[q] * c2 - m_run); rs += p0[q] + p1[q]; }
            l_run = l_run * alpha + rs;
            bf16x8 pf[4];
            pf[0] = pack8(p0[0], p0[1], p0[2], p0[3], p0[4], p0[5], p0[6], p0[7]); pf[1] = pack8(p0[8], p0[9], p0[10], p0[11], p0[12], p0[13], p0[14], p0[15]);
            pf[2] = pack8(p1[0], p1[1], p1[2], p1[3], p1[4], p1[5], p1[6], p1[7]); pf[3] = pack8(p1[8], p1[9], p1[10], p1[11], p1[12], p1[13], p1[14], p1[15]);
#pragma unroll
            for (int dt = 0; dt < 4; ++dt) { const LAS unsigned char* vd = vad[dt] + toff;
#pragma unroll
                for (int kk = 0; kk < 4; ++kk) { const s16x4 lo = vtr(vd + (16 * kk) * 256), hi = vtr(vd + (16 * kk + 8) * 256); o[dt] = MFMA32(cat4(lo, hi), pf[kk], o[dt]); } }
        }
    }
    attn_q_load(C, cntl, na0, na1, nent, NQ);
    if (wave_on) {
        SUBTS(8);
        l_run += __shfl_xor(l_run, 32);
        const float inv = 1.f / l_run; v4u wv[4][2];
#pragma unroll
        for (int dt = 0; dt < 4; ++dt)
#pragma unroll
            for (int kp = 0; kp < 2; ++kp) { const unsigned w0 = pk2(o[dt][8 * kp] * inv, o[dt][8 * kp + 1] * inv), w1 = pk2(o[dt][8 * kp + 2] * inv, o[dt][8 * kp + 3] * inv), w2 = pk2(o[dt][8 * kp + 4] * inv, o[dt][8 * kp + 5] * inv), w3 = pk2(o[dt][8 * kp + 6] * inv, o[dt][8 * kp + 7] * inv);
                auto r0 = __builtin_amdgcn_permlane32_swap(w0, w2, false, false); auto r1 = __builtin_amdgcn_permlane32_swap(w1, w3, false, false); wv[dt][kp] = (v4u){r0[0], r1[0], r0[1], r1[1]}; }
        if (valid) { const size_t row = ((tb + qtok) * NH + h) * 4 + slot; bf16* op = C.PART + row * 128 + 8 * hh;
#pragma unroll
            for (int dt = 0; dt < 4; ++dt)
#pragma unroll
                for (int kp = 0; kp < 2; ++kp) *(v4u*)(op + 32 * dt + 16 * kp) = wv[dt][kp];
            if (hh == 0) *(f32x2*)(C.ML + row * 2) = (f32x2){m_run, l_run}; }
    }
    asm volatile("s_waitcnt lgkmcnt(0)" ::: "memory"); __builtin_amdgcn_s_barrier();
    SUBTS(9);
}
struct MergeIn { unsigned short sel; f32x2 ml[4]; v4u pa[4], pc[4]; };
__device__ __forceinline__ void moba_merge_load(const Ctx& C, size_t t, MergeIn& m) {
    const int lane = C.lane, hd = lane >> 3, dc = lane & 7; const size_t row0 = (t * NH + hd) * 4;
    m.sel = C.SEL[t * NH + hd];
#pragma unroll
    for (int s = 0; s < 4; ++s) { m.ml[s] = *(const f32x2*)(C.ML + (row0 + s) * 2); const v4u* pp = (const v4u*)(C.PART + (row0 + s) * 128 + 16 * dc); m.pa[s] = pp[0]; m.pc[s] = pp[1]; }
}
__device__ __forceinline__ void moba_merge_store(const Ctx& C, size_t t, MergeIn& m) {
    const int lane = C.lane, hd = lane >> 3, dc = lane & 7;
    const int np = m.sel >> 12; float M = -1e30f, wg[4], wsum = 0.f;
#pragma unroll
    for (int s = 0; s < 4; ++s) { const bool v = (s == 3) || (s < np); m.ml[s].x = v ? m.ml[s].x : -1e30f; m.ml[s].y = v ? m.ml[s].y : 0.f; M = fmaxf(M, m.ml[s].x); }
#pragma unroll
    for (int s = 0; s < 4; ++s) { wg[s] = m.ml[s].y * __builtin_amdgcn_exp2f(m.ml[s].x - M); wsum += wg[s]; }
    const float inv = 1.f / wsum; float acc[16];
#pragma unroll
    for (int q = 0; q < 16; ++q) acc[q] = 0.f;
#pragma unroll
    for (int s = 0; s < 4; ++s) { const unsigned vm = ((s == 3) || (s < np)) ? 0xffffffffu : 0u; const float ws_ = wg[s] * inv; v4u a = m.pa[s], c = m.pc[s];
        a.x &= vm; a.y &= vm; a.z &= vm; a.w &= vm; c.x &= vm; c.y &= vm; c.z &= vm; c.w &= vm;
        acc[0] += ws_ * bflo(a.x); acc[1] += ws_ * bfhi(a.x); acc[2] += ws_ * bflo(a.y); acc[3] += ws_ * bfhi(a.y); acc[4] += ws_ * bflo(a.z); acc[5] += ws_ * bfhi(a.z); acc[6] += ws_ * bflo(a.w); acc[7] += ws_ * bfhi(a.w);
        acc[8] += ws_ * bflo(c.x); acc[9] += ws_ * bfhi(c.x); acc[10] += ws_ * bflo(c.y); acc[11] += ws_ * bfhi(c.y); acc[12] += ws_ * bflo(c.z); acc[13] += ws_ * bfhi(c.z); acc[14] += ws_ * bflo(c.w); acc[15] += ws_ * bfhi(c.w); }
    v4u o0, o1; o0.x = pk2(acc[0], acc[1]); o0.y = pk2(acc[2], acc[3]); o0.z = pk2(acc[4], acc[5]); o0.w = pk2(acc[6], acc[7]); o1.x = pk2(acc[8], acc[9]); o1.y = pk2(acc[10], acc[11]); o1.z = pk2(acc[12], acc[13]); o1.w = pk2(acc[14], acc[15]);
    v4u* op = (v4u*)(C.CONCAT + t * D + 1024 + hd * 128 + 16 * dc); op[0] = o0; op[1] = o1;
}
__device__ __forceinline__ void moba_merge_pair(const Ctx& C, size_t ta, size_t tb, bool has_b) {
    MergeIn A, B; moba_merge_load(C, ta, A); moba_merge_load(C, has_b ? tb : ta, B);
    moba_merge_store(C, ta, A); if (has_b) moba_merge_store(C, tb, B);
}

constexpr int GKP = 192;
__device__ __forceinline__ void gla_v_to_lds(const Ctx& C, size_t t0, int h, int off) {
#pragma unroll
    for (int pp = 0; pp < 2; ++pp) { const int p = C.tid + 512 * pp; const v4u v = *(const v4u*)(C.PROJ + (t0 + (p >> 4)) * NPROJ + GV + h * 128 + 8 * (p & 15)); *(LAS v4u*)(C.lds + off + (p >> 4) * VP + 16 * (p & 15)) = v; }
}
__device__ __forceinline__ void gla_u_item(const Ctx& C, int b, int h, int n4) {
    const int tid = C.tid, lane = C.lane, w = C.wave, r = lane & 31, hh = lane >> 5;
    v4u kr[4], vr[4][2];
#pragma unroll
    for (int c = 0; c < 4; ++c) { const size_t t0 = (size_t)b * SEQ + 64 * (4 * n4 + c); const int tok = tid >> 3, ch = tid & 7;
        kr[c] = *(const v4u*)(C.KUPD + (t0 + tok) * 512 + h * 64 + 8 * ch);
#pragma unroll
        for (int pp = 0; pp < 2; ++pp) { const int p = tid + 512 * pp; vr[c][pp] = *(const v4u*)(C.PROJ + (t0 + (p >> 4)) * NPROJ + GV + h * 128 + 8 * (p & 15)); } }
#pragma unroll
    for (int c = 0; c < 4; ++c) { const int tok = tid >> 3, ch = tid & 7; *(LAS v4u*)(C.lds + c * 32768 + tok * GKP + 16 * ch) = kr[c];
#pragma unroll
        for (int pp = 0; pp < 2; ++pp) { const int p = tid + 512 * pp; *(LAS v4u*)(C.lds + c * 32768 + 64 * GKP + (p >> 4) * VP + 16 * (p & 15)) = vr[c][pp]; } }
    __syncthreads();
    const int mt = w & 3, nt = w >> 2, q = (lane & 15) >> 2, cb = (16 * ((lane >> 4) & 1) + 4 * (lane & 3)) * 2;
#pragma unroll
    for (int c = 0; c < 4; ++c) {
        const LAS unsigned char* va = C.lds + c * 32768 + 64 * GKP + (4 * hh + q) * VP + cb + mt * 64; const LAS unsigned char* ka = C.lds + c * 32768 + (4 * hh + q) * GKP + cb + nt * 64;
        f32x16 acc;
#pragma unroll
        for (int i = 0; i < 16; ++i) acc[i] = 0.f;
#pragma unroll
        for (int s = 0; s < 4; ++s) acc = MFMA32(cat4(vtr(va + 16 * s * VP), vtr(va + (16 * s + 8) * VP)), cat4(vtr(ka + 16 * s * GKP), vtr(ka + (16 * s + 8) * GKP)), acc);
        float* up = C.UT + (size_t)((b * NH + h) * 64 + 4 * n4 + c) * 8192 + (32 * mt) * 64 + 32 * nt + r;
#pragma unroll
        for (int i = 0; i < 16; ++i) up[crow(i, hh) * 64] = acc[i];
    }
    __syncthreads();
}
__device__ __forceinline__ void gla_scan_item(const Ctx& C, int id) {
    { const int idx = id * NTHREADS + C.tid;
        const int bh = idx >> 13, rem = idx & 8191, dk = rem & 63; float s = 0.f;
        const float* up = C.UT + (size_t)bh * 64 * 8192 + rem; const float* dp = C.DEC + (size_t)bh * 64 * 64 + dk; bf16* sp = C.ST + (size_t)bh * 64 * 8192 + rem;
        float uv[64], dv[64];
#pragma unroll
        for (int n = 0; n < 64; ++n) { uv[n] = up[(size_t)n * 8192]; dv[n] = dp[n * 64]; }
#pragma unroll
        for (int n = 0; n < 64; ++n) { sp[(size_t)n * 8192] = (bf16)(pk2(s, 0.f) & 0xffffu); s = dv[n] * s + uv[n]; }
    }
}

__device__ __forceinline__ void p5_attn_phase(const Ctx& C, int rep) {
    volatile LAS int* qslot = (volatile LAS int*)(C.lds + MISC_OFF + 64);
    LAS int* pfx = (LAS int*)(C.lds + RING_BYTES + 1024);
    LAS int* cntl = (LAS int*)(C.lds + RING_BYTES + 2112);
    if (C.tid < 256) { const int c = ((C.tid & 15) < 15) ? (int)C.ctl[CW_LCNT + C.tid * 8] : 0; pfx[1 + C.tid] = (c + 255) >> 8; cntl[C.tid] = c; }
    __syncthreads();
    if (C.tid < 64) {
        const int l4 = 4 * C.tid; int v0 = pfx[1 + l4], v1 = v0 + pfx[2 + l4], v2 = v1 + pfx[3 + l4], v3 = v2 + pfx[4 + l4]; int run = v3;
#pragma unroll
        for (int o = 1; o < 64; o <<= 1) { const int up = __shfl_up(run, o); if (C.tid >= o) run += up; }
        const int base = run - v3;
        pfx[1 + l4] = base + v0; pfx[2 + l4] = base + v1; pfx[3 + l4] = base + v2; pfx[4 + l4] = base + v3; if (C.tid == 0) pfx[0] = 0; }
    __syncthreads();
    const int npast = pfx[256]; unsigned* cnt = C.ctl + CW_Q + 64 * rep;
    int c0, c1; AttnQ Q, NQ;
    { const int id0 = C.vcu; __syncthreads(); p5_publish_next(C, id0, npast, pfx, qslot); __syncthreads(); c0 = qslot[0]; c1 = qslot[1]; }
    { const int ent = attn_list_load(C, cntl, c0, c1); attn_q_load(C, cntl, c0, c1, ent, Q); }
    __syncthreads();
    while (c0 >= 0) {
        Ctx C5 = C; { int t_ = C.tid; asm volatile("" : "+v"(t_)); C5.tid = t_; C5.lane = t_ & 63; }
        int nid = 0; if (C5.tid == 0) nid = C5.G + (int)atomicAdd(cnt, 1u);
        int n0, n1;
        if (c0 < 256) moba_attn_item(C5, cntl, c0 >> 7, (c0 >> 4) & 7, c0 & 15, c1 < 0, Q, nid, npast, pfx, qslot, n0, n1, NQ);
        else { p5_publish_next(C5, nid, npast, pfx, qslot); __syncthreads(); n0 = qslot[0]; n1 = qslot[1]; const int nent = attn_list_load(C5, cntl, n0, n1);
               gla_scan_item(C5, c0 - 512); attn_q_load(C5, cntl, n0, n1, nent, NQ); asm volatile("s_waitcnt lgkmcnt(0)" ::: "memory"); __builtin_amdgcn_s_barrier(); }
        c0 = n0; c1 = n1; Q = NQ;
    }
}


struct GlaRaw { v4u vraw[2], sraw[2], graw_[2], qraw, kraw; };
__device__ __forceinline__ void gla_out_load(const Ctx& C, int b, int h, int n, GlaRaw& R) {
    const int tid = C.tid; const size_t t0 = (size_t)b * SEQ + 64 * n; const int bhn = (b * NH + h) * 64 + n;
#pragma unroll
    for (int pp = 0; pp < 2; ++pp) { const int p = tid + 512 * pp; R.vraw[pp] = *(const v4u*)(C.PROJ + (t0 + (p >> 4)) * NPROJ + GV + h * 128 + 8 * (p & 15));
        R.graw_[pp] = *(const v4u*)(C.PROJ + (t0 + (p >> 4)) * NPROJ + GG + h * 128 + 8 * (p & 15)); R.sraw[pp] = *(const v4u*)(C.ST + (size_t)bhn * 8192 + (p >> 3) * 64 + 8 * (p & 7)); }
    R.qraw = *(const v4u*)(C.QDEC + (t0 + (tid >> 3)) * 512 + h * 64 + 8 * (tid & 7)); R.kraw = *(const v4u*)(C.KDEC + (t0 + (tid >> 3)) * 512 + h * 64 + 8 * (tid & 7));
}
__device__ __forceinline__ void gla_out_item(const Ctx& C, int b, int h, int n, const GlaRaw& R, bool has_next, int nb, int nh, int nn, GlaRaw& N) {
    const int lane = C.lane, w = C.wave, r = lane & 31, hh = lane >> 5, dvt = w & 3, lt = w >> 2; const size_t t0 = (size_t)b * SEQ + 64 * n; const int bhn = (b * NH + h) * 64 + n;
    constexpr int VT = 0, RED = 64 * VP, QT = RED + 1024, KT = QT + 64 * 144, SST = KT + 64 * 144, GT = SST + 128 * 144;
    const size_t tl = t0 + 32 * lt + r;
    f32x4 gn[4];
    { const int tid = C.tid;
#pragma unroll
      for (int k4 = 0; k4 < 4; ++k4) gn[k4] = *(const f32x4*)(C.gla_g + 32 * dvt + 8 * k4 + 4 * hh);
#pragma unroll
      for (int pp = 0; pp < 2; ++pp) { const int p = tid + 512 * pp; *(LAS v4u*)(C.lds + VT + (p >> 4) * VP + 16 * (p & 15)) = R.vraw[pp]; *(LAS v4u*)(C.lds + GT + (p >> 4) * 272 + 16 * (p & 15)) = R.graw_[pp];
          *(LAS v4u*)(C.lds + SST + (p >> 3) * 144 + 16 * (p & 7)) = R.sraw[pp]; }
      *(LAS v4u*)(C.lds + QT + (tid >> 3) * 144 + 16 * (tid & 7)) = R.qraw; *(LAS v4u*)(C.lds + KT + (tid >> 3) * 144 + 16 * (tid & 7)) = R.kraw; }
    asm volatile("s_waitcnt lgkmcnt(0)" ::: "memory"); __builtin_amdgcn_s_barrier();
    if (has_next) gla_out_load(C, nb, nh, nn, N);
    bf16x8 qd[4], kd[2][4], sfr[4]; v2u graw[4];
#pragma unroll
    for (int s = 0; s < 4; ++s) { const int co = 32 * s + 16 * hh; qd[s] = *(const LAS bf16x8*)(C.lds + QT + (32 * lt + r) * 144 + co); kd[1][s] = *(const LAS bf16x8*)(C.lds + KT + (32 * lt + r) * 144 + co);
        kd[0][s] = *(const LAS bf16x8*)(C.lds + KT + r * 144 + co); sfr[s] = *(const LAS bf16x8*)(C.lds + SST + (32 * dvt + r) * 144 + co); }
#pragma unroll
    for (int k4 = 0; k4 < 4; ++k4) graw[k4] = *(const LAS v2u*)(C.lds + GT + (32 * lt + r) * 272 + (32 * dvt + 8 * k4 + 4 * hh) * 2);
    f32x16 o;
#pragma unroll
    for (int i = 0; i < 16; ++i) o[i] = 0.f;
    const LAS unsigned char* va = C.lds + VT + (4 * hh + ((lane & 15) >> 2)) * VP + (16 * ((lane >> 4) & 1) + 4 * (lane & 3)) * 2 + dvt * 64;
#pragma unroll
    for (int mt = 0; mt < 2; ++mt) {
        if (mt > lt) break;
        const bool diag = (mt == lt); f32x16 X;
#pragma unroll
        for (int i = 0; i < 16; ++i) X[i] = 0.f;
#pragma unroll
        for (int s = 0; s < 4; ++s) X = MFMA32(diag ? kd[1][s] : kd[0][s], qd[s], X);
        if (diag) {
#pragma unroll
            for (int i = 0; i < 16; ++i) if (crow(i, hh) > r) X[i] = 0.f; }
        const bf16x8 pf0 = pack8(X[0], X[1], X[2], X[3], X[4], X[5], X[6], X[7]), pf1 = pack8(X[8], X[9], X[10], X[11], X[12], X[13], X[14], X[15]);
        o = MFMA32(cat4(vtr(va + (32 * mt) * VP), vtr(va + (32 * mt + 8) * VP)), pf0, o);
        o = MFMA32(cat4(vtr(va + (32 * mt + 16) * VP), vtr(va + (32 * mt + 24) * VP)), pf1, o);
    }
#pragma unroll
    for (int s = 0; s < 4; ++s) o = MFMA32(sfr[s], qd[s], o);
    float ss = 0.f;
#pragma unroll
    for (int i = 0; i < 16; ++i) ss += o[i] * o[i];
    ss += __shfl_xor(ss, 32);
    LAS float* red = (LAS float*)(C.lds + RED);
    if (hh == 0) red[dvt * 64 + 32 * lt + r] = ss;
    asm volatile("s_waitcnt lgkmcnt(0)" ::: "memory"); __builtin_amdgcn_s_barrier();
    const int l = 32 * lt + r; const float rstd = rsqrtf((red[l] + red[64 + l] + red[128 + l] + red[192 + l]) * (1.f / 128.f) + EPS); v2u wpk[4];
#pragma unroll
    for (int k4 = 0; k4 < 4; ++k4) {
        const float ga = bflo(graw[k4].x), gb = bfhi(graw[k4].x), gc = bflo(graw[k4].y), gd = bfhi(graw[k4].y); const f32x4 gnv = gn[k4];
        const float y0 = o[4 * k4] * rstd * gnv.x * (ga / (1.f + __expf(-ga))), y1 = o[4 * k4 + 1] * rstd * gnv.y * (gb / (1.f + __expf(-gb)));
        const float y2 = o[4 * k4 + 2] * rstd * gnv.z * (gc / (1.f + __expf(-gc))), y3 = o[4 * k4 + 3] * rstd * gnv.w * (gd / (1.f + __expf(-gd)));
        wpk[k4].x = pk2(y0, y1); wpk[k4].y = pk2(y2, y3); }
#pragma unroll
    for (int kp = 0; kp < 2; ++kp) { auto r0 = __builtin_amdgcn_permlane32_swap(wpk[2 * kp].x, wpk[2 * kp + 1].x, false, false); auto r1 = __builtin_amdgcn_permlane32_swap(wpk[2 * kp].y, wpk[2 * kp + 1].y, false, false);
        *(v4u*)(C.CONCAT + tl * D + h * 128 + 32 * dvt + 16 * kp + 8 * hh) = (v4u){r0[0], r1[0], r0[1], r1[1]}; }
    asm volatile("s_waitcnt lgkmcnt(0)" ::: "memory"); __builtin_amdgcn_s_barrier();
}


#define INS16(L, xin) do { int x_ = (xin); _Pragma("unroll") for (int i_ = 0; i_ < 16; ++i_) { const int hi_ = max(L[i_], x_); x_ = min(L[i_], x_); L[i_] = hi_; } } while (0)
#define CE_DESC(a, b) do { const int hi_ = max(a, b), lo_ = min(a, b); a = hi_; b = lo_; } while (0)
#define BITONIC_MERGE16(L) do { _Pragma("unroll") for (int j_ = 8; j_ > 0; j_ >>= 1) _Pragma("unroll") for (int i_ = 0; i_ < 16; ++i_) if ((i_ & j_) == 0) CE_DESC(L[i_], L[i_ | j_]); } while (0)
#define SORT16(L) do { _Pragma("unroll") for (int k_ = 2; k_ <= 16; k_ <<= 1) _Pragma("unroll") for (int j_ = k_ >> 1; j_ > 0; j_ >>= 1) _Pragma("unroll") for (int i_ = 0; i_ < 16; ++i_) { const int l_ = i_ ^ j_; \
        if (l_ > i_) { if ((i_ & k_) == 0) CE_DESC(L[i_], L[l_]); else CE_DESC(L[l_], L[i_]); } } } while (0)
#define MERGE16(L, M) do { _Pragma("unroll") for (int i_ = 0; i_ < 16; ++i_) L[i_] = max(L[i_], M[15 - i_]); BITONIC_MERGE16(L); } while (0)
__device__ __forceinline__ int ord_key(float v) { int u = __float_as_int(v); return u ^ ((u >> 31) & 0x7fffffff); }
__device__ __forceinline__ float ord_val(int k, int mask) { int u = k & ~mask; return __int_as_float(u ^ ((u >> 31) & 0x7fffffff)); }
__device__ __forceinline__ void peer_topk_item(const Ctx& C, int tg, int hd, const LAS unsigned char* qlds, int lrow0) {
    const int lane = C.lane, r = lane & 31, hh = lane >> 5; const size_t tok = (size_t)tg * 32 + r;
    int La[16], Lb[16];
#pragma unroll
    for (int c = 0; c < 2; ++c) {
        int L[16];
#pragma unroll
        for (int i = 0; i < 16; ++i) L[i] = (int)0x80000000;
        bf16x8 qf[8];
        { const int row = lrow0 + r;
#pragma unroll
          for (int s = 0; s < 8; ++s) qf[s] = *(const LAS bf16x8*)(qlds + row * 512 + 16 * ((16 * c + 2 * s + hh) ^ (row & 15))); }
        int G[16];
        bf16x8 kfA[8], kfB[8];
#define PT_KLOAD(dst, kt) do { const bf16* kp_ = C.KEYSB + ((size_t)(hd * 2 + c) * 128 + 32 * (kt) + r) * 128 + 8 * hh; _Pragma("unroll") for (int s = 0; s < 8; ++s) dst[s] = *(const bf16x8*)(kp_ + 16 * s); } while (0)
#define PT_MMA(src) do { _Pragma("unroll") for (int i = 0; i < 16; ++i) X[i] = 0.f; _Pragma("unroll") for (int s = 0; s < 8; ++s) X = MFMA32(src[s], qf[s], X); } while (0)
#define PT_SORT(kt) do { _Pragma("unroll") for (int i = 0; i < 16; ++i) G[i] = (ord_key(X[i]) & ~127) | (32 * (kt) + crow(i, hh)); SORT16(G); MERGE16(L, G); } while (0)
        f32x16 X;
        PT_KLOAD(kfA, 0); PT_KLOAD(kfB, 1);
#pragma unroll 1
        for (int k2 = 0; k2 < 2; ++k2) {
            PT_MMA(kfA); if (k2 == 0) PT_KLOAD(kfA, 2); PT_SORT(2 * k2);
            PT_MMA(kfB); if (k2 == 0) PT_KLOAD(kfB, 3); PT_SORT(2 * k2 + 1);
        }
#undef PT_KLOAD
#undef PT_MMA
#undef PT_SORT
        int M[16];
#pragma unroll
        for (int i = 0; i < 16; ++i) M[i] = __shfl_xor(L[i], 32);
        MERGE16(L, M);
#pragma unroll
        for (int i = 0; i < 16; ++i) { if (c == 0) La[i] = L[i]; else Lb[i] = L[i]; }
    }
    SUBTS(3);
    float sa[16], sb[16]; int Lc[16];
#pragma unroll
    for (int i = 0; i < 16; ++i) { sa[i] = ord_val(La[i], 127); sb[i] = ord_val(Lb[i], 127); Lc[i] = (int)0x80000000; }
#define ST_KEY(i, j) ((ord_key(sa[i] + sb[j]) & ~255) | ((i) * 16 + (j)))
#define ST_ROWMERGE(i, n) do { _Pragma("unroll") for (int k_ = 0; k_ < (n); ++k_) Lc[15 - k_] = max(Lc[15 - k_], ST_KEY(i, k_)); BITONIC_MERGE16(Lc); } while (0)
#pragma unroll
    for (int j = 0; j < 16; ++j) Lc[j] = ST_KEY(0, j);
    ST_ROWMERGE(1, 8); ST_ROWMERGE(2, 5); ST_ROWMERGE(3, 4); ST_ROWMERGE(4, 3);
#pragma unroll
    for (int i = 5; i < 16; ++i)
#pragma unroll
        for (int j = 0; j < 16; ++j) if ((i + 1) * (j + 1) <= 16) INS16(Lc, ST_KEY(i, j));
#undef ST_KEY
#undef ST_ROWMERGE
    SUBTS(4);
    unsigned pkA[4], pkB[4];
#pragma unroll
    for (int w4 = 0; w4 < 4; ++w4) { pkA[w4] = (unsigned)(La[4 * w4] & 127) | ((unsigned)(La[4 * w4 + 1] & 127) << 8) | ((unsigned)(La[4 * w4 + 2] & 127) << 16) | ((unsigned)(La[4 * w4 + 3] & 127) << 24);
        pkB[w4] = (unsigned)(Lb[4 * w4] & 127) | ((unsigned)(Lb[4 * w4 + 1] & 127) << 8) | ((unsigned)(Lb[4 * w4 + 2] & 127) << 16) | ((unsigned)(Lb[4 * w4 + 3] & 127) << 24); }
    float e[16], sum = 0.f; int ex[16]; const float mx = ord_val(Lc[0], 255);
#pragma unroll
    for (int i = 0; i < 16; ++i) {
        e[i] = __expf(ord_val(Lc[i], 255) - mx); sum += e[i];
        const unsigned ii = ((unsigned)Lc[i] >> 4) & 15u, jj = (unsigned)Lc[i] & 15u, sa_ = (ii & 7u) | 0x0c0c0c00u, sb_ = (jj & 7u) | 0x0c0c0c00u;
        const unsigned i1 = (ii & 8u) ? __builtin_amdgcn_perm(pkA[3], pkA[2], sa_) : __builtin_amdgcn_perm(pkA[1], pkA[0], sa_);
        const unsigned i2 = (jj & 8u) ? __builtin_amdgcn_perm(pkB[3], pkB[2], sb_) : __builtin_amdgcn_perm(pkB[1], pkB[0], sb_);
        ex[i] = (int)(i1 * 128u + i2);
    }
    SUBTS(5);
    const float inv = 1.f / sum;
    if (hh == 0) {
        v4u* ep = (v4u*)(C.EXPI + tok * 128 + hd * 16); f32x4* gp = (f32x4*)(C.GATE + tok * 128 + hd * 16); f32x4* up = (f32x4*)(C.GU + tok * 128 + hd * 16);
        unsigned sc[16];
#pragma unroll
        for (int k = 0; k < 16; ++k) sc[k] = C.UVS[ex[k]];
        const float hs = C.HS[tok];
#pragma unroll
        for (int q = 0; q < 4; ++q) { ep[q] = (v4u){(unsigned)ex[4 * q], (unsigned)ex[4 * q + 1], (unsigned)ex[4 * q + 2], (unsigned)ex[4 * q + 3]};
            gp[q] = (f32x4){e[4 * q] * inv * bfhi(sc[4 * q]), e[4 * q + 1] * inv * bfhi(sc[4 * q + 1]), e[4 * q + 2] * inv * bfhi(sc[4 * q + 2]), e[4 * q + 3] * inv * bfhi(sc[4 * q + 3])};
            up[q] = (f32x4){hs * bflo(sc[4 * q]), hs * bflo(sc[4 * q + 1]), hs * bflo(sc[4 * q + 2]), hs * bflo(sc[4 * q + 3])};
            }
    }
}

__device__ __forceinline__ int peer_dequeue(const Ctx& C, unsigned* cnt, int xcc) {
    volatile LAS int* slot = (volatile LAS int*)(C.lds + MISC_OFF + 64);
    asm volatile("s_waitcnt lgkmcnt(0)" ::: "memory"); __builtin_amdgcn_s_barrier();
    if (C.tid == 0) { int res = -1;
        { const unsigned id = atomicAdd(cnt + 64 * xcc, 1u); if (id < (unsigned)NCHUNK) res = xcc * NCHUNK + (int)id; }
        for (int tries = 0; tries < 64 && res < 0; ++tries) {
            unsigned hd[NSL];
#pragma unroll
            for (int s = 0; s < NSL; ++s) hd[s] = __hip_atomic_load(cnt + 64 * ((xcc + s) & (NSL - 1)), __ATOMIC_RELAXED, __HIP_MEMORY_SCOPE_AGENT);
            int pick = -1;
#pragma unroll
            for (int s = NSL - 1; s >= 0; --s) pick = (hd[s] < (unsigned)NCHUNK) ? s : pick;
            if (pick < 0) break;
            const int sl = (xcc + pick) & (NSL - 1); const unsigned id = atomicAdd(cnt + 64 * sl, 1u); if (id < (unsigned)NCHUNK) res = sl * NCHUNK + (int)id; }
        *slot = res; }
    asm volatile("s_waitcnt lgkmcnt(0)" ::: "memory"); __builtin_amdgcn_s_barrier();
    return *slot;
}
#define ROWSUM16(d) do { d += __builtin_amdgcn_update_dpp(0, d, 0x121, 0xf, 0xf, false); d += __builtin_amdgcn_update_dpp(0, d, 0x122, 0xf, 0xf, false); \
                         d += __builtin_amdgcn_update_dpp(0, d, 0x124, 0xf, 0xf, false); d += __builtin_amdgcn_update_dpp(0, d, 0x128, 0xf, 0xf, false); } while (0)
#define PA_ISSUE1(buf, esrc, j_) buf[j_] = *(const v4u*)(tab + (((unsigned)__builtin_amdgcn_ds_swizzle(esrc, ((j_) << 5) | 0x10) << 8) + lo16))
#define PA_ISSUE(buf, esrc) do { PA_ISSUE1(buf, esrc, 0); PA_ISSUE1(buf, esrc, 1); PA_ISSUE1(buf, esrc, 2); PA_ISSUE1(buf, esrc, 3); PA_ISSUE1(buf, esrc, 4); PA_ISSUE1(buf, esrc, 5); PA_ISSUE1(buf, esrc, 6); PA_ISSUE1(buf, esrc, 7); \
        PA_ISSUE1(buf, esrc, 8); PA_ISSUE1(buf, esrc, 9); PA_ISSUE1(buf, esrc, 10); PA_ISSUE1(buf, esrc, 11); PA_ISSUE1(buf, esrc, 12); PA_ISSUE1(buf, esrc, 13); PA_ISSUE1(buf, esrc, 14); PA_ISSUE1(buf, esrc, 15); } while (0)
#define PA_RS(out, lo, hi, bit, rot) do { const int s_ = (bit) ? (lo) : (hi); int k_ = (bit) ? (hi) : (lo); k_ += __builtin_amdgcn_update_dpp(0, s_, 0x120 + (rot), 0xf, 0xf, false); out = k_; } while (0)
#define PA_COMPUTE(buf, hq_, dstv) do { int d_[16]; _Pragma("unroll") for (int j_ = 0; j_ < 16; ++j_) { const v4u u_ = buf[j_]; \
        int t_ = __builtin_amdgcn_sdot4((int)hq_.x, (int)u_.x, 0, false); t_ = __builtin_amdgcn_sdot4((int)hq_.y, (int)u_.y, t_, false); t_ = __builtin_amdgcn_sdot4((int)hq_.z, (int)u_.z, t_, false); d_[j_] = __builtin_amdgcn_sdot4((int)hq_.w, (int)u_.w, t_, false); } \
        int e8_[8], e4_[4], e2_[2]; _Pragma("unroll") for (int p_ = 0; p_ < 8; ++p_) PA_RS(e8_[p_], d_[2 * p_], d_[2 * p_ + 1], b0, 1); \
        _Pragma("unroll") for (int p_ = 0; p_ < 4; ++p_) PA_RS(e4_[p_], e8_[2 * p_], e8_[2 * p_ + 1], b1, 2); \
        PA_RS(e2_[0], e4_[0], e4_[1], b2, 4); PA_RS(e2_[1], e4_[2], e4_[3], b2, 4); PA_RS(dstv, e2_[0], e2_[1], b3, 8); } while (0)
__device__ __forceinline__ void peer_a_chunk(const Ctx& C, int t0, int x, int* act) {
    const int lane = C.lane, i = lane & 15;
    v4u hq[8]; int el[8], eh[8];
#pragma unroll
    for (int tt = 0; tt < 8; ++tt) { hq[tt] = __builtin_nontemporal_load((const v4u*)(C.HQ + ((size_t)x * T + t0 + tt) * SLW + 16 * i)); el[tt] = __builtin_nontemporal_load(C.EXPI + (size_t)(t0 + tt) * 128 + lane); eh[tt] = __builtin_nontemporal_load(C.EXPI + (size_t)(t0 + tt) * 128 + 64 + lane); }
    if (PROBE_EMASK != 0x3fff && act != C.ACT) {
#pragma unroll
        for (int tt = 0; tt < 8; ++tt) { el[tt] &= PROBE_EMASK; eh[tt] &= PROBE_EMASK; } }
    const unsigned char* tab = C.UQ + (size_t)x * NEXP * SLW; const unsigned lo16 = 16u * (unsigned)i; const bool b0 = i & 1, b1 = i & 2, b2 = i & 4, b3 = i & 8;
    v4u bA[16], bB[16];
    PA_ISSUE(bA, el[0]);
#pragma unroll
    for (int tt = 0; tt < 8; ++tt) {
        __builtin_amdgcn_sched_barrier(0);
        PA_ISSUE(bB, eh[tt]);
        int r_lo = 0, r_hi = 0;
        PA_COMPUTE(bA, hq[tt], r_lo);
        if (tt + 1 < 8) PA_ISSUE(bA, el[tt + 1]);
        PA_COMPUTE(bB, hq[tt], r_hi);
        act[((size_t)x * T + t0 + tt) * 128 + lane] = r_lo; act[((size_t)x * T + t0 + tt) * 128 + 64 + lane] = r_hi;
    }
}
#undef PA_ISSUE
#undef PA_ISSUE1
#undef PA_COMPUTE
#undef PA_RS
__device__ __forceinline__ void peer_weights_token(const Ctx& C, size_t t) {
    const int lane = C.lane; const size_t o = t * 128 + lane;
    int s_lo = 0, s_hi = 0;
#pragma unroll
    for (int x = 0; x < NSL; ++x) { s_lo += C.ACT[(size_t)x * T * 128 + o]; s_hi += C.ACT[(size_t)x * T * 128 + o + 64]; }
    const float a_lo = (float)s_lo * C.GU[o], a_hi = (float)s_hi * C.GU[o + 64];
    const float w_lo = C.GATE[o] * 0.5f * a_lo * (1.f + erff(a_lo * 0.70710678118654752f)), w_hi = C.GATE[o + 64] * 0.5f * a_hi * (1.f + erff(a_hi * 0.70710678118654752f));
    const float wm = wave_max(fmaxf(fabsf(w_lo), fabsf(w_hi))), winv = wm > 0.f ? 127.f / wm : 0.f;
    unsigned p_lo = (unsigned)((int)rintf(w_lo * winv) & 0xff), p_hi = (unsigned)((int)rintf(w_hi * winv) & 0xff);
    p_lo |= (unsigned)__builtin_amdgcn_update_dpp(0, (int)p_lo, 0xB1, 0xf, 0xf, false) << 8; p_lo |= (unsigned)__builtin_amdgcn_update_dpp(0, (int)p_lo, 0x4E, 0xf, 0xf, false) << 16;
    p_hi |= (unsigned)__builtin_amdgcn_update_dpp(0, (int)p_hi, 0xB1, 0xf, 0xf, false) << 8; p_hi |= (unsigned)__builtin_amdgcn_update_dpp(0, (int)p_hi, 0x4E, 0xf, 0xf, false) << 16;
    if ((lane & 3) == 0) { C.PW[t * 32 + (lane >> 2)] = p_lo; C.PW[t * 32 + 16 + (lane >> 2)] = p_hi; }
    if (lane == 0) C.WSC[t] = wm * (1.f / 127.f);
}
#define PB_ISSUE(buf, esrc) do { _Pragma("unroll") for (int j_ = 0; j_ < 16; ++j_) { const unsigned e_ = (unsigned)__builtin_amdgcn_ds_bpermute(4 * (16 * (j_ >> 2) + 4 * g + (j_ & 3)), esrc); buf[j_] = *(const v4u*)(tab + ((e_ << 8) + lo16)); } } while (0)
#define PB_TR4(r0_, r1_, r2_, r3_, wp_, base) do { const unsigned t0_ = __builtin_amdgcn_perm(r1_, r0_, 0x05010400u), t1_ = __builtin_amdgcn_perm(r1_, r0_, 0x07030602u), t2_ = __builtin_amdgcn_perm(r3_, r2_, 0x05010400u), t3_ = __builtin_amdgcn_perm(r3_, r2_, 0x07030602u); \
        c[(base)] = __builtin_amdgcn_sdot4((int)__builtin_amdgcn_perm(t2_, t0_, 0x05040100u), wp_, c[(base)], false); c[(base) + 1] = __builtin_amdgcn_sdot4((int)__builtin_amdgcn_perm(t2_, t0_, 0x07060302u), wp_, c[(base) + 1], false); \
        c[(base) + 2] = __builtin_amdgcn_sdot4((int)__builtin_amdgcn_perm(t3_, t1_, 0x05040100u), wp_, c[(base) + 2], false); c[(base) + 3] = __builtin_amdgcn_sdot4((int)__builtin_amdgcn_perm(t3_, t1_, 0x07060302u), wp_, c[(base) + 3], false); } while (0)
#define PB_COMPUTE(buf, psrc) do { _Pragma("unroll") for (int jb_ = 0; jb_ < 4; ++jb_) { const int wp_ = __builtin_amdgcn_ds_bpermute(4 * (16 * jb_ + 4 * g), (int)psrc); \
        PB_TR4(buf[4 * jb_].x, buf[4 * jb_ + 1].x, buf[4 * jb_ + 2].x, buf[4 * jb_ + 3].x, wp_, 0); PB_TR4(buf[4 * jb_].y, buf[4 * jb_ + 1].y, buf[4 * jb_ + 2].y, buf[4 * jb_ + 3].y, wp_, 4); \
        PB_TR4(buf[4 * jb_].z, buf[4 * jb_ + 1].z, buf[4 * jb_ + 2].z, buf[4 * jb_ + 3].z, wp_, 8); PB_TR4(buf[4 * jb_].w, buf[4 * jb_ + 1].w, buf[4 * jb_ + 2].w, buf[4 * jb_ + 3].w, wp_, 12); } } while (0)
__device__ __forceinline__ int isum_swap16(int v) { auto r = __builtin_amdgcn_permlane16_swap((unsigned)v, (unsigned)v, false, false); return (int)r[0] + (int)r[1]; }
__device__ __forceinline__ int isum_swap32(int v) { auto r = __builtin_amdgcn_permlane32_swap((unsigned)v, (unsigned)v, false, false); return (int)r[0] + (int)r[1]; }
__device__ __forceinline__ void peer_b_chunk(const Ctx& C, int t0, int x, float* dst) {
    const int lane = C.lane, i = lane & 15, g = lane >> 4, b = t0 / SEQ;
    int el[8], eh[8]; unsigned pl[8], ph[8]; float ws[8];
#pragma unroll
    for (int tt = 0; tt < 8; ++tt) { const size_t o = (size_t)(t0 + tt) * 128 + lane;
        el[tt] = __builtin_nontemporal_load(C.EXPI + o); eh[tt] = __builtin_nontemporal_load(C.EXPI + o + 64);
        const unsigned p_lo = C.PW[(size_t)(t0 + tt) * 32 + (lane >> 2)], p_hi = C.PW[(size_t)(t0 + tt) * 32 + 16 + (lane >> 2)]; ws[tt] = C.WSC[t0 + tt];
        pl[tt] = p_lo; ph[tt] = p_hi; }
    const unsigned char* tab = C.VQ + (size_t)x * NEXP * SLW; const unsigned lo16 = 16u * (unsigned)i;
    const int d0 = x * SLW + 16 * i + 4 * g; const f32x4 gm = *(const f32x4*)(C.MOD + b * NMOD + 5 * D + d0);
    v4u bA[16], bB[16];
    PB_ISSUE(bA, el[0]);
#pragma unroll
    for (int tt = 0; tt < 8; ++tt) {
        __builtin_amdgcn_sched_barrier(0);
        PB_ISSUE(bB, eh[tt]);
        const size_t off = (size_t)(t0 + tt) * D + d0; const v2u x1r = __builtin_nontemporal_load((const v2u*)(C.X1B + off)); const f32x4 x1 = {bflo(x1r.x), bfhi(x1r.x), bflo(x1r.y), bfhi(x1r.y)};
        int c[16];
#pragma unroll
        for (int q = 0; q < 16; ++q) c[q] = 0;
        PB_COMPUTE(bA, pl[tt]);
        if (tt + 1 < 8) PB_ISSUE(bA, el[tt + 1]);
        PB_COMPUTE(bB, ph[tt]);
        int e8[8], f4[4];
#pragma unroll
        for (int q = 0; q < 8; ++q) { auto r_ = __builtin_amdgcn_permlane32_swap((unsigned)c[q], (unsigned)c[q + 8], false, false); e8[q] = (int)r_[0] + (int)r_[1]; }
#pragma unroll
        for (int q = 0; q < 4; ++q) { auto r_ = __builtin_amdgcn_permlane16_swap((unsigned)e8[q], (unsigned)e8[q + 4], false, false); f4[q] = (int)r_[0] + (int)r_[1]; }
        f32x4 o;
#pragma unroll
        for (int q = 0; q < 4; ++q) o[q] = (float)f4[q] * ws[tt];
        __builtin_nontemporal_store(x1 + gm * o, (f32x4*)(dst + off));
    }
}
#undef PB_ISSUE
#undef PB_COMPUTE
#undef PB_TR4
template <int STAGE> __device__ __forceinline__ void peer_expert_phase(const Ctx& C, float* dst, int rep) {
    const int xcc = (int)(xb_xcc_id() & (NSL - 1)); unsigned* cnt = C.ctl + (STAGE == 0 ? CW_QA : CW_QB) + 64 * NSL * rep;
    for (;;) {
        const int id = peer_dequeue(C, cnt, xcc); if (id < 0) break;
        const int x = id / NCHUNK, t0 = (id % NCHUNK) * PCH + C.wave * (PCH / NWAVES);
        for (int sub = 0; sub < PCH / NWAVES; sub += 8) { if (STAGE == 0) peer_a_chunk(C, t0 + sub, x, rep ? (int*)C.QP : C.ACT); else peer_b_chunk(C, t0 + sub, x, dst); }
    }
}

__device__ __forceinline__ void first_unit(int nM, int nN, int G, int c, int& pm, int& pn) {
    const int nwg = nM * nN; if (c >= nwg) { pm = -1; pn = 0; return; }
    int wgid = c; { const int q = nwg / 8, r = nwg % 8, xcd = wgid % 8, off = wgid / 8; wgid = (xcd < r ? xcd * (q + 1) : r * (q + 1) + (xcd - r) * q) + off; }
    const int nig = 8 * nN, gid = wgid / nig, fm = gid * 8, gsz = (nM - fm) < 8 ? (nM - fm) : 8;
    pm = fm + ((wgid % nig) % gsz); pn = (wgid % nig) / gsz; (void)G;
}
struct Args { const void* in[18]; float* out; unsigned char* ws; int ph_lo, ph_hi; };
__global__ void __launch_bounds__(NTHREADS, 2) fwd_kernel(Args args) {
    extern __shared__ __attribute__((aligned(16))) unsigned char lds[];
    Ctx C;
    C.lds = (LAS unsigned char*)lds; C.tid = threadIdx.x; C.lane = C.tid & 63; C.wave = __builtin_amdgcn_readfirstlane(C.tid >> 6);
    C.G = gridDim.x; { const int bx = blockIdx.x; C.vcu = (C.G % 8 == 0) ? (bx % 8) * (C.G / 8) + bx / 8 : bx; }
    C.gw = C.vcu * NWAVES + C.wave; C.ngw = C.G * NWAVES;
    C.x = (const float*)args.in[0]; C.c = (const float*)args.in[1]; C.pos = (const int*)args.in[2]; C.w_ada = (const float*)args.in[3]; C.b_ada = (const float*)args.in[4]; C.g1 = (const float*)args.in[5];
    C.w_in = (const float*)args.in[6]; C.w_a2 = (const float*)args.in[7]; C.b_a = (const float*)args.in[8]; C.gla_g = (const float*)args.in[9]; C.qg = (const float*)args.in[10]; C.kg = (const float*)args.in[11];
    C.w_out = (const float*)args.in[12]; C.g2 = (const float*)args.in[13]; C.w_q = (const float*)args.in[14]; C.keys = (const float*)args.in[15]; C.pu = (const float*)args.in[16]; C.pv = (const float*)args.in[17];
    C.out = args.out; unsigned char* ws = args.ws;
#define CTX_WS_PTRS() do { C.ctl = (unsigned*)(ws + WS_CTL); C.MODI = (long long*)(C.ctl + CW_MOD); C.MOD = (float*)(ws + WS_MODF); C.MODP = (float*)(ws + WS_MODP); C.WIN = (bf16*)(ws + WS_WIN); C.WGA = (bf16*)(ws + WS_WGA); C.WOUT = (bf16*)(ws + WS_WOUT); C.WQ = (bf16*)(ws + WS_WQ); C.KEYSB = (bf16*)(ws + WS_KEYS); C.UQ = ws + WS_UB; C.VQ = ws + WS_VB; C.HQ = ws + WS_HQ; C.X1B = (bf16*)(ws + WS_X1B); C.WINQ = ws + WS_WIN; C.WQQ = ws + WS_WQ; C.WINS = (float*)(ws + WS_WINS); C.WQS = (float*)(ws + WS_WQS); C.US = (float*)(ws + WS_US); C.UVS = (unsigned*)(ws + WS_US); C.VS = (float*)(ws + WS_VS); C.HS = (float*)(ws + WS_HS); C.GU = (float*)(ws + WS_GU); C.PW = (unsigned*)(ws + WS_PW); C.WSC = (float*)(ws + WS_WSC); C.ACT = (int*)(ws + WS_ACT); C.QDEC = (bf16*)(ws + WS_QDEC); C.KDEC = (bf16*)(ws + WS_KDEC); C.KUPD = (bf16*)(ws + WS_KUPD); C.PART = (bf16*)(ws + WS_PART); C.ML = (float*)(ws + WS_ML); C.LIST = (unsigned short*)(ws + WS_LIST); C.SEL = (unsigned short*)(ws + WS_SEL); C.H = (bf16*)(ws + WS_H); C.CONCAT = (bf16*)(ws + WS_CONCAT); C.PROJ = (bf16*)(ws + WS_PROJ); C.ST = (bf16*)(ws + WS_ST); C.CS = (float*)(ws + WS_CS); C.KMEAN = (float*)(ws + WS_KMEAN); C.DEC = (float*)(ws + WS_DEC); C.BCUM = (float*)(ws + WS_BCUM); C.UT = (float*)(ws + WS_UT); C.QP = (float*)(ws + WS_QP); C.GATE = (float*)(ws + WS_GATE); C.EXPI = (int*)(ws + WS_EXP); } while (0)
    CTX_WS_PTRS();
    for (int u = C.tid; u < (LDS_BYTES - RING_BYTES) / 4; u += NTHREADS) ((LAS unsigned*)(C.lds + RING_BYTES))[u] = 0u;
    __syncthreads();
    const int lo = args.ph_lo, hi = args.ph_hi;
    if (PROBE_TS >= 0 && blockIdx.x == PROBE_BLK && threadIdx.x == 0) ((volatile LAS unsigned long long*)(C.lds + RING_BYTES + 8192))[0] = __builtin_amdgcn_s_memrealtime();
    XcdBarrier bar; bar.bar = C.ctl + CW_BAR; bar.x = 0; bar.st = nullptr;
    if (hi - lo > 1) bar = xcd_barrier_post(C.ctl + CW_BAR, (volatile LAS unsigned*)(C.lds + MISC_OFF) + 8);
#ifndef SKIPMASK
#define SKIPMASK 0
#endif
#ifndef REPEATMASK
#define REPEATMASK 0
#endif
#define IN(k) (!((SKIPMASK >> (k)) & 1) && lo <= (k) && (k) < hi)
#define REP(k, ...) do { if ((REPEATMASK >> (k)) & 1) { const int rep_ = 1; (void)rep_; __VA_ARGS__; xcd_barrier(bar); } { const int rep_ = 0; (void)rep_; __VA_ARGS__; } } while (0)
#define SEAM(k) do { if (PROBE_ARR && PROBE_TS >= 0 && blockIdx.x == PROBE_BLK && threadIdx.x == 0) ((volatile LAS unsigned long long*)(C.lds + RING_BYTES + 8192))[32 + (k)] = __builtin_amdgcn_s_memrealtime(); if (IN(k) && IN((k) + 1)) xcd_barrier(bar); if (PROBE_TS >= 0 && blockIdx.x == PROBE_BLK && threadIdx.x == 0) ((volatile LAS unsigned long long*)(C.lds + RING_BYTES + 8192))[(k) + 1] = __builtin_amdgcn_s_memrealtime(); { int t_ = C.tid; asm volatile("" : "+v"(t_)); C.tid = t_; C.lane = t_ & 63; } CTX_WS_PTRS(); } while (0)
    if (IN(0)) REP(0, p0_phase(C, rep_)); SEAM(0);
    if (IN(1)) REP(1, norm_mod_phase<true>(C, C.x, C.g1, 0, D, C.H)); SEAM(1);
    if (IN(2)) REP(2, pg8::Gemm g{(const bf16*)C.HQ, (const bf16*)C.WINQ, T, NPROJ, D / 2, 256, (size_t)T * 256}; pg8::StaticOrder S; S.init(T, NPROJ, C.G, (int)blockIdx.x); pg8::EpiBf16Q E{C.PROJ, NPROJ, C.HS, C.WINS};
                 pg8::gemm_phase<pg8::EpiBf16Q, pg8::StaticOrder, PG8_ALIGN, PG8_SP2>(C.lds, g, S, E)); SEAM(2);
    if (IN(3)) REP(3, for (int it = C.vcu; it < 256 + 256 + 256 * P3_GLA_TWICE; it += C.G) { Ctx C3 = C; { int t_ = C.tid; asm volatile("" : "+v"(t_)); C3.tid = t_; C3.lane = t_ & 63; }
                 if (it < 256) moba_prep_item(C3, it >> 7, (it >> 4) & 7, it & 15, rep_); else { const int g_ = (it - 256) & 255; gla_prep_item(C3, g_ >> 7, (g_ >> 1) & 63, g_ & 1); } }); SEAM(3);
    if (IN(4)) REP(4, for (int it = C.vcu; it < 256 + 256; it += C.G) { if (it < 256) moba_select_item(C, it >> 7, (it >> 4) & 7, it & 15, rep_); else { const int g_ = it - 256; gla_u_item(C, g_ >> 7, (g_ >> 4) & 7, g_ & 15); } }); SEAM(4);
    if (IN(5)) REP(5, p5_attn_phase(C, rep_)); SEAM(5);
    if (IN(6)) REP(6, { GlaRaw R_, N_; int it = C.vcu; if (it < 1024) gla_out_load(C, it >> 9, (it >> 6) & 7, it & 63, R_); for (; it < 1024; it += C.G) { const int nx = it + C.G; gla_out_item(C, it >> 9, (it >> 6) & 7, it & 63, R_, nx < 1024, nx >> 9, (nx >> 6) & 7, nx & 63, N_); R_ = N_; } } for (int t = C.gw; t < T; t += 2 * C.ngw) moba_merge_pair(C, (size_t)t, (size_t)(t + C.ngw), t + C.ngw < T)); SEAM(6);
    if (IN(7)) REP(7, pg8::Gemm g{C.CONCAT, C.WOUT, T, D, D}; pg8::StaticOrder S; S.init(T, D, C.G, (int)blockIdx.x); pg8::EpiResGate E{C.x, C.X1B, D, C.MOD + 2 * D, NMOD, SEQ / 256};
                 pg8::gemm_phase<pg8::EpiResGate, pg8::StaticOrder, PG8_ALIGN, PG8_SP2>(C.lds, g, S, E)); SEAM(7);
    if (IN(8)) REP(8, norm_mod_phase<false>(C, nullptr, C.g2, 3 * D, 4 * D, C.H)); SEAM(8);
    if (IN(9)) REP(9, int upm_ = -1; int upn_ = 0; first_unit(T / 256, D / 256, C.G, (int)blockIdx.x, upm_, upn_); SUBTS(0);
                 { pg8::Gemm g{(const bf16*)C.HQ, (const bf16*)C.WQQ, T, D, D / 2, 256, (size_t)T * 256}; pg8::StaticOrder S; S.init(T, D, C.G, (int)blockIdx.x); pg8::EpiLdsTileQ E{C.HS, C.WQS}; pg8::gemm_phase<pg8::EpiLdsTileQ, pg8::StaticOrder, false, PG8_SP2>(C.lds, g, S, E); }
                 __syncthreads(); SUBTS(1); if (upm_ >= 0) peer_topk_item(C, upm_ * 8 + C.wave, upn_, C.lds, 32 * C.wave); __syncthreads(); SUBTS(2)); SEAM(9);
    if (IN(10)) { _Pragma("unroll 1") for (int rp_ = P10_PASSES - 1; rp_ >= 0; --rp_) { peer_expert_phase<0>(C, nullptr, rp_); if (rp_) xcd_barrier(bar); } } SEAM(10);
    if (IN(11)) REP(11, for (int t = C.gw; t < T; t += C.ngw) peer_weights_token(C, (size_t)t)); SEAM(11);
    if (IN(12)) REP(12, peer_expert_phase<1>(C, rep_ ? C.QP : C.out, rep_));
    if (PROBE_TS >= 0) { xcd_barrier(bar); if (blockIdx.x == PROBE_BLK && threadIdx.x == 0) { volatile LAS unsigned long long* ts = (volatile LAS unsigned long long*)(C.lds + RING_BYTES + 8192); const unsigned long long tend = __builtin_amdgcn_s_memrealtime();
        const unsigned long long d = PROBE_SA >= 0 ? ts[40 + PROBE_SB] - ts[40 + PROBE_SA] : (PROBE_ARR ? ts[32 + PROBE_TS] : PROBE_TS == 12 ? tend : ts[PROBE_TS + 1]) - ts[PROBE_TS]; C.out[0] += (float)d * (PROBE_SA >= 0 ? 0.01f : 0.001f); } }
#undef IN
#undef SEAM
}

extern "C" void kernel_launch(void* const* d_in, const int* in_sizes, int n_in, void* d_out, int out_size, void* d_ws, size_t ws_size, hipStream_t stream) {
    static int grid = 0;
    if (grid == 0) {
        if (n_in != 18 || in_sizes[0] != T * D || out_size != T * D || ws_size < WS_END) { fprintf(stderr, "kernel_launch: shape/workspace mismatch (n_in %d, in0 %d, out %d, ws %zu, need %zu); nothing launched\n", n_in, n_in > 0 ? in_sizes[0] : -1, out_size, ws_size, (size_t)WS_END); grid = -1; return; }
        int dev = 0, cus = 0, per_cu = 0;
        if (hipGetDevice(&dev) != hipSuccess || hipDeviceGetAttribute(&cus, hipDeviceAttributeMultiprocessorCount, dev) != hipSuccess) { fprintf(stderr, "kernel_launch: device query failed\n"); grid = -1; return; }
        if (hipFuncSetAttribute((const void*)fwd_kernel, hipFuncAttributeMaxDynamicSharedMemorySize, LDS_BYTES) != hipSuccess) { fprintf(stderr, "kernel_launch: hipFuncSetAttribute failed\n"); grid = -1; return; }
        if (hipOccupancyMaxActiveBlocksPerMultiprocessor(&per_cu, (const void*)fwd_kernel, NTHREADS, LDS_BYTES) != hipSuccess || per_cu < 1) { fprintf(stderr, "kernel_launch: occupancy query reports %d workgroups per CU\n", per_cu); (void)hipGetLastError(); grid = -1; return; }
        grid = cus;
    }
    if (grid < 0) return;
    if (hipMemsetAsync((char*)d_ws + WS_CTL, 0, CTL_ZERO_BYTES, stream) != hipSuccess) { fprintf(stderr, "kernel_launch: memset failed\n"); return; }
    Args a{};
    for (int i = 0; i < 18; ++i) a.in[i] = d_in[i];
    a.out = (float*)d_out; a.ws = (unsigned char*)d_ws;
#if MK_N_LAUNCHES == 1
    a.ph_lo = 0; a.ph_hi = N_PHASES;
    void* kargs[] = {&a};
#if defined(MK_PLAIN_LAUNCH)
    (void)kargs; hipLaunchKernelGGL(fwd_kernel, dim3(grid), dim3(NTHREADS), LDS_BYTES, stream, a);
#else
    hipError_t le = hipLaunchCooperativeKernel((const void*)fwd_kernel, dim3(grid), dim3(NTHREADS), kargs, LDS_BYTES, stream);
    if (le != hipSuccess) fprintf(stderr, "kernel_launch: cooperative launch failed: %s (grid %d)\n", hipGetErrorName(le), grid);
#endif
#else
    for (int p = 0; p < N_PHASES; ++p) { a.ph_lo = p; a.ph_hi = p + 1; hipLaunchKernelGGL(fwd_kernel, dim3(grid), dim3(NTHREADS), LDS_BYTES, stream, a); }
#endif
}
```
